# Optimizing an MI355X kernel written in HIP

```python
import jax
import jax.numpy as jnp
from jax import lax
import numpy as np

D_MODEL = 1024
BATCH = 4
SEQ = 4096
DEPTH = 4

GRID_W = 64
CTX_LEN = 256
HEAD_DIM = 64
EPS = 1e-6

A_HEADS = 8
A_KV_HEADS = 2
A_GROUP = A_HEADS // A_KV_HEADS
A_BLOCK = 128
ROPE_THETA = 10000.0

LRU_WIDTH = 512
LRU_BLOCKS = 8
LRU_BLOCK_W = LRU_WIDTH // LRU_BLOCKS
LRU_C = 8.0

CONV_W = 4
CONV_PAD = ((CONV_W - 1) // 2, CONV_W // 2)

DN_HEADS = 4
DN_DK = 128
DN_DV = 128
DN_CHUNK = 64

NA_HEADS = 8
NA_WIN_R = 8
NA_WIN_C = 16

N_BRANCH = 4
BRANCH_W = 512

N_EXPERTS = 32
TOP_K = 4
D_EXPERT = D_MODEL
SWIGLU_LIMIT = 7.0
SWIGLU_ALPHA = 1.702

IN_SPLITS = (
    ('a_q', A_HEADS * HEAD_DIM), ('a_k', A_KV_HEADS * HEAD_DIM), ('a_v', A_KV_HEADS * HEAD_DIM),
    ('b_x', LRU_WIDTH), ('b_y', LRU_WIDTH),
    ('c_q', DN_HEADS * DN_DK), ('c_k', DN_HEADS * DN_DK), ('c_v', DN_HEADS * DN_DV),
    ('c_z', DN_HEADS * DN_DV), ('c_a', 2 * DN_HEADS), ('c_b', 2 * DN_HEADS),
    ('d_q', NA_HEADS * HEAD_DIM), ('d_k', NA_HEADS * HEAD_DIM), ('d_v', NA_HEADS * HEAD_DIM),
    ('gate', N_BRANCH * D_MODEL),
)
IN_WIDTH = sum(w for _, w in IN_SPLITS)

kernel_name = 'hybrid_flow_backbone_block'


def rms_norm(x, g):
    xf = x.astype(jnp.float32)
    y = xf * lax.rsqrt(jnp.mean(xf * xf, axis=-1, keepdims=True) + EPS)
    return (y * g.astype(jnp.float32)).astype(x.dtype)


def l2_normalize(x):
    xf = x.astype(jnp.float32)
    return xf * lax.rsqrt(jnp.sum(xf * xf, axis=-1, keepdims=True) + EPS)


def modulate(h, shift, scale):
    return h * (1 + scale) + shift


def split_in(u):
    offs = np.cumsum([w for _, w in IN_SPLITS])[:-1].tolist()
    return dict(zip([n for n, _ in IN_SPLITS], jnp.split(u, offs, axis=-1)))


def flip_seq(ts):
    return tuple(jnp.flip(t, axis=1) for t in ts)


def dwconv(x, w, b=None):
    y = lax.conv_general_dilated(x, w[:, None, :].astype(x.dtype), window_strides=(1,),
                                 padding=[CONV_PAD], dimension_numbers=('NWC', 'WIO', 'NWC'),
                                 feature_group_count=x.shape[-1])
    return y if b is None else y + b.astype(x.dtype)


def axial_rope_tables(n_tokens):
    t = jnp.arange(n_tokens)
    row = (t // GRID_W).astype(jnp.float32)
    col = (t % GRID_W).astype(jnp.float32)
    n_freq = HEAD_DIM // 4
    inv = ROPE_THETA ** (-jnp.arange(n_freq, dtype=jnp.float32) / n_freq)
    ang = jnp.concatenate([row[:, None] * inv[None], col[:, None] * inv[None]], axis=-1)
    return jnp.cos(ang), jnp.sin(ang)


def apply_rope(x, cos, sin):
    half = x.shape[-1] // 2
    shp = (x.shape[1],) + (1,) * (x.ndim - 3) + (half,)
    cos, sin = cos.reshape(shp), sin.reshape(shp)
    xf = x.astype(jnp.float32)
    x1, x2 = xf[..., :half], xf[..., half:]
    return jnp.concatenate([x1 * cos - x2 * sin, x2 * cos + x1 * sin], axis=-1).astype(x.dtype)


def gqa_dense(q, k, v):
    s = jnp.einsum('bqkgd,blkd->bkgql', q, k) * (q.shape[-1] ** -0.5)
    p = jax.nn.softmax(s.astype(jnp.float32), axis=-1).astype(v.dtype)
    return jnp.einsum('bkgql,blkd->bqkgd', p, v)


def mixer_gqa(q, k, v, qc, kc, vc, g_q, g_k, cos, sin, ctx_out):
    B, S, _ = q.shape
    L = qc.shape[1]
    q = q.reshape(B, S, A_KV_HEADS, A_GROUP, HEAD_DIM)
    k = k.reshape(B, S, A_KV_HEADS, HEAD_DIM)
    v = v.reshape(B, S, A_KV_HEADS, HEAD_DIM)
    qc = rms_norm(qc.reshape(B, L, A_KV_HEADS, A_GROUP, HEAD_DIM), g_q)
    kc = rms_norm(kc.reshape(B, L, A_KV_HEADS, HEAD_DIM), g_k)
    vc = vc.reshape(B, L, A_KV_HEADS, HEAD_DIM)
    q = apply_rope(rms_norm(q, g_q), cos, sin)
    k = apply_rope(rms_norm(k, g_k), cos, sin)
    scale = HEAD_DIM ** -0.5

    def block(qb):
        s = jnp.concatenate([jnp.einsum('bqkgd,bskd->bkgqs', qb, k),
                             jnp.einsum('bqkgd,blkd->bkgql', qb, kc)], axis=-1) * scale
        p = jax.nn.softmax(s.astype(jnp.float32), axis=-1).astype(v.dtype)
        return (jnp.einsum('bkgqs,bskd->bqkgd', p[..., :S], v)
                + jnp.einsum('bkgql,blkd->bqkgd', p[..., S:], vc))

    qb = q.reshape(B, S // A_BLOCK, A_BLOCK, A_KV_HEADS, A_GROUP, HEAD_DIM).swapaxes(0, 1)
    o = lax.map(block, qb).swapaxes(0, 1).reshape(B, S, A_HEADS * HEAD_DIM)
    oc = gqa_dense(qc, kc, vc).reshape(B, L, A_HEADS * HEAD_DIM) if ctx_out else None
    return o, oc


def _rglru_coeffs(x, lam, w_r, b_r, w_i, b_i):
    xf = x.astype(jnp.float32)
    blk = xf.reshape(x.shape[:-1] + (LRU_BLOCKS, LRU_BLOCK_W))
    r = jax.nn.sigmoid(jnp.einsum('blnc,ncd->blnd', blk, w_r).reshape(x.shape) + b_r)
    i = jax.nn.sigmoid(jnp.einsum('blnc,ncd->blnd', blk, w_i).reshape(x.shape) + b_i)
    log_a = -LRU_C * r * jax.nn.softplus(-lam.astype(jnp.float32))
    return jnp.exp(log_a), jnp.sqrt(-jnp.expm1(2 * log_a)) * (i * xf)


def _lin_combine(e1, e2):
    a1, b1 = e1
    a2, b2 = e2
    return a1 * a2, a2 * b1 + b2


def _linear_scan(a, b, h0):
    b = b.at[:, 0].add(a[:, 0] * h0)
    _, h = lax.associative_scan(_lin_combine, (a, b), axis=1)
    return h


def mixer_rglru(xb, yb, xbc, ybc, conv_w, conv_b, lam, w_r, b_r, w_i, b_i, ctx_out):
    xb = dwconv(xb, conv_w, conv_b)
    xbc = dwconv(xbc, conv_w, conv_b)
    h0 = jnp.zeros((xb.shape[0], LRU_WIDTH), jnp.float32)
    hs, hcs = [], []
    for d in range(2):
        a, bb = _rglru_coeffs(xb, lam[d], w_r[d], b_r[d], w_i[d], b_i[d])
        ac, bc = _rglru_coeffs(xbc, lam[d], w_r[d], b_r[d], w_i[d], b_i[d])
        if d == 1:
            a, bb, ac, bc = flip_seq((a, bb, ac, bc))
        hc = _linear_scan(ac, bc, h0)
        h = _linear_scan(a, bb, hc[:, -1])
        if d == 1:
            h, hc = flip_seq((h, hc))
        hs.append(h)
        hcs.append(hc)
    y = ((hs[0] + hs[1]) * jax.nn.gelu(yb.astype(jnp.float32))).astype(yb.dtype)
    yc = ((hcs[0] + hcs[1]) * jax.nn.gelu(ybc.astype(jnp.float32))).astype(ybc.dtype) if ctx_out else None
    return y, yc


def chunk_gated_delta(q, k, v, g, beta, s0):
    B, L, H, _ = q.shape
    DV = v.shape[-1]
    C = DN_CHUNK
    n = L // C

    def blk(t):
        return jnp.moveaxis(t.reshape((B, n, C, H) + t.shape[3:]), 3, 1)

    q, k, v, beta = blk(q), blk(k), blk(v), blk(beta)
    gc = jnp.cumsum(blk(g), axis=-1)
    kb = k * beta[..., None]
    vb = v * beta[..., None]
    lower = np.tril(np.ones((C, C), dtype=bool))
    diff = gc[..., :, None] - gc[..., None, :]
    decay = jnp.where(lower, jnp.exp(jnp.where(lower, diff, 0.0)), 0.0)
    lmat = jnp.einsum('bhncd,bhned->bhnce', kb, k) * decay
    u = lax.linalg.triangular_solve(lmat, vb, left_side=True, lower=True, unit_diagonal=True)
    w = lax.linalg.triangular_solve(lmat, kb * jnp.exp(gc)[..., None], left_side=True, lower=True,
                                    unit_diagonal=True)
    qk = jnp.einsum('bhncd,bhned->bhnce', q, k) * decay
    qg = q * jnp.exp(gc)[..., None]
    kd = k * jnp.exp(gc[..., -1:] - gc)[..., None]
    glast = jnp.exp(gc[..., -1])

    def step(s, xs):
        qk_i, qg_i, w_i, u_i, kd_i, gl_i = xs
        vn = u_i - jnp.einsum('bhcd,bhde->bhce', w_i, s)
        o = jnp.einsum('bhcd,bhde->bhce', qg_i, s) + jnp.einsum('bhce,bhef->bhcf', qk_i, vn)
        s = s * gl_i[..., None, None] + jnp.einsum('bhcd,bhce->bhde', kd_i, vn)
        return s, o

    xs = tuple(jnp.moveaxis(t, 2, 0) for t in (qk, qg, w, u, kd, glast))
    s_fin, o = lax.scan(step, s0, xs)
    o = jnp.moveaxis(jnp.moveaxis(o, 0, 2), 1, 3).reshape(B, L, H, DV)
    return o, s_fin


def _gdn_prep(q, k, v, ga, gb, conv_w, a_log, dt_bias):
    B, L, _ = q.shape
    nk = DN_HEADS * DN_DK
    qkv = jax.nn.silu(dwconv(jnp.concatenate([q, k, v], axis=-1), conv_w).astype(jnp.float32))
    qh = l2_normalize(qkv[..., :nk].reshape(B, L, DN_HEADS, DN_DK)) * (DN_DK ** -0.5)
    kh = l2_normalize(qkv[..., nk:2 * nk].reshape(B, L, DN_HEADS, DN_DK))
    vh = qkv[..., 2 * nk:].reshape(B, L, DN_HEADS, DN_DV)
    g = -jnp.exp(a_log.astype(jnp.float32)) * jax.nn.softplus(
        ga.astype(jnp.float32).reshape(B, L, 2, DN_HEADS) + dt_bias.astype(jnp.float32))
    beta = jax.nn.sigmoid(gb.astype(jnp.float32).reshape(B, L, 2, DN_HEADS))
    return qh, kh, vh, g, beta


def _gdn_out(o, z, g_out):
    B, L, _ = z.shape
    zf = jax.nn.silu(z.astype(jnp.float32).reshape(B, L, DN_HEADS, DN_DV))
    return (rms_norm(o, g_out) * zf).reshape(B, L, DN_HEADS * DN_DV).astype(z.dtype)


def mixer_gdn(q, k, v, z, ga, gb, qc, kc, vc, zc, gac, gbc, conv_w, a_log, dt_bias, g_out, ctx_out):
    qh, kh, vh, g, beta = _gdn_prep(q, k, v, ga, gb, conv_w, a_log, dt_bias)
    qch, kch, vch, gcx, bcx = _gdn_prep(qc, kc, vc, gac, gbc, conv_w, a_log, dt_bias)
    s_zero = jnp.zeros((q.shape[0], DN_HEADS, DN_DK, DN_DV), jnp.float32)
    outs, outs_c = [], []
    for d in range(2):
        lat_in = (qh, kh, vh, g[:, :, d], beta[:, :, d])
        ctx_in = (qch, kch, vch, gcx[:, :, d], bcx[:, :, d])
        if d == 1:
            lat_in, ctx_in = flip_seq(lat_in), flip_seq(ctx_in)
        oc, s_ctx = chunk_gated_delta(*ctx_in, s_zero)
        o, _ = chunk_gated_delta(*lat_in, s_ctx)
        if d == 1:
            o, oc = flip_seq((o, oc))
        outs.append(o)
        outs_c.append(oc)
    y = _gdn_out(outs[0] + outs[1], z, g_out)
    yc = _gdn_out(outs_c[0] + outs_c[1], zc, g_out) if ctx_out else None
    return y, yc


def mixer_na(q, k, v, qc, kc, vc, rpb, ctx_out):
    B, S, _ = q.shape
    L = qc.shape[1]
    rows = S // GRID_W
    wr = min(NA_WIN_R, rows)
    scale = HEAD_DIM ** -0.5
    qg = q.reshape(B, rows, GRID_W, NA_HEADS, HEAD_DIM).transpose(1, 0, 3, 2, 4)
    kg = k.reshape(B, rows, GRID_W, NA_HEADS, HEAD_DIM).transpose(0, 3, 1, 2, 4)
    vg = v.reshape(B, rows, GRID_W, NA_HEADS, HEAD_DIM).transpose(0, 3, 1, 2, 4)
    kct = kc.reshape(B, L, NA_HEADS, HEAD_DIM).transpose(0, 2, 1, 3)
    vct = vc.reshape(B, L, NA_HEADS, HEAD_DIM).transpose(0, 2, 1, 3)
    cstart = np.clip(np.arange(GRID_W) - NA_WIN_C // 2, 0, GRID_W - NA_WIN_C)
    cidx = cstart[:, None] + np.arange(NA_WIN_C)[None, :]
    cbias = cidx - np.arange(GRID_W)[:, None] + NA_WIN_C - 1
    n_nb = wr * NA_WIN_C

    def row_fn(args):
        r, q_row = args
        rs = jnp.clip(r - wr // 2, 0, rows - wr)
        kb = lax.dynamic_slice_in_dim(kg, rs, wr, axis=2)[:, :, :, cidx]
        vb = lax.dynamic_slice_in_dim(vg, rs, wr, axis=2)[:, :, :, cidx]
        ridx = rs + jnp.arange(wr) - r + NA_WIN_R - 1
        bias = rpb[:, ridx[None, :, None], cbias[:, None, :]]
        s_nb = jnp.einsum('bhcd,bhwcjd->bhcwj', q_row, kb) * scale + bias[None]
        s_c = jnp.einsum('bhcd,bhld->bhcl', q_row, kct) * scale
        s = jnp.concatenate([s_nb.reshape(B, NA_HEADS, GRID_W, n_nb), s_c.astype(s_nb.dtype)], axis=-1)
        p = jax.nn.softmax(s.astype(jnp.float32), axis=-1).astype(v.dtype)
        return (jnp.einsum('bhcwj,bhwcjd->bhcd', p[..., :n_nb].reshape(B, NA_HEADS, GRID_W, wr, NA_WIN_C), vb)
                + jnp.einsum('bhcl,bhld->bhcd', p[..., n_nb:], vct))

    o = lax.map(row_fn, (jnp.arange(rows), qg))
    o = o.transpose(1, 0, 3, 2, 4).reshape(B, S, NA_HEADS * HEAD_DIM)
    oc = None
    if ctx_out:
        oc = gqa_dense(qc.reshape(B, L, NA_HEADS, 1, HEAD_DIM), kc.reshape(B, L, NA_HEADS, HEAD_DIM),
                       vc.reshape(B, L, NA_HEADS, HEAD_DIM)).reshape(B, L, NA_HEADS * HEAD_DIM)
    return o, oc


def merge_branches(ys, gate_logits, w_branch, w_out):
    gates = jax.nn.sigmoid(gate_logits.astype(jnp.float32))
    m = gates[..., :D_MODEL] * (ys[0] @ w_branch[0]).astype(jnp.float32)
    for i in range(1, N_BRANCH):
        m = m + gates[..., i * D_MODEL:(i + 1) * D_MODEL] * (ys[i] @ w_branch[i]).astype(jnp.float32)
    return m.astype(ys[0].dtype) @ w_out


def moe_ffn(t, w_router, b_router, w_gu, b_gu, w_dn, b_dn):
    logits = (t @ w_router + b_router).astype(jnp.float32)
    top_v, top_i = lax.top_k(logits, TOP_K)
    top_w = jax.nn.softmax(top_v, axis=-1)
    gate_w = jnp.sum(jax.nn.one_hot(top_i, N_EXPERTS, dtype=jnp.float32) * top_w[..., None], axis=1)
    out = jnp.zeros(t.shape, jnp.float32)
    for e in range(N_EXPERTS):
        gu = t @ w_gu[e] + b_gu[e]
        gate = jnp.minimum(gu[:, :D_EXPERT], SWIGLU_LIMIT)
        up = jnp.clip(gu[:, D_EXPERT:], -SWIGLU_LIMIT, SWIGLU_LIMIT)
        act = (up + 1) * gate * jax.nn.sigmoid(SWIGLU_ALPHA * gate)
        out = out + gate_w[:, e:e + 1] * (act @ w_dn[e] + b_dn[e]).astype(jnp.float32)
    return out.astype(t.dtype)


def trunk_layer(x, xc, mod, mod_c, g_norm1, g_norm2, w_in, a_gq, a_gk,
                b_conv_w, b_conv_b, b_lam, b_wr, b_br, b_wi, b_bi,
                c_conv_w, c_alog, c_dtb, c_gout, d_rpb, w_branch, w_out,
                w_router, b_router, w_gu, b_gu, w_dn, b_dn, cos, sin, ctx_out):
    sh1, sc1, gt1, sh2, sc2, gt2 = jnp.split(mod, 6, axis=-1)
    csh1, csc1, cgt1, csh2, csc2, cgt2 = jnp.split(mod_c, 6, axis=-1)
    h = modulate(rms_norm(x, g_norm1), sh1, sc1)
    hc = modulate(rms_norm(xc, g_norm1), csh1, csc1)
    u = split_in(h @ w_in)
    uc = split_in(hc @ w_in)
    ya, yac = mixer_gqa(u['a_q'], u['a_k'], u['a_v'], uc['a_q'], uc['a_k'], uc['a_v'],
                        a_gq, a_gk, cos, sin, ctx_out)
    yb, ybc = mixer_rglru(u['b_x'], u['b_y'], uc['b_x'], uc['b_y'], b_conv_w, b_conv_b,
                          b_lam, b_wr, b_br, b_wi, b_bi, ctx_out)
    yc, ycc = mixer_gdn(u['c_q'], u['c_k'], u['c_v'], u['c_z'], u['c_a'], u['c_b'],
                        uc['c_q'], uc['c_k'], uc['c_v'], uc['c_z'], uc['c_a'], uc['c_b'],
                        c_conv_w, c_alog, c_dtb, c_gout, ctx_out)
    yd, ydc = mixer_na(u['d_q'], u['d_k'], u['d_v'], uc['d_q'], uc['d_k'], uc['d_v'], d_rpb, ctx_out)
    x = x + gt1 * merge_branches((ya, yb, yc, yd), u['gate'], w_branch, w_out)
    h2 = modulate(rms_norm(x, g_norm2), sh2, sc2)
    B, S, D = x.shape
    if ctx_out:
        xc = xc + cgt1 * merge_branches((yac, ybc, ycc, ydc), uc['gate'], w_branch, w_out)
        hc2 = modulate(rms_norm(xc, g_norm2), csh2, csc2)
        f = moe_ffn(jnp.concatenate([h2.reshape(-1, D), hc2.reshape(-1, D)], axis=0),
                    w_router, b_router, w_gu, b_gu, w_dn, b_dn)
        x = x + gt2 * f[:B * S].reshape(B, S, D)
        xc = xc + cgt2 * f[B * S:].reshape(xc.shape)
    else:
        x = x + gt2 * moe_ffn(h2.reshape(-1, D), w_router, b_router, w_gu, b_gu, w_dn, b_dn).reshape(B, S, D)
    return x, xc


def setup_inputs(seed: int = 0) -> dict:
    key = jax.random.key(seed)
    ks = iter(jax.random.split(key, 40))
    D = D_MODEL
    f32 = jnp.float32

    def nrm(shape, scale):
        return jax.random.normal(next(ks), shape, f32) * scale

    def unif(shape, lo, hi):
        return jax.random.uniform(next(ks), shape, f32, minval=lo, maxval=hi)

    x = nrm((BATCH, SEQ, D), 1.0)
    c = nrm((BATCH, D), 1.0)
    ctx = nrm((BATCH, CTX_LEN, D), 1.0)
    c_ctx = nrm((D,), 1.0)
    w_mod = nrm((DEPTH, D, 6 * D), D ** -0.5)
    b_mod = nrm((DEPTH, 6 * D), 0.02)
    g_norm1 = 1.0 + nrm((DEPTH, D), 0.1)
    g_norm2 = 1.0 + nrm((DEPTH, D), 0.1)
    w_in = nrm((DEPTH, D, IN_WIDTH), D ** -0.5)
    a_gq = 1.0 + nrm((DEPTH, HEAD_DIM), 0.1)
    a_gk = 1.0 + nrm((DEPTH, HEAD_DIM), 0.1)
    b_conv_w = nrm((DEPTH, CONV_W, LRU_WIDTH), CONV_W ** -0.5)
    b_conv_b = nrm((DEPTH, LRU_WIDTH), 0.02)
    a0 = unif((DEPTH, 2, LRU_WIDTH), 0.9, 0.999) ** (1.0 / LRU_C)
    b_lam = jnp.log(a0) - jnp.log1p(-a0)
    b_wr = nrm((DEPTH, 2, LRU_BLOCKS, LRU_BLOCK_W, LRU_BLOCK_W), LRU_BLOCK_W ** -0.5)
    b_br = nrm((DEPTH, 2, LRU_WIDTH), 0.02)
    b_wi = nrm((DEPTH, 2, LRU_BLOCKS, LRU_BLOCK_W, LRU_BLOCK_W), LRU_BLOCK_W ** -0.5)
    b_bi = nrm((DEPTH, 2, LRU_WIDTH), 0.02)
    c_conv_w = nrm((DEPTH, CONV_W, DN_HEADS * (2 * DN_DK + DN_DV)), CONV_W ** -0.5)
    c_alog = jnp.log(unif((DEPTH, 2, DN_HEADS), 1.0, 16.0))
    dt = jnp.exp(unif((DEPTH, 2, DN_HEADS), float(np.log(1e-3)), float(np.log(1e-1))))
    c_dtb = dt + jnp.log(-jnp.expm1(-dt))
    c_gout = 1.0 + nrm((DEPTH, DN_DV), 0.1)
    d_rpb = nrm((DEPTH, NA_HEADS, 2 * NA_WIN_R - 1, 2 * NA_WIN_C - 1), 0.1)
    w_branch = nrm((DEPTH, N_BRANCH, BRANCH_W, D), BRANCH_W ** -0.5)
    w_out = nrm((DEPTH, D, D), D ** -0.5)
    w_router = nrm((DEPTH, D, N_EXPERTS), D ** -0.5)
    b_router = nrm((DEPTH, N_EXPERTS), 0.01)
    w_gu = nrm((DEPTH, N_EXPERTS, D, 2 * D_EXPERT), D ** -0.5)
    b_gu = nrm((DEPTH, N_EXPERTS, 2 * D_EXPERT), 0.02)
    w_dn = nrm((DEPTH, N_EXPERTS, D_EXPERT, D), D_EXPERT ** -0.5)
    b_dn = nrm((DEPTH, N_EXPERTS, D), 0.02)
    g_final = 1.0 + nrm((D,), 0.1)
    return {'x': x, 'c': c, 'ctx': ctx, 'c_ctx': c_ctx, 'w_mod': w_mod, 'b_mod': b_mod,
            'g_norm1': g_norm1, 'g_norm2': g_norm2, 'w_in': w_in, 'a_gq': a_gq, 'a_gk': a_gk,
            'b_conv_w': b_conv_w, 'b_conv_b': b_conv_b, 'b_lam': b_lam, 'b_wr': b_wr, 'b_br': b_br,
            'b_wi': b_wi, 'b_bi': b_bi, 'c_conv_w': c_conv_w, 'c_alog': c_alog, 'c_dtb': c_dtb,
            'c_gout': c_gout, 'd_rpb': d_rpb, 'w_branch': w_branch, 'w_out': w_out,
            'w_router': w_router, 'b_router': b_router, 'w_gu': w_gu, 'b_gu': b_gu,
            'w_dn': w_dn, 'b_dn': b_dn, 'g_final': g_final}


def reference(x, c, ctx, c_ctx, w_mod, b_mod, g_norm1, g_norm2, w_in, a_gq, a_gk,
              b_conv_w, b_conv_b, b_lam, b_wr, b_br, b_wi, b_bi, c_conv_w, c_alog, c_dtb,
              c_gout, d_rpb, w_branch, w_out, w_router, b_router, w_gu, b_gu, w_dn, b_dn, g_final):
    cos, sin = axial_rope_tables(x.shape[1])
    sc = jax.nn.silu(c)
    scc = jax.nn.silu(c_ctx)
    xc = ctx
    for l in range(DEPTH):
        mod = (sc @ w_mod[l] + b_mod[l])[:, None, :]
        mod_c = (scc @ w_mod[l] + b_mod[l])[None, None, :]
        x, xc = trunk_layer(x, xc, mod, mod_c, g_norm1[l], g_norm2[l], w_in[l], a_gq[l], a_gk[l],
                            b_conv_w[l], b_conv_b[l], b_lam[l], b_wr[l], b_br[l], b_wi[l], b_bi[l],
                            c_conv_w[l], c_alog[l], c_dtb[l], c_gout[l], d_rpb[l], w_branch[l], w_out[l],
                            w_router[l], b_router[l], w_gu[l], b_gu[l], w_dn[l], b_dn[l], cos, sin,
                            l < DEPTH - 1)
    return rms_norm(x, g_final)
```

```cpp
#include <hip/hip_runtime.h>
#include <cstdio>
#include <cstdint>

#ifndef MK_MULTI
#define MK_MULTI 1
#endif

constexpr int D = 1024, NB = 4, SEQ = 4096, LCTX = 256, DEPTH = 4;
constexpr int TLAT = NB * SEQ, TCTX = NB * LCTX, MROWS = TLAT + TCTX;
constexpr int NCHUNK = MROWS / 64;
constexpr int INW = 9488, UW = 9472;
constexpr int UQ = 0, UK = 512, UV = 640, UBX = 768, UBY = 1280, UCQ = 1792, UCK = 2304, UCV = 2816, UCZ = 3328, UDQ = 3840, UDK = 4352, UDV = 4864, UG = 5376;
constexpr int NEXP = 32, TOPK = 4;
constexpr int KEYS = SEQ + LCTX;
constexpr int MOE_ROWS = MROWS * TOPK + NEXP * 256;
constexpr float EPS = 1e-6f;
constexpr float LOG2E = 1.4426950408889634f;

constexpr size_t al256(size_t x) { return (x + 255) & ~(size_t)255; }
constexpr size_t WS_CTL = 0, CTL_BYTES = 1u << 20;
constexpr size_t WS_MOD  = WS_CTL + CTL_BYTES;
constexpr size_t WS_ROPE = WS_MOD + al256((size_t)DEPTH * 5 * 6144 * 4);
constexpr size_t WS_LRUW = WS_ROPE + al256(2 * 64 * 16 * 4);
constexpr size_t WS_WIN  = WS_LRUW + al256((size_t)DEPTH * 2 * 2 * 8 * 4096 * 2);
constexpr size_t WS_WBR  = WS_WIN + al256((size_t)DEPTH * UW * D * 2);
constexpr size_t WS_WOUT = WS_WBR + al256((size_t)DEPTH * 4 * 1024 * 512 * 2);
constexpr size_t WS_WGU  = WS_WOUT + al256((size_t)DEPTH * D * D * 2);
constexpr size_t WS_WDN  = WS_WGU + al256((size_t)DEPTH * NEXP * 2048 * 1024 * 2);
constexpr size_t WS_X    = WS_WDN + al256((size_t)DEPTH * NEXP * 1024 * 1024 * 2);
constexpr size_t WS_H    = WS_X + al256((size_t)MROWS * D * 4);
constexpr size_t WS_U    = WS_H + al256((size_t)MROWS * D * 2);
constexpr size_t WS_CAB  = WS_U + al256((size_t)MROWS * UW * 2);
constexpr size_t WS_VAT  = WS_CAB + al256((size_t)MROWS * 16 * 4);
constexpr size_t WS_VDT  = WS_VAT + al256((size_t)NB * 2 * 64 * KEYS * 2);
constexpr size_t WS_LRA  = WS_VDT + al256((size_t)NB * 8 * 64 * KEYS * 2);
constexpr size_t WS_LRB  = WS_LRA + al256((size_t)NCHUNK * 2 * 512 * 4);
constexpr size_t WS_LRC  = WS_LRB + al256((size_t)NCHUNK * 2 * 512 * 4);
constexpr int NCD = NCHUNK * 4 * 2;
constexpr size_t WS_GW   = WS_LRC + al256((size_t)NCHUNK * 2 * 512 * 4);
constexpr size_t WS_GU   = WS_GW + al256((size_t)NCD * 64 * 128 * 2);
constexpr size_t WS_GQG  = WS_GU + al256((size_t)NCD * 64 * 128 * 2);
constexpr size_t WS_GKD  = WS_GQG + al256((size_t)NCD * 64 * 128 * 2);
constexpr size_t WS_GQK  = WS_GKD + al256((size_t)NCD * 64 * 128 * 2);
constexpr size_t WS_GGL  = WS_GQK + al256((size_t)NCD * 64 * 64 * 2);
constexpr size_t WS_GO   = WS_GGL + al256((size_t)NCD * 4);
constexpr size_t WS_Y    = WS_GO + al256((size_t)2 * MROWS * 512 * 4);
constexpr size_t WS_MF   = WS_Y + al256((size_t)4 * MROWS * 512 * 2);
constexpr size_t WS_MB   = WS_MF + al256((size_t)MROWS * D * 4);
constexpr size_t WS_SROW = WS_MB + al256((size_t)MROWS * D * 2);
constexpr size_t WS_SW   = WS_SROW + al256((size_t)MROWS * 4 * 4);
constexpr size_t WS_SEP  = WS_SW + al256((size_t)MROWS * 4 * 4);
constexpr size_t WS_LIST = WS_SEP + al256((size_t)MROWS * 4 * 4);
constexpr size_t WS_HS   = WS_LIST + al256((size_t)NEXP * MROWS * 4);
constexpr size_t WS_ACT  = WS_HS + al256((size_t)MOE_ROWS * D * 2);
constexpr size_t WS_YS   = WS_ACT + al256((size_t)MOE_ROWS * D * 2);
constexpr size_t WS_END  = WS_YS + al256((size_t)MOE_ROWS * D * 2);

constexpr int CW_BAR = 4096;
constexpr int CW_CNT = 1024;

constexpr int RING_BYTES = 131072;
constexpr int MISC_OFF = RING_BYTES;
constexpr int LDS_BYTES = 147456;
constexpr int NWAVES = 8, NT = 512;

#define GAS __attribute__((address_space(1)))
#define LAS __attribute__((address_space(3)))
typedef unsigned short bf16;
typedef unsigned v4u __attribute__((ext_vector_type(4)));
typedef unsigned v2u __attribute__((ext_vector_type(2)));
typedef float f32x4 __attribute__((ext_vector_type(4)));
typedef float f32x16 __attribute__((ext_vector_type(16)));
typedef short bf16x8 __attribute__((ext_vector_type(8)));
typedef short bf16x4 __attribute__((ext_vector_type(4)));

__device__ __forceinline__ unsigned f2bf(float f) { unsigned u = __builtin_bit_cast(unsigned, f); return (u + 0x7fffu + ((u >> 16) & 1u)) >> 16; }
__device__ __forceinline__ unsigned pk2(float lo, float hi) { return f2bf(lo) | (f2bf(hi) << 16); }
__device__ __forceinline__ float bf2f(unsigned short b) { return __builtin_bit_cast(float, (unsigned)b << 16); }
__device__ __forceinline__ float bflo(unsigned w) { return __builtin_bit_cast(float, w << 16); }
__device__ __forceinline__ float bfhi(unsigned w) { return __builtin_bit_cast(float, w & 0xffff0000u); }
__device__ __forceinline__ float wave_sum(float v) {
#pragma unroll
    for (int o = 1; o < 64; o <<= 1) v += __shfl_xor(v, o);
    return v;
}
__device__ __forceinline__ float sigmoidf_(float x) { return 1.f / (1.f + __expf(-x)); }
__device__ __forceinline__ float softplusf_(float x) { return x > 20.f ? x : log1pf(__expf(x)); }
__device__ __forceinline__ float siluf_(float x) { return x / (1.f + __expf(-x)); }
namespace pg8 {
#define PG8_LAS __attribute__((address_space(3)))
typedef unsigned short bf16_t;
typedef short bf16x8 __attribute__((ext_vector_type(8)));
typedef float f32x4 __attribute__((ext_vector_type(4)));
typedef unsigned u32x4 __attribute__((ext_vector_type(4)));
constexpr int BM = 256, BK = 64, HALF = 128, HTB = HALF * BK * 2  , STAGE_BYTES = 8 * HTB, NXCD = 8, WGM = 8;

__host__ __device__ __forceinline__ int lds_byte(int r, int c) { const int st = (r >> 4) * 2 + (c >> 5), rr = r & 15, cc = c & 31, ob = rr * 64 + cc * 2; return st * 1024 + (ob ^ (((ob >> 9) & 1) << 5)); }
__host__ __device__ __forceinline__ void stage_rc(int b, int& R, int& C) { const int st = b / 1024, sb = b % 1024, swz = sb ^ (((sb >> 9) & 1) << 5); R = (st >> 1) * 16 + swz / 64; C = (st & 1) * 32 + (swz % 64) / 2; }
__host__ __device__ __forceinline__ int perm32(int rho) { const int n = rho >> 4, i = rho & 15; return 8 * (i >> 2) + 4 * n + (i & 3); }

struct Unit { int pm, pn; };
struct Gemm { const bf16_t* A; const bf16_t* Bt; int M, N, K; };

struct StaticOrder {
    int nM, nN, nwg, G, c;
    __host__ __device__ void init(int M, int N, int G_, int c_) { nM = M / BM; nN = N / BM; nwg = nM * nN; G = G_; c = c_; }
    __host__ __device__ bool next(int i, Unit& u) const {
        const long L = (long)i * G + c; if (L >= nwg) return false;
        int wgid = (int)L; { const int q = nwg / NXCD, r = nwg % NXCD, xcd = wgid % NXCD, off = wgid / NXCD; wgid = (xcd < r ? xcd * (q + 1) : r * (q + 1) + (xcd - r) * q) + off; }
        const int nig = WGM * nN, gid = wgid / nig, fm = gid * WGM, gsz = (nM - fm) < WGM ? (nM - fm) : WGM;
        u.pm = fm + ((wgid % nig) % gsz); u.pn = (wgid % nig) / gsz; return true;
    }
    __device__ __forceinline__ void a_ready(const Unit&) const {}
    __device__ __forceinline__ void done(const Unit&) const {}
};

__device__ __forceinline__ unsigned cvt_pk_bf16(float lo, float hi) { unsigned r; asm volatile("v_cvt_pk_bf16_f32 %0, %1, %2" : "=v"(r) : "v"(lo), "v"(hi)); return r; }
typedef float f32x2 __attribute__((ext_vector_type(2)));
template <class Epi, class Sched, bool ALIGN_EPI = false, bool SP2 = false>
__device__ __forceinline__ void gemm_phase(PG8_LAS unsigned char* lds, const Gemm g, const Sched& S, const Epi& E) {
    int tid_o = threadIdx.x; asm volatile("" : "+v"(tid_o));
    const int tid = tid_o, wid = __builtin_amdgcn_readfirstlane(tid >> 6), lane = tid & 63, wr = wid >> 2, wc = wid & 3, fr = lane & 15, fq = lane >> 4;
    const int K = g.K, nt = K / BK;
    unsigned voffA[2], voffB[2];
#pragma unroll
    for (int i = 0; i < 2; ++i) { int R, C; stage_rc(tid * 16 + i * 8192, R, C); const int Rb = Epi::PERM ? ((R & ~31) + perm32(R & 31)) : R;
        voffA[i] = (unsigned)(R * K + C) * 2u; voffB[i] = (unsigned)(Rb * K + C) * 2u; }
    const size_t kstep = (size_t)(BK * 2);
    const size_t hstep = (size_t)HALF * K * 2;
    const size_t tstep = 2 * hstep;
    const unsigned ldsw = (unsigned)wid * 1024u;
    const int aoff = lds_byte(wr * 64 + fr, fq * 8), boff = lds_byte(wc * 32 + fr, fq * 8);
#define PG8_SA(b, h) (((b) * 2 + (h)) * HTB)
#define PG8_SB(b, h) ((4 + (b) * 2 + (h)) * HTB)
#define PG8_STAGE(bufoff, gbase, voff) do { _Pragma("unroll") for (int _i = 0; _i < 2; ++_i) \
        __builtin_amdgcn_global_load_lds((const unsigned*)((const char*)(gbase) + (voff)[_i]), (PG8_LAS unsigned*)(lds + (bufoff) + ldsw + _i * 8192), 16, 0, 0); } while (0)
#define PG8_LDA(dst, b, h) do { _Pragma("unroll") for (int m = 0; m < 4; ++m) _Pragma("unroll") for (int k = 0; k < 2; ++k) dst[m][k] = *(const PG8_LAS bf16x8*)(lds + PG8_SA(b, h) + aoff + m * 2048 + k * 1024); } while (0)
#define PG8_LDB(dst, b, h) do { _Pragma("unroll") for (int n = 0; n < 2; ++n) _Pragma("unroll") for (int k = 0; k < 2; ++k) dst[n][k] = *(const PG8_LAS bf16x8*)(lds + PG8_SB(b, h) + boff + n * 2048 + k * 1024); } while (0)
#define PG8_MMA(ai, bj, At, Bt) do { __builtin_amdgcn_s_setprio(1); _Pragma("unroll") for (int m = 0; m < 4; ++m) _Pragma("unroll") for (int n = 0; n < 2; ++n) _Pragma("unroll") for (int k = 0; k < 2; ++k) \
        acc[ai][bj][m][n] = __builtin_amdgcn_mfma_f32_16x16x32_bf16(Bt[n][k], At[m][k], acc[ai][bj][m][n], 0, 0, 0); __builtin_amdgcn_s_setprio(0); } while (0)
#define PG8_WAIT_V(n) asm volatile("s_waitcnt vmcnt(" #n ")" ::: "memory")
#define PG8_WAIT_L(n) asm volatile("s_waitcnt lgkmcnt(" #n ")" ::: "memory")
#define PG8_BAR __builtin_amdgcn_s_barrier()
#define PG8_SCHED __builtin_amdgcn_sched_barrier(0)
    Unit cur, nxt; int ui = 0;
    if (!S.next(0, cur)) return;
    f32x4 acc[2][2][4][2];
#pragma unroll
    for (int a = 0; a < 2; ++a)
#pragma unroll
        for (int b = 0; b < 2; ++b)
#pragma unroll
            for (int m = 0; m < 4; ++m)
#pragma unroll
                for (int n = 0; n < 2; ++n) acc[a][b][m][n] = (f32x4){0.f, 0.f, 0.f, 0.f};
    bf16x8 At[4][2], B0[2][2], B1[2][2];
    const char* cA = (const char*)g.A + (size_t)cur.pm * tstep; const char* cB = (const char*)g.Bt + (size_t)cur.pn * tstep;
    S.a_ready(cur);
    if constexpr (SP2) {
        PG8_STAGE(PG8_SB(0, 0), cB, voffB); PG8_STAGE(PG8_SB(0, 1), cB + hstep, voffB); PG8_STAGE(PG8_SA(0, 0), cA, voffA); PG8_STAGE(PG8_SA(0, 1), cA + hstep, voffA);
        if (wr == 1) PG8_BAR;
        PG8_WAIT_V(2); PG8_BAR;
        PG8_STAGE(PG8_SB(1, 0), cB + kstep, voffB); PG8_STAGE(PG8_SA(1, 0), cA + kstep, voffA); PG8_STAGE(PG8_SB(1, 1), cB + hstep + kstep, voffB);
        PG8_WAIT_V(6); PG8_BAR;
    } else {
        PG8_STAGE(PG8_SB(0, 0), cB, voffB); PG8_STAGE(PG8_SA(0, 0), cA, voffA); PG8_STAGE(PG8_SB(0, 1), cB + hstep, voffB); PG8_STAGE(PG8_SA(0, 1), cA + hstep, voffA);
        if (wr == 1) PG8_BAR;
        PG8_WAIT_V(4); PG8_BAR;
        PG8_STAGE(PG8_SB(1, 0), cB + kstep, voffB); PG8_STAGE(PG8_SA(1, 0), cA + kstep, voffA); PG8_STAGE(PG8_SB(1, 1), cB + hstep + kstep, voffB);
        PG8_WAIT_V(6); PG8_BAR;
    }
    for (;;) {
        const bool has_next = S.next(ui + 1, nxt);
        const char* nA = has_next ? (const char*)g.A + (size_t)nxt.pm * tstep : cA; const char* nB = has_next ? (const char*)g.Bt + (size_t)nxt.pn * tstep : cB;
        for (int t = 0; t < nt; t += 2) {
            const bool last = (t == nt - 2);
            const char* a1 = cA + (size_t)(t + 1) * kstep;
            const char* a2 = last ? nA : cA + (size_t)(t + 2) * kstep; const char* b2 = last ? nB : cB + (size_t)(t + 2) * kstep;
            const char* a3 = a2 + kstep; const char* b3 = b2 + kstep;
            if (last && has_next) S.a_ready(nxt);
            if constexpr (SP2) {
            PG8_LDB(B0, 0, 0); PG8_LDB(B1, 0, 1); PG8_SCHED; PG8_LDA(At, 0, 0); PG8_STAGE(PG8_SA(1, 1), a1 + hstep, voffA);
            PG8_WAIT_V(8); PG8_WAIT_L(0); PG8_BAR; PG8_MMA(0, 0, At, B0); PG8_MMA(0, 1, At, B1); PG8_BAR; PG8_SCHED;
            PG8_LDA(At, 0, 1); PG8_STAGE(PG8_SB(0, 0), b2, voffB); PG8_STAGE(PG8_SB(0, 1), b2 + hstep, voffB); PG8_STAGE(PG8_SA(0, 0), a2, voffA);
            PG8_WAIT_V(8); PG8_WAIT_L(0); PG8_BAR; PG8_MMA(1, 0, At, B0); PG8_MMA(1, 1, At, B1); PG8_BAR; PG8_SCHED;
            PG8_LDB(B0, 1, 0); PG8_LDB(B1, 1, 1); PG8_SCHED; PG8_LDA(At, 1, 0); PG8_STAGE(PG8_SA(0, 1), a2 + hstep, voffA);
            PG8_WAIT_V(8); PG8_WAIT_L(0); PG8_BAR; PG8_MMA(0, 0, At, B0); PG8_MMA(0, 1, At, B1); PG8_BAR; PG8_SCHED;
            PG8_LDA(At, 1, 1); PG8_STAGE(PG8_SB(1, 0), b3, voffB); PG8_STAGE(PG8_SB(1, 1), b3 + hstep, voffB); PG8_STAGE(PG8_SA(1, 0), a3, voffA);
            PG8_WAIT_V(8); PG8_WAIT_L(0); PG8_BAR; PG8_MMA(1, 0, At, B0); PG8_MMA(1, 1, At, B1); PG8_BAR; PG8_SCHED;
            } else {
            PG8_LDB(B0, 0, 0); PG8_SCHED; PG8_LDA(At, 0, 0); PG8_STAGE(PG8_SA(1, 1), a1 + hstep, voffA);
            PG8_WAIT_L(8); PG8_BAR; PG8_WAIT_L(0); PG8_MMA(0, 0, At, B0); PG8_BAR; PG8_SCHED;
            PG8_LDB(B1, 0, 1); PG8_STAGE(PG8_SB(0, 0), b2, voffB);
            PG8_BAR; PG8_WAIT_L(0); PG8_MMA(0, 1, At, B1); PG8_BAR;
            PG8_LDA(At, 0, 1); PG8_STAGE(PG8_SA(0, 0), a2, voffA);
            PG8_BAR; PG8_WAIT_L(0); PG8_MMA(1, 0, At, B0); PG8_BAR; PG8_SCHED;
            PG8_STAGE(PG8_SB(0, 1), b2 + hstep, voffB);
            PG8_WAIT_V(6); PG8_BAR; PG8_MMA(1, 1, At, B1); PG8_BAR;
            PG8_LDB(B0, 1, 0); PG8_SCHED; PG8_LDA(At, 1, 0); PG8_STAGE(PG8_SA(0, 1), a2 + hstep, voffA);
            PG8_WAIT_L(8); PG8_BAR; PG8_WAIT_L(0); PG8_MMA(0, 0, At, B0); PG8_BAR; PG8_SCHED;
            PG8_LDB(B1, 1, 1); PG8_STAGE(PG8_SB(1, 0), b3, voffB);
            PG8_BAR; PG8_WAIT_L(0); PG8_MMA(0, 1, At, B1); PG8_BAR;
            PG8_LDA(At, 1, 1); PG8_STAGE(PG8_SA(1, 0), a3, voffA);
            PG8_BAR; PG8_WAIT_L(0); PG8_MMA(1, 0, At, B0); PG8_BAR; PG8_SCHED;
            PG8_STAGE(PG8_SB(1, 1), b3 + hstep, voffB);
            PG8_WAIT_V(6); PG8_BAR; PG8_MMA(1, 1, At, B1); PG8_BAR;
            }
        }
        if constexpr (ALIGN_EPI) { if (wr == 0) PG8_BAR; }
        if constexpr (!Epi::AFTER_DRAIN) { E(acc, cur, wr, wc, fr, fq); S.done(cur); }
        if (!has_next) break;
#pragma unroll
        for (int a = 0; a < 2; ++a)
#pragma unroll
            for (int b = 0; b < 2; ++b)
#pragma unroll
                for (int m = 0; m < 4; ++m)
#pragma unroll
                    for (int n = 0; n < 2; ++n) acc[a][b][m][n] = (f32x4){0.f, 0.f, 0.f, 0.f};
        cur = nxt; cA = nA; cB = nB; ++ui;
        if constexpr (ALIGN_EPI) { if (wr == 1) PG8_BAR; }
    }
    PG8_WAIT_V(0);
    if constexpr (!ALIGN_EPI) { if (wr == 0) PG8_BAR; }
    PG8_BAR;
    if constexpr (Epi::AFTER_DRAIN) { E.fused(acc, cur, wr, wc, fr, fq, lds, wid, lane); S.done(cur); }
#undef PG8_SA
#undef PG8_SB
#undef PG8_STAGE
#undef PG8_LDA
#undef PG8_LDB
#undef PG8_MMA
#undef PG8_WAIT_V
#undef PG8_WAIT_L
#undef PG8_BAR
#undef PG8_SCHED
}
}

namespace pg8 {
__device__ __forceinline__ float bflo_(unsigned w) { return __builtin_bit_cast(float, w << 16); }
__device__ __forceinline__ float bfhi_(unsigned w) { return __builtin_bit_cast(float, w & 0xffff0000u); }
__device__ __forceinline__ float sigm_(float x) { return 1.f / (1.f + __expf(-x)); }

struct EpiStoreBf16 {
    static constexpr bool PERM = true, AFTER_DRAIN = false;
    bf16_t* O; int ldc;
    __device__ __forceinline__ void operator()(const f32x4 (&acc)[2][2][4][2], const Unit& u, int wr, int wc, int fr, int fq) const {
        const int row0 = u.pm * BM + wr * 64 + fr, col0 = u.pn * BM + wc * 32 + 8 * fq;
#pragma unroll
        for (int ai = 0; ai < 2; ++ai)
#pragma unroll
            for (int m = 0; m < 4; ++m) { bf16_t* rowp = O + (size_t)(row0 + ai * HALF + m * 16) * ldc + col0;
#pragma unroll
                for (int bj = 0; bj < 2; ++bj) { const f32x4 v0 = acc[ai][bj][m][0], v1 = acc[ai][bj][m][1];
                    u32x4 w; w.x = cvt_pk_bf16(v0[0], v0[1]); w.y = cvt_pk_bf16(v0[2], v0[3]); w.z = cvt_pk_bf16(v1[0], v1[1]); w.w = cvt_pk_bf16(v1[2], v1[3]);
                    *(u32x4*)(rowp + bj * HALF) = w; } }
    }
};

struct EpiMerge {
    static constexpr bool PERM = true, AFTER_DRAIN = false;
    const bf16_t* U; int ldu, gcol0; float* Mf; bf16_t* Mb; int npm;
    __device__ __forceinline__ void operator()(const f32x4 (&acc)[2][2][4][2], const Unit& u, int wr, int wc, int fr, int fq) const {
        const int br = u.pm / npm, pm = u.pm - br * npm, pn = u.pn & 3;
        const int row0 = pm * BM + wr * 64 + fr, col0 = pn * BM + wc * 32 + 8 * fq;
#pragma unroll
        for (int ai = 0; ai < 2; ++ai)
#pragma unroll
            for (int m = 0; m < 4; ++m) { const size_t row = (size_t)(row0 + ai * HALF + m * 16);
#pragma unroll
                for (int bj = 0; bj < 2; ++bj) { const int col = col0 + bj * HALF;
                    const u32x4 g = *(const u32x4*)(U + row * ldu + gcol0 + br * 1024 + col);
                    f32x4 v0 = acc[ai][bj][m][0], v1 = acc[ai][bj][m][1];
                    v0[0] *= sigm_(bflo_(g.x)); v0[1] *= sigm_(bfhi_(g.x)); v0[2] *= sigm_(bflo_(g.y)); v0[3] *= sigm_(bfhi_(g.y));
                    v1[0] *= sigm_(bflo_(g.z)); v1[1] *= sigm_(bfhi_(g.z)); v1[2] *= sigm_(bflo_(g.w)); v1[3] *= sigm_(bfhi_(g.w));
                    float* mp = Mf + row * 1024 + col;
                    if (br > 0) { v0 = v0 + *(const f32x4*)mp; v1 = v1 + *(const f32x4*)(mp + 4); }
                    if (br < 3) { *(f32x4*)mp = v0; *(f32x4*)(mp + 4) = v1; }
                    else { u32x4 w; w.x = cvt_pk_bf16(v0[0], v0[1]); w.y = cvt_pk_bf16(v0[2], v0[3]); w.z = cvt_pk_bf16(v1[0], v1[1]); w.w = cvt_pk_bf16(v1[2], v1[3]);
                        *(u32x4*)(Mb + row * 1024 + col) = w; } } }
    }
};
struct MergeOrder {
    int G, c, npm;
    __device__ __forceinline__ bool next(int i, Unit& u) const {
        const int su = (i >> 2) * G + c; if (su >= npm * 4) return false;
        const int br = i & 3; u.pm = br * npm + (su >> 2); u.pn = br * 4 + (su & 3); return true; }
    __device__ __forceinline__ void a_ready(const Unit&) const {}
    __device__ __forceinline__ void done(const Unit&) const {}
};

struct EpiResid {
    static constexpr bool PERM = false, AFTER_DRAIN = false;
    float* X; const float* gt;
    __device__ __forceinline__ void operator()(const f32x4 (&acc)[2][2][4][2], const Unit& u, int wr, int wc, int fr, int fq) const {
        const int row0 = u.pm * BM + wr * 64 + fr, col0 = u.pn * BM + wc * 32 + 4 * fq;
        const int mr = u.pm < 64 ? (u.pm >> 4) : 4;
        f32x4 gv[2][2];
#pragma unroll
        for (int bj = 0; bj < 2; ++bj)
#pragma unroll
            for (int n = 0; n < 2; ++n) gv[bj][n] = *(const f32x4*)(gt + (size_t)mr * 6144 + col0 + bj * HALF + n * 16);
#pragma unroll
        for (int ai = 0; ai < 2; ++ai)
#pragma unroll
            for (int m = 0; m < 4; ++m) { float* rowp = X + (size_t)(row0 + ai * HALF + m * 16) * 1024 + col0;
#pragma unroll
                for (int bj = 0; bj < 2; ++bj)
#pragma unroll
                    for (int n = 0; n < 2; ++n) { float* p = rowp + bj * HALF + n * 16; *(f32x4*)p = *(const f32x4*)p + gv[bj][n] * acc[ai][bj][m][n]; } }
    }
};

struct MoeOrder {
    const PG8_LAS int* tpre; int G, c, ncol;
    __device__ __forceinline__ bool next(int i, Unit& u) const {
        const int L = i * G + c, tau = L / ncol; if (tau >= tpre[32]) return false;
        int e = 0;
#pragma unroll 1
        while (tpre[e + 1] <= tau) ++e;
        u.pm = tau; u.pn = e * ncol + (L - tau * ncol); return true; }
    __device__ __forceinline__ void a_ready(const Unit&) const {}
    __device__ __forceinline__ void done(const Unit&) const {}
};
struct EpiSwiglu {
    static constexpr bool PERM = true, AFTER_DRAIN = false;
    bf16_t* ACT; const float* bgu;
    __device__ __forceinline__ void operator()(const f32x4 (&acc)[2][2][4][2], const Unit& u, int wr, int wc, int fr, int fq) const {
        const int e = u.pn >> 3, pnl = u.pn & 7;
        const int row0 = u.pm * BM + wr * 64 + fr, cl = 128 * pnl + wc * 32 + 8 * fq;
        const float* bg = bgu + (size_t)e * 2048 + cl;
        const f32x4 bg0 = *(const f32x4*)bg, bg1 = *(const f32x4*)(bg + 4), bu0 = *(const f32x4*)(bg + 1024), bu1 = *(const f32x4*)(bg + 1028);
#pragma unroll
        for (int ai = 0; ai < 2; ++ai)
#pragma unroll
            for (int m = 0; m < 4; ++m) {
                f32x4 g0 = acc[ai][0][m][0] + bg0, g1 = acc[ai][0][m][1] + bg1, u0 = acc[ai][1][m][0] + bu0, u1 = acc[ai][1][m][1] + bu1;
                float o[8];
#pragma unroll
                for (int j = 0; j < 4; ++j) { const float g = fminf(g0[j], 7.f), up = fminf(fmaxf(u0[j], -7.f), 7.f); o[j] = (up + 1.f) * g * sigm_(1.702f * g); }
#pragma unroll
                for (int j = 0; j < 4; ++j) { const float g = fminf(g1[j], 7.f), up = fminf(fmaxf(u1[j], -7.f), 7.f); o[4 + j] = (up + 1.f) * g * sigm_(1.702f * g); }
                u32x4 w; w.x = cvt_pk_bf16(o[0], o[1]); w.y = cvt_pk_bf16(o[2], o[3]); w.z = cvt_pk_bf16(o[4], o[5]); w.w = cvt_pk_bf16(o[6], o[7]);
                *(u32x4*)(ACT + (size_t)(row0 + ai * HALF + m * 16) * 1024 + cl) = w; }
    }
};
struct EpiDown {
    static constexpr bool PERM = true, AFTER_DRAIN = false;
    bf16_t* YS; const float* bdn;
    __device__ __forceinline__ void operator()(const f32x4 (&acc)[2][2][4][2], const Unit& u, int wr, int wc, int fr, int fq) const {
        const int e = u.pn >> 2, pnl = u.pn & 3;
        const int row0 = u.pm * BM + wr * 64 + fr, col0 = pnl * BM + wc * 32 + 8 * fq;
        f32x4 bv[2][2];
#pragma unroll
        for (int bj = 0; bj < 2; ++bj)
#pragma unroll
            for (int n = 0; n < 2; ++n) bv[bj][n] = *(const f32x4*)(bdn + (size_t)e * 1024 + col0 + bj * HALF + 4 * n);
#pragma unroll
        for (int ai = 0; ai < 2; ++ai)
#pragma unroll
            for (int m = 0; m < 4; ++m) { bf16_t* rowp = YS + (size_t)(row0 + ai * HALF + m * 16) * 1024 + col0;
#pragma unroll
                for (int bj = 0; bj < 2; ++bj) { const f32x4 v0 = acc[ai][bj][m][0] + bv[bj][0], v1 = acc[ai][bj][m][1] + bv[bj][1];
                    u32x4 w; w.x = cvt_pk_bf16(v0[0], v0[1]); w.y = cvt_pk_bf16(v0[2], v0[3]); w.z = cvt_pk_bf16(v1[0], v1[1]); w.w = cvt_pk_bf16(v1[2], v1[3]);
                    *(u32x4*)(rowp + bj * HALF) = w; } }
    }
};
}
#define XB_TMO      128
#define XB_XCNT(j)  (256  + 64 * (j))
#define XB_XSUB(j)  (1280 + 64 * (j))
#define XB_XGEN(j)  (2304 + 64 * (j))
#define XB_TOP      3328
#define XB_TOPGEN   3392
#define XCD_BAR_WORDS 3456
#define XB_SPIN_CAP (1u << 18)
#define LAS __attribute__((address_space(3)))

__device__ __forceinline__ unsigned xb_ld(unsigned* p)              { return __hip_atomic_load(p, __ATOMIC_RELAXED, __HIP_MEMORY_SCOPE_AGENT); }
__device__ __forceinline__ unsigned xb_add(unsigned* p, unsigned v) { return __hip_atomic_fetch_add(p, v, __ATOMIC_RELAXED, __HIP_MEMORY_SCOPE_AGENT); }
__device__ __forceinline__ unsigned xb_xcc_id() { return (unsigned)__builtin_amdgcn_s_getreg((3 << 11) | 20) & 0xFu; }
#define XB_SPIN(cond, bar) do { unsigned _sp = 0; while (cond) { __builtin_amdgcn_s_sleep(1); \
    if ((++_sp & 255u) == 0u) { if (xb_ld(&(bar)[XB_TMO])) break; if (_sp > XB_SPIN_CAP) { atomicAdd(&(bar)[XB_TMO], 1u); break; } } } } while (0)

struct XcdBarrier {
    unsigned* bar; unsigned x;
    volatile LAS unsigned* st;
};

__device__ __forceinline__ XcdBarrier xcd_barrier_post(unsigned* bar, volatile LAS unsigned* st) {
    XcdBarrier b; b.bar = bar; b.x = xb_xcc_id(); b.st = st;
    if (threadIdx.x == 0) (void)xb_add(&bar[XB_XCNT(b.x)], 1u);
    return b;
}
__device__ __forceinline__ void xcd_barrier_complete(unsigned* bar, unsigned x, unsigned& nloc, unsigned& nx) {
    const unsigned G = gridDim.x * gridDim.y * gridDim.z;
    unsigned sum, cnt, mine, sp = 0u;
    for (;;) {
        sum = 0u; cnt = 0u; mine = 0u;
#pragma unroll
        for (unsigned j = 0; j < 16; ++j) { const unsigned c = xb_ld(&bar[XB_XCNT(j)]); sum += c; cnt += (c > 0u) ? 1u : 0u; mine = (j == x) ? c : mine; }
        if (sum == G) break;
        __builtin_amdgcn_s_sleep(1);
        if ((++sp & 255u) == 0u) { if (xb_ld(&bar[XB_TMO])) break; if (sp > XB_SPIN_CAP) { atomicAdd(&bar[XB_TMO], 1u); break; } }
    }
    nloc = mine > 0u ? mine : 1u; nx = cnt > 0u ? cnt : 1u;
}

__device__ __forceinline__ void xcd_barrier(const XcdBarrier& b) {
    asm volatile("s_waitcnt vmcnt(0)" ::: "memory");
    __syncthreads();
    if (threadIdx.x == 0) {
        unsigned* bar = b.bar;
        __builtin_amdgcn_s_waitcnt(0);
        unsigned nloc = b.st[0], nx = b.st[1];
        if (nloc == 0u) { xcd_barrier_complete(bar, b.x, nloc, nx); b.st[0] = nloc; b.st[1] = nx; }
        const unsigned old = xb_add(&bar[XB_XSUB(b.x)], 1u);
        const unsigned gen = old / nloc;
        if (old + 1u == (gen + 1u) * nloc) {
            __builtin_amdgcn_fence(__ATOMIC_RELEASE, "agent");
            asm volatile("s_waitcnt vmcnt(0)" ::: "memory");
            const unsigned og = xb_add(&bar[XB_TOP], 1u);
            const unsigned tg = og / nx;
            if (og + 1u == (tg + 1u) * nx) xb_add(&bar[XB_TOPGEN], 1u);
            else XB_SPIN(xb_ld(&bar[XB_TOPGEN]) == tg, bar);
            __builtin_amdgcn_fence(__ATOMIC_ACQUIRE, "agent");
            xb_add(&bar[XB_XGEN(b.x)], 1u);
            asm volatile("s_waitcnt vmcnt(0)" ::: "memory");
        } else {
            XB_SPIN(xb_ld(&bar[XB_XGEN(b.x)]) == gen, bar);
            __builtin_amdgcn_fence(__ATOMIC_ACQUIRE, "agent");
            asm volatile("s_waitcnt vmcnt(0)" ::: "memory");
        }
    }
    __syncthreads();
}

struct Frame {
    LAS unsigned char* lds;
    unsigned* ctl;
    int tid, lane, wave, G, bid;
    const float* const* in; const float* const* in0;
    float* out;
    unsigned char* ws; unsigned char* ws0;
};
#define WSP(T, off) ((T*)(F.ws + (off)))
#define REFRESH_TID(F) do { int t_ = threadIdx.x; asm volatile("" : "+v"(t_)); F.tid = t_; F.lane = t_ & 63; \
    int z_ = 0; asm volatile("s_mov_b32 %0, 0" : "=s"(z_)); F.ws = F.ws0 + z_; F.in = F.in0 + z_; F.bid = (int)blockIdx.x + z_; } while (0)
#define I_X 0
#define I_C 1
#define I_CTX 2
#define I_CCTX 3
#define I_WMOD 4
#define I_BMOD 5
#define I_G1 6
#define I_G2 7
#define I_WIN 8
#define I_AGQ 9
#define I_AGK 10
#define I_BCW 11
#define I_BCB 12
#define I_BLAM 13
#define I_BWR 14
#define I_BBR 15
#define I_BWI 16
#define I_BBI 17
#define I_CCW 18
#define I_CALOG 19
#define I_CDTB 20
#define I_CGOUT 21
#define I_RPB 22
#define I_WBR 23
#define I_WOUT 24
#define I_WRT 25
#define I_BRT 26
#define I_WGU 27
#define I_BGU 28
#define I_WDN 29
#define I_BDN 30
#define I_GFIN 31

__device__ __forceinline__ int mod_row(int r) { return r < TLAT ? (r >> 12) : 4; }

__device__ __forceinline__ void p0_transpose_item(const float* W, size_t pitch, int K, bf16* WT, int drow0, int scol0, int k0, LAS float* scr, int lane) {
    float v[32];
#pragma unroll
    for (int i = 0; i < 32; ++i) { const int kk = 2 * i + (lane >> 5); v[i] = W[(size_t)(k0 + kk) * pitch + scol0 + (lane & 31)]; }
#pragma unroll
    for (int i = 0; i < 32; ++i) { const int kk = 2 * i + (lane >> 5); scr[kk * 33 + (lane & 31)] = v[i]; }
    asm volatile("s_waitcnt lgkmcnt(0)" ::: "memory");
    const int c = lane & 7;
#pragma unroll
    for (int j = 0; j < 4; ++j) { const int n = (lane >> 3) + 8 * j; const LAS float* s = scr + (8 * c) * 33 + n;
        v4u o; o.x = pk2(s[0 * 33], s[1 * 33]); o.y = pk2(s[2 * 33], s[3 * 33]); o.z = pk2(s[4 * 33], s[5 * 33]); o.w = pk2(s[6 * 33], s[7 * 33]);
        *(v4u*)(WT + (size_t)(drow0 + n) * K + k0 + 8 * c) = o; }
    asm volatile("s_waitcnt lgkmcnt(0)" ::: "memory");
}

__device__ __forceinline__ void p0_prologue(Frame& F) {
    LAS float* scr = (LAS float*)(F.lds + F.wave * 16384);
    const int gw = F.bid * NWAVES + F.wave, NGW = F.G * NWAVES;
    constexpr int I_IN = DEPTH * 16 * (UW / 32);
    constexpr int I_BR = DEPTH * 4 * 8 * 32;
    constexpr int I_OUT = DEPTH * 16 * 32;
    constexpr int I_GU = DEPTH * NEXP * 16 * 64;
    constexpr int I_DN = DEPTH * NEXP * 16 * 32;
    constexpr int NITEMS = I_IN + I_BR + I_OUT + I_GU + I_DN;
    for (int it = gw; it < NITEMS; it += NGW) {
        int r = it;
        if (r < I_IN) { const int l = r / (16 * 296), q = r % (16 * 296), kb = q / 296, nb = q % 296; const int n0 = nb * 32, sc = n0 < 3840 ? n0 : n0 + 16;
            p0_transpose_item(F.in[I_WIN] + (size_t)l * D * INW, INW, D, WSP(bf16, WS_WIN) + (size_t)l * UW * D, n0, sc, kb * 64, scr, F.lane); continue; }
        r -= I_IN;
        if (r < I_BR) { const int mi = r / 256, q = r % 256, kb = q / 32, nb = q % 32;
            p0_transpose_item(F.in[I_WBR] + (size_t)mi * 512 * 1024, 1024, 512, WSP(bf16, WS_WBR) + (size_t)mi * 1024 * 512, nb * 32, nb * 32, kb * 64, scr, F.lane); continue; }
        r -= I_BR;
        if (r < I_OUT) { const int l = r / 512, q = r % 512, kb = q / 32, nb = q % 32;
            p0_transpose_item(F.in[I_WOUT] + (size_t)l * D * D, D, D, WSP(bf16, WS_WOUT) + (size_t)l * D * D, nb * 32, nb * 32, kb * 64, scr, F.lane); continue; }
        r -= I_OUT;
        if (r < I_GU) { const int mi = r / 1024, q = r % 1024, kb = q / 64, nb = q % 64; const int j0 = nb * 32, pn = j0 >> 8, bj = (j0 >> 7) & 1, cc = j0 & 127;
            p0_transpose_item(F.in[I_WGU] + (size_t)mi * D * 2048, 2048, D, WSP(bf16, WS_WGU) + (size_t)mi * 2048 * D, j0, 1024 * bj + 128 * pn + cc, kb * 64, scr, F.lane); continue; }
        r -= I_GU;
        { const int mi = r / 512, q = r % 512, kb = q / 32, nb = q % 32;
            p0_transpose_item(F.in[I_WDN] + (size_t)mi * D * D, D, D, WSP(bf16, WS_WDN) + (size_t)mi * D * D, nb * 32, nb * 32, kb * 64, scr, F.lane); }
    }
    __syncthreads();
    {
        LAS float* sc = (LAS float*)F.lds;
        LAS float* part = sc + 5 * 1024;
        bool staged = false;
        for (int it = F.bid; it < DEPTH * 96; it += F.G) {
            if (!staged) {
                for (int i = F.tid; i < 5 * 1024; i += NT) { const int r = i >> 10, k = i & 1023; const float cv = r < 4 ? F.in[I_C][r * 1024 + k] : F.in[I_CCTX][k]; sc[i] = siluf_(cv); }
                __syncthreads(); staged = true;
            }
            const int l = it / 96, cg = it % 96, col = cg * 64 + F.lane;
            const float* wm = F.in[I_WMOD] + (size_t)l * D * 6144 + col;
            float a0 = 0.f, a1 = 0.f, a2 = 0.f, a3 = 0.f, a4 = 0.f;
            const int kb = F.wave * 128;
#pragma unroll 16
            for (int k = 0; k < 128; ++k) { const float w = wm[(size_t)(kb + k) * 6144];
                a0 += sc[kb + k] * w; a1 += sc[1024 + kb + k] * w; a2 += sc[2048 + kb + k] * w; a3 += sc[3072 + kb + k] * w; a4 += sc[4096 + kb + k] * w; }
            LAS float* pp = part + F.wave * 320 + F.lane;
            pp[0] = a0; pp[64] = a1; pp[128] = a2; pp[192] = a3; pp[256] = a4;
            __syncthreads();
            if (F.tid < 320) { const int r = F.tid >> 6, ln = F.tid & 63; float s = 0.f;
#pragma unroll
                for (int w = 0; w < 8; ++w) s += part[w * 320 + r * 64 + ln];
                const int cc = cg * 64 + ln;
                WSP(float, WS_MOD)[((size_t)l * 5 + r) * 6144 + cc] = s + F.in[I_BMOD][l * 6144 + cc]; }
            __syncthreads();
        }
    }
    if (F.bid == 0) {
        for (int i = F.tid; i < 1024; i += NT) { const int p = i >> 4, f = i & 15; const float inv = powf(10000.f, -(float)f / 16.f); const float ang = (float)p * inv;
            WSP(float, WS_ROPE)[i] = cosf(ang); WSP(float, WS_ROPE)[1024 + i] = sinf(ang); }
    }
    for (int i = F.bid * NT + F.tid; i < DEPTH * 2 * 2 * 8 * 4096; i += F.G * NT) {
        const int c = i & 63, d = (i >> 6) & 63, n = (i >> 12) & 7, gate = (i >> 15) & 1, ld = i >> 16;
        const float* src = gate ? F.in[I_BWI] : F.in[I_BWR];
        WSP(bf16, WS_LRUW)[i] = (bf16)f2bf(src[((size_t)ld * 8 + n) * 4096 + c * 64 + d]);
    }
}

template <int MODE>
__device__ __forceinline__ void norm_phase(Frame& F, int l) {
    LAS float* hs = (LAS float*)F.lds;
    LAS int* lcnt = (LAS int*)(F.lds + 65536);
    LAS int* lbase = lcnt + 32;
    const int ngroups = (MODE == 2 ? TLAT : MROWS) / 16;
    const float* modl = WSP(float, WS_MOD) + (size_t)l * 5 * 6144;
    for (int gi = F.bid; gi < ngroups; gi += F.G) {
        REFRESH_TID(F);
        if (MODE == 1) { if (F.tid < 32) lcnt[F.tid] = 0; }
#pragma unroll
        for (int i = 0; i < 2; ++i) {
            const int lr = 2 * F.wave + i, r = gi * 16 + lr, mr = mod_row(r);
            const float* xsrc;
            if (MODE == 0 && l == 0) xsrc = r < TLAT ? F.in[I_X] + (size_t)r * D : F.in[I_CTX] + (size_t)(r - TLAT) * D;
            else xsrc = WSP(float, WS_X) + (size_t)r * D;
            f32x4 v[4];
#pragma unroll
            for (int j = 0; j < 4; ++j) v[j] = *(const f32x4*)(xsrc + 4 * F.lane + 256 * j);
            if ((MODE == 0 && l > 0) || MODE == 2) {
                const int lp = MODE == 2 ? DEPTH - 1 : l - 1;
                const float* gt2 = WSP(float, WS_MOD) + ((size_t)lp * 5 + mr) * 6144 + 5120;
                f32x4 cb[4];
#pragma unroll
                for (int j = 0; j < 4; ++j) cb[j] = (f32x4){0.f, 0.f, 0.f, 0.f};
#pragma unroll
                for (int k = 0; k < 4; ++k) {
                    const int sr = WSP(int, WS_SROW)[r * 4 + k]; const float w = WSP(float, WS_SW)[r * 4 + k];
                    const bf16* yr = WSP(bf16, WS_YS) + (size_t)sr * D;
#pragma unroll
                    for (int j = 0; j < 4; ++j) { const v2u y = *(const v2u*)(yr + 4 * F.lane + 256 * j);
                        cb[j].x += w * bflo(y.x); cb[j].y += w * bfhi(y.x); cb[j].z += w * bflo(y.y); cb[j].w += w * bfhi(y.y); }
                }
#pragma unroll
                for (int j = 0; j < 4; ++j) { const f32x4 g = *(const f32x4*)(gt2 + 4 * F.lane + 256 * j); v[j] = v[j] + g * cb[j]; }
            }
            if (MODE == 0) {
#pragma unroll
                for (int j = 0; j < 4; ++j) *(f32x4*)(WSP(float, WS_X) + (size_t)r * D + 4 * F.lane + 256 * j) = v[j];
            }
            float ss = 0.f;
#pragma unroll
            for (int j = 0; j < 4; ++j) ss += (v[j].x * v[j].x + v[j].y * v[j].y) + (v[j].z * v[j].z + v[j].w * v[j].w);
            const float rstd = rsqrtf(wave_sum(ss) * (1.f / D) + EPS);
            if (MODE == 2) {
#pragma unroll
                for (int j = 0; j < 4; ++j) { const f32x4 g = *(const f32x4*)(F.in[I_GFIN] + 4 * F.lane + 256 * j);
                    *(f32x4*)(F.out + (size_t)r * D + 4 * F.lane + 256 * j) = v[j] * rstd * g; }
            } else {
                const float* gn = F.in[MODE == 0 ? I_G1 : I_G2] + l * D;
                const float* sh = modl + (size_t)mr * 6144 + (MODE == 0 ? 0 : 3072);
                const float* sc = sh + 1024;
#pragma unroll
                for (int j = 0; j < 4; ++j) { const int c0 = 4 * F.lane + 256 * j;
                    const f32x4 g = *(const f32x4*)(gn + c0), a = *(const f32x4*)(sh + c0), s = *(const f32x4*)(sc + c0);
                    const f32x4 h = (v[j] * rstd * g) * (s + 1.f) + a;
                    *(LAS f32x4*)(hs + lr * 1024 + c0) = h;
                    v2u o; o.x = pk2(h.x, h.y); o.y = pk2(h.z, h.w);
                    *(v2u*)(WSP(bf16, WS_H) + (size_t)r * D + c0) = o; }
            }
        }
        if (MODE == 2) continue;
        __syncthreads();
        if (MODE == 0) {
            if (F.tid < 256) {
                const int lr = F.tid >> 4, col = F.tid & 15;
                const float* w = F.in[I_WIN] + (size_t)l * D * INW + 3840 + col;
                const LAS float* hr = hs + lr * 1024;
                float a0 = 0.f, a1 = 0.f, a2 = 0.f, a3 = 0.f;
#pragma unroll 4
                for (int k = 0; k < 1024; k += 4) { const f32x4 h = *(const LAS f32x4*)(hr + k);
                    a0 += h.x * w[(size_t)k * INW]; a1 += h.y * w[(size_t)(k + 1) * INW]; a2 += h.z * w[(size_t)(k + 2) * INW]; a3 += h.w * w[(size_t)(k + 3) * INW]; }
                WSP(float, WS_CAB)[(size_t)(gi * 16 + lr) * 16 + col] = (a0 + a1) + (a2 + a3);
            }
        } else {
            const int lr = F.tid >> 5, e = F.tid & 31, r = gi * 16 + lr;
            const float* w = F.in[I_WRT] + (size_t)l * D * NEXP + e;
            const LAS float* hr = hs + lr * 1024;
            float a0 = 0.f, a1 = 0.f, a2 = 0.f, a3 = 0.f;
#pragma unroll 4
            for (int k = 0; k < 1024; k += 4) { const f32x4 h = *(const LAS f32x4*)(hr + k);
                a0 += h.x * w[(k) * NEXP]; a1 += h.y * w[(k + 1) * NEXP]; a2 += h.z * w[(k + 2) * NEXP]; a3 += h.w * w[(k + 3) * NEXP]; }
            const float lg = ((a0 + a1) + (a2 + a3)) + F.in[I_BRT][l * NEXP + e];
            float tv0, tv1, tv2, tv3; int ti0, ti1, ti2, ti3; bool taken = false;
#define TOP1(TV, TI) do { float bv = taken ? -INFINITY : lg; int bi = e; \
                _Pragma("unroll") for (int off = 16; off >= 1; off >>= 1) { const float ov = __shfl_xor(bv, off); const int oi = __shfl_xor(bi, off); \
                    if (ov > bv || (ov == bv && oi < bi)) { bv = ov; bi = oi; } } \
                TV = bv; TI = bi; if (bi == e) taken = true; } while (0)
            TOP1(tv0, ti0); TOP1(tv1, ti1); TOP1(tv2, ti2); TOP1(tv3, ti3);
#undef TOP1
            const float e1 = __expf(tv1 - tv0), e2 = __expf(tv2 - tv0), e3 = __expf(tv3 - tv0);
            const float inv = 1.f / (1.f + e1 + e2 + e3);
            const int my_e = e == 0 ? ti0 : (e == 1 ? ti1 : (e == 2 ? ti2 : ti3));
            const float my_w = e == 0 ? inv : (e == 1 ? e1 * inv : (e == 2 ? e2 * inv : e3 * inv));
            int pl = 0;
            if (e < 4) pl = atomicAdd((int*)&lcnt[my_e], 1);
            __syncthreads();
            if (F.tid < 32) { const int c = lcnt[F.tid]; lbase[F.tid] = c > 0 ? (int)__hip_atomic_fetch_add(F.ctl + CW_CNT + l * 32 + F.tid, (unsigned)c, __ATOMIC_RELAXED, __HIP_MEMORY_SCOPE_AGENT) : 0; }
            __syncthreads();
            if (e < 4) { const int p = lbase[my_e] + pl;
                WSP(int, WS_LIST)[(size_t)my_e * MROWS + p] = r * 4 + e;
                WSP(int, WS_SEP)[r * 4 + e] = (my_e << 20) | p;
                WSP(float, WS_SW)[r * 4 + e] = my_w; }
        }
        __syncthreads();
    }
}

__device__ __forceinline__ void moe_table(Frame& F, int l) {
    LAS int* tpre = (LAS int*)(F.lds + MISC_OFF + 256);
    LAS int* cnt = tpre + 40;
    __syncthreads();
    if (F.tid < 32) cnt[F.tid] = (int)__hip_atomic_load(F.ctl + CW_CNT + l * 32 + F.tid, __ATOMIC_RELAXED, __HIP_MEMORY_SCOPE_AGENT);
    __syncthreads();
    if (F.tid == 0) { int s = 0; for (int e = 0; e < 32; ++e) { tpre[e] = s; s += (cnt[e] + 255) >> 8; } tpre[32] = s; }
    __syncthreads();
}
__device__ __forceinline__ void moe_gather(Frame& F, int l) {
    moe_table(F, l);
    const LAS int* tpre = (const LAS int*)(F.lds + MISC_OFF + 256);
    const LAS int* cnt = tpre + 40;
    const int gw = F.bid * NWAVES + F.wave, NGW = F.G * NWAVES;
    REFRESH_TID(F);
    for (int e = 0; e < NEXP; ++e) {
        const int n = cnt[e], base = tpre[e] * 256;
        for (int p = gw; p < n; p += NGW) {
            const int tk = WSP(int, WS_LIST)[(size_t)e * MROWS + p]; const int tok = tk >> 2;
            const v4u* src = (const v4u*)(WSP(bf16, WS_H) + (size_t)tok * D);
            v4u* dst = (v4u*)(WSP(bf16, WS_HS) + (size_t)(base + p) * D);
            dst[F.lane] = src[F.lane]; dst[F.lane + 64] = src[F.lane + 64];
            if (F.lane == 0) WSP(int, WS_SROW)[tk] = base + p;
        }
    }
}

constexpr int AT_KP = 72, AT_VP = 68;
constexpr int AT_KB = 64 * AT_KP * 2, AT_VB = 64 * AT_VP * 2, AT_BUF = AT_KB + AT_VB;
constexpr int AT_RPB = 2 * AT_BUF;

struct AttnUnit {
    int kind;
    int b, hx, qx;
};

__device__ __forceinline__ void attn_unit(Frame& F, int l, const AttnUnit un) {
    REFRESH_TID(F);
    const int lane = F.lane, w = F.wave, q32 = lane & 31, hh = lane >> 5;
    const bf16* U = WSP(bf16, WS_U);
    const bool na = (un.kind & 1) != 0, ctxq = un.kind >= 2;
    const int b = un.b;
    int qrow0, qcol, kcol, ycol, nlat, krow_lat0, r_grid = 0, c0 = 0, rs_w = 0;
    const bf16* vt; bf16* Y;
    if (!na) {
        const int head = 4 * un.hx + (w & 3);
        qrow0 = (ctxq ? TLAT + b * LCTX : b * SEQ) + 64 * un.qx + 32 * (w >> 2);
        qcol = UQ + head * 64; kcol = UK + un.hx * 64; ycol = head * 64;
        vt = WSP(bf16, WS_VAT) + (size_t)(b * 2 + un.hx) * 64 * KEYS;
        Y = WSP(bf16, WS_Y);
        nlat = ctxq ? 0 : 64; krow_lat0 = b * SEQ;
    } else {
        const int head = un.hx;
        if (ctxq) { qrow0 = TLAT + b * LCTX + 32 * w; nlat = 0; krow_lat0 = 0; }
        else {
            r_grid = 4 * un.qx + (w >> 1); c0 = 32 * (w & 1);
            qrow0 = b * SEQ + 64 * r_grid + c0;
            int rs_min = 4 * un.qx - 4; rs_min = rs_min < 0 ? 0 : (rs_min > 56 ? 56 : rs_min);
            int rs_max = 4 * un.qx + 3 - 4; rs_max = rs_max < 0 ? 0 : (rs_max > 56 ? 56 : rs_max);
            nlat = rs_max + 8 - rs_min; krow_lat0 = b * SEQ + 64 * rs_min;
            rs_w = r_grid - 4; rs_w = rs_w < 0 ? 0 : (rs_w > 56 ? 56 : rs_w);
            rs_w -= rs_min;
        }
        qcol = UDQ + head * 64; kcol = UDK + head * 64; ycol = head * 64;
        vt = WSP(bf16, WS_VDT) + (size_t)(b * 8 + head) * 64 * KEYS;
        Y = WSP(bf16, WS_Y) + (size_t)3 * MROWS * 512;
    }
    const int vkey_lat0 = krow_lat0 - b * SEQ;
    const int ntile = nlat + 4;
    LAS unsigned char* lds = F.lds;
    if (na && !ctxq) {
        LAS float* rp = (LAS float*)(lds + AT_RPB);
        const float* src = F.in[I_RPB] + ((size_t)l * 8 + un.hx) * 465;
        for (int i = F.tid; i < 465; i += NT) rp[i] = src[i] * LOG2E;
    }
    bf16x8 qf[4];
    {
        const bf16* qp = U + (size_t)(qrow0 + q32) * UW + qcol + 8 * hh;
#pragma unroll
        for (int s = 0; s < 4; ++s) qf[s] = *(const bf16x8*)(qp + 16 * s);
    }
    const int lk = F.tid >> 3, lc = F.tid & 7;
    v4u kreg, vreg;
#define AT_LOAD(i) do { const int i_ = (i); int krow0_, vkey0_; \
        if (i_ < nlat) { krow0_ = krow_lat0 + 64 * i_; vkey0_ = vkey_lat0 + 64 * i_; } else { krow0_ = TLAT + b * LCTX + 64 * (i_ - nlat); vkey0_ = SEQ + 64 * (i_ - nlat); } \
        kreg = *(const v4u*)(U + (size_t)(krow0_ + lk) * UW + kcol + lc * 8); \
        vreg = *(const v4u*)(vt + (size_t)lk * KEYS + vkey0_ + lc * 8); } while (0)
#define AT_STORE(buf) do { LAS unsigned char* b_ = lds + (buf) * AT_BUF; \
        *(LAS v4u*)(b_ + lk * (AT_KP * 2) + lc * 16) = kreg; \
        *(LAS v2u*)(b_ + AT_KB + lk * (AT_VP * 2) + lc * 16) = (v2u){vreg.x, vreg.y}; \
        *(LAS v2u*)(b_ + AT_KB + lk * (AT_VP * 2) + lc * 16 + 8) = (v2u){vreg.z, vreg.w}; } while (0)
    float m_run = -1e30f, l_run = 0.f;
    f32x16 o0, o1;
#pragma unroll
    for (int i = 0; i < 16; ++i) { o0[i] = 0.f; o1[i] = 0.f; }
    const float sscale = 0.125f * LOG2E;
    const int cq = c0 + q32;
    int cst = cq - 8; cst = cst < 0 ? 0 : (cst > 48 ? 48 : cst);
    AT_LOAD(0);
    for (int i = 0; i < ntile; ++i) {
        AT_STORE(i & 1);
        if (i + 1 < ntile) AT_LOAD(i + 1);
        __syncthreads();
        const bool lat_na = na && !ctxq && i < nlat;
        if (lat_na && (i < rs_w || i > rs_w + 7)) continue;
        const LAS unsigned char* kb = lds + (i & 1) * AT_BUF;
        const LAS unsigned char* vb = kb + AT_KB;
        f32x16 s0, s1;
#pragma unroll
        for (int j = 0; j < 16; ++j) { s0[j] = 0.f; s1[j] = 0.f; }
#pragma unroll
        for (int s = 0; s < 4; ++s) {
            const bf16x8 k0 = *(const LAS bf16x8*)(kb + (q32) * (AT_KP * 2) + (16 * s + 8 * hh) * 2);
            const bf16x8 k1 = *(const LAS bf16x8*)(kb + (32 + q32) * (AT_KP * 2) + (16 * s + 8 * hh) * 2);
            s0 = __builtin_amdgcn_mfma_f32_32x32x16_bf16(k0, qf[s], s0, 0, 0, 0);
            s1 = __builtin_amdgcn_mfma_f32_32x32x16_bf16(k1, qf[s], s1, 0, 0, 0);
        }
        if (lat_na) {
            const LAS float* rp = (const LAS float*)(lds + AT_RPB);
            const int kr = (krow_lat0 - b * SEQ) / 64 + i;
            const int rb = (kr - r_grid + 7) * 31 + 15 - cq;
#pragma unroll
            for (int j = 0; j < 16; ++j) {
                const int kc0 = (j & 3) + 8 * (j >> 2) + 4 * hh, kc1 = kc0 + 32;
                const bool ok0 = kc0 >= cst && kc0 < cst + 16, ok1 = kc1 >= cst && kc1 < cst + 16;
                s0[j] = ok0 ? s0[j] * sscale + rp[ok0 ? rb + kc0 : 0] : -1e30f;
                s1[j] = ok1 ? s1[j] * sscale + rp[ok1 ? rb + kc1 : 0] : -1e30f;
            }
        } else {
#pragma unroll
            for (int j = 0; j < 16; ++j) { s0[j] *= sscale; s1[j] *= sscale; }
        }
        float mx = s0[0];
#pragma unroll
        for (int j = 1; j < 16; ++j) mx = fmaxf(mx, s0[j]);
#pragma unroll
        for (int j = 0; j < 16; ++j) mx = fmaxf(mx, s1[j]);
        mx = fmaxf(mx, __shfl_xor(mx, 32));
        const float m_new = fmaxf(m_run, mx);
        const float alpha = exp2f(m_run - m_new);
        m_run = m_new;
        float ps = 0.f;
#pragma unroll
        for (int j = 0; j < 16; ++j) { s0[j] = exp2f(s0[j] - m_new); s1[j] = exp2f(s1[j] - m_new); ps += s0[j] + s1[j]; }
        l_run = l_run * alpha + ps;
#pragma unroll
        for (int j = 0; j < 16; ++j) { o0[j] *= alpha; o1[j] *= alpha; }
        bf16x8 pb[2][2];
#pragma unroll
        for (int s2 = 0; s2 < 2; ++s2) {
            v4u t0, t1;
            t0.x = pk2(s0[8 * s2 + 0], s0[8 * s2 + 1]); t0.y = pk2(s0[8 * s2 + 2], s0[8 * s2 + 3]); t0.z = pk2(s0[8 * s2 + 4], s0[8 * s2 + 5]); t0.w = pk2(s0[8 * s2 + 6], s0[8 * s2 + 7]);
            t1.x = pk2(s1[8 * s2 + 0], s1[8 * s2 + 1]); t1.y = pk2(s1[8 * s2 + 2], s1[8 * s2 + 3]); t1.z = pk2(s1[8 * s2 + 4], s1[8 * s2 + 5]); t1.w = pk2(s1[8 * s2 + 6], s1[8 * s2 + 7]);
            pb[0][s2] = __builtin_bit_cast(bf16x8, t0); pb[1][s2] = __builtin_bit_cast(bf16x8, t1);
        }
#pragma unroll
        for (int sub = 0; sub < 2; ++sub)
#pragma unroll
            for (int s2 = 0; s2 < 2; ++s2) {
                const int ko = (32 * sub + 16 * s2 + 4 * hh) * 2;
                const v2u a0 = *(const LAS v2u*)(vb + (q32) * (AT_VP * 2) + ko), a1 = *(const LAS v2u*)(vb + (q32) * (AT_VP * 2) + ko + 16);
                const v2u c0_ = *(const LAS v2u*)(vb + (32 + q32) * (AT_VP * 2) + ko), c1_ = *(const LAS v2u*)(vb + (32 + q32) * (AT_VP * 2) + ko + 16);
                const bf16x8 vf0 = __builtin_bit_cast(bf16x8, ((v4u){a0.x, a0.y, a1.x, a1.y}));
                const bf16x8 vf1 = __builtin_bit_cast(bf16x8, ((v4u){c0_.x, c0_.y, c1_.x, c1_.y}));
                o0 = __builtin_amdgcn_mfma_f32_32x32x16_bf16(vf0, pb[sub][s2], o0, 0, 0, 0);
                o1 = __builtin_amdgcn_mfma_f32_32x32x16_bf16(vf1, pb[sub][s2], o1, 0, 0, 0);
            }
    }
#undef AT_LOAD
#undef AT_STORE
    const float lt = l_run + __shfl_xor(l_run, 32);
    const float inv = 1.f / lt;
    bf16* yp = Y + (size_t)(qrow0 + q32) * 512 + ycol + 4 * hh;
#pragma unroll
    for (int g = 0; g < 4; ++g) {
        v2u a; a.x = pk2(o0[4 * g] * inv, o0[4 * g + 1] * inv); a.y = pk2(o0[4 * g + 2] * inv, o0[4 * g + 3] * inv);
        v2u c; c.x = pk2(o1[4 * g] * inv, o1[4 * g + 1] * inv); c.y = pk2(o1[4 * g + 2] * inv, o1[4 * g + 3] * inv);
        *(v2u*)(yp + 8 * g) = a; *(v2u*)(yp + 32 + 8 * g) = c;
    }
    __syncthreads();
}

__device__ __forceinline__ void attn_phase(Frame& F, int l) {
    for (int L = F.bid; L < 1088; L += F.G) {
        AttnUnit un;
        if (L < 512) { un.kind = 0; un.b = L >> 7; un.hx = (L >> 6) & 1; un.qx = L & 63; }
        else if (L < 1024) { const int q = L - 512; un.kind = 1; un.b = q >> 7; un.hx = (q >> 4) & 7; un.qx = q & 15; }
        else if (L < 1056) { const int q = L - 1024; un.kind = 2; un.b = q >> 3; un.hx = (q >> 2) & 1; un.qx = q & 3; }
        else { const int q = L - 1056; un.kind = 3; un.b = q >> 3; un.hx = q & 7; un.qx = 0; }
        attn_unit(F, l, un);
    }
}

__device__ __forceinline__ void qk_prep(Frame& F, int l) {
    REFRESH_TID(F);
    const int gw = F.bid * NWAVES + F.wave, NGW = F.G * NWAVES, lane = F.lane;
    bf16* U = WSP(bf16, WS_U);
    const float* tab = WSP(float, WS_ROPE);
    const float gq = F.in[I_AGQ][l * 64 + lane], gk = F.in[I_AGK][l * 64 + lane];
    for (int r = gw; r < MROWS; r += NGW) {
        const bool lat = r < TLAT;
        float cs = 1.f, sn = 0.f;
        if (lat) { const int t = r & 4095, i = lane & 31; const int idx = i < 16 ? (t >> 6) * 16 + i : (t & 63) * 16 + (i - 16); cs = tab[idx]; sn = tab[1024 + idx]; }
        bf16* up = U + (size_t)r * UW + lane;
        float xv[10];
#pragma unroll
        for (int hd = 0; hd < 10; ++hd) xv[hd] = bf2f(up[hd < 8 ? UQ + hd * 64 : UK + (hd - 8) * 64]);
#pragma unroll
        for (int hd = 0; hd < 10; ++hd) {
            const float x = xv[hd];
            const float ss = wave_sum(x * x);
            float y = x * rsqrtf(ss * (1.f / 64.f) + EPS) * (hd < 8 ? gq : gk);
            const float p = __shfl_xor(y, 32);
            if (lat) y = lane < 32 ? y * cs - p * sn : y * cs + p * sn;
            up[hd < 8 ? UQ + hd * 64 : UK + (hd - 8) * 64] = (bf16)f2bf(y);
        }
    }
}

__device__ __forceinline__ void v_transpose(Frame& F) {
    REFRESH_TID(F);
    const int gw = F.bid * NWAVES + F.wave, NGW = F.G * NWAVES, lane = F.lane;
    LAS bf16* T = (LAS bf16*)(F.lds + F.wave * 9216);
    const bf16* U = WSP(bf16, WS_U);
    for (int it = gw; it < NCHUNK * 10; it += NGW) {
        const int g = it / 10, hd = it % 10;
        int b, key0;
        if (g < 256) { b = g >> 6; key0 = (g & 63) * 64; } else { b = (g - 256) >> 2; key0 = SEQ + ((g - 256) & 3) * 64; }
        const int scol = hd < 2 ? UV + hd * 64 : UDV + (hd - 2) * 64;
        bf16* dst = hd < 2 ? WSP(bf16, WS_VAT) + (size_t)(b * 2 + hd) * 64 * KEYS : WSP(bf16, WS_VDT) + (size_t)(b * 8 + hd - 2) * 64 * KEYS;
        v4u rv[8];
#pragma unroll
        for (int i = 0; i < 8; ++i) { const int tok = 8 * i + (lane >> 3), ch = lane & 7; rv[i] = *(const v4u*)(U + (size_t)(64 * g + tok) * UW + scol + ch * 8); }
#pragma unroll
        for (int i = 0; i < 8; ++i) { const int tok = 8 * i + (lane >> 3), ch = lane & 7; const unsigned wv[4] = {rv[i].x, rv[i].y, rv[i].z, rv[i].w};
#pragma unroll
            for (int j = 0; j < 4; ++j) { T[(ch * 8 + 2 * j) * 72 + tok] = (bf16)(wv[j] & 0xffffu); T[(ch * 8 + 2 * j + 1) * 72 + tok] = (bf16)(wv[j] >> 16); } }
        asm volatile("s_waitcnt lgkmcnt(0)" ::: "memory");
#pragma unroll
        for (int i = 0; i < 8; ++i) { const int d = 8 * i + (lane >> 3), ch = lane & 7;
            const v4u o = *(const LAS v4u*)(T + d * 72 + ch * 8);
            *(v4u*)(dst + (size_t)d * KEYS + key0 + ch * 8) = o; }
        asm volatile("s_waitcnt lgkmcnt(0)" ::: "memory");
    }
}

constexpr int LR_XCB = 0, LR_WV = 17408, LR_WVB = 12288;
__device__ __forceinline__ void seq_bounds(int g, int& lo, int& hi) {
    if (g < 256) { lo = (g >> 6) * SEQ; hi = lo + SEQ; } else { lo = TLAT + ((g - 256) >> 2) * LCTX; hi = lo + LCTX; }
}
__device__ __forceinline__ void lru_stage_conv(Frame& F, int l, int g, int q) {
    LAS bf16* raw = (LAS bf16*)(F.lds + LR_WV);
    LAS bf16* xcb = (LAS bf16*)(F.lds + LR_XCB);
    const bf16* U = WSP(bf16, WS_U);
    int lo, hi; seq_bounds(g, lo, hi);
    __syncthreads();
    for (int i = F.tid; i < 67 * 16; i += NT) { const int rr = i >> 4, ch = i & 15, row = 64 * g - 1 + rr;
        v4u v = (v4u){0u, 0u, 0u, 0u};
        if (row >= lo && row < hi) v = *(const v4u*)(U + (size_t)row * UW + UBX + 128 * q + ch * 8);
        *(LAS v4u*)(raw + rr * 128 + ch * 8) = v; }
    __syncthreads();
    {
        const int ch = F.tid & 127, tg = F.tid >> 7, cabs = 128 * q + ch;
        const float* cw = F.in[I_BCW] + (size_t)l * 4 * 512 + cabs;
        const float w0 = cw[0], w1 = cw[512], w2 = cw[1024], w3 = cw[1536], bb = F.in[I_BCB][l * 512 + cabs];
        float x0 = bf2f(raw[(16 * tg) * 128 + ch]), x1 = bf2f(raw[(16 * tg + 1) * 128 + ch]), x2 = bf2f(raw[(16 * tg + 2) * 128 + ch]);
#pragma unroll
        for (int t = 0; t < 16; ++t) { const float x3 = bf2f(raw[(16 * tg + t + 3) * 128 + ch]);
            const float y = bb + w0 * x0 + w1 * x1 + w2 * x2 + w3 * x3;
            xcb[(16 * tg + t) * 136 + ch] = (bf16)f2bf(y);
            x0 = x1; x1 = x2; x2 = x3; }
    }
    __syncthreads();
}
__device__ __forceinline__ void lru_gates(Frame& F, int l, int dir, int q) {
    const int lane = F.lane, w = F.wave, r16 = lane & 15, quad = lane >> 4;
    const LAS bf16* xcb = (const LAS bf16*)(F.lds + LR_XCB);
    LAS float* sa = (LAS float*)(F.lds + LR_WV + w * LR_WVB);
    LAS float* sb = sa + 1024;
    const int nbl = w >> 2, dt = w & 3, nb = 2 * q + nbl;
    const bf16* wr = WSP(bf16, WS_LRUW) + ((((size_t)(l * 2 + dir) * 2 + 0) * 8 + nb) * 64 + 16 * dt + r16) * 64 + 8 * quad;
    const bf16* wi = WSP(bf16, WS_LRUW) + ((((size_t)(l * 2 + dir) * 2 + 1) * 8 + nb) * 64 + 16 * dt + r16) * 64 + 8 * quad;
    const bf16x8 br0 = *(const bf16x8*)wr, br1 = *(const bf16x8*)(wr + 32), bi0 = *(const bf16x8*)wi, bi1 = *(const bf16x8*)(wi + 32);
    const int cabs = 64 * nb + 16 * dt + r16, cl = 64 * nbl + 16 * dt + r16;
    const float bR = F.in[I_BBR][(l * 2 + dir) * 512 + cabs], bI = F.in[I_BBI][(l * 2 + dir) * 512 + cabs];
    const float sp = softplusf_(-F.in[I_BLAM][(l * 2 + dir) * 512 + cabs]);
#pragma unroll
    for (int tt = 0; tt < 4; ++tt) {
        const LAS bf16* ap = xcb + (16 * tt + r16) * 136 + 64 * nbl + 8 * quad;
        const bf16x8 a0 = *(const LAS bf16x8*)ap, a1 = *(const LAS bf16x8*)(ap + 32);
        f32x4 ar = (f32x4){0.f, 0.f, 0.f, 0.f}, ai = ar;
        ar = __builtin_amdgcn_mfma_f32_16x16x32_bf16(a0, br0, ar, 0, 0, 0); ar = __builtin_amdgcn_mfma_f32_16x16x32_bf16(a1, br1, ar, 0, 0, 0);
        ai = __builtin_amdgcn_mfma_f32_16x16x32_bf16(a0, bi0, ai, 0, 0, 0); ai = __builtin_amdgcn_mfma_f32_16x16x32_bf16(a1, bi1, ai, 0, 0, 0);
#pragma unroll
        for (int j = 0; j < 4; ++j) { const int t = 16 * tt + 4 * quad + j;
            const float rg = sigmoidf_(ar[j] + bR), ig = sigmoidf_(ai[j] + bI);
            const float la = -8.f * rg * sp;
            const float a = __expf(la), mult = sqrtf(-expm1f(2.f * la));
            const float xv = bf2f(xcb[t * 136 + cl]);
            sa[t * 16 + r16] = a; sb[t * 16 + r16] = mult * ig * xv; }
    }
    asm volatile("s_waitcnt lgkmcnt(0)" ::: "memory");
}
__device__ __forceinline__ void lru_pass1(Frame& F, int l) {
#pragma unroll 1
    for (int it = F.bid; it < NCHUNK * 4; it += F.G) {
        REFRESH_TID(F);
        const int g = it >> 2, q = it & 3;
        lru_stage_conv(F, l, g, q);
#pragma unroll 1
        for (int dir = 0; dir < 2; ++dir) {
            lru_gates(F, l, dir, q);
            const int lane = F.lane, w = F.wave, ch = lane & 15, seg = lane >> 4;
            const LAS float* sa = (const LAS float*)(F.lds + LR_WV + w * LR_WVB); const LAS float* sb = sa + 1024;
            float A = 1.f, B = 0.f;
#pragma unroll
            for (int k = 0; k < 16; ++k) { const int tp = 16 * seg + k, t = dir ? 63 - tp : tp; const float a = sa[t * 16 + ch]; B = a * B + sb[t * 16 + ch]; A *= a; }
            float At = 1.f, Bt = 0.f;
#pragma unroll
            for (int s = 0; s < 4; ++s) { const float As = __shfl(A, 16 * s + ch), Bs = __shfl(B, 16 * s + ch); Bt = As * Bt + Bs; At *= As; }
            if (seg == 0) { const int cabs = 128 * q + 64 * (w >> 2) + 16 * (w & 3) + ch;
                WSP(float, WS_LRA)[((size_t)g * 2 + dir) * 512 + cabs] = At; WSP(float, WS_LRB)[((size_t)g * 2 + dir) * 512 + cabs] = Bt; }
            asm volatile("s_waitcnt lgkmcnt(0)" ::: "memory");
        }
    }
}
__device__ __forceinline__ void lru_carry(Frame& F, int item) {
    REFRESH_TID(F);
    const int b = item >> 1, dir = item & 1, ch = F.tid;
    const float* LA = WSP(float, WS_LRA); const float* LB = WSP(float, WS_LRB); float* LC = WSP(float, WS_LRC);
    float h = 0.f;
    for (int s = 0; s < 68; ++s) {
        int g;
        if (s < 4) g = 256 + 4 * b + (dir ? 3 - s : s); else g = 64 * b + (dir ? 63 - (s - 4) : (s - 4));
        const size_t idx = ((size_t)g * 2 + dir) * 512 + ch;
        LC[idx] = h; h = LA[idx] * h + LB[idx];
    }
}
__device__ __forceinline__ float gelu_tanh(float x) { const float u = 0.7978845608028654f * (x + 0.044715f * x * x * x); return 0.5f * x * (1.f + tanhf(u)); }
__device__ __forceinline__ void lru_pass2(Frame& F, int l) {
#pragma unroll 1
    for (int it = F.bid; it < NCHUNK * 4; it += F.G) {
        REFRESH_TID(F);
        const int g = it >> 2, q = it & 3;
        lru_stage_conv(F, l, g, q);
        const int lane = F.lane, w = F.wave, ch = lane & 15, seg = lane >> 4;
        LAS float* sa = (LAS float*)(F.lds + LR_WV + w * LR_WVB); LAS float* sb = sa + 1024; LAS float* sh = sa + 2048;
        const int cabs = 128 * q + 64 * (w >> 2) + 16 * (w & 3) + ch;
#pragma unroll 1
        for (int dir = 0; dir < 2; ++dir) {
            lru_gates(F, l, dir, q);
            float A = 1.f, B = 0.f;
#pragma unroll
            for (int k = 0; k < 16; ++k) { const int tp = 16 * seg + k, t = dir ? 63 - tp : tp; const float a = sa[t * 16 + ch]; B = a * B + sb[t * 16 + ch]; A *= a; }
            float h = WSP(float, WS_LRC)[((size_t)g * 2 + dir) * 512 + cabs];
#pragma unroll
            for (int s = 0; s < 3; ++s) { const float As = __shfl(A, 16 * s + ch), Bs = __shfl(B, 16 * s + ch); if (s < seg) h = As * h + Bs; }
#pragma unroll
            for (int k = 0; k < 16; ++k) { const int tp = 16 * seg + k, t = dir ? 63 - tp : tp; h = sa[t * 16 + ch] * h + sb[t * 16 + ch];
                if (dir == 0) sh[t * 16 + ch] = h; else sh[t * 16 + ch] += h; }
            asm volatile("s_waitcnt lgkmcnt(0)" ::: "memory");
        }
        const bf16* U = WSP(bf16, WS_U); bf16* YB = WSP(bf16, WS_Y) + (size_t)1 * MROWS * 512;
#pragma unroll
        for (int k = 0; k < 16; ++k) { const int t = 16 * seg + k; const size_t row = (size_t)64 * g + t;
            const float yv = bf2f(U[row * UW + UBY + cabs]);
            YB[row * 512 + cabs] = (bf16)f2bf(sh[t * 16 + ch] * gelu_tanh(yv)); }
        asm volatile("s_waitcnt lgkmcnt(0)" ::: "memory");
    }
}

constexpr int GD_Q = 0, GD_K = 17408, GD_V = 34816, GD_KK = 52224, GD_QK = 68864, GD_L = 85504, GD_SM = 118272;
__device__ __forceinline__ void gdn_prep(Frame& F, int l) {
    const bf16* U = WSP(bf16, WS_U);
    const int w = F.wave;
#pragma unroll 1
    for (int it = F.bid; it < NCHUNK * 4; it += F.G) {
        int tid = F.tid; asm volatile("" : "+v"(tid));
        const int lane = tid & 63, r16 = lane & 15, quad = lane >> 4;
        const int g = it >> 2, h = it & 3;
        int lo, hi; seq_bounds(g, lo, hi);
        LAS bf16* raw = (LAS bf16*)(F.lds + GD_KK);
#pragma unroll 1
        for (int ten = 0; ten < 3; ++ten) {
            const int ucol = (ten == 0 ? UCQ : (ten == 1 ? UCK : UCV)) + 128 * h;
            __syncthreads();
            for (int i = tid; i < 67 * 16; i += NT) { const int rr = i >> 4, ch = i & 15, row = 64 * g - 1 + rr;
                v4u v = (v4u){0u, 0u, 0u, 0u};
                if (row >= lo && row < hi) v = *(const v4u*)(U + (size_t)row * UW + ucol + ch * 8);
                *(LAS v4u*)(raw + rr * 128 + ch * 8) = v; }
            __syncthreads();
            const int t = tid >> 3, ds = tid & 7;
            const float* cw = F.in[I_CCW] + (size_t)l * 4 * 1536 + ten * 512 + 128 * h + 16 * ds;
            float y[16]; float ss = 0.f;
#pragma unroll
            for (int jj = 0; jj < 16; ++jj) {
                float a = 0.f;
#pragma unroll
                for (int j = 0; j < 4; ++j) a += cw[j * 1536 + jj] * bf2f(raw[(t + j) * 128 + 16 * ds + jj]);
                a = siluf_(a); y[jj] = a; ss += a * a;
            }
            float sc = 1.f;
            if (ten < 2) { ss += __shfl_xor(ss, 1); ss += __shfl_xor(ss, 2); ss += __shfl_xor(ss, 4); sc = rsqrtf(ss + EPS); if (ten == 0) sc *= 0.08838834764831845f; }
            LAS bf16* dstp = (LAS bf16*)(F.lds + (ten == 0 ? GD_Q : (ten == 1 ? GD_K : GD_V))) + t * 136 + 16 * ds;
            v4u o0, o1;
            o0.x = pk2(y[0] * sc, y[1] * sc); o0.y = pk2(y[2] * sc, y[3] * sc); o0.z = pk2(y[4] * sc, y[5] * sc); o0.w = pk2(y[6] * sc, y[7] * sc);
            o1.x = pk2(y[8] * sc, y[9] * sc); o1.y = pk2(y[10] * sc, y[11] * sc); o1.z = pk2(y[12] * sc, y[13] * sc); o1.w = pk2(y[14] * sc, y[15] * sc);
            *(LAS v4u*)dstp = o0; *(LAS v4u*)(dstp + 8) = o1;
        }
        __syncthreads();
        const LAS bf16* qs = (const LAS bf16*)(F.lds + GD_Q); const LAS bf16* ks = (const LAS bf16*)(F.lds + GD_K); const LAS bf16* vs = (const LAS bf16*)(F.lds + GD_V);
        {
            const int mat = w >> 2, rt = w & 3;
            const LAS bf16* As = mat ? qs : ks;
            LAS float* Out = (LAS float*)(F.lds + (mat ? GD_QK : GD_KK));
            bf16x8 af[4];
#pragma unroll
            for (int s = 0; s < 4; ++s) af[s] = *(const LAS bf16x8*)(As + (16 * rt + r16) * 136 + 32 * s + 8 * quad);
#pragma unroll
            for (int ct = 0; ct < 4; ++ct) {
                f32x4 acc = (f32x4){0.f, 0.f, 0.f, 0.f};
#pragma unroll
                for (int s = 0; s < 4; ++s) { const bf16x8 bfr = *(const LAS bf16x8*)(ks + (16 * ct + r16) * 136 + 32 * s + 8 * quad);
                    acc = __builtin_amdgcn_mfma_f32_16x16x32_bf16(af[s], bfr, acc, 0, 0, 0); }
#pragma unroll
                for (int j = 0; j < 4; ++j) Out[(16 * rt + 4 * quad + j) * 65 + 16 * ct + r16] = acc[j];
            }
        }
        int tid2 = F.tid; asm volatile("" : "+v"(tid2));
        const int dir = tid2 >> 8, dt = tid2 & 255;
        LAS float* sm = (LAS float*)(F.lds + GD_SM) + dir * 256;
        if (dt < 64) {
            const int ti = dir ? 63 - dt : dt; const size_t row = (size_t)64 * g + ti;
            const float ga = WSP(float, WS_CAB)[row * 16 + dir * 4 + h], gb = WSP(float, WS_CAB)[row * 16 + 8 + dir * 4 + h];
            const float gv = -__expf(F.in[I_CALOG][(l * 2 + dir) * 4 + h]) * softplusf_(ga + F.in[I_CDTB][(l * 2 + dir) * 4 + h]);
            float v = gv;
#pragma unroll
            for (int off = 1; off < 64; off <<= 1) { const float u = __shfl_up(v, off); if (lane >= off) v += u; }
            sm[dt] = gv; sm[64 + dt] = sigmoidf_(gb); sm[128 + dt] = v; sm[192 + dt] = __expf(v);
        }
        __syncthreads();
        const size_t cd = ((size_t)g * 4 + h) * 2 + dir;
        const LAS float* KK = (const LAS float*)(F.lds + GD_KK); const LAS float* QKm = (const LAS float*)(F.lds + GD_QK);
        LAS float* Ls = (LAS float*)(F.lds + GD_L) + dir * 4096;
        {
            bf16* gqk = WSP(bf16, WS_GQK) + cd * 4096;
            for (int idx = dt; idx < 4096; idx += 256) { const int i = idx >> 6, j = idx & 63; const int ti = dir ? 63 - i : i, tj = dir ? 63 - j : j;
                const float dec = j <= i ? __expf(sm[128 + i] - sm[128 + j]) : 0.f;
                Ls[idx] = j < i ? sm[64 + i] * KK[ti * 65 + tj] * dec : 0.f;
                gqk[idx] = (bf16)f2bf(QKm[ti * 65 + tj] * dec); }
        }
        __syncthreads();
        {
            float X[64];
            int c = F.tid & 255; asm volatile("" : "+v"(c));
            bf16* outp = (c < 128 ? WSP(bf16, WS_GU) : WSP(bf16, WS_GW)) + cd * 8192 + (c & 127);
            const LAS bf16* src = (c < 128 ? vs : ks) + (c & 127);
#pragma unroll
            for (int i = 0; i < 64; ++i) {
                const int ti = dir ? 63 - i : i;
                float a = sm[64 + i] * bf2f(src[ti * 136]); if (c >= 128) a *= sm[192 + i];
#pragma unroll
                for (int j = 0; j < i; ++j) a -= Ls[i * 64 + j] * X[j];
                X[i] = a;
                outp[i * 128] = (bf16)f2bf(a);
                asm volatile("" ::: "memory");
            }
        }
        {
            bf16* gqg = WSP(bf16, WS_GQG) + cd * 8192; bf16* gkd = WSP(bf16, WS_GKD) + cd * 8192;
            const float gl = sm[128 + 63];
            for (int idx = dt; idx < 8192; idx += 256) { const int i = idx >> 7, d = idx & 127; const int ti = dir ? 63 - i : i;
                gqg[idx] = (bf16)f2bf(bf2f(qs[ti * 136 + d]) * sm[192 + i]); }
            for (int idx = dt; idx < 8192; idx += 256) { const int d = idx >> 6, i = idx & 63; const int ti = dir ? 63 - i : i;
                gkd[idx] = (bf16)f2bf(bf2f(ks[ti * 136 + d]) * __expf(gl - sm[128 + i])); }
            if (dt == 0) WSP(float, WS_GGL)[cd] = __expf(gl);
        }
    }
    __syncthreads();
}

constexpr int GS_ST = 0, GS_VN = 4352;
struct GdnOps { bf16x8 a[4]; bf16x8 qk[2]; bf16x8 kd[2]; float uv[4]; float gl; };
__device__ __forceinline__ void gdn_load(Frame& F, GdnOps& o, size_t cd, int sl) {
    const int lane = F.lane, w = F.wave, r16 = lane & 15, quad = lane >> 4, rt = w & 3;
    const bf16* ap = (w < 4 ? WSP(bf16, WS_GW) : WSP(bf16, WS_GQG)) + cd * 8192 + (size_t)(16 * rt + r16) * 128 + 8 * quad;
#pragma unroll
    for (int s = 0; s < 4; ++s) o.a[s] = *(const bf16x8*)(ap + 32 * s);
    const bf16* kp = WSP(bf16, WS_GKD) + cd * 8192 + (size_t)(16 * w + r16) * 64 + 8 * quad;
    o.kd[0] = *(const bf16x8*)kp; o.kd[1] = *(const bf16x8*)(kp + 32);
    if (w >= 4) { const bf16* qp = WSP(bf16, WS_GQK) + cd * 4096 + (size_t)(16 * rt + r16) * 64 + 8 * quad; o.qk[0] = *(const bf16x8*)qp; o.qk[1] = *(const bf16x8*)(qp + 32); }
    else { const bf16* up = WSP(bf16, WS_GU) + cd * 8192 + (size_t)(16 * rt + 4 * quad) * 128 + 16 * sl + r16;
#pragma unroll
        for (int j = 0; j < 4; ++j) o.uv[j] = bf2f(up[j * 128]); }
    o.gl = WSP(float, WS_GGL)[cd];
}
__device__ __forceinline__ size_t gdn_cd(int b, int h, int dir, int s) {
    int g; if (s < 4) g = 256 + 4 * b + (dir ? 3 - s : s); else g = 64 * b + (dir ? 63 - (s - 4) : (s - 4));
    return ((size_t)g * 4 + h) * 2 + dir;
}
__device__ __forceinline__ void gdn_scan(Frame& F, int chain) {
    REFRESH_TID(F);
    const int sl = chain & 7, dir = (chain >> 3) & 1, h = (chain >> 4) & 3, b = chain >> 6;
    const int lane = F.lane, w = F.wave, r16 = lane & 15, quad = lane >> 4, rt = w & 3;
    LAS bf16* St = (LAS bf16*)(F.lds + GS_ST); LAS bf16* VNt = (LAS bf16*)(F.lds + GS_VN);
    __syncthreads();
    for (int i = F.tid; i < (GS_VN + 2304) / 4; i += NT) ((LAS unsigned*)F.lds)[i] = 0u;
    __syncthreads();
    f32x4 sacc = (f32x4){0.f, 0.f, 0.f, 0.f};
    GdnOps cur, nxt;
    gdn_load(F, cur, gdn_cd(b, h, dir, 0), sl);
    float* GO = WSP(float, WS_GO) + (size_t)dir * MROWS * 512;
#pragma unroll 1
    for (int s = 0; s < 68; ++s) {
        const size_t cdc = gdn_cd(b, h, dir, s);
        if (s + 1 < 68) gdn_load(F, nxt, gdn_cd(b, h, dir, s + 1), sl);
        bf16x8 sbf[4];
#pragma unroll
        for (int ks = 0; ks < 4; ++ks) sbf[ks] = *(const LAS bf16x8*)(St + r16 * 136 + 32 * ks + 8 * quad);
        f32x4 acc = (f32x4){0.f, 0.f, 0.f, 0.f};
#pragma unroll
        for (int ks = 0; ks < 4; ++ks) acc = __builtin_amdgcn_mfma_f32_16x16x32_bf16(cur.a[ks], sbf[ks], acc, 0, 0, 0);
        if (w < 4) {
            v2u o; o.x = pk2(cur.uv[0] - acc[0], cur.uv[1] - acc[1]); o.y = pk2(cur.uv[2] - acc[2], cur.uv[3] - acc[3]);
            *(LAS v2u*)(VNt + r16 * 72 + 16 * rt + 4 * quad) = o;
        }
        __syncthreads();
        const bf16x8 vb0 = *(const LAS bf16x8*)(VNt + r16 * 72 + 8 * quad), vb1 = *(const LAS bf16x8*)(VNt + r16 * 72 + 32 + 8 * quad);
        if (w >= 4) {
            acc = __builtin_amdgcn_mfma_f32_16x16x32_bf16(cur.qk[0], vb0, acc, 0, 0, 0);
            acc = __builtin_amdgcn_mfma_f32_16x16x32_bf16(cur.qk[1], vb1, acc, 0, 0, 0);
            const int g = (int)(cdc >> 3);
#pragma unroll
            for (int j = 0; j < 4; ++j) { const int i = 16 * rt + 4 * quad + j; const int ti = dir ? 63 - i : i;
                GO[((size_t)64 * g + ti) * 512 + h * 128 + 16 * sl + r16] = acc[j]; }
        }
        sacc = sacc * cur.gl;
        sacc = __builtin_amdgcn_mfma_f32_16x16x32_bf16(cur.kd[0], vb0, sacc, 0, 0, 0);
        sacc = __builtin_amdgcn_mfma_f32_16x16x32_bf16(cur.kd[1], vb1, sacc, 0, 0, 0);
        { v2u o; o.x = pk2(sacc[0], sacc[1]); o.y = pk2(sacc[2], sacc[3]); *(LAS v2u*)(St + r16 * 136 + 16 * w + 4 * quad) = o; }
        __syncthreads();
        cur = nxt;
    }
}
__device__ __forceinline__ void gdn_out(Frame& F, int l) {
    REFRESH_TID(F);
    const int gw = F.bid * NWAVES + F.wave, NGW = F.G * NWAVES, lane = F.lane;
    const float* G0 = WSP(float, WS_GO); const float* G1 = G0 + (size_t)MROWS * 512;
    const bf16* U = WSP(bf16, WS_U); bf16* YC = WSP(bf16, WS_Y) + (size_t)2 * MROWS * 512;
    const float g0 = F.in[I_CGOUT][l * 128 + 2 * lane], g1 = F.in[I_CGOUT][l * 128 + 2 * lane + 1];
    for (int r = gw; r < MROWS; r += NGW) {
#pragma unroll
        for (int h = 0; h < 4; ++h) {
            const size_t o = (size_t)r * 512 + h * 128 + 2 * lane;
            const float a0 = G0[o] + G1[o], a1 = G0[o + 1] + G1[o + 1];
            const float ss = wave_sum(a0 * a0 + a1 * a1);
            const float rs = rsqrtf(ss * (1.f / 128.f) + EPS);
            const unsigned zz = *(const unsigned*)(U + (size_t)r * UW + UCZ + h * 128 + 2 * lane);
            *(unsigned*)(YC + o) = pk2(a0 * rs * g0 * siluf_(bflo(zz)), a1 * rs * g1 * siluf_(bfhi(zz)));
        }
    }
}

constexpr int PH_PER_LAYER = 11, PH_FINAL = 1 + PH_PER_LAYER * DEPTH, N_PHASES = PH_FINAL + 1;
struct Args { const float* in[32]; float* out; unsigned char* ws; int ph_lo, ph_hi, li, pad; };

__global__ void __launch_bounds__(NT, 2) hybrid_fwd(Args args) {
    extern __shared__ __attribute__((aligned(16))) unsigned char lds_raw[];
    Frame F;
    F.lds = (LAS unsigned char*)lds_raw;
    F.tid = threadIdx.x; F.lane = F.tid & 63; F.wave = __builtin_amdgcn_readfirstlane(F.tid >> 6);
    F.G = gridDim.x; F.bid = blockIdx.x;
    F.in = args.in; F.in0 = args.in;
    F.out = args.out; F.ws = args.ws; F.ws0 = args.ws; F.ctl = (unsigned*)(args.ws + WS_CTL);
    volatile LAS unsigned* MISC = (volatile LAS unsigned*)(F.lds + MISC_OFF);
    if (F.tid < 64) MISC[F.tid] = 0u;
    __syncthreads();
    const int lo = args.ph_lo, hi = args.ph_hi;
    XcdBarrier bar = xcd_barrier_post(F.ctl + CW_BAR + args.li * XCD_BAR_WORDS, MISC + 8);
#ifndef ONLY_MASK
#define ONLY_MASK 0xFFFF
#endif
#define PHON(b) ((ONLY_MASK >> (b)) & 1)
#define IN(k) (lo <= (k) && (k) < hi)
#define SEAM(k) do { if ((k) + 1 < hi) xcd_barrier(bar); } while (0)

    if (PHON(0) && IN(0)) { REFRESH_TID(F); p0_prologue(F); SEAM(0); }
#pragma unroll 1
    for (int l = 0; l < DEPTH; ++l) {
        const int pb = 1 + PH_PER_LAYER * l;
        if (PHON(1) && IN(pb + 0)) { REFRESH_TID(F); norm_phase<0>(F, l); SEAM(pb + 0); }
        if (PHON(2) && IN(pb + 1)) { REFRESH_TID(F);
            pg8::Gemm g{WSP(bf16, WS_H), WSP(bf16, WS_WIN) + (size_t)l * UW * D, MROWS, UW, D};
            pg8::StaticOrder S; S.init(MROWS, UW, F.G, F.bid);
            pg8::EpiStoreBf16 E{WSP(bf16, WS_U), UW};
            pg8::gemm_phase<pg8::EpiStoreBf16, pg8::StaticOrder, true, true>(F.lds, g, S, E);
            SEAM(pb + 1);
        }
        if (PHON(3) && IN(pb + 2)) { REFRESH_TID(F);
#ifndef NO_C1
            gdn_prep(F, l);
#endif
#ifndef NO_C2
            lru_pass1(F, l);
#endif
            __syncthreads();
#ifndef NO_C3
            qk_prep(F, l);
#endif
#ifndef NO_C4
            v_transpose(F);
#endif
            SEAM(pb + 2);
        }
        if (PHON(4) && IN(pb + 3)) { REFRESH_TID(F);
            for (int ch = F.bid; ch < 256; ch += F.G) gdn_scan(F, ch);
            for (int it = F.bid; it < 8; it += F.G) lru_carry(F, it);
            __syncthreads();
            attn_phase(F, l);
            SEAM(pb + 3);
        }
        if (PHON(5) && IN(pb + 4)) { REFRESH_TID(F);
            lru_pass2(F, l);
            __syncthreads();
            gdn_out(F, l);
            SEAM(pb + 4);
        }
        if (PHON(6) && IN(pb + 5)) { REFRESH_TID(F);
            pg8::Gemm g{WSP(bf16, WS_Y), WSP(bf16, WS_WBR) + (size_t)l * 4 * 1024 * 512, 4 * MROWS, 4 * 1024, 512};
            pg8::MergeOrder S{F.G, F.bid, MROWS / 256};
            pg8::EpiMerge E{WSP(bf16, WS_U), UW, UG, WSP(float, WS_MF), WSP(bf16, WS_MB), MROWS / 256};
            pg8::gemm_phase<pg8::EpiMerge, pg8::MergeOrder, true, true>(F.lds, g, S, E);
            SEAM(pb + 5);
        }
        if (PHON(7) && IN(pb + 6)) { REFRESH_TID(F);
            pg8::Gemm g{WSP(bf16, WS_MB), WSP(bf16, WS_WOUT) + (size_t)l * D * D, MROWS, D, D};
            pg8::StaticOrder S; S.init(MROWS, D, F.G, F.bid);
            pg8::EpiResid E{WSP(float, WS_X), WSP(float, WS_MOD) + (size_t)l * 5 * 6144 + 2048};
            pg8::gemm_phase<pg8::EpiResid, pg8::StaticOrder, true, true>(F.lds, g, S, E);
            SEAM(pb + 6);
        }
        if (PHON(8) && IN(pb + 7)) { REFRESH_TID(F); norm_phase<1>(F, l); SEAM(pb + 7); }
        if (PHON(9) && IN(pb + 8)) { REFRESH_TID(F); moe_gather(F, l); SEAM(pb + 8); }
        if (PHON(10) && IN(pb + 9)) { REFRESH_TID(F);
            moe_table(F, l);
            pg8::Gemm g{WSP(bf16, WS_HS), WSP(bf16, WS_WGU) + (size_t)l * NEXP * 2048 * D, MOE_ROWS, NEXP * 2048, D};
            pg8::MoeOrder S{(const LAS int*)(F.lds + MISC_OFF + 256), F.G, F.bid, 8};
            pg8::EpiSwiglu E{WSP(bf16, WS_ACT), F.in[I_BGU] + (size_t)l * NEXP * 2048};
            pg8::gemm_phase<pg8::EpiSwiglu, pg8::MoeOrder, true, true>(F.lds, g, S, E);
            SEAM(pb + 9);
        }
        if (PHON(11) && IN(pb + 10)) { REFRESH_TID(F);
            moe_table(F, l);
            pg8::Gemm g{WSP(bf16, WS_ACT), WSP(bf16, WS_WDN) + (size_t)l * NEXP * D * D, MOE_ROWS, NEXP * D, D};
            pg8::MoeOrder S{(const LAS int*)(F.lds + MISC_OFF + 256), F.G, F.bid, 4};
            pg8::EpiDown E{WSP(bf16, WS_YS), F.in[I_BDN] + (size_t)l * NEXP * D};
            pg8::gemm_phase<pg8::EpiDown, pg8::MoeOrder, true, true>(F.lds, g, S, E);
            SEAM(pb + 10);
        }
    }
    if (PHON(12) && IN(PH_FINAL)) { REFRESH_TID(F); norm_phase<2>(F, 0); }
#undef IN
#undef SEAM
}

extern "C" void kernel_launch(void* const* d_in, const int* in_sizes, int n_in, void* d_out, int out_size, void* d_ws, size_t ws_size, hipStream_t stream) {
    static int grid = 0;
    if (grid == 0) {
        if (n_in != 32 || out_size != TLAT * D || ws_size < WS_END) { fprintf(stderr, "kernel_launch: unexpected shapes (n_in %d out %d ws %zu need %zu)\n", n_in, out_size, ws_size, (size_t)WS_END); grid = -1; return; }
        int dev = 0, cus = 0, per_cu = 0;
        if (hipGetDevice(&dev) != hipSuccess || hipDeviceGetAttribute(&cus, hipDeviceAttributeMultiprocessorCount, dev) != hipSuccess) { grid = -1; return; }
        if (hipFuncSetAttribute((const void*)hybrid_fwd, hipFuncAttributeMaxDynamicSharedMemorySize, LDS_BYTES) != hipSuccess) { fprintf(stderr, "kernel_launch: hipFuncSetAttribute failed\n"); grid = -1; return; }
        if (hipOccupancyMaxActiveBlocksPerMultiprocessor(&per_cu, (const void*)hybrid_fwd, NT, LDS_BYTES) != hipSuccess || per_cu < 1) fprintf(stderr, "kernel_launch: occupancy query says %d\n", per_cu);
        (void)hipGetLastError();
        grid = cus;
    }
    if (grid < 0) return;
    if (hipMemsetAsync((char*)d_ws + WS_CTL, 0, CTL_BYTES, stream) != hipSuccess) return;
    Args a{};
    for (int i = 0; i < 32; ++i) a.in[i] = (const float*)d_in[i];
    a.out = (float*)d_out; a.ws = (unsigned char*)d_ws;
#if MK_MULTI
    for (int p = 0; p < N_PHASES; ++p) { a.ph_lo = p; a.ph_hi = p + 1; a.li = p;
        hipLaunchKernelGGL(hybrid_fwd, dim3(grid), dim3(NT), LDS_BYTES, stream, a); }
#else
    a.ph_lo = 0; a.ph_hi = N_PHASES; a.li = 0;
    hipLaunchKernelGGL(hybrid_fwd, dim3(grid), dim3(NT), LDS_BYTES, stream, a);
#endif
    const hipError_t le = hipPeekAtLastError();
    if (le != hipSuccess) fprintf(stderr, "kernel_launch: launch failed: %s\n", hipGetErrorName(le));
}
```

```cpp
#include <hip/hip_runtime.h>
#include <cstdio>
#include <cstdint>

#ifndef MK_MULTI
#define MK_MULTI 0
#endif

constexpr int D = 1024, NB = 4, SEQ = 4096, LCTX = 256, DEPTH = 4;
constexpr int TLAT = NB * SEQ, TCTX = NB * LCTX, MROWS = TLAT + TCTX;
constexpr int NCHUNK = MROWS / 64;
constexpr int INW = 9488, UW = 9472;
constexpr int UQ = 0, UK = 512, UV = 640, UBX = 768, UBY = 1280, UCQ = 1792, UCK = 2304, UCV = 2816, UCZ = 3328, UDQ = 3840, UDK = 4352, UDV = 4864, UG = 5376;
constexpr int NEXP = 32, TOPK = 4;
constexpr int KEYS = SEQ + LCTX;
constexpr int MOE_ROWS = MROWS * TOPK + NEXP * 256;
constexpr float EPS = 1e-6f;
constexpr float LOG2E = 1.4426950408889634f;

constexpr size_t al256(size_t x) { return (x + 255) & ~(size_t)255; }
constexpr size_t WS_CTL = 0, CTL_BYTES = 1u << 20;
constexpr size_t WS_MOD  = WS_CTL + CTL_BYTES;
constexpr size_t WS_ROPE = WS_MOD + al256((size_t)DEPTH * 5 * 6144 * 4);
constexpr size_t WS_LRUW = WS_ROPE + al256(2 * 64 * 16 * 4);
constexpr size_t WS_WIN  = WS_LRUW + al256((size_t)DEPTH * 2 * 2 * 8 * 4096 * 2);
constexpr size_t WS_WBR  = WS_WIN + al256((size_t)DEPTH * UW * D * 2);
constexpr size_t WS_WOUT = WS_WBR + al256((size_t)DEPTH * 4 * 1024 * 512 * 2);
constexpr size_t WS_WGU  = WS_WOUT + al256((size_t)DEPTH * D * D * 2);
constexpr size_t WS_WDN  = WS_WGU + al256((size_t)DEPTH * NEXP * 2048 * 1024 * 2);
constexpr size_t WS_X    = WS_WDN + al256((size_t)DEPTH * NEXP * 1024 * 1024 * 2);
constexpr size_t WS_H    = WS_X + al256((size_t)MROWS * D * 4);
constexpr size_t WS_U    = WS_H + al256((size_t)MROWS * D * 2);
constexpr size_t WS_CAB  = WS_U + al256((size_t)MROWS * UW * 2);
constexpr size_t WS_VAT  = WS_CAB + al256((size_t)MROWS * 16 * 4);
constexpr size_t WS_VDT  = WS_VAT + al256((size_t)NB * 2 * 64 * KEYS * 2);
constexpr size_t WS_LRA  = WS_VDT + al256((size_t)NB * 8 * 64 * KEYS * 2);
constexpr size_t WS_LRB  = WS_LRA + al256((size_t)NCHUNK * 2 * 512 * 4);
constexpr size_t WS_LRC  = WS_LRB + al256((size_t)NCHUNK * 2 * 512 * 4);
constexpr int NCD = NCHUNK * 4 * 2;
constexpr size_t WS_GW   = WS_LRC + al256((size_t)NCHUNK * 2 * 512 * 4);
constexpr size_t WS_GU   = WS_GW + al256((size_t)NCD * 64 * 128 * 2);
constexpr size_t WS_GQG  = WS_GU + al256((size_t)NCD * 64 * 128 * 2);
constexpr size_t WS_GKD  = WS_GQG + al256((size_t)NCD * 64 * 128 * 2);
constexpr size_t WS_GQK  = WS_GKD + al256((size_t)NCD * 64 * 128 * 2);
constexpr size_t WS_GGL  = WS_GQK + al256((size_t)NCD * 64 * 64 * 2);
constexpr size_t WS_GO   = WS_GGL + al256((size_t)NCD * 4);
constexpr size_t WS_Y    = WS_GO + al256((size_t)2 * MROWS * 512 * 4);
constexpr size_t WS_MF   = WS_Y + al256((size_t)4 * MROWS * 512 * 2);
constexpr size_t WS_MB   = WS_MF + al256((size_t)MROWS * D * 4);
constexpr size_t WS_SROW = WS_MB + al256((size_t)MROWS * D * 2);
constexpr size_t WS_SW   = WS_SROW + al256((size_t)MROWS * 4 * 4);
constexpr size_t WS_SEP  = WS_SW + al256((size_t)MROWS * 4 * 4);
constexpr size_t WS_LIST = WS_SEP + al256((size_t)MROWS * 4 * 4);
constexpr size_t WS_HS   = WS_LIST + al256((size_t)NEXP * MROWS * 4);
constexpr size_t WS_ACT  = WS_HS + al256((size_t)MOE_ROWS * D * 2);
constexpr size_t WS_YS   = WS_ACT + al256((size_t)MOE_ROWS * D * 2);
constexpr size_t WS_END  = WS_YS + al256((size_t)MOE_ROWS * D * 2);

constexpr int CW_BAR = 4096;
constexpr int CW_CNT = 1024;

constexpr int RING_BYTES = 131072;
constexpr int MISC_OFF = RING_BYTES;
constexpr int LDS_BYTES = 147456;
constexpr int NWAVES = 8, NT = 512;

#define GAS __attribute__((address_space(1)))
#define LAS __attribute__((address_space(3)))
typedef unsigned short bf16;
typedef unsigned v4u __attribute__((ext_vector_type(4)));
typedef unsigned v2u __attribute__((ext_vector_type(2)));
typedef float f32x4 __attribute__((ext_vector_type(4)));
typedef float f32x16 __attribute__((ext_vector_type(16)));
typedef short bf16x8 __attribute__((ext_vector_type(8)));
typedef short bf16x4 __attribute__((ext_vector_type(4)));

typedef float f32x2_t __attribute__((ext_vector_type(2))); typedef __bf16 bf16x2_t __attribute__((ext_vector_type(2)));
__device__ __forceinline__ unsigned pk2(float lo, float hi) { f32x2_t v = {lo, hi}; bf16x2_t b = __builtin_convertvector(v, bf16x2_t); return __builtin_bit_cast(unsigned, b); }
__device__ __forceinline__ unsigned f2bf(float f) { return pk2(f, 0.f) & 0xffffu; }
__device__ __forceinline__ float bf2f(unsigned short b) { return __builtin_bit_cast(float, (unsigned)b << 16); }
__device__ __forceinline__ float bflo(unsigned w) { return __builtin_bit_cast(float, w << 16); }
__device__ __forceinline__ float bfhi(unsigned w) { return __builtin_bit_cast(float, w & 0xffff0000u); }
__device__ __forceinline__ float wave_sum(float v) {
#pragma unroll
    for (int o = 1; o < 64; o <<= 1) v += __shfl_xor(v, o);
    return v;
}
__device__ __forceinline__ float sigmoidf_(float x) { return 1.f / (1.f + __expf(-x)); }
__device__ __forceinline__ float softplusf_(float x) { return x > 20.f ? x : log1pf(__expf(x)); }
__device__ __forceinline__ float siluf_(float x) { return x / (1.f + __expf(-x)); }
namespace pg8 {
#define PG8_LAS __attribute__((address_space(3)))
typedef unsigned short bf16_t;
typedef short bf16x8 __attribute__((ext_vector_type(8)));
typedef float f32x4 __attribute__((ext_vector_type(4)));
typedef unsigned u32x4 __attribute__((ext_vector_type(4)));
constexpr int BM = 256, BK = 64, HALF = 128, HTB = HALF * BK * 2  , STAGE_BYTES = 8 * HTB, NXCD = 8, WGM = 8;

__host__ __device__ __forceinline__ int lds_byte(int r, int c) { const int st = (r >> 4) * 2 + (c >> 5), rr = r & 15, cc = c & 31, ob = rr * 64 + cc * 2; return st * 1024 + (ob ^ (((ob >> 9) & 1) << 5)); }
__host__ __device__ __forceinline__ void stage_rc(int b, int& R, int& C) { const int st = b / 1024, sb = b % 1024, swz = sb ^ (((sb >> 9) & 1) << 5); R = (st >> 1) * 16 + swz / 64; C = (st & 1) * 32 + (swz % 64) / 2; }
__host__ __device__ __forceinline__ int perm32(int rho) { const int n = rho >> 4, i = rho & 15; return 8 * (i >> 2) + 4 * n + (i & 3); }

struct Unit { int pm, pn; };
struct Gemm { const bf16_t* A; const bf16_t* Bt; int M, N, K; };

struct StaticOrder {
    int nM, nN, nwg, G, c;
    __host__ __device__ void init(int M, int N, int G_, int c_) { nM = M / BM; nN = N / BM; nwg = nM * nN; G = G_; c = c_; }
    __host__ __device__ bool next(int i, Unit& u) const {
        const long L = (long)i * G + c; if (L >= nwg) return false;
        int wgid = (int)L; { const int q = nwg / NXCD, r = nwg % NXCD, xcd = wgid % NXCD, off = wgid / NXCD; wgid = (xcd < r ? xcd * (q + 1) : r * (q + 1) + (xcd - r) * q) + off; }
        const int nig = WGM * nN, gid = wgid / nig, fm = gid * WGM, gsz = (nM - fm) < WGM ? (nM - fm) : WGM;
        u.pm = fm + ((wgid % nig) % gsz); u.pn = (wgid % nig) / gsz; return true;
    }
    __device__ __forceinline__ void a_ready(const Unit&) const {}
    __device__ __forceinline__ void done(const Unit&) const {}
};

__device__ __forceinline__ unsigned cvt_pk_bf16(float lo, float hi) { unsigned r; asm volatile("v_cvt_pk_bf16_f32 %0, %1, %2" : "=v"(r) : "v"(lo), "v"(hi)); return r; }
typedef float f32x2 __attribute__((ext_vector_type(2)));
template <class Epi, class Sched, bool ALIGN_EPI = false, bool SP2 = false>
__device__ __forceinline__ void gemm_phase(PG8_LAS unsigned char* lds, const Gemm g, const Sched& S, const Epi& E) {
    int tid_o = threadIdx.x; asm volatile("" : "+v"(tid_o));
    const int tid = tid_o, wid = __builtin_amdgcn_readfirstlane(tid >> 6), lane = tid & 63, wr = wid >> 2, wc = wid & 3, fr = lane & 15, fq = lane >> 4;
    const int K = g.K, nt = K / BK;
    unsigned voffA[2], voffB[2];
#pragma unroll
    for (int i = 0; i < 2; ++i) { int R, C; stage_rc(tid * 16 + i * 8192, R, C); const int Rb = Epi::PERM ? ((R & ~31) + perm32(R & 31)) : R;
        voffA[i] = (unsigned)(R * K + C) * 2u; voffB[i] = (unsigned)(Rb * K + C) * 2u; }
    const size_t kstep = (size_t)(BK * 2);
    const size_t hstep = (size_t)HALF * K * 2;
    const size_t tstep = 2 * hstep;
    const unsigned ldsw = (unsigned)wid * 1024u;
    const int aoff = lds_byte(wr * 64 + fr, fq * 8), boff = lds_byte(wc * 32 + fr, fq * 8);
#define PG8_SA(b, h) (((b) * 2 + (h)) * HTB)
#define PG8_SB(b, h) ((4 + (b) * 2 + (h)) * HTB)
#define PG8_STAGE(bufoff, gbase, voff) do { _Pragma("unroll") for (int _i = 0; _i < 2; ++_i) \
        __builtin_amdgcn_global_load_lds((const unsigned*)((const char*)(gbase) + (voff)[_i]), (PG8_LAS unsigned*)(lds + (bufoff) + ldsw + _i * 8192), 16, 0, 0); } while (0)
#define PG8_LDA(dst, b, h) do { _Pragma("unroll") for (int m = 0; m < 4; ++m) _Pragma("unroll") for (int k = 0; k < 2; ++k) dst[m][k] = *(const PG8_LAS bf16x8*)(lds + PG8_SA(b, h) + aoff + m * 2048 + k * 1024); } while (0)
#define PG8_LDB(dst, b, h) do { _Pragma("unroll") for (int n = 0; n < 2; ++n) _Pragma("unroll") for (int k = 0; k < 2; ++k) dst[n][k] = *(const PG8_LAS bf16x8*)(lds + PG8_SB(b, h) + boff + n * 2048 + k * 1024); } while (0)
#define PG8_MMA(ai, bj, At, Bt) do { __builtin_amdgcn_s_setprio(1); _Pragma("unroll") for (int m = 0; m < 4; ++m) _Pragma("unroll") for (int n = 0; n < 2; ++n) _Pragma("unroll") for (int k = 0; k < 2; ++k) \
        acc[ai][bj][m][n] = __builtin_amdgcn_mfma_f32_16x16x32_bf16(Bt[n][k], At[m][k], acc[ai][bj][m][n], 0, 0, 0); __builtin_amdgcn_s_setprio(0); } while (0)
#define PG8_WAIT_V(n) asm volatile("s_waitcnt vmcnt(" #n ")" ::: "memory")
#define PG8_WAIT_L(n) asm volatile("s_waitcnt lgkmcnt(" #n ")" ::: "memory")
#define PG8_BAR __builtin_amdgcn_s_barrier()
#define PG8_SCHED __builtin_amdgcn_sched_barrier(0)
    Unit cur, nxt; int ui = 0;
    if (!S.next(0, cur)) return;
    f32x4 acc[2][2][4][2];
#pragma unroll
    for (int a = 0; a < 2; ++a)
#pragma unroll
        for (int b = 0; b < 2; ++b)
#pragma unroll
            for (int m = 0; m < 4; ++m)
#pragma unroll
                for (int n = 0; n < 2; ++n) acc[a][b][m][n] = (f32x4){0.f, 0.f, 0.f, 0.f};
    bf16x8 At[4][2], B0[2][2], B1[2][2];
    const char* cA = (const char*)g.A + (size_t)cur.pm * tstep; const char* cB = (const char*)g.Bt + (size_t)cur.pn * tstep;
    S.a_ready(cur);
    if constexpr (SP2) {
        PG8_STAGE(PG8_SB(0, 0), cB, voffB); PG8_STAGE(PG8_SB(0, 1), cB + hstep, voffB); PG8_STAGE(PG8_SA(0, 0), cA, voffA); PG8_STAGE(PG8_SA(0, 1), cA + hstep, voffA);
        if (wr == 1) PG8_BAR;
        PG8_WAIT_V(2); PG8_BAR;
        PG8_STAGE(PG8_SB(1, 0), cB + kstep, voffB); PG8_STAGE(PG8_SA(1, 0), cA + kstep, voffA); PG8_STAGE(PG8_SB(1, 1), cB + hstep + kstep, voffB);
        PG8_WAIT_V(6); PG8_BAR;
    } else {
        PG8_STAGE(PG8_SB(0, 0), cB, voffB); PG8_STAGE(PG8_SA(0, 0), cA, voffA); PG8_STAGE(PG8_SB(0, 1), cB + hstep, voffB); PG8_STAGE(PG8_SA(0, 1), cA + hstep, voffA);
        if (wr == 1) PG8_BAR;
        PG8_WAIT_V(4); PG8_BAR;
        PG8_STAGE(PG8_SB(1, 0), cB + kstep, voffB); PG8_STAGE(PG8_SA(1, 0), cA + kstep, voffA); PG8_STAGE(PG8_SB(1, 1), cB + hstep + kstep, voffB);
        PG8_WAIT_V(6); PG8_BAR;
    }
    for (;;) {
        const bool has_next = S.next(ui + 1, nxt);
        const char* nA = has_next ? (const char*)g.A + (size_t)nxt.pm * tstep : cA; const char* nB = has_next ? (const char*)g.Bt + (size_t)nxt.pn * tstep : cB;
        for (int t = 0; t < nt; t += 2) {
            const bool last = (t == nt - 2);
            const char* a1 = cA + (size_t)(t + 1) * kstep;
            const char* a2 = last ? nA : cA + (size_t)(t + 2) * kstep; const char* b2 = last ? nB : cB + (size_t)(t + 2) * kstep;
            const char* a3 = a2 + kstep; const char* b3 = b2 + kstep;
            if (last && has_next) S.a_ready(nxt);
            if constexpr (SP2) {
            PG8_LDB(B0, 0, 0); PG8_LDB(B1, 0, 1); PG8_SCHED; PG8_LDA(At, 0, 0); PG8_STAGE(PG8_SA(1, 1), a1 + hstep, voffA);
            PG8_WAIT_V(8); PG8_WAIT_L(0); PG8_BAR; PG8_MMA(0, 0, At, B0); PG8_MMA(0, 1, At, B1); PG8_BAR; PG8_SCHED;
            PG8_LDA(At, 0, 1); PG8_STAGE(PG8_SB(0, 0), b2, voffB); PG8_STAGE(PG8_SB(0, 1), b2 + hstep, voffB); PG8_STAGE(PG8_SA(0, 0), a2, voffA);
            PG8_WAIT_V(8); PG8_WAIT_L(0); PG8_BAR; PG8_MMA(1, 0, At, B0); PG8_MMA(1, 1, At, B1); PG8_BAR; PG8_SCHED;
            PG8_LDB(B0, 1, 0); PG8_LDB(B1, 1, 1); PG8_SCHED; PG8_LDA(At, 1, 0); PG8_STAGE(PG8_SA(0, 1), a2 + hstep, voffA);
            PG8_WAIT_V(8); PG8_WAIT_L(0); PG8_BAR; PG8_MMA(0, 0, At, B0); PG8_MMA(0, 1, At, B1); PG8_BAR; PG8_SCHED;
            PG8_LDA(At, 1, 1); PG8_STAGE(PG8_SB(1, 0), b3, voffB); PG8_STAGE(PG8_SB(1, 1), b3 + hstep, voffB); PG8_STAGE(PG8_SA(1, 0), a3, voffA);
            PG8_WAIT_V(8); PG8_WAIT_L(0); PG8_BAR; PG8_MMA(1, 0, At, B0); PG8_MMA(1, 1, At, B1); PG8_BAR; PG8_SCHED;
            } else {
            PG8_LDB(B0, 0, 0); PG8_SCHED; PG8_LDA(At, 0, 0); PG8_STAGE(PG8_SA(1, 1), a1 + hstep, voffA);
            PG8_WAIT_L(8); PG8_BAR; PG8_WAIT_L(0); PG8_MMA(0, 0, At, B0); PG8_BAR; PG8_SCHED;
            PG8_LDB(B1, 0, 1); PG8_STAGE(PG8_SB(0, 0), b2, voffB);
            PG8_BAR; PG8_WAIT_L(0); PG8_MMA(0, 1, At, B1); PG8_BAR;
            PG8_LDA(At, 0, 1); PG8_STAGE(PG8_SA(0, 0), a2, voffA);
            PG8_BAR; PG8_WAIT_L(0); PG8_MMA(1, 0, At, B0); PG8_BAR; PG8_SCHED;
            PG8_STAGE(PG8_SB(0, 1), b2 + hstep, voffB);
            PG8_WAIT_V(6); PG8_BAR; PG8_MMA(1, 1, At, B1); PG8_BAR;
            PG8_LDB(B0, 1, 0); PG8_SCHED; PG8_LDA(At, 1, 0); PG8_STAGE(PG8_SA(0, 1), a2 + hstep, voffA);
            PG8_WAIT_L(8); PG8_BAR; PG8_WAIT_L(0); PG8_MMA(0, 0, At, B0); PG8_BAR; PG8_SCHED;
            PG8_LDB(B1, 1, 1); PG8_STAGE(PG8_SB(1, 0), b3, voffB);
            PG8_BAR; PG8_WAIT_L(0); PG8_MMA(0, 1, At, B1); PG8_BAR;
            PG8_LDA(At, 1, 1); PG8_STAGE(PG8_SA(1, 0), a3, voffA);
            PG8_BAR; PG8_WAIT_L(0); PG8_MMA(1, 0, At, B0); PG8_BAR; PG8_SCHED;
            PG8_STAGE(PG8_SB(1, 1), b3 + hstep, voffB);
            PG8_WAIT_V(6); PG8_BAR; PG8_MMA(1, 1, At, B1); PG8_BAR;
            }
        }
        if constexpr (ALIGN_EPI) { if (wr == 0) PG8_BAR; }
        if constexpr (!Epi::AFTER_DRAIN) { E(acc, cur, wr, wc, fr, fq); S.done(cur); }
        if (!has_next) break;
#pragma unroll
        for (int a = 0; a < 2; ++a)
#pragma unroll
            for (int b = 0; b < 2; ++b)
#pragma unroll
                for (int m = 0; m < 4; ++m)
#pragma unroll
                    for (int n = 0; n < 2; ++n) acc[a][b][m][n] = (f32x4){0.f, 0.f, 0.f, 0.f};
        cur = nxt; cA = nA; cB = nB; ++ui;
        if constexpr (ALIGN_EPI) { if (wr == 1) PG8_BAR; }
    }
    PG8_WAIT_V(0);
    if constexpr (!ALIGN_EPI) { if (wr == 0) PG8_BAR; }
    PG8_BAR;
    if constexpr (Epi::AFTER_DRAIN) { E.fused(acc, cur, wr, wc, fr, fq, lds, wid, lane); S.done(cur); }
#undef PG8_SA
#undef PG8_SB
#undef PG8_STAGE
#undef PG8_LDA
#undef PG8_LDB
#undef PG8_MMA
#undef PG8_WAIT_V
#undef PG8_WAIT_L
#undef PG8_BAR
#undef PG8_SCHED
}
}

namespace pg8 {
__device__ __forceinline__ float bflo_(unsigned w) { return __builtin_bit_cast(float, w << 16); }
__device__ __forceinline__ float bfhi_(unsigned w) { return __builtin_bit_cast(float, w & 0xffff0000u); }
__device__ __forceinline__ float sigm_(float x) { return 1.f / (1.f + __expf(-x)); }

struct EpiStoreBf16 {
    static constexpr bool PERM = true, AFTER_DRAIN = false;
    bf16_t* O; int ldc;
    __device__ __forceinline__ void operator()(const f32x4 (&acc)[2][2][4][2], const Unit& u, int wr, int wc, int fr, int fq) const {
        const int row0 = u.pm * BM + wr * 64 + fr, col0 = u.pn * BM + wc * 32 + 8 * fq;
#pragma unroll
        for (int ai = 0; ai < 2; ++ai)
#pragma unroll
            for (int m = 0; m < 4; ++m) { bf16_t* rowp = O + (size_t)(row0 + ai * HALF + m * 16) * ldc + col0;
#pragma unroll
                for (int bj = 0; bj < 2; ++bj) { const f32x4 v0 = acc[ai][bj][m][0], v1 = acc[ai][bj][m][1];
                    u32x4 w; w.x = cvt_pk_bf16(v0[0], v0[1]); w.y = cvt_pk_bf16(v0[2], v0[3]); w.z = cvt_pk_bf16(v1[0], v1[1]); w.w = cvt_pk_bf16(v1[2], v1[3]);
                    *(u32x4*)(rowp + bj * HALF) = w; } }
    }
};

struct EpiMerge {
    static constexpr bool PERM = true, AFTER_DRAIN = false;
    const bf16_t* U; int ldu, gcol0; float* Mf; bf16_t* Mb; int npm;
    __device__ __forceinline__ void operator()(const f32x4 (&acc)[2][2][4][2], const Unit& u, int wr, int wc, int fr, int fq) const {
        const int br = u.pm / npm, pm = u.pm - br * npm, pn = u.pn & 3;
        const int row0 = pm * BM + wr * 64 + fr, col0 = pn * BM + wc * 32 + 8 * fq;
#pragma unroll
        for (int ai = 0; ai < 2; ++ai)
#pragma unroll
            for (int m = 0; m < 4; ++m) { const size_t row = (size_t)(row0 + ai * HALF + m * 16);
#pragma unroll
                for (int bj = 0; bj < 2; ++bj) { const int col = col0 + bj * HALF;
                    const u32x4 g = *(const u32x4*)(U + row * ldu + gcol0 + br * 1024 + col);
                    f32x4 v0 = acc[ai][bj][m][0], v1 = acc[ai][bj][m][1];
                    v0[0] *= sigm_(bflo_(g.x)); v0[1] *= sigm_(bfhi_(g.x)); v0[2] *= sigm_(bflo_(g.y)); v0[3] *= sigm_(bfhi_(g.y));
                    v1[0] *= sigm_(bflo_(g.z)); v1[1] *= sigm_(bfhi_(g.z)); v1[2] *= sigm_(bflo_(g.w)); v1[3] *= sigm_(bfhi_(g.w));
                    float* mp = Mf + row * 1024 + col;
                    if (br > 0) { v0 = v0 + *(const f32x4*)mp; v1 = v1 + *(const f32x4*)(mp + 4); }
                    if (br < 3) { *(f32x4*)mp = v0; *(f32x4*)(mp + 4) = v1; }
                    else { u32x4 w; w.x = cvt_pk_bf16(v0[0], v0[1]); w.y = cvt_pk_bf16(v0[2], v0[3]); w.z = cvt_pk_bf16(v1[0], v1[1]); w.w = cvt_pk_bf16(v1[2], v1[3]);
                        *(u32x4*)(Mb + row * 1024 + col) = w; } } }
    }
};
struct MergeOrder {
    int G, c, npm;
    __device__ __forceinline__ bool next(int i, Unit& u) const {
        const int su = (i >> 2) * G + c; if (su >= npm * 4) return false;
        const int br = i & 3; u.pm = br * npm + (su >> 2); u.pn = br * 4 + (su & 3); return true; }
    __device__ __forceinline__ void a_ready(const Unit&) const {}
    __device__ __forceinline__ void done(const Unit&) const {}
};

struct EpiResid {
    static constexpr bool PERM = false, AFTER_DRAIN = false;
    float* X; const float* gt;
    __device__ __forceinline__ void operator()(const f32x4 (&acc)[2][2][4][2], const Unit& u, int wr, int wc, int fr, int fq) const {
        const int row0 = u.pm * BM + wr * 64 + fr, col0 = u.pn * BM + wc * 32 + 4 * fq;
        const int mr = u.pm < 64 ? (u.pm >> 4) : 4;
        f32x4 gv[2][2];
#pragma unroll
        for (int bj = 0; bj < 2; ++bj)
#pragma unroll
            for (int n = 0; n < 2; ++n) gv[bj][n] = *(const f32x4*)(gt + (size_t)mr * 6144 + col0 + bj * HALF + n * 16);
#pragma unroll
        for (int ai = 0; ai < 2; ++ai)
#pragma unroll
            for (int m = 0; m < 4; ++m) { float* rowp = X + (size_t)(row0 + ai * HALF + m * 16) * 1024 + col0;
#pragma unroll
                for (int bj = 0; bj < 2; ++bj)
#pragma unroll
                    for (int n = 0; n < 2; ++n) { float* p = rowp + bj * HALF + n * 16; *(f32x4*)p = *(const f32x4*)p + gv[bj][n] * acc[ai][bj][m][n]; } }
    }
};

struct MoeOrder {
    const PG8_LAS int* tpre; int G, c, ncol;
    __device__ __forceinline__ bool next(int i, Unit& u) const {
        const int L = i * G + c, tau = L / ncol; if (tau >= tpre[32]) return false;
        int e = 0;
#pragma unroll 1
        while (tpre[e + 1] <= tau) ++e;
        u.pm = tau; u.pn = e * ncol + (L - tau * ncol); return true; }
    __device__ __forceinline__ void a_ready(const Unit&) const {}
    __device__ __forceinline__ void done(const Unit&) const {}
};
struct EpiSwiglu {
    static constexpr bool PERM = true, AFTER_DRAIN = false;
    bf16_t* ACT; const float* bgu;
    __device__ __forceinline__ void operator()(const f32x4 (&acc)[2][2][4][2], const Unit& u, int wr, int wc, int fr, int fq) const {
        const int e = u.pn >> 3, pnl = u.pn & 7;
        const int row0 = u.pm * BM + wr * 64 + fr, cl = 128 * pnl + wc * 32 + 8 * fq;
        const float* bg = bgu + (size_t)e * 2048 + cl;
        const f32x4 bg0 = *(const f32x4*)bg, bg1 = *(const f32x4*)(bg + 4), bu0 = *(const f32x4*)(bg + 1024), bu1 = *(const f32x4*)(bg + 1028);
#pragma unroll
        for (int ai = 0; ai < 2; ++ai)
#pragma unroll
            for (int m = 0; m < 4; ++m) {
                f32x4 g0 = acc[ai][0][m][0] + bg0, g1 = acc[ai][0][m][1] + bg1, u0 = acc[ai][1][m][0] + bu0, u1 = acc[ai][1][m][1] + bu1;
                float o[8];
#pragma unroll
                for (int j = 0; j < 4; ++j) { const float g = fminf(g0[j], 7.f), up = fminf(fmaxf(u0[j], -7.f), 7.f); o[j] = (up + 1.f) * g * sigm_(1.702f * g); }
#pragma unroll
                for (int j = 0; j < 4; ++j) { const float g = fminf(g1[j], 7.f), up = fminf(fmaxf(u1[j], -7.f), 7.f); o[4 + j] = (up + 1.f) * g * sigm_(1.702f * g); }
                u32x4 w; w.x = cvt_pk_bf16(o[0], o[1]); w.y = cvt_pk_bf16(o[2], o[3]); w.z = cvt_pk_bf16(o[4], o[5]); w.w = cvt_pk_bf16(o[6], o[7]);
                *(u32x4*)(ACT + (size_t)(row0 + ai * HALF + m * 16) * 1024 + cl) = w; }
    }
};
struct EpiDown {
    static constexpr bool PERM = true, AFTER_DRAIN = false;
    bf16_t* YS; const float* bdn;
    __device__ __forceinline__ void operator()(const f32x4 (&acc)[2][2][4][2], const Unit& u, int wr, int wc, int fr, int fq) const {
        const int e = u.pn >> 2, pnl = u.pn & 3;
        const int row0 = u.pm * BM + wr * 64 + fr, col0 = pnl * BM + wc * 32 + 8 * fq;
        f32x4 bv[2][2];
#pragma unroll
        for (int bj = 0; bj < 2; ++bj)
#pragma unroll
            for (int n = 0; n < 2; ++n) bv[bj][n] = *(const f32x4*)(bdn + (size_t)e * 1024 + col0 + bj * HALF + 4 * n);
#pragma unroll
        for (int ai = 0; ai < 2; ++ai)
#pragma unroll
            for (int m = 0; m < 4; ++m) { bf16_t* rowp = YS + (size_t)(row0 + ai * HALF + m * 16) * 1024 + col0;
#pragma unroll
                for (int bj = 0; bj < 2; ++bj) { const f32x4 v0 = acc[ai][bj][m][0] + bv[bj][0], v1 = acc[ai][bj][m][1] + bv[bj][1];
                    u32x4 w; w.x = cvt_pk_bf16(v0[0], v0[1]); w.y = cvt_pk_bf16(v0[2], v0[3]); w.z = cvt_pk_bf16(v1[0], v1[1]); w.w = cvt_pk_bf16(v1[2], v1[3]);
                    *(u32x4*)(rowp + bj * HALF) = w; } }
    }
};
}
#define XB_TMO      128
#define XB_XCNT(j)  (256  + 64 * (j))
#define XB_XSUB(j)  (1280 + 64 * (j))
#define XB_XGEN(j)  (2304 + 64 * (j))
#define XB_TOP      3328
#define XB_TOPGEN   3392
#define XCD_BAR_WORDS 3456
#define XB_SPIN_CAP (1u << 18)
#define LAS __attribute__((address_space(3)))

__device__ __forceinline__ unsigned xb_ld(unsigned* p)              { return __hip_atomic_load(p, __ATOMIC_RELAXED, __HIP_MEMORY_SCOPE_AGENT); }
__device__ __forceinline__ unsigned xb_add(unsigned* p, unsigned v) { return __hip_atomic_fetch_add(p, v, __ATOMIC_RELAXED, __HIP_MEMORY_SCOPE_AGENT); }
__device__ __forceinline__ unsigned xb_xcc_id() { return (unsigned)__builtin_amdgcn_s_getreg((3 << 11) | 20) & 0xFu; }
#define XB_SPIN(cond, bar) do { unsigned _sp = 0; while (cond) { __builtin_amdgcn_s_sleep(1); \
    if ((++_sp & 255u) == 0u) { if (xb_ld(&(bar)[XB_TMO])) break; if (_sp > XB_SPIN_CAP) { atomicAdd(&(bar)[XB_TMO], 1u); break; } } } } while (0)

struct XcdBarrier {
    unsigned* bar; unsigned x;
    volatile LAS unsigned* st;
};

__device__ __forceinline__ XcdBarrier xcd_barrier_post(unsigned* bar, volatile LAS unsigned* st) {
    XcdBarrier b; b.bar = bar; b.x = xb_xcc_id(); b.st = st;
    if (threadIdx.x == 0) (void)xb_add(&bar[XB_XCNT(b.x)], 1u);
    return b;
}
__device__ __forceinline__ void xcd_barrier_complete(unsigned* bar, unsigned x, unsigned& nloc, unsigned& nx) {
    const unsigned G = gridDim.x * gridDim.y * gridDim.z;
    unsigned sum, cnt, mine, sp = 0u;
    for (;;) {
        sum = 0u; cnt = 0u; mine = 0u;
#pragma unroll
        for (unsigned j = 0; j < 16; ++j) { const unsigned c = xb_ld(&bar[XB_XCNT(j)]); sum += c; cnt += (c > 0u) ? 1u : 0u; mine = (j == x) ? c : mine; }
        if (sum == G) break;
        __builtin_amdgcn_s_sleep(1);
        if ((++sp & 255u) == 0u) { if (xb_ld(&bar[XB_TMO])) break; if (sp > XB_SPIN_CAP) { atomicAdd(&bar[XB_TMO], 1u); break; } }
    }
    nloc = mine > 0u ? mine : 1u; nx = cnt > 0u ? cnt : 1u;
}

__device__ __forceinline__ void xcd_barrier(const XcdBarrier& b) {
    asm volatile("s_waitcnt vmcnt(0)" ::: "memory");
    __syncthreads();
    if (threadIdx.x == 0) {
        unsigned* bar = b.bar;
        __builtin_amdgcn_s_waitcnt(0);
        unsigned nloc = b.st[0], nx = b.st[1];
        if (nloc == 0u) { xcd_barrier_complete(bar, b.x, nloc, nx); b.st[0] = nloc; b.st[1] = nx; }
        const unsigned old = xb_add(&bar[XB_XSUB(b.x)], 1u);
        const unsigned gen = old / nloc;
        if (old + 1u == (gen + 1u) * nloc) {
            __builtin_amdgcn_fence(__ATOMIC_RELEASE, "agent");
            asm volatile("s_waitcnt vmcnt(0)" ::: "memory");
            const unsigned og = xb_add(&bar[XB_TOP], 1u);
            const unsigned tg = og / nx;
            if (og + 1u == (tg + 1u) * nx) xb_add(&bar[XB_TOPGEN], 1u);
            else XB_SPIN(xb_ld(&bar[XB_TOPGEN]) == tg, bar);
            __builtin_amdgcn_fence(__ATOMIC_ACQUIRE, "agent");
            xb_add(&bar[XB_XGEN(b.x)], 1u);
            asm volatile("s_waitcnt vmcnt(0)" ::: "memory");
        } else {
            XB_SPIN(xb_ld(&bar[XB_XGEN(b.x)]) == gen, bar);
            __builtin_amdgcn_fence(__ATOMIC_ACQUIRE, "agent");
            asm volatile("s_waitcnt vmcnt(0)" ::: "memory");
        }
    }
    __syncthreads();
}

struct Frame {
    LAS unsigned char* lds;
    unsigned* ctl;
    int tid, lane, wave, G, bid;
    const float* const* in; const float* const* in0;
    float* out;
    unsigned char* ws; unsigned char* ws0;
};
#define WSP(T, off) ((T*)(F.ws + (off)))
#define REFRESH_TID(F) do { int t_ = threadIdx.x; asm volatile("" : "+v"(t_)); F.tid = t_; F.lane = t_ & 63; \
    int z_ = 0; asm volatile("s_mov_b32 %0, 0" : "=s"(z_)); F.ws = F.ws0 + z_; F.in = F.in0 + z_; F.bid = (int)blockIdx.x + z_; } while (0)
#define I_X 0
#define I_C 1
#define I_CTX 2
#define I_CCTX 3
#define I_WMOD 4
#define I_BMOD 5
#define I_G1 6
#define I_G2 7
#define I_WIN 8
#define I_AGQ 9
#define I_AGK 10
#define I_BCW 11
#define I_BCB 12
#define I_BLAM 13
#define I_BWR 14
#define I_BBR 15
#define I_BWI 16
#define I_BBI 17
#define I_CCW 18
#define I_CALOG 19
#define I_CDTB 20
#define I_CGOUT 21
#define I_RPB 22
#define I_WBR 23
#define I_WOUT 24
#define I_WRT 25
#define I_BRT 26
#define I_WGU 27
#define I_BGU 28
#define I_WDN 29
#define I_BDN 30
#define I_GFIN 31

__device__ __forceinline__ int mod_row(int r) { return r < TLAT ? (r >> 12) : 4; }

__device__ __forceinline__ void p0_transpose_item(const float* W, size_t pitch, int K, bf16* WT, int drow0, int scol0, int k0, LAS float* scr, int lane) {
    float v[32];
#pragma unroll
    for (int i = 0; i < 32; ++i) { const int kk = 2 * i + (lane >> 5); v[i] = W[(size_t)(k0 + kk) * pitch + scol0 + (lane & 31)]; }
#pragma unroll
    for (int i = 0; i < 32; ++i) { const int kk = 2 * i + (lane >> 5); scr[kk * 33 + (lane & 31)] = v[i]; }
    asm volatile("s_waitcnt lgkmcnt(0)" ::: "memory");
    const int c = lane & 7;
#pragma unroll
    for (int j = 0; j < 4; ++j) { const int n = (lane >> 3) + 8 * j; const LAS float* s = scr + (8 * c) * 33 + n;
        v4u o; o.x = pk2(s[0 * 33], s[1 * 33]); o.y = pk2(s[2 * 33], s[3 * 33]); o.z = pk2(s[4 * 33], s[5 * 33]); o.w = pk2(s[6 * 33], s[7 * 33]);
        *(v4u*)(WT + (size_t)(drow0 + n) * K + k0 + 8 * c) = o; }
    asm volatile("s_waitcnt lgkmcnt(0)" ::: "memory");
}

__device__ __forceinline__ void p0_prologue(Frame& F) {
    LAS float* scr = (LAS float*)(F.lds + F.wave * 16384);
    const int gw = F.bid * NWAVES + F.wave, NGW = F.G * NWAVES;
    constexpr int I_IN = DEPTH * 16 * (UW / 32);
    constexpr int I_BR = DEPTH * 4 * 8 * 32;
    constexpr int I_OUT = DEPTH * 16 * 32;
    constexpr int I_GU = DEPTH * NEXP * 16 * 64;
    constexpr int I_DN = DEPTH * NEXP * 16 * 32;
    constexpr int NITEMS = I_IN + I_BR + I_OUT + I_GU + I_DN;
    for (int it = gw; it < NITEMS; it += NGW) {
        int r = it;
        if (r < I_IN) { const int l = r / (16 * 296), q = r % (16 * 296), kb = q / 296, nb = q % 296; const int n0 = nb * 32, sc = n0 < 3840 ? n0 : n0 + 16;
            p0_transpose_item(F.in[I_WIN] + (size_t)l * D * INW, INW, D, WSP(bf16, WS_WIN) + (size_t)l * UW * D, n0, sc, kb * 64, scr, F.lane); continue; }
        r -= I_IN;
        if (r < I_BR) { const int mi = r / 256, q = r % 256, kb = q / 32, nb = q % 32;
            p0_transpose_item(F.in[I_WBR] + (size_t)mi * 512 * 1024, 1024, 512, WSP(bf16, WS_WBR) + (size_t)mi * 1024 * 512, nb * 32, nb * 32, kb * 64, scr, F.lane); continue; }
        r -= I_BR;
        if (r < I_OUT) { const int l = r / 512, q = r % 512, kb = q / 32, nb = q % 32;
            p0_transpose_item(F.in[I_WOUT] + (size_t)l * D * D, D, D, WSP(bf16, WS_WOUT) + (size_t)l * D * D, nb * 32, nb * 32, kb * 64, scr, F.lane); continue; }
        r -= I_OUT;
        if (r < I_GU) { const int mi = r / 1024, q = r % 1024, kb = q / 64, nb = q % 64; const int j0 = nb * 32, pn = j0 >> 8, bj = (j0 >> 7) & 1, cc = j0 & 127;
            p0_transpose_item(F.in[I_WGU] + (size_t)mi * D * 2048, 2048, D, WSP(bf16, WS_WGU) + (size_t)mi * 2048 * D, j0, 1024 * bj + 128 * pn + cc, kb * 64, scr, F.lane); continue; }
        r -= I_GU;
        { const int mi = r / 512, q = r % 512, kb = q / 32, nb = q % 32;
            p0_transpose_item(F.in[I_WDN] + (size_t)mi * D * D, D, D, WSP(bf16, WS_WDN) + (size_t)mi * D * D, nb * 32, nb * 32, kb * 64, scr, F.lane); }
    }
    __syncthreads();
    {
        LAS float* sc = (LAS float*)F.lds;
        LAS float* part = sc + 5 * 1024;
        bool staged = false;
        for (int it = F.bid; it < DEPTH * 96; it += F.G) {
            if (!staged) {
                for (int i = F.tid; i < 5 * 1024; i += NT) { const int r = i >> 10, k = i & 1023; const float cv = r < 4 ? F.in[I_C][r * 1024 + k] : F.in[I_CCTX][k]; sc[i] = siluf_(cv); }
                __syncthreads(); staged = true;
            }
            const int l = it / 96, cg = it % 96, col = cg * 64 + F.lane;
            const float* wm = F.in[I_WMOD] + (size_t)l * D * 6144 + col;
            float a0 = 0.f, a1 = 0.f, a2 = 0.f, a3 = 0.f, a4 = 0.f;
            const int kb = F.wave * 128;
#pragma unroll 16
            for (int k = 0; k < 128; ++k) { const float w = wm[(size_t)(kb + k) * 6144];
                a0 += sc[kb + k] * w; a1 += sc[1024 + kb + k] * w; a2 += sc[2048 + kb + k] * w; a3 += sc[3072 + kb + k] * w; a4 += sc[4096 + kb + k] * w; }
            LAS float* pp = part + F.wave * 320 + F.lane;
            pp[0] = a0; pp[64] = a1; pp[128] = a2; pp[192] = a3; pp[256] = a4;
            __syncthreads();
            if (F.tid < 320) { const int r = F.tid >> 6, ln = F.tid & 63; float s = 0.f;
#pragma unroll
                for (int w = 0; w < 8; ++w) s += part[w * 320 + r * 64 + ln];
                const int cc = cg * 64 + ln;
                WSP(float, WS_MOD)[((size_t)l * 5 + r) * 6144 + cc] = s + F.in[I_BMOD][l * 6144 + cc]; }
            __syncthreads();
        }
    }
    if (F.bid == 0) {
        for (int i = F.tid; i < 1024; i += NT) { const int p = i >> 4, f = i & 15; const float inv = powf(10000.f, -(float)f / 16.f); const float ang = (float)p * inv;
            WSP(float, WS_ROPE)[i] = cosf(ang); WSP(float, WS_ROPE)[1024 + i] = sinf(ang); }
    }
    for (int i = F.bid * NT + F.tid; i < DEPTH * 2 * 2 * 8 * 4096; i += F.G * NT) {
        const int c = i & 63, d = (i >> 6) & 63, n = (i >> 12) & 7, gate = (i >> 15) & 1, ld = i >> 16;
        const float* src = gate ? F.in[I_BWI] : F.in[I_BWR];
        WSP(bf16, WS_LRUW)[i] = (bf16)f2bf(src[((size_t)ld * 8 + n) * 4096 + c * 64 + d]);
    }
}

template <int MODE>
__device__ __forceinline__ void norm_phase(Frame& F, int l) {
    LAS float* hs = (LAS float*)F.lds;
    LAS int* lcnt = (LAS int*)(F.lds + 65536);
    LAS int* lbase = lcnt + 32;
    const int ngroups = (MODE == 2 ? TLAT : MROWS) / 16;
    const float* modl = WSP(float, WS_MOD) + (size_t)l * 5 * 6144;
    for (int gi = F.bid; gi < ngroups; gi += F.G) {
        REFRESH_TID(F);
        if (MODE == 1) { if (F.tid < 32) lcnt[F.tid] = 0; }
#pragma unroll
        for (int i = 0; i < 2; ++i) {
            const int lr = 2 * F.wave + i, r = gi * 16 + lr, mr = mod_row(r);
            const float* xsrc;
            if (MODE == 0 && l == 0) xsrc = r < TLAT ? F.in[I_X] + (size_t)r * D : F.in[I_CTX] + (size_t)(r - TLAT) * D;
            else xsrc = WSP(float, WS_X) + (size_t)r * D;
            f32x4 v[4];
#pragma unroll
            for (int j = 0; j < 4; ++j) v[j] = *(const f32x4*)(xsrc + 4 * F.lane + 256 * j);
            if ((MODE == 0 && l > 0) || MODE == 2) {
                const int lp = MODE == 2 ? DEPTH - 1 : l - 1;
                const float* gt2 = WSP(float, WS_MOD) + ((size_t)lp * 5 + mr) * 6144 + 5120;
                f32x4 cb[4];
#pragma unroll
                for (int j = 0; j < 4; ++j) cb[j] = (f32x4){0.f, 0.f, 0.f, 0.f};
#pragma unroll
                for (int k = 0; k < 4; ++k) {
                    const int sr = WSP(int, WS_SROW)[r * 4 + k]; const float w = WSP(float, WS_SW)[r * 4 + k];
                    const bf16* yr = WSP(bf16, WS_YS) + (size_t)sr * D;
#pragma unroll
                    for (int j = 0; j < 4; ++j) { const v2u y = *(const v2u*)(yr + 4 * F.lane + 256 * j);
                        cb[j].x += w * bflo(y.x); cb[j].y += w * bfhi(y.x); cb[j].z += w * bflo(y.y); cb[j].w += w * bfhi(y.y); }
                }
#pragma unroll
                for (int j = 0; j < 4; ++j) { const f32x4 g = *(const f32x4*)(gt2 + 4 * F.lane + 256 * j); v[j] = v[j] + g * cb[j]; }
            }
            if (MODE == 0) {
#pragma unroll
                for (int j = 0; j < 4; ++j) *(f32x4*)(WSP(float, WS_X) + (size_t)r * D + 4 * F.lane + 256 * j) = v[j];
            }
            float ss = 0.f;
#pragma unroll
            for (int j = 0; j < 4; ++j) ss += (v[j].x * v[j].x + v[j].y * v[j].y) + (v[j].z * v[j].z + v[j].w * v[j].w);
            const float rstd = rsqrtf(wave_sum(ss) * (1.f / D) + EPS);
            if (MODE == 2) {
#pragma unroll
                for (int j = 0; j < 4; ++j) { const f32x4 g = *(const f32x4*)(F.in[I_GFIN] + 4 * F.lane + 256 * j);
                    *(f32x4*)(F.out + (size_t)r * D + 4 * F.lane + 256 * j) = v[j] * rstd * g; }
            } else {
                const float* gn = F.in[MODE == 0 ? I_G1 : I_G2] + l * D;
                const float* sh = modl + (size_t)mr * 6144 + (MODE == 0 ? 0 : 3072);
                const float* sc = sh + 1024;
#pragma unroll
                for (int j = 0; j < 4; ++j) { const int c0 = 4 * F.lane + 256 * j;
                    const f32x4 g = *(const f32x4*)(gn + c0), a = *(const f32x4*)(sh + c0), s = *(const f32x4*)(sc + c0);
                    const f32x4 h = (v[j] * rstd * g) * (s + 1.f) + a;
                    *(LAS f32x4*)(hs + lr * 1024 + c0) = h;
                    v2u o; o.x = pk2(h.x, h.y); o.y = pk2(h.z, h.w);
                    *(v2u*)(WSP(bf16, WS_H) + (size_t)r * D + c0) = o; }
            }
        }
        if (MODE == 2) continue;
        __syncthreads();
        LAS float* red = (LAS float*)(F.lds + 65536 + 256);
        {
            const int r16 = F.lane & 15, quad = F.lane >> 4, w = F.wave;
            const size_t stride = MODE == 0 ? (size_t)INW : (size_t)NEXP;
            const float* wp = (MODE == 0 ? F.in[I_WIN] + (size_t)l * D * INW + 3840 : F.in[I_WRT] + (size_t)l * D * NEXP) + (size_t)(128 * w + quad) * stride + r16;
            const LAS float* hp = hs + r16 * 1024 + 128 * w + quad;
            f32x4 acc0 = (f32x4){0.f, 0.f, 0.f, 0.f}, acc1 = acc0;
            float b0[32], b1[32];
#pragma unroll
            for (int s = 0; s < 32; ++s) { b0[s] = wp[(size_t)(4 * s) * stride]; if (MODE == 1) b1[s] = wp[(size_t)(4 * s) * stride + 16]; }
#pragma unroll
            for (int s = 0; s < 32; ++s) { const float av = hp[4 * s];
                acc0 = __builtin_amdgcn_mfma_f32_16x16x4f32(av, b0[s], acc0, 0, 0, 0);
                if (MODE == 1) acc1 = __builtin_amdgcn_mfma_f32_16x16x4f32(av, b1[s], acc1, 0, 0, 0); }
#pragma unroll
            for (int j = 0; j < 4; ++j) { red[(w * 16 + 4 * quad + j) * 32 + r16] = acc0[j]; if (MODE == 1) red[(w * 16 + 4 * quad + j) * 32 + 16 + r16] = acc1[j]; }
        }
        __syncthreads();
        if (MODE == 0) {
            if (F.tid < 256) {
                const int lr = F.tid >> 4, col = F.tid & 15;
                float sacc = 0.f;
#pragma unroll
                for (int w = 0; w < 8; ++w) sacc += red[(w * 16 + lr) * 32 + col];
                WSP(float, WS_CAB)[(size_t)(gi * 16 + lr) * 16 + col] = sacc;
            }
        } else {
            const int lr = F.tid >> 5, e = F.tid & 31, r = gi * 16 + lr;
            float sacc = 0.f;
#pragma unroll
            for (int w = 0; w < 8; ++w) sacc += red[(w * 16 + lr) * 32 + e];
            const float lg = sacc + F.in[I_BRT][l * NEXP + e];
            float tv0, tv1, tv2, tv3; int ti0, ti1, ti2, ti3; bool taken = false;
#define TOP1(TV, TI) do { float bv = taken ? -INFINITY : lg; int bi = e; \
                _Pragma("unroll") for (int off = 16; off >= 1; off >>= 1) { const float ov = __shfl_xor(bv, off); const int oi = __shfl_xor(bi, off); \
                    if (ov > bv || (ov == bv && oi < bi)) { bv = ov; bi = oi; } } \
                TV = bv; TI = bi; if (bi == e) taken = true; } while (0)
            TOP1(tv0, ti0); TOP1(tv1, ti1); TOP1(tv2, ti2); TOP1(tv3, ti3);
#undef TOP1
            const float e1 = __expf(tv1 - tv0), e2 = __expf(tv2 - tv0), e3 = __expf(tv3 - tv0);
            const float inv = 1.f / (1.f + e1 + e2 + e3);
            const int my_e = e == 0 ? ti0 : (e == 1 ? ti1 : (e == 2 ? ti2 : ti3));
            const float my_w = e == 0 ? inv : (e == 1 ? e1 * inv : (e == 2 ? e2 * inv : e3 * inv));
            int pl = 0;
            if (e < 4) pl = atomicAdd((int*)&lcnt[my_e], 1);
            __syncthreads();
            if (F.tid < 32) { const int c = lcnt[F.tid]; lbase[F.tid] = c > 0 ? (int)__hip_atomic_fetch_add(F.ctl + CW_CNT + l * 32 + F.tid, (unsigned)c, __ATOMIC_RELAXED, __HIP_MEMORY_SCOPE_AGENT) : 0; }
            __syncthreads();
            if (e < 4) { const int p = lbase[my_e] + pl;
                WSP(int, WS_LIST)[(size_t)my_e * MROWS + p] = r * 4 + e;
                WSP(int, WS_SEP)[r * 4 + e] = (my_e << 20) | p;
                WSP(float, WS_SW)[r * 4 + e] = my_w; }
        }
        __syncthreads();
    }
}

__device__ __forceinline__ void moe_table(Frame& F, int l) {
    LAS int* tpre = (LAS int*)(F.lds + MISC_OFF + 256);
    LAS int* cnt = tpre + 40;
    __syncthreads();
    if (F.tid < 32) cnt[F.tid] = (int)__hip_atomic_load(F.ctl + CW_CNT + l * 32 + F.tid, __ATOMIC_RELAXED, __HIP_MEMORY_SCOPE_AGENT);
    __syncthreads();
    if (F.tid == 0) { int s = 0; for (int e = 0; e < 32; ++e) { tpre[e] = s; s += (cnt[e] + 255) >> 8; } tpre[32] = s; }
    __syncthreads();
}
__device__ __forceinline__ void moe_gather(Frame& F, int l) {
    moe_table(F, l);
    const LAS int* tpre = (const LAS int*)(F.lds + MISC_OFF + 256);
    const LAS int* cnt = tpre + 40;
    const int gw = F.bid * NWAVES + F.wave, NGW = F.G * NWAVES;
    REFRESH_TID(F);
    for (int e = 0; e < NEXP; ++e) {
        const int n = cnt[e], base = tpre[e] * 256;
        for (int p = gw; p < n; p += NGW) {
            const int tk = WSP(int, WS_LIST)[(size_t)e * MROWS + p]; const int tok = tk >> 2;
            const v4u* src = (const v4u*)(WSP(bf16, WS_H) + (size_t)tok * D);
            v4u* dst = (v4u*)(WSP(bf16, WS_HS) + (size_t)(base + p) * D);
            dst[F.lane] = src[F.lane]; dst[F.lane + 64] = src[F.lane + 64];
            if (F.lane == 0) WSP(int, WS_SROW)[tk] = base + p;
        }
    }
}

constexpr int AT_KP = 72, AT_VP = 68;
constexpr int AT_KB = 64 * AT_KP * 2, AT_VB = 64 * AT_VP * 2, AT_BUF = AT_KB + AT_VB;
constexpr int AT_RPB = 2 * AT_BUF;

struct AttnUnit {
    int kind;
    int b, hx, qx;
};

__device__ __forceinline__ void attn_unit(Frame& F, int l, const AttnUnit un) {
    REFRESH_TID(F);
    const int lane = F.lane, w = F.wave, q32 = lane & 31, hh = lane >> 5;
    const bf16* U = WSP(bf16, WS_U);
    const bool na = (un.kind & 1) != 0, ctxq = un.kind >= 2;
    const int b = un.b;
    int qrow0, qcol, kcol, ycol, nlat, krow_lat0, r_grid = 0, c0 = 0, rs_w = 0;
    const bf16* vt; bf16* Y;
    if (!na) {
        const int head = 4 * un.hx + (w & 3);
        qrow0 = (ctxq ? TLAT + b * LCTX : b * SEQ) + 64 * un.qx + 32 * (w >> 2);
        qcol = UQ + head * 64; kcol = UK + un.hx * 64; ycol = head * 64;
        vt = WSP(bf16, WS_VAT) + (size_t)(b * 2 + un.hx) * 64 * KEYS;
        Y = WSP(bf16, WS_Y);
        nlat = ctxq ? 0 : 64; krow_lat0 = b * SEQ;
    } else {
        const int head = un.hx;
        if (ctxq) { qrow0 = TLAT + b * LCTX + 32 * w; nlat = 0; krow_lat0 = 0; }
        else {
            r_grid = 4 * un.qx + (w >> 1); c0 = 32 * (w & 1);
            qrow0 = b * SEQ + 64 * r_grid + c0;
            int rs_min = 4 * un.qx - 4; rs_min = rs_min < 0 ? 0 : (rs_min > 56 ? 56 : rs_min);
            int rs_max = 4 * un.qx + 3 - 4; rs_max = rs_max < 0 ? 0 : (rs_max > 56 ? 56 : rs_max);
            nlat = rs_max + 8 - rs_min; krow_lat0 = b * SEQ + 64 * rs_min;
            rs_w = r_grid - 4; rs_w = rs_w < 0 ? 0 : (rs_w > 56 ? 56 : rs_w);
            rs_w -= rs_min;
        }
        qcol = UDQ + head * 64; kcol = UDK + head * 64; ycol = head * 64;
        vt = WSP(bf16, WS_VDT) + (size_t)(b * 8 + head) * 64 * KEYS;
        Y = WSP(bf16, WS_Y) + (size_t)3 * MROWS * 512;
    }
    const int vkey_lat0 = krow_lat0 - b * SEQ;
    const int ntile = nlat + 4;
    LAS unsigned char* lds = F.lds;
    if (na && !ctxq) {
        LAS float* rp = (LAS float*)(lds + AT_RPB);
        const float* src = F.in[I_RPB] + ((size_t)l * 8 + un.hx) * 465;
        for (int i = F.tid; i < 465; i += NT) rp[i] = src[i] * LOG2E;
    }
    bf16x8 qf[4];
    {
        const bf16* qp = U + (size_t)(qrow0 + q32) * UW + qcol + 8 * hh;
#pragma unroll
        for (int s = 0; s < 4; ++s) qf[s] = *(const bf16x8*)(qp + 16 * s);
    }
    const int lk = F.tid >> 3, lc = F.tid & 7;
    v4u kreg, vreg;
#define AT_LOAD(i) do { const int i_ = (i); int krow0_, vkey0_; \
        if (i_ < nlat) { krow0_ = krow_lat0 + 64 * i_; vkey0_ = vkey_lat0 + 64 * i_; } else { krow0_ = TLAT + b * LCTX + 64 * (i_ - nlat); vkey0_ = SEQ + 64 * (i_ - nlat); } \
        kreg = *(const v4u*)(U + (size_t)(krow0_ + lk) * UW + kcol + lc * 8); \
        vreg = *(const v4u*)(vt + (size_t)lk * KEYS + vkey0_ + lc * 8); } while (0)
#define AT_STORE(buf) do { LAS unsigned char* b_ = lds + (buf) * AT_BUF; \
        *(LAS v4u*)(b_ + lk * (AT_KP * 2) + lc * 16) = kreg; \
        *(LAS v2u*)(b_ + AT_KB + lk * (AT_VP * 2) + lc * 16) = (v2u){vreg.x, vreg.y}; \
        *(LAS v2u*)(b_ + AT_KB + lk * (AT_VP * 2) + lc * 16 + 8) = (v2u){vreg.z, vreg.w}; } while (0)
    float m_run = -1e30f, l_run = 0.f;
    f32x16 o0, o1;
#pragma unroll
    for (int i = 0; i < 16; ++i) { o0[i] = 0.f; o1[i] = 0.f; }
    const float sscale = 0.125f * LOG2E;
    const int cq = c0 + q32;
    int cst = cq - 8; cst = cst < 0 ? 0 : (cst > 48 ? 48 : cst);
    AT_LOAD(0);
    for (int i = 0; i < ntile; ++i) {
        AT_STORE(i & 1);
        if (i + 1 < ntile) AT_LOAD(i + 1);
        __syncthreads();
        const bool lat_na = na && !ctxq && i < nlat;
        if (lat_na && (i < rs_w || i > rs_w + 7)) continue;
        const LAS unsigned char* kb = lds + (i & 1) * AT_BUF;
        const LAS unsigned char* vb = kb + AT_KB;
        f32x16 s0, s1;
#pragma unroll
        for (int j = 0; j < 16; ++j) { s0[j] = 0.f; s1[j] = 0.f; }
#pragma unroll
        for (int s = 0; s < 4; ++s) {
            const bf16x8 k0 = *(const LAS bf16x8*)(kb + (q32) * (AT_KP * 2) + (16 * s + 8 * hh) * 2);
            const bf16x8 k1 = *(const LAS bf16x8*)(kb + (32 + q32) * (AT_KP * 2) + (16 * s + 8 * hh) * 2);
            s0 = __builtin_amdgcn_mfma_f32_32x32x16_bf16(k0, qf[s], s0, 0, 0, 0);
            s1 = __builtin_amdgcn_mfma_f32_32x32x16_bf16(k1, qf[s], s1, 0, 0, 0);
        }
        if (lat_na) {
            const LAS float* rp = (const LAS float*)(lds + AT_RPB);
            const int kr = (krow_lat0 - b * SEQ) / 64 + i;
            const int rb = (kr - r_grid + 7) * 31 + 15 - cq;
#pragma unroll
            for (int j = 0; j < 16; ++j) {
                const int kc0 = (j & 3) + 8 * (j >> 2) + 4 * hh, kc1 = kc0 + 32;
                const bool ok0 = kc0 >= cst && kc0 < cst + 16, ok1 = kc1 >= cst && kc1 < cst + 16;
                s0[j] = ok0 ? s0[j] * sscale + rp[ok0 ? rb + kc0 : 0] : -1e30f;
                s1[j] = ok1 ? s1[j] * sscale + rp[ok1 ? rb + kc1 : 0] : -1e30f;
            }
        } else if (na) {
#pragma unroll
            for (int j = 0; j < 16; ++j) { s0[j] *= sscale; s1[j] *= sscale; }
        }
        float mx = fmaxf(s0[0], s1[0]);
#pragma unroll
        for (int j = 1; j < 16; ++j) mx = fmaxf(mx, fmaxf(s0[j], s1[j]));
        mx = fmaxf(mx, __shfl_xor(mx, 32));
        const float m_new = fmaxf(m_run, mx);
        if (__builtin_amdgcn_ballot_w64(m_new > m_run) != 0ull) {
            const float alpha = __builtin_amdgcn_exp2f(m_run - m_new);
            l_run *= alpha;
#pragma unroll
            for (int j = 0; j < 16; ++j) { o0[j] *= alpha; o1[j] *= alpha; }
            m_run = m_new;
        }
        float ps = 0.f;
#pragma unroll
        for (int j = 0; j < 16; ++j) { s0[j] = __builtin_amdgcn_exp2f(s0[j] - m_run); s1[j] = __builtin_amdgcn_exp2f(s1[j] - m_run); ps += s0[j] + s1[j]; }
        l_run += ps;
        bf16x8 pb[2][2];
#pragma unroll
        for (int s2 = 0; s2 < 2; ++s2) {
            v4u t0, t1;
            t0.x = pk2(s0[8 * s2 + 0], s0[8 * s2 + 1]); t0.y = pk2(s0[8 * s2 + 2], s0[8 * s2 + 3]); t0.z = pk2(s0[8 * s2 + 4], s0[8 * s2 + 5]); t0.w = pk2(s0[8 * s2 + 6], s0[8 * s2 + 7]);
            t1.x = pk2(s1[8 * s2 + 0], s1[8 * s2 + 1]); t1.y = pk2(s1[8 * s2 + 2], s1[8 * s2 + 3]); t1.z = pk2(s1[8 * s2 + 4], s1[8 * s2 + 5]); t1.w = pk2(s1[8 * s2 + 6], s1[8 * s2 + 7]);
            pb[0][s2] = __builtin_bit_cast(bf16x8, t0); pb[1][s2] = __builtin_bit_cast(bf16x8, t1);
        }
#pragma unroll
        for (int sub = 0; sub < 2; ++sub)
#pragma unroll
            for (int s2 = 0; s2 < 2; ++s2) {
                const int ko = (32 * sub + 16 * s2 + 4 * hh) * 2;
                const v2u a0 = *(const LAS v2u*)(vb + (q32) * (AT_VP * 2) + ko), a1 = *(const LAS v2u*)(vb + (q32) * (AT_VP * 2) + ko + 16);
                const v2u c0_ = *(const LAS v2u*)(vb + (32 + q32) * (AT_VP * 2) + ko), c1_ = *(const LAS v2u*)(vb + (32 + q32) * (AT_VP * 2) + ko + 16);
                const bf16x8 vf0 = __builtin_bit_cast(bf16x8, ((v4u){a0.x, a0.y, a1.x, a1.y}));
                const bf16x8 vf1 = __builtin_bit_cast(bf16x8, ((v4u){c0_.x, c0_.y, c1_.x, c1_.y}));
                o0 = __builtin_amdgcn_mfma_f32_32x32x16_bf16(vf0, pb[sub][s2], o0, 0, 0, 0);
                o1 = __builtin_amdgcn_mfma_f32_32x32x16_bf16(vf1, pb[sub][s2], o1, 0, 0, 0);
            }
    }
#undef AT_LOAD
#undef AT_STORE
    const float lt = l_run + __shfl_xor(l_run, 32);
    const float inv = 1.f / lt;
    bf16* yp = Y + (size_t)(qrow0 + q32) * 512 + ycol + 4 * hh;
#pragma unroll
    for (int g = 0; g < 4; ++g) {
        v2u a; a.x = pk2(o0[4 * g] * inv, o0[4 * g + 1] * inv); a.y = pk2(o0[4 * g + 2] * inv, o0[4 * g + 3] * inv);
        v2u c; c.x = pk2(o1[4 * g] * inv, o1[4 * g + 1] * inv); c.y = pk2(o1[4 * g + 2] * inv, o1[4 * g + 3] * inv);
        *(v2u*)(yp + 8 * g) = a; *(v2u*)(yp + 32 + 8 * g) = c;
    }
    __syncthreads();
}

__device__ __forceinline__ void attn_phase(Frame& F, int l) {
    for (int L = F.bid; L < 1088; L += F.G) {
        AttnUnit un;
        if (L < 512) { un.kind = 0; un.b = L >> 7; un.hx = (L >> 6) & 1; un.qx = L & 63; }
        else if (L < 1024) { const int q = L - 512; un.kind = 1; un.b = q >> 7; un.hx = (q >> 4) & 7; un.qx = q & 15; }
        else if (L < 1056) { const int q = L - 1024; un.kind = 2; un.b = q >> 3; un.hx = (q >> 2) & 1; un.qx = q & 3; }
        else { const int q = L - 1056; un.kind = 3; un.b = q >> 3; un.hx = q & 7; un.qx = 0; }
        attn_unit(F, l, un);
    }
}

__device__ __forceinline__ void qk_prep(Frame& F, int l) {
    REFRESH_TID(F);
    const int gw = F.bid * NWAVES + F.wave, NGW = F.G * NWAVES, lane = F.lane;
    bf16* U = WSP(bf16, WS_U);
    const float* tab = WSP(float, WS_ROPE);
    const float gq = F.in[I_AGQ][l * 64 + lane], gk = F.in[I_AGK][l * 64 + lane];
    for (int r = gw; r < MROWS; r += NGW) {
        const bool lat = r < TLAT;
        float cs = 1.f, sn = 0.f;
        if (lat) { const int t = r & 4095, i = lane & 31; const int idx = i < 16 ? (t >> 6) * 16 + i : (t & 63) * 16 + (i - 16); cs = tab[idx]; sn = tab[1024 + idx]; }
        bf16* up = U + (size_t)r * UW + lane;
        float xv[10];
#pragma unroll
        for (int hd = 0; hd < 10; ++hd) xv[hd] = bf2f(up[hd < 8 ? UQ + hd * 64 : UK + (hd - 8) * 64]);
#pragma unroll
        for (int hd = 0; hd < 10; ++hd) {
            const float x = xv[hd];
            const float ss = wave_sum(x * x);
            float y = x * rsqrtf(ss * (1.f / 64.f) + EPS) * (hd < 8 ? gq : gk);
            const float p = __shfl_xor(y, 32);
            if (lat) y = lane < 32 ? y * cs - p * sn : y * cs + p * sn;
            if (hd < 8) y *= 0.125f * LOG2E;
            up[hd < 8 ? UQ + hd * 64 : UK + (hd - 8) * 64] = (bf16)f2bf(y);
        }
    }
}

__device__ __forceinline__ void v_transpose(Frame& F) {
    REFRESH_TID(F);
    const int gw = F.bid * NWAVES + F.wave, NGW = F.G * NWAVES, lane = F.lane;
    LAS bf16* T = (LAS bf16*)(F.lds + F.wave * 9216);
    const bf16* U = WSP(bf16, WS_U);
    for (int it = gw; it < NCHUNK * 10; it += NGW) {
        const int g = it / 10, hd = it % 10;
        int b, key0;
        if (g < 256) { b = g >> 6; key0 = (g & 63) * 64; } else { b = (g - 256) >> 2; key0 = SEQ + ((g - 256) & 3) * 64; }
        const int scol = hd < 2 ? UV + hd * 64 : UDV + (hd - 2) * 64;
        bf16* dst = hd < 2 ? WSP(bf16, WS_VAT) + (size_t)(b * 2 + hd) * 64 * KEYS : WSP(bf16, WS_VDT) + (size_t)(b * 8 + hd - 2) * 64 * KEYS;
        v4u rv[8];
#pragma unroll
        for (int i = 0; i < 8; ++i) { const int tok = 8 * i + (lane >> 3), ch = lane & 7; rv[i] = *(const v4u*)(U + (size_t)(64 * g + tok) * UW + scol + ch * 8); }
#pragma unroll
        for (int i = 0; i < 8; ++i) { const int tok = 8 * i + (lane >> 3), ch = lane & 7; const unsigned wv[4] = {rv[i].x, rv[i].y, rv[i].z, rv[i].w};
#pragma unroll
            for (int j = 0; j < 4; ++j) { T[(ch * 8 + 2 * j) * 72 + tok] = (bf16)(wv[j] & 0xffffu); T[(ch * 8 + 2 * j + 1) * 72 + tok] = (bf16)(wv[j] >> 16); } }
        asm volatile("s_waitcnt lgkmcnt(0)" ::: "memory");
#pragma unroll
        for (int i = 0; i < 8; ++i) { const int d = 8 * i + (lane >> 3), ch = lane & 7;
            const v4u o = *(const LAS v4u*)(T + d * 72 + ch * 8);
            *(v4u*)(dst + (size_t)d * KEYS + key0 + ch * 8) = o; }
        asm volatile("s_waitcnt lgkmcnt(0)" ::: "memory");
    }
}

constexpr int LR_XCB = 0, LR_WV = 17408, LR_WVB = 12288;
__device__ __forceinline__ void seq_bounds(int g, int& lo, int& hi) {
    if (g < 256) { lo = (g >> 6) * SEQ; hi = lo + SEQ; } else { lo = TLAT + ((g - 256) >> 2) * LCTX; hi = lo + LCTX; }
}
__device__ __forceinline__ void lru_stage_conv(Frame& F, int l, int g, int q) {
    LAS bf16* raw = (LAS bf16*)(F.lds + LR_WV);
    LAS bf16* xcb = (LAS bf16*)(F.lds + LR_XCB);
    const bf16* U = WSP(bf16, WS_U);
    int lo, hi; seq_bounds(g, lo, hi);
    __syncthreads();
    for (int i = F.tid; i < 67 * 16; i += NT) { const int rr = i >> 4, ch = i & 15, row = 64 * g - 1 + rr;
        v4u v = (v4u){0u, 0u, 0u, 0u};
        if (row >= lo && row < hi) v = *(const v4u*)(U + (size_t)row * UW + UBX + 128 * q + ch * 8);
        *(LAS v4u*)(raw + rr * 128 + ch * 8) = v; }
    __syncthreads();
    {
        const int ch = F.tid & 127, tg = F.tid >> 7, cabs = 128 * q + ch;
        const float* cw = F.in[I_BCW] + (size_t)l * 4 * 512 + cabs;
        const float w0 = cw[0], w1 = cw[512], w2 = cw[1024], w3 = cw[1536], bb = F.in[I_BCB][l * 512 + cabs];
        float x0 = bf2f(raw[(16 * tg) * 128 + ch]), x1 = bf2f(raw[(16 * tg + 1) * 128 + ch]), x2 = bf2f(raw[(16 * tg + 2) * 128 + ch]);
#pragma unroll
        for (int t = 0; t < 16; ++t) { const float x3 = bf2f(raw[(16 * tg + t + 3) * 128 + ch]);
            const float y = bb + w0 * x0 + w1 * x1 + w2 * x2 + w3 * x3;
            xcb[(16 * tg + t) * 136 + ch] = (bf16)f2bf(y);
            x0 = x1; x1 = x2; x2 = x3; }
    }
    __syncthreads();
}
__device__ __forceinline__ void lru_gates(Frame& F, int l, int dir, int q) {
    const int lane = F.lane, w = F.wave, r16 = lane & 15, quad = lane >> 4;
    const LAS bf16* xcb = (const LAS bf16*)(F.lds + LR_XCB);
    LAS float* sa = (LAS float*)(F.lds + LR_WV + w * LR_WVB);
    LAS float* sb = sa + 1024;
    const int nbl = w >> 2, dt = w & 3, nb = 2 * q + nbl;
    const bf16* wr = WSP(bf16, WS_LRUW) + ((((size_t)(l * 2 + dir) * 2 + 0) * 8 + nb) * 64 + 16 * dt + r16) * 64 + 8 * quad;
    const bf16* wi = WSP(bf16, WS_LRUW) + ((((size_t)(l * 2 + dir) * 2 + 1) * 8 + nb) * 64 + 16 * dt + r16) * 64 + 8 * quad;
    const bf16x8 br0 = *(const bf16x8*)wr, br1 = *(const bf16x8*)(wr + 32), bi0 = *(const bf16x8*)wi, bi1 = *(const bf16x8*)(wi + 32);
    const int cabs = 64 * nb + 16 * dt + r16, cl = 64 * nbl + 16 * dt + r16;
    const float bR = F.in[I_BBR][(l * 2 + dir) * 512 + cabs], bI = F.in[I_BBI][(l * 2 + dir) * 512 + cabs];
    const float sp = softplusf_(-F.in[I_BLAM][(l * 2 + dir) * 512 + cabs]);
#pragma unroll
    for (int tt = 0; tt < 4; ++tt) {
        const LAS bf16* ap = xcb + (16 * tt + r16) * 136 + 64 * nbl + 8 * quad;
        const bf16x8 a0 = *(const LAS bf16x8*)ap, a1 = *(const LAS bf16x8*)(ap + 32);
        f32x4 ar = (f32x4){0.f, 0.f, 0.f, 0.f}, ai = ar;
        ar = __builtin_amdgcn_mfma_f32_16x16x32_bf16(a0, br0, ar, 0, 0, 0); ar = __builtin_amdgcn_mfma_f32_16x16x32_bf16(a1, br1, ar, 0, 0, 0);
        ai = __builtin_amdgcn_mfma_f32_16x16x32_bf16(a0, bi0, ai, 0, 0, 0); ai = __builtin_amdgcn_mfma_f32_16x16x32_bf16(a1, bi1, ai, 0, 0, 0);
#pragma unroll
        for (int j = 0; j < 4; ++j) { const int t = 16 * tt + 4 * quad + j;
            const float rg = sigmoidf_(ar[j] + bR), ig = sigmoidf_(ai[j] + bI);
            const float la = -8.f * rg * sp;
            const float a = __expf(la), mult = sqrtf(-expm1f(2.f * la));
            const float xv = bf2f(xcb[t * 136 + cl]);
            sa[t * 16 + r16] = a; sb[t * 16 + r16] = mult * ig * xv; }
    }
    asm volatile("s_waitcnt lgkmcnt(0)" ::: "memory");
}
__device__ __forceinline__ void lru_pass1(Frame& F, int l) {
#pragma unroll 1
    for (int it = F.bid; it < NCHUNK * 4; it += F.G) {
        REFRESH_TID(F);
        const int g = it >> 2, q = it & 3;
        lru_stage_conv(F, l, g, q);
#pragma unroll 1
        for (int dir = 0; dir < 2; ++dir) {
            lru_gates(F, l, dir, q);
            const int lane = F.lane, w = F.wave, ch = lane & 15, seg = lane >> 4;
            const LAS float* sa = (const LAS float*)(F.lds + LR_WV + w * LR_WVB); const LAS float* sb = sa + 1024;
            float A = 1.f, B = 0.f;
#pragma unroll
            for (int k = 0; k < 16; ++k) { const int tp = 16 * seg + k, t = dir ? 63 - tp : tp; const float a = sa[t * 16 + ch]; B = a * B + sb[t * 16 + ch]; A *= a; }
            float At = 1.f, Bt = 0.f;
#pragma unroll
            for (int s = 0; s < 4; ++s) { const float As = __shfl(A, 16 * s + ch), Bs = __shfl(B, 16 * s + ch); Bt = As * Bt + Bs; At *= As; }
            if (seg == 0) { const int cabs = 128 * q + 64 * (w >> 2) + 16 * (w & 3) + ch;
                WSP(float, WS_LRA)[((size_t)g * 2 + dir) * 512 + cabs] = At; WSP(float, WS_LRB)[((size_t)g * 2 + dir) * 512 + cabs] = Bt; }
            asm volatile("s_waitcnt lgkmcnt(0)" ::: "memory");
        }
    }
}
__device__ __forceinline__ void lru_carry_all(Frame& F) {
    REFRESH_TID(F);
    if (F.tid >= 16) return;
    const float* LA = WSP(float, WS_LRA); const float* LB = WSP(float, WS_LRB); float* LC = WSP(float, WS_LRC);
    for (int chain = F.bid * 16 + F.tid; chain < 4096; chain += F.G * 16) {
        const int ch = chain & 511, dir = (chain >> 9) & 1, b = chain >> 10;
        float h = 0.f;
#pragma unroll 1
        for (int sb = 0; sb < 4; ++sb) {
            float av[17], bv[17]; size_t ix[17];
#pragma unroll
            for (int k = 0; k < 17; ++k) { const int s = sb * 17 + k; int g;
                if (s < 4) g = 256 + 4 * b + (dir ? 3 - s : s); else g = 64 * b + (dir ? 63 - (s - 4) : (s - 4));
                ix[k] = ((size_t)g * 2 + dir) * 512 + ch; av[k] = LA[ix[k]]; bv[k] = LB[ix[k]]; }
#pragma unroll
            for (int k = 0; k < 17; ++k) { LC[ix[k]] = h; h = av[k] * h + bv[k]; }
        }
    }
}
__device__ __forceinline__ float gelu_tanh(float x) { const float u = 0.7978845608028654f * (x + 0.044715f * x * x * x); return 0.5f * x * (1.f + tanhf(u)); }
__device__ __forceinline__ void lru_pass2(Frame& F, int l) {
#pragma unroll 1
    for (int it = F.bid; it < NCHUNK * 4; it += F.G) {
        REFRESH_TID(F);
        const int g = it >> 2, q = it & 3;
        lru_stage_conv(F, l, g, q);
        const int lane = F.lane, w = F.wave, ch = lane & 15, seg = lane >> 4;
        LAS float* sa = (LAS float*)(F.lds + LR_WV + w * LR_WVB); LAS float* sb = sa + 1024; LAS float* sh = sa + 2048;
        const int cabs = 128 * q + 64 * (w >> 2) + 16 * (w & 3) + ch;
#pragma unroll 1
        for (int dir = 0; dir < 2; ++dir) {
            lru_gates(F, l, dir, q);
            float A = 1.f, B = 0.f;
#pragma unroll
            for (int k = 0; k < 16; ++k) { const int tp = 16 * seg + k, t = dir ? 63 - tp : tp; const float a = sa[t * 16 + ch]; B = a * B + sb[t * 16 + ch]; A *= a; }
            float h = WSP(float, WS_LRC)[((size_t)g * 2 + dir) * 512 + cabs];
#pragma unroll
            for (int s = 0; s < 3; ++s) { const float As = __shfl(A, 16 * s + ch), Bs = __shfl(B, 16 * s + ch); if (s < seg) h = As * h + Bs; }
#pragma unroll
            for (int k = 0; k < 16; ++k) { const int tp = 16 * seg + k, t = dir ? 63 - tp : tp; h = sa[t * 16 + ch] * h + sb[t * 16 + ch];
                if (dir == 0) sh[t * 16 + ch] = h; else sh[t * 16 + ch] += h; }
            asm volatile("s_waitcnt lgkmcnt(0)" ::: "memory");
        }
        const bf16* U = WSP(bf16, WS_U); bf16* YB = WSP(bf16, WS_Y) + (size_t)1 * MROWS * 512;
#pragma unroll
        for (int k = 0; k < 16; ++k) { const int t = 16 * seg + k; const size_t row = (size_t)64 * g + t;
            const float yv = bf2f(U[row * UW + UBY + cabs]);
            YB[row * 512 + cabs] = (bf16)f2bf(sh[t * 16 + ch] * gelu_tanh(yv)); }
        asm volatile("s_waitcnt lgkmcnt(0)" ::: "memory");
    }
}

#ifndef GDN_PREP_REPS
#define GDN_PREP_REPS 1
#endif
constexpr int GD_Q = 0, GD_K = 17408, GD_V = 34816, GD_KK = 52224, GD_QK = 68864, GD_L = 85504, GD_SM = 118272;
__device__ __forceinline__ void gdn_prep(Frame& F, int l) {
    const bf16* U = WSP(bf16, WS_U);
    const int w = F.wave;
#pragma unroll 1
    for (int it0 = F.bid; it0 < NCHUNK * 4 * GDN_PREP_REPS; it0 += F.G) {
        const int it = it0 % (NCHUNK * 4);
        int tid = F.tid; asm volatile("" : "+v"(tid));
        const int lane = tid & 63, r16 = lane & 15, quad = lane >> 4;
        const int g = it >> 2, h = it & 3;
        int lo, hi; seq_bounds(g, lo, hi);
        LAS bf16* raw = (LAS bf16*)(F.lds + GD_KK);
#pragma unroll 1
        for (int ten = 0; ten < 3; ++ten) {
            const int ucol = (ten == 0 ? UCQ : (ten == 1 ? UCK : UCV)) + 128 * h;
            __syncthreads();
            for (int i = tid; i < 67 * 16; i += NT) { const int rr = i >> 4, ch = i & 15, row = 64 * g - 1 + rr;
                v4u v = (v4u){0u, 0u, 0u, 0u};
                if (row >= lo && row < hi) v = *(const v4u*)(U + (size_t)row * UW + ucol + ch * 8);
                *(LAS v4u*)(raw + rr * 128 + ch * 8) = v; }
            __syncthreads();
            const int t = tid >> 3, ds = tid & 7;
            const float* cw = F.in[I_CCW] + (size_t)l * 4 * 1536 + ten * 512 + 128 * h + 16 * ds;
            float y[16]; float ss = 0.f;
#pragma unroll
            for (int jj = 0; jj < 16; ++jj) {
                float a = 0.f;
#pragma unroll
                for (int j = 0; j < 4; ++j) a += cw[j * 1536 + jj] * bf2f(raw[(t + j) * 128 + 16 * ds + jj]);
                a = siluf_(a); y[jj] = a; ss += a * a;
            }
            float sc = 1.f;
            if (ten < 2) { ss += __shfl_xor(ss, 1); ss += __shfl_xor(ss, 2); ss += __shfl_xor(ss, 4); sc = rsqrtf(ss + EPS); if (ten == 0) sc *= 0.08838834764831845f; }
            LAS bf16* dstp = (LAS bf16*)(F.lds + (ten == 0 ? GD_Q : (ten == 1 ? GD_K : GD_V))) + t * 136 + 16 * ds;
            v4u o0, o1;
            o0.x = pk2(y[0] * sc, y[1] * sc); o0.y = pk2(y[2] * sc, y[3] * sc); o0.z = pk2(y[4] * sc, y[5] * sc); o0.w = pk2(y[6] * sc, y[7] * sc);
            o1.x = pk2(y[8] * sc, y[9] * sc); o1.y = pk2(y[10] * sc, y[11] * sc); o1.z = pk2(y[12] * sc, y[13] * sc); o1.w = pk2(y[14] * sc, y[15] * sc);
            *(LAS v4u*)dstp = o0; *(LAS v4u*)(dstp + 8) = o1;
        }
        __syncthreads();
        const LAS bf16* qs = (const LAS bf16*)(F.lds + GD_Q); const LAS bf16* ks = (const LAS bf16*)(F.lds + GD_K); const LAS bf16* vs = (const LAS bf16*)(F.lds + GD_V);
        {
            const int mat = w >> 2, rt = w & 3;
            const LAS bf16* As = mat ? qs : ks;
            LAS float* Out = (LAS float*)(F.lds + (mat ? GD_QK : GD_KK));
            bf16x8 af[4];
#pragma unroll
            for (int s = 0; s < 4; ++s) af[s] = *(const LAS bf16x8*)(As + (16 * rt + r16) * 136 + 32 * s + 8 * quad);
#pragma unroll
            for (int ct = 0; ct < 4; ++ct) {
                f32x4 acc = (f32x4){0.f, 0.f, 0.f, 0.f};
#pragma unroll
                for (int s = 0; s < 4; ++s) { const bf16x8 bfr = *(const LAS bf16x8*)(ks + (16 * ct + r16) * 136 + 32 * s + 8 * quad);
                    acc = __builtin_amdgcn_mfma_f32_16x16x32_bf16(af[s], bfr, acc, 0, 0, 0); }
#pragma unroll
                for (int j = 0; j < 4; ++j) Out[(16 * rt + 4 * quad + j) * 65 + 16 * ct + r16] = acc[j];
            }
        }
        int tid2 = F.tid; asm volatile("" : "+v"(tid2));
        const int dir = tid2 >> 8, dt = tid2 & 255;
        LAS float* sm = (LAS float*)(F.lds + GD_SM) + dir * 256;
        if (dt < 64) {
            const int ti = dir ? 63 - dt : dt; const size_t row = (size_t)64 * g + ti;
            const float ga = WSP(float, WS_CAB)[row * 16 + dir * 4 + h], gb = WSP(float, WS_CAB)[row * 16 + 8 + dir * 4 + h];
            const float gv = -__expf(F.in[I_CALOG][(l * 2 + dir) * 4 + h]) * softplusf_(ga + F.in[I_CDTB][(l * 2 + dir) * 4 + h]);
            float v = gv;
#pragma unroll
            for (int off = 1; off < 64; off <<= 1) { const float u = __shfl_up(v, off); if (lane >= off) v += u; }
            sm[dt] = gv; sm[64 + dt] = sigmoidf_(gb); sm[128 + dt] = v; sm[192 + dt] = __expf(v);
        }
        __syncthreads();
        const size_t cd = ((size_t)g * 4 + h) * 2 + dir;
        const LAS float* KK = (const LAS float*)(F.lds + GD_KK); const LAS float* QKm = (const LAS float*)(F.lds + GD_QK);
        LAS float* Ls = (LAS float*)(F.lds + GD_L) + dir * 4096;
        {
            bf16* gqk = WSP(bf16, WS_GQK) + cd * 4096;
            for (int idx = dt; idx < 4096; idx += 256) { const int i = idx >> 6, j = idx & 63; const int ti = dir ? 63 - i : i, tj = dir ? 63 - j : j;
                const float dec = j <= i ? __expf(sm[128 + i] - sm[128 + j]) : 0.f;
                Ls[idx] = j < i ? sm[64 + i] * KK[ti * 65 + tj] * dec : 0.f;
                gqk[idx] = (bf16)f2bf(QKm[ti * 65 + tj] * dec); }
        }
        __syncthreads();
        {
            float X[64];
            int c = F.tid & 255; asm volatile("" : "+v"(c));
            bf16* outp = (c < 128 ? WSP(bf16, WS_GU) : WSP(bf16, WS_GW)) + cd * 8192 + (c & 127);
            const LAS bf16* src = (c < 128 ? vs : ks) + (c & 127);
#pragma unroll
            for (int i = 0; i < 64; ++i) {
                const int ti = dir ? 63 - i : i;
                float a = sm[64 + i] * bf2f(src[ti * 136]); if (c >= 128) a *= sm[192 + i];
#pragma unroll
                for (int j = 0; j < i; ++j) a -= Ls[i * 64 + j] * X[j];
                X[i] = a;
                outp[i * 128] = (bf16)f2bf(a);
                asm volatile("" ::: "memory");
            }
        }
        {
            bf16* gqg = WSP(bf16, WS_GQG) + cd * 8192; bf16* gkd = WSP(bf16, WS_GKD) + cd * 8192;
            const float gl = sm[128 + 63];
            for (int idx = dt; idx < 8192; idx += 256) { const int i = idx >> 7, d = idx & 127; const int ti = dir ? 63 - i : i;
                gqg[idx] = (bf16)f2bf(bf2f(qs[ti * 136 + d]) * sm[192 + i]); }
            for (int idx = dt; idx < 8192; idx += 256) { const int d = idx >> 6, i = idx & 63; const int ti = dir ? 63 - i : i;
                gkd[idx] = (bf16)f2bf(bf2f(ks[ti * 136 + d]) * __expf(gl - sm[128 + i])); }
            if (dt == 0) WSP(float, WS_GGL)[cd] = __expf(gl);
        }
    }
    __syncthreads();
}

constexpr int GS_ST = 0, GS_VN = 4352;
struct GdnOps { bf16x8 a[4]; bf16x8 qk[2]; bf16x8 kd[2]; float uv[4]; float gl; };
__device__ __forceinline__ void gdn_load(Frame& F, GdnOps& o, size_t cd, int sl) {
    const int lane = F.lane, w = F.wave, r16 = lane & 15, quad = lane >> 4, rt = w & 3;
    const bf16* ap = (w < 4 ? WSP(bf16, WS_GW) : WSP(bf16, WS_GQG)) + cd * 8192 + (size_t)(16 * rt + r16) * 128 + 8 * quad;
#pragma unroll
    for (int s = 0; s < 4; ++s) o.a[s] = *(const bf16x8*)(ap + 32 * s);
    const bf16* kp = WSP(bf16, WS_GKD) + cd * 8192 + (size_t)(16 * w + r16) * 64 + 8 * quad;
    o.kd[0] = *(const bf16x8*)kp; o.kd[1] = *(const bf16x8*)(kp + 32);
    if (w >= 4) { const bf16* qp = WSP(bf16, WS_GQK) + cd * 4096 + (size_t)(16 * rt + r16) * 64 + 8 * quad; o.qk[0] = *(const bf16x8*)qp; o.qk[1] = *(const bf16x8*)(qp + 32); }
    else { const bf16* up = WSP(bf16, WS_GU) + cd * 8192 + (size_t)(16 * rt + 4 * quad) * 128 + 16 * sl + r16;
#pragma unroll
        for (int j = 0; j < 4; ++j) o.uv[j] = bf2f(up[j * 128]); }
    o.gl = WSP(float, WS_GGL)[cd];
}
__device__ __forceinline__ size_t gdn_cd(int b, int h, int dir, int s) {
    int g; if (s < 4) g = 256 + 4 * b + (dir ? 3 - s : s); else g = 64 * b + (dir ? 63 - (s - 4) : (s - 4));
    return ((size_t)g * 4 + h) * 2 + dir;
}
__device__ __forceinline__ void gdn_scan(Frame& F, int chain) {
    REFRESH_TID(F);
    const int sl = chain & 7, dir = (chain >> 3) & 1, h = (chain >> 4) & 3, b = chain >> 6;
    const int lane = F.lane, w = F.wave, r16 = lane & 15, quad = lane >> 4, rt = w & 3;
    LAS bf16* St = (LAS bf16*)(F.lds + GS_ST); LAS bf16* VNt = (LAS bf16*)(F.lds + GS_VN);
    __syncthreads();
    for (int i = F.tid; i < (GS_VN + 2304) / 4; i += NT) ((LAS unsigned*)F.lds)[i] = 0u;
    __syncthreads();
    f32x4 sacc = (f32x4){0.f, 0.f, 0.f, 0.f};
    GdnOps cur, nxt;
    gdn_load(F, cur, gdn_cd(b, h, dir, 0), sl);
    float* GO = WSP(float, WS_GO) + (size_t)dir * MROWS * 512;
#pragma unroll 1
    for (int s = 0; s < 68; ++s) {
        const size_t cdc = gdn_cd(b, h, dir, s);
        if (s + 1 < 68) gdn_load(F, nxt, gdn_cd(b, h, dir, s + 1), sl);
        bf16x8 sbf[4];
#pragma unroll
        for (int ks = 0; ks < 4; ++ks) sbf[ks] = *(const LAS bf16x8*)(St + r16 * 136 + 32 * ks + 8 * quad);
        f32x4 acc = (f32x4){0.f, 0.f, 0.f, 0.f};
#pragma unroll
        for (int ks = 0; ks < 4; ++ks) acc = __builtin_amdgcn_mfma_f32_16x16x32_bf16(cur.a[ks], sbf[ks], acc, 0, 0, 0);
        if (w < 4) {
            v2u o; o.x = pk2(cur.uv[0] - acc[0], cur.uv[1] - acc[1]); o.y = pk2(cur.uv[2] - acc[2], cur.uv[3] - acc[3]);
            *(LAS v2u*)(VNt + r16 * 72 + 16 * rt + 4 * quad) = o;
        }
        __syncthreads();
        const bf16x8 vb0 = *(const LAS bf16x8*)(VNt + r16 * 72 + 8 * quad), vb1 = *(const LAS bf16x8*)(VNt + r16 * 72 + 32 + 8 * quad);
        if (w >= 4) {
            acc = __builtin_amdgcn_mfma_f32_16x16x32_bf16(cur.qk[0], vb0, acc, 0, 0, 0);
            acc = __builtin_amdgcn_mfma_f32_16x16x32_bf16(cur.qk[1], vb1, acc, 0, 0, 0);
            const int g = (int)(cdc >> 3);
#pragma unroll
            for (int j = 0; j < 4; ++j) { const int i = 16 * rt + 4 * quad + j; const int ti = dir ? 63 - i : i;
                GO[((size_t)64 * g + ti) * 512 + h * 128 + 16 * sl + r16] = acc[j]; }
        }
        sacc = sacc * cur.gl;
        sacc = __builtin_amdgcn_mfma_f32_16x16x32_bf16(cur.kd[0], vb0, sacc, 0, 0, 0);
        sacc = __builtin_amdgcn_mfma_f32_16x16x32_bf16(cur.kd[1], vb1, sacc, 0, 0, 0);
        { v2u o; o.x = pk2(sacc[0], sacc[1]); o.y = pk2(sacc[2], sacc[3]); *(LAS v2u*)(St + r16 * 136 + 16 * w + 4 * quad) = o; }
        __syncthreads();
        cur = nxt;
    }
}
__device__ __forceinline__ void gdn_out(Frame& F, int l) {
    REFRESH_TID(F);
    const int gw = F.bid * NWAVES + F.wave, NGW = F.G * NWAVES, lane = F.lane;
    const float* G0 = WSP(float, WS_GO); const float* G1 = G0 + (size_t)MROWS * 512;
    const bf16* U = WSP(bf16, WS_U); bf16* YC = WSP(bf16, WS_Y) + (size_t)2 * MROWS * 512;
    const float g0 = F.in[I_CGOUT][l * 128 + 2 * lane], g1 = F.in[I_CGOUT][l * 128 + 2 * lane + 1];
    for (int r = gw; r < MROWS; r += NGW) {
#pragma unroll
        for (int h = 0; h < 4; ++h) {
            const size_t o = (size_t)r * 512 + h * 128 + 2 * lane;
            const float a0 = G0[o] + G1[o], a1 = G0[o + 1] + G1[o + 1];
            const float ss = wave_sum(a0 * a0 + a1 * a1);
            const float rs = rsqrtf(ss * (1.f / 128.f) + EPS);
            const unsigned zz = *(const unsigned*)(U + (size_t)r * UW + UCZ + h * 128 + 2 * lane);
            *(unsigned*)(YC + o) = pk2(a0 * rs * g0 * siluf_(bflo(zz)), a1 * rs * g1 * siluf_(bfhi(zz)));
        }
    }
}

#ifndef REP_P0
#define REP_P0 1
#endif
#ifndef REP_B
#define REP_B 1
#endif
#ifndef REP_D1
#define REP_D1 1
#endif
#ifndef REP_D2
#define REP_D2 1
#endif
#ifndef REP_E
#define REP_E 1
#endif
#ifndef REP_F
#define REP_F 1
#endif
#ifndef REP_I
#define REP_I 1
#endif
#ifndef REP_J
#define REP_J 1
#endif
#ifndef REP_C1
#define REP_C1 1
#endif
#ifndef REP_C2
#define REP_C2 1
#endif
#ifndef REP_C4
#define REP_C4 1
#endif
#ifndef REP_G2
#define REP_G2 1
#endif

constexpr int PH_PER_LAYER = 11, PH_FINAL = 1 + PH_PER_LAYER * DEPTH, N_PHASES = PH_FINAL + 1;
struct Args { const float* in[32]; float* out; unsigned char* ws; int ph_lo, ph_hi, li, pad; };

__global__ void __launch_bounds__(NT, 2) hybrid_fwd(Args args) {
    extern __shared__ __attribute__((aligned(16))) unsigned char lds_raw[];
    Frame F;
    F.lds = (LAS unsigned char*)lds_raw;
    F.tid = threadIdx.x; F.lane = F.tid & 63; F.wave = __builtin_amdgcn_readfirstlane(F.tid >> 6);
    F.G = gridDim.x; F.bid = blockIdx.x;
    F.in = args.in; F.in0 = args.in;
    F.out = args.out; F.ws = args.ws; F.ws0 = args.ws; F.ctl = (unsigned*)(args.ws + WS_CTL);
    volatile LAS unsigned* MISC = (volatile LAS unsigned*)(F.lds + MISC_OFF);
    if (F.tid < 64) MISC[F.tid] = 0u;
    __syncthreads();
    const int lo = args.ph_lo, hi = args.ph_hi;
    XcdBarrier bar = xcd_barrier_post(F.ctl + CW_BAR + args.li * XCD_BAR_WORDS, MISC + 8);
#ifndef ONLY_MASK
#define ONLY_MASK 0xFFFF
#endif
#define PHON(b) ((ONLY_MASK >> (b)) & 1)
#define IN(k) (lo <= (k) && (k) < hi)
#define SEAM(k) do { if ((k) + 1 < hi) xcd_barrier(bar); } while (0)

    if (PHON(0) && IN(0)) { REFRESH_TID(F); _Pragma("unroll 1") for (int rep_ = 0; rep_ < REP_P0; ++rep_) { p0_prologue(F); __syncthreads(); } SEAM(0); }
#pragma unroll 1
    for (int l = 0; l < DEPTH; ++l) {
        const int pb = 1 + PH_PER_LAYER * l;
        if (PHON(1) && IN(pb + 0)) { REFRESH_TID(F); norm_phase<0>(F, l); SEAM(pb + 0); }
        if (PHON(2) && IN(pb + 1)) { REFRESH_TID(F);
            pg8::Gemm g{WSP(bf16, WS_H), WSP(bf16, WS_WIN) + (size_t)l * UW * D, MROWS, UW, D};
            pg8::StaticOrder S; S.init(MROWS, UW, F.G, F.bid);
            pg8::EpiStoreBf16 E{WSP(bf16, WS_U), UW};
            _Pragma("unroll 1") for (int rep_ = 0; rep_ < REP_B; ++rep_) { pg8::gemm_phase<pg8::EpiStoreBf16, pg8::StaticOrder, true, true>(F.lds, g, S, E); __syncthreads(); }
            SEAM(pb + 1);
        }
        if (PHON(3) && IN(pb + 2)) { REFRESH_TID(F);
#ifndef NO_C1
            _Pragma("unroll 1") for (int rep_ = 0; rep_ < REP_C1; ++rep_) { gdn_prep(F, l); __syncthreads(); }
#endif
#ifndef NO_C2
            _Pragma("unroll 1") for (int rep_ = 0; rep_ < REP_C2; ++rep_) { lru_pass1(F, l); __syncthreads(); }
#endif
            __syncthreads();
#ifndef NO_C3
            qk_prep(F, l);
#endif
#ifndef NO_C4
            _Pragma("unroll 1") for (int rep_ = 0; rep_ < REP_C4; ++rep_) { v_transpose(F); __syncthreads(); }
#endif
            SEAM(pb + 2);
        }
        if (PHON(4) && IN(pb + 3)) { REFRESH_TID(F);
            _Pragma("unroll 1") for (int rep_ = 0; rep_ < REP_D1; ++rep_) { for (int ch = F.bid; ch < 256; ch += F.G) gdn_scan(F, ch); __syncthreads(); }
            lru_carry_all(F);
            __syncthreads();
            _Pragma("unroll 1") for (int rep_ = 0; rep_ < REP_D2; ++rep_) { attn_phase(F, l); __syncthreads(); }
            SEAM(pb + 3);
        }
        if (PHON(5) && IN(pb + 4)) { REFRESH_TID(F);
            _Pragma("unroll 1") for (int rep_ = 0; rep_ < REP_E; ++rep_) { lru_pass2(F, l); __syncthreads(); }
            __syncthreads();
            gdn_out(F, l);
            SEAM(pb + 4);
        }
        if (PHON(6) && IN(pb + 5)) { REFRESH_TID(F);
            pg8::Gemm g{WSP(bf16, WS_Y), WSP(bf16, WS_WBR) + (size_t)l * 4 * 1024 * 512, 4 * MROWS, 4 * 1024, 512};
            pg8::MergeOrder S{F.G, F.bid, MROWS / 256};
            pg8::EpiMerge E{WSP(bf16, WS_U), UW, UG, WSP(float, WS_MF), WSP(bf16, WS_MB), MROWS / 256};
            _Pragma("unroll 1") for (int rep_ = 0; rep_ < REP_F; ++rep_) { pg8::gemm_phase<pg8::EpiMerge, pg8::MergeOrder, true, true>(F.lds, g, S, E); __syncthreads(); }
            SEAM(pb + 5);
        }
        if (PHON(7) && IN(pb + 6)) { REFRESH_TID(F);
            pg8::Gemm g{WSP(bf16, WS_MB), WSP(bf16, WS_WOUT) + (size_t)l * D * D, MROWS, D, D};
            pg8::StaticOrder S; S.init(MROWS, D, F.G, F.bid);
            pg8::EpiResid E{WSP(float, WS_X), WSP(float, WS_MOD) + (size_t)l * 5 * 6144 + 2048};
            pg8::gemm_phase<pg8::EpiResid, pg8::StaticOrder, true, true>(F.lds, g, S, E);
            SEAM(pb + 6);
        }
        if (PHON(8) && IN(pb + 7)) { REFRESH_TID(F); norm_phase<1>(F, l); SEAM(pb + 7); }
        if (PHON(9) && IN(pb + 8)) { REFRESH_TID(F); _Pragma("unroll 1") for (int rep_ = 0; rep_ < REP_G2; ++rep_) { moe_gather(F, l); __syncthreads(); } SEAM(pb + 8); }
        if (PHON(10) && IN(pb + 9)) { REFRESH_TID(F);
            moe_table(F, l);
            pg8::Gemm g{WSP(bf16, WS_HS), WSP(bf16, WS_WGU) + (size_t)l * NEXP * 2048 * D, MOE_ROWS, NEXP * 2048, D};
            pg8::MoeOrder S{(const LAS int*)(F.lds + MISC_OFF + 256), F.G, F.bid, 8};
            pg8::EpiSwiglu E{WSP(bf16, WS_ACT), F.in[I_BGU] + (size_t)l * NEXP * 2048};
            _Pragma("unroll 1") for (int rep_ = 0; rep_ < REP_I; ++rep_) { pg8::gemm_phase<pg8::EpiSwiglu, pg8::MoeOrder, true, true>(F.lds, g, S, E); __syncthreads(); }
            SEAM(pb + 9);
        }
        if (PHON(11) && IN(pb + 10)) { REFRESH_TID(F);
            moe_table(F, l);
            pg8::Gemm g{WSP(bf16, WS_ACT), WSP(bf16, WS_WDN) + (size_t)l * NEXP * D * D, MOE_ROWS, NEXP * D, D};
            pg8::MoeOrder S{(const LAS int*)(F.lds + MISC_OFF + 256), F.G, F.bid, 4};
            pg8::EpiDown E{WSP(bf16, WS_YS), F.in[I_BDN] + (size_t)l * NEXP * D};
            _Pragma("unroll 1") for (int rep_ = 0; rep_ < REP_J; ++rep_) { pg8::gemm_phase<pg8::EpiDown, pg8::MoeOrder, true, true>(F.lds, g, S, E); __syncthreads(); }
            SEAM(pb + 10);
        }
    }
    if (PHON(12) && IN(PH_FINAL)) { REFRESH_TID(F); norm_phase<2>(F, 0); }
#undef IN
#undef SEAM
}

extern "C" void kernel_launch(void* const* d_in, const int* in_sizes, int n_in, void* d_out, int out_size, void* d_ws, size_t ws_size, hipStream_t stream) {
    static int grid = 0;
    if (grid == 0) {
        if (n_in != 32 || out_size != TLAT * D || ws_size < WS_END) { fprintf(stderr, "kernel_launch: unexpected shapes (n_in %d out %d ws %zu need %zu)\n", n_in, out_size, ws_size, (size_t)WS_END); grid = -1; return; }
        int dev = 0, cus = 0, per_cu = 0;
        if (hipGetDevice(&dev) != hipSuccess || hipDeviceGetAttribute(&cus, hipDeviceAttributeMultiprocessorCount, dev) != hipSuccess) { grid = -1; return; }
        if (hipFuncSetAttribute((const void*)hybrid_fwd, hipFuncAttributeMaxDynamicSharedMemorySize, LDS_BYTES) != hipSuccess) { fprintf(stderr, "kernel_launch: hipFuncSetAttribute failed\n"); grid = -1; return; }
        if (hipOccupancyMaxActiveBlocksPerMultiprocessor(&per_cu, (const void*)hybrid_fwd, NT, LDS_BYTES) != hipSuccess || per_cu < 1) fprintf(stderr, "kernel_launch: occupancy query says %d\n", per_cu);
        (void)hipGetLastError();
        grid = cus;
    }
    if (grid < 0) return;
    if (hipMemsetAsync((char*)d_ws + WS_CTL, 0, CTL_BYTES, stream) != hipSuccess) return;
    Args a{};
    for (int i = 0; i < 32; ++i) a.in[i] = (const float*)d_in[i];
    a.out = (float*)d_out; a.ws = (unsigned char*)d_ws;
#if MK_MULTI
    for (int p = 0; p < N_PHASES; ++p) { a.ph_lo = p; a.ph_hi = p + 1; a.li = p;
        hipLaunchKernelGGL(hybrid_fwd, dim3(grid), dim3(NT), LDS_BYTES, stream, a); }
#else
    a.ph_lo = 0; a.ph_hi = N_PHASES; a.li = 0;
    hipLaunchKernelGGL(hybrid_fwd, dim3(grid), dim3(NT), LDS_BYTES, stream, a);
#endif
    const hipError_t le = hipPeekAtLastError();
    if (le != hipSuccess) fprintf(stderr, "kernel_launch: launch failed: %s\n", hipGetErrorName(le));
}
```

```cpp
#include <hip/hip_runtime.h>
#include <cstdio>
#include <cstdint>

#ifndef MK_MULTI
#define MK_MULTI 0
#endif

constexpr int D = 1024, NB = 4, SEQ = 4096, LCTX = 256, DEPTH = 4;
constexpr int TLAT = NB * SEQ, TCTX = NB * LCTX, MROWS = TLAT + TCTX;
constexpr int NCHUNK = MROWS / 64;
constexpr int INW = 9488, UW = 9472;
constexpr int UQ = 0, UK = 512, UV = 640, UBX = 768, UBY = 1280, UCQ = 1792, UCK = 2304, UCV = 2816, UCZ = 3328, UDQ = 3840, UDK = 4352, UDV = 4864, UG = 5376;
constexpr int NEXP = 32, TOPK = 4;
constexpr int KEYS = SEQ + LCTX;
constexpr int MOE_ROWS = MROWS * TOPK + NEXP * 256;
constexpr float EPS = 1e-6f;
constexpr float LOG2E = 1.4426950408889634f;

constexpr size_t al256(size_t x) { return (x + 255) & ~(size_t)255; }
constexpr size_t WS_CTL = 0, CTL_BYTES = 1u << 20;
constexpr size_t WS_MOD  = WS_CTL + CTL_BYTES;
constexpr size_t WS_ROPE = WS_MOD + al256((size_t)DEPTH * 5 * 6144 * 4);
constexpr size_t WS_LRUW = WS_ROPE + al256(2 * 64 * 16 * 4);
constexpr size_t WS_WIN  = WS_LRUW + al256((size_t)DEPTH * 2 * 2 * 8 * 4096 * 2);
constexpr size_t WS_WBR  = WS_WIN + al256((size_t)DEPTH * UW * D * 2);
constexpr size_t WS_WOUT = WS_WBR + al256((size_t)DEPTH * 4 * 1024 * 512 * 2);
constexpr size_t WS_WGU  = WS_WOUT + al256((size_t)DEPTH * D * D * 2);
constexpr size_t WS_WDN  = WS_WGU + al256((size_t)DEPTH * NEXP * 2048 * 1024 * 2);
constexpr size_t WS_X    = WS_WDN + al256((size_t)DEPTH * NEXP * 1024 * 1024 * 2);
constexpr size_t WS_H    = WS_X + al256((size_t)MROWS * D * 4);
constexpr size_t WS_U    = WS_H + al256((size_t)MROWS * D * 2);
constexpr size_t WS_CAB  = WS_U + al256((size_t)MROWS * UW * 2);
constexpr size_t WS_VAT  = WS_CAB + al256((size_t)MROWS * 16 * 4);
constexpr size_t WS_VDT  = WS_VAT + al256((size_t)NB * 2 * 64 * KEYS * 2);
constexpr size_t WS_LRA  = WS_VDT + al256((size_t)NB * 8 * 64 * KEYS * 2);
constexpr size_t WS_LRB  = WS_LRA + al256((size_t)NCHUNK * 2 * 512 * 4);
constexpr size_t WS_LRC  = WS_LRB + al256((size_t)NCHUNK * 2 * 512 * 4);
constexpr int NCD = NCHUNK * 4 * 2;
constexpr size_t WS_GW   = WS_LRC + al256((size_t)NCHUNK * 2 * 512 * 4);
constexpr size_t WS_GU   = WS_GW + al256((size_t)NCD * 64 * 128 * 2);
constexpr size_t WS_GQG  = WS_GU + al256((size_t)NCD * 64 * 128 * 2);
constexpr size_t WS_GKD  = WS_GQG + al256((size_t)NCD * 64 * 128 * 2);
constexpr size_t WS_GQK  = WS_GKD + al256((size_t)NCD * 64 * 128 * 2);
constexpr size_t WS_GGL  = WS_GQK + al256((size_t)NCD * 64 * 64 * 2);
constexpr size_t WS_GO   = WS_GGL + al256((size_t)NCD * 4);
constexpr size_t WS_Y    = WS_GO + al256((size_t)2 * MROWS * 512 * 4);
constexpr size_t WS_MF   = WS_Y + al256((size_t)4 * MROWS * 512 * 2);
constexpr size_t WS_MB   = WS_MF + al256((size_t)MROWS * D * 4);
constexpr size_t WS_SROW = WS_MB + al256((size_t)MROWS * D * 2);
constexpr size_t WS_SW   = WS_SROW + al256((size_t)MROWS * 4 * 4);
constexpr size_t WS_SEP  = WS_SW + al256((size_t)MROWS * 4 * 4);
constexpr size_t WS_LIST = WS_SEP + al256((size_t)MROWS * 4 * 4);
constexpr size_t WS_HS   = WS_LIST + al256((size_t)NEXP * MROWS * 4);
constexpr size_t WS_ACT  = WS_HS + al256((size_t)MOE_ROWS * D * 2);
constexpr size_t WS_YS   = WS_ACT + al256((size_t)MOE_ROWS * D * 2);
constexpr size_t WS_END  = WS_YS + al256((size_t)MOE_ROWS * D * 2);

constexpr int CW_BAR = 4096;
constexpr int CW_CNT = 1024;

constexpr int RING_BYTES = 131072;
constexpr int MISC_OFF = RING_BYTES;
constexpr int LDS_BYTES = 147456;
constexpr int NWAVES = 8, NT = 512;

#define GAS __attribute__((address_space(1)))
#define LAS __attribute__((address_space(3)))
typedef unsigned short bf16;
typedef unsigned v4u __attribute__((ext_vector_type(4)));
typedef unsigned v2u __attribute__((ext_vector_type(2)));
typedef float f32x4 __attribute__((ext_vector_type(4)));
typedef float f32x16 __attribute__((ext_vector_type(16)));
typedef short bf16x8 __attribute__((ext_vector_type(8)));
typedef short bf16x4 __attribute__((ext_vector_type(4)));

typedef float f32x2_t __attribute__((ext_vector_type(2))); typedef __bf16 bf16x2_t __attribute__((ext_vector_type(2)));
__device__ __forceinline__ unsigned pk2(float lo, float hi) { f32x2_t v = {lo, hi}; bf16x2_t b = __builtin_convertvector(v, bf16x2_t); return __builtin_bit_cast(unsigned, b); }
__device__ __forceinline__ unsigned f2bf(float f) { return pk2(f, 0.f) & 0xffffu; }
__device__ __forceinline__ float bf2f(unsigned short b) { return __builtin_bit_cast(float, (unsigned)b << 16); }
__device__ __forceinline__ float bflo(unsigned w) { return __builtin_bit_cast(float, w << 16); }
__device__ __forceinline__ float bfhi(unsigned w) { return __builtin_bit_cast(float, w & 0xffff0000u); }
__device__ __forceinline__ float wave_sum(float v) {
#pragma unroll
    for (int o = 1; o < 64; o <<= 1) v += __shfl_xor(v, o);
    return v;
}
__device__ __forceinline__ float sigmoidf_(float x) { return 1.f / (1.f + __expf(-x)); }
__device__ __forceinline__ float softplusf_(float x) { return x > 20.f ? x : log1pf(__expf(x)); }
__device__ __forceinline__ float siluf_(float x) { return x / (1.f + __expf(-x)); }
__device__ __forceinline__ void lds_barrier() { asm volatile("s_waitcnt lgkmcnt(0)\n\ts_barrier" ::: "memory"); }
namespace pg8 {
#define PG8_LAS __attribute__((address_space(3)))
typedef unsigned short bf16_t;
typedef short bf16x8 __attribute__((ext_vector_type(8)));
typedef float f32x4 __attribute__((ext_vector_type(4)));
typedef unsigned u32x4 __attribute__((ext_vector_type(4)));
constexpr int BM = 256, BK = 64, HALF = 128, HTB = HALF * BK * 2  , STAGE_BYTES = 8 * HTB, NXCD = 8, WGM = 8;

__host__ __device__ __forceinline__ int lds_byte(int r, int c) { const int st = (r >> 4) * 2 + (c >> 5), rr = r & 15, cc = c & 31, ob = rr * 64 + cc * 2; return st * 1024 + (ob ^ (((ob >> 9) & 1) << 5)); }
__host__ __device__ __forceinline__ void stage_rc(int b, int& R, int& C) { const int st = b / 1024, sb = b % 1024, swz = sb ^ (((sb >> 9) & 1) << 5); R = (st >> 1) * 16 + swz / 64; C = (st & 1) * 32 + (swz % 64) / 2; }
__host__ __device__ __forceinline__ int perm32(int rho) { const int n = rho >> 4, i = rho & 15; return 8 * (i >> 2) + 4 * n + (i & 3); }

struct Unit { int pm, pn; };
struct Gemm { const bf16_t* A; const bf16_t* Bt; int M, N, K; };

struct StaticOrder {
    int nM, nN, nwg, G, c;
    __host__ __device__ void init(int M, int N, int G_, int c_) { nM = M / BM; nN = N / BM; nwg = nM * nN; G = G_; c = c_; }
    __host__ __device__ bool next(int i, Unit& u) const {
        const long L = (long)i * G + c; if (L >= nwg) return false;
        int wgid = (int)L; { const int q = nwg / NXCD, r = nwg % NXCD, xcd = wgid % NXCD, off = wgid / NXCD; wgid = (xcd < r ? xcd * (q + 1) : r * (q + 1) + (xcd - r) * q) + off; }
        const int nig = WGM * nN, gid = wgid / nig, fm = gid * WGM, gsz = (nM - fm) < WGM ? (nM - fm) : WGM;
        u.pm = fm + ((wgid % nig) % gsz); u.pn = (wgid % nig) / gsz; return true;
    }
    __device__ __forceinline__ void a_ready(const Unit&) const {}
    __device__ __forceinline__ void done(const Unit&) const {}
};

__device__ __forceinline__ unsigned cvt_pk_bf16(float lo, float hi) { unsigned r; asm volatile("v_cvt_pk_bf16_f32 %0, %1, %2" : "=v"(r) : "v"(lo), "v"(hi)); return r; }
typedef float f32x2 __attribute__((ext_vector_type(2)));
template <class Epi, class Sched, bool ALIGN_EPI = false, bool SP2 = false>
__device__ __forceinline__ void gemm_phase(PG8_LAS unsigned char* lds, const Gemm g, const Sched& S, const Epi& E, const int wid_in) {
    int lane_o = (int)__builtin_amdgcn_mbcnt_hi(~0u, __builtin_amdgcn_mbcnt_lo(~0u, 0u)); asm volatile("" : "+v"(lane_o));
    const int wid = __builtin_amdgcn_readfirstlane(wid_in), lane = lane_o, tid = wid * 64 + lane, wr = wid >> 2, wc = wid & 3, fr = lane & 15, fq = lane >> 4;
    const int K = g.K, nt = K / BK;
    unsigned voffA[2], voffB[2];
#pragma unroll
    for (int i = 0; i < 2; ++i) { int R, C; stage_rc(tid * 16 + i * 8192, R, C); const int Rb = Epi::PERM ? ((R & ~31) + perm32(R & 31)) : R;
        voffA[i] = (unsigned)(R * K + C) * 2u; voffB[i] = (unsigned)(Rb * K + C) * 2u; }
    const size_t kstep = (size_t)(BK * 2);
    const size_t hstep = (size_t)HALF * K * 2;
    const size_t tstep = 2 * hstep;
    const unsigned ldsw = (unsigned)wid * 1024u;
    const int aoff = lds_byte(wr * 64 + fr, fq * 8), boff = lds_byte(wc * 32 + fr, fq * 8);
#define PG8_SA(b, h) (((b) * 2 + (h)) * HTB)
#define PG8_SB(b, h) ((4 + (b) * 2 + (h)) * HTB)
#define PG8_STAGE(bufoff, gbase, voff) do { _Pragma("unroll") for (int _i = 0; _i < 2; ++_i) \
        __builtin_amdgcn_global_load_lds((const unsigned*)((const char*)(gbase) + (voff)[_i]), (PG8_LAS unsigned*)(lds + (bufoff) + ldsw + _i * 8192), 16, 0, 0); } while (0)
#define PG8_LDA(dst, b, h) do { _Pragma("unroll") for (int m = 0; m < 4; ++m) _Pragma("unroll") for (int k = 0; k < 2; ++k) dst[m][k] = *(const PG8_LAS bf16x8*)(lds + PG8_SA(b, h) + aoff + m * 2048 + k * 1024); } while (0)
#define PG8_LDB(dst, b, h) do { _Pragma("unroll") for (int n = 0; n < 2; ++n) _Pragma("unroll") for (int k = 0; k < 2; ++k) dst[n][k] = *(const PG8_LAS bf16x8*)(lds + PG8_SB(b, h) + boff + n * 2048 + k * 1024); } while (0)
#define PG8_MMA(ai, bj, At, Bt) do { __builtin_amdgcn_s_setprio(1); _Pragma("unroll") for (int m = 0; m < 4; ++m) _Pragma("unroll") for (int n = 0; n < 2; ++n) _Pragma("unroll") for (int k = 0; k < 2; ++k) \
        acc[ai][bj][m][n] = __builtin_amdgcn_mfma_f32_16x16x32_bf16(Bt[n][k], At[m][k], acc[ai][bj][m][n], 0, 0, 0); __builtin_amdgcn_s_setprio(0); } while (0)
#define PG8_WAIT_V(n) asm volatile("s_waitcnt vmcnt(" #n ")" ::: "memory")
#define PG8_WAIT_L(n) asm volatile("s_waitcnt lgkmcnt(" #n ")" ::: "memory")
#define PG8_BAR __builtin_amdgcn_s_barrier()
#define PG8_SCHED __builtin_amdgcn_sched_barrier(0)
    Unit cur, nxt; int ui = 0;
    if (!S.next(0, cur)) return;
    f32x4 acc[2][2][4][2];
#pragma unroll
    for (int a = 0; a < 2; ++a)
#pragma unroll
        for (int b = 0; b < 2; ++b)
#pragma unroll
            for (int m = 0; m < 4; ++m)
#pragma unroll
                for (int n = 0; n < 2; ++n) acc[a][b][m][n] = (f32x4){0.f, 0.f, 0.f, 0.f};
    bf16x8 At[4][2], B0[2][2], B1[2][2];
    const char* cA = (const char*)g.A + (size_t)cur.pm * tstep; const char* cB = (const char*)g.Bt + (size_t)cur.pn * tstep;
    S.a_ready(cur);
    if constexpr (SP2) {
        PG8_STAGE(PG8_SB(0, 0), cB, voffB); PG8_STAGE(PG8_SB(0, 1), cB + hstep, voffB); PG8_STAGE(PG8_SA(0, 0), cA, voffA); PG8_STAGE(PG8_SA(0, 1), cA + hstep, voffA);
        if (wr == 1) PG8_BAR;
        PG8_WAIT_V(2); PG8_BAR;
        PG8_STAGE(PG8_SB(1, 0), cB + kstep, voffB); PG8_STAGE(PG8_SA(1, 0), cA + kstep, voffA); PG8_STAGE(PG8_SB(1, 1), cB + hstep + kstep, voffB);
        PG8_WAIT_V(6); PG8_BAR;
    } else {
        PG8_STAGE(PG8_SB(0, 0), cB, voffB); PG8_STAGE(PG8_SA(0, 0), cA, voffA); PG8_STAGE(PG8_SB(0, 1), cB + hstep, voffB); PG8_STAGE(PG8_SA(0, 1), cA + hstep, voffA);
        if (wr == 1) PG8_BAR;
        PG8_WAIT_V(4); PG8_BAR;
        PG8_STAGE(PG8_SB(1, 0), cB + kstep, voffB); PG8_STAGE(PG8_SA(1, 0), cA + kstep, voffA); PG8_STAGE(PG8_SB(1, 1), cB + hstep + kstep, voffB);
        PG8_WAIT_V(6); PG8_BAR;
    }
    for (;;) {
        const bool has_next = S.next(ui + 1, nxt);
        const char* nA = has_next ? (const char*)g.A + (size_t)nxt.pm * tstep : cA; const char* nB = has_next ? (const char*)g.Bt + (size_t)nxt.pn * tstep : cB;
        for (int t = 0; t < nt; t += 2) {
            const bool last = (t == nt - 2);
            const char* a1 = cA + (size_t)(t + 1) * kstep;
            const char* a2 = last ? nA : cA + (size_t)(t + 2) * kstep; const char* b2 = last ? nB : cB + (size_t)(t + 2) * kstep;
            const char* a3 = a2 + kstep; const char* b3 = b2 + kstep;
            if (last && has_next) S.a_ready(nxt);
            if constexpr (SP2) {
            PG8_LDB(B0, 0, 0); PG8_LDB(B1, 0, 1); PG8_SCHED; PG8_LDA(At, 0, 0); PG8_STAGE(PG8_SA(1, 1), a1 + hstep, voffA);
            PG8_WAIT_V(8); PG8_WAIT_L(0); PG8_BAR; PG8_MMA(0, 0, At, B0); PG8_MMA(0, 1, At, B1); PG8_BAR; PG8_SCHED;
            PG8_LDA(At, 0, 1); PG8_STAGE(PG8_SB(0, 0), b2, voffB); PG8_STAGE(PG8_SB(0, 1), b2 + hstep, voffB); PG8_STAGE(PG8_SA(0, 0), a2, voffA);
            PG8_WAIT_V(8); PG8_WAIT_L(0); PG8_BAR; PG8_MMA(1, 0, At, B0); PG8_MMA(1, 1, At, B1); PG8_BAR; PG8_SCHED;
            PG8_LDB(B0, 1, 0); PG8_LDB(B1, 1, 1); PG8_SCHED; PG8_LDA(At, 1, 0); PG8_STAGE(PG8_SA(0, 1), a2 + hstep, voffA);
            PG8_WAIT_V(8); PG8_WAIT_L(0); PG8_BAR; PG8_MMA(0, 0, At, B0); PG8_MMA(0, 1, At, B1); PG8_BAR; PG8_SCHED;
            PG8_LDA(At, 1, 1); PG8_STAGE(PG8_SB(1, 0), b3, voffB); PG8_STAGE(PG8_SB(1, 1), b3 + hstep, voffB); PG8_STAGE(PG8_SA(1, 0), a3, voffA);
            PG8_WAIT_V(8); PG8_WAIT_L(0); PG8_BAR; PG8_MMA(1, 0, At, B0); PG8_MMA(1, 1, At, B1); PG8_BAR; PG8_SCHED;
            } else {
            PG8_LDB(B0, 0, 0); PG8_SCHED; PG8_LDA(At, 0, 0); PG8_STAGE(PG8_SA(1, 1), a1 + hstep, voffA);
            PG8_WAIT_L(8); PG8_BAR; PG8_WAIT_L(0); PG8_MMA(0, 0, At, B0); PG8_BAR; PG8_SCHED;
            PG8_LDB(B1, 0, 1); PG8_STAGE(PG8_SB(0, 0), b2, voffB);
            PG8_BAR; PG8_WAIT_L(0); PG8_MMA(0, 1, At, B1); PG8_BAR;
            PG8_LDA(At, 0, 1); PG8_STAGE(PG8_SA(0, 0), a2, voffA);
            PG8_BAR; PG8_WAIT_L(0); PG8_MMA(1, 0, At, B0); PG8_BAR; PG8_SCHED;
            PG8_STAGE(PG8_SB(0, 1), b2 + hstep, voffB);
            PG8_WAIT_V(6); PG8_BAR; PG8_MMA(1, 1, At, B1); PG8_BAR;
            PG8_LDB(B0, 1, 0); PG8_SCHED; PG8_LDA(At, 1, 0); PG8_STAGE(PG8_SA(0, 1), a2 + hstep, voffA);
            PG8_WAIT_L(8); PG8_BAR; PG8_WAIT_L(0); PG8_MMA(0, 0, At, B0); PG8_BAR; PG8_SCHED;
            PG8_LDB(B1, 1, 1); PG8_STAGE(PG8_SB(1, 0), b3, voffB);
            PG8_BAR; PG8_WAIT_L(0); PG8_MMA(0, 1, At, B1); PG8_BAR;
            PG8_LDA(At, 1, 1); PG8_STAGE(PG8_SA(1, 0), a3, voffA);
            PG8_BAR; PG8_WAIT_L(0); PG8_MMA(1, 0, At, B0); PG8_BAR; PG8_SCHED;
            PG8_STAGE(PG8_SB(1, 1), b3 + hstep, voffB);
            PG8_WAIT_V(6); PG8_BAR; PG8_MMA(1, 1, At, B1); PG8_BAR;
            }
        }
        if constexpr (ALIGN_EPI) { if (wr == 0) PG8_BAR; }
        if constexpr (!Epi::AFTER_DRAIN) { E(acc, cur, wr, wc, fr, fq); S.done(cur); }
        if (!has_next) break;
#pragma unroll
        for (int a = 0; a < 2; ++a)
#pragma unroll
            for (int b = 0; b < 2; ++b)
#pragma unroll
                for (int m = 0; m < 4; ++m)
#pragma unroll
                    for (int n = 0; n < 2; ++n) acc[a][b][m][n] = (f32x4){0.f, 0.f, 0.f, 0.f};
        cur = nxt; cA = nA; cB = nB; ++ui;
        if constexpr (ALIGN_EPI) { if (wr == 1) PG8_BAR; }
    }
    PG8_WAIT_V(0);
    if constexpr (!ALIGN_EPI) { if (wr == 0) PG8_BAR; }
    PG8_BAR;
    if constexpr (Epi::AFTER_DRAIN) { E.fused(acc, cur, wr, wc, fr, fq, lds, wid, lane); S.done(cur); }
#undef PG8_SA
#undef PG8_SB
#undef PG8_STAGE
#undef PG8_LDA
#undef PG8_LDB
#undef PG8_MMA
#undef PG8_WAIT_V
#undef PG8_WAIT_L
#undef PG8_BAR
#undef PG8_SCHED
}
}

namespace pg8 {
__device__ __forceinline__ float bflo_(unsigned w) { return __builtin_bit_cast(float, w << 16); }
__device__ __forceinline__ float bfhi_(unsigned w) { return __builtin_bit_cast(float, w & 0xffff0000u); }
__device__ __forceinline__ float sigm_(float x) { return 1.f / (1.f + __expf(-x)); }

struct EpiStoreBf16 {
    static constexpr bool PERM = true, AFTER_DRAIN = false;
    bf16_t* O; int ldc;
    __device__ __forceinline__ void operator()(const f32x4 (&acc)[2][2][4][2], const Unit& u, int wr, int wc, int fr, int fq) const {
        const int row0 = u.pm * BM + wr * 64 + fr, col0 = u.pn * BM + wc * 32 + 8 * fq;
#pragma unroll
        for (int ai = 0; ai < 2; ++ai)
#pragma unroll
            for (int m = 0; m < 4; ++m) { bf16_t* rowp = O + (size_t)(row0 + ai * HALF + m * 16) * ldc + col0;
#pragma unroll
                for (int bj = 0; bj < 2; ++bj) { const f32x4 v0 = acc[ai][bj][m][0], v1 = acc[ai][bj][m][1];
                    u32x4 w; w.x = cvt_pk_bf16(v0[0], v0[1]); w.y = cvt_pk_bf16(v0[2], v0[3]); w.z = cvt_pk_bf16(v1[0], v1[1]); w.w = cvt_pk_bf16(v1[2], v1[3]);
                    *(u32x4*)(rowp + bj * HALF) = w; } }
    }
};

struct EpiMerge {
    static constexpr bool PERM = true, AFTER_DRAIN = false;
    const bf16_t* U; int ldu, gcol0; float* Mf; bf16_t* Mb; int npm;
    __device__ __forceinline__ void operator()(const f32x4 (&acc)[2][2][4][2], const Unit& u, int wr, int wc, int fr, int fq) const {
        const int br = u.pm / npm, pm = u.pm - br * npm, pn = u.pn & 3;
        const int row0 = pm * BM + wr * 64 + fr, col0 = pn * BM + wc * 32 + 8 * fq;
#pragma unroll
        for (int ai = 0; ai < 2; ++ai)
#pragma unroll
            for (int m = 0; m < 4; ++m) { const size_t row = (size_t)(row0 + ai * HALF + m * 16);
#pragma unroll
                for (int bj = 0; bj < 2; ++bj) { const int col = col0 + bj * HALF;
                    const u32x4 g = *(const u32x4*)(U + row * ldu + gcol0 + br * 1024 + col);
                    f32x4 v0 = acc[ai][bj][m][0], v1 = acc[ai][bj][m][1];
                    v0[0] *= sigm_(bflo_(g.x)); v0[1] *= sigm_(bfhi_(g.x)); v0[2] *= sigm_(bflo_(g.y)); v0[3] *= sigm_(bfhi_(g.y));
                    v1[0] *= sigm_(bflo_(g.z)); v1[1] *= sigm_(bfhi_(g.z)); v1[2] *= sigm_(bflo_(g.w)); v1[3] *= sigm_(bfhi_(g.w));
                    float* mp = Mf + row * 1024 + col;
                    if (br > 0) { v0 = v0 + *(const f32x4*)mp; v1 = v1 + *(const f32x4*)(mp + 4); }
                    if (br < 3) { *(f32x4*)mp = v0; *(f32x4*)(mp + 4) = v1; }
                    else { u32x4 w; w.x = cvt_pk_bf16(v0[0], v0[1]); w.y = cvt_pk_bf16(v0[2], v0[3]); w.z = cvt_pk_bf16(v1[0], v1[1]); w.w = cvt_pk_bf16(v1[2], v1[3]);
                        *(u32x4*)(Mb + row * 1024 + col) = w; } } }
    }
};
struct MergeOrder {
    int G, c, npm, ncnt;
    __device__ __forceinline__ bool next(int i, Unit& u) const {
        const int su = (i >> 2) * G + c; if (su >= ncnt * 4) return false;
        const int br = i & 3; u.pm = br * npm + (su >> 2); u.pn = br * 4 + (su & 3); return true; }
    __device__ __forceinline__ void a_ready(const Unit&) const {}
    __device__ __forceinline__ void done(const Unit&) const {}
};

struct EpiResid {
    static constexpr bool PERM = false, AFTER_DRAIN = false;
    float* X; const float* gt;
    __device__ __forceinline__ void operator()(const f32x4 (&acc)[2][2][4][2], const Unit& u, int wr, int wc, int fr, int fq) const {
        const int row0 = u.pm * BM + wr * 64 + fr, col0 = u.pn * BM + wc * 32 + 4 * fq;
        const int mr = u.pm < 64 ? (u.pm >> 4) : 4;
        f32x4 gv[2][2];
#pragma unroll
        for (int bj = 0; bj < 2; ++bj)
#pragma unroll
            for (int n = 0; n < 2; ++n) gv[bj][n] = *(const f32x4*)(gt + (size_t)mr * 6144 + col0 + bj * HALF + n * 16);
#pragma unroll
        for (int ai = 0; ai < 2; ++ai)
#pragma unroll
            for (int m = 0; m < 4; ++m) { float* rowp = X + (size_t)(row0 + ai * HALF + m * 16) * 1024 + col0;
#pragma unroll
                for (int bj = 0; bj < 2; ++bj)
#pragma unroll
                    for (int n = 0; n < 2; ++n) { float* p = rowp + bj * HALF + n * 16; *(f32x4*)p = *(const f32x4*)p + gv[bj][n] * acc[ai][bj][m][n]; } }
    }
};

struct MoeOrder {
    const PG8_LAS int* tpre; int G, c, ncol;
    __device__ __forceinline__ bool next(int i, Unit& u) const {
        const int L = i * G + c, tau = L / ncol; if (tau >= tpre[32]) return false;
        int e = 0;
#pragma unroll 1
        while (tpre[e + 1] <= tau) ++e;
        u.pm = tau; u.pn = e * ncol + (L - tau * ncol); return true; }
    __device__ __forceinline__ void a_ready(const Unit&) const {}
    __device__ __forceinline__ void done(const Unit&) const {}
};
struct EpiSwiglu {
    static constexpr bool PERM = true, AFTER_DRAIN = false;
    bf16_t* ACT; const float* bgu;
    __device__ __forceinline__ void operator()(const f32x4 (&acc)[2][2][4][2], const Unit& u, int wr, int wc, int fr, int fq) const {
        const int e = u.pn >> 3, pnl = u.pn & 7;
        const int row0 = u.pm * BM + wr * 64 + fr, cl = 128 * pnl + wc * 32 + 8 * fq;
        const float* bg = bgu + (size_t)e * 2048 + cl;
        const f32x4 bg0 = *(const f32x4*)bg, bg1 = *(const f32x4*)(bg + 4), bu0 = *(const f32x4*)(bg + 1024), bu1 = *(const f32x4*)(bg + 1028);
#pragma unroll
        for (int ai = 0; ai < 2; ++ai)
#pragma unroll
            for (int m = 0; m < 4; ++m) {
                f32x4 g0 = acc[ai][0][m][0] + bg0, g1 = acc[ai][0][m][1] + bg1, u0 = acc[ai][1][m][0] + bu0, u1 = acc[ai][1][m][1] + bu1;
                float o[8];
#pragma unroll
                for (int j = 0; j < 4; ++j) { const float g = fminf(g0[j], 7.f), up = fminf(fmaxf(u0[j], -7.f), 7.f); o[j] = (up + 1.f) * g * sigm_(1.702f * g); }
#pragma unroll
                for (int j = 0; j < 4; ++j) { const float g = fminf(g1[j], 7.f), up = fminf(fmaxf(u1[j], -7.f), 7.f); o[4 + j] = (up + 1.f) * g * sigm_(1.702f * g); }
                u32x4 w; w.x = cvt_pk_bf16(o[0], o[1]); w.y = cvt_pk_bf16(o[2], o[3]); w.z = cvt_pk_bf16(o[4], o[5]); w.w = cvt_pk_bf16(o[6], o[7]);
                *(u32x4*)(ACT + (size_t)(row0 + ai * HALF + m * 16) * 1024 + cl) = w; }
    }
};
struct EpiDown {
    static constexpr bool PERM = true, AFTER_DRAIN = false;
    bf16_t* YS; const float* bdn;
    __device__ __forceinline__ void operator()(const f32x4 (&acc)[2][2][4][2], const Unit& u, int wr, int wc, int fr, int fq) const {
        const int e = u.pn >> 2, pnl = u.pn & 3;
        const int row0 = u.pm * BM + wr * 64 + fr, col0 = pnl * BM + wc * 32 + 8 * fq;
        f32x4 bv[2][2];
#pragma unroll
        for (int bj = 0; bj < 2; ++bj)
#pragma unroll
            for (int n = 0; n < 2; ++n) bv[bj][n] = *(const f32x4*)(bdn + (size_t)e * 1024 + col0 + bj * HALF + 4 * n);
#pragma unroll
        for (int ai = 0; ai < 2; ++ai)
#pragma unroll
            for (int m = 0; m < 4; ++m) { bf16_t* rowp = YS + (size_t)(row0 + ai * HALF + m * 16) * 1024 + col0;
#pragma unroll
                for (int bj = 0; bj < 2; ++bj) { const f32x4 v0 = acc[ai][bj][m][0] + bv[bj][0], v1 = acc[ai][bj][m][1] + bv[bj][1];
                    u32x4 w; w.x = cvt_pk_bf16(v0[0], v0[1]); w.y = cvt_pk_bf16(v0[2], v0[3]); w.z = cvt_pk_bf16(v1[0], v1[1]); w.w = cvt_pk_bf16(v1[2], v1[3]);
                    *(u32x4*)(rowp + bj * HALF) = w; } }
    }
};
}
#define XB_TMO      128
#define XB_XCNT(j)  (256  + 64 * (j))
#define XB_XSUB(j)  (1280 + 64 * (j))
#define XB_XGEN(j)  (2304 + 64 * (j))
#define XB_TOP      3328
#define XB_TOPGEN   3392
#define XCD_BAR_WORDS 3456
#define XB_SPIN_CAP (1u << 18)
#define LAS __attribute__((address_space(3)))

__device__ __forceinline__ unsigned xb_ld(unsigned* p)              { return __hip_atomic_load(p, __ATOMIC_RELAXED, __HIP_MEMORY_SCOPE_AGENT); }
__device__ __forceinline__ unsigned xb_add(unsigned* p, unsigned v) { return __hip_atomic_fetch_add(p, v, __ATOMIC_RELAXED, __HIP_MEMORY_SCOPE_AGENT); }
__device__ __forceinline__ unsigned xb_xcc_id() { return (unsigned)__builtin_amdgcn_s_getreg((3 << 11) | 20) & 0xFu; }
#define XB_SPIN(cond, bar) do { unsigned _sp = 0; while (cond) { __builtin_amdgcn_s_sleep(1); \
    if ((++_sp & 255u) == 0u) { if (xb_ld(&(bar)[XB_TMO])) break; if (_sp > XB_SPIN_CAP) { atomicAdd(&(bar)[XB_TMO], 1u); break; } } } } while (0)

struct XcdBarrier {
    unsigned* bar; unsigned x;
    volatile LAS unsigned* st;
};

__device__ __forceinline__ XcdBarrier xcd_barrier_post(unsigned* bar, volatile LAS unsigned* st) {
    XcdBarrier b; b.bar = bar; b.x = xb_xcc_id(); b.st = st;
    if (threadIdx.x == 0) (void)xb_add(&bar[XB_XCNT(b.x)], 1u);
    return b;
}
__device__ __forceinline__ void xcd_barrier_complete(unsigned* bar, unsigned x, unsigned& nloc, unsigned& nx) {
    const unsigned G = gridDim.x * gridDim.y * gridDim.z;
    unsigned sum, cnt, mine, sp = 0u;
    for (;;) {
        sum = 0u; cnt = 0u; mine = 0u;
#pragma unroll
        for (unsigned j = 0; j < 16; ++j) { const unsigned c = xb_ld(&bar[XB_XCNT(j)]); sum += c; cnt += (c > 0u) ? 1u : 0u; mine = (j == x) ? c : mine; }
        if (sum == G) break;
        __builtin_amdgcn_s_sleep(1);
        if ((++sp & 255u) == 0u) { if (xb_ld(&bar[XB_TMO])) break; if (sp > XB_SPIN_CAP) { atomicAdd(&bar[XB_TMO], 1u); break; } }
    }
    nloc = mine > 0u ? mine : 1u; nx = cnt > 0u ? cnt : 1u;
}

__device__ __forceinline__ void xcd_barrier(const XcdBarrier& b) {
    asm volatile("s_waitcnt vmcnt(0)" ::: "memory");
    __syncthreads();
    if (threadIdx.x == 0) {
        unsigned* bar = b.bar;
        __builtin_amdgcn_s_waitcnt(0);
        unsigned nloc = b.st[0], nx = b.st[1];
        if (nloc == 0u) { xcd_barrier_complete(bar, b.x, nloc, nx); b.st[0] = nloc; b.st[1] = nx; }
        const unsigned old = xb_add(&bar[XB_XSUB(b.x)], 1u);
        const unsigned gen = old / nloc;
        if (old + 1u == (gen + 1u) * nloc) {
            __builtin_amdgcn_fence(__ATOMIC_RELEASE, "agent");
            asm volatile("s_waitcnt vmcnt(0)" ::: "memory");
            const unsigned og = xb_add(&bar[XB_TOP], 1u);
            const unsigned tg = og / nx;
            if (og + 1u == (tg + 1u) * nx) xb_add(&bar[XB_TOPGEN], 1u);
            else XB_SPIN(xb_ld(&bar[XB_TOPGEN]) == tg, bar);
            __builtin_amdgcn_fence(__ATOMIC_ACQUIRE, "agent");
            xb_add(&bar[XB_XGEN(b.x)], 1u);
            asm volatile("s_waitcnt vmcnt(0)" ::: "memory");
        } else {
            XB_SPIN(xb_ld(&bar[XB_XGEN(b.x)]) == gen, bar);
            __builtin_amdgcn_fence(__ATOMIC_ACQUIRE, "agent");
            asm volatile("s_waitcnt vmcnt(0)" ::: "memory");
        }
    }
    __syncthreads();
}

struct Frame {
    LAS unsigned char* lds;
    unsigned* ctl;
    int tid, lane, wave, G, bid;
    const float* const* in; const float* const* in0;
    float* out;
    unsigned char* ws; unsigned char* ws0;
};
#define WSP(T, off) ((T*)(F.ws + (off)))
#define REFRESH_TID(F) do { int t_ = (int)__builtin_amdgcn_mbcnt_hi(~0u, __builtin_amdgcn_mbcnt_lo(~0u, 0u)); asm volatile("" : "+v"(t_)); F.lane = t_; F.tid = F.wave * 64 + t_; \
    int z_ = 0; asm volatile("s_mov_b32 %0, 0" : "=s"(z_)); F.ws = F.ws0 + z_; F.in = F.in0 + z_; F.bid = (int)blockIdx.x + z_; } while (0)
#define I_X 0
#define I_C 1
#define I_CTX 2
#define I_CCTX 3
#define I_WMOD 4
#define I_BMOD 5
#define I_G1 6
#define I_G2 7
#define I_WIN 8
#define I_AGQ 9
#define I_AGK 10
#define I_BCW 11
#define I_BCB 12
#define I_BLAM 13
#define I_BWR 14
#define I_BBR 15
#define I_BWI 16
#define I_BBI 17
#define I_CCW 18
#define I_CALOG 19
#define I_CDTB 20
#define I_CGOUT 21
#define I_RPB 22
#define I_WBR 23
#define I_WOUT 24
#define I_WRT 25
#define I_BRT 26
#define I_WGU 27
#define I_BGU 28
#define I_WDN 29
#define I_BDN 30
#define I_GFIN 31

__device__ __forceinline__ int mod_row(int r) { return r < TLAT ? (r >> 12) : 4; }

__device__ __forceinline__ void p0_transpose_item(const float* W, size_t pitch, int K, bf16* WT, int drow0, int scol0, int k0, LAS float* scr, int lane) {
    float v[32];
#pragma unroll
    for (int i = 0; i < 32; ++i) { const int kk = 2 * i + (lane >> 5); v[i] = W[(size_t)(k0 + kk) * pitch + scol0 + (lane & 31)]; }
#pragma unroll
    for (int i = 0; i < 32; ++i) { const int kk = 2 * i + (lane >> 5); scr[kk * 33 + (lane & 31)] = v[i]; }
    asm volatile("s_waitcnt lgkmcnt(0)" ::: "memory");
    const int c = lane & 7;
#pragma unroll
    for (int j = 0; j < 4; ++j) { const int n = (lane >> 3) + 8 * j; const LAS float* s = scr + (8 * c) * 33 + n;
        v4u o; o.x = pk2(s[0 * 33], s[1 * 33]); o.y = pk2(s[2 * 33], s[3 * 33]); o.z = pk2(s[4 * 33], s[5 * 33]); o.w = pk2(s[6 * 33], s[7 * 33]);
        *(v4u*)(WT + (size_t)(drow0 + n) * K + k0 + 8 * c) = o; }
    asm volatile("s_waitcnt lgkmcnt(0)" ::: "memory");
}

__device__ __forceinline__ void p0_prologue(Frame& F) {
    LAS float* scr = (LAS float*)(F.lds + F.wave * 16384);
    const int gw = F.bid * NWAVES + F.wave, NGW = F.G * NWAVES;
    constexpr int I_IN = DEPTH * 16 * (UW / 32);
    constexpr int I_BR = DEPTH * 4 * 8 * 32;
    constexpr int I_OUT = DEPTH * 16 * 32;
    constexpr int I_GU = DEPTH * NEXP * 16 * 64;
    constexpr int I_DN = DEPTH * NEXP * 16 * 32;
    constexpr int NITEMS = I_IN + I_BR + I_OUT + I_GU + I_DN;
    for (int it = gw; it < NITEMS; it += NGW) {
        int r = it;
        if (r < I_IN) { const int l = r / (16 * 296), q = r % (16 * 296), kb = q / 296, nb = q % 296; const int n0 = nb * 32, sc = n0 < 3840 ? n0 : n0 + 16;
            p0_transpose_item(F.in[I_WIN] + (size_t)l * D * INW, INW, D, WSP(bf16, WS_WIN) + (size_t)l * UW * D, n0, sc, kb * 64, scr, F.lane); continue; }
        r -= I_IN;
        if (r < I_BR) { const int mi = r / 256, q = r % 256, kb = q / 32, nb = q % 32;
            p0_transpose_item(F.in[I_WBR] + (size_t)mi * 512 * 1024, 1024, 512, WSP(bf16, WS_WBR) + (size_t)mi * 1024 * 512, nb * 32, nb * 32, kb * 64, scr, F.lane); continue; }
        r -= I_BR;
        if (r < I_OUT) { const int l = r / 512, q = r % 512, kb = q / 32, nb = q % 32;
            p0_transpose_item(F.in[I_WOUT] + (size_t)l * D * D, D, D, WSP(bf16, WS_WOUT) + (size_t)l * D * D, nb * 32, nb * 32, kb * 64, scr, F.lane); continue; }
        r -= I_OUT;
        if (r < I_GU) { const int mi = r / 1024, q = r % 1024, kb = q / 64, nb = q % 64; const int j0 = nb * 32, pn = j0 >> 8, bj = (j0 >> 7) & 1, cc = j0 & 127;
            p0_transpose_item(F.in[I_WGU] + (size_t)mi * D * 2048, 2048, D, WSP(bf16, WS_WGU) + (size_t)mi * 2048 * D, j0, 1024 * bj + 128 * pn + cc, kb * 64, scr, F.lane); continue; }
        r -= I_GU;
        { const int mi = r / 512, q = r % 512, kb = q / 32, nb = q % 32;
            p0_transpose_item(F.in[I_WDN] + (size_t)mi * D * D, D, D, WSP(bf16, WS_WDN) + (size_t)mi * D * D, nb * 32, nb * 32, kb * 64, scr, F.lane); }
    }
    __syncthreads();
    {
        LAS float* sc = (LAS float*)F.lds;
        LAS float* part = sc + 5 * 1024;
        bool staged = false;
        for (int it = F.bid; it < DEPTH * 96; it += F.G) {
            if (!staged) {
                for (int i = F.tid; i < 5 * 1024; i += NT) { const int r = i >> 10, k = i & 1023; const float cv = r < 4 ? F.in[I_C][r * 1024 + k] : F.in[I_CCTX][k]; sc[i] = siluf_(cv); }
                __syncthreads(); staged = true;
            }
            const int l = it / 96, cg = it % 96, col = cg * 64 + F.lane;
            const float* wm = F.in[I_WMOD] + (size_t)l * D * 6144 + col;
            float a0 = 0.f, a1 = 0.f, a2 = 0.f, a3 = 0.f, a4 = 0.f;
            const int kb = F.wave * 128;
#pragma unroll 16
            for (int k = 0; k < 128; ++k) { const float w = wm[(size_t)(kb + k) * 6144];
                a0 += sc[kb + k] * w; a1 += sc[1024 + kb + k] * w; a2 += sc[2048 + kb + k] * w; a3 += sc[3072 + kb + k] * w; a4 += sc[4096 + kb + k] * w; }
            LAS float* pp = part + F.wave * 320 + F.lane;
            pp[0] = a0; pp[64] = a1; pp[128] = a2; pp[192] = a3; pp[256] = a4;
            __syncthreads();
            if (F.tid < 320) { const int r = F.tid >> 6, ln = F.tid & 63; float s = 0.f;
#pragma unroll
                for (int w = 0; w < 8; ++w) s += part[w * 320 + r * 64 + ln];
                const int cc = cg * 64 + ln;
                WSP(float, WS_MOD)[((size_t)l * 5 + r) * 6144 + cc] = s + F.in[I_BMOD][l * 6144 + cc]; }
            __syncthreads();
        }
    }
    if (F.bid == 0) {
        for (int i = F.tid; i < 1024; i += NT) { const int p = i >> 4, f = i & 15; const float inv = powf(10000.f, -(float)f / 16.f); const float ang = (float)p * inv;
            WSP(float, WS_ROPE)[i] = cosf(ang); WSP(float, WS_ROPE)[1024 + i] = sinf(ang); }
    }
    for (int i = F.bid * NT + F.tid; i < DEPTH * 2 * 2 * 8 * 4096; i += F.G * NT) {
        const int c = i & 63, d = (i >> 6) & 63, n = (i >> 12) & 7, gate = (i >> 15) & 1, ld = i >> 16;
        const float* src = gate ? F.in[I_BWI] : F.in[I_BWR];
        WSP(bf16, WS_LRUW)[i] = (bf16)f2bf(src[((size_t)ld * 8 + n) * 4096 + c * 64 + d]);
    }
}

template <int MODE>
__device__ __forceinline__ void norm_phase(Frame& F, int l) {
    LAS float* hs = (LAS float*)F.lds;
    LAS int* lcnt = (LAS int*)(F.lds + 65536);
    LAS int* lbase = lcnt + 32;
    const int ngroups = (MODE == 2 ? TLAT : MROWS) / 16;
    const float* modl = WSP(float, WS_MOD) + (size_t)l * 5 * 6144;
    for (int gi = F.bid; gi < ngroups; gi += F.G) {
        REFRESH_TID(F);
        if (MODE == 1) { if (F.tid < 32) lcnt[F.tid] = 0; }
#pragma unroll
        for (int i = 0; i < 2; ++i) {
            const int lr = 2 * F.wave + i, r = gi * 16 + lr, mr = mod_row(r);
            const float* xsrc;
            if (MODE == 0 && l == 0) xsrc = r < TLAT ? F.in[I_X] + (size_t)r * D : F.in[I_CTX] + (size_t)(r - TLAT) * D;
            else xsrc = WSP(float, WS_X) + (size_t)r * D;
            f32x4 v[4];
#pragma unroll
            for (int j = 0; j < 4; ++j) v[j] = *(const f32x4*)(xsrc + 4 * F.lane + 256 * j);
            if ((MODE == 0 && l > 0) || MODE == 2) {
                const int lp = MODE == 2 ? DEPTH - 1 : l - 1;
                const float* gt2 = WSP(float, WS_MOD) + ((size_t)lp * 5 + mr) * 6144 + 5120;
                f32x4 cb[4];
#pragma unroll
                for (int j = 0; j < 4; ++j) cb[j] = (f32x4){0.f, 0.f, 0.f, 0.f};
#pragma unroll
                for (int k = 0; k < 4; ++k) {
                    const int sr = WSP(int, WS_SROW)[r * 4 + k]; const float w = WSP(float, WS_SW)[r * 4 + k];
                    const bf16* yr = WSP(bf16, WS_YS) + (size_t)sr * D;
#pragma unroll
                    for (int j = 0; j < 4; ++j) { const v2u y = *(const v2u*)(yr + 4 * F.lane + 256 * j);
                        cb[j].x += w * bflo(y.x); cb[j].y += w * bfhi(y.x); cb[j].z += w * bflo(y.y); cb[j].w += w * bfhi(y.y); }
                }
#pragma unroll
                for (int j = 0; j < 4; ++j) { const f32x4 g = *(const f32x4*)(gt2 + 4 * F.lane + 256 * j); v[j] = v[j] + g * cb[j]; }
            }
            if (MODE == 0) {
#pragma unroll
                for (int j = 0; j < 4; ++j) *(f32x4*)(WSP(float, WS_X) + (size_t)r * D + 4 * F.lane + 256 * j) = v[j];
            }
            float ss = 0.f;
#pragma unroll
            for (int j = 0; j < 4; ++j) ss += (v[j].x * v[j].x + v[j].y * v[j].y) + (v[j].z * v[j].z + v[j].w * v[j].w);
            const float rstd = rsqrtf(wave_sum(ss) * (1.f / D) + EPS);
            if (MODE == 2) {
#pragma unroll
                for (int j = 0; j < 4; ++j) { const f32x4 g = *(const f32x4*)(F.in[I_GFIN] + 4 * F.lane + 256 * j);
                    *(f32x4*)(F.out + (size_t)r * D + 4 * F.lane + 256 * j) = v[j] * rstd * g; }
            } else {
                const float* gn = F.in[MODE == 0 ? I_G1 : I_G2] + l * D;
                const float* sh = modl + (size_t)mr * 6144 + (MODE == 0 ? 0 : 3072);
                const float* sc = sh + 1024;
#pragma unroll
                for (int j = 0; j < 4; ++j) { const int c0 = 4 * F.lane + 256 * j;
                    const f32x4 g = *(const f32x4*)(gn + c0), a = *(const f32x4*)(sh + c0), s = *(const f32x4*)(sc + c0);
                    const f32x4 h = (v[j] * rstd * g) * (s + 1.f) + a;
                    *(LAS f32x4*)(hs + lr * 1024 + c0) = h;
                    v2u o; o.x = pk2(h.x, h.y); o.y = pk2(h.z, h.w);
                    *(v2u*)(WSP(bf16, WS_H) + (size_t)r * D + c0) = o; }
            }
        }
        if (MODE == 2) continue;
        __syncthreads();
        LAS float* red = (LAS float*)(F.lds + 65536 + 256);
        {
            const int r16 = F.lane & 15, quad = F.lane >> 4, w = F.wave;
            const size_t stride = MODE == 0 ? (size_t)INW : (size_t)NEXP;
            const float* wp = (MODE == 0 ? F.in[I_WIN] + (size_t)l * D * INW + 3840 : F.in[I_WRT] + (size_t)l * D * NEXP) + (size_t)(128 * w + quad) * stride + r16;
            const LAS float* hp = hs + r16 * 1024 + 128 * w + quad;
            f32x4 acc0 = (f32x4){0.f, 0.f, 0.f, 0.f}, acc1 = acc0;
            float b0[32], b1[32];
#pragma unroll
            for (int s = 0; s < 32; ++s) { b0[s] = wp[(size_t)(4 * s) * stride]; if (MODE == 1) b1[s] = wp[(size_t)(4 * s) * stride + 16]; }
#pragma unroll
            for (int s = 0; s < 32; ++s) { const float av = hp[4 * s];
                acc0 = __builtin_amdgcn_mfma_f32_16x16x4f32(av, b0[s], acc0, 0, 0, 0);
                if (MODE == 1) acc1 = __builtin_amdgcn_mfma_f32_16x16x4f32(av, b1[s], acc1, 0, 0, 0); }
#pragma unroll
            for (int j = 0; j < 4; ++j) { red[(w * 16 + 4 * quad + j) * 32 + r16] = acc0[j]; if (MODE == 1) red[(w * 16 + 4 * quad + j) * 32 + 16 + r16] = acc1[j]; }
        }
        __syncthreads();
        if (MODE == 0) {
            if (F.tid < 256) {
                const int lr = F.tid >> 4, col = F.tid & 15;
                float sacc = 0.f;
#pragma unroll
                for (int w = 0; w < 8; ++w) sacc += red[(w * 16 + lr) * 32 + col];
                WSP(float, WS_CAB)[(size_t)(gi * 16 + lr) * 16 + col] = sacc;
            }
        } else {
            const int lr = F.tid >> 5, e = F.tid & 31, r = gi * 16 + lr;
            float sacc = 0.f;
#pragma unroll
            for (int w = 0; w < 8; ++w) sacc += red[(w * 16 + lr) * 32 + e];
            const float lg = sacc + F.in[I_BRT][l * NEXP + e];
            float tv0, tv1, tv2, tv3; int ti0, ti1, ti2, ti3; bool taken = false;
#define TOP1(TV, TI) do { float bv = taken ? -INFINITY : lg; int bi = e; \
                _Pragma("unroll") for (int off = 16; off >= 1; off >>= 1) { const float ov = __shfl_xor(bv, off); const int oi = __shfl_xor(bi, off); \
                    if (ov > bv || (ov == bv && oi < bi)) { bv = ov; bi = oi; } } \
                TV = bv; TI = bi; if (bi == e) taken = true; } while (0)
            TOP1(tv0, ti0); TOP1(tv1, ti1); TOP1(tv2, ti2); TOP1(tv3, ti3);
#undef TOP1
            const float e1 = __expf(tv1 - tv0), e2 = __expf(tv2 - tv0), e3 = __expf(tv3 - tv0);
            const float inv = 1.f / (1.f + e1 + e2 + e3);
            const int my_e = e == 0 ? ti0 : (e == 1 ? ti1 : (e == 2 ? ti2 : ti3));
            const float my_w = e == 0 ? inv : (e == 1 ? e1 * inv : (e == 2 ? e2 * inv : e3 * inv));
            int pl = 0;
            if (e < 4) pl = atomicAdd((int*)&lcnt[my_e], 1);
            __syncthreads();
            if (F.tid < 32) { const int c = lcnt[F.tid]; lbase[F.tid] = c > 0 ? (int)__hip_atomic_fetch_add(F.ctl + CW_CNT + l * 32 + F.tid, (unsigned)c, __ATOMIC_RELAXED, __HIP_MEMORY_SCOPE_AGENT) : 0; }
            __syncthreads();
            if (e < 4) { const int p = lbase[my_e] + pl;
                WSP(int, WS_LIST)[(size_t)my_e * MROWS + p] = r * 4 + e;
                WSP(int, WS_SEP)[r * 4 + e] = (my_e << 20) | p;
                WSP(float, WS_SW)[r * 4 + e] = my_w; }
        }
        __syncthreads();
    }
}

__device__ __forceinline__ void moe_table(Frame& F, int l) {
    LAS int* tpre = (LAS int*)(F.lds + MISC_OFF + 256);
    LAS int* cnt = tpre + 40;
    __syncthreads();
    if (F.tid < 32) cnt[F.tid] = (int)__hip_atomic_load(F.ctl + CW_CNT + l * 32 + F.tid, __ATOMIC_RELAXED, __HIP_MEMORY_SCOPE_AGENT);
    __syncthreads();
    if (F.tid == 0) { int s = 0; for (int e = 0; e < 32; ++e) { tpre[e] = s; s += (cnt[e] + 255) >> 8; } tpre[32] = s; }
    __syncthreads();
}
__device__ __forceinline__ void moe_gather(Frame& F, int l) {
    moe_table(F, l);
    const LAS int* tpre = (const LAS int*)(F.lds + MISC_OFF + 256);
    const LAS int* cnt = tpre + 40;
    const int gw = F.bid * NWAVES + F.wave, NGW = F.G * NWAVES;
    REFRESH_TID(F);
    for (int e = 0; e < NEXP; ++e) {
        const int n = cnt[e], base = tpre[e] * 256;
        for (int p = gw; p < n; p += NGW) {
            const int tk = WSP(int, WS_LIST)[(size_t)e * MROWS + p]; const int tok = tk >> 2;
            const v4u* src = (const v4u*)(WSP(bf16, WS_H) + (size_t)tok * D);
            v4u* dst = (v4u*)(WSP(bf16, WS_HS) + (size_t)(base + p) * D);
            dst[F.lane] = src[F.lane]; dst[F.lane + 64] = src[F.lane + 64];
            if (F.lane == 0) WSP(int, WS_SROW)[tk] = base + p;
        }
    }
}

constexpr int AT_KP = 72, AT_VP = 68;
constexpr int AT_KB = 64 * AT_KP * 2, AT_VB = 64 * AT_VP * 2, AT_BUF = AT_KB + AT_VB;
constexpr int AT_RPB = 2 * AT_BUF;

struct AttnUnit {
    int kind;
    int b, hx, qx;
};

__device__ __forceinline__ void attn_unit(Frame& F, int l, const AttnUnit un) {
    REFRESH_TID(F);
    const int lane = F.lane, w = F.wave, q32 = lane & 31, hh = lane >> 5;
    const bf16* U = WSP(bf16, WS_U);
    const bool na = (un.kind & 1) != 0, ctxq = un.kind >= 2;
    const int b = un.b;
    int qrow0, qcol, kcol, ycol, nlat, krow_lat0, r_grid = 0, c0 = 0, rs_w = 0;
    const bf16* vt; bf16* Y;
    if (!na) {
        const int head = 4 * un.hx + (w & 3);
        qrow0 = (ctxq ? TLAT + b * LCTX : b * SEQ) + 64 * un.qx + 32 * (w >> 2);
        qcol = UQ + head * 64; kcol = UK + un.hx * 64; ycol = head * 64;
        vt = WSP(bf16, WS_VAT) + (size_t)(b * 2 + un.hx) * 64 * KEYS;
        Y = WSP(bf16, WS_Y);
        nlat = ctxq ? 0 : 64; krow_lat0 = b * SEQ;
    } else {
        const int head = un.hx;
        if (ctxq) { qrow0 = TLAT + b * LCTX + 32 * w; nlat = 0; krow_lat0 = 0; }
        else {
            r_grid = 4 * un.qx + (w >> 1); c0 = 32 * (w & 1);
            qrow0 = b * SEQ + 64 * r_grid + c0;
            int rs_min = 4 * un.qx - 4; rs_min = rs_min < 0 ? 0 : (rs_min > 56 ? 56 : rs_min);
            int rs_max = 4 * un.qx + 3 - 4; rs_max = rs_max < 0 ? 0 : (rs_max > 56 ? 56 : rs_max);
            nlat = rs_max + 8 - rs_min; krow_lat0 = b * SEQ + 64 * rs_min;
            rs_w = r_grid - 4; rs_w = rs_w < 0 ? 0 : (rs_w > 56 ? 56 : rs_w);
            rs_w -= rs_min;
        }
        qcol = UDQ + head * 64; kcol = UDK + head * 64; ycol = head * 64;
        vt = WSP(bf16, WS_VDT) + (size_t)(b * 8 + head) * 64 * KEYS;
        Y = WSP(bf16, WS_Y) + (size_t)3 * MROWS * 512;
    }
    const int vkey_lat0 = krow_lat0 - b * SEQ;
    const int ntile = nlat + 4;
    LAS unsigned char* lds = F.lds;
    if (na && !ctxq) {
        LAS float* rp = (LAS float*)(lds + AT_RPB);
        const float* src = F.in[I_RPB] + ((size_t)l * 8 + un.hx) * 465;
        for (int i = F.tid; i < 465; i += NT) rp[i] = src[i] * LOG2E;
    }
    bf16x8 qf[4];
    {
        const bf16* qp = U + (size_t)(qrow0 + q32) * UW + qcol + 8 * hh;
#pragma unroll
        for (int s = 0; s < 4; ++s) qf[s] = *(const bf16x8*)(qp + 16 * s);
    }
    const int lk = F.tid >> 3, lc = F.tid & 7;
    v4u kreg, vreg;
#define AT_LOAD(i) do { const int i_ = (i); int krow0_, vkey0_; \
        if (i_ < nlat) { krow0_ = krow_lat0 + 64 * i_; vkey0_ = vkey_lat0 + 64 * i_; } else { krow0_ = TLAT + b * LCTX + 64 * (i_ - nlat); vkey0_ = SEQ + 64 * (i_ - nlat); } \
        kreg = *(const v4u*)(U + (size_t)(krow0_ + lk) * UW + kcol + lc * 8); \
        vreg = *(const v4u*)(vt + (size_t)lk * KEYS + vkey0_ + lc * 8); } while (0)
#define AT_STORE(buf) do { LAS unsigned char* b_ = lds + (buf) * AT_BUF; \
        *(LAS v4u*)(b_ + lk * (AT_KP * 2) + lc * 16) = kreg; \
        *(LAS v2u*)(b_ + AT_KB + lk * (AT_VP * 2) + lc * 16) = (v2u){vreg.x, vreg.y}; \
        *(LAS v2u*)(b_ + AT_KB + lk * (AT_VP * 2) + lc * 16 + 8) = (v2u){vreg.z, vreg.w}; } while (0)
    float m_run = -1e30f, l_run = 0.f;
    f32x16 o0, o1;
#pragma unroll
    for (int i = 0; i < 16; ++i) { o0[i] = 0.f; o1[i] = 0.f; }
    const float sscale = 0.125f * LOG2E;
    const int cq = c0 + q32;
    int cst = cq - 8; cst = cst < 0 ? 0 : (cst > 48 ? 48 : cst);
    AT_LOAD(0);
    for (int i = 0; i < ntile; ++i) {
        AT_STORE(i & 1);
        if (i + 1 < ntile) AT_LOAD(i + 1);
        lds_barrier();
        const bool lat_na = na && !ctxq && i < nlat;
        if (lat_na && (i < rs_w || i > rs_w + 7)) continue;
        const LAS unsigned char* kb = lds + (i & 1) * AT_BUF;
        const LAS unsigned char* vb = kb + AT_KB;
        f32x16 s0, s1;
#pragma unroll
        for (int j = 0; j < 16; ++j) { s0[j] = 0.f; s1[j] = 0.f; }
#pragma unroll
        for (int s = 0; s < 4; ++s) {
            const bf16x8 k0 = *(const LAS bf16x8*)(kb + (q32) * (AT_KP * 2) + (16 * s + 8 * hh) * 2);
            const bf16x8 k1 = *(const LAS bf16x8*)(kb + (32 + q32) * (AT_KP * 2) + (16 * s + 8 * hh) * 2);
            s0 = __builtin_amdgcn_mfma_f32_32x32x16_bf16(k0, qf[s], s0, 0, 0, 0);
            s1 = __builtin_amdgcn_mfma_f32_32x32x16_bf16(k1, qf[s], s1, 0, 0, 0);
        }
        if (lat_na) {
            const LAS float* rp = (const LAS float*)(lds + AT_RPB);
            const int kr = (krow_lat0 - b * SEQ) / 64 + i;
            const int rb = (kr - r_grid + 7) * 31 + 15 - cq;
#pragma unroll
            for (int j = 0; j < 16; ++j) {
                const int kc0 = (j & 3) + 8 * (j >> 2) + 4 * hh, kc1 = kc0 + 32;
                const bool ok0 = kc0 >= cst && kc0 < cst + 16, ok1 = kc1 >= cst && kc1 < cst + 16;
                s0[j] = ok0 ? s0[j] * sscale + rp[ok0 ? rb + kc0 : 0] : -1e30f;
                s1[j] = ok1 ? s1[j] * sscale + rp[ok1 ? rb + kc1 : 0] : -1e30f;
            }
        } else if (na) {
#pragma unroll
            for (int j = 0; j < 16; ++j) { s0[j] *= sscale; s1[j] *= sscale; }
        }
        float mx = fmaxf(s0[0], s1[0]);
#pragma unroll
        for (int j = 1; j < 16; ++j) mx = fmaxf(mx, fmaxf(s0[j], s1[j]));
        mx = fmaxf(mx, __shfl_xor(mx, 32));
        const float m_new = fmaxf(m_run, mx);
        if (__builtin_amdgcn_ballot_w64(m_new > m_run) != 0ull) {
            const float alpha = __builtin_amdgcn_exp2f(m_run - m_new);
            l_run *= alpha;
#pragma unroll
            for (int j = 0; j < 16; ++j) { o0[j] *= alpha; o1[j] *= alpha; }
            m_run = m_new;
        }
        float ps = 0.f;
#pragma unroll
        for (int j = 0; j < 16; ++j) { s0[j] = __builtin_amdgcn_exp2f(s0[j] - m_run); s1[j] = __builtin_amdgcn_exp2f(s1[j] - m_run); ps += s0[j] + s1[j]; }
        l_run += ps;
        bf16x8 pb[2][2];
#pragma unroll
        for (int s2 = 0; s2 < 2; ++s2) {
            v4u t0, t1;
            t0.x = pk2(s0[8 * s2 + 0], s0[8 * s2 + 1]); t0.y = pk2(s0[8 * s2 + 2], s0[8 * s2 + 3]); t0.z = pk2(s0[8 * s2 + 4], s0[8 * s2 + 5]); t0.w = pk2(s0[8 * s2 + 6], s0[8 * s2 + 7]);
            t1.x = pk2(s1[8 * s2 + 0], s1[8 * s2 + 1]); t1.y = pk2(s1[8 * s2 + 2], s1[8 * s2 + 3]); t1.z = pk2(s1[8 * s2 + 4], s1[8 * s2 + 5]); t1.w = pk2(s1[8 * s2 + 6], s1[8 * s2 + 7]);
            pb[0][s2] = __builtin_bit_cast(bf16x8, t0); pb[1][s2] = __builtin_bit_cast(bf16x8, t1);
        }
#pragma unroll
        for (int sub = 0; sub < 2; ++sub)
#pragma unroll
            for (int s2 = 0; s2 < 2; ++s2) {
                const int ko = (32 * sub + 16 * s2 + 4 * hh) * 2;
                const v2u a0 = *(const LAS v2u*)(vb + (q32) * (AT_VP * 2) + ko), a1 = *(const LAS v2u*)(vb + (q32) * (AT_VP * 2) + ko + 16);
                const v2u c0_ = *(const LAS v2u*)(vb + (32 + q32) * (AT_VP * 2) + ko), c1_ = *(const LAS v2u*)(vb + (32 + q32) * (AT_VP * 2) + ko + 16);
                const bf16x8 vf0 = __builtin_bit_cast(bf16x8, ((v4u){a0.x, a0.y, a1.x, a1.y}));
                const bf16x8 vf1 = __builtin_bit_cast(bf16x8, ((v4u){c0_.x, c0_.y, c1_.x, c1_.y}));
                o0 = __builtin_amdgcn_mfma_f32_32x32x16_bf16(vf0, pb[sub][s2], o0, 0, 0, 0);
                o1 = __builtin_amdgcn_mfma_f32_32x32x16_bf16(vf1, pb[sub][s2], o1, 0, 0, 0);
            }
    }
#undef AT_LOAD
#undef AT_STORE
    const float lt = l_run + __shfl_xor(l_run, 32);
    const float inv = 1.f / lt;
    bf16* yp = Y + (size_t)(qrow0 + q32) * 512 + ycol + 4 * hh;
#pragma unroll
    for (int g = 0; g < 4; ++g) {
        v2u a; a.x = pk2(o0[4 * g] * inv, o0[4 * g + 1] * inv); a.y = pk2(o0[4 * g + 2] * inv, o0[4 * g + 3] * inv);
        v2u c; c.x = pk2(o1[4 * g] * inv, o1[4 * g + 1] * inv); c.y = pk2(o1[4 * g + 2] * inv, o1[4 * g + 3] * inv);
        *(v2u*)(yp + 8 * g) = a; *(v2u*)(yp + 32 + 8 * g) = c;
    }
    __syncthreads();
}

__device__ __forceinline__ void attn_phase(Frame& F, int l) {
    const int x = F.bid & 7, y = F.bid >> 3, ny = F.G >> 3;
    for (int q = y; q < 64; q += ny) { AttnUnit un; un.kind = 0; un.b = x >> 1; un.hx = x & 1; un.qx = q; attn_unit(F, l, un); }
    for (int q = y; q < 64; q += ny) { const int combo = x + 8 * (q >> 4); AttnUnit un; un.kind = 1; un.b = combo >> 3; un.hx = combo & 7; un.qx = q & 15; attn_unit(F, l, un); }
    for (int q = y; q < 8; q += ny) { AttnUnit un;
        if (q < 4) { un.kind = 2; un.b = x >> 1; un.hx = x & 1; un.qx = q; }
        else { const int combo = x + 8 * (q - 4); un.kind = 3; un.b = combo >> 3; un.hx = combo & 7; un.qx = 0; }
        attn_unit(F, l, un); }
}

__device__ __forceinline__ void qk_prep(Frame& F, int l) {
    REFRESH_TID(F);
    const int gw = F.bid * NWAVES + F.wave, NGW = F.G * NWAVES, lane = F.lane;
    bf16* U = WSP(bf16, WS_U);
    const float* tab = WSP(float, WS_ROPE);
    const int d0 = (lane & 7) * 8;
    float gq[8], gk[8];
#pragma unroll
    for (int j = 0; j < 8; ++j) { gq[j] = F.in[I_AGQ][l * 64 + d0 + j]; gk[j] = F.in[I_AGK][l * 64 + d0 + j]; }
    for (int r = gw; r < MROWS; r += NGW) {
        const bool lat = r < TLAT;
        bf16* up = U + (size_t)r * UW;
        const v4u qv = *(const v4u*)(up + UQ + lane * 8);
        v4u kv = (v4u){0u, 0u, 0u, 0u};
        if (lane < 16) kv = *(const v4u*)(up + UK + lane * 8);
        float cs[8], sn[8];
#pragma unroll
        for (int j = 0; j < 8; ++j) { cs[j] = 1.f; sn[j] = 0.f; }
        if (lat) { const int t = r & 4095;
#pragma unroll
            for (int j = 0; j < 8; ++j) { const int i = (d0 + j) & 31; const int idx = i < 16 ? (t >> 6) * 16 + i : (t & 63) * 16 + (i - 16); cs[j] = tab[idx]; sn[j] = tab[1024 + idx]; } }
#pragma unroll
        for (int which = 0; which < 2; ++which) {
            const v4u raw = which ? kv : qv;
            float x[8] = {bflo(raw.x), bfhi(raw.x), bflo(raw.y), bfhi(raw.y), bflo(raw.z), bfhi(raw.z), bflo(raw.w), bfhi(raw.w)};
            float ss = 0.f;
#pragma unroll
            for (int j = 0; j < 8; ++j) ss += x[j] * x[j];
            ss += __shfl_xor(ss, 1); ss += __shfl_xor(ss, 2); ss += __shfl_xor(ss, 4);
            const float rs = rsqrtf(ss * (1.f / 64.f) + EPS);
            float y[8];
#pragma unroll
            for (int j = 0; j < 8; ++j) y[j] = x[j] * rs * (which ? gk[j] : gq[j]);
            const bool hi = (lane & 4) != 0;
#pragma unroll
            for (int j = 0; j < 8; ++j) { const float p = __shfl_xor(y[j], 4);
                if (lat) y[j] = hi ? y[j] * cs[j] + p * sn[j] : y[j] * cs[j] - p * sn[j];
                if (!which) y[j] *= 0.125f * LOG2E; }
            v4u o; o.x = pk2(y[0], y[1]); o.y = pk2(y[2], y[3]); o.z = pk2(y[4], y[5]); o.w = pk2(y[6], y[7]);
            if (!which) *(v4u*)(up + UQ + lane * 8) = o; else if (lane < 16) *(v4u*)(up + UK + lane * 8) = o;
        }
    }
}

__device__ __forceinline__ void v_transpose(Frame& F) {
    REFRESH_TID(F);
    const int gw = F.bid * NWAVES + F.wave, NGW = F.G * NWAVES, lane = F.lane;
    LAS bf16* T = (LAS bf16*)(F.lds + F.wave * 9216);
    const bf16* U = WSP(bf16, WS_U);
    for (int it = gw; it < NCHUNK * 10; it += NGW) {
        const int g = it / 10, hd = it % 10;
        int b, key0;
        if (g < 256) { b = g >> 6; key0 = (g & 63) * 64; } else { b = (g - 256) >> 2; key0 = SEQ + ((g - 256) & 3) * 64; }
        const int scol = hd < 2 ? UV + hd * 64 : UDV + (hd - 2) * 64;
        bf16* dst = hd < 2 ? WSP(bf16, WS_VAT) + (size_t)(b * 2 + hd) * 64 * KEYS : WSP(bf16, WS_VDT) + (size_t)(b * 8 + hd - 2) * 64 * KEYS;
        v4u rv[8];
#pragma unroll
        for (int i = 0; i < 8; ++i) { const int tok = 8 * i + (lane >> 3), ch = lane & 7; rv[i] = *(const v4u*)(U + (size_t)(64 * g + tok) * UW + scol + ch * 8); }
#pragma unroll
        for (int i = 0; i < 8; ++i) { const int tok = 8 * i + (lane >> 3), ch = lane & 7; const unsigned wv[4] = {rv[i].x, rv[i].y, rv[i].z, rv[i].w};
#pragma unroll
            for (int j = 0; j < 4; ++j) { T[(ch * 8 + 2 * j) * 72 + tok] = (bf16)(wv[j] & 0xffffu); T[(ch * 8 + 2 * j + 1) * 72 + tok] = (bf16)(wv[j] >> 16); } }
        asm volatile("s_waitcnt lgkmcnt(0)" ::: "memory");
#pragma unroll
        for (int i = 0; i < 8; ++i) { const int d = 8 * i + (lane >> 3), ch = lane & 7;
            const v4u o = *(const LAS v4u*)(T + d * 72 + ch * 8);
            *(v4u*)(dst + (size_t)d * KEYS + key0 + ch * 8) = o; }
        asm volatile("s_waitcnt lgkmcnt(0)" ::: "memory");
    }
}

constexpr int LR_XCB = 0, LR_WV = 17408, LR_WVB = 12288;
__device__ __forceinline__ void seq_bounds(int g, int& lo, int& hi) {
    if (g < 256) { lo = (g >> 6) * SEQ; hi = lo + SEQ; } else { lo = TLAT + ((g - 256) >> 2) * LCTX; hi = lo + LCTX; }
}
__device__ __forceinline__ void lru_stage_conv(Frame& F, int l, int g, int q) {
    LAS bf16* raw = (LAS bf16*)(F.lds + LR_WV);
    LAS bf16* xcb = (LAS bf16*)(F.lds + LR_XCB);
    const bf16* U = WSP(bf16, WS_U);
    int lo, hi; seq_bounds(g, lo, hi);
    __syncthreads();
    for (int i = F.tid; i < 67 * 16; i += NT) { const int rr = i >> 4, ch = i & 15, row = 64 * g - 1 + rr;
        v4u v = (v4u){0u, 0u, 0u, 0u};
        if (row >= lo && row < hi) v = *(const v4u*)(U + (size_t)row * UW + UBX + 128 * q + ch * 8);
        *(LAS v4u*)(raw + rr * 128 + ch * 8) = v; }
    __syncthreads();
    {
        const int ch = F.tid & 127, tg = F.tid >> 7, cabs = 128 * q + ch;
        const float* cw = F.in[I_BCW] + (size_t)l * 4 * 512 + cabs;
        const float w0 = cw[0], w1 = cw[512], w2 = cw[1024], w3 = cw[1536], bb = F.in[I_BCB][l * 512 + cabs];
        float x0 = bf2f(raw[(16 * tg) * 128 + ch]), x1 = bf2f(raw[(16 * tg + 1) * 128 + ch]), x2 = bf2f(raw[(16 * tg + 2) * 128 + ch]);
#pragma unroll
        for (int t = 0; t < 16; ++t) { const float x3 = bf2f(raw[(16 * tg + t + 3) * 128 + ch]);
            const float y = bb + w0 * x0 + w1 * x1 + w2 * x2 + w3 * x3;
            xcb[(16 * tg + t) * 136 + ch] = (bf16)f2bf(y);
            x0 = x1; x1 = x2; x2 = x3; }
    }
    __syncthreads();
}
__device__ __forceinline__ void lru_gates(Frame& F, int l, int dir, int q) {
    const int lane = F.lane, w = F.wave, r16 = lane & 15, quad = lane >> 4;
    const LAS bf16* xcb = (const LAS bf16*)(F.lds + LR_XCB);
    LAS float* sa = (LAS float*)(F.lds + LR_WV + w * LR_WVB);
    LAS float* sb = sa + 1024;
    const int nbl = w >> 2, dt = w & 3, nb = 2 * q + nbl;
    const bf16* wr = WSP(bf16, WS_LRUW) + ((((size_t)(l * 2 + dir) * 2 + 0) * 8 + nb) * 64 + 16 * dt + r16) * 64 + 8 * quad;
    const bf16* wi = WSP(bf16, WS_LRUW) + ((((size_t)(l * 2 + dir) * 2 + 1) * 8 + nb) * 64 + 16 * dt + r16) * 64 + 8 * quad;
    const bf16x8 br0 = *(const bf16x8*)wr, br1 = *(const bf16x8*)(wr + 32), bi0 = *(const bf16x8*)wi, bi1 = *(const bf16x8*)(wi + 32);
    const int cabs = 64 * nb + 16 * dt + r16, cl = 64 * nbl + 16 * dt + r16;
    const float bR = F.in[I_BBR][(l * 2 + dir) * 512 + cabs], bI = F.in[I_BBI][(l * 2 + dir) * 512 + cabs];
    const float sp = softplusf_(-F.in[I_BLAM][(l * 2 + dir) * 512 + cabs]);
#pragma unroll
    for (int tt = 0; tt < 4; ++tt) {
        const LAS bf16* ap = xcb + (16 * tt + r16) * 136 + 64 * nbl + 8 * quad;
        const bf16x8 a0 = *(const LAS bf16x8*)ap, a1 = *(const LAS bf16x8*)(ap + 32);
        f32x4 ar = (f32x4){0.f, 0.f, 0.f, 0.f}, ai = ar;
        ar = __builtin_amdgcn_mfma_f32_16x16x32_bf16(a0, br0, ar, 0, 0, 0); ar = __builtin_amdgcn_mfma_f32_16x16x32_bf16(a1, br1, ar, 0, 0, 0);
        ai = __builtin_amdgcn_mfma_f32_16x16x32_bf16(a0, bi0, ai, 0, 0, 0); ai = __builtin_amdgcn_mfma_f32_16x16x32_bf16(a1, bi1, ai, 0, 0, 0);
#pragma unroll
        for (int j = 0; j < 4; ++j) { const int t = 16 * tt + 4 * quad + j;
            const float rg = sigmoidf_(ar[j] + bR), ig = sigmoidf_(ai[j] + bI);
            const float la = -8.f * rg * sp;
            const float a = __expf(la), x2 = 2.f * la;
            const float om = x2 > -0.05f ? -x2 * (1.f + x2 * (0.5f + x2 * (0.16666667f + x2 * 0.041666668f))) : 1.f - __expf(x2);
            const float mult = __builtin_amdgcn_sqrtf(om);
            const float xv = bf2f(xcb[t * 136 + cl]);
            sa[t * 16 + r16] = a; sb[t * 16 + r16] = mult * ig * xv; }
    }
    asm volatile("s_waitcnt lgkmcnt(0)" ::: "memory");
}
__device__ __forceinline__ void lru_pass1(Frame& F, int l) {
#pragma unroll 1
    for (int it = (F.bid + F.G / 2) % F.G; it < NCHUNK * 4; it += F.G) {
        REFRESH_TID(F);
        const int g = it >> 2, q = it & 3;
        lru_stage_conv(F, l, g, q);
#pragma unroll 1
        for (int dir = 0; dir < 2; ++dir) {
            lru_gates(F, l, dir, q);
            const int lane = F.lane, w = F.wave, ch = lane & 15, seg = lane >> 4;
            const LAS float* sa = (const LAS float*)(F.lds + LR_WV + w * LR_WVB); const LAS float* sb = sa + 1024;
            float A = 1.f, B = 0.f;
#pragma unroll
            for (int k = 0; k < 16; ++k) { const int tp = 16 * seg + k, t = dir ? 63 - tp : tp; const float a = sa[t * 16 + ch]; B = a * B + sb[t * 16 + ch]; A *= a; }
            float At = 1.f, Bt = 0.f;
#pragma unroll
            for (int s = 0; s < 4; ++s) { const float As = __shfl(A, 16 * s + ch), Bs = __shfl(B, 16 * s + ch); Bt = As * Bt + Bs; At *= As; }
            if (seg == 0) { const int cabs = 128 * q + 64 * (w >> 2) + 16 * (w & 3) + ch;
                WSP(float, WS_LRA)[((size_t)g * 2 + dir) * 512 + cabs] = At; WSP(float, WS_LRB)[((size_t)g * 2 + dir) * 512 + cabs] = Bt; }
            asm volatile("s_waitcnt lgkmcnt(0)" ::: "memory");
        }
    }
}
__device__ __forceinline__ void lru_carry_all(Frame& F) {
    REFRESH_TID(F);
    if (F.tid >= 16) return;
    const float* LA = WSP(float, WS_LRA); const float* LB = WSP(float, WS_LRB); float* LC = WSP(float, WS_LRC);
    for (int chain = F.bid * 16 + F.tid; chain < 4096; chain += F.G * 16) {
        const int ch = chain & 511, dir = (chain >> 9) & 1, b = chain >> 10;
        float h = 0.f;
#pragma unroll 1
        for (int sb = 0; sb < 4; ++sb) {
            float av[17], bv[17]; size_t ix[17];
#pragma unroll
            for (int k = 0; k < 17; ++k) { const int s = sb * 17 + k; int g;
                if (s < 4) g = 256 + 4 * b + (dir ? 3 - s : s); else g = 64 * b + (dir ? 63 - (s - 4) : (s - 4));
                ix[k] = ((size_t)g * 2 + dir) * 512 + ch; av[k] = LA[ix[k]]; bv[k] = LB[ix[k]]; }
#pragma unroll
            for (int k = 0; k < 17; ++k) { LC[ix[k]] = h; h = av[k] * h + bv[k]; }
        }
    }
}
__device__ __forceinline__ float gelu_tanh(float x) { const float u = 0.7978845608028654f * (x + 0.044715f * x * x * x); return x / (1.f + __expf(-2.f * u)); }
__device__ __forceinline__ void lru_pass2(Frame& F, int l) {
#pragma unroll 1
    for (int it = F.bid; it < NCHUNK * 4; it += F.G) {
        REFRESH_TID(F);
        const int g = it >> 2, q = it & 3;
        lru_stage_conv(F, l, g, q);
        const int lane = F.lane, w = F.wave, ch = lane & 15, seg = lane >> 4;
        LAS float* sa = (LAS float*)(F.lds + LR_WV + w * LR_WVB); LAS float* sb = sa + 1024; LAS float* sh = sa + 2048;
        const int cabs = 128 * q + 64 * (w >> 2) + 16 * (w & 3) + ch;
#pragma unroll 1
        for (int dir = 0; dir < 2; ++dir) {
            lru_gates(F, l, dir, q);
            float A = 1.f, B = 0.f;
#pragma unroll
            for (int k = 0; k < 16; ++k) { const int tp = 16 * seg + k, t = dir ? 63 - tp : tp; const float a = sa[t * 16 + ch]; B = a * B + sb[t * 16 + ch]; A *= a; }
            float h = WSP(float, WS_LRC)[((size_t)g * 2 + dir) * 512 + cabs];
#pragma unroll
            for (int s = 0; s < 3; ++s) { const float As = __shfl(A, 16 * s + ch), Bs = __shfl(B, 16 * s + ch); if (s < seg) h = As * h + Bs; }
#pragma unroll
            for (int k = 0; k < 16; ++k) { const int tp = 16 * seg + k, t = dir ? 63 - tp : tp; h = sa[t * 16 + ch] * h + sb[t * 16 + ch];
                if (dir == 0) sh[t * 16 + ch] = h; else sh[t * 16 + ch] += h; }
            asm volatile("s_waitcnt lgkmcnt(0)" ::: "memory");
        }
        const bf16* U = WSP(bf16, WS_U); bf16* YB = WSP(bf16, WS_Y) + (size_t)1 * MROWS * 512;
#pragma unroll
        for (int k = 0; k < 16; ++k) { const int t = 16 * seg + k; const size_t row = (size_t)64 * g + t;
            const float yv = bf2f(U[row * UW + UBY + cabs]);
            YB[row * 512 + cabs] = (bf16)f2bf(sh[t * 16 + ch] * gelu_tanh(yv)); }
        asm volatile("s_waitcnt lgkmcnt(0)" ::: "memory");
    }
}

#ifndef GDN_PREP_REPS
#define GDN_PREP_REPS 1
#endif
constexpr int GD_Q = 0, GD_K = 17408, GD_V = 34816, GD_KK = 52224, GD_QK = 68864, GD_L = 85504, GD_SM = 118272;
__device__ __forceinline__ void gdn_prep(Frame& F, int l) {
    const bf16* U = WSP(bf16, WS_U);
    const int w = F.wave;
#pragma unroll 1
    for (int it0 = F.bid; it0 < NCHUNK * 4 * GDN_PREP_REPS; it0 += F.G) {
        const int it = it0 % (NCHUNK * 4);
        int tid = F.tid; asm volatile("" : "+v"(tid));
        const int lane = tid & 63, r16 = lane & 15, quad = lane >> 4;
        const int g = it >> 2, h = it & 3;
        int lo, hi; seq_bounds(g, lo, hi);
        LAS bf16* raw = (LAS bf16*)(F.lds + GD_KK);
#pragma unroll 1
        for (int ten = 0; ten < 3; ++ten) {
            const int ucol = (ten == 0 ? UCQ : (ten == 1 ? UCK : UCV)) + 128 * h;
            __syncthreads();
            for (int i = tid; i < 67 * 16; i += NT) { const int rr = i >> 4, ch = i & 15, row = 64 * g - 1 + rr;
                v4u v = (v4u){0u, 0u, 0u, 0u};
                if (row >= lo && row < hi) v = *(const v4u*)(U + (size_t)row * UW + ucol + ch * 8);
                *(LAS v4u*)(raw + rr * 128 + ch * 8) = v; }
            __syncthreads();
            const int t = tid >> 3, ds = tid & 7;
            const float* cw = F.in[I_CCW] + (size_t)l * 4 * 1536 + ten * 512 + 128 * h + 16 * ds;
            float y[16]; float ss = 0.f;
#pragma unroll
            for (int jj = 0; jj < 16; ++jj) {
                float a = 0.f;
#pragma unroll
                for (int j = 0; j < 4; ++j) a += cw[j * 1536 + jj] * bf2f(raw[(t + j) * 128 + 16 * ds + jj]);
                a = siluf_(a); y[jj] = a; ss += a * a;
            }
            float sc = 1.f;
            if (ten < 2) { ss += __shfl_xor(ss, 1); ss += __shfl_xor(ss, 2); ss += __shfl_xor(ss, 4); sc = rsqrtf(ss + EPS); if (ten == 0) sc *= 0.08838834764831845f; }
            LAS bf16* dstp = (LAS bf16*)(F.lds + (ten == 0 ? GD_Q : (ten == 1 ? GD_K : GD_V))) + t * 136 + 16 * ds;
            v4u o0, o1;
            o0.x = pk2(y[0] * sc, y[1] * sc); o0.y = pk2(y[2] * sc, y[3] * sc); o0.z = pk2(y[4] * sc, y[5] * sc); o0.w = pk2(y[6] * sc, y[7] * sc);
            o1.x = pk2(y[8] * sc, y[9] * sc); o1.y = pk2(y[10] * sc, y[11] * sc); o1.z = pk2(y[12] * sc, y[13] * sc); o1.w = pk2(y[14] * sc, y[15] * sc);
            *(LAS v4u*)dstp = o0; *(LAS v4u*)(dstp + 8) = o1;
        }
        __syncthreads();
        const LAS bf16* qs = (const LAS bf16*)(F.lds + GD_Q); const LAS bf16* ks = (const LAS bf16*)(F.lds + GD_K); const LAS bf16* vs = (const LAS bf16*)(F.lds + GD_V);
        {
            const int mat = w >> 2, rt = w & 3;
            const LAS bf16* As = mat ? qs : ks;
            LAS float* Out = (LAS float*)(F.lds + (mat ? GD_QK : GD_KK));
            bf16x8 af[4];
#pragma unroll
            for (int s = 0; s < 4; ++s) af[s] = *(const LAS bf16x8*)(As + (16 * rt + r16) * 136 + 32 * s + 8 * quad);
#pragma unroll
            for (int ct = 0; ct < 4; ++ct) {
                f32x4 acc = (f32x4){0.f, 0.f, 0.f, 0.f};
#pragma unroll
                for (int s = 0; s < 4; ++s) { const bf16x8 bfr = *(const LAS bf16x8*)(ks + (16 * ct + r16) * 136 + 32 * s + 8 * quad);
                    acc = __builtin_amdgcn_mfma_f32_16x16x32_bf16(af[s], bfr, acc, 0, 0, 0); }
#pragma unroll
                for (int j = 0; j < 4; ++j) Out[(16 * rt + 4 * quad + j) * 65 + 16 * ct + r16] = acc[j];
            }
        }
        int tid2 = F.tid; asm volatile("" : "+v"(tid2));
        const int dir = tid2 >> 8, dt = tid2 & 255;
        LAS float* sm = (LAS float*)(F.lds + GD_SM) + dir * 256;
        if (dt < 64) {
            const int ti = dir ? 63 - dt : dt; const size_t row = (size_t)64 * g + ti;
            const float ga = WSP(float, WS_CAB)[row * 16 + dir * 4 + h], gb = WSP(float, WS_CAB)[row * 16 + 8 + dir * 4 + h];
            const float gv = -__expf(F.in[I_CALOG][(l * 2 + dir) * 4 + h]) * softplusf_(ga + F.in[I_CDTB][(l * 2 + dir) * 4 + h]);
            float v = gv;
#pragma unroll
            for (int off = 1; off < 64; off <<= 1) { const float u = __builtin_bit_cast(float, __builtin_amdgcn_ds_bpermute(((lane - off) & 63) << 2, __builtin_bit_cast(int, v))); if (lane >= off) v += u; }
            sm[dt] = gv; sm[64 + dt] = sigmoidf_(gb); sm[128 + dt] = v; sm[192 + dt] = __expf(v);
        }
        __syncthreads();
        const size_t cd = ((size_t)g * 4 + h) * 2 + dir;
        const LAS float* KK = (const LAS float*)(F.lds + GD_KK); const LAS float* QKm = (const LAS float*)(F.lds + GD_QK);
        LAS float* Ls = (LAS float*)(F.lds + GD_L) + dir * 4096;
        {
            bf16* gqk = WSP(bf16, WS_GQK) + cd * 4096;
            for (int idx = dt; idx < 4096; idx += 256) { const int i = idx >> 6, j = idx & 63; const int ti = dir ? 63 - i : i, tj = dir ? 63 - j : j;
                const float dec = j <= i ? __expf(sm[128 + i] - sm[128 + j]) : 0.f;
                Ls[idx] = j < i ? sm[64 + i] * KK[ti * 65 + tj] * dec : 0.f;
                gqk[idx] = (bf16)f2bf(QKm[ti * 65 + tj] * dec); }
        }
        __syncthreads();
        {
            float X[64];
            int c = F.tid & 255; asm volatile("" : "+v"(c));
            bf16* outp = WSP(bf16, WS_GW) + cd * 8192 + (c & 127);
            const LAS bf16* src = (c < 128 ? vs : ks) + (c & 127);
#pragma unroll
            for (int i = 0; i < 64; ++i) {
                const int ti = dir ? 63 - i : i;
                float a = sm[64 + i] * bf2f(src[ti * 136]); if (c >= 128) a *= sm[192 + i];
#pragma unroll
                for (int j = 0; j < i; ++j) a -= Ls[i * 64 + j] * X[j];
                X[i] = a;
                if (c >= 128) outp[i * 128] = (bf16)f2bf(a);
                asm volatile("" ::: "memory");
            }
            if (c < 128) {
                v4u* up = (v4u*)(WSP(bf16, WS_GU) + cd * 8192 + (size_t)c * 64);
#pragma unroll
                for (int q8 = 0; q8 < 8; ++q8) { v4u o; o.x = pk2(X[8 * q8], X[8 * q8 + 1]); o.y = pk2(X[8 * q8 + 2], X[8 * q8 + 3]); o.z = pk2(X[8 * q8 + 4], X[8 * q8 + 5]); o.w = pk2(X[8 * q8 + 6], X[8 * q8 + 7]); up[q8] = o; }
            }
        }
        {
            bf16* gqg = WSP(bf16, WS_GQG) + cd * 8192; bf16* gkd = WSP(bf16, WS_GKD) + cd * 8192;
            const float gl = sm[128 + 63];
            for (int idx = dt; idx < 8192; idx += 256) { const int i = idx >> 7, d = idx & 127; const int ti = dir ? 63 - i : i;
                gqg[idx] = (bf16)f2bf(bf2f(qs[ti * 136 + d]) * sm[192 + i]); }
            for (int idx = dt; idx < 8192; idx += 256) { const int d = idx >> 6, i = idx & 63; const int ti = dir ? 63 - i : i;
                gkd[idx] = (bf16)f2bf(bf2f(ks[ti * 136 + d]) * __expf(gl - sm[128 + i])); }
            if (dt == 0) WSP(float, WS_GGL)[cd] = __expf(gl);
        }
    }
    __syncthreads();
}

constexpr int GS_ST = 0, GS_VN = 4352, GS_O = 8192;
struct GdnOps { bf16x8 a[4]; bf16x8 qk[2]; bf16x8 kd[2]; v2u uv; float gl; };
__device__ __forceinline__ void gdn_load(Frame& F, GdnOps& o, size_t cd, int sl) {
    const int lane = F.lane, w = F.wave, r16 = lane & 15, quad = lane >> 4, rt = w & 3;
    const bf16* ap = (w < 4 ? WSP(bf16, WS_GW) : WSP(bf16, WS_GQG)) + cd * 8192 + (size_t)(16 * rt + r16) * 128 + 8 * quad;
#pragma unroll
    for (int s = 0; s < 4; ++s) o.a[s] = *(const bf16x8*)(ap + 32 * s);
    const bf16* kp = WSP(bf16, WS_GKD) + cd * 8192 + (size_t)(16 * w + r16) * 64 + 8 * quad;
    o.kd[0] = *(const bf16x8*)kp; o.kd[1] = *(const bf16x8*)(kp + 32);
    { const bf16* qp = WSP(bf16, WS_GQK) + cd * 4096 + (size_t)(16 * rt + r16) * 64 + 8 * quad; o.qk[0] = *(const bf16x8*)qp; o.qk[1] = *(const bf16x8*)(qp + 32); }
    o.uv = *(const v2u*)(WSP(bf16, WS_GU) + cd * 8192 + (size_t)(16 * sl + r16) * 64 + 16 * rt + 4 * quad);
    o.gl = WSP(float, WS_GGL)[cd];
}
__device__ __forceinline__ size_t gdn_cd(int b, int h, int dir, int s) {
    int g; if (s < 4) g = 256 + 4 * b + (dir ? 3 - s : s); else g = 64 * b + (dir ? 63 - (s - 4) : (s - 4));
    return ((size_t)g * 4 + h) * 2 + dir;
}
__device__ __forceinline__ void gdn_scan(Frame& F, int chain) {
    REFRESH_TID(F);
    const int xq = chain & 7, yq = chain >> 3, cg = (yq >> 3) * 8 + xq, sl = yq & 7;
    const int dir = cg & 1, h = (cg >> 1) & 3, b = cg >> 3;
    const int lane = F.lane, w = F.wave, r16 = lane & 15, quad = lane >> 4, rt = w & 3;
    LAS bf16* St = (LAS bf16*)(F.lds + GS_ST); LAS bf16* VNt = (LAS bf16*)(F.lds + GS_VN);
    __syncthreads();
    for (int i = F.tid; i < (GS_VN + 2304) / 4; i += NT) ((LAS unsigned*)F.lds)[i] = 0u;
    __syncthreads();
    f32x4 sacc = (f32x4){0.f, 0.f, 0.f, 0.f};
    float* GO = WSP(float, WS_GO) + (size_t)dir * MROWS * 512;
    LAS float* Ost = (LAS float*)(F.lds + GS_O);
#define GDN_STEP(cur, s_) do { \
        bf16x8 sbf[4]; \
        _Pragma("unroll") for (int ks = 0; ks < 4; ++ks) sbf[ks] = *(const LAS bf16x8*)(St + r16 * 136 + 32 * ks + 8 * quad); \
        f32x4 acc = (f32x4){0.f, 0.f, 0.f, 0.f}; \
        _Pragma("unroll") for (int ks = 0; ks < 4; ++ks) acc = __builtin_amdgcn_mfma_f32_16x16x32_bf16(cur.a[ks], sbf[ks], acc, 0, 0, 0); \
        if (w < 4) { v2u o; o.x = pk2(bflo(cur.uv.x) - acc[0], bfhi(cur.uv.x) - acc[1]); o.y = pk2(bflo(cur.uv.y) - acc[2], bfhi(cur.uv.y) - acc[3]); \
            *(LAS v2u*)(VNt + r16 * 72 + 16 * rt + 4 * quad) = o; } \
        lds_barrier(); \
        const bf16x8 vb0 = *(const LAS bf16x8*)(VNt + r16 * 72 + 8 * quad), vb1 = *(const LAS bf16x8*)(VNt + r16 * 72 + 32 + 8 * quad); \
        if (w >= 4) { \
            acc = __builtin_amdgcn_mfma_f32_16x16x32_bf16(cur.qk[0], vb0, acc, 0, 0, 0); \
            acc = __builtin_amdgcn_mfma_f32_16x16x32_bf16(cur.qk[1], vb1, acc, 0, 0, 0); \
            _Pragma("unroll") for (int j = 0; j < 4; ++j) Ost[(((s_) & 3) * 64 + 16 * rt + 4 * quad + j) * 16 + r16] = acc[j]; } \
        sacc = sacc * cur.gl; \
        sacc = __builtin_amdgcn_mfma_f32_16x16x32_bf16(cur.kd[0], vb0, sacc, 0, 0, 0); \
        sacc = __builtin_amdgcn_mfma_f32_16x16x32_bf16(cur.kd[1], vb1, sacc, 0, 0, 0); \
        { v2u o; o.x = pk2(sacc[0], sacc[1]); o.y = pk2(sacc[2], sacc[3]); *(LAS v2u*)(St + r16 * 136 + 16 * w + 4 * quad) = o; } \
        lds_barrier(); \
    } while (0)
    GdnOps r0, r1, r2, r3;
    gdn_load(F, r0, gdn_cd(b, h, dir, 0), sl); gdn_load(F, r1, gdn_cd(b, h, dir, 1), sl); gdn_load(F, r2, gdn_cd(b, h, dir, 2), sl); gdn_load(F, r3, gdn_cd(b, h, dir, 3), sl);
#pragma unroll 1
    for (int s = 0; s < 68; s += 4) {
        GDN_STEP(r0, s);     gdn_load(F, r0, gdn_cd(b, h, dir, (s + 4 < 68 ? s + 4 : 67)), sl);
        GDN_STEP(r1, s + 1); gdn_load(F, r1, gdn_cd(b, h, dir, (s + 5 < 68 ? s + 5 : 67)), sl);
        GDN_STEP(r2, s + 2); gdn_load(F, r2, gdn_cd(b, h, dir, (s + 6 < 68 ? s + 6 : 67)), sl);
        GDN_STEP(r3, s + 3);
#pragma unroll
        for (int k2 = 0; k2 < 2; ++k2) { const int idx = F.tid + 512 * k2, st = idx >> 8, i = (idx >> 2) & 63, qd = idx & 3;
            const f32x4 v = *(const LAS f32x4*)(Ost + (st * 64 + i) * 16 + 4 * qd);
            const int g = (int)(gdn_cd(b, h, dir, s + st) >> 3), ti = dir ? 63 - i : i;
            *(f32x4*)(GO + ((size_t)64 * g + ti) * 512 + h * 128 + 16 * sl + 4 * qd) = v; }
        gdn_load(F, r3, gdn_cd(b, h, dir, (s + 7 < 68 ? s + 7 : 67)), sl);
    }
#undef GDN_STEP
    __syncthreads();
}
__device__ __forceinline__ void gdn_out(Frame& F, int l) {
    REFRESH_TID(F);
    const int gw = F.bid * NWAVES + F.wave, NGW = F.G * NWAVES, lane = F.lane;
    const float* G0 = WSP(float, WS_GO); const float* G1 = G0 + (size_t)MROWS * 512;
    const bf16* U = WSP(bf16, WS_U); bf16* YC = WSP(bf16, WS_Y) + (size_t)2 * MROWS * 512;
    const float g0 = F.in[I_CGOUT][l * 128 + 2 * lane], g1 = F.in[I_CGOUT][l * 128 + 2 * lane + 1];
    for (int r = gw; r < MROWS; r += NGW) {
#pragma unroll
        for (int h = 0; h < 4; ++h) {
            const size_t o = (size_t)r * 512 + h * 128 + 2 * lane;
            const float a0 = G0[o] + G1[o], a1 = G0[o + 1] + G1[o + 1];
            const float ss = wave_sum(a0 * a0 + a1 * a1);
            const float rs = rsqrtf(ss * (1.f / 128.f) + EPS);
            const unsigned zz = *(const unsigned*)(U + (size_t)r * UW + UCZ + h * 128 + 2 * lane);
            *(unsigned*)(YC + o) = pk2(a0 * rs * g0 * siluf_(bflo(zz)), a1 * rs * g1 * siluf_(bfhi(zz)));
        }
    }
}

__device__ __forceinline__ void side_k256(f32x4& c0, f32x4& c1, const bf16* ap, const bf16* bp0, const bf16* bp1) {
    bf16x8 a[8], b0[8], b1[8];
#pragma unroll
    for (int s = 0; s < 8; ++s) { a[s] = *(const bf16x8*)(ap + 32 * s); b0[s] = *(const bf16x8*)(bp0 + 32 * s); b1[s] = *(const bf16x8*)(bp1 + 32 * s); }
#pragma unroll
    for (int s = 0; s < 8; ++s) { c0 = __builtin_amdgcn_mfma_f32_16x16x32_bf16(a[s], b0[s], c0, 0, 0, 0); c1 = __builtin_amdgcn_mfma_f32_16x16x32_bf16(a[s], b1[s], c1, 0, 0, 0); }
}
__device__ __forceinline__ void side_merge(Frame& F, int l) {
    REFRESH_TID(F);
    const int lane = F.lane, w = F.wave, r16 = lane & 15, quad = lane >> 4, rt = w & 3, chf = w >> 2;
    const bf16* U = WSP(bf16, WS_U);
    for (int tile = F.bid; tile < 256; tile += F.G) {
        const int row0 = TLAT + 64 * (tile >> 4) + 16 * rt, col0 = 64 * (tile & 15) + 32 * chf;
        f32x4 m0 = (f32x4){0.f, 0.f, 0.f, 0.f}, m1 = m0;
#pragma unroll 1
        for (int br = 0; br < 4; ++br) {
            const bf16* ap = WSP(bf16, WS_Y) + ((size_t)br * MROWS + row0 + r16) * 512 + 8 * quad;
            const bf16* bp0 = WSP(bf16, WS_WBR) + (((size_t)l * 4 + br) * 1024 + col0 + r16) * 512 + 8 * quad;
            const bf16* bp1 = bp0 + (size_t)16 * 512;
            f32x4 c0 = (f32x4){0.f, 0.f, 0.f, 0.f}, c1 = c0;
            side_k256(c0, c1, ap, bp0, bp1);
            side_k256(c0, c1, ap + 256, bp0 + 256, bp1 + 256);
#pragma unroll
            for (int j = 0; j < 4; ++j) { const bf16* gp = U + (size_t)(row0 + 4 * quad + j) * UW + UG + br * 1024 + col0 + r16;
                m0[j] += sigmoidf_(bf2f(gp[0])) * c0[j]; m1[j] += sigmoidf_(bf2f(gp[16])) * c1[j]; }
        }
#pragma unroll
        for (int j = 0; j < 4; ++j) { bf16* mp = WSP(bf16, WS_MB) + (size_t)(row0 + 4 * quad + j) * 1024 + col0 + r16;
            mp[0] = (bf16)f2bf(m0[j]); mp[16] = (bf16)f2bf(m1[j]); }
    }
}
__device__ __forceinline__ void side_outproj(Frame& F, int l) {
    REFRESH_TID(F);
    const int lane = F.lane, w = F.wave, r16 = lane & 15, quad = lane >> 4, rt = w & 3, chf = w >> 2;
    const float* gt = WSP(float, WS_MOD) + ((size_t)l * 5 + 4) * 6144 + 2048;
    for (int tile = F.bid; tile < 256; tile += F.G) {
        const int row0 = TLAT + 64 * (tile >> 4) + 16 * rt, col0 = 64 * (tile & 15) + 32 * chf;
        const bf16* ap = WSP(bf16, WS_MB) + (size_t)(row0 + r16) * 1024 + 8 * quad;
        const bf16* bp0 = WSP(bf16, WS_WOUT) + ((size_t)l * 1024 + col0 + r16) * 1024 + 8 * quad;
        const bf16* bp1 = bp0 + (size_t)16 * 1024;
        f32x4 c0 = (f32x4){0.f, 0.f, 0.f, 0.f}, c1 = c0;
#pragma unroll 1
        for (int kb = 0; kb < 4; ++kb) side_k256(c0, c1, ap + 256 * kb, bp0 + 256 * kb, bp1 + 256 * kb);
        const float g0 = gt[col0 + r16], g1 = gt[col0 + 16 + r16];
#pragma unroll
        for (int j = 0; j < 4; ++j) { float* xp = WSP(float, WS_X) + (size_t)(row0 + 4 * quad + j) * 1024 + col0 + r16;
            xp[0] += g0 * c0[j]; xp[16] += g1 * c1[j]; }
    }
}

#ifndef REP_P0
#define REP_P0 1
#endif
#ifndef REP_B
#define REP_B 1
#endif
#ifndef REP_D1
#define REP_D1 1
#endif
#ifndef REP_D2
#define REP_D2 1
#endif
#ifndef REP_E
#define REP_E 1
#endif
#ifndef REP_F
#define REP_F 1
#endif
#ifndef REP_I
#define REP_I 1
#endif
#ifndef REP_J
#define REP_J 1
#endif
#ifndef REP_C1
#define REP_C1 1
#endif
#ifndef REP_C2
#define REP_C2 1
#endif
#ifndef REP_C4
#define REP_C4 1
#endif
#ifndef REP_G2
#define REP_G2 1
#endif

constexpr int PH_PER_LAYER = 11, PH_FINAL = 1 + PH_PER_LAYER * DEPTH, N_PHASES = PH_FINAL + 1;
struct Args { const float* in[32]; float* out; unsigned char* ws; int ph_lo, ph_hi, li, pad; };

__global__ void __launch_bounds__(NT, 2) hybrid_fwd(Args args) {
    extern __shared__ __attribute__((aligned(16))) unsigned char lds_raw[];
    Frame F;
    F.lds = (LAS unsigned char*)lds_raw;
    F.wave = __builtin_amdgcn_readfirstlane((int)threadIdx.x >> 6); F.lane = (int)__builtin_amdgcn_mbcnt_hi(~0u, __builtin_amdgcn_mbcnt_lo(~0u, 0u)); F.tid = F.wave * 64 + F.lane;
    F.G = gridDim.x; F.bid = blockIdx.x;
    F.in = args.in; F.in0 = args.in;
    F.out = args.out; F.ws = args.ws; F.ws0 = args.ws; F.ctl = (unsigned*)(args.ws + WS_CTL);
    volatile LAS unsigned* MISC = (volatile LAS unsigned*)(F.lds + MISC_OFF);
    if (F.tid < 64) MISC[F.tid] = 0u;
    __syncthreads();
    const int lo = args.ph_lo, hi = args.ph_hi;
    XcdBarrier bar = xcd_barrier_post(F.ctl + CW_BAR + args.li * XCD_BAR_WORDS, MISC + 8);
#ifndef ONLY_MASK
#define ONLY_MASK 0xFFFF
#endif
#define PHON(b) ((ONLY_MASK >> (b)) & 1)
#define IN(k) (lo <= (k) && (k) < hi)
#define SEAM(k) do { if ((k) + 1 < hi) xcd_barrier(bar); } while (0)
#ifdef PROBE_PHASE
    unsigned long long pr_acc = 0ull, pr_t0 = 0ull;
#define PR_BEGIN(k) do { if ((k) == PROBE_PHASE) pr_t0 = __builtin_amdgcn_s_memrealtime(); } while (0)
#define PR_END(k) do { if ((k) == PROBE_PHASE) pr_acc += __builtin_amdgcn_s_memrealtime() - pr_t0; } while (0)
#else
#define PR_BEGIN(k) do { } while (0)
#define PR_END(k) do { } while (0)
#endif

    if (PHON(0) && IN(0)) { REFRESH_TID(F); _Pragma("unroll 1") for (int rep_ = 0; rep_ < REP_P0; ++rep_) { p0_prologue(F); __syncthreads(); } SEAM(0); PR_END(0); }
#pragma unroll 1
    for (int l = 0; l < DEPTH; ++l) {
        const int pb = 1 + PH_PER_LAYER * l;
        if (PHON(1) && IN(pb + 0)) { PR_BEGIN(1); REFRESH_TID(F); norm_phase<0>(F, l); SEAM(pb + 0); PR_END(1); }
        if (PHON(2) && IN(pb + 1)) { PR_BEGIN(2); REFRESH_TID(F);
            pg8::Gemm g{WSP(bf16, WS_H), WSP(bf16, WS_WIN) + (size_t)l * UW * D, MROWS, UW, D};
            pg8::StaticOrder S; S.init(MROWS, UW, F.G, F.bid);
            pg8::EpiStoreBf16 E{WSP(bf16, WS_U), UW};
            _Pragma("unroll 1") for (int rep_ = 0; rep_ < REP_B; ++rep_) { pg8::gemm_phase<pg8::EpiStoreBf16, pg8::StaticOrder, true, true>(F.lds, g, S, E, F.wave); __syncthreads(); }
            SEAM(pb + 1); PR_END(2);
        }
        if (PHON(3) && IN(pb + 2)) { PR_BEGIN(3); REFRESH_TID(F);
#ifndef NO_C1
            _Pragma("unroll 1") for (int rep_ = 0; rep_ < REP_C1; ++rep_) { gdn_prep(F, l); __syncthreads(); }
#endif
#ifndef NO_C2
            _Pragma("unroll 1") for (int rep_ = 0; rep_ < REP_C2; ++rep_) { lru_pass1(F, l); __syncthreads(); }
#endif
            __syncthreads();
#ifndef NO_C3
            qk_prep(F, l);
#endif
#ifndef NO_C4
            _Pragma("unroll 1") for (int rep_ = 0; rep_ < REP_C4; ++rep_) { v_transpose(F); __syncthreads(); }
#endif
            SEAM(pb + 2); PR_END(3);
        }
        if (PHON(4) && IN(pb + 3)) { PR_BEGIN(4); REFRESH_TID(F);
            _Pragma("unroll 1") for (int rep_ = 0; rep_ < REP_D1; ++rep_) { for (int ch = F.bid; ch < 256; ch += F.G) gdn_scan(F, ch); __syncthreads(); }
            lru_carry_all(F);
            __syncthreads();
            _Pragma("unroll 1") for (int rep_ = 0; rep_ < REP_D2; ++rep_) { attn_phase(F, l); __syncthreads(); }
            SEAM(pb + 3); PR_END(4);
        }
        if (PHON(5) && IN(pb + 4)) { PR_BEGIN(5); REFRESH_TID(F);
            _Pragma("unroll 1") for (int rep_ = 0; rep_ < REP_E; ++rep_) { lru_pass2(F, l); __syncthreads(); }
            __syncthreads();
            gdn_out(F, l);
            SEAM(pb + 4); PR_END(5);
        }
        if (PHON(6) && IN(pb + 5)) { PR_BEGIN(6); REFRESH_TID(F);
            pg8::Gemm g{WSP(bf16, WS_Y), WSP(bf16, WS_WBR) + (size_t)l * 4 * 1024 * 512, 4 * MROWS, 4 * 1024, 512};
            pg8::MergeOrder S{F.G, F.bid, MROWS / 256, TLAT / 256};
            pg8::EpiMerge E{WSP(bf16, WS_U), UW, UG, WSP(float, WS_MF), WSP(bf16, WS_MB), MROWS / 256};
            _Pragma("unroll 1") for (int rep_ = 0; rep_ < REP_F; ++rep_) { pg8::gemm_phase<pg8::EpiMerge, pg8::MergeOrder, true, true>(F.lds, g, S, E, F.wave); __syncthreads(); }
            side_merge(F, l);
            SEAM(pb + 5); PR_END(6);
        }
        if (PHON(7) && IN(pb + 6)) { PR_BEGIN(7); REFRESH_TID(F);
            pg8::Gemm g{WSP(bf16, WS_MB), WSP(bf16, WS_WOUT) + (size_t)l * D * D, MROWS, D, D};
            pg8::StaticOrder S; S.init(TLAT, D, F.G, F.bid);
            pg8::EpiResid E{WSP(float, WS_X), WSP(float, WS_MOD) + (size_t)l * 5 * 6144 + 2048};
            pg8::gemm_phase<pg8::EpiResid, pg8::StaticOrder, true, true>(F.lds, g, S, E, F.wave);
            side_outproj(F, l);
            SEAM(pb + 6); PR_END(7);
        }
        if (PHON(8) && IN(pb + 7)) { PR_BEGIN(8); REFRESH_TID(F); norm_phase<1>(F, l); SEAM(pb + 7); PR_END(8); }
        if (PHON(9) && IN(pb + 8)) { PR_BEGIN(9); REFRESH_TID(F); _Pragma("unroll 1") for (int rep_ = 0; rep_ < REP_G2; ++rep_) { moe_gather(F, l); __syncthreads(); } SEAM(pb + 8); PR_END(9); }
        if (PHON(10) && IN(pb + 9)) { PR_BEGIN(10); REFRESH_TID(F);
            moe_table(F, l);
            pg8::Gemm g{WSP(bf16, WS_HS), WSP(bf16, WS_WGU) + (size_t)l * NEXP * 2048 * D, MOE_ROWS, NEXP * 2048, D};
            pg8::MoeOrder S{(const LAS int*)(F.lds + MISC_OFF + 256), F.G, F.bid, 8};
            pg8::EpiSwiglu E{WSP(bf16, WS_ACT), F.in[I_BGU] + (size_t)l * NEXP * 2048};
            _Pragma("unroll 1") for (int rep_ = 0; rep_ < REP_I; ++rep_) { pg8::gemm_phase<pg8::EpiSwiglu, pg8::MoeOrder, true, true>(F.lds, g, S, E, F.wave); __syncthreads(); }
            SEAM(pb + 9); PR_END(10);
        }
        if (PHON(11) && IN(pb + 10)) { PR_BEGIN(11); REFRESH_TID(F);
            moe_table(F, l);
            pg8::Gemm g{WSP(bf16, WS_ACT), WSP(bf16, WS_WDN) + (size_t)l * NEXP * D * D, MOE_ROWS, NEXP * D, D};
            pg8::MoeOrder S{(const LAS int*)(F.lds + MISC_OFF + 256), F.G, F.bid, 4};
            pg8::EpiDown E{WSP(bf16, WS_YS), F.in[I_BDN] + (size_t)l * NEXP * D};
            _Pragma("unroll 1") for (int rep_ = 0; rep_ < REP_J; ++rep_) { pg8::gemm_phase<pg8::EpiDown, pg8::MoeOrder, true, true>(F.lds, g, S, E, F.wave); __syncthreads(); }
            SEAM(pb + 10); PR_END(11);
        }
    }
    if (PHON(12) && IN(PH_FINAL)) { PR_BEGIN(12); REFRESH_TID(F); norm_phase<2>(F, 0); PR_END(12); }
#ifdef PROBE_PHASE
    if (blockIdx.x == 0) { const unsigned long long te = __builtin_amdgcn_s_memrealtime(); while (__builtin_amdgcn_s_memrealtime() - te < PROBE_MULT * pr_acc) __builtin_amdgcn_s_sleep(8); }
#endif
#undef IN
#undef SEAM
}

extern "C" void kernel_launch(void* const* d_in, const int* in_sizes, int n_in, void* d_out, int out_size, void* d_ws, size_t ws_size, hipStream_t stream) {
    static int grid = 0;
    if (grid == 0) {
        if (n_in != 32 || out_size != TLAT * D || ws_size < WS_END) { fprintf(stderr, "kernel_launch: unexpected shapes (n_in %d out %d ws %zu need %zu)\n", n_in, out_size, ws_size, (size_t)WS_END); grid = -1; return; }
        int dev = 0, cus = 0, per_cu = 0;
        if (hipGetDevice(&dev) != hipSuccess || hipDeviceGetAttribute(&cus, hipDeviceAttributeMultiprocessorCount, dev) != hipSuccess) { grid = -1; return; }
        if (hipFuncSetAttribute((const void*)hybrid_fwd, hipFuncAttributeMaxDynamicSharedMemorySize, LDS_BYTES) != hipSuccess) { fprintf(stderr, "kernel_launch: hipFuncSetAttribute failed\n"); grid = -1; return; }
        if (hipOccupancyMaxActiveBlocksPerMultiprocessor(&per_cu, (const void*)hybrid_fwd, NT, LDS_BYTES) != hipSuccess || per_cu < 1) fprintf(stderr, "kernel_launch: occupancy query says %d\n", per_cu);
        (void)hipGetLastError();
        grid = cus;
    }
    if (grid < 0) return;
    if (hipMemsetAsync((char*)d_ws + WS_CTL, 0, CTL_BYTES, stream) != hipSuccess) return;
    Args a{};
    for (int i = 0; i < 32; ++i) a.in[i] = (const float*)d_in[i];
    a.out = (float*)d_out; a.ws = (unsigned char*)d_ws;
#if MK_MULTI
    for (int p = 0; p < N_PHASES; ++p) { a.ph_lo = p; a.ph_hi = p + 1; a.li = p;
        hipLaunchKernelGGL(hybrid_fwd, dim3(grid), dim3(NT), LDS_BYTES, stream, a); }
#else
    a.ph_lo = 0; a.ph_hi = N_PHASES; a.li = 0;
    hipLaunchKernelGGL(hybrid_fwd, dim3(grid), dim3(NT), LDS_BYTES, stream, a);
#endif
    const hipError_t le = hipPeekAtLastError();
    if (le != hipSuccess) fprintf(stderr, "kernel_launch: launch failed: %s\n", hipGetErrorName(le));
}
```

```cpp
#include <hip/hip_runtime.h>
#include <cstdio>
#include <cstdint>

#ifndef MK_MULTI
#define MK_MULTI 0
#endif

constexpr int D = 1024, NB = 4, SEQ = 4096, LCTX = 256, DEPTH = 4;
constexpr int TLAT = NB * SEQ, TCTX = NB * LCTX, MROWS = TLAT + TCTX;
constexpr int NCHUNK = MROWS / 64;
constexpr int INW = 9488, UW = 9472;
constexpr int UQ = 0, UK = 512, UV = 640, UBX = 768, UBY = 1280, UCQ = 1792, UCK = 2304, UCV = 2816, UCZ = 3328, UDQ = 3840, UDK = 4352, UDV = 4864, UG = 5376;
constexpr int NEXP = 32, TOPK = 4;
constexpr int KEYS = SEQ + LCTX;
constexpr int MOE_ROWS = MROWS * TOPK + NEXP * 256;
constexpr float EPS = 1e-6f;
constexpr float LOG2E = 1.4426950408889634f;

constexpr size_t al256(size_t x) { return (x + 255) & ~(size_t)255; }
constexpr size_t WS_CTL = 0, CTL_BYTES = 1u << 20;
constexpr size_t WS_MOD  = WS_CTL + CTL_BYTES;
constexpr size_t WS_ROPE = WS_MOD + al256((size_t)DEPTH * 5 * 6144 * 4);
constexpr size_t WS_LRUW = WS_ROPE + al256(2 * 64 * 16 * 4);
constexpr size_t WS_WIN  = WS_LRUW + al256((size_t)DEPTH * 2 * 2 * 8 * 4096 * 2);
constexpr size_t WS_WBR  = WS_WIN + al256((size_t)DEPTH * UW * D * 2);
constexpr size_t WS_WOUT = WS_WBR + al256((size_t)DEPTH * 4 * 1024 * 512 * 2);
constexpr size_t WS_WGU  = WS_WOUT + al256((size_t)DEPTH * D * D * 2);
constexpr size_t WS_WDN  = WS_WGU + al256((size_t)DEPTH * NEXP * 2048 * 1024 * 2);
constexpr size_t WS_X    = WS_WDN + al256((size_t)DEPTH * NEXP * 1024 * 1024 * 2);
constexpr size_t WS_H    = WS_X + al256((size_t)MROWS * D * 4);
constexpr size_t WS_U    = WS_H + al256((size_t)MROWS * D * 2);
constexpr size_t WS_CAB  = WS_U + al256((size_t)MROWS * UW * 2);
constexpr size_t WS_VAT  = WS_CAB + al256((size_t)MROWS * 16 * 4);
constexpr size_t WS_VDT  = WS_VAT + al256((size_t)NB * 2 * 64 * KEYS * 2);
constexpr size_t WS_LRA  = WS_VDT + al256((size_t)NB * 8 * 64 * KEYS * 2);
constexpr size_t WS_LRB  = WS_LRA + al256((size_t)NCHUNK * 2 * 512 * 4);
constexpr size_t WS_LRC  = WS_LRB + al256((size_t)NCHUNK * 2 * 512 * 4);
constexpr int NCD = NCHUNK * 4 * 2;
constexpr size_t WS_GW   = WS_LRC + al256((size_t)NCHUNK * 2 * 512 * 4);
constexpr size_t WS_GU   = WS_GW + al256((size_t)NCD * 64 * 128 * 2);
constexpr size_t WS_GQG  = WS_GU + al256((size_t)NCD * 64 * 128 * 2);
constexpr size_t WS_GKD  = WS_GQG + al256((size_t)NCD * 64 * 128 * 2);
constexpr size_t WS_GQK  = WS_GKD + al256((size_t)NCD * 64 * 128 * 2);
constexpr size_t WS_GGL  = WS_GQK + al256((size_t)NCD * 64 * 64 * 2);
constexpr size_t WS_GO   = WS_GGL + al256((size_t)NCD * 4);
constexpr size_t WS_Y    = WS_GO + al256((size_t)2 * MROWS * 512 * 4);
constexpr size_t WS_MF   = WS_Y + al256((size_t)4 * MROWS * 512 * 2);
constexpr size_t WS_MB   = WS_MF + al256((size_t)MROWS * D * 4);
constexpr size_t WS_SROW = WS_MB + al256((size_t)MROWS * D * 2);
constexpr size_t WS_SW   = WS_SROW + al256((size_t)MROWS * 4 * 4);
constexpr size_t WS_SEP  = WS_SW + al256((size_t)MROWS * 4 * 4);
constexpr size_t WS_LIST = WS_SEP + al256((size_t)MROWS * 4 * 4);
constexpr size_t WS_HS   = WS_LIST + al256((size_t)NEXP * MROWS * 4);
constexpr size_t WS_ACT  = WS_HS + al256((size_t)MOE_ROWS * D * 2);
constexpr size_t WS_YS   = WS_ACT + al256((size_t)MOE_ROWS * D * 2);
constexpr size_t WS_END  = WS_YS + al256((size_t)MOE_ROWS * D * 2);

constexpr int CW_BAR = 4096;
constexpr int CW_CNT = 1024;

constexpr int RING_BYTES = 131072;
constexpr int MISC_OFF = RING_BYTES;
constexpr int LDS_BYTES = 147456;
constexpr int NWAVES = 8, NT = 512;

#define GAS __attribute__((address_space(1)))
#define LAS __attribute__((address_space(3)))
typedef unsigned short bf16;
typedef unsigned v4u __attribute__((ext_vector_type(4)));
typedef unsigned v2u __attribute__((ext_vector_type(2)));
typedef float f32x4 __attribute__((ext_vector_type(4)));
typedef float f32x16 __attribute__((ext_vector_type(16)));
typedef short bf16x8 __attribute__((ext_vector_type(8)));
typedef short bf16x4 __attribute__((ext_vector_type(4)));

typedef float f32x2_t __attribute__((ext_vector_type(2))); typedef __bf16 bf16x2_t __attribute__((ext_vector_type(2)));
__device__ __forceinline__ unsigned pk2(float lo, float hi) { f32x2_t v = {lo, hi}; bf16x2_t b = __builtin_convertvector(v, bf16x2_t); return __builtin_bit_cast(unsigned, b); }
__device__ __forceinline__ unsigned f2bf(float f) { return pk2(f, 0.f) & 0xffffu; }
__device__ __forceinline__ float bf2f(unsigned short b) { return __builtin_bit_cast(float, (unsigned)b << 16); }
__device__ __forceinline__ float bflo(unsigned w) { return __builtin_bit_cast(float, w << 16); }
__device__ __forceinline__ float bfhi(unsigned w) { return __builtin_bit_cast(float, w & 0xffff0000u); }
__device__ __forceinline__ float wave_sum(float v) {
#pragma unroll
    for (int o = 1; o < 64; o <<= 1) v += __shfl_xor(v, o);
    return v;
}
__device__ __forceinline__ float sigmoidf_(float x) { return 1.f / (1.f + __expf(-x)); }
__device__ __forceinline__ float softplusf_(float x) { return x > 20.f ? x : log1pf(__expf(x)); }
__device__ __forceinline__ float siluf_(float x) { return x / (1.f + __expf(-x)); }
__device__ __forceinline__ void lds_barrier() { asm volatile("s_waitcnt lgkmcnt(0)\n\ts_barrier" ::: "memory"); }
namespace pg8 {
#define PG8_LAS __attribute__((address_space(3)))
typedef unsigned short bf16_t;
typedef short bf16x8 __attribute__((ext_vector_type(8)));
typedef float f32x4 __attribute__((ext_vector_type(4)));
typedef unsigned u32x4 __attribute__((ext_vector_type(4)));
constexpr int BM = 256, BK = 64, HALF = 128, HTB = HALF * BK * 2  , STAGE_BYTES = 8 * HTB, NXCD = 8, WGM = 8;

__host__ __device__ __forceinline__ int lds_byte(int r, int c) { const int st = (r >> 4) * 2 + (c >> 5), rr = r & 15, cc = c & 31, ob = rr * 64 + cc * 2; return st * 1024 + (ob ^ (((ob >> 9) & 1) << 5)); }
__host__ __device__ __forceinline__ void stage_rc(int b, int& R, int& C) { const int st = b / 1024, sb = b % 1024, swz = sb ^ (((sb >> 9) & 1) << 5); R = (st >> 1) * 16 + swz / 64; C = (st & 1) * 32 + (swz % 64) / 2; }
__host__ __device__ __forceinline__ int perm32(int rho) { const int n = rho >> 4, i = rho & 15; return 8 * (i >> 2) + 4 * n + (i & 3); }

struct Unit { int pm, pn; };
struct Gemm { const bf16_t* A; const bf16_t* Bt; int M, N, K; };

struct StaticOrder {
    int nM, nN, nwg, G, c;
    __host__ __device__ void init(int M, int N, int G_, int c_) { nM = M / BM; nN = N / BM; nwg = nM * nN; G = G_; c = c_; }
    __host__ __device__ bool next(int i, Unit& u) const {
        const long L = (long)i * G + c; if (L >= nwg) return false;
        int wgid = (int)L; { const int q = nwg / NXCD, r = nwg % NXCD, xcd = wgid % NXCD, off = wgid / NXCD; wgid = (xcd < r ? xcd * (q + 1) : r * (q + 1) + (xcd - r) * q) + off; }
        const int nig = WGM * nN, gid = wgid / nig, fm = gid * WGM, gsz = (nM - fm) < WGM ? (nM - fm) : WGM;
        u.pm = fm + ((wgid % nig) % gsz); u.pn = (wgid % nig) / gsz; return true;
    }
    __device__ __forceinline__ void a_ready(const Unit&) const {}
    __device__ __forceinline__ void done(const Unit&) const {}
};

__device__ __forceinline__ unsigned cvt_pk_bf16(float lo, float hi) { unsigned r; asm volatile("v_cvt_pk_bf16_f32 %0, %1, %2" : "=v"(r) : "v"(lo), "v"(hi)); return r; }
typedef float f32x2 __attribute__((ext_vector_type(2)));
template <class Epi, class Sched, bool ALIGN_EPI = false, bool SP2 = false>
__device__ __forceinline__ void gemm_phase(PG8_LAS unsigned char* lds, const Gemm g, const Sched& S, const Epi& E, const int wid_in) {
    int lane_o = (int)__builtin_amdgcn_mbcnt_hi(~0u, __builtin_amdgcn_mbcnt_lo(~0u, 0u)); asm volatile("" : "+v"(lane_o));
    const int wid = __builtin_amdgcn_readfirstlane(wid_in), lane = lane_o, tid = wid * 64 + lane, wr = wid >> 2, wc = wid & 3, fr = lane & 15, fq = lane >> 4;
    const int K = g.K, nt = K / BK;
    unsigned voffA[2], voffB[2];
#pragma unroll
    for (int i = 0; i < 2; ++i) { int R, C; stage_rc(tid * 16 + i * 8192, R, C); const int Rb = Epi::PERM ? ((R & ~31) + perm32(R & 31)) : R;
        voffA[i] = (unsigned)(R * K + C) * 2u; voffB[i] = (unsigned)(Rb * K + C) * 2u; }
    const size_t kstep = (size_t)(BK * 2);
    const size_t hstep = (size_t)HALF * K * 2;
    const size_t tstep = 2 * hstep;
    const unsigned ldsw = (unsigned)wid * 1024u;
    const int aoff = lds_byte(wr * 64 + fr, fq * 8), boff = lds_byte(wc * 32 + fr, fq * 8);
#define PG8_SA(b, h) (((b) * 2 + (h)) * HTB)
#define PG8_SB(b, h) ((4 + (b) * 2 + (h)) * HTB)
#define PG8_STAGE(bufoff, gbase, voff) do { _Pragma("unroll") for (int _i = 0; _i < 2; ++_i) \
        __builtin_amdgcn_global_load_lds((const unsigned*)((const char*)(gbase) + (voff)[_i]), (PG8_LAS unsigned*)(lds + (bufoff) + ldsw + _i * 8192), 16, 0, 0); } while (0)
#define PG8_LDA(dst, b, h) do { _Pragma("unroll") for (int m = 0; m < 4; ++m) _Pragma("unroll") for (int k = 0; k < 2; ++k) dst[m][k] = *(const PG8_LAS bf16x8*)(lds + PG8_SA(b, h) + aoff + m * 2048 + k * 1024); } while (0)
#define PG8_LDB(dst, b, h) do { _Pragma("unroll") for (int n = 0; n < 2; ++n) _Pragma("unroll") for (int k = 0; k < 2; ++k) dst[n][k] = *(const PG8_LAS bf16x8*)(lds + PG8_SB(b, h) + boff + n * 2048 + k * 1024); } while (0)
#define PG8_MMA(ai, bj, At, Bt) do { __builtin_amdgcn_s_setprio(1); _Pragma("unroll") for (int m = 0; m < 4; ++m) _Pragma("unroll") for (int n = 0; n < 2; ++n) _Pragma("unroll") for (int k = 0; k < 2; ++k) \
        acc[ai][bj][m][n] = __builtin_amdgcn_mfma_f32_16x16x32_bf16(Bt[n][k], At[m][k], acc[ai][bj][m][n], 0, 0, 0); __builtin_amdgcn_s_setprio(0); } while (0)
#define PG8_WAIT_V(n) asm volatile("s_waitcnt vmcnt(" #n ")" ::: "memory")
#define PG8_WAIT_L(n) asm volatile("s_waitcnt lgkmcnt(" #n ")" ::: "memory")
#define PG8_BAR __builtin_amdgcn_s_barrier()
#define PG8_SCHED __builtin_amdgcn_sched_barrier(0)
    Unit cur, nxt; int ui = 0;
    if (!S.next(0, cur)) return;
    f32x4 acc[2][2][4][2];
#pragma unroll
    for (int a = 0; a < 2; ++a)
#pragma unroll
        for (int b = 0; b < 2; ++b)
#pragma unroll
            for (int m = 0; m < 4; ++m)
#pragma unroll
                for (int n = 0; n < 2; ++n) acc[a][b][m][n] = (f32x4){0.f, 0.f, 0.f, 0.f};
    bf16x8 At[4][2], B0[2][2], B1[2][2];
    const char* cA = (const char*)g.A + (size_t)cur.pm * tstep; const char* cB = (const char*)g.Bt + (size_t)cur.pn * tstep;
    S.a_ready(cur);
    if constexpr (SP2) {
        PG8_STAGE(PG8_SB(0, 0), cB, voffB); PG8_STAGE(PG8_SB(0, 1), cB + hstep, voffB); PG8_STAGE(PG8_SA(0, 0), cA, voffA); PG8_STAGE(PG8_SA(0, 1), cA + hstep, voffA);
        if (wr == 1) PG8_BAR;
        PG8_WAIT_V(2); PG8_BAR;
        PG8_STAGE(PG8_SB(1, 0), cB + kstep, voffB); PG8_STAGE(PG8_SA(1, 0), cA + kstep, voffA); PG8_STAGE(PG8_SB(1, 1), cB + hstep + kstep, voffB);
        PG8_WAIT_V(6); PG8_BAR;
    } else {
        PG8_STAGE(PG8_SB(0, 0), cB, voffB); PG8_STAGE(PG8_SA(0, 0), cA, voffA); PG8_STAGE(PG8_SB(0, 1), cB + hstep, voffB); PG8_STAGE(PG8_SA(0, 1), cA + hstep, voffA);
        if (wr == 1) PG8_BAR;
        PG8_WAIT_V(4); PG8_BAR;
        PG8_STAGE(PG8_SB(1, 0), cB + kstep, voffB); PG8_STAGE(PG8_SA(1, 0), cA + kstep, voffA); PG8_STAGE(PG8_SB(1, 1), cB + hstep + kstep, voffB);
        PG8_WAIT_V(6); PG8_BAR;
    }
    for (;;) {
        const bool has_next = S.next(ui + 1, nxt);
        const char* nA = has_next ? (const char*)g.A + (size_t)nxt.pm * tstep : cA; const char* nB = has_next ? (const char*)g.Bt + (size_t)nxt.pn * tstep : cB;
        for (int t = 0; t < nt; t += 2) {
            const bool last = (t == nt - 2);
            const char* a1 = cA + (size_t)(t + 1) * kstep;
            const char* a2 = last ? nA : cA + (size_t)(t + 2) * kstep; const char* b2 = last ? nB : cB + (size_t)(t + 2) * kstep;
            const char* a3 = a2 + kstep; const char* b3 = b2 + kstep;
            if (last && has_next) S.a_ready(nxt);
            if constexpr (SP2) {
            PG8_LDB(B0, 0, 0); PG8_LDB(B1, 0, 1); PG8_SCHED; PG8_LDA(At, 0, 0); PG8_STAGE(PG8_SA(1, 1), a1 + hstep, voffA);
            PG8_WAIT_V(8); PG8_WAIT_L(0); PG8_BAR; PG8_MMA(0, 0, At, B0); PG8_MMA(0, 1, At, B1); PG8_BAR; PG8_SCHED;
            PG8_LDA(At, 0, 1); PG8_STAGE(PG8_SB(0, 0), b2, voffB); PG8_STAGE(PG8_SB(0, 1), b2 + hstep, voffB); PG8_STAGE(PG8_SA(0, 0), a2, voffA);
            PG8_WAIT_V(8); PG8_WAIT_L(0); PG8_BAR; PG8_MMA(1, 0, At, B0); PG8_MMA(1, 1, At, B1); PG8_BAR; PG8_SCHED;
            PG8_LDB(B0, 1, 0); PG8_LDB(B1, 1, 1); PG8_SCHED; PG8_LDA(At, 1, 0); PG8_STAGE(PG8_SA(0, 1), a2 + hstep, voffA);
            PG8_WAIT_V(8); PG8_WAIT_L(0); PG8_BAR; PG8_MMA(0, 0, At, B0); PG8_MMA(0, 1, At, B1); PG8_BAR; PG8_SCHED;
            PG8_LDA(At, 1, 1); PG8_STAGE(PG8_SB(1, 0), b3, voffB); PG8_STAGE(PG8_SB(1, 1), b3 + hstep, voffB); PG8_STAGE(PG8_SA(1, 0), a3, voffA);
            PG8_WAIT_V(8); PG8_WAIT_L(0); PG8_BAR; PG8_MMA(1, 0, At, B0); PG8_MMA(1, 1, At, B1); PG8_BAR; PG8_SCHED;
            } else {
            PG8_LDB(B0, 0, 0); PG8_SCHED; PG8_LDA(At, 0, 0); PG8_STAGE(PG8_SA(1, 1), a1 + hstep, voffA);
            PG8_WAIT_L(8); PG8_BAR; PG8_WAIT_L(0); PG8_MMA(0, 0, At, B0); PG8_BAR; PG8_SCHED;
            PG8_LDB(B1, 0, 1); PG8_STAGE(PG8_SB(0, 0), b2, voffB);
            PG8_BAR; PG8_WAIT_L(0); PG8_MMA(0, 1, At, B1); PG8_BAR;
            PG8_LDA(At, 0, 1); PG8_STAGE(PG8_SA(0, 0), a2, voffA);
            PG8_BAR; PG8_WAIT_L(0); PG8_MMA(1, 0, At, B0); PG8_BAR; PG8_SCHED;
            PG8_STAGE(PG8_SB(0, 1), b2 + hstep, voffB);
            PG8_WAIT_V(6); PG8_BAR; PG8_MMA(1, 1, At, B1); PG8_BAR;
            PG8_LDB(B0, 1, 0); PG8_SCHED; PG8_LDA(At, 1, 0); PG8_STAGE(PG8_SA(0, 1), a2 + hstep, voffA);
            PG8_WAIT_L(8); PG8_BAR; PG8_WAIT_L(0); PG8_MMA(0, 0, At, B0); PG8_BAR; PG8_SCHED;
            PG8_LDB(B1, 1, 1); PG8_STAGE(PG8_SB(1, 0), b3, voffB);
            PG8_BAR; PG8_WAIT_L(0); PG8_MMA(0, 1, At, B1); PG8_BAR;
            PG8_LDA(At, 1, 1); PG8_STAGE(PG8_SA(1, 0), a3, voffA);
            PG8_BAR; PG8_WAIT_L(0); PG8_MMA(1, 0, At, B0); PG8_BAR; PG8_SCHED;
            PG8_STAGE(PG8_SB(1, 1), b3 + hstep, voffB);
            PG8_WAIT_V(6); PG8_BAR; PG8_MMA(1, 1, At, B1); PG8_BAR;
            }
        }
        if constexpr (ALIGN_EPI) { if (wr == 0) PG8_BAR; }
        if constexpr (!Epi::AFTER_DRAIN) { E(acc, cur, wr, wc, fr, fq); S.done(cur); }
        if (!has_next) break;
#pragma unroll
        for (int a = 0; a < 2; ++a)
#pragma unroll
            for (int b = 0; b < 2; ++b)
#pragma unroll
                for (int m = 0; m < 4; ++m)
#pragma unroll
                    for (int n = 0; n < 2; ++n) acc[a][b][m][n] = (f32x4){0.f, 0.f, 0.f, 0.f};
        cur = nxt; cA = nA; cB = nB; ++ui;
        if constexpr (ALIGN_EPI) { if (wr == 1) PG8_BAR; }
    }
    PG8_WAIT_V(0);
    if constexpr (!ALIGN_EPI) { if (wr == 0) PG8_BAR; }
    PG8_BAR;
    if constexpr (Epi::AFTER_DRAIN) { E.fused(acc, cur, wr, wc, fr, fq, lds, wid, lane); S.done(cur); }
#undef PG8_SA
#undef PG8_SB
#undef PG8_STAGE
#undef PG8_LDA
#undef PG8_LDB
#undef PG8_MMA
#undef PG8_WAIT_V
#undef PG8_WAIT_L
#undef PG8_BAR
#undef PG8_SCHED
}
}

namespace pg8 {
__device__ __forceinline__ float bflo_(unsigned w) { return __builtin_bit_cast(float, w << 16); }
__device__ __forceinline__ float bfhi_(unsigned w) { return __builtin_bit_cast(float, w & 0xffff0000u); }
__device__ __forceinline__ float sigm_(float x) { return 1.f / (1.f + __expf(-x)); }

struct EpiStoreBf16 {
    static constexpr bool PERM = true, AFTER_DRAIN = false;
    bf16_t* O; int ldc;
    __device__ __forceinline__ void operator()(const f32x4 (&acc)[2][2][4][2], const Unit& u, int wr, int wc, int fr, int fq) const {
        const int row0 = u.pm * BM + wr * 64 + fr, col0 = u.pn * BM + wc * 32 + 8 * fq;
#pragma unroll
        for (int ai = 0; ai < 2; ++ai)
#pragma unroll
            for (int m = 0; m < 4; ++m) { bf16_t* rowp = O + (size_t)(row0 + ai * HALF + m * 16) * ldc + col0;
#pragma unroll
                for (int bj = 0; bj < 2; ++bj) { const f32x4 v0 = acc[ai][bj][m][0], v1 = acc[ai][bj][m][1];
                    u32x4 w; w.x = cvt_pk_bf16(v0[0], v0[1]); w.y = cvt_pk_bf16(v0[2], v0[3]); w.z = cvt_pk_bf16(v1[0], v1[1]); w.w = cvt_pk_bf16(v1[2], v1[3]);
                    *(u32x4*)(rowp + bj * HALF) = w; } }
    }
};

struct EpiMerge {
    static constexpr bool PERM = true, AFTER_DRAIN = false;
    const bf16_t* U; int ldu, gcol0; bf16_t* Mf; bf16_t* Mb; int npm;
    __device__ __forceinline__ void operator()(const f32x4 (&acc)[2][2][4][2], const Unit& u, int wr, int wc, int fr, int fq) const {
        const int br = u.pm / npm, pm = u.pm - br * npm, pn = u.pn & 3;
        const int row0 = pm * BM + wr * 64 + fr, col0 = pn * BM + wc * 32 + 8 * fq;
#pragma unroll
        for (int ai = 0; ai < 2; ++ai)
#pragma unroll
            for (int m = 0; m < 4; ++m) { const size_t row = (size_t)(row0 + ai * HALF + m * 16);
#pragma unroll
                for (int bj = 0; bj < 2; ++bj) { const int col = col0 + bj * HALF;
                    const u32x4 g = *(const u32x4*)(U + row * ldu + gcol0 + br * 1024 + col);
                    f32x4 v0 = acc[ai][bj][m][0], v1 = acc[ai][bj][m][1];
                    v0[0] *= sigm_(bflo_(g.x)); v0[1] *= sigm_(bfhi_(g.x)); v0[2] *= sigm_(bflo_(g.y)); v0[3] *= sigm_(bfhi_(g.y));
                    v1[0] *= sigm_(bflo_(g.z)); v1[1] *= sigm_(bfhi_(g.z)); v1[2] *= sigm_(bflo_(g.w)); v1[3] *= sigm_(bfhi_(g.w));
                    bf16_t* mp = Mf + row * 1024 + col;
                    if (br > 0) { const u32x4 p = *(const u32x4*)mp;
                        v0[0] += bflo_(p.x); v0[1] += bfhi_(p.x); v0[2] += bflo_(p.y); v0[3] += bfhi_(p.y); v1[0] += bflo_(p.z); v1[1] += bfhi_(p.z); v1[2] += bflo_(p.w); v1[3] += bfhi_(p.w); }
                    u32x4 w; w.x = cvt_pk_bf16(v0[0], v0[1]); w.y = cvt_pk_bf16(v0[2], v0[3]); w.z = cvt_pk_bf16(v1[0], v1[1]); w.w = cvt_pk_bf16(v1[2], v1[3]);
                    *(u32x4*)((br < 3 ? mp : Mb + row * 1024 + col)) = w; } }
    }
};
struct MergeOrder {
    int G, c, npm, ncnt;
    __device__ __forceinline__ bool next(int i, Unit& u) const {
        const int su = (i >> 2) * G + c; if (su >= ncnt * 4) return false;
        const int br = i & 3; u.pm = br * npm + (su >> 2); u.pn = br * 4 + (su & 3); return true; }
    __device__ __forceinline__ void a_ready(const Unit&) const {}
    __device__ __forceinline__ void done(const Unit&) const {}
};

struct EpiResid {
    static constexpr bool PERM = false, AFTER_DRAIN = false;
    float* X; const float* gt;
    __device__ __forceinline__ void operator()(const f32x4 (&acc)[2][2][4][2], const Unit& u, int wr, int wc, int fr, int fq) const {
        const int row0 = u.pm * BM + wr * 64 + fr, col0 = u.pn * BM + wc * 32 + 4 * fq;
        const int mr = u.pm < 64 ? (u.pm >> 4) : 4;
        f32x4 gv[2][2];
#pragma unroll
        for (int bj = 0; bj < 2; ++bj)
#pragma unroll
            for (int n = 0; n < 2; ++n) gv[bj][n] = *(const f32x4*)(gt + (size_t)mr * 6144 + col0 + bj * HALF + n * 16);
#pragma unroll
        for (int ai = 0; ai < 2; ++ai)
#pragma unroll
            for (int m = 0; m < 4; ++m) { float* rowp = X + (size_t)(row0 + ai * HALF + m * 16) * 1024 + col0;
#pragma unroll
                for (int bj = 0; bj < 2; ++bj)
#pragma unroll
                    for (int n = 0; n < 2; ++n) { float* p = rowp + bj * HALF + n * 16; *(f32x4*)p = *(const f32x4*)p + gv[bj][n] * acc[ai][bj][m][n]; } }
    }
};

struct MoeOrder {
    const PG8_LAS int* tpre; int G, c, ncol;
    __device__ __forceinline__ bool next(int i, Unit& u) const {
        int tau, pnl;
        if ((G & 7) == 0 && ((G >> 3) % ncol) == 0) { const int x = c & 7, y = c >> 3, rp = (G >> 3) / ncol; tau = (i * 8 + x) * rp + y / ncol; pnl = y % ncol; }
        else { const int L = i * G + c; tau = L / ncol; pnl = L - tau * ncol; }
        if (tau >= tpre[32]) return false;
        int e = 0;
#pragma unroll 1
        while (tpre[e + 1] <= tau) ++e;
        u.pm = tau; u.pn = e * ncol + pnl; return true; }
    __device__ __forceinline__ void a_ready(const Unit&) const {}
    __device__ __forceinline__ void done(const Unit&) const {}
};
struct EpiSwiglu {
    static constexpr bool PERM = true, AFTER_DRAIN = false;
    bf16_t* ACT; const float* bgu;
    __device__ __forceinline__ void operator()(const f32x4 (&acc)[2][2][4][2], const Unit& u, int wr, int wc, int fr, int fq) const {
        const int e = u.pn >> 3, pnl = u.pn & 7;
        const int row0 = u.pm * BM + wr * 64 + fr, cl = 128 * pnl + wc * 32 + 8 * fq;
        const float* bg = bgu + (size_t)e * 2048 + cl;
        const f32x4 bg0 = *(const f32x4*)bg, bg1 = *(const f32x4*)(bg + 4), bu0 = *(const f32x4*)(bg + 1024), bu1 = *(const f32x4*)(bg + 1028);
#pragma unroll
        for (int ai = 0; ai < 2; ++ai)
#pragma unroll
            for (int m = 0; m < 4; ++m) {
                f32x4 g0 = acc[ai][0][m][0] + bg0, g1 = acc[ai][0][m][1] + bg1, u0 = acc[ai][1][m][0] + bu0, u1 = acc[ai][1][m][1] + bu1;
                float o[8];
#pragma unroll
                for (int j = 0; j < 4; ++j) { const float g = fminf(g0[j], 7.f), up = fminf(fmaxf(u0[j], -7.f), 7.f); o[j] = (up + 1.f) * g * sigm_(1.702f * g); }
#pragma unroll
                for (int j = 0; j < 4; ++j) { const float g = fminf(g1[j], 7.f), up = fminf(fmaxf(u1[j], -7.f), 7.f); o[4 + j] = (up + 1.f) * g * sigm_(1.702f * g); }
                u32x4 w; w.x = cvt_pk_bf16(o[0], o[1]); w.y = cvt_pk_bf16(o[2], o[3]); w.z = cvt_pk_bf16(o[4], o[5]); w.w = cvt_pk_bf16(o[6], o[7]);
                *(u32x4*)(ACT + (size_t)(row0 + ai * HALF + m * 16) * 1024 + cl) = w; }
    }
};
struct EpiDown {
    static constexpr bool PERM = true, AFTER_DRAIN = false;
    bf16_t* YS; const float* bdn;
    __device__ __forceinline__ void operator()(const f32x4 (&acc)[2][2][4][2], const Unit& u, int wr, int wc, int fr, int fq) const {
        const int e = u.pn >> 2, pnl = u.pn & 3;
        const int row0 = u.pm * BM + wr * 64 + fr, col0 = pnl * BM + wc * 32 + 8 * fq;
        f32x4 bv[2][2];
#pragma unroll
        for (int bj = 0; bj < 2; ++bj)
#pragma unroll
            for (int n = 0; n < 2; ++n) bv[bj][n] = *(const f32x4*)(bdn + (size_t)e * 1024 + col0 + bj * HALF + 4 * n);
#pragma unroll
        for (int ai = 0; ai < 2; ++ai)
#pragma unroll
            for (int m = 0; m < 4; ++m) { bf16_t* rowp = YS + (size_t)(row0 + ai * HALF + m * 16) * 1024 + col0;
#pragma unroll
                for (int bj = 0; bj < 2; ++bj) { const f32x4 v0 = acc[ai][bj][m][0] + bv[bj][0], v1 = acc[ai][bj][m][1] + bv[bj][1];
                    u32x4 w; w.x = cvt_pk_bf16(v0[0], v0[1]); w.y = cvt_pk_bf16(v0[2], v0[3]); w.z = cvt_pk_bf16(v1[0], v1[1]); w.w = cvt_pk_bf16(v1[2], v1[3]);
                    *(u32x4*)(rowp + bj * HALF) = w; } }
    }
};
}
#define XB_TMO      128
#define XB_XCNT(j)  (256  + 64 * (j))
#define XB_XSUB(j)  (1280 + 64 * (j))
#define XB_XGEN(j)  (2304 + 64 * (j))
#define XB_TOP      3328
#define XB_TOPGEN   3392
#define XCD_BAR_WORDS 3456
#define XB_SPIN_CAP (1u << 18)
#define LAS __attribute__((address_space(3)))

__device__ __forceinline__ unsigned xb_ld(unsigned* p)              { return __hip_atomic_load(p, __ATOMIC_RELAXED, __HIP_MEMORY_SCOPE_AGENT); }
__device__ __forceinline__ unsigned xb_add(unsigned* p, unsigned v) { return __hip_atomic_fetch_add(p, v, __ATOMIC_RELAXED, __HIP_MEMORY_SCOPE_AGENT); }
__device__ __forceinline__ unsigned xb_xcc_id() { return (unsigned)__builtin_amdgcn_s_getreg((3 << 11) | 20) & 0xFu; }
#define XB_SPIN(cond, bar) do { unsigned _sp = 0; while (cond) { __builtin_amdgcn_s_sleep(1); \
    if ((++_sp & 255u) == 0u) { if (xb_ld(&(bar)[XB_TMO])) break; if (_sp > XB_SPIN_CAP) { atomicAdd(&(bar)[XB_TMO], 1u); break; } } } } while (0)

struct XcdBarrier {
    unsigned* bar; unsigned x;
    volatile LAS unsigned* st;
};

__device__ __forceinline__ XcdBarrier xcd_barrier_post(unsigned* bar, volatile LAS unsigned* st) {
    XcdBarrier b; b.bar = bar; b.x = xb_xcc_id(); b.st = st;
    if (threadIdx.x == 0) (void)xb_add(&bar[XB_XCNT(b.x)], 1u);
    return b;
}
__device__ __forceinline__ void xcd_barrier_complete(unsigned* bar, unsigned x, unsigned& nloc, unsigned& nx) {
    const unsigned G = gridDim.x * gridDim.y * gridDim.z;
    unsigned sum, cnt, mine, sp = 0u;
    for (;;) {
        sum = 0u; cnt = 0u; mine = 0u;
#pragma unroll
        for (unsigned j = 0; j < 16; ++j) { const unsigned c = xb_ld(&bar[XB_XCNT(j)]); sum += c; cnt += (c > 0u) ? 1u : 0u; mine = (j == x) ? c : mine; }
        if (sum == G) break;
        __builtin_amdgcn_s_sleep(1);
        if ((++sp & 255u) == 0u) { if (xb_ld(&bar[XB_TMO])) break; if (sp > XB_SPIN_CAP) { atomicAdd(&bar[XB_TMO], 1u); break; } }
    }
    nloc = mine > 0u ? mine : 1u; nx = cnt > 0u ? cnt : 1u;
}

__device__ __forceinline__ void xcd_barrier(const XcdBarrier& b) {
    asm volatile("s_waitcnt vmcnt(0)" ::: "memory");
    __syncthreads();
    if (threadIdx.x == 0) {
        unsigned* bar = b.bar;
        __builtin_amdgcn_s_waitcnt(0);
        unsigned nloc = b.st[0], nx = b.st[1];
        if (nloc == 0u) { xcd_barrier_complete(bar, b.x, nloc, nx); b.st[0] = nloc; b.st[1] = nx; }
        const unsigned old = xb_add(&bar[XB_XSUB(b.x)], 1u);
        const unsigned gen = old / nloc;
        if (old + 1u == (gen + 1u) * nloc) {
            __builtin_amdgcn_fence(__ATOMIC_RELEASE, "agent");
            asm volatile("s_waitcnt vmcnt(0)" ::: "memory");
            const unsigned og = xb_add(&bar[XB_TOP], 1u);
            const unsigned tg = og / nx;
            if (og + 1u == (tg + 1u) * nx) xb_add(&bar[XB_TOPGEN], 1u);
            else XB_SPIN(xb_ld(&bar[XB_TOPGEN]) == tg, bar);
            __builtin_amdgcn_fence(__ATOMIC_ACQUIRE, "agent");
            xb_add(&bar[XB_XGEN(b.x)], 1u);
            asm volatile("s_waitcnt vmcnt(0)" ::: "memory");
        } else {
            XB_SPIN(xb_ld(&bar[XB_XGEN(b.x)]) == gen, bar);
            __builtin_amdgcn_fence(__ATOMIC_ACQUIRE, "agent");
            asm volatile("s_waitcnt vmcnt(0)" ::: "memory");
        }
    }
    __syncthreads();
}

struct Frame {
    LAS unsigned char* lds;
    unsigned* ctl;
    int tid, lane, wave, G, bid;
    unsigned long long pr;
    const float* const* in; const float* const* in0;
    float* out;
    unsigned char* ws; unsigned char* ws0;
};
#define WSP(T, off) ((T*)(F.ws + (off)))
#define REFRESH_TID(F) do { int t_ = (int)__builtin_amdgcn_mbcnt_hi(~0u, __builtin_amdgcn_mbcnt_lo(~0u, 0u)); asm volatile("" : "+v"(t_)); F.lane = t_; F.tid = F.wave * 64 + t_; \
    int z_ = 0; asm volatile("s_mov_b32 %0, 0" : "=s"(z_)); F.ws = F.ws0 + z_; F.in = F.in0 + z_; F.bid = (int)blockIdx.x + z_; } while (0)
#define I_X 0
#define I_C 1
#define I_CTX 2
#define I_CCTX 3
#define I_WMOD 4
#define I_BMOD 5
#define I_G1 6
#define I_G2 7
#define I_WIN 8
#define I_AGQ 9
#define I_AGK 10
#define I_BCW 11
#define I_BCB 12
#define I_BLAM 13
#define I_BWR 14
#define I_BBR 15
#define I_BWI 16
#define I_BBI 17
#define I_CCW 18
#define I_CALOG 19
#define I_CDTB 20
#define I_CGOUT 21
#define I_RPB 22
#define I_WBR 23
#define I_WOUT 24
#define I_WRT 25
#define I_BRT 26
#define I_WGU 27
#define I_BGU 28
#define I_WDN 29
#define I_BDN 30
#define I_GFIN 31

__device__ __forceinline__ int mod_row(int r) { return r < TLAT ? (r >> 12) : 4; }

__device__ __forceinline__ void p0_transpose_item(const float* W, size_t pitch, int K, bf16* WT, int drow0, int scol0, int k0, LAS float* scr, int lane) {
    float v[32];
#pragma unroll
    for (int i = 0; i < 32; ++i) { const int kk = 2 * i + (lane >> 5); v[i] = W[(size_t)(k0 + kk) * pitch + scol0 + (lane & 31)]; }
#pragma unroll
    for (int i = 0; i < 32; ++i) { const int kk = 2 * i + (lane >> 5); scr[kk * 33 + (lane & 31)] = v[i]; }
    asm volatile("s_waitcnt lgkmcnt(0)" ::: "memory");
    const int c = lane & 7;
#pragma unroll
    for (int j = 0; j < 4; ++j) { const int n = (lane >> 3) + 8 * j; const LAS float* s = scr + (8 * c) * 33 + n;
        v4u o; o.x = pk2(s[0 * 33], s[1 * 33]); o.y = pk2(s[2 * 33], s[3 * 33]); o.z = pk2(s[4 * 33], s[5 * 33]); o.w = pk2(s[6 * 33], s[7 * 33]);
        *(v4u*)(WT + (size_t)(drow0 + n) * K + k0 + 8 * c) = o; }
    asm volatile("s_waitcnt lgkmcnt(0)" ::: "memory");
}

__device__ __forceinline__ void p0_prologue(Frame& F) {
    LAS float* scr = (LAS float*)(F.lds + F.wave * 16384);
    const int gw = F.bid * NWAVES + F.wave, NGW = F.G * NWAVES;
    constexpr int I_IN = DEPTH * 16 * (UW / 32);
    constexpr int I_BR = DEPTH * 4 * 8 * 32;
    constexpr int I_OUT = DEPTH * 16 * 32;
    constexpr int I_GU = DEPTH * NEXP * 16 * 64;
    constexpr int I_DN = DEPTH * NEXP * 16 * 32;
    constexpr int NITEMS = I_IN + I_BR + I_OUT + I_GU + I_DN;
    for (int it = gw; it < NITEMS; it += NGW) {
        int r = it;
        if (r < I_IN) { const int l = r / (16 * 296), q = r % (16 * 296), kb = q / 296, nb = q % 296; const int n0 = nb * 32, sc = n0 < 3840 ? n0 : n0 + 16;
            p0_transpose_item(F.in[I_WIN] + (size_t)l * D * INW, INW, D, WSP(bf16, WS_WIN) + (size_t)l * UW * D, n0, sc, kb * 64, scr, F.lane); continue; }
        r -= I_IN;
        if (r < I_BR) { const int mi = r / 256, q = r % 256, kb = q / 32, nb = q % 32;
            p0_transpose_item(F.in[I_WBR] + (size_t)mi * 512 * 1024, 1024, 512, WSP(bf16, WS_WBR) + (size_t)mi * 1024 * 512, nb * 32, nb * 32, kb * 64, scr, F.lane); continue; }
        r -= I_BR;
        if (r < I_OUT) { const int l = r / 512, q = r % 512, kb = q / 32, nb = q % 32;
            p0_transpose_item(F.in[I_WOUT] + (size_t)l * D * D, D, D, WSP(bf16, WS_WOUT) + (size_t)l * D * D, nb * 32, nb * 32, kb * 64, scr, F.lane); continue; }
        r -= I_OUT;
        if (r < I_GU) { const int mi = r / 1024, q = r % 1024, kb = q / 64, nb = q % 64; const int j0 = nb * 32, pn = j0 >> 8, bj = (j0 >> 7) & 1, cc = j0 & 127;
            p0_transpose_item(F.in[I_WGU] + (size_t)mi * D * 2048, 2048, D, WSP(bf16, WS_WGU) + (size_t)mi * 2048 * D, j0, 1024 * bj + 128 * pn + cc, kb * 64, scr, F.lane); continue; }
        r -= I_GU;
        { const int mi = r / 512, q = r % 512, kb = q / 32, nb = q % 32;
            p0_transpose_item(F.in[I_WDN] + (size_t)mi * D * D, D, D, WSP(bf16, WS_WDN) + (size_t)mi * D * D, nb * 32, nb * 32, kb * 64, scr, F.lane); }
    }
    __syncthreads();
    {
        LAS float* sc = (LAS float*)F.lds;
        LAS float* part = sc + 5 * 1024;
        bool staged = false;
        for (int it = F.bid; it < DEPTH * 96; it += F.G) {
            if (!staged) {
                for (int i = F.tid; i < 5 * 1024; i += NT) { const int r = i >> 10, k = i & 1023; const float cv = r < 4 ? F.in[I_C][r * 1024 + k] : F.in[I_CCTX][k]; sc[i] = siluf_(cv); }
                __syncthreads(); staged = true;
            }
            const int l = it / 96, cg = it % 96, col = cg * 64 + F.lane;
            const float* wm = F.in[I_WMOD] + (size_t)l * D * 6144 + col;
            float a0 = 0.f, a1 = 0.f, a2 = 0.f, a3 = 0.f, a4 = 0.f;
            const int kb = F.wave * 128;
#pragma unroll 16
            for (int k = 0; k < 128; ++k) { const float w = wm[(size_t)(kb + k) * 6144];
                a0 += sc[kb + k] * w; a1 += sc[1024 + kb + k] * w; a2 += sc[2048 + kb + k] * w; a3 += sc[3072 + kb + k] * w; a4 += sc[4096 + kb + k] * w; }
            LAS float* pp = part + F.wave * 320 + F.lane;
            pp[0] = a0; pp[64] = a1; pp[128] = a2; pp[192] = a3; pp[256] = a4;
            __syncthreads();
            if (F.tid < 320) { const int r = F.tid >> 6, ln = F.tid & 63; float s = 0.f;
#pragma unroll
                for (int w = 0; w < 8; ++w) s += part[w * 320 + r * 64 + ln];
                const int cc = cg * 64 + ln;
                WSP(float, WS_MOD)[((size_t)l * 5 + r) * 6144 + cc] = s + F.in[I_BMOD][l * 6144 + cc]; }
            __syncthreads();
        }
    }
    if (F.bid == 0) {
        for (int i = F.tid; i < 1024; i += NT) { const int p = i >> 4, f = i & 15; const float inv = powf(10000.f, -(float)f / 16.f); const float ang = (float)p * inv;
            WSP(float, WS_ROPE)[i] = cosf(ang); WSP(float, WS_ROPE)[1024 + i] = sinf(ang); }
    }
    for (int i = F.bid * NT + F.tid; i < DEPTH * 2 * 2 * 8 * 4096; i += F.G * NT) {
        const int c = i & 63, d = (i >> 6) & 63, n = (i >> 12) & 7, gate = (i >> 15) & 1, ld = i >> 16;
        const float* src = gate ? F.in[I_BWI] : F.in[I_BWR];
        WSP(bf16, WS_LRUW)[i] = (bf16)f2bf(src[((size_t)ld * 8 + n) * 4096 + c * 64 + d]);
    }
}

template <int MODE>
__device__ __forceinline__ void norm_phase(Frame& F, int l) {
    LAS float* hs = (LAS float*)F.lds;
    LAS int* lcnt = (LAS int*)(F.lds + 65536);
    LAS int* lbase = lcnt + 32;
    const int ngroups = (MODE == 2 ? TLAT : MROWS) / 16;
    const float* modl = WSP(float, WS_MOD) + (size_t)l * 5 * 6144;
    for (int gi = F.bid; gi < ngroups; gi += F.G) {
        REFRESH_TID(F);
        if (MODE == 1) { if (F.tid < 32) lcnt[F.tid] = 0; }
#pragma unroll
        for (int i = 0; i < 2; ++i) {
            const int lr = 2 * F.wave + i, r = gi * 16 + lr, mr = mod_row(r);
            const float* xsrc;
            if (MODE == 0 && l == 0) xsrc = r < TLAT ? F.in[I_X] + (size_t)r * D : F.in[I_CTX] + (size_t)(r - TLAT) * D;
            else xsrc = WSP(float, WS_X) + (size_t)r * D;
            f32x4 v[4];
#pragma unroll
            for (int j = 0; j < 4; ++j) v[j] = *(const f32x4*)(xsrc + 4 * F.lane + 256 * j);
            if ((MODE == 0 && l > 0) || MODE == 2) {
                const int lp = MODE == 2 ? DEPTH - 1 : l - 1;
                const float* gt2 = WSP(float, WS_MOD) + ((size_t)lp * 5 + mr) * 6144 + 5120;
                f32x4 cb[4];
#pragma unroll
                for (int j = 0; j < 4; ++j) cb[j] = (f32x4){0.f, 0.f, 0.f, 0.f};
#pragma unroll
                for (int k = 0; k < 4; ++k) {
                    const int sr = WSP(int, WS_SROW)[r * 4 + k]; const float w = WSP(float, WS_SW)[r * 4 + k];
                    const bf16* yr = WSP(bf16, WS_YS) + (size_t)sr * D;
#pragma unroll
                    for (int j = 0; j < 4; ++j) { const v2u y = *(const v2u*)(yr + 4 * F.lane + 256 * j);
                        cb[j].x += w * bflo(y.x); cb[j].y += w * bfhi(y.x); cb[j].z += w * bflo(y.y); cb[j].w += w * bfhi(y.y); }
                }
#pragma unroll
                for (int j = 0; j < 4; ++j) { const f32x4 g = *(const f32x4*)(gt2 + 4 * F.lane + 256 * j); v[j] = v[j] + g * cb[j]; }
            }
            if (MODE == 0) {
#pragma unroll
                for (int j = 0; j < 4; ++j) *(f32x4*)(WSP(float, WS_X) + (size_t)r * D + 4 * F.lane + 256 * j) = v[j];
            }
            float ss = 0.f;
#pragma unroll
            for (int j = 0; j < 4; ++j) ss += (v[j].x * v[j].x + v[j].y * v[j].y) + (v[j].z * v[j].z + v[j].w * v[j].w);
            const float rstd = rsqrtf(wave_sum(ss) * (1.f / D) + EPS);
            if (MODE == 2) {
#pragma unroll
                for (int j = 0; j < 4; ++j) { const f32x4 g = *(const f32x4*)(F.in[I_GFIN] + 4 * F.lane + 256 * j);
                    *(f32x4*)(F.out + (size_t)r * D + 4 * F.lane + 256 * j) = v[j] * rstd * g; }
            } else {
                const float* gn = F.in[MODE == 0 ? I_G1 : I_G2] + l * D;
                const float* sh = modl + (size_t)mr * 6144 + (MODE == 0 ? 0 : 3072);
                const float* sc = sh + 1024;
#pragma unroll
                for (int j = 0; j < 4; ++j) { const int c0 = 4 * F.lane + 256 * j;
                    const f32x4 g = *(const f32x4*)(gn + c0), a = *(const f32x4*)(sh + c0), s = *(const f32x4*)(sc + c0);
                    const f32x4 h = (v[j] * rstd * g) * (s + 1.f) + a;
                    *(LAS f32x4*)(hs + lr * 1024 + c0) = h;
                    v2u o; o.x = pk2(h.x, h.y); o.y = pk2(h.z, h.w);
                    *(v2u*)(WSP(bf16, WS_H) + (size_t)r * D + c0) = o; }
            }
        }
        if (MODE == 2) continue;
        __syncthreads();
        LAS float* red = (LAS float*)(F.lds + 65536 + 256);
        {
            const int r16 = F.lane & 15, quad = F.lane >> 4, w = F.wave;
            const size_t stride = MODE == 0 ? (size_t)INW : (size_t)NEXP;
            const float* wp = (MODE == 0 ? F.in[I_WIN] + (size_t)l * D * INW + 3840 : F.in[I_WRT] + (size_t)l * D * NEXP) + (size_t)(128 * w + quad) * stride + r16;
            const LAS float* hp = hs + r16 * 1024 + 128 * w + quad;
            f32x4 acc0 = (f32x4){0.f, 0.f, 0.f, 0.f}, acc1 = acc0;
            float b0[32], b1[32];
#pragma unroll
            for (int s = 0; s < 32; ++s) { b0[s] = wp[(size_t)(4 * s) * stride]; if (MODE == 1) b1[s] = wp[(size_t)(4 * s) * stride + 16]; }
#pragma unroll
            for (int s = 0; s < 32; ++s) { const float av = hp[4 * s];
                acc0 = __builtin_amdgcn_mfma_f32_16x16x4f32(av, b0[s], acc0, 0, 0, 0);
                if (MODE == 1) acc1 = __builtin_amdgcn_mfma_f32_16x16x4f32(av, b1[s], acc1, 0, 0, 0); }
#pragma unroll
            for (int j = 0; j < 4; ++j) { red[(w * 16 + 4 * quad + j) * 32 + r16] = acc0[j]; if (MODE == 1) red[(w * 16 + 4 * quad + j) * 32 + 16 + r16] = acc1[j]; }
        }
        __syncthreads();
        if (MODE == 0) {
            if (F.tid < 256) {
                const int lr = F.tid >> 4, col = F.tid & 15;
                float sacc = 0.f;
#pragma unroll
                for (int w = 0; w < 8; ++w) sacc += red[(w * 16 + lr) * 32 + col];
                WSP(float, WS_CAB)[(size_t)(gi * 16 + lr) * 16 + col] = sacc;
            }
        } else {
            const int lr = F.tid >> 5, e = F.tid & 31, r = gi * 16 + lr;
            float sacc = 0.f;
#pragma unroll
            for (int w = 0; w < 8; ++w) sacc += red[(w * 16 + lr) * 32 + e];
            const float lg = sacc + F.in[I_BRT][l * NEXP + e];
            float tv0, tv1, tv2, tv3; int ti0, ti1, ti2, ti3; bool taken = false;
#define TOP1(TV, TI) do { float bv = taken ? -INFINITY : lg; int bi = e; \
                _Pragma("unroll") for (int off = 16; off >= 1; off >>= 1) { const float ov = __shfl_xor(bv, off); const int oi = __shfl_xor(bi, off); \
                    if (ov > bv || (ov == bv && oi < bi)) { bv = ov; bi = oi; } } \
                TV = bv; TI = bi; if (bi == e) taken = true; } while (0)
            TOP1(tv0, ti0); TOP1(tv1, ti1); TOP1(tv2, ti2); TOP1(tv3, ti3);
#undef TOP1
            const float e1 = __expf(tv1 - tv0), e2 = __expf(tv2 - tv0), e3 = __expf(tv3 - tv0);
            const float inv = 1.f / (1.f + e1 + e2 + e3);
            const int my_e = e == 0 ? ti0 : (e == 1 ? ti1 : (e == 2 ? ti2 : ti3));
            const float my_w = e == 0 ? inv : (e == 1 ? e1 * inv : (e == 2 ? e2 * inv : e3 * inv));
            int pl = 0;
            if (e < 4) pl = atomicAdd((int*)&lcnt[my_e], 1);
            __syncthreads();
            if (F.tid < 32) { const int c = lcnt[F.tid]; lbase[F.tid] = c > 0 ? (int)__hip_atomic_fetch_add(F.ctl + CW_CNT + l * 32 + F.tid, (unsigned)c, __ATOMIC_RELAXED, __HIP_MEMORY_SCOPE_AGENT) : 0; }
            __syncthreads();
            if (e < 4) { const int p = lbase[my_e] + pl;
                WSP(int, WS_LIST)[(size_t)my_e * MROWS + p] = r * 4 + e;
                WSP(int, WS_SEP)[r * 4 + e] = (my_e << 20) | p;
                WSP(float, WS_SW)[r * 4 + e] = my_w; }
        }
        __syncthreads();
    }
}

__device__ __forceinline__ void moe_table(Frame& F, int l) {
    LAS int* tpre = (LAS int*)(F.lds + MISC_OFF + 256);
    LAS int* cnt = tpre + 40;
    __syncthreads();
    if (F.tid < 32) cnt[F.tid] = (int)__hip_atomic_load(F.ctl + CW_CNT + l * 32 + F.tid, __ATOMIC_RELAXED, __HIP_MEMORY_SCOPE_AGENT);
    __syncthreads();
    if (F.tid == 0) { int s = 0; for (int e = 0; e < 32; ++e) { tpre[e] = s; s += (cnt[e] + 255) >> 8; } tpre[32] = s; }
    __syncthreads();
}
__device__ __forceinline__ void moe_gather(Frame& F, int l) {
    moe_table(F, l);
    const LAS int* tpre = (const LAS int*)(F.lds + MISC_OFF + 256);
    const LAS int* cnt = tpre + 40;
    const int gw = F.bid * NWAVES + F.wave, NGW = F.G * NWAVES;
    REFRESH_TID(F);
    for (int e = 0; e < NEXP; ++e) {
        const int n = cnt[e], base = tpre[e] * 256;
        for (int p = gw; p < n; p += NGW) {
            const int tk = WSP(int, WS_LIST)[(size_t)e * MROWS + p]; const int tok = tk >> 2;
            const v4u* src = (const v4u*)(WSP(bf16, WS_H) + (size_t)tok * D);
            v4u* dst = (v4u*)(WSP(bf16, WS_HS) + (size_t)(base + p) * D);
            dst[F.lane] = src[F.lane]; dst[F.lane + 64] = src[F.lane + 64];
            if (F.lane == 0) WSP(int, WS_SROW)[tk] = base + p;
        }
    }
}

constexpr int AT_KP = 72, AT_VP = 68;
constexpr int AT_KB = 64 * AT_KP * 2, AT_VB = 64 * AT_VP * 2, AT_BUF = AT_KB + AT_VB;
constexpr int AT_RPB = 2 * AT_BUF;

struct AttnUnit {
    int kind;
    int b, hx, qx;
};

__device__ __forceinline__ void attn_unit(Frame& F, int l, const AttnUnit un) {
    REFRESH_TID(F);
    const int lane = F.lane, w = F.wave, q32 = lane & 31, hh = lane >> 5;
    const bf16* U = WSP(bf16, WS_U);
    const bool na = (un.kind & 1) != 0, ctxq = un.kind >= 2;
    const int b = un.b;
    int qrow0, qcol, kcol, ycol, nlat, krow_lat0, r_grid = 0, c0 = 0, rs_w = 0;
    const bf16* vt; bf16* Y;
    if (!na) {
        const int head = 4 * un.hx + (w & 3);
        qrow0 = (ctxq ? TLAT + b * LCTX : b * SEQ) + 64 * un.qx + 32 * (w >> 2);
        qcol = UQ + head * 64; kcol = UK + un.hx * 64; ycol = head * 64;
        vt = WSP(bf16, WS_VAT) + (size_t)(b * 2 + un.hx) * 64 * KEYS;
        Y = WSP(bf16, WS_Y);
        nlat = ctxq ? 0 : 64; krow_lat0 = b * SEQ;
    } else {
        const int head = un.hx;
        if (ctxq) { qrow0 = TLAT + b * LCTX + 32 * w; nlat = 0; krow_lat0 = 0; }
        else {
            r_grid = 4 * un.qx + (w >> 1); c0 = 32 * (w & 1);
            qrow0 = b * SEQ + 64 * r_grid + c0;
            int rs_min = 4 * un.qx - 4; rs_min = rs_min < 0 ? 0 : (rs_min > 56 ? 56 : rs_min);
            int rs_max = 4 * un.qx + 3 - 4; rs_max = rs_max < 0 ? 0 : (rs_max > 56 ? 56 : rs_max);
            nlat = rs_max + 8 - rs_min; krow_lat0 = b * SEQ + 64 * rs_min;
            rs_w = r_grid - 4; rs_w = rs_w < 0 ? 0 : (rs_w > 56 ? 56 : rs_w);
            rs_w -= rs_min;
        }
        qcol = UDQ + head * 64; kcol = UDK + head * 64; ycol = head * 64;
        vt = WSP(bf16, WS_VDT) + (size_t)(b * 8 + head) * 64 * KEYS;
        Y = WSP(bf16, WS_Y) + (size_t)3 * MROWS * 512;
    }
    const int vkey_lat0 = krow_lat0 - b * SEQ;
    const int ntile = nlat + 4;
    LAS unsigned char* lds = F.lds;
    if (na && !ctxq) {
        LAS float* rp = (LAS float*)(lds + AT_RPB);
        const float* src = F.in[I_RPB] + ((size_t)l * 8 + un.hx) * 465;
        for (int i = F.tid; i < 465; i += NT) rp[i] = src[i] * LOG2E;
    }
    bf16x8 qf[4];
    {
        const bf16* qp = U + (size_t)(qrow0 + q32) * UW + qcol + 8 * hh;
#pragma unroll
        for (int s = 0; s < 4; ++s) qf[s] = *(const bf16x8*)(qp + 16 * s);
    }
    const int lk = F.tid >> 3, lc = F.tid & 7;
    v4u kr[4], vr[4];
#define AT_LOAD(st, i) do { const int i_ = (i) < ntile ? (i) : ntile - 1; int krow0_, vkey0_; \
        if (i_ < nlat) { krow0_ = krow_lat0 + 64 * i_; vkey0_ = vkey_lat0 + 64 * i_; } else { krow0_ = TLAT + b * LCTX + 64 * (i_ - nlat); vkey0_ = SEQ + 64 * (i_ - nlat); } \
        kr[st] = *(const v4u*)(U + (size_t)(krow0_ + lk) * UW + kcol + lc * 8); \
        vr[st] = *(const v4u*)(vt + (size_t)lk * KEYS + vkey0_ + lc * 8); } while (0)
#define AT_STORE(st, buf) do { LAS unsigned char* b_ = lds + (buf) * AT_BUF; \
        *(LAS v4u*)(b_ + lk * (AT_KP * 2) + lc * 16) = kr[st]; \
        *(LAS v2u*)(b_ + AT_KB + lk * (AT_VP * 2) + lc * 16) = (v2u){vr[st].x, vr[st].y}; \
        *(LAS v2u*)(b_ + AT_KB + lk * (AT_VP * 2) + lc * 16 + 8) = (v2u){vr[st].z, vr[st].w}; } while (0)
    float m_run = -1e30f, l_run = 0.f;
    f32x16 o0, o1;
#pragma unroll
    for (int i = 0; i < 16; ++i) { o0[i] = 0.f; o1[i] = 0.f; }
    const float sscale = 0.125f * LOG2E;
    const int cq = c0 + q32;
    int cst = cq - 8; cst = cst < 0 ? 0 : (cst > 48 ? 48 : cst);
    AT_LOAD(0, 0); AT_LOAD(1, 1); AT_LOAD(2, 2); AT_LOAD(3, 3);
#pragma unroll 1
    for (int i0 = 0; i0 < ntile; i0 += 4) {
#pragma unroll
      for (int st = 0; st < 4; ++st) {
        const int i = i0 + st;
        if (i >= ntile) break;
        AT_STORE(st, i & 1);
        AT_LOAD(st, i + 4);
        lds_barrier();
        const bool lat_na = na && !ctxq && i < nlat;
        if (lat_na && (i < rs_w || i > rs_w + 7)) continue;
        const LAS unsigned char* kb = lds + (i & 1) * AT_BUF;
        const LAS unsigned char* vb = kb + AT_KB;
        f32x16 s0, s1;
#pragma unroll
        for (int j = 0; j < 16; ++j) { s0[j] = 0.f; s1[j] = 0.f; }
#pragma unroll
        for (int s = 0; s < 4; ++s) {
            const bf16x8 k0 = *(const LAS bf16x8*)(kb + (q32) * (AT_KP * 2) + (16 * s + 8 * hh) * 2);
            const bf16x8 k1 = *(const LAS bf16x8*)(kb + (32 + q32) * (AT_KP * 2) + (16 * s + 8 * hh) * 2);
            s0 = __builtin_amdgcn_mfma_f32_32x32x16_bf16(k0, qf[s], s0, 0, 0, 0);
            s1 = __builtin_amdgcn_mfma_f32_32x32x16_bf16(k1, qf[s], s1, 0, 0, 0);
        }
        if (lat_na) {
            const LAS float* rp = (const LAS float*)(lds + AT_RPB);
            const int kr = (krow_lat0 - b * SEQ) / 64 + i;
            const int rb = (kr - r_grid + 7) * 31 + 15 - cq;
#pragma unroll
            for (int j = 0; j < 16; ++j) {
                const int kc0 = (j & 3) + 8 * (j >> 2) + 4 * hh, kc1 = kc0 + 32;
                const bool ok0 = kc0 >= cst && kc0 < cst + 16, ok1 = kc1 >= cst && kc1 < cst + 16;
                s0[j] = ok0 ? s0[j] * sscale + rp[ok0 ? rb + kc0 : 0] : -1e30f;
                s1[j] = ok1 ? s1[j] * sscale + rp[ok1 ? rb + kc1 : 0] : -1e30f;
            }
        } else if (na) {
#pragma unroll
            for (int j = 0; j < 16; ++j) { s0[j] *= sscale; s1[j] *= sscale; }
        }
        float mx = fmaxf(s0[0], s1[0]);
#pragma unroll
        for (int j = 1; j < 16; ++j) mx = fmaxf(mx, fmaxf(s0[j], s1[j]));
        mx = fmaxf(mx, __shfl_xor(mx, 32));
        const float m_new = fmaxf(m_run, mx);
        if (__builtin_amdgcn_ballot_w64(m_new > m_run) != 0ull) {
            const float alpha = __builtin_amdgcn_exp2f(m_run - m_new);
            l_run *= alpha;
#pragma unroll
            for (int j = 0; j < 16; ++j) { o0[j] *= alpha; o1[j] *= alpha; }
            m_run = m_new;
        }
        float ps = 0.f;
#pragma unroll
        for (int j = 0; j < 16; ++j) { s0[j] = __builtin_amdgcn_exp2f(s0[j] - m_run); s1[j] = __builtin_amdgcn_exp2f(s1[j] - m_run); ps += s0[j] + s1[j]; }
        l_run += ps;
        bf16x8 pb[2][2];
#pragma unroll
        for (int s2 = 0; s2 < 2; ++s2) {
            v4u t0, t1;
            t0.x = pk2(s0[8 * s2 + 0], s0[8 * s2 + 1]); t0.y = pk2(s0[8 * s2 + 2], s0[8 * s2 + 3]); t0.z = pk2(s0[8 * s2 + 4], s0[8 * s2 + 5]); t0.w = pk2(s0[8 * s2 + 6], s0[8 * s2 + 7]);
            t1.x = pk2(s1[8 * s2 + 0], s1[8 * s2 + 1]); t1.y = pk2(s1[8 * s2 + 2], s1[8 * s2 + 3]); t1.z = pk2(s1[8 * s2 + 4], s1[8 * s2 + 5]); t1.w = pk2(s1[8 * s2 + 6], s1[8 * s2 + 7]);
            pb[0][s2] = __builtin_bit_cast(bf16x8, t0); pb[1][s2] = __builtin_bit_cast(bf16x8, t1);
        }
#pragma unroll
        for (int sub = 0; sub < 2; ++sub)
#pragma unroll
            for (int s2 = 0; s2 < 2; ++s2) {
                const int ko = (32 * sub + 16 * s2 + 4 * hh) * 2;
                const v2u a0 = *(const LAS v2u*)(vb + (q32) * (AT_VP * 2) + ko), a1 = *(const LAS v2u*)(vb + (q32) * (AT_VP * 2) + ko + 16);
                const v2u c0_ = *(const LAS v2u*)(vb + (32 + q32) * (AT_VP * 2) + ko), c1_ = *(const LAS v2u*)(vb + (32 + q32) * (AT_VP * 2) + ko + 16);
                const bf16x8 vf0 = __builtin_bit_cast(bf16x8, ((v4u){a0.x, a0.y, a1.x, a1.y}));
                const bf16x8 vf1 = __builtin_bit_cast(bf16x8, ((v4u){c0_.x, c0_.y, c1_.x, c1_.y}));
                o0 = __builtin_amdgcn_mfma_f32_32x32x16_bf16(vf0, pb[sub][s2], o0, 0, 0, 0);
                o1 = __builtin_amdgcn_mfma_f32_32x32x16_bf16(vf1, pb[sub][s2], o1, 0, 0, 0);
            }
      }
    }
#undef AT_LOAD
#undef AT_STORE
    const float lt = l_run + __shfl_xor(l_run, 32);
    const float inv = 1.f / lt;
    bf16* yp = Y + (size_t)(qrow0 + q32) * 512 + ycol + 4 * hh;
#pragma unroll
    for (int g = 0; g < 4; ++g) {
        v2u a; a.x = pk2(o0[4 * g] * inv, o0[4 * g + 1] * inv); a.y = pk2(o0[4 * g + 2] * inv, o0[4 * g + 3] * inv);
        v2u c; c.x = pk2(o1[4 * g] * inv, o1[4 * g + 1] * inv); c.y = pk2(o1[4 * g + 2] * inv, o1[4 * g + 3] * inv);
        *(v2u*)(yp + 8 * g) = a; *(v2u*)(yp + 32 + 8 * g) = c;
    }
    __syncthreads();
}

__device__ __forceinline__ void attn_phase(Frame& F, int l) {
    const int x = F.bid & 7, y = F.bid >> 3, ny = F.G >> 3;
    for (int q = y; q < 64; q += ny) { AttnUnit un; un.kind = 0; un.b = x >> 1; un.hx = x & 1; un.qx = q; attn_unit(F, l, un); }
    for (int q = y; q < 64; q += ny) { const int combo = x + 8 * (q >> 4); AttnUnit un; un.kind = 1; un.b = combo >> 3; un.hx = combo & 7; un.qx = q & 15; attn_unit(F, l, un); }
    for (int q = y; q < 8; q += ny) { AttnUnit un;
        if (q < 4) { un.kind = 2; un.b = x >> 1; un.hx = x & 1; un.qx = q; }
        else { const int combo = x + 8 * (q - 4); un.kind = 3; un.b = combo >> 3; un.hx = combo & 7; un.qx = 0; }
        attn_unit(F, l, un); }
}


__device__ __forceinline__ void qk_prep(Frame& F, int l) {
    REFRESH_TID(F);
    const int gw = F.bid * NWAVES + F.wave, NGW = F.G * NWAVES, lane = F.lane;
    bf16* U = WSP(bf16, WS_U);
    const float* tab = WSP(float, WS_ROPE);
    const int d0 = (lane & 7) * 8;
    float gq[8], gk[8];
#pragma unroll
    for (int j = 0; j < 8; ++j) { gq[j] = F.in[I_AGQ][l * 64 + d0 + j]; gk[j] = F.in[I_AGK][l * 64 + d0 + j]; }
    for (int r = gw; r < MROWS; r += NGW) {
        const bool lat = r < TLAT;
        bf16* up = U + (size_t)r * UW;
        const v4u qv = *(const v4u*)(up + UQ + lane * 8);
        v4u kv = (v4u){0u, 0u, 0u, 0u};
        if (lane < 16) kv = *(const v4u*)(up + UK + lane * 8);
        float cs[8], sn[8];
#pragma unroll
        for (int j = 0; j < 8; ++j) { cs[j] = 1.f; sn[j] = 0.f; }
        if (lat) { const int t = r & 4095;
#pragma unroll
            for (int j = 0; j < 8; ++j) { const int i = (d0 + j) & 31; const int idx = i < 16 ? (t >> 6) * 16 + i : (t & 63) * 16 + (i - 16); cs[j] = tab[idx]; sn[j] = tab[1024 + idx]; } }
#pragma unroll
        for (int which = 0; which < 2; ++which) {
            const v4u raw = which ? kv : qv;
            float x[8] = {bflo(raw.x), bfhi(raw.x), bflo(raw.y), bfhi(raw.y), bflo(raw.z), bfhi(raw.z), bflo(raw.w), bfhi(raw.w)};
            float ss = 0.f;
#pragma unroll
            for (int j = 0; j < 8; ++j) ss += x[j] * x[j];
            ss += __shfl_xor(ss, 1); ss += __shfl_xor(ss, 2); ss += __shfl_xor(ss, 4);
            const float rs = rsqrtf(ss * (1.f / 64.f) + EPS);
            float y[8];
#pragma unroll
            for (int j = 0; j < 8; ++j) y[j] = x[j] * rs * (which ? gk[j] : gq[j]);
            const bool hi = (lane & 4) != 0;
#pragma unroll
            for (int j = 0; j < 8; ++j) { const float p = __shfl_xor(y[j], 4);
                if (lat) y[j] = hi ? y[j] * cs[j] + p * sn[j] : y[j] * cs[j] - p * sn[j];
                if (!which) y[j] *= 0.125f * LOG2E; }
            v4u o; o.x = pk2(y[0], y[1]); o.y = pk2(y[2], y[3]); o.z = pk2(y[4], y[5]); o.w = pk2(y[6], y[7]);
            if (!which) *(v4u*)(up + UQ + lane * 8) = o; else if (lane < 16) *(v4u*)(up + UK + lane * 8) = o;
        }
    }
}

__device__ __forceinline__ void v_transpose(Frame& F) {
    REFRESH_TID(F);
    const int gw = F.bid * NWAVES + F.wave, NGW = F.G * NWAVES, lane = F.lane;
    LAS bf16* T = (LAS bf16*)(F.lds + F.wave * 9216);
    const bf16* U = WSP(bf16, WS_U);
    for (int it = gw; it < NCHUNK * 10; it += NGW) {
        const int g = it / 10, hd = it % 10;
        int b, key0;
        if (g < 256) { b = g >> 6; key0 = (g & 63) * 64; } else { b = (g - 256) >> 2; key0 = SEQ + ((g - 256) & 3) * 64; }
        const int scol = hd < 2 ? UV + hd * 64 : UDV + (hd - 2) * 64;
        bf16* dst = hd < 2 ? WSP(bf16, WS_VAT) + (size_t)(b * 2 + hd) * 64 * KEYS : WSP(bf16, WS_VDT) + (size_t)(b * 8 + hd - 2) * 64 * KEYS;
        v4u rv[8];
#pragma unroll
        for (int i = 0; i < 8; ++i) { const int tok = 8 * i + (lane >> 3), ch = lane & 7; rv[i] = *(const v4u*)(U + (size_t)(64 * g + tok) * UW + scol + ch * 8); }
#pragma unroll
        for (int i = 0; i < 8; ++i) { const int tok = 8 * i + (lane >> 3), ch = lane & 7; const unsigned wv[4] = {rv[i].x, rv[i].y, rv[i].z, rv[i].w};
#pragma unroll
            for (int j = 0; j < 4; ++j) { T[(ch * 8 + 2 * j) * 72 + tok] = (bf16)(wv[j] & 0xffffu); T[(ch * 8 + 2 * j + 1) * 72 + tok] = (bf16)(wv[j] >> 16); } }
        asm volatile("s_waitcnt lgkmcnt(0)" ::: "memory");
#pragma unroll
        for (int i = 0; i < 8; ++i) { const int d = 8 * i + (lane >> 3), ch = lane & 7;
            const v4u o = *(const LAS v4u*)(T + d * 72 + ch * 8);
            *(v4u*)(dst + (size_t)d * KEYS + key0 + ch * 8) = o; }
        asm volatile("s_waitcnt lgkmcnt(0)" ::: "memory");
    }
}

constexpr int LR_XCB = 0, LR_WV = 17408, LR_WVB = 12288;
__device__ __forceinline__ void seq_bounds(int g, int& lo, int& hi) {
    if (g < 256) { lo = (g >> 6) * SEQ; hi = lo + SEQ; } else { lo = TLAT + ((g - 256) >> 2) * LCTX; hi = lo + LCTX; }
}
__device__ __forceinline__ void lru_stage_conv(Frame& F, int l, int g, int q) {
    LAS bf16* raw = (LAS bf16*)(F.lds + LR_WV);
    LAS bf16* xcb = (LAS bf16*)(F.lds + LR_XCB);
    const bf16* U = WSP(bf16, WS_U);
    int lo, hi; seq_bounds(g, lo, hi);
    __syncthreads();
    for (int i = F.tid; i < 67 * 16; i += NT) { const int rr = i >> 4, ch = i & 15, row = 64 * g - 1 + rr;
        v4u v = (v4u){0u, 0u, 0u, 0u};
        if (row >= lo && row < hi) v = *(const v4u*)(U + (size_t)row * UW + UBX + 128 * q + ch * 8);
        *(LAS v4u*)(raw + rr * 128 + ch * 8) = v; }
    __syncthreads();
    {
        const int ch = F.tid & 127, tg = F.tid >> 7, cabs = 128 * q + ch;
        const float* cw = F.in[I_BCW] + (size_t)l * 4 * 512 + cabs;
        const float w0 = cw[0], w1 = cw[512], w2 = cw[1024], w3 = cw[1536], bb = F.in[I_BCB][l * 512 + cabs];
        float x0 = bf2f(raw[(16 * tg) * 128 + ch]), x1 = bf2f(raw[(16 * tg + 1) * 128 + ch]), x2 = bf2f(raw[(16 * tg + 2) * 128 + ch]);
#pragma unroll
        for (int t = 0; t < 16; ++t) { const float x3 = bf2f(raw[(16 * tg + t + 3) * 128 + ch]);
            const float y = bb + w0 * x0 + w1 * x1 + w2 * x2 + w3 * x3;
            xcb[(16 * tg + t) * 136 + ch] = (bf16)f2bf(y);
            x0 = x1; x1 = x2; x2 = x3; }
    }
    __syncthreads();
}
__device__ __forceinline__ void lru_gates(Frame& F, int l, int dir, int q) {
    const int lane = F.lane, w = F.wave, r16 = lane & 15, quad = lane >> 4;
    const LAS bf16* xcb = (const LAS bf16*)(F.lds + LR_XCB);
    LAS float* sa = (LAS float*)(F.lds + LR_WV + w * LR_WVB);
    LAS float* sb = sa + 1024;
    const int nbl = w >> 2, dt = w & 3, nb = 2 * q + nbl;
    const bf16* wr = WSP(bf16, WS_LRUW) + ((((size_t)(l * 2 + dir) * 2 + 0) * 8 + nb) * 64 + 16 * dt + r16) * 64 + 8 * quad;
    const bf16* wi = WSP(bf16, WS_LRUW) + ((((size_t)(l * 2 + dir) * 2 + 1) * 8 + nb) * 64 + 16 * dt + r16) * 64 + 8 * quad;
    const bf16x8 br0 = *(const bf16x8*)wr, br1 = *(const bf16x8*)(wr + 32), bi0 = *(const bf16x8*)wi, bi1 = *(const bf16x8*)(wi + 32);
    const int cabs = 64 * nb + 16 * dt + r16, cl = 64 * nbl + 16 * dt + r16;
    const float bR = F.in[I_BBR][(l * 2 + dir) * 512 + cabs], bI = F.in[I_BBI][(l * 2 + dir) * 512 + cabs];
    const float sp = softplusf_(-F.in[I_BLAM][(l * 2 + dir) * 512 + cabs]);
#pragma unroll
    for (int tt = 0; tt < 4; ++tt) {
        const LAS bf16* ap = xcb + (16 * tt + r16) * 136 + 64 * nbl + 8 * quad;
        const bf16x8 a0 = *(const LAS bf16x8*)ap, a1 = *(const LAS bf16x8*)(ap + 32);
        f32x4 ar = (f32x4){0.f, 0.f, 0.f, 0.f}, ai = ar;
        ar = __builtin_amdgcn_mfma_f32_16x16x32_bf16(a0, br0, ar, 0, 0, 0); ar = __builtin_amdgcn_mfma_f32_16x16x32_bf16(a1, br1, ar, 0, 0, 0);
        ai = __builtin_amdgcn_mfma_f32_16x16x32_bf16(a0, bi0, ai, 0, 0, 0); ai = __builtin_amdgcn_mfma_f32_16x16x32_bf16(a1, bi1, ai, 0, 0, 0);
#pragma unroll
        for (int j = 0; j < 4; ++j) { const int t = 16 * tt + 4 * quad + j;
            const float rg = sigmoidf_(ar[j] + bR), ig = sigmoidf_(ai[j] + bI);
            const float la = -8.f * rg * sp;
            const float a = __expf(la), x2 = 2.f * la;
            const float om = x2 > -0.05f ? -x2 * (1.f + x2 * (0.5f + x2 * (0.16666667f + x2 * 0.041666668f))) : 1.f - __expf(x2);
            const float mult = __builtin_amdgcn_sqrtf(om);
            const float xv = bf2f(xcb[t * 136 + cl]);
            sa[t * 16 + r16] = a; sb[t * 16 + r16] = mult * ig * xv; }
    }
    asm volatile("s_waitcnt lgkmcnt(0)" ::: "memory");
}
__device__ __forceinline__ void lru_pass1(Frame& F, int l) {
#pragma unroll 1
    for (int it = (F.bid + F.G / 2) % F.G; it < NCHUNK * 4; it += F.G) {
        REFRESH_TID(F);
        const int g = it >> 2, q = it & 3;
        lru_stage_conv(F, l, g, q);
#pragma unroll 1
        for (int dir = 0; dir < 2; ++dir) {
            lru_gates(F, l, dir, q);
            const int lane = F.lane, w = F.wave, ch = lane & 15, seg = lane >> 4;
            const LAS float* sa = (const LAS float*)(F.lds + LR_WV + w * LR_WVB); const LAS float* sb = sa + 1024;
            float A = 1.f, B = 0.f;
#pragma unroll
            for (int k = 0; k < 16; ++k) { const int tp = 16 * seg + k, t = dir ? 63 - tp : tp; const float a = sa[t * 16 + ch]; B = a * B + sb[t * 16 + ch]; A *= a; }
            float At = 1.f, Bt = 0.f;
#pragma unroll
            for (int s = 0; s < 4; ++s) { const float As = __shfl(A, 16 * s + ch), Bs = __shfl(B, 16 * s + ch); Bt = As * Bt + Bs; At *= As; }
            if (seg == 0) { const int cabs = 128 * q + 64 * (w >> 2) + 16 * (w & 3) + ch;
                WSP(float, WS_LRA)[((size_t)g * 2 + dir) * 512 + cabs] = At; WSP(float, WS_LRB)[((size_t)g * 2 + dir) * 512 + cabs] = Bt; }
            asm volatile("s_waitcnt lgkmcnt(0)" ::: "memory");
        }
    }
}
__device__ __forceinline__ void lru_carry_all(Frame& F) {
    REFRESH_TID(F);
    if (F.tid >= 16) return;
    const float* LA = WSP(float, WS_LRA); const float* LB = WSP(float, WS_LRB); float* LC = WSP(float, WS_LRC);
    for (int chain = F.bid * 16 + F.tid; chain < 4096; chain += F.G * 16) {
        const int ch = chain & 511, dir = (chain >> 9) & 1, b = chain >> 10;
        float h = 0.f;
#pragma unroll 1
        for (int sb = 0; sb < 4; ++sb) {
            float av[17], bv[17]; size_t ix[17];
#pragma unroll
            for (int k = 0; k < 17; ++k) { const int s = sb * 17 + k; int g;
                if (s < 4) g = 256 + 4 * b + (dir ? 3 - s : s); else g = 64 * b + (dir ? 63 - (s - 4) : (s - 4));
                ix[k] = ((size_t)g * 2 + dir) * 512 + ch; av[k] = LA[ix[k]]; bv[k] = LB[ix[k]]; }
#pragma unroll
            for (int k = 0; k < 17; ++k) { LC[ix[k]] = h; h = av[k] * h + bv[k]; }
        }
    }
}
__device__ __forceinline__ float gelu_tanh(float x) { const float u = 0.7978845608028654f * (x + 0.044715f * x * x * x); return x / (1.f + __expf(-2.f * u)); }
__device__ __forceinline__ void lru_pass2(Frame& F, int l) {
#pragma unroll 1
    for (int it = F.bid; it < NCHUNK * 4; it += F.G) {
        REFRESH_TID(F);
        const int g = it >> 2, q = it & 3;
        lru_stage_conv(F, l, g, q);
        const int lane = F.lane, w = F.wave, ch = lane & 15, seg = lane >> 4;
        LAS float* sa = (LAS float*)(F.lds + LR_WV + w * LR_WVB); LAS float* sb = sa + 1024; LAS float* sh = sa + 2048;
        const int cabs = 128 * q + 64 * (w >> 2) + 16 * (w & 3) + ch;
#pragma unroll 1
        for (int dir = 0; dir < 2; ++dir) {
            lru_gates(F, l, dir, q);
            float A = 1.f, B = 0.f;
#pragma unroll
            for (int k = 0; k < 16; ++k) { const int tp = 16 * seg + k, t = dir ? 63 - tp : tp; const float a = sa[t * 16 + ch]; B = a * B + sb[t * 16 + ch]; A *= a; }
            float h = WSP(float, WS_LRC)[((size_t)g * 2 + dir) * 512 + cabs];
#pragma unroll
            for (int s = 0; s < 3; ++s) { const float As = __shfl(A, 16 * s + ch), Bs = __shfl(B, 16 * s + ch); if (s < seg) h = As * h + Bs; }
#pragma unroll
            for (int k = 0; k < 16; ++k) { const int tp = 16 * seg + k, t = dir ? 63 - tp : tp; h = sa[t * 16 + ch] * h + sb[t * 16 + ch];
                if (dir == 0) sh[t * 16 + ch] = h; else sh[t * 16 + ch] += h; }
            asm volatile("s_waitcnt lgkmcnt(0)" ::: "memory");
        }
        const bf16* U = WSP(bf16, WS_U); bf16* YB = WSP(bf16, WS_Y) + (size_t)1 * MROWS * 512;
#pragma unroll
        for (int k = 0; k < 16; ++k) { const int t = 16 * seg + k; const size_t row = (size_t)64 * g + t;
            const float yv = bf2f(U[row * UW + UBY + cabs]);
            YB[row * 512 + cabs] = (bf16)f2bf(sh[t * 16 + ch] * gelu_tanh(yv)); }
        asm volatile("s_waitcnt lgkmcnt(0)" ::: "memory");
    }
}

#ifndef GDN_PREP_REPS
#define GDN_PREP_REPS 1
#endif
constexpr int GD_Q = 0, GD_K = 17408, GD_V = 34816, GD_KK = 52224, GD_QK = 68864, GD_L = 85504, GD_SM = 118272;
__device__ __forceinline__ void gdn_prep(Frame& F, int l) {
    const bf16* U = WSP(bf16, WS_U);
    const int w = F.wave;
#pragma unroll 1
    for (int it0 = F.bid; it0 < NCHUNK * 4 * GDN_PREP_REPS; it0 += F.G) {
        const int it = it0 % (NCHUNK * 4);
        int tid = F.tid; asm volatile("" : "+v"(tid));
        const int lane = tid & 63, r16 = lane & 15, quad = lane >> 4;
        const int g = it >> 2, h = it & 3;
        int lo, hi; seq_bounds(g, lo, hi);
        LAS bf16* raw = (LAS bf16*)(F.lds + GD_KK);
#pragma unroll 1
        for (int ten = 0; ten < 3; ++ten) {
            const int ucol = (ten == 0 ? UCQ : (ten == 1 ? UCK : UCV)) + 128 * h;
            __syncthreads();
            for (int i = tid; i < 67 * 16; i += NT) { const int rr = i >> 4, ch = i & 15, row = 64 * g - 1 + rr;
                v4u v = (v4u){0u, 0u, 0u, 0u};
                if (row >= lo && row < hi) v = *(const v4u*)(U + (size_t)row * UW + ucol + ch * 8);
                *(LAS v4u*)(raw + rr * 128 + ch * 8) = v; }
            __syncthreads();
            const int t = tid >> 3, ds = tid & 7;
            const float* cw = F.in[I_CCW] + (size_t)l * 4 * 1536 + ten * 512 + 128 * h + 16 * ds;
            float y[16]; float ss = 0.f;
#pragma unroll
            for (int jj = 0; jj < 16; ++jj) {
                float a = 0.f;
#pragma unroll
                for (int j = 0; j < 4; ++j) a += cw[j * 1536 + jj] * bf2f(raw[(t + j) * 128 + 16 * ds + jj]);
                a = siluf_(a); y[jj] = a; ss += a * a;
            }
            float sc = 1.f;
            if (ten < 2) { ss += __shfl_xor(ss, 1); ss += __shfl_xor(ss, 2); ss += __shfl_xor(ss, 4); sc = rsqrtf(ss + EPS); if (ten == 0) sc *= 0.08838834764831845f; }
            LAS bf16* dstp = (LAS bf16*)(F.lds + (ten == 0 ? GD_Q : (ten == 1 ? GD_K : GD_V))) + t * 136 + 16 * ds;
            v4u o0, o1;
            o0.x = pk2(y[0] * sc, y[1] * sc); o0.y = pk2(y[2] * sc, y[3] * sc); o0.z = pk2(y[4] * sc, y[5] * sc); o0.w = pk2(y[6] * sc, y[7] * sc);
            o1.x = pk2(y[8] * sc, y[9] * sc); o1.y = pk2(y[10] * sc, y[11] * sc); o1.z = pk2(y[12] * sc, y[13] * sc); o1.w = pk2(y[14] * sc, y[15] * sc);
            *(LAS v4u*)dstp = o0; *(LAS v4u*)(dstp + 8) = o1;
        }
        __syncthreads();
        const LAS bf16* qs = (const LAS bf16*)(F.lds + GD_Q); const LAS bf16* ks = (const LAS bf16*)(F.lds + GD_K); const LAS bf16* vs = (const LAS bf16*)(F.lds + GD_V);
        {
            const int mat = w >> 2, rt = w & 3;
            const LAS bf16* As = mat ? qs : ks;
            LAS float* Out = (LAS float*)(F.lds + (mat ? GD_QK : GD_KK));
            bf16x8 af[4];
#pragma unroll
            for (int s = 0; s < 4; ++s) af[s] = *(const LAS bf16x8*)(As + (16 * rt + r16) * 136 + 32 * s + 8 * quad);
#pragma unroll
            for (int ct = 0; ct < 4; ++ct) {
                f32x4 acc = (f32x4){0.f, 0.f, 0.f, 0.f};
#pragma unroll
                for (int s = 0; s < 4; ++s) { const bf16x8 bfr = *(const LAS bf16x8*)(ks + (16 * ct + r16) * 136 + 32 * s + 8 * quad);
                    acc = __builtin_amdgcn_mfma_f32_16x16x32_bf16(af[s], bfr, acc, 0, 0, 0); }
#pragma unroll
                for (int j = 0; j < 4; ++j) Out[(16 * rt + 4 * quad + j) * 65 + 16 * ct + r16] = acc[j];
            }
        }
        int tid2 = F.tid; asm volatile("" : "+v"(tid2));
        const int dir = tid2 >> 8, dt = tid2 & 255;
        LAS float* sm = (LAS float*)(F.lds + GD_SM) + dir * 256;
        if (dt < 64) {
            const int ti = dir ? 63 - dt : dt; const size_t row = (size_t)64 * g + ti;
            const float ga = WSP(float, WS_CAB)[row * 16 + dir * 4 + h], gb = WSP(float, WS_CAB)[row * 16 + 8 + dir * 4 + h];
            const float gv = -__expf(F.in[I_CALOG][(l * 2 + dir) * 4 + h]) * softplusf_(ga + F.in[I_CDTB][(l * 2 + dir) * 4 + h]);
            float v = gv;
#pragma unroll
            for (int off = 1; off < 64; off <<= 1) { const float u = __builtin_bit_cast(float, __builtin_amdgcn_ds_bpermute(((lane - off) & 63) << 2, __builtin_bit_cast(int, v))); if (lane >= off) v += u; }
            sm[dt] = gv; sm[64 + dt] = sigmoidf_(gb); sm[128 + dt] = v; sm[192 + dt] = __expf(v);
        }
        __syncthreads();
        size_t cd;
        { int bq, cq_, stp; if (g < 256) { bq = g >> 6; cq_ = g & 63; stp = 4 + (dir ? 63 - cq_ : cq_); } else { bq = (g - 256) >> 2; cq_ = (g - 256) & 3; stp = dir ? 3 - cq_ : cq_; }
          cd = ((size_t)((bq * 4 + h) * 2 + dir)) * 68 + stp; }
        const LAS float* KK = (const LAS float*)(F.lds + GD_KK); const LAS float* QKm = (const LAS float*)(F.lds + GD_QK);
        LAS float* Ls = (LAS float*)(F.lds + GD_L) + dir * 4096;
        {
            bf16* gqk = WSP(bf16, WS_GQK) + cd * 4096;
            for (int idx = dt; idx < 4096; idx += 256) { const int i = idx >> 6, j = idx & 63; const int ti = dir ? 63 - i : i, tj = dir ? 63 - j : j;
                const float dec = j <= i ? __expf(sm[128 + i] - sm[128 + j]) : 0.f;
                Ls[idx] = j < i ? sm[64 + i] * KK[ti * 65 + tj] * dec : 0.f;
                gqk[idx] = (bf16)f2bf(QKm[ti * 65 + tj] * dec); }
        }
        __syncthreads();
        {
            float X[64];
            int c = F.tid & 255; asm volatile("" : "+v"(c));
            bf16* outp = WSP(bf16, WS_GW) + cd * 8192 + (c & 127);
            const LAS bf16* src = (c < 128 ? vs : ks) + (c & 127);
#pragma unroll
            for (int i = 0; i < 64; ++i) {
                const int ti = dir ? 63 - i : i;
                float a = sm[64 + i] * bf2f(src[ti * 136]); if (c >= 128) a *= sm[192 + i];
#pragma unroll
                for (int j = 0; j < i; ++j) a -= Ls[i * 64 + j] * X[j];
                X[i] = a;
                if (c >= 128) outp[i * 128] = (bf16)f2bf(a);
                asm volatile("" ::: "memory");
            }
            if (c < 128) {
                v4u* up = (v4u*)(WSP(bf16, WS_GU) + cd * 8192 + (size_t)c * 64);
#pragma unroll
                for (int q8 = 0; q8 < 8; ++q8) { v4u o; o.x = pk2(X[8 * q8], X[8 * q8 + 1]); o.y = pk2(X[8 * q8 + 2], X[8 * q8 + 3]); o.z = pk2(X[8 * q8 + 4], X[8 * q8 + 5]); o.w = pk2(X[8 * q8 + 6], X[8 * q8 + 7]); up[q8] = o; }
            }
        }
        {
            bf16* gqg = WSP(bf16, WS_GQG) + cd * 8192; bf16* gkd = WSP(bf16, WS_GKD) + cd * 8192;
            const float gl = sm[128 + 63];
            for (int idx = dt; idx < 8192; idx += 256) { const int i = idx >> 7, d = idx & 127; const int ti = dir ? 63 - i : i;
                gqg[idx] = (bf16)f2bf(bf2f(qs[ti * 136 + d]) * sm[192 + i]); }
            for (int idx = dt; idx < 8192; idx += 256) { const int d = idx >> 6, i = idx & 63; const int ti = dir ? 63 - i : i;
                gkd[idx] = (bf16)f2bf(bf2f(ks[ti * 136 + d]) * __expf(gl - sm[128 + i])); }
            if (dt == 0) WSP(float, WS_GGL)[cd] = __expf(gl);
        }
    }
    __syncthreads();
}

constexpr int GS_ST = 0, GS_VN = 4352, GS_O = 8192;
struct GdnOps { bf16x8 a[4]; bf16x8 qk[2]; bf16x8 kd[2]; v2u uv; float gl; };
__device__ __forceinline__ bf16x8 ld16_asm(const void* p) { bf16x8 v; asm volatile("global_load_dwordx4 %0, %1, off" : "=v"(v) : "v"(p) : "memory"); return v; }
__device__ __forceinline__ v2u ld8_asm(const void* p) { v2u v; asm volatile("global_load_dwordx2 %0, %1, off" : "=v"(v) : "v"(p) : "memory"); return v; }
__device__ __forceinline__ float ld4_asm(const void* p) { float v; asm volatile("global_load_dword %0, %1, off" : "=v"(v) : "v"(p) : "memory"); return v; }
__device__ __forceinline__ void gdn_load_asm(Frame& F, GdnOps& o, size_t cd, int sl) {
    const int lane = F.lane, w = F.wave, r16 = lane & 15, quad = lane >> 4, rt = w & 3;
    const bf16* ap = (w < 4 ? WSP(bf16, WS_GW) : WSP(bf16, WS_GQG)) + cd * 8192 + (size_t)(16 * rt + r16) * 128 + 8 * quad;
#pragma unroll
    for (int s = 0; s < 4; ++s) o.a[s] = ld16_asm(ap + 32 * s);
    const bf16* kp = WSP(bf16, WS_GKD) + cd * 8192 + (size_t)(16 * w + r16) * 64 + 8 * quad;
    o.kd[0] = ld16_asm(kp); o.kd[1] = ld16_asm(kp + 32);
    const bf16* qp = WSP(bf16, WS_GQK) + cd * 4096 + (size_t)(16 * rt + r16) * 64 + 8 * quad;
    o.qk[0] = ld16_asm(qp); o.qk[1] = ld16_asm(qp + 32);
    o.uv = ld8_asm(WSP(bf16, WS_GU) + cd * 8192 + (size_t)(16 * sl + r16) * 64 + 16 * rt + 4 * quad);
    o.gl = ld4_asm(WSP(float, WS_GGL) + cd);
}
__device__ __forceinline__ void gdn_load(Frame& F, GdnOps& o, size_t cd, int sl) {
    const int lane = F.lane, w = F.wave, r16 = lane & 15, quad = lane >> 4, rt = w & 3;
    const bf16* ap = (w < 4 ? WSP(bf16, WS_GW) : WSP(bf16, WS_GQG)) + cd * 8192 + (size_t)(16 * rt + r16) * 128 + 8 * quad;
#pragma unroll
    for (int s = 0; s < 4; ++s) o.a[s] = *(const bf16x8*)(ap + 32 * s);
    const bf16* kp = WSP(bf16, WS_GKD) + cd * 8192 + (size_t)(16 * w + r16) * 64 + 8 * quad;
    o.kd[0] = *(const bf16x8*)kp; o.kd[1] = *(const bf16x8*)(kp + 32);
    { const bf16* qp = WSP(bf16, WS_GQK) + cd * 4096 + (size_t)(16 * rt + r16) * 64 + 8 * quad; o.qk[0] = *(const bf16x8*)qp; o.qk[1] = *(const bf16x8*)(qp + 32); }
    o.uv = *(const v2u*)(WSP(bf16, WS_GU) + cd * 8192 + (size_t)(16 * sl + r16) * 64 + 16 * rt + 4 * quad);
    o.gl = WSP(float, WS_GGL)[cd];
}
__device__ __forceinline__ size_t gdn_cd(int b, int h, int dir, int s) { return ((size_t)((b * 4 + h) * 2 + dir)) * 68 + s; }
__device__ __forceinline__ int gdn_g(int b, int dir, int s) {
    return s < 4 ? 256 + 4 * b + (dir ? 3 - s : s) : 64 * b + (dir ? 63 - (s - 4) : (s - 4)); }
__device__ __forceinline__ void gdn_scan(Frame& F, int chain) {
    REFRESH_TID(F);
    const int xq = chain & 7, yq = chain >> 3, cg = (yq >> 3) * 8 + xq, sl = yq & 7;
    const int dir = cg & 1, h = (cg >> 1) & 3, b = cg >> 3;
    const int lane = F.lane, w = F.wave, r16 = lane & 15, quad = lane >> 4, rt = w & 3;
    LAS bf16* St = (LAS bf16*)(F.lds + GS_ST); LAS bf16* VNt = (LAS bf16*)(F.lds + GS_VN);
    __syncthreads();
    for (int i = F.tid; i < (GS_VN + 2304) / 4; i += NT) ((LAS unsigned*)F.lds)[i] = 0u;
    __syncthreads();
    f32x4 sacc = (f32x4){0.f, 0.f, 0.f, 0.f};
    float* GO = WSP(float, WS_GO) + (size_t)dir * MROWS * 512;
    LAS float* Ost = (LAS float*)(F.lds + GS_O);
#define GDN_STEP(cur, s_) do { \
          \
        asm volatile("s_waitcnt vmcnt(30)" : "+v"(cur.a[0]), "+v"(cur.a[1]), "+v"(cur.a[2]), "+v"(cur.a[3]), "+v"(cur.kd[0]), "+v"(cur.kd[1]), "+v"(cur.qk[0]), "+v"(cur.qk[1]), "+v"(cur.uv), "+v"(cur.gl) :: "memory"); \
        bf16x8 sbf[4]; \
        _Pragma("unroll") for (int ks = 0; ks < 4; ++ks) sbf[ks] = *(const LAS bf16x8*)(St + r16 * 136 + 32 * ks + 8 * quad); \
        f32x4 acc = (f32x4){0.f, 0.f, 0.f, 0.f}; \
        _Pragma("unroll") for (int ks = 0; ks < 4; ++ks) acc = __builtin_amdgcn_mfma_f32_16x16x32_bf16(cur.a[ks], sbf[ks], acc, 0, 0, 0); \
        if (w < 4) { v2u o; o.x = pk2(bflo(cur.uv.x) - acc[0], bfhi(cur.uv.x) - acc[1]); o.y = pk2(bflo(cur.uv.y) - acc[2], bfhi(cur.uv.y) - acc[3]); \
            *(LAS v2u*)(VNt + r16 * 72 + 16 * rt + 4 * quad) = o; } \
        lds_barrier(); \
        const bf16x8 vb0 = *(const LAS bf16x8*)(VNt + r16 * 72 + 8 * quad), vb1 = *(const LAS bf16x8*)(VNt + r16 * 72 + 32 + 8 * quad); \
        if (w >= 4) { \
            acc = __builtin_amdgcn_mfma_f32_16x16x32_bf16(cur.qk[0], vb0, acc, 0, 0, 0); \
            acc = __builtin_amdgcn_mfma_f32_16x16x32_bf16(cur.qk[1], vb1, acc, 0, 0, 0); \
            _Pragma("unroll") for (int j = 0; j < 4; ++j) Ost[(((s_) & 3) * 64 + 16 * rt + 4 * quad + j) * 16 + r16] = acc[j]; } \
        sacc = sacc * cur.gl; \
        sacc = __builtin_amdgcn_mfma_f32_16x16x32_bf16(cur.kd[0], vb0, sacc, 0, 0, 0); \
        sacc = __builtin_amdgcn_mfma_f32_16x16x32_bf16(cur.kd[1], vb1, sacc, 0, 0, 0); \
        { v2u o; o.x = pk2(sacc[0], sacc[1]); o.y = pk2(sacc[2], sacc[3]); *(LAS v2u*)(St + r16 * 136 + 16 * w + 4 * quad) = o; } \
        lds_barrier(); \
    } while (0)
    GdnOps r0, r1, r2, r3;
    gdn_load_asm(F, r0, gdn_cd(b, h, dir, 0), sl); gdn_load_asm(F, r1, gdn_cd(b, h, dir, 1), sl); gdn_load_asm(F, r2, gdn_cd(b, h, dir, 2), sl); gdn_load_asm(F, r3, gdn_cd(b, h, dir, 3), sl);
#pragma unroll 1
    for (int s = 0; s < 68; s += 4) {
        GDN_STEP(r0, s);     gdn_load_asm(F, r0, gdn_cd(b, h, dir, (s + 4 < 68 ? s + 4 : 67)), sl);
        GDN_STEP(r1, s + 1); gdn_load_asm(F, r1, gdn_cd(b, h, dir, (s + 5 < 68 ? s + 5 : 67)), sl);
        GDN_STEP(r2, s + 2); gdn_load_asm(F, r2, gdn_cd(b, h, dir, (s + 6 < 68 ? s + 6 : 67)), sl);
        GDN_STEP(r3, s + 3);
#pragma unroll
        for (int k2 = 0; k2 < 2; ++k2) { const int idx = F.tid + 512 * k2, st = idx >> 8, i = (idx >> 2) & 63, qd = idx & 3;
            const f32x4 v = *(const LAS f32x4*)(Ost + (st * 64 + i) * 16 + 4 * qd);
            const int g = gdn_g(b, dir, s + st), ti = dir ? 63 - i : i;
            *(f32x4*)(GO + ((size_t)64 * g + ti) * 512 + h * 128 + 16 * sl + 4 * qd) = v; }
        gdn_load_asm(F, r3, gdn_cd(b, h, dir, (s + 7 < 68 ? s + 7 : 67)), sl);
    }
#undef GDN_STEP
    asm volatile("s_waitcnt vmcnt(0)" ::: "memory");
    __syncthreads();
}
template <int NCT> struct GdnOpsW { bf16x8 a[4]; bf16x8 qk[2]; bf16x8 kd[2]; v2u uv[NCT]; float gl; };
template <int NCT>
__device__ __forceinline__ void gdn_load_wide(Frame& F, GdnOpsW<NCT>& o, size_t cd, int part) {
    const int lane = F.lane, w = F.wave, r16 = lane & 15, quad = lane >> 4, rt = w & 3;
    const bf16* ap = (w < 4 ? WSP(bf16, WS_GW) : WSP(bf16, WS_GQG)) + cd * 8192 + (size_t)(16 * rt + r16) * 128 + 8 * quad;
#pragma unroll
    for (int s = 0; s < 4; ++s) o.a[s] = *(const bf16x8*)(ap + 32 * s);
    const bf16* kp = WSP(bf16, WS_GKD) + cd * 8192 + (size_t)(16 * w + r16) * 64 + 8 * quad;
    o.kd[0] = *(const bf16x8*)kp; o.kd[1] = *(const bf16x8*)(kp + 32);
    { const bf16* qp = WSP(bf16, WS_GQK) + cd * 4096 + (size_t)(16 * rt + r16) * 64 + 8 * quad; o.qk[0] = *(const bf16x8*)qp; o.qk[1] = *(const bf16x8*)(qp + 32); }
    const bf16* up = WSP(bf16, WS_GU) + cd * 8192 + (size_t)(part * NCT * 16 + r16) * 64 + 16 * rt + 4 * quad;
#pragma unroll
    for (int ct = 0; ct < NCT; ++ct) o.uv[ct] = *(const v2u*)(up + (size_t)ct * 16 * 64);
    o.gl = WSP(float, WS_GGL)[cd];
}
template <int NCT>
__device__ __forceinline__ void gdn_scan_wide(Frame& F, int cg, int part) {
    REFRESH_TID(F);
    constexpr int NC = NCT * 16, OFF_VN = NC * 136 * 2, OFF_O = OFF_VN + NC * 72 * 2;
    const int dir = cg & 1, h = (cg >> 1) & 3, b = cg >> 3;
    const int lane = F.lane, w = F.wave, r16 = lane & 15, quad = lane >> 4, rt = w & 3;
    LAS bf16* St = (LAS bf16*)(F.lds); LAS bf16* VNt = (LAS bf16*)(F.lds + OFF_VN); LAS float* Ost = (LAS float*)(F.lds + OFF_O);
    __syncthreads();
    for (int i = F.tid; i < OFF_O / 4; i += NT) ((LAS unsigned*)F.lds)[i] = 0u;
    __syncthreads();
    f32x4 sacc[NCT];
#pragma unroll
    for (int ct = 0; ct < NCT; ++ct) sacc[ct] = (f32x4){0.f, 0.f, 0.f, 0.f};
    float* GO = WSP(float, WS_GO) + (size_t)dir * MROWS * 512;
#define GDNW_STEP(cur, s_) do { \
        f32x4 acc[NCT]; \
        _Pragma("unroll") for (int ct = 0; ct < NCT; ++ct) { acc[ct] = (f32x4){0.f, 0.f, 0.f, 0.f}; \
            _Pragma("unroll") for (int ks = 0; ks < 4; ++ks) { const bf16x8 sb = *(const LAS bf16x8*)(St + (16 * ct + r16) * 136 + 32 * ks + 8 * quad); \
                acc[ct] = __builtin_amdgcn_mfma_f32_16x16x32_bf16(cur.a[ks], sb, acc[ct], 0, 0, 0); } } \
        if (w < 4) { _Pragma("unroll") for (int ct = 0; ct < NCT; ++ct) { v2u o; o.x = pk2(bflo(cur.uv[ct].x) - acc[ct][0], bfhi(cur.uv[ct].x) - acc[ct][1]); o.y = pk2(bflo(cur.uv[ct].y) - acc[ct][2], bfhi(cur.uv[ct].y) - acc[ct][3]); \
            *(LAS v2u*)(VNt + (16 * ct + r16) * 72 + 16 * rt + 4 * quad) = o; } } \
        lds_barrier(); \
        _Pragma("unroll") for (int ct = 0; ct < NCT; ++ct) { \
            const bf16x8 vb0 = *(const LAS bf16x8*)(VNt + (16 * ct + r16) * 72 + 8 * quad), vb1 = *(const LAS bf16x8*)(VNt + (16 * ct + r16) * 72 + 32 + 8 * quad); \
            if (w >= 4) { acc[ct] = __builtin_amdgcn_mfma_f32_16x16x32_bf16(cur.qk[0], vb0, acc[ct], 0, 0, 0); acc[ct] = __builtin_amdgcn_mfma_f32_16x16x32_bf16(cur.qk[1], vb1, acc[ct], 0, 0, 0); \
                _Pragma("unroll") for (int j = 0; j < 4; ++j) Ost[(16 * rt + 4 * quad + j) * NC + 16 * ct + r16] = acc[ct][j]; } \
            sacc[ct] = sacc[ct] * cur.gl; \
            sacc[ct] = __builtin_amdgcn_mfma_f32_16x16x32_bf16(cur.kd[0], vb0, sacc[ct], 0, 0, 0); \
            sacc[ct] = __builtin_amdgcn_mfma_f32_16x16x32_bf16(cur.kd[1], vb1, sacc[ct], 0, 0, 0); \
            { v2u o; o.x = pk2(sacc[ct][0], sacc[ct][1]); o.y = pk2(sacc[ct][2], sacc[ct][3]); *(LAS v2u*)(St + (16 * ct + r16) * 136 + 16 * w + 4 * quad) = o; } } \
        lds_barrier(); \
        { const int g = gdn_g(b, dir, (s_)); constexpr int TPR = NC / 16 ;   \
            for (int idx = F.tid; idx < 64 * TPR; idx += NT) { const int i = idx / TPR, c16 = (idx % TPR) * 16, ti = dir ? 63 - i : i; \
                float* gp = GO + ((size_t)64 * g + ti) * 512 + h * 128 + part * NC + c16; \
                _Pragma("unroll") for (int k4 = 0; k4 < 4; ++k4) *(f32x4*)(gp + 4 * k4) = *(const LAS f32x4*)(Ost + i * NC + c16 + 4 * k4); } } \
    } while (0)
    GdnOpsW<NCT> r0, r1;
    gdn_load_wide<NCT>(F, r0, gdn_cd(b, h, dir, 0), part); gdn_load_wide<NCT>(F, r1, gdn_cd(b, h, dir, 1), part);
#pragma unroll 1
    for (int s = 0; s < 68; s += 2) {
        GDNW_STEP(r0, s);     gdn_load_wide<NCT>(F, r0, gdn_cd(b, h, dir, (s + 2 < 68 ? s + 2 : 67)), part);
        GDNW_STEP(r1, s + 1); gdn_load_wide<NCT>(F, r1, gdn_cd(b, h, dir, (s + 3 < 68 ? s + 3 : 67)), part);
    }
#undef GDNW_STEP
    __syncthreads();
}
__device__ __forceinline__ void gdn_out(Frame& F, int l) {
    REFRESH_TID(F);
    const int gw = F.bid * NWAVES + F.wave, NGW = F.G * NWAVES, lane = F.lane;
    const float* G0 = WSP(float, WS_GO); const float* G1 = G0 + (size_t)MROWS * 512;
    const bf16* U = WSP(bf16, WS_U); bf16* YC = WSP(bf16, WS_Y) + (size_t)2 * MROWS * 512;
    const float g0 = F.in[I_CGOUT][l * 128 + 2 * lane], g1 = F.in[I_CGOUT][l * 128 + 2 * lane + 1];
    for (int r = gw; r < MROWS; r += NGW) {
#pragma unroll
        for (int h = 0; h < 4; ++h) {
            const size_t o = (size_t)r * 512 + h * 128 + 2 * lane;
            const float a0 = G0[o] + G1[o], a1 = G0[o + 1] + G1[o + 1];
            const float ss = wave_sum(a0 * a0 + a1 * a1);
            const float rs = rsqrtf(ss * (1.f / 128.f) + EPS);
            const unsigned zz = *(const unsigned*)(U + (size_t)r * UW + UCZ + h * 128 + 2 * lane);
            *(unsigned*)(YC + o) = pk2(a0 * rs * g0 * siluf_(bflo(zz)), a1 * rs * g1 * siluf_(bfhi(zz)));
        }
    }
}

__device__ __forceinline__ void side_k256(f32x4& c0, f32x4& c1, const bf16* ap, const bf16* bp0, const bf16* bp1) {
    bf16x8 a[8], b0[8], b1[8];
#pragma unroll
    for (int s = 0; s < 8; ++s) { a[s] = *(const bf16x8*)(ap + 32 * s); b0[s] = *(const bf16x8*)(bp0 + 32 * s); b1[s] = *(const bf16x8*)(bp1 + 32 * s); }
#pragma unroll
    for (int s = 0; s < 8; ++s) { c0 = __builtin_amdgcn_mfma_f32_16x16x32_bf16(a[s], b0[s], c0, 0, 0, 0); c1 = __builtin_amdgcn_mfma_f32_16x16x32_bf16(a[s], b1[s], c1, 0, 0, 0); }
}
__device__ __forceinline__ void side_merge(Frame& F, int l) {
    REFRESH_TID(F);
    const int lane = F.lane, w = F.wave, r16 = lane & 15, quad = lane >> 4, rt = w & 3, chf = w >> 2;
    const bf16* U = WSP(bf16, WS_U);
    for (int tile = F.bid; tile < 256; tile += F.G) {
        const int row0 = TLAT + 64 * (tile >> 4) + 16 * rt, col0 = 64 * (tile & 15) + 32 * chf;
        f32x4 m0 = (f32x4){0.f, 0.f, 0.f, 0.f}, m1 = m0;
#pragma unroll 1
        for (int br = 0; br < 4; ++br) {
            const bf16* ap = WSP(bf16, WS_Y) + ((size_t)br * MROWS + row0 + r16) * 512 + 8 * quad;
            const bf16* bp0 = WSP(bf16, WS_WBR) + (((size_t)l * 4 + br) * 1024 + col0 + r16) * 512 + 8 * quad;
            const bf16* bp1 = bp0 + (size_t)16 * 512;
            f32x4 c0 = (f32x4){0.f, 0.f, 0.f, 0.f}, c1 = c0;
            side_k256(c0, c1, ap, bp0, bp1);
            side_k256(c0, c1, ap + 256, bp0 + 256, bp1 + 256);
#pragma unroll
            for (int j = 0; j < 4; ++j) { const bf16* gp = U + (size_t)(row0 + 4 * quad + j) * UW + UG + br * 1024 + col0 + r16;
                m0[j] += sigmoidf_(bf2f(gp[0])) * c0[j]; m1[j] += sigmoidf_(bf2f(gp[16])) * c1[j]; }
        }
#pragma unroll
        for (int j = 0; j < 4; ++j) { bf16* mp = WSP(bf16, WS_MB) + (size_t)(row0 + 4 * quad + j) * 1024 + col0 + r16;
            mp[0] = (bf16)f2bf(m0[j]); mp[16] = (bf16)f2bf(m1[j]); }
    }
}
__device__ __forceinline__ void side_outproj(Frame& F, int l) {
    REFRESH_TID(F);
    const int lane = F.lane, w = F.wave, r16 = lane & 15, quad = lane >> 4, rt = w & 3, chf = w >> 2;
    const float* gt = WSP(float, WS_MOD) + ((size_t)l * 5 + 4) * 6144 + 2048;
    for (int tile = F.bid; tile < 256; tile += F.G) {
        const int row0 = TLAT + 64 * (tile >> 4) + 16 * rt, col0 = 64 * (tile & 15) + 32 * chf;
        const bf16* ap = WSP(bf16, WS_MB) + (size_t)(row0 + r16) * 1024 + 8 * quad;
        const bf16* bp0 = WSP(bf16, WS_WOUT) + ((size_t)l * 1024 + col0 + r16) * 1024 + 8 * quad;
        const bf16* bp1 = bp0 + (size_t)16 * 1024;
        f32x4 c0 = (f32x4){0.f, 0.f, 0.f, 0.f}, c1 = c0;
#pragma unroll 1
        for (int kb = 0; kb < 4; ++kb) side_k256(c0, c1, ap + 256 * kb, bp0 + 256 * kb, bp1 + 256 * kb);
        const float g0 = gt[col0 + r16], g1 = gt[col0 + 16 + r16];
#pragma unroll
        for (int j = 0; j < 4; ++j) { float* xp = WSP(float, WS_X) + (size_t)(row0 + 4 * quad + j) * 1024 + col0 + r16;
            xp[0] += g0 * c0[j]; xp[16] += g1 * c1[j]; }
    }
}

#ifndef SCAN_PARTS
#define SCAN_PARTS 2
#endif
constexpr int NSCAN = 4 * SCAN_PARTS;
constexpr int CW_Q = 2048;
__device__ __forceinline__ void mixer_queue_phase(Frame& F, int l) {
    volatile LAS int* qslot = (volatile LAS int*)(F.lds + MISC_OFF + 64);
    const int x0 = (int)(xb_xcc_id() & 7u);
#if defined(PROBE_SUB) && (PROBE_SUB == 4 || PROBE_SUB == 5)
    const unsigned long long tq0 = __builtin_amdgcn_s_memrealtime();
#endif
#pragma unroll 1
    for (int kq = 0; kq < 8; ++kq) {
      const int x = (x0 + kq) & 7;
      for (;;) {
        __syncthreads();
        if (F.tid == 0) *qslot = (int)__hip_atomic_fetch_add(F.ctl + CW_Q + l * 8 + x, 1u, __ATOMIC_RELAXED, __HIP_MEMORY_SCOPE_AGENT);
        __syncthreads();
        const int idx = __builtin_amdgcn_readfirstlane(*qslot);
        if (idx >= 136 + NSCAN) break;
#ifdef PROBE_SUB
        unsigned long long t0_ = 0ull; const bool pr_on = false;
#endif
        if (idx < NSCAN) { gdn_scan_wide<8 / SCAN_PARTS>(F, x + 8 * (idx / SCAN_PARTS), idx % SCAN_PARTS); }
        else { AttnUnit un; const int q = idx - NSCAN;
            if (q < 64) { un.kind = 0; un.b = x >> 1; un.hx = x & 1; un.qx = q; }
            else if (q < 128) { const int qq = q - 64, combo = x + 8 * (qq >> 4); un.kind = 1; un.b = combo >> 3; un.hx = combo & 7; un.qx = qq & 15; }
            else { const int qq = q - 128;
                if (qq < 4) { un.kind = 2; un.b = x >> 1; un.hx = x & 1; un.qx = qq; }
                else { const int combo = x + 8 * (qq - 4); un.kind = 3; un.b = combo >> 3; un.hx = combo & 7; un.qx = 0; } }
            attn_unit(F, l, un); }
#ifdef PROBE_SUB
        if (pr_on) F.pr += __builtin_amdgcn_s_memrealtime() - t0_;
        if (PROBE_SUB == 13 && F.bid == 8 && idx >= 4 && idx < 68) F.pr += 100;
        if (PROBE_SUB == 14 && F.bid == 8 && idx >= 68 && idx < 140) F.pr += 100;
#endif
      }
    }
#if defined(PROBE_SUB) && PROBE_SUB == 4
    if (F.tid == 0) __hip_atomic_fetch_max(F.ctl + 3000 + l, (unsigned)(__builtin_amdgcn_s_memrealtime() - tq0), __ATOMIC_RELAXED, __HIP_MEMORY_SCOPE_AGENT);
#endif
#if defined(PROBE_SUB) && PROBE_SUB == 5
    if (F.tid == 0) __hip_atomic_fetch_max(F.ctl + 3000 + l, 0x7fffffffu - (unsigned)(__builtin_amdgcn_s_memrealtime() - tq0), __ATOMIC_RELAXED, __HIP_MEMORY_SCOPE_AGENT);
#endif
}

#ifndef REP_P0
#define REP_P0 1
#endif
#ifndef REP_B
#define REP_B 1
#endif
#ifndef REP_D1
#define REP_D1 1
#endif
#ifndef REP_D2
#define REP_D2 1
#endif
#ifndef REP_E
#define REP_E 1
#endif
#ifndef REP_F
#define REP_F 1
#endif
#ifndef REP_I
#define REP_I 1
#endif
#ifndef REP_J
#define REP_J 1
#endif
#ifndef REP_C1
#define REP_C1 1
#endif
#ifndef REP_C2
#define REP_C2 1
#endif
#ifndef REP_C4
#define REP_C4 1
#endif
#ifndef REP_G2
#define REP_G2 1
#endif

#ifndef MIXER_QUEUE
#define MIXER_QUEUE 1
#endif
constexpr int PH_PER_LAYER = 11, PH_FINAL = 1 + PH_PER_LAYER * DEPTH, N_PHASES = PH_FINAL + 1;
struct Args { const float* in[32]; float* out; unsigned char* ws; int ph_lo, ph_hi, li, pad; };

__global__ void __launch_bounds__(NT, 2) hybrid_fwd(Args args) {
    extern __shared__ __attribute__((aligned(16))) unsigned char lds_raw[];
    Frame F;
    F.lds = (LAS unsigned char*)lds_raw;
    F.wave = __builtin_amdgcn_readfirstlane((int)threadIdx.x >> 6); F.lane = (int)__builtin_amdgcn_mbcnt_hi(~0u, __builtin_amdgcn_mbcnt_lo(~0u, 0u)); F.tid = F.wave * 64 + F.lane;
    F.G = gridDim.x; F.bid = blockIdx.x; F.pr = 0ull;
    F.in = args.in; F.in0 = args.in;
    F.out = args.out; F.ws = args.ws; F.ws0 = args.ws; F.ctl = (unsigned*)(args.ws + WS_CTL);
    volatile LAS unsigned* MISC = (volatile LAS unsigned*)(F.lds + MISC_OFF);
    if (F.tid < 64) MISC[F.tid] = 0u;
    __syncthreads();
    const int lo = args.ph_lo, hi = args.ph_hi;
    XcdBarrier bar = xcd_barrier_post(F.ctl + CW_BAR + args.li * XCD_BAR_WORDS, MISC + 8);
#ifndef ONLY_MASK
#define ONLY_MASK 0xFFFF
#endif
#define PHON(b) ((ONLY_MASK >> (b)) & 1)
#define IN(k) (lo <= (k) && (k) < hi)
#define SEAM(k) do { if ((k) + 1 < hi) xcd_barrier(bar); } while (0)
#ifdef PROBE_PHASE
    unsigned long long pr_acc = 0ull, pr_t0 = 0ull;
#define PR_BEGIN(k) do { if ((k) == PROBE_PHASE) pr_t0 = __builtin_amdgcn_s_memrealtime(); } while (0)
#define PR_END(k) do { if ((k) == PROBE_PHASE) pr_acc += __builtin_amdgcn_s_memrealtime() - pr_t0; } while (0)
#else
#define PR_BEGIN(k) do { } while (0)
#define PR_END(k) do { } while (0)
#endif

    if (PHON(0) && IN(0)) { REFRESH_TID(F); _Pragma("unroll 1") for (int rep_ = 0; rep_ < REP_P0; ++rep_) { p0_prologue(F); __syncthreads(); } SEAM(0); PR_END(0); }
#pragma unroll 1
    for (int l = 0; l < DEPTH; ++l) {
        const int pb = 1 + PH_PER_LAYER * l;
        if (PHON(1) && IN(pb + 0)) { PR_BEGIN(1); REFRESH_TID(F); norm_phase<0>(F, l); SEAM(pb + 0); PR_END(1); }
        if (PHON(2) && IN(pb + 1)) { PR_BEGIN(2); REFRESH_TID(F);
            pg8::Gemm g{WSP(bf16, WS_H), WSP(bf16, WS_WIN) + (size_t)l * UW * D, MROWS, UW, D};
            pg8::StaticOrder S; S.init(MROWS, UW, F.G, F.bid);
            pg8::EpiStoreBf16 E{WSP(bf16, WS_U), UW};
            _Pragma("unroll 1") for (int rep_ = 0; rep_ < REP_B; ++rep_) { pg8::gemm_phase<pg8::EpiStoreBf16, pg8::StaticOrder, true, true>(F.lds, g, S, E, F.wave); __syncthreads(); }
            SEAM(pb + 1); PR_END(2);
        }
        if (PHON(3) && IN(pb + 2)) { PR_BEGIN(3); REFRESH_TID(F);
#ifndef NO_C1
            _Pragma("unroll 1") for (int rep_ = 0; rep_ < REP_C1; ++rep_) { gdn_prep(F, l); __syncthreads(); }
#endif
#ifndef NO_C2
            _Pragma("unroll 1") for (int rep_ = 0; rep_ < REP_C2; ++rep_) { lru_pass1(F, l); __syncthreads(); }
#endif
            __syncthreads();
#ifndef NO_C3
            qk_prep(F, l);
#endif
#ifndef NO_C4
            _Pragma("unroll 1") for (int rep_ = 0; rep_ < REP_C4; ++rep_) { v_transpose(F); __syncthreads(); }
#endif
            SEAM(pb + 2); PR_END(3);
        }
        if (PHON(4) && IN(pb + 3)) { PR_BEGIN(4); REFRESH_TID(F);
#if MIXER_QUEUE
            lru_carry_all(F);
            __syncthreads();
            mixer_queue_phase(F, l);
#else
            PR_BEGIN(20); for (int ch = F.bid; ch < 256; ch += F.G) gdn_scan(F, ch); PR_END(20);
            PR_BEGIN(21); lru_carry_all(F);
            __syncthreads(); PR_END(21);
            PR_BEGIN(22); attn_phase(F, l); PR_END(22);
#endif
            PR_BEGIN(23);
            SEAM(pb + 3); PR_END(23); PR_END(4);
        }
        if (PHON(5) && IN(pb + 4)) { PR_BEGIN(5); REFRESH_TID(F);
            _Pragma("unroll 1") for (int rep_ = 0; rep_ < REP_E; ++rep_) { lru_pass2(F, l); __syncthreads(); }
            __syncthreads();
            gdn_out(F, l);
            SEAM(pb + 4); PR_END(5);
        }
        if (PHON(6) && IN(pb + 5)) { PR_BEGIN(6); REFRESH_TID(F);
            pg8::Gemm g{WSP(bf16, WS_Y), WSP(bf16, WS_WBR) + (size_t)l * 4 * 1024 * 512, 4 * MROWS, 4 * 1024, 512};
            pg8::MergeOrder S{F.G, F.bid, MROWS / 256, TLAT / 256};
            pg8::EpiMerge E{WSP(bf16, WS_U), UW, UG, WSP(bf16, WS_MF), WSP(bf16, WS_MB), MROWS / 256};
            _Pragma("unroll 1") for (int rep_ = 0; rep_ < REP_F; ++rep_) { pg8::gemm_phase<pg8::EpiMerge, pg8::MergeOrder, true, true>(F.lds, g, S, E, F.wave); __syncthreads(); }
            PR_BEGIN(13); side_merge(F, l); PR_END(13);
            SEAM(pb + 5); PR_END(6);
        }
        if (PHON(7) && IN(pb + 6)) { PR_BEGIN(7); REFRESH_TID(F);
            pg8::Gemm g{WSP(bf16, WS_MB), WSP(bf16, WS_WOUT) + (size_t)l * D * D, MROWS, D, D};
            pg8::StaticOrder S; S.init(TLAT, D, F.G, F.bid);
            pg8::EpiResid E{WSP(float, WS_X), WSP(float, WS_MOD) + (size_t)l * 5 * 6144 + 2048};
            pg8::gemm_phase<pg8::EpiResid, pg8::StaticOrder, true, true>(F.lds, g, S, E, F.wave);
            PR_BEGIN(14); side_outproj(F, l); PR_END(14);
            SEAM(pb + 6); PR_END(7);
        }
        if (PHON(8) && IN(pb + 7)) { PR_BEGIN(8); REFRESH_TID(F); norm_phase<1>(F, l); SEAM(pb + 7); PR_END(8); }
        if (PHON(9) && IN(pb + 8)) { PR_BEGIN(9); REFRESH_TID(F); _Pragma("unroll 1") for (int rep_ = 0; rep_ < REP_G2; ++rep_) { moe_gather(F, l); __syncthreads(); } SEAM(pb + 8); PR_END(9); }
        if (PHON(10) && IN(pb + 9)) { PR_BEGIN(10); REFRESH_TID(F);
            moe_table(F, l);
            pg8::Gemm g{WSP(bf16, WS_HS), WSP(bf16, WS_WGU) + (size_t)l * NEXP * 2048 * D, MOE_ROWS, NEXP * 2048, D};
            pg8::MoeOrder S{(const LAS int*)(F.lds + MISC_OFF + 256), F.G, F.bid, 8};
            pg8::EpiSwiglu E{WSP(bf16, WS_ACT), F.in[I_BGU] + (size_t)l * NEXP * 2048};
            _Pragma("unroll 1") for (int rep_ = 0; rep_ < REP_I; ++rep_) { pg8::gemm_phase<pg8::EpiSwiglu, pg8::MoeOrder, true, true>(F.lds, g, S, E, F.wave); __syncthreads(); }
            SEAM(pb + 9); PR_END(10);
        }
        if (PHON(11) && IN(pb + 10)) { PR_BEGIN(11); REFRESH_TID(F);
            moe_table(F, l);
            pg8::Gemm g{WSP(bf16, WS_ACT), WSP(bf16, WS_WDN) + (size_t)l * NEXP * D * D, MOE_ROWS, NEXP * D, D};
            pg8::MoeOrder S{(const LAS int*)(F.lds + MISC_OFF + 256), F.G, F.bid, 4};
            pg8::EpiDown E{WSP(bf16, WS_YS), F.in[I_BDN] + (size_t)l * NEXP * D};
            _Pragma("unroll 1") for (int rep_ = 0; rep_ < REP_J; ++rep_) { pg8::gemm_phase<pg8::EpiDown, pg8::MoeOrder, true, true>(F.lds, g, S, E, F.wave); __syncthreads(); }
            SEAM(pb + 10); PR_END(11);
        }
    }
    if (PHON(12) && IN(PH_FINAL)) { PR_BEGIN(12); REFRESH_TID(F); norm_phase<2>(F, 0); PR_END(12); }
#if defined(PROBE_SUB) && (PROBE_SUB == 4 || PROBE_SUB == 5)
    if (blockIdx.x == 0) { unsigned long long tot = 0ull;
        for (int q = 0; q < 4; ++q) { const unsigned v = __hip_atomic_load(F.ctl + 3000 + q, __ATOMIC_RELAXED, __HIP_MEMORY_SCOPE_AGENT); tot += (PROBE_SUB == 4) ? v : (0x7fffffffu - v); }
        F.pr = tot; }
#endif
#ifdef PROBE_SUB
    if (F.pr) { const unsigned long long te = __builtin_amdgcn_s_memrealtime(); while (__builtin_amdgcn_s_memrealtime() - te < PROBE_MULT * F.pr) __builtin_amdgcn_s_sleep(8); }
#endif
#ifdef PROBE_PHASE
    if (blockIdx.x == 0) { const unsigned long long te = __builtin_amdgcn_s_memrealtime(); while (__builtin_amdgcn_s_memrealtime() - te < PROBE_MULT * pr_acc) __builtin_amdgcn_s_sleep(8); }
#endif
#undef IN
#undef SEAM
}

extern "C" void kernel_launch(void* const* d_in, const int* in_sizes, int n_in, void* d_out, int out_size, void* d_ws, size_t ws_size, hipStream_t stream) {
    static int grid = 0;
    if (grid == 0) {
        if (n_in != 32 || out_size != TLAT * D || ws_size < WS_END) { fprintf(stderr, "kernel_launch: unexpected shapes (n_in %d out %d ws %zu need %zu)\n", n_in, out_size, ws_size, (size_t)WS_END); grid = -1; return; }
        int dev = 0, cus = 0, per_cu = 0;
        if (hipGetDevice(&dev) != hipSuccess || hipDeviceGetAttribute(&cus, hipDeviceAttributeMultiprocessorCount, dev) != hipSuccess) { grid = -1; return; }
        if (hipFuncSetAttribute((const void*)hybrid_fwd, hipFuncAttributeMaxDynamicSharedMemorySize, LDS_BYTES) != hipSuccess) { fprintf(stderr, "kernel_launch: hipFuncSetAttribute failed\n"); grid = -1; return; }
        if (hipOccupancyMaxActiveBlocksPerMultiprocessor(&per_cu, (const void*)hybrid_fwd, NT, LDS_BYTES) != hipSuccess || per_cu < 1) fprintf(stderr, "kernel_launch: occupancy query says %d\n", per_cu);
        (void)hipGetLastError();
        grid = cus;
    }
    if (grid < 0) return;
    if (hipMemsetAsync((char*)d_ws + WS_CTL, 0, CTL_BYTES, stream) != hipSuccess) return;
    Args a{};
    for (int i = 0; i < 32; ++i) a.in[i] = (const float*)d_in[i];
    a.out = (float*)d_out; a.ws = (unsigned char*)d_ws;
#if MK_MULTI
    for (int p = 0; p < N_PHASES; ++p) { a.ph_lo = p; a.ph_hi = p + 1; a.li = p;
        hipLaunchKernelGGL(hybrid_fwd, dim3(grid), dim3(NT), LDS_BYTES, stream, a); }
#else
    a.ph_lo = 0; a.ph_hi = N_PHASES; a.li = 0;
    hipLaunchKernelGGL(hybrid_fwd, dim3(grid), dim3(NT), LDS_BYTES, stream, a);
#endif
    const hipError_t le = hipPeekAtLastError();
    if (le != hipSuccess) fprintf(stderr, "kernel_launch: launch failed: %s\n", hipGetErrorName(le));
}
```

```cpp
#include <hip/hip_runtime.h>
#include <cstdio>
#include <cstdint>

#ifndef MK_MULTI
#define MK_MULTI 0
#endif

constexpr int D = 1024, NB = 4, SEQ = 4096, LCTX = 256, DEPTH = 4;
constexpr int TLAT = NB * SEQ, TCTX = NB * LCTX, MROWS = TLAT + TCTX;
constexpr int NCHUNK = MROWS / 64;
constexpr int INW = 9488, UW = 9472;
constexpr int UQ = 0, UK = 512, UV = 640, UBX = 768, UBY = 1280, UCQ = 1792, UCK = 2304, UCV = 2816, UCZ = 3328, UDQ = 3840, UDK = 4352, UDV = 4864, UG = 5376;
constexpr int NEXP = 32, TOPK = 4;
constexpr int KEYS = SEQ + LCTX;
constexpr int MOE_ROWS = MROWS * TOPK + NEXP * 256;
constexpr float EPS = 1e-6f;
constexpr float LOG2E = 1.4426950408889634f;

constexpr size_t al256(size_t x) { return (x + 255) & ~(size_t)255; }
constexpr size_t WS_CTL = 0, CTL_BYTES = 1u << 20;
constexpr size_t WS_MOD  = WS_CTL + CTL_BYTES;
constexpr size_t WS_ROPE = WS_MOD + al256((size_t)DEPTH * 5 * 6144 * 4);
constexpr size_t WS_LRUW = WS_ROPE + al256(2 * 64 * 16 * 4);
constexpr size_t WS_WIN  = WS_LRUW + al256((size_t)DEPTH * 2 * 2 * 8 * 4096 * 2);
constexpr size_t WS_WBR  = WS_WIN + al256((size_t)DEPTH * UW * D * 2);
constexpr size_t WS_WOUT = WS_WBR + al256((size_t)DEPTH * 4 * 1024 * 512 * 2);
constexpr size_t WS_WGU  = WS_WOUT + al256((size_t)DEPTH * D * D * 2);
constexpr size_t WS_WDN  = WS_WGU + al256((size_t)DEPTH * NEXP * 2048 * 1024 * 2);
constexpr size_t WS_X    = WS_WDN + al256((size_t)DEPTH * NEXP * 1024 * 1024 * 2);
constexpr size_t WS_H    = WS_X + al256((size_t)MROWS * D * 4);
constexpr size_t WS_U    = WS_H + al256((size_t)MROWS * D * 2);
constexpr size_t WS_CAB  = WS_U + al256((size_t)MROWS * UW * 2);
constexpr size_t WS_VAT  = WS_CAB + al256((size_t)MROWS * 16 * 4);
constexpr size_t WS_VDT  = WS_VAT + al256((size_t)NB * 2 * 64 * KEYS * 2);
constexpr size_t WS_LRA  = WS_VDT + al256((size_t)NB * 8 * 64 * KEYS * 2);
constexpr size_t WS_LRB  = WS_LRA + al256((size_t)NCHUNK * 2 * 512 * 4);
constexpr size_t WS_LRC  = WS_LRB + al256((size_t)NCHUNK * 2 * 512 * 4);
constexpr int NCD = NCHUNK * 4 * 2;
constexpr size_t WS_GW   = WS_LRC + al256((size_t)NCHUNK * 2 * 512 * 4);
constexpr size_t WS_GU   = WS_GW + al256((size_t)NCD * 64 * 128 * 2);
constexpr size_t WS_GQG  = WS_GU + al256((size_t)NCD * 64 * 128 * 2);
constexpr size_t WS_GKD  = WS_GQG + al256((size_t)NCD * 64 * 128 * 2);
constexpr size_t WS_GQK  = WS_GKD + al256((size_t)NCD * 64 * 128 * 2);
constexpr size_t WS_GGL  = WS_GQK + al256((size_t)NCD * 64 * 64 * 2);
constexpr size_t WS_GO   = WS_GGL + al256((size_t)NCD * 4);
constexpr size_t WS_Y    = WS_GO + al256((size_t)2 * MROWS * 512 * 4);
constexpr size_t WS_MF   = WS_Y + al256((size_t)4 * MROWS * 512 * 2);
constexpr size_t WS_MB   = WS_MF + al256((size_t)MROWS * D * 4);
constexpr size_t WS_SROW = WS_MB + al256((size_t)MROWS * D * 2);
constexpr size_t WS_SW   = WS_SROW + al256((size_t)MROWS * 4 * 4);
constexpr size_t WS_SEP  = WS_SW + al256((size_t)MROWS * 4 * 4);
constexpr size_t WS_LIST = WS_SEP + al256((size_t)MROWS * 4 * 4);
constexpr size_t WS_HS   = WS_LIST + al256((size_t)NEXP * MROWS * 4);
constexpr size_t WS_ACT  = WS_HS + al256((size_t)MOE_ROWS * D * 2);
constexpr size_t WS_YS   = WS_ACT + al256((size_t)MOE_ROWS * D * 2);
constexpr size_t WS_END  = WS_YS + al256((size_t)MOE_ROWS * D * 2);

constexpr int CW_BAR = 4096;
constexpr int CW_CNT = 1024;

constexpr int RING_BYTES = 131072;
constexpr int MISC_OFF = RING_BYTES;
constexpr int LDS_BYTES = 147456;
constexpr int NWAVES = 8, NT = 512;

#define GAS __attribute__((address_space(1)))
#define LAS __attribute__((address_space(3)))
typedef unsigned short bf16;
typedef unsigned v4u __attribute__((ext_vector_type(4)));
typedef unsigned v2u __attribute__((ext_vector_type(2)));
typedef float f32x4 __attribute__((ext_vector_type(4)));
typedef float f32x16 __attribute__((ext_vector_type(16)));
typedef short bf16x8 __attribute__((ext_vector_type(8)));
typedef short bf16x4 __attribute__((ext_vector_type(4)));

typedef float f32x2_t __attribute__((ext_vector_type(2))); typedef __bf16 bf16x2_t __attribute__((ext_vector_type(2)));
__device__ __forceinline__ unsigned pk2(float lo, float hi) { f32x2_t v = {lo, hi}; bf16x2_t b = __builtin_convertvector(v, bf16x2_t); return __builtin_bit_cast(unsigned, b); }
__device__ __forceinline__ unsigned f2bf(float f) { return pk2(f, 0.f) & 0xffffu; }
__device__ __forceinline__ float bf2f(unsigned short b) { return __builtin_bit_cast(float, (unsigned)b << 16); }
__device__ __forceinline__ float bflo(unsigned w) { return __builtin_bit_cast(float, w << 16); }
__device__ __forceinline__ float bfhi(unsigned w) { return __builtin_bit_cast(float, w & 0xffff0000u); }
__device__ __forceinline__ float wave_sum(float v) {
#pragma unroll
    for (int o = 1; o < 64; o <<= 1) v += __shfl_xor(v, o);
    return v;
}
__device__ __forceinline__ float sigmoidf_(float x) { return 1.f / (1.f + __expf(-x)); }
__device__ __forceinline__ float softplusf_(float x) { return x > 20.f ? x : log1pf(__expf(x)); }
__device__ __forceinline__ float siluf_(float x) { return x / (1.f + __expf(-x)); }
__device__ __forceinline__ void lds_barrier() { asm volatile("s_waitcnt lgkmcnt(0)\n\ts_barrier" ::: "memory"); }
namespace pg8 {
#define PG8_LAS __attribute__((address_space(3)))
typedef unsigned short bf16_t;
typedef short bf16x8 __attribute__((ext_vector_type(8)));
typedef float f32x4 __attribute__((ext_vector_type(4)));
typedef unsigned u32x4 __attribute__((ext_vector_type(4)));
constexpr int BM = 256, BK = 64, HALF = 128, HTB = HALF * BK * 2  , STAGE_BYTES = 8 * HTB, NXCD = 8, WGM = 8;

__host__ __device__ __forceinline__ int lds_byte(int r, int c) { const int st = (r >> 4) * 2 + (c >> 5), rr = r & 15, cc = c & 31, ob = rr * 64 + cc * 2; return st * 1024 + (ob ^ (((ob >> 9) & 1) << 5)); }
__host__ __device__ __forceinline__ void stage_rc(int b, int& R, int& C) { const int st = b / 1024, sb = b % 1024, swz = sb ^ (((sb >> 9) & 1) << 5); R = (st >> 1) * 16 + swz / 64; C = (st & 1) * 32 + (swz % 64) / 2; }
__host__ __device__ __forceinline__ int perm32(int rho) { const int n = rho >> 4, i = rho & 15; return 8 * (i >> 2) + 4 * n + (i & 3); }

struct Unit { int pm, pn; };
struct Gemm { const bf16_t* A; const bf16_t* Bt; int M, N, K; };

struct StaticOrder {
    int nM, nN, nwg, G, c;
    __host__ __device__ void init(int M, int N, int G_, int c_) { nM = M / BM; nN = N / BM; nwg = nM * nN; G = G_; c = c_; }
    __host__ __device__ bool next(int i, Unit& u) const {
        const long L = (long)i * G + c; if (L >= nwg) return false;
        int wgid = (int)L; { const int q = nwg / NXCD, r = nwg % NXCD, xcd = wgid % NXCD, off = wgid / NXCD; wgid = (xcd < r ? xcd * (q + 1) : r * (q + 1) + (xcd - r) * q) + off; }
        const int nig = WGM * nN, gid = wgid / nig, fm = gid * WGM, gsz = (nM - fm) < WGM ? (nM - fm) : WGM;
        u.pm = fm + ((wgid % nig) % gsz); u.pn = (wgid % nig) / gsz; return true;
    }
    __device__ __forceinline__ void a_ready(const Unit&) const {}
    __device__ __forceinline__ void done(const Unit&) const {}
};

__device__ __forceinline__ unsigned cvt_pk_bf16(float lo, float hi) { unsigned r; asm volatile("v_cvt_pk_bf16_f32 %0, %1, %2" : "=v"(r) : "v"(lo), "v"(hi)); return r; }
typedef float f32x2 __attribute__((ext_vector_type(2)));
template <class Epi, class Sched, bool ALIGN_EPI = false, bool SP2 = false>
__device__ __forceinline__ void gemm_phase(PG8_LAS unsigned char* lds, const Gemm g, const Sched& S, const Epi& E, const int wid_in) {
    int lane_o = (int)__builtin_amdgcn_mbcnt_hi(~0u, __builtin_amdgcn_mbcnt_lo(~0u, 0u)); asm volatile("" : "+v"(lane_o));
    const int wid = __builtin_amdgcn_readfirstlane(wid_in), lane = lane_o, tid = wid * 64 + lane, wr = wid >> 2, wc = wid & 3, fr = lane & 15, fq = lane >> 4;
    const int K = g.K, nt = K / BK;
    unsigned voffA[2], voffB[2];
#pragma unroll
    for (int i = 0; i < 2; ++i) { int R, C; stage_rc(tid * 16 + i * 8192, R, C); const int Rb = Epi::PERM ? ((R & ~31) + perm32(R & 31)) : R;
        voffA[i] = (unsigned)(R * K + C) * 2u; voffB[i] = (unsigned)(Rb * K + C) * 2u; }
    const size_t kstep = (size_t)(BK * 2);
    const size_t hstep = (size_t)HALF * K * 2;
    const size_t tstep = 2 * hstep;
    const unsigned ldsw = (unsigned)wid * 1024u;
    const int aoff = lds_byte(wr * 64 + fr, fq * 8), boff = lds_byte(wc * 32 + fr, fq * 8);
#define PG8_SA(b, h) (((b) * 2 + (h)) * HTB)
#define PG8_SB(b, h) ((4 + (b) * 2 + (h)) * HTB)
#define PG8_STAGE(bufoff, gbase, voff) do { _Pragma("unroll") for (int _i = 0; _i < 2; ++_i) \
        __builtin_amdgcn_global_load_lds((const unsigned*)((const char*)(gbase) + (voff)[_i]), (PG8_LAS unsigned*)(lds + (bufoff) + ldsw + _i * 8192), 16, 0, 0); } while (0)
#define PG8_LDA(dst, b, h) do { _Pragma("unroll") for (int m = 0; m < 4; ++m) _Pragma("unroll") for (int k = 0; k < 2; ++k) dst[m][k] = *(const PG8_LAS bf16x8*)(lds + PG8_SA(b, h) + aoff + m * 2048 + k * 1024); } while (0)
#define PG8_LDB(dst, b, h) do { _Pragma("unroll") for (int n = 0; n < 2; ++n) _Pragma("unroll") for (int k = 0; k < 2; ++k) dst[n][k] = *(const PG8_LAS bf16x8*)(lds + PG8_SB(b, h) + boff + n * 2048 + k * 1024); } while (0)
#define PG8_MMA(ai, bj, At, Bt) do { __builtin_amdgcn_s_setprio(1); _Pragma("unroll") for (int m = 0; m < 4; ++m) _Pragma("unroll") for (int n = 0; n < 2; ++n) _Pragma("unroll") for (int k = 0; k < 2; ++k) \
        acc[ai][bj][m][n] = __builtin_amdgcn_mfma_f32_16x16x32_bf16(Bt[n][k], At[m][k], acc[ai][bj][m][n], 0, 0, 0); __builtin_amdgcn_s_setprio(0); } while (0)
#define PG8_WAIT_V(n) asm volatile("s_waitcnt vmcnt(" #n ")" ::: "memory")
#define PG8_WAIT_L(n) asm volatile("s_waitcnt lgkmcnt(" #n ")" ::: "memory")
#define PG8_BAR __builtin_amdgcn_s_barrier()
#define PG8_SCHED __builtin_amdgcn_sched_barrier(0)
    Unit cur, nxt; int ui = 0;
    if (!S.next(0, cur)) return;
    f32x4 acc[2][2][4][2];
#pragma unroll
    for (int a = 0; a < 2; ++a)
#pragma unroll
        for (int b = 0; b < 2; ++b)
#pragma unroll
            for (int m = 0; m < 4; ++m)
#pragma unroll
                for (int n = 0; n < 2; ++n) acc[a][b][m][n] = (f32x4){0.f, 0.f, 0.f, 0.f};
    bf16x8 At[4][2], B0[2][2], B1[2][2];
    const char* cA = (const char*)g.A + (size_t)cur.pm * tstep; const char* cB = (const char*)g.Bt + (size_t)cur.pn * tstep;
    S.a_ready(cur);
    if constexpr (SP2) {
        PG8_STAGE(PG8_SB(0, 0), cB, voffB); PG8_STAGE(PG8_SB(0, 1), cB + hstep, voffB); PG8_STAGE(PG8_SA(0, 0), cA, voffA); PG8_STAGE(PG8_SA(0, 1), cA + hstep, voffA);
        if (wr == 1) PG8_BAR;
        PG8_WAIT_V(2); PG8_BAR;
        PG8_STAGE(PG8_SB(1, 0), cB + kstep, voffB); PG8_STAGE(PG8_SA(1, 0), cA + kstep, voffA); PG8_STAGE(PG8_SB(1, 1), cB + hstep + kstep, voffB);
        PG8_WAIT_V(6); PG8_BAR;
    } else {
        PG8_STAGE(PG8_SB(0, 0), cB, voffB); PG8_STAGE(PG8_SA(0, 0), cA, voffA); PG8_STAGE(PG8_SB(0, 1), cB + hstep, voffB); PG8_STAGE(PG8_SA(0, 1), cA + hstep, voffA);
        if (wr == 1) PG8_BAR;
        PG8_WAIT_V(4); PG8_BAR;
        PG8_STAGE(PG8_SB(1, 0), cB + kstep, voffB); PG8_STAGE(PG8_SA(1, 0), cA + kstep, voffA); PG8_STAGE(PG8_SB(1, 1), cB + hstep + kstep, voffB);
        PG8_WAIT_V(6); PG8_BAR;
    }
    for (;;) {
        const bool has_next = S.next(ui + 1, nxt);
        const char* nA = has_next ? (const char*)g.A + (size_t)nxt.pm * tstep : cA; const char* nB = has_next ? (const char*)g.Bt + (size_t)nxt.pn * tstep : cB;
        for (int t = 0; t < nt; t += 2) {
            const bool last = (t == nt - 2);
            const char* a1 = cA + (size_t)(t + 1) * kstep;
            const char* a2 = last ? nA : cA + (size_t)(t + 2) * kstep; const char* b2 = last ? nB : cB + (size_t)(t + 2) * kstep;
            const char* a3 = a2 + kstep; const char* b3 = b2 + kstep;
            if (last && has_next) S.a_ready(nxt);
            if constexpr (SP2) {
            PG8_LDB(B0, 0, 0); PG8_LDB(B1, 0, 1); PG8_SCHED; PG8_LDA(At, 0, 0); PG8_STAGE(PG8_SA(1, 1), a1 + hstep, voffA);
            PG8_WAIT_V(8); PG8_WAIT_L(0); PG8_BAR; PG8_MMA(0, 0, At, B0); PG8_MMA(0, 1, At, B1); PG8_BAR; PG8_SCHED;
            PG8_LDA(At, 0, 1); PG8_STAGE(PG8_SB(0, 0), b2, voffB); PG8_STAGE(PG8_SB(0, 1), b2 + hstep, voffB); PG8_STAGE(PG8_SA(0, 0), a2, voffA);
            PG8_WAIT_V(8); PG8_WAIT_L(0); PG8_BAR; PG8_MMA(1, 0, At, B0); PG8_MMA(1, 1, At, B1); PG8_BAR; PG8_SCHED;
            PG8_LDB(B0, 1, 0); PG8_LDB(B1, 1, 1); PG8_SCHED; PG8_LDA(At, 1, 0); PG8_STAGE(PG8_SA(0, 1), a2 + hstep, voffA);
            PG8_WAIT_V(8); PG8_WAIT_L(0); PG8_BAR; PG8_MMA(0, 0, At, B0); PG8_MMA(0, 1, At, B1); PG8_BAR; PG8_SCHED;
            PG8_LDA(At, 1, 1); PG8_STAGE(PG8_SB(1, 0), b3, voffB); PG8_STAGE(PG8_SB(1, 1), b3 + hstep, voffB); PG8_STAGE(PG8_SA(1, 0), a3, voffA);
            PG8_WAIT_V(8); PG8_WAIT_L(0); PG8_BAR; PG8_MMA(1, 0, At, B0); PG8_MMA(1, 1, At, B1); PG8_BAR; PG8_SCHED;
            } else {
            PG8_LDB(B0, 0, 0); PG8_SCHED; PG8_LDA(At, 0, 0); PG8_STAGE(PG8_SA(1, 1), a1 + hstep, voffA);
            PG8_WAIT_L(8); PG8_BAR; PG8_WAIT_L(0); PG8_MMA(0, 0, At, B0); PG8_BAR; PG8_SCHED;
            PG8_LDB(B1, 0, 1); PG8_STAGE(PG8_SB(0, 0), b2, voffB);
            PG8_BAR; PG8_WAIT_L(0); PG8_MMA(0, 1, At, B1); PG8_BAR;
            PG8_LDA(At, 0, 1); PG8_STAGE(PG8_SA(0, 0), a2, voffA);
            PG8_BAR; PG8_WAIT_L(0); PG8_MMA(1, 0, At, B0); PG8_BAR; PG8_SCHED;
            PG8_STAGE(PG8_SB(0, 1), b2 + hstep, voffB);
            PG8_WAIT_V(6); PG8_BAR; PG8_MMA(1, 1, At, B1); PG8_BAR;
            PG8_LDB(B0, 1, 0); PG8_SCHED; PG8_LDA(At, 1, 0); PG8_STAGE(PG8_SA(0, 1), a2 + hstep, voffA);
            PG8_WAIT_L(8); PG8_BAR; PG8_WAIT_L(0); PG8_MMA(0, 0, At, B0); PG8_BAR; PG8_SCHED;
            PG8_LDB(B1, 1, 1); PG8_STAGE(PG8_SB(1, 0), b3, voffB);
            PG8_BAR; PG8_WAIT_L(0); PG8_MMA(0, 1, At, B1); PG8_BAR;
            PG8_LDA(At, 1, 1); PG8_STAGE(PG8_SA(1, 0), a3, voffA);
            PG8_BAR; PG8_WAIT_L(0); PG8_MMA(1, 0, At, B0); PG8_BAR; PG8_SCHED;
            PG8_STAGE(PG8_SB(1, 1), b3 + hstep, voffB);
            PG8_WAIT_V(6); PG8_BAR; PG8_MMA(1, 1, At, B1); PG8_BAR;
            }
        }
        if constexpr (ALIGN_EPI) { if (wr == 0) PG8_BAR; }
        if constexpr (!Epi::AFTER_DRAIN) { E(acc, cur, wr, wc, fr, fq); S.done(cur); }
        if (!has_next) break;
#pragma unroll
        for (int a = 0; a < 2; ++a)
#pragma unroll
            for (int b = 0; b < 2; ++b)
#pragma unroll
                for (int m = 0; m < 4; ++m)
#pragma unroll
                    for (int n = 0; n < 2; ++n) acc[a][b][m][n] = (f32x4){0.f, 0.f, 0.f, 0.f};
        cur = nxt; cA = nA; cB = nB; ++ui;
        if constexpr (ALIGN_EPI) { if (wr == 1) PG8_BAR; }
    }
    PG8_WAIT_V(0);
    if constexpr (!ALIGN_EPI) { if (wr == 0) PG8_BAR; }
    PG8_BAR;
    if constexpr (Epi::AFTER_DRAIN) { E.fused(acc, cur, wr, wc, fr, fq, lds, wid, lane); S.done(cur); }
#undef PG8_SA
#undef PG8_SB
#undef PG8_STAGE
#undef PG8_LDA
#undef PG8_LDB
#undef PG8_MMA
#undef PG8_WAIT_V
#undef PG8_WAIT_L
#undef PG8_BAR
#undef PG8_SCHED
}
}

namespace pg8 {
__device__ __forceinline__ float bflo_(unsigned w) { return __builtin_bit_cast(float, w << 16); }
__device__ __forceinline__ float bfhi_(unsigned w) { return __builtin_bit_cast(float, w & 0xffff0000u); }
__device__ __forceinline__ float sigm_(float x) { return 1.f / (1.f + __expf(-x)); }

struct EpiStoreBf16 {
    static constexpr bool PERM = true, AFTER_DRAIN = false;
    bf16_t* O; int ldc;
    __device__ __forceinline__ void operator()(const f32x4 (&acc)[2][2][4][2], const Unit& u, int wr, int wc, int fr, int fq) const {
        const int row0 = u.pm * BM + wr * 64 + fr, col0 = u.pn * BM + wc * 32 + 8 * fq;
#pragma unroll
        for (int ai = 0; ai < 2; ++ai)
#pragma unroll
            for (int m = 0; m < 4; ++m) { bf16_t* rowp = O + (size_t)(row0 + ai * HALF + m * 16) * ldc + col0;
#pragma unroll
                for (int bj = 0; bj < 2; ++bj) { const f32x4 v0 = acc[ai][bj][m][0], v1 = acc[ai][bj][m][1];
                    u32x4 w; w.x = cvt_pk_bf16(v0[0], v0[1]); w.y = cvt_pk_bf16(v0[2], v0[3]); w.z = cvt_pk_bf16(v1[0], v1[1]); w.w = cvt_pk_bf16(v1[2], v1[3]);
                    *(u32x4*)(rowp + bj * HALF) = w; } }
    }
};

struct EpiMerge {
    static constexpr bool PERM = true, AFTER_DRAIN = false;
    const bf16_t* U; int ldu, gcol0; bf16_t* Mf; bf16_t* Mb; int npm;
    __device__ __forceinline__ void operator()(const f32x4 (&acc)[2][2][4][2], const Unit& u, int wr, int wc, int fr, int fq) const {
        const int br = u.pm / npm, pm = u.pm - br * npm, pn = u.pn & 3;
        const int row0 = pm * BM + wr * 64 + fr, col0 = pn * BM + wc * 32 + 8 * fq;
#pragma unroll
        for (int ai = 0; ai < 2; ++ai)
#pragma unroll
            for (int m = 0; m < 4; ++m) { const size_t row = (size_t)(row0 + ai * HALF + m * 16);
#pragma unroll
                for (int bj = 0; bj < 2; ++bj) { const int col = col0 + bj * HALF;
                    const u32x4 g = *(const u32x4*)(U + row * ldu + gcol0 + br * 1024 + col);
                    f32x4 v0 = acc[ai][bj][m][0], v1 = acc[ai][bj][m][1];
                    v0[0] *= sigm_(bflo_(g.x)); v0[1] *= sigm_(bfhi_(g.x)); v0[2] *= sigm_(bflo_(g.y)); v0[3] *= sigm_(bfhi_(g.y));
                    v1[0] *= sigm_(bflo_(g.z)); v1[1] *= sigm_(bfhi_(g.z)); v1[2] *= sigm_(bflo_(g.w)); v1[3] *= sigm_(bfhi_(g.w));
                    bf16_t* mp = Mf + row * 1024 + col;
                    if (br > 0) { const u32x4 p = *(const u32x4*)mp;
                        v0[0] += bflo_(p.x); v0[1] += bfhi_(p.x); v0[2] += bflo_(p.y); v0[3] += bfhi_(p.y); v1[0] += bflo_(p.z); v1[1] += bfhi_(p.z); v1[2] += bflo_(p.w); v1[3] += bfhi_(p.w); }
                    u32x4 w; w.x = cvt_pk_bf16(v0[0], v0[1]); w.y = cvt_pk_bf16(v0[2], v0[3]); w.z = cvt_pk_bf16(v1[0], v1[1]); w.w = cvt_pk_bf16(v1[2], v1[3]);
                    *(u32x4*)((br < 3 ? mp : Mb + row * 1024 + col)) = w; } }
    }
};
struct MergeOrder {
    int G, c, npm, ncnt;
    __device__ __forceinline__ bool next(int i, Unit& u) const {
        const int su = (i >> 2) * G + c; if (su >= ncnt * 4) return false;
        const int br = i & 3; u.pm = br * npm + (su >> 2); u.pn = br * 4 + (su & 3); return true; }
    __device__ __forceinline__ void a_ready(const Unit&) const {}
    __device__ __forceinline__ void done(const Unit&) const {}
};

struct EpiResid {
    static constexpr bool PERM = false, AFTER_DRAIN = false;
    float* X; const float* gt;
    __device__ __forceinline__ void operator()(const f32x4 (&acc)[2][2][4][2], const Unit& u, int wr, int wc, int fr, int fq) const {
        const int row0 = u.pm * BM + wr * 64 + fr, col0 = u.pn * BM + wc * 32 + 4 * fq;
        const int mr = u.pm < 64 ? (u.pm >> 4) : 4;
        f32x4 gv[2][2];
#pragma unroll
        for (int bj = 0; bj < 2; ++bj)
#pragma unroll
            for (int n = 0; n < 2; ++n) gv[bj][n] = *(const f32x4*)(gt + (size_t)mr * 6144 + col0 + bj * HALF + n * 16);
#pragma unroll
        for (int ai = 0; ai < 2; ++ai)
#pragma unroll
            for (int m = 0; m < 4; ++m) { float* rowp = X + (size_t)(row0 + ai * HALF + m * 16) * 1024 + col0;
#pragma unroll
                for (int bj = 0; bj < 2; ++bj)
#pragma unroll
                    for (int n = 0; n < 2; ++n) { float* p = rowp + bj * HALF + n * 16; *(f32x4*)p = *(const f32x4*)p + gv[bj][n] * acc[ai][bj][m][n]; } }
    }
};

struct MoeOrder {
    const PG8_LAS int* tpre; int G, c, ncol;
    __device__ __forceinline__ bool next(int i, Unit& u) const {
        int tau, pnl;
        if ((G & 7) == 0 && ((G >> 3) % ncol) == 0) { const int x = c & 7, y = c >> 3, rp = (G >> 3) / ncol; tau = (i * 8 + x) * rp + y / ncol; pnl = y % ncol; }
        else { const int L = i * G + c; tau = L / ncol; pnl = L - tau * ncol; }
        if (tau >= tpre[32]) return false;
        int e = 0;
#pragma unroll 1
        while (tpre[e + 1] <= tau) ++e;
        u.pm = tau; u.pn = e * ncol + pnl; return true; }
    __device__ __forceinline__ void a_ready(const Unit&) const {}
    __device__ __forceinline__ void done(const Unit&) const {}
};
struct EpiSwiglu {
    static constexpr bool PERM = true, AFTER_DRAIN = false;
    bf16_t* ACT; const float* bgu;
    __device__ __forceinline__ void operator()(const f32x4 (&acc)[2][2][4][2], const Unit& u, int wr, int wc, int fr, int fq) const {
        const int e = u.pn >> 3, pnl = u.pn & 7;
        const int row0 = u.pm * BM + wr * 64 + fr, cl = 128 * pnl + wc * 32 + 8 * fq;
        const float* bg = bgu + (size_t)e * 2048 + cl;
        const f32x4 bg0 = *(const f32x4*)bg, bg1 = *(const f32x4*)(bg + 4), bu0 = *(const f32x4*)(bg + 1024), bu1 = *(const f32x4*)(bg + 1028);
#pragma unroll
        for (int ai = 0; ai < 2; ++ai)
#pragma unroll
            for (int m = 0; m < 4; ++m) {
                f32x4 g0 = acc[ai][0][m][0] + bg0, g1 = acc[ai][0][m][1] + bg1, u0 = acc[ai][1][m][0] + bu0, u1 = acc[ai][1][m][1] + bu1;
                float o[8];
#pragma unroll
                for (int j = 0; j < 4; ++j) { const float g = fminf(g0[j], 7.f), up = fminf(fmaxf(u0[j], -7.f), 7.f); o[j] = (up + 1.f) * g * sigm_(1.702f * g); }
#pragma unroll
                for (int j = 0; j < 4; ++j) { const float g = fminf(g1[j], 7.f), up = fminf(fmaxf(u1[j], -7.f), 7.f); o[4 + j] = (up + 1.f) * g * sigm_(1.702f * g); }
                u32x4 w; w.x = cvt_pk_bf16(o[0], o[1]); w.y = cvt_pk_bf16(o[2], o[3]); w.z = cvt_pk_bf16(o[4], o[5]); w.w = cvt_pk_bf16(o[6], o[7]);
                *(u32x4*)(ACT + (size_t)(row0 + ai * HALF + m * 16) * 1024 + cl) = w; }
    }
};
struct EpiDown {
    static constexpr bool PERM = true, AFTER_DRAIN = false;
    bf16_t* YS; const float* bdn;
    __device__ __forceinline__ void operator()(const f32x4 (&acc)[2][2][4][2], const Unit& u, int wr, int wc, int fr, int fq) const {
        const int e = u.pn >> 2, pnl = u.pn & 3;
        const int row0 = u.pm * BM + wr * 64 + fr, col0 = pnl * BM + wc * 32 + 8 * fq;
        f32x4 bv[2][2];
#pragma unroll
        for (int bj = 0; bj < 2; ++bj)
#pragma unroll
            for (int n = 0; n < 2; ++n) bv[bj][n] = *(const f32x4*)(bdn + (size_t)e * 1024 + col0 + bj * HALF + 4 * n);
#pragma unroll
        for (int ai = 0; ai < 2; ++ai)
#pragma unroll
            for (int m = 0; m < 4; ++m) { bf16_t* rowp = YS + (size_t)(row0 + ai * HALF + m * 16) * 1024 + col0;
#pragma unroll
                for (int bj = 0; bj < 2; ++bj) { const f32x4 v0 = acc[ai][bj][m][0] + bv[bj][0], v1 = acc[ai][bj][m][1] + bv[bj][1];
                    u32x4 w; w.x = cvt_pk_bf16(v0[0], v0[1]); w.y = cvt_pk_bf16(v0[2], v0[3]); w.z = cvt_pk_bf16(v1[0], v1[1]); w.w = cvt_pk_bf16(v1[2], v1[3]);
                    *(u32x4*)(rowp + bj * HALF) = w; } }
    }
};
}
#define XB_TMO      128
#define XB_XCNT(j)  (256  + 64 * (j))
#define XB_XSUB(j)  (1280 + 64 * (j))
#define XB_XGEN(j)  (2304 + 64 * (j))
#define XB_TOP      3328
#define XB_TOPGEN   3392
#define XCD_BAR_WORDS 3456
#define XB_SPIN_CAP (1u << 18)
#define LAS __attribute__((address_space(3)))

__device__ __forceinline__ unsigned xb_ld(unsigned* p)              { return __hip_atomic_load(p, __ATOMIC_RELAXED, __HIP_MEMORY_SCOPE_AGENT); }
__device__ __forceinline__ unsigned xb_add(unsigned* p, unsigned v) { return __hip_atomic_fetch_add(p, v, __ATOMIC_RELAXED, __HIP_MEMORY_SCOPE_AGENT); }
__device__ __forceinline__ unsigned xb_xcc_id() { return (unsigned)__builtin_amdgcn_s_getreg((3 << 11) | 20) & 0xFu; }
#define XB_SPIN(cond, bar) do { unsigned _sp = 0; while (cond) { __builtin_amdgcn_s_sleep(1); \
    if ((++_sp & 255u) == 0u) { if (xb_ld(&(bar)[XB_TMO])) break; if (_sp > XB_SPIN_CAP) { atomicAdd(&(bar)[XB_TMO], 1u); break; } } } } while (0)

struct XcdBarrier {
    unsigned* bar; unsigned x;
    volatile LAS unsigned* st;
};

__device__ __forceinline__ XcdBarrier xcd_barrier_post(unsigned* bar, volatile LAS unsigned* st) {
    XcdBarrier b; b.bar = bar; b.x = xb_xcc_id(); b.st = st;
    if (threadIdx.x == 0) (void)xb_add(&bar[XB_XCNT(b.x)], 1u);
    return b;
}
__device__ __forceinline__ void xcd_barrier_complete(unsigned* bar, unsigned x, unsigned& nloc, unsigned& nx) {
    const unsigned G = gridDim.x * gridDim.y * gridDim.z;
    unsigned sum, cnt, mine, sp = 0u;
    for (;;) {
        sum = 0u; cnt = 0u; mine = 0u;
#pragma unroll
        for (unsigned j = 0; j < 16; ++j) { const unsigned c = xb_ld(&bar[XB_XCNT(j)]); sum += c; cnt += (c > 0u) ? 1u : 0u; mine = (j == x) ? c : mine; }
        if (sum == G) break;
        __builtin_amdgcn_s_sleep(1);
        if ((++sp & 255u) == 0u) { if (xb_ld(&bar[XB_TMO])) break; if (sp > XB_SPIN_CAP) { atomicAdd(&bar[XB_TMO], 1u); break; } }
    }
    nloc = mine > 0u ? mine : 1u; nx = cnt > 0u ? cnt : 1u;
}

__device__ __forceinline__ void xcd_barrier(const XcdBarrier& b) {
    asm volatile("s_waitcnt vmcnt(0)" ::: "memory");
    __syncthreads();
    if (threadIdx.x == 0) {
        unsigned* bar = b.bar;
        __builtin_amdgcn_s_waitcnt(0);
        unsigned nloc = b.st[0], nx = b.st[1];
        if (nloc == 0u) { xcd_barrier_complete(bar, b.x, nloc, nx); b.st[0] = nloc; b.st[1] = nx; }
        const unsigned old = xb_add(&bar[XB_XSUB(b.x)], 1u);
        const unsigned gen = old / nloc;
        if (old + 1u == (gen + 1u) * nloc) {
            __builtin_amdgcn_fence(__ATOMIC_RELEASE, "agent");
            asm volatile("s_waitcnt vmcnt(0)" ::: "memory");
            const unsigned og = xb_add(&bar[XB_TOP], 1u);
            const unsigned tg = og / nx;
            if (og + 1u == (tg + 1u) * nx) xb_add(&bar[XB_TOPGEN], 1u);
            else XB_SPIN(xb_ld(&bar[XB_TOPGEN]) == tg, bar);
            __builtin_amdgcn_fence(__ATOMIC_ACQUIRE, "agent");
            xb_add(&bar[XB_XGEN(b.x)], 1u);
            asm volatile("s_waitcnt vmcnt(0)" ::: "memory");
        } else {
            XB_SPIN(xb_ld(&bar[XB_XGEN(b.x)]) == gen, bar);
            __builtin_amdgcn_fence(__ATOMIC_ACQUIRE, "agent");
            asm volatile("s_waitcnt vmcnt(0)" ::: "memory");
        }
    }
    __syncthreads();
}

struct Frame {
    LAS unsigned char* lds;
    unsigned* ctl;
    int tid, lane, wave, G, bid;
    unsigned long long pr;
    const float* const* in; const float* const* in0;
    float* out;
    unsigned char* ws; unsigned char* ws0;
};
#define WSP(T, off) ((T*)(F.ws + (off)))
#define REFRESH_TID(F) do { int t_ = (int)__builtin_amdgcn_mbcnt_hi(~0u, __builtin_amdgcn_mbcnt_lo(~0u, 0u)); asm volatile("" : "+v"(t_)); F.lane = t_; F.tid = F.wave * 64 + t_; \
    int z_ = 0; asm volatile("s_mov_b32 %0, 0" : "=s"(z_)); F.ws = F.ws0 + z_; F.in = F.in0 + z_; F.bid = (int)blockIdx.x + z_; } while (0)
#define I_X 0
#define I_C 1
#define I_CTX 2
#define I_CCTX 3
#define I_WMOD 4
#define I_BMOD 5
#define I_G1 6
#define I_G2 7
#define I_WIN 8
#define I_AGQ 9
#define I_AGK 10
#define I_BCW 11
#define I_BCB 12
#define I_BLAM 13
#define I_BWR 14
#define I_BBR 15
#define I_BWI 16
#define I_BBI 17
#define I_CCW 18
#define I_CALOG 19
#define I_CDTB 20
#define I_CGOUT 21
#define I_RPB 22
#define I_WBR 23
#define I_WOUT 24
#define I_WRT 25
#define I_BRT 26
#define I_WGU 27
#define I_BGU 28
#define I_WDN 29
#define I_BDN 30
#define I_GFIN 31

__device__ __forceinline__ int mod_row(int r) { return r < TLAT ? (r >> 12) : 4; }

__device__ __forceinline__ void p0_transpose_item(const float* W, size_t pitch, int K, bf16* WT, int drow0, int scol0, int k0, LAS float* scr, int lane) {
    float v[32];
#pragma unroll
    for (int i = 0; i < 32; ++i) { const int kk = 2 * i + (lane >> 5); v[i] = W[(size_t)(k0 + kk) * pitch + scol0 + (lane & 31)]; }
#pragma unroll
    for (int i = 0; i < 32; ++i) { const int kk = 2 * i + (lane >> 5); scr[kk * 33 + (lane & 31)] = v[i]; }
    asm volatile("s_waitcnt lgkmcnt(0)" ::: "memory");
    const int c = lane & 7;
#pragma unroll
    for (int j = 0; j < 4; ++j) { const int n = (lane >> 3) + 8 * j; const LAS float* s = scr + (8 * c) * 33 + n;
        v4u o; o.x = pk2(s[0 * 33], s[1 * 33]); o.y = pk2(s[2 * 33], s[3 * 33]); o.z = pk2(s[4 * 33], s[5 * 33]); o.w = pk2(s[6 * 33], s[7 * 33]);
        *(v4u*)(WT + (size_t)(drow0 + n) * K + k0 + 8 * c) = o; }
    asm volatile("s_waitcnt lgkmcnt(0)" ::: "memory");
}

__device__ __forceinline__ void p0_prologue(Frame& F) {
    LAS float* scr = (LAS float*)(F.lds + F.wave * 16384);
    const int gw = F.bid * NWAVES + F.wave, NGW = F.G * NWAVES;
    constexpr int I_IN = DEPTH * 16 * (UW / 32);
    constexpr int I_BR = DEPTH * 4 * 8 * 32;
    constexpr int I_OUT = DEPTH * 16 * 32;
    constexpr int I_GU = DEPTH * NEXP * 16 * 64;
    constexpr int I_DN = DEPTH * NEXP * 16 * 32;
    constexpr int NITEMS = I_IN + I_BR + I_OUT + I_GU + I_DN;
    for (int it = gw; it < NITEMS; it += NGW) {
        int r = it;
        if (r < I_IN) { const int l = r / (16 * 296), q = r % (16 * 296), kb = q / 296, nb = q % 296; const int n0 = nb * 32, sc = n0 < 3840 ? n0 : n0 + 16;
            p0_transpose_item(F.in[I_WIN] + (size_t)l * D * INW, INW, D, WSP(bf16, WS_WIN) + (size_t)l * UW * D, n0, sc, kb * 64, scr, F.lane); continue; }
        r -= I_IN;
        if (r < I_BR) { const int mi = r / 256, q = r % 256, kb = q / 32, nb = q % 32;
            p0_transpose_item(F.in[I_WBR] + (size_t)mi * 512 * 1024, 1024, 512, WSP(bf16, WS_WBR) + (size_t)mi * 1024 * 512, nb * 32, nb * 32, kb * 64, scr, F.lane); continue; }
        r -= I_BR;
        if (r < I_OUT) { const int l = r / 512, q = r % 512, kb = q / 32, nb = q % 32;
            p0_transpose_item(F.in[I_WOUT] + (size_t)l * D * D, D, D, WSP(bf16, WS_WOUT) + (size_t)l * D * D, nb * 32, nb * 32, kb * 64, scr, F.lane); continue; }
        r -= I_OUT;
        if (r < I_GU) { const int mi = r / 1024, q = r % 1024, kb = q / 64, nb = q % 64; const int j0 = nb * 32, pn = j0 >> 8, bj = (j0 >> 7) & 1, cc = j0 & 127;
            p0_transpose_item(F.in[I_WGU] + (size_t)mi * D * 2048, 2048, D, WSP(bf16, WS_WGU) + (size_t)mi * 2048 * D, j0, 1024 * bj + 128 * pn + cc, kb * 64, scr, F.lane); continue; }
        r -= I_GU;
        { const int mi = r / 512, q = r % 512, kb = q / 32, nb = q % 32;
            p0_transpose_item(F.in[I_WDN] + (size_t)mi * D * D, D, D, WSP(bf16, WS_WDN) + (size_t)mi * D * D, nb * 32, nb * 32, kb * 64, scr, F.lane); }
    }
    __syncthreads();
    {
        LAS float* sc = (LAS float*)F.lds;
        LAS float* part = sc + 5 * 1024;
        bool staged = false;
        for (int it = F.bid; it < DEPTH * 96; it += F.G) {
            if (!staged) {
                for (int i = F.tid; i < 5 * 1024; i += NT) { const int r = i >> 10, k = i & 1023; const float cv = r < 4 ? F.in[I_C][r * 1024 + k] : F.in[I_CCTX][k]; sc[i] = siluf_(cv); }
                __syncthreads(); staged = true;
            }
            const int l = it / 96, cg = it % 96, col = cg * 64 + F.lane;
            const float* wm = F.in[I_WMOD] + (size_t)l * D * 6144 + col;
            float a0 = 0.f, a1 = 0.f, a2 = 0.f, a3 = 0.f, a4 = 0.f;
            const int kb = F.wave * 128;
#pragma unroll 16
            for (int k = 0; k < 128; ++k) { const float w = wm[(size_t)(kb + k) * 6144];
                a0 += sc[kb + k] * w; a1 += sc[1024 + kb + k] * w; a2 += sc[2048 + kb + k] * w; a3 += sc[3072 + kb + k] * w; a4 += sc[4096 + kb + k] * w; }
            LAS float* pp = part + F.wave * 320 + F.lane;
            pp[0] = a0; pp[64] = a1; pp[128] = a2; pp[192] = a3; pp[256] = a4;
            __syncthreads();
            if (F.tid < 320) { const int r = F.tid >> 6, ln = F.tid & 63; float s = 0.f;
#pragma unroll
                for (int w = 0; w < 8; ++w) s += part[w * 320 + r * 64 + ln];
                const int cc = cg * 64 + ln;
                WSP(float, WS_MOD)[((size_t)l * 5 + r) * 6144 + cc] = s + F.in[I_BMOD][l * 6144 + cc]; }
            __syncthreads();
        }
    }
    if (F.bid == 0) {
        for (int i = F.tid; i < 1024; i += NT) { const int p = i >> 4, f = i & 15; const float inv = powf(10000.f, -(float)f / 16.f); const float ang = (float)p * inv;
            WSP(float, WS_ROPE)[i] = cosf(ang); WSP(float, WS_ROPE)[1024 + i] = sinf(ang); }
    }
    for (int i = F.bid * NT + F.tid; i < DEPTH * 2 * 2 * 8 * 4096; i += F.G * NT) {
        const int c = i & 63, d = (i >> 6) & 63, n = (i >> 12) & 7, gate = (i >> 15) & 1, ld = i >> 16;
        const float* src = gate ? F.in[I_BWI] : F.in[I_BWR];
        WSP(bf16, WS_LRUW)[i] = (bf16)f2bf(src[((size_t)ld * 8 + n) * 4096 + c * 64 + d]);
    }
}

template <int MODE>
__device__ __forceinline__ void norm_phase(Frame& F, int l) {
    LAS float* hs = (LAS float*)F.lds;
    LAS int* lcnt = (LAS int*)(F.lds + 65536);
    LAS int* lbase = lcnt + 32;
    const int ngroups = (MODE == 2 ? TLAT : MROWS) / 16;
    const float* modl = WSP(float, WS_MOD) + (size_t)l * 5 * 6144;
    for (int gi = F.bid; gi < ngroups; gi += F.G) {
        REFRESH_TID(F);
        if (MODE == 1) { if (F.tid < 32) lcnt[F.tid] = 0; }
#pragma unroll
        for (int i = 0; i < 2; ++i) {
            const int lr = 2 * F.wave + i, r = gi * 16 + lr, mr = mod_row(r);
            const float* xsrc;
            if (MODE == 0 && l == 0) xsrc = r < TLAT ? F.in[I_X] + (size_t)r * D : F.in[I_CTX] + (size_t)(r - TLAT) * D;
            else xsrc = WSP(float, WS_X) + (size_t)r * D;
            f32x4 v[4];
#pragma unroll
            for (int j = 0; j < 4; ++j) v[j] = *(const f32x4*)(xsrc + 4 * F.lane + 256 * j);
            if ((MODE == 0 && l > 0) || MODE == 2) {
                const int lp = MODE == 2 ? DEPTH - 1 : l - 1;
                const float* gt2 = WSP(float, WS_MOD) + ((size_t)lp * 5 + mr) * 6144 + 5120;
                f32x4 cb[4];
#pragma unroll
                for (int j = 0; j < 4; ++j) cb[j] = (f32x4){0.f, 0.f, 0.f, 0.f};
#pragma unroll
                for (int k = 0; k < 4; ++k) {
                    const int sr = WSP(int, WS_SROW)[r * 4 + k]; const float w = WSP(float, WS_SW)[r * 4 + k];
                    const bf16* yr = WSP(bf16, WS_YS) + (size_t)sr * D;
#pragma unroll
                    for (int j = 0; j < 4; ++j) { const v2u y = *(const v2u*)(yr + 4 * F.lane + 256 * j);
                        cb[j].x += w * bflo(y.x); cb[j].y += w * bfhi(y.x); cb[j].z += w * bflo(y.y); cb[j].w += w * bfhi(y.y); }
                }
#pragma unroll
                for (int j = 0; j < 4; ++j) { const f32x4 g = *(const f32x4*)(gt2 + 4 * F.lane + 256 * j); v[j] = v[j] + g * cb[j]; }
            }
            if (MODE == 0) {
#pragma unroll
                for (int j = 0; j < 4; ++j) *(f32x4*)(WSP(float, WS_X) + (size_t)r * D + 4 * F.lane + 256 * j) = v[j];
            }
            float ss = 0.f;
#pragma unroll
            for (int j = 0; j < 4; ++j) ss += (v[j].x * v[j].x + v[j].y * v[j].y) + (v[j].z * v[j].z + v[j].w * v[j].w);
            const float rstd = rsqrtf(wave_sum(ss) * (1.f / D) + EPS);
            if (MODE == 2) {
#pragma unroll
                for (int j = 0; j < 4; ++j) { const f32x4 g = *(const f32x4*)(F.in[I_GFIN] + 4 * F.lane + 256 * j);
                    *(f32x4*)(F.out + (size_t)r * D + 4 * F.lane + 256 * j) = v[j] * rstd * g; }
            } else {
                const float* gn = F.in[MODE == 0 ? I_G1 : I_G2] + l * D;
                const float* sh = modl + (size_t)mr * 6144 + (MODE == 0 ? 0 : 3072);
                const float* sc = sh + 1024;
#pragma unroll
                for (int j = 0; j < 4; ++j) { const int c0 = 4 * F.lane + 256 * j;
                    const f32x4 g = *(const f32x4*)(gn + c0), a = *(const f32x4*)(sh + c0), s = *(const f32x4*)(sc + c0);
                    const f32x4 h = (v[j] * rstd * g) * (s + 1.f) + a;
                    *(LAS f32x4*)(hs + lr * 1024 + c0) = h;
                    v2u o; o.x = pk2(h.x, h.y); o.y = pk2(h.z, h.w);
                    *(v2u*)(WSP(bf16, WS_H) + (size_t)r * D + c0) = o; }
            }
        }
        if (MODE == 2) continue;
        __syncthreads();
        LAS float* red = (LAS float*)(F.lds + 65536 + 256);
        {
            const int r16 = F.lane & 15, quad = F.lane >> 4, w = F.wave;
            const size_t stride = MODE == 0 ? (size_t)INW : (size_t)NEXP;
            const float* wp = (MODE == 0 ? F.in[I_WIN] + (size_t)l * D * INW + 3840 : F.in[I_WRT] + (size_t)l * D * NEXP) + (size_t)(128 * w + quad) * stride + r16;
            const LAS float* hp = hs + r16 * 1024 + 128 * w + quad;
            f32x4 acc0 = (f32x4){0.f, 0.f, 0.f, 0.f}, acc1 = acc0;
            float b0[32], b1[32];
#pragma unroll
            for (int s = 0; s < 32; ++s) { b0[s] = wp[(size_t)(4 * s) * stride]; if (MODE == 1) b1[s] = wp[(size_t)(4 * s) * stride + 16]; }
#pragma unroll
            for (int s = 0; s < 32; ++s) { const float av = hp[4 * s];
                acc0 = __builtin_amdgcn_mfma_f32_16x16x4f32(av, b0[s], acc0, 0, 0, 0);
                if (MODE == 1) acc1 = __builtin_amdgcn_mfma_f32_16x16x4f32(av, b1[s], acc1, 0, 0, 0); }
#pragma unroll
            for (int j = 0; j < 4; ++j) { red[(w * 16 + 4 * quad + j) * 32 + r16] = acc0[j]; if (MODE == 1) red[(w * 16 + 4 * quad + j) * 32 + 16 + r16] = acc1[j]; }
        }
        __syncthreads();
        if (MODE == 0) {
            if (F.tid < 256) {
                const int lr = F.tid >> 4, col = F.tid & 15;
                float sacc = 0.f;
#pragma unroll
                for (int w = 0; w < 8; ++w) sacc += red[(w * 16 + lr) * 32 + col];
                WSP(float, WS_CAB)[(size_t)(gi * 16 + lr) * 16 + col] = sacc;
            }
        } else {
            const int lr = F.tid >> 5, e = F.tid & 31, r = gi * 16 + lr;
            float sacc = 0.f;
#pragma unroll
            for (int w = 0; w < 8; ++w) sacc += red[(w * 16 + lr) * 32 + e];
            const float lg = sacc + F.in[I_BRT][l * NEXP + e];
            float tv0, tv1, tv2, tv3; int ti0, ti1, ti2, ti3; bool taken = false;
#define TOP1(TV, TI) do { float bv = taken ? -INFINITY : lg; int bi = e; \
                _Pragma("unroll") for (int off = 16; off >= 1; off >>= 1) { const float ov = __shfl_xor(bv, off); const int oi = __shfl_xor(bi, off); \
                    if (ov > bv || (ov == bv && oi < bi)) { bv = ov; bi = oi; } } \
                TV = bv; TI = bi; if (bi == e) taken = true; } while (0)
            TOP1(tv0, ti0); TOP1(tv1, ti1); TOP1(tv2, ti2); TOP1(tv3, ti3);
#undef TOP1
            const float e1 = __expf(tv1 - tv0), e2 = __expf(tv2 - tv0), e3 = __expf(tv3 - tv0);
            const float inv = 1.f / (1.f + e1 + e2 + e3);
            const int my_e = e == 0 ? ti0 : (e == 1 ? ti1 : (e == 2 ? ti2 : ti3));
            const float my_w = e == 0 ? inv : (e == 1 ? e1 * inv : (e == 2 ? e2 * inv : e3 * inv));
            int pl = 0;
            if (e < 4) pl = atomicAdd((int*)&lcnt[my_e], 1);
            __syncthreads();
            if (F.tid < 32) { const int c = lcnt[F.tid]; lbase[F.tid] = c > 0 ? (int)__hip_atomic_fetch_add(F.ctl + CW_CNT + l * 32 + F.tid, (unsigned)c, __ATOMIC_RELAXED, __HIP_MEMORY_SCOPE_AGENT) : 0; }
            __syncthreads();
            if (e < 4) { const int p = lbase[my_e] + pl;
                WSP(int, WS_LIST)[(size_t)my_e * MROWS + p] = r * 4 + e;
                WSP(int, WS_SEP)[r * 4 + e] = (my_e << 20) | p;
                WSP(float, WS_SW)[r * 4 + e] = my_w; }
        }
        __syncthreads();
    }
}

__device__ __forceinline__ void moe_table(Frame& F, int l) {
    LAS int* tpre = (LAS int*)(F.lds + MISC_OFF + 256);
    LAS int* cnt = tpre + 40;
    __syncthreads();
    if (F.tid < 32) cnt[F.tid] = (int)__hip_atomic_load(F.ctl + CW_CNT + l * 32 + F.tid, __ATOMIC_RELAXED, __HIP_MEMORY_SCOPE_AGENT);
    __syncthreads();
    if (F.tid == 0) { int s = 0; for (int e = 0; e < 32; ++e) { tpre[e] = s; s += (cnt[e] + 255) >> 8; } tpre[32] = s; }
    __syncthreads();
}
__device__ __forceinline__ void moe_gather(Frame& F, int l) {
    moe_table(F, l);
    const LAS int* tpre = (const LAS int*)(F.lds + MISC_OFF + 256);
    const LAS int* cnt = tpre + 40;
    const int gw = F.bid * NWAVES + F.wave, NGW = F.G * NWAVES;
    REFRESH_TID(F);
    for (int e = 0; e < NEXP; ++e) {
        const int n = cnt[e], base = tpre[e] * 256;
        for (int p = gw; p < n; p += NGW) {
            const int tk = WSP(int, WS_LIST)[(size_t)e * MROWS + p]; const int tok = tk >> 2;
            const v4u* src = (const v4u*)(WSP(bf16, WS_H) + (size_t)tok * D);
            v4u* dst = (v4u*)(WSP(bf16, WS_HS) + (size_t)(base + p) * D);
            dst[F.lane] = src[F.lane]; dst[F.lane + 64] = src[F.lane + 64];
            if (F.lane == 0) WSP(int, WS_SROW)[tk] = base + p;
        }
    }
}

constexpr int AT_KP = 72, AT_VP = 68;
constexpr int AT_KB = 64 * AT_KP * 2, AT_VB = 64 * AT_VP * 2, AT_BUF = AT_KB + AT_VB;
constexpr int AT_RPB = 2 * AT_BUF;

__device__ __forceinline__ float max3f_(float a, float b, float c) { float r; asm("v_max3_f32 %0, %1, %2, %3" : "=v"(r) : "v"(a), "v"(b), "v"(c)); return r; }
struct AttnUnit {
    int kind;
    int b, hx, qx;
};

__device__ __forceinline__ void attn_unit(Frame& F, int l, const AttnUnit un) {
    REFRESH_TID(F);
    const int lane = F.lane, w = F.wave, q32 = lane & 31, hh = lane >> 5;
    const bf16* U = WSP(bf16, WS_U);
    const bool na = (un.kind & 1) != 0, ctxq = un.kind >= 2;
    const int b = un.b;
    int qrow0, qcol, kcol, ycol, nlat, krow_lat0, r_grid = 0, c0 = 0, rs_w = 0;
    const bf16* vt; bf16* Y;
    if (!na) {
        const int head = 4 * un.hx + (w & 3);
        qrow0 = (ctxq ? TLAT + b * LCTX : b * SEQ) + 64 * un.qx + 32 * (w >> 2);
        qcol = UQ + head * 64; kcol = UK + un.hx * 64; ycol = head * 64;
        vt = WSP(bf16, WS_VAT) + (size_t)(b * 2 + un.hx) * 64 * KEYS;
        Y = WSP(bf16, WS_Y);
        nlat = ctxq ? 0 : 64; krow_lat0 = b * SEQ;
    } else {
        const int head = un.hx;
        if (ctxq) { qrow0 = TLAT + b * LCTX + 32 * w; nlat = 0; krow_lat0 = 0; }
        else {
            r_grid = 4 * un.qx + (w >> 1); c0 = 32 * (w & 1);
            qrow0 = b * SEQ + 64 * r_grid + c0;
            int rs_min = 4 * un.qx - 4; rs_min = rs_min < 0 ? 0 : (rs_min > 56 ? 56 : rs_min);
            int rs_max = 4 * un.qx + 3 - 4; rs_max = rs_max < 0 ? 0 : (rs_max > 56 ? 56 : rs_max);
            nlat = rs_max + 8 - rs_min; krow_lat0 = b * SEQ + 64 * rs_min;
            rs_w = r_grid - 4; rs_w = rs_w < 0 ? 0 : (rs_w > 56 ? 56 : rs_w);
            rs_w -= rs_min;
        }
        qcol = UDQ + head * 64; kcol = UDK + head * 64; ycol = head * 64;
        vt = WSP(bf16, WS_VDT) + (size_t)(b * 8 + head) * 64 * KEYS;
        Y = WSP(bf16, WS_Y) + (size_t)3 * MROWS * 512;
    }
    const int vkey_lat0 = krow_lat0 - b * SEQ;
    const int ntile = nlat + 4;
    LAS unsigned char* lds = F.lds;
    if (na && !ctxq) {
        LAS float* rp = (LAS float*)(lds + AT_RPB);
        const float* src = F.in[I_RPB] + ((size_t)l * 8 + un.hx) * 465;
        for (int i = F.tid; i < 465; i += NT) rp[i] = src[i] * LOG2E;
    }
    bf16x8 qf[4];
    {
        const bf16* qp = U + (size_t)(qrow0 + q32) * UW + qcol + 8 * hh;
#pragma unroll
        for (int s = 0; s < 4; ++s) qf[s] = *(const bf16x8*)(qp + 16 * s);
        if (na) {
#pragma unroll
            for (int s = 0; s < 4; ++s) { v4u t = __builtin_bit_cast(v4u, qf[s]); const float sc = 0.125f * LOG2E;
                t.x = pk2(bflo(t.x) * sc, bfhi(t.x) * sc); t.y = pk2(bflo(t.y) * sc, bfhi(t.y) * sc); t.z = pk2(bflo(t.z) * sc, bfhi(t.z) * sc); t.w = pk2(bflo(t.w) * sc, bfhi(t.w) * sc);
                qf[s] = __builtin_bit_cast(bf16x8, t); }
        }
    }
    const int lk = F.tid >> 3, lc = F.tid & 7;
    v4u kr[4], vr[4];
#define AT_LOAD(st, i) do { const int i_ = (i) < ntile ? (i) : ntile - 1; int krow0_, vkey0_; \
        if (i_ < nlat) { krow0_ = krow_lat0 + 64 * i_; vkey0_ = vkey_lat0 + 64 * i_; } else { krow0_ = TLAT + b * LCTX + 64 * (i_ - nlat); vkey0_ = SEQ + 64 * (i_ - nlat); } \
        kr[st] = *(const v4u*)(U + (size_t)(krow0_ + lk) * UW + kcol + lc * 8); \
        vr[st] = *(const v4u*)(vt + (size_t)lk * KEYS + vkey0_ + lc * 8); } while (0)
#define AT_STORE(st, buf) do { LAS unsigned char* b_ = lds + (buf) * AT_BUF; \
        *(LAS v4u*)(b_ + lk * (AT_KP * 2) + lc * 16) = kr[st]; \
        *(LAS v2u*)(b_ + AT_KB + lk * (AT_VP * 2) + lc * 16) = (v2u){vr[st].x, vr[st].y}; \
        *(LAS v2u*)(b_ + AT_KB + lk * (AT_VP * 2) + lc * 16 + 8) = (v2u){vr[st].z, vr[st].w}; } while (0)
    float m_run = 0.f, l_run = 0.f;
    f32x16 negm;
#pragma unroll
    for (int i = 0; i < 16; ++i) negm[i] = 0.f;
    bool first = true;
    f32x16 o0, o1;
#pragma unroll
    for (int i = 0; i < 16; ++i) { o0[i] = 0.f; o1[i] = 0.f; }
    const float sscale = 0.125f * LOG2E;
    const int cq = c0 + q32;
    int cst = cq - 8; cst = cst < 0 ? 0 : (cst > 48 ? 48 : cst);
    AT_LOAD(0, 0); AT_LOAD(1, 1); AT_LOAD(2, 2); AT_LOAD(3, 3);
#pragma unroll 1
    for (int i0 = 0; i0 < ntile; i0 += 4) {
#pragma unroll
      for (int st = 0; st < 4; ++st) {
        const int i = i0 + st;
        if (i >= ntile) break;
        AT_STORE(st, i & 1);
        AT_LOAD(st, i + 4);
        lds_barrier();
        const bool lat_na = na && !ctxq && i < nlat;
        if (lat_na && (i < rs_w || i > rs_w + 7)) continue;
        const LAS unsigned char* kb = lds + (i & 1) * AT_BUF;
        const LAS unsigned char* vb = kb + AT_KB;
        f32x16 s0, s1;
#pragma unroll
        for (int s = 0; s < 4; ++s) {
            const bf16x8 k0 = *(const LAS bf16x8*)(kb + (q32) * (AT_KP * 2) + (16 * s + 8 * hh) * 2);
            const bf16x8 k1 = *(const LAS bf16x8*)(kb + (32 + q32) * (AT_KP * 2) + (16 * s + 8 * hh) * 2);
            s0 = __builtin_amdgcn_mfma_f32_32x32x16_bf16(k0, qf[s], s == 0 ? negm : s0, 0, 0, 0);
            s1 = __builtin_amdgcn_mfma_f32_32x32x16_bf16(k1, qf[s], s == 0 ? negm : s1, 0, 0, 0);
        }
        if (lat_na) {
            const LAS float* rp = (const LAS float*)(lds + AT_RPB);
            const int kr = (krow_lat0 - b * SEQ) / 64 + i;
            const int rb = (kr - r_grid + 7) * 31 + 15 - cq;
#pragma unroll
            for (int j = 0; j < 16; ++j) {
                const int kc0 = (j & 3) + 8 * (j >> 2) + 4 * hh, kc1 = kc0 + 32;
                const bool ok0 = kc0 >= cst && kc0 < cst + 16, ok1 = kc1 >= cst && kc1 < cst + 16;
                int i0 = rb + kc0, i1 = rb + kc1; i0 = i0 < 0 ? 0 : (i0 > 464 ? 464 : i0); i1 = i1 < 0 ? 0 : (i1 > 464 ? 464 : i1);
                const float b0 = rp[i0], b1 = rp[i1];
                s0[j] = ok0 ? s0[j] + b0 : -1e30f;
                s1[j] = ok1 ? s1[j] + b1 : -1e30f;
            }
        }
        float mx = max3f_(s0[0], s1[0], s0[1]);
        mx = max3f_(mx, s1[1], s0[2]); mx = max3f_(mx, s1[2], s0[3]); mx = max3f_(mx, s1[3], s0[4]); mx = max3f_(mx, s1[4], s0[5]); mx = max3f_(mx, s1[5], s0[6]);
        mx = max3f_(mx, s1[6], s0[7]); mx = max3f_(mx, s1[7], s0[8]); mx = max3f_(mx, s1[8], s0[9]); mx = max3f_(mx, s1[9], s0[10]); mx = max3f_(mx, s1[10], s0[11]);
        mx = max3f_(mx, s1[11], s0[12]); mx = max3f_(mx, s1[12], s0[13]); mx = max3f_(mx, s1[13], s0[14]); mx = max3f_(mx, s1[14], s0[15]); mx = fmaxf(mx, s1[15]);
        mx = fmaxf(mx, __shfl_xor(mx, 32));
        if (first || __builtin_amdgcn_ballot_w64(mx > 6.f) != 0ull) {
            const float d = first ? fmaxf(mx, -120.f) : fmaxf(mx, 0.f);
            const float alpha = __builtin_amdgcn_exp2f(-d);
            l_run *= alpha; m_run += d;
#pragma unroll
            for (int j = 0; j < 16; ++j) { o0[j] *= alpha; o1[j] *= alpha; s0[j] -= d; s1[j] -= d; negm[j] = -m_run; }
            first = false;
        }
        f32x2_t ps2 = {0.f, 0.f};
#pragma unroll
        for (int j = 0; j < 16; ++j) { s0[j] = __builtin_amdgcn_exp2f(s0[j]); s1[j] = __builtin_amdgcn_exp2f(s1[j]); ps2 += (f32x2_t){s0[j], s1[j]}; }
        l_run += ps2.x + ps2.y;
        bf16x8 pb[2][2];
#pragma unroll
        for (int s2 = 0; s2 < 2; ++s2) {
            v4u t0, t1;
            t0.x = pk2(s0[8 * s2 + 0], s0[8 * s2 + 1]); t0.y = pk2(s0[8 * s2 + 2], s0[8 * s2 + 3]); t0.z = pk2(s0[8 * s2 + 4], s0[8 * s2 + 5]); t0.w = pk2(s0[8 * s2 + 6], s0[8 * s2 + 7]);
            t1.x = pk2(s1[8 * s2 + 0], s1[8 * s2 + 1]); t1.y = pk2(s1[8 * s2 + 2], s1[8 * s2 + 3]); t1.z = pk2(s1[8 * s2 + 4], s1[8 * s2 + 5]); t1.w = pk2(s1[8 * s2 + 6], s1[8 * s2 + 7]);
            pb[0][s2] = __builtin_bit_cast(bf16x8, t0); pb[1][s2] = __builtin_bit_cast(bf16x8, t1);
        }
#pragma unroll
        for (int sub = 0; sub < 2; ++sub)
#pragma unroll
            for (int s2 = 0; s2 < 2; ++s2) {
                const int ko = (32 * sub + 16 * s2 + 4 * hh) * 2;
                const v2u a0 = *(const LAS v2u*)(vb + (q32) * (AT_VP * 2) + ko), a1 = *(const LAS v2u*)(vb + (q32) * (AT_VP * 2) + ko + 16);
                const v2u c0_ = *(const LAS v2u*)(vb + (32 + q32) * (AT_VP * 2) + ko), c1_ = *(const LAS v2u*)(vb + (32 + q32) * (AT_VP * 2) + ko + 16);
                const bf16x8 vf0 = __builtin_bit_cast(bf16x8, ((v4u){a0.x, a0.y, a1.x, a1.y}));
                const bf16x8 vf1 = __builtin_bit_cast(bf16x8, ((v4u){c0_.x, c0_.y, c1_.x, c1_.y}));
                o0 = __builtin_amdgcn_mfma_f32_32x32x16_bf16(vf0, pb[sub][s2], o0, 0, 0, 0);
                o1 = __builtin_amdgcn_mfma_f32_32x32x16_bf16(vf1, pb[sub][s2], o1, 0, 0, 0);
            }
      }
    }
#undef AT_LOAD
#undef AT_STORE
    const float lt = l_run + __shfl_xor(l_run, 32);
    const float inv = 1.f / lt;
    bf16* yp = Y + (size_t)(qrow0 + q32) * 512 + ycol + 4 * hh;
#pragma unroll
    for (int g = 0; g < 4; ++g) {
        v2u a; a.x = pk2(o0[4 * g] * inv, o0[4 * g + 1] * inv); a.y = pk2(o0[4 * g + 2] * inv, o0[4 * g + 3] * inv);
        v2u c; c.x = pk2(o1[4 * g] * inv, o1[4 * g + 1] * inv); c.y = pk2(o1[4 * g + 2] * inv, o1[4 * g + 3] * inv);
        *(v2u*)(yp + 8 * g) = a; *(v2u*)(yp + 32 + 8 * g) = c;
    }
    __syncthreads();
}

__device__ __forceinline__ void attn_phase(Frame& F, int l) {
    const int x = F.bid & 7, y = F.bid >> 3, ny = F.G >> 3;
    for (int q = y; q < 64; q += ny) { AttnUnit un; un.kind = 0; un.b = x >> 1; un.hx = x & 1; un.qx = q; attn_unit(F, l, un); }
    for (int q = y; q < 64; q += ny) { const int combo = x + 8 * (q >> 4); AttnUnit un; un.kind = 1; un.b = combo >> 3; un.hx = combo & 7; un.qx = q & 15; attn_unit(F, l, un); }
    for (int q = y; q < 8; q += ny) { AttnUnit un;
        if (q < 4) { un.kind = 2; un.b = x >> 1; un.hx = x & 1; un.qx = q; }
        else { const int combo = x + 8 * (q - 4); un.kind = 3; un.b = combo >> 3; un.hx = combo & 7; un.qx = 0; }
        attn_unit(F, l, un); }
}


__device__ __forceinline__ void qk_prep(Frame& F, int l) {
    REFRESH_TID(F);
    const int gw = F.bid * NWAVES + F.wave, NGW = F.G * NWAVES, lane = F.lane;
    bf16* U = WSP(bf16, WS_U);
    const float* tab = WSP(float, WS_ROPE);
    const int d0 = (lane & 7) * 8;
    float gq[8], gk[8];
#pragma unroll
    for (int j = 0; j < 8; ++j) { gq[j] = F.in[I_AGQ][l * 64 + d0 + j]; gk[j] = F.in[I_AGK][l * 64 + d0 + j]; }
    for (int r = gw; r < MROWS; r += NGW) {
        const bool lat = r < TLAT;
        bf16* up = U + (size_t)r * UW;
        const v4u qv = *(const v4u*)(up + UQ + lane * 8);
        v4u kv = (v4u){0u, 0u, 0u, 0u};
        if (lane < 16) kv = *(const v4u*)(up + UK + lane * 8);
        float cs[8], sn[8];
#pragma unroll
        for (int j = 0; j < 8; ++j) { cs[j] = 1.f; sn[j] = 0.f; }
        if (lat) { const int t = r & 4095;
#pragma unroll
            for (int j = 0; j < 8; ++j) { const int i = (d0 + j) & 31; const int idx = i < 16 ? (t >> 6) * 16 + i : (t & 63) * 16 + (i - 16); cs[j] = tab[idx]; sn[j] = tab[1024 + idx]; } }
#pragma unroll
        for (int which = 0; which < 2; ++which) {
            const v4u raw = which ? kv : qv;
            float x[8] = {bflo(raw.x), bfhi(raw.x), bflo(raw.y), bfhi(raw.y), bflo(raw.z), bfhi(raw.z), bflo(raw.w), bfhi(raw.w)};
            float ss = 0.f;
#pragma unroll
            for (int j = 0; j < 8; ++j) ss += x[j] * x[j];
            ss += __shfl_xor(ss, 1); ss += __shfl_xor(ss, 2); ss += __shfl_xor(ss, 4);
            const float rs = rsqrtf(ss * (1.f / 64.f) + EPS);
            float y[8];
#pragma unroll
            for (int j = 0; j < 8; ++j) y[j] = x[j] * rs * (which ? gk[j] : gq[j]);
            const bool hi = (lane & 4) != 0;
#pragma unroll
            for (int j = 0; j < 8; ++j) { const float p = __shfl_xor(y[j], 4);
                if (lat) y[j] = hi ? y[j] * cs[j] + p * sn[j] : y[j] * cs[j] - p * sn[j];
                if (!which) y[j] *= 0.125f * LOG2E; }
            v4u o; o.x = pk2(y[0], y[1]); o.y = pk2(y[2], y[3]); o.z = pk2(y[4], y[5]); o.w = pk2(y[6], y[7]);
            if (!which) *(v4u*)(up + UQ + lane * 8) = o; else if (lane < 16) *(v4u*)(up + UK + lane * 8) = o;
        }
    }
}

__device__ __forceinline__ void v_transpose(Frame& F) {
    REFRESH_TID(F);
    const int gw = F.bid * NWAVES + F.wave, NGW = F.G * NWAVES, lane = F.lane;
    LAS bf16* T = (LAS bf16*)(F.lds + F.wave * 9216);
    const bf16* U = WSP(bf16, WS_U);
    for (int it = gw; it < NCHUNK * 10; it += NGW) {
        const int g = it / 10, hd = it % 10;
        int b, key0;
        if (g < 256) { b = g >> 6; key0 = (g & 63) * 64; } else { b = (g - 256) >> 2; key0 = SEQ + ((g - 256) & 3) * 64; }
        const int scol = hd < 2 ? UV + hd * 64 : UDV + (hd - 2) * 64;
        bf16* dst = hd < 2 ? WSP(bf16, WS_VAT) + (size_t)(b * 2 + hd) * 64 * KEYS : WSP(bf16, WS_VDT) + (size_t)(b * 8 + hd - 2) * 64 * KEYS;
        v4u rv[8];
#pragma unroll
        for (int i = 0; i < 8; ++i) { const int tok = 8 * i + (lane >> 3), ch = lane & 7; rv[i] = *(const v4u*)(U + (size_t)(64 * g + tok) * UW + scol + ch * 8); }
#pragma unroll
        for (int i = 0; i < 8; ++i) { const int tok = 8 * i + (lane >> 3), ch = lane & 7; const unsigned wv[4] = {rv[i].x, rv[i].y, rv[i].z, rv[i].w};
#pragma unroll
            for (int j = 0; j < 4; ++j) { T[(ch * 8 + 2 * j) * 72 + tok] = (bf16)(wv[j] & 0xffffu); T[(ch * 8 + 2 * j + 1) * 72 + tok] = (bf16)(wv[j] >> 16); } }
        asm volatile("s_waitcnt lgkmcnt(0)" ::: "memory");
#pragma unroll
        for (int i = 0; i < 8; ++i) { const int d = 8 * i + (lane >> 3), ch = lane & 7;
            const v4u o = *(const LAS v4u*)(T + d * 72 + ch * 8);
            *(v4u*)(dst + (size_t)d * KEYS + key0 + ch * 8) = o; }
        asm volatile("s_waitcnt lgkmcnt(0)" ::: "memory");
    }
}

constexpr int LR_XCB = 0, LR_WV = 17408, LR_WVB = 12288;
__device__ __forceinline__ void seq_bounds(int g, int& lo, int& hi) {
    if (g < 256) { lo = (g >> 6) * SEQ; hi = lo + SEQ; } else { lo = TLAT + ((g - 256) >> 2) * LCTX; hi = lo + LCTX; }
}
struct LruRaw { v4u r[3]; };
__device__ __forceinline__ void lru_raw_load(Frame& F, LruRaw& R, int g, int q) {
    const bf16* U = WSP(bf16, WS_U);
    int lo, hi; seq_bounds(g, lo, hi);
#pragma unroll
    for (int k = 0; k < 3; ++k) { const int i = F.tid + NT * k, rr = i >> 4, ch = i & 15, row = 64 * g - 1 + rr;
        v4u v = (v4u){0u, 0u, 0u, 0u};
        if (i < 67 * 16 && row >= lo && row < hi) v = *(const v4u*)(U + (size_t)row * UW + UBX + 128 * q + ch * 8);
        R.r[k] = v; }
}
__device__ __forceinline__ void lru_stage_conv(Frame& F, int l, const LruRaw& R, int q) {
    LAS bf16* raw = (LAS bf16*)(F.lds + LR_WV);
    LAS bf16* xcb = (LAS bf16*)(F.lds + LR_XCB);
    __syncthreads();
#pragma unroll
    for (int k = 0; k < 3; ++k) { const int i = F.tid + NT * k, rr = i >> 4, ch = i & 15; if (i < 67 * 16) *(LAS v4u*)(raw + rr * 128 + ch * 8) = R.r[k]; }
    __syncthreads();
    {
        const int ch = F.tid & 127, tg = F.tid >> 7, cabs = 128 * q + ch;
        const float* cw = F.in[I_BCW] + (size_t)l * 4 * 512 + cabs;
        const float w0 = cw[0], w1 = cw[512], w2 = cw[1024], w3 = cw[1536], bb = F.in[I_BCB][l * 512 + cabs];
        float x0 = bf2f(raw[(16 * tg) * 128 + ch]), x1 = bf2f(raw[(16 * tg + 1) * 128 + ch]), x2 = bf2f(raw[(16 * tg + 2) * 128 + ch]);
#pragma unroll
        for (int t = 0; t < 16; ++t) { const float x3 = bf2f(raw[(16 * tg + t + 3) * 128 + ch]);
            const float y = bb + w0 * x0 + w1 * x1 + w2 * x2 + w3 * x3;
            xcb[(16 * tg + t) * 136 + ch] = (bf16)f2bf(y);
            x0 = x1; x1 = x2; x2 = x3; }
    }
    __syncthreads();
}
struct LruW { bf16x8 br0, br1, bi0, bi1; float bR, bI, lam; };
__device__ __forceinline__ void lru_w_load(Frame& F, LruW& W, int l, int dir, int q) {
    const int lane = F.lane, w = F.wave, r16 = lane & 15, quad = lane >> 4;
    const int nbl = w >> 2, dt = w & 3, nb = 2 * q + nbl;
    const bf16* wr = WSP(bf16, WS_LRUW) + ((((size_t)(l * 2 + dir) * 2 + 0) * 8 + nb) * 64 + 16 * dt + r16) * 64 + 8 * quad;
    const bf16* wi = WSP(bf16, WS_LRUW) + ((((size_t)(l * 2 + dir) * 2 + 1) * 8 + nb) * 64 + 16 * dt + r16) * 64 + 8 * quad;
    W.br0 = *(const bf16x8*)wr; W.br1 = *(const bf16x8*)(wr + 32); W.bi0 = *(const bf16x8*)wi; W.bi1 = *(const bf16x8*)(wi + 32);
    const int cabs = 64 * nb + 16 * dt + r16;
    W.bR = F.in[I_BBR][(l * 2 + dir) * 512 + cabs]; W.bI = F.in[I_BBI][(l * 2 + dir) * 512 + cabs]; W.lam = F.in[I_BLAM][(l * 2 + dir) * 512 + cabs];
}
__device__ __forceinline__ void lru_gates(Frame& F, const LruW& W) {
    const int lane = F.lane, w = F.wave, r16 = lane & 15, quad = lane >> 4;
    const LAS bf16* xcb = (const LAS bf16*)(F.lds + LR_XCB);
    LAS float* sa = (LAS float*)(F.lds + LR_WV + w * LR_WVB);
    LAS float* sb = sa + 1024;
    const int nbl = w >> 2, dt = w & 3;
    const int cl = 64 * nbl + 16 * dt + r16;
    const float sp = softplusf_(-W.lam);
#pragma unroll
    for (int tt = 0; tt < 4; ++tt) {
        const LAS bf16* ap = xcb + (16 * tt + r16) * 136 + 64 * nbl + 8 * quad;
        const bf16x8 a0 = *(const LAS bf16x8*)ap, a1 = *(const LAS bf16x8*)(ap + 32);
        f32x4 ar = (f32x4){0.f, 0.f, 0.f, 0.f}, ai = ar;
        ar = __builtin_amdgcn_mfma_f32_16x16x32_bf16(a0, W.br0, ar, 0, 0, 0); ar = __builtin_amdgcn_mfma_f32_16x16x32_bf16(a1, W.br1, ar, 0, 0, 0);
        ai = __builtin_amdgcn_mfma_f32_16x16x32_bf16(a0, W.bi0, ai, 0, 0, 0); ai = __builtin_amdgcn_mfma_f32_16x16x32_bf16(a1, W.bi1, ai, 0, 0, 0);
#pragma unroll
        for (int j = 0; j < 4; ++j) { const int t = 16 * tt + 4 * quad + j;
            const float rg = sigmoidf_(ar[j] + W.bR), ig = sigmoidf_(ai[j] + W.bI);
            const float la = -8.f * rg * sp;
            const float a = __expf(la), x2 = 2.f * la;
            const float om = x2 > -0.05f ? -x2 * (1.f + x2 * (0.5f + x2 * (0.16666667f + x2 * 0.041666668f))) : 1.f - __expf(x2);
            const float mult = __builtin_amdgcn_sqrtf(om);
            const float xv = bf2f(xcb[t * 136 + cl]);
            sa[t * 16 + r16] = a; sb[t * 16 + r16] = mult * ig * xv; }
    }
    asm volatile("s_waitcnt lgkmcnt(0)" ::: "memory");
}
__device__ __forceinline__ void lru_pass1(Frame& F, int l) {
    int it = (F.bid + F.G / 2) % F.G;
    LruRaw R; REFRESH_TID(F);
    if (it < NCHUNK * 4) lru_raw_load(F, R, it >> 2, it & 3);
#pragma unroll 1
    for (; it < NCHUNK * 4; it += F.G) {
        REFRESH_TID(F);
        const int g = it >> 2, q = it & 3;
        LruW W0, W1; lru_w_load(F, W0, l, 0, q); lru_w_load(F, W1, l, 1, q);
        lru_stage_conv(F, l, R, q);
        { const int itn = it + F.G < NCHUNK * 4 ? it + F.G : it; lru_raw_load(F, R, itn >> 2, itn & 3); }
#pragma unroll
        for (int dir = 0; dir < 2; ++dir) {
            lru_gates(F, dir ? W1 : W0);
            const int lane = F.lane, w = F.wave, ch = lane & 15, seg = lane >> 4;
            const LAS float* sa = (const LAS float*)(F.lds + LR_WV + w * LR_WVB); const LAS float* sb = sa + 1024;
            float A = 1.f, B = 0.f;
#pragma unroll
            for (int k = 0; k < 16; ++k) { const int tp = 16 * seg + k, t = dir ? 63 - tp : tp; const float a = sa[t * 16 + ch]; B = a * B + sb[t * 16 + ch]; A *= a; }
            float At = 1.f, Bt = 0.f;
#pragma unroll
            for (int s = 0; s < 4; ++s) { const float As = __shfl(A, 16 * s + ch), Bs = __shfl(B, 16 * s + ch); Bt = As * Bt + Bs; At *= As; }
            if (seg == 0) { const int cabs = 128 * q + 64 * (w >> 2) + 16 * (w & 3) + ch;
                WSP(float, WS_LRA)[((size_t)g * 2 + dir) * 512 + cabs] = At; WSP(float, WS_LRB)[((size_t)g * 2 + dir) * 512 + cabs] = Bt; }
            asm volatile("s_waitcnt lgkmcnt(0)" ::: "memory");
        }
    }
}
__device__ __forceinline__ void lru_carry_all(Frame& F) {
    REFRESH_TID(F);
    if (F.tid >= 16) return;
    const float* LA = WSP(float, WS_LRA); const float* LB = WSP(float, WS_LRB); float* LC = WSP(float, WS_LRC);
    for (int chain = F.bid * 16 + F.tid; chain < 4096; chain += F.G * 16) {
        const int ch = chain & 511, dir = (chain >> 9) & 1, b = chain >> 10;
        float h = 0.f;
#pragma unroll 1
        for (int sb = 0; sb < 4; ++sb) {
            float av[17], bv[17]; size_t ix[17];
#pragma unroll
            for (int k = 0; k < 17; ++k) { const int s = sb * 17 + k; int g;
                if (s < 4) g = 256 + 4 * b + (dir ? 3 - s : s); else g = 64 * b + (dir ? 63 - (s - 4) : (s - 4));
                ix[k] = ((size_t)g * 2 + dir) * 512 + ch; av[k] = LA[ix[k]]; bv[k] = LB[ix[k]]; }
#pragma unroll
            for (int k = 0; k < 17; ++k) { LC[ix[k]] = h; h = av[k] * h + bv[k]; }
        }
    }
}
__device__ __forceinline__ float gelu_tanh(float x) { const float u = 0.7978845608028654f * (x + 0.044715f * x * x * x); return x / (1.f + __expf(-2.f * u)); }
__device__ __forceinline__ void lru_pass2(Frame& F, int l) {
    int it = F.bid;
    LruRaw R; REFRESH_TID(F);
    if (it < NCHUNK * 4) lru_raw_load(F, R, it >> 2, it & 3);
#pragma unroll 1
    for (; it < NCHUNK * 4; it += F.G) {
        REFRESH_TID(F);
        const int g = it >> 2, q = it & 3;
        const int lane = F.lane, w = F.wave, ch = lane & 15, seg = lane >> 4;
        const int cabs = 128 * q + 64 * (w >> 2) + 16 * (w & 3) + ch;
        const bf16* U = WSP(bf16, WS_U); bf16* YB = WSP(bf16, WS_Y) + (size_t)1 * MROWS * 512;
        LruW W0, W1; lru_w_load(F, W0, l, 0, q); lru_w_load(F, W1, l, 1, q);
        const float hc0 = WSP(float, WS_LRC)[((size_t)g * 2 + 0) * 512 + cabs], hc1 = WSP(float, WS_LRC)[((size_t)g * 2 + 1) * 512 + cabs];
        unsigned yraw[16];
#pragma unroll
        for (int k = 0; k < 16; ++k) yraw[k] = U[((size_t)64 * g + 16 * seg + k) * UW + UBY + cabs];
        lru_stage_conv(F, l, R, q);
        { const int itn = it + F.G < NCHUNK * 4 ? it + F.G : it; lru_raw_load(F, R, itn >> 2, itn & 3); }
        LAS float* sa = (LAS float*)(F.lds + LR_WV + w * LR_WVB); LAS float* sb = sa + 1024; LAS float* sh = sa + 2048;
#pragma unroll
        for (int dir = 0; dir < 2; ++dir) {
            lru_gates(F, dir ? W1 : W0);
            float A = 1.f, B = 0.f;
#pragma unroll
            for (int k = 0; k < 16; ++k) { const int tp = 16 * seg + k, t = dir ? 63 - tp : tp; const float a = sa[t * 16 + ch]; B = a * B + sb[t * 16 + ch]; A *= a; }
            float h = dir ? hc1 : hc0;
#pragma unroll
            for (int s = 0; s < 3; ++s) { const float As = __shfl(A, 16 * s + ch), Bs = __shfl(B, 16 * s + ch); if (s < seg) h = As * h + Bs; }
#pragma unroll
            for (int k = 0; k < 16; ++k) { const int tp = 16 * seg + k, t = dir ? 63 - tp : tp; h = sa[t * 16 + ch] * h + sb[t * 16 + ch];
                if (dir == 0) sh[t * 16 + ch] = h; else sh[t * 16 + ch] += h; }
            asm volatile("s_waitcnt lgkmcnt(0)" ::: "memory");
        }
#pragma unroll
        for (int k = 0; k < 16; ++k) { const int t = 16 * seg + k; const size_t row = (size_t)64 * g + t;
            YB[row * 512 + cabs] = (bf16)f2bf(sh[t * 16 + ch] * gelu_tanh(bflo(yraw[k]))); }
        asm volatile("s_waitcnt lgkmcnt(0)" ::: "memory");
    }
}

#ifndef GDN_PREP_REPS
#define GDN_PREP_REPS 1
#endif
#ifdef PROBE_SUB
#define GP_T(k) do { if (PROBE_SUB == (k) && F.bid == 0) { const unsigned long long n_ = __builtin_amdgcn_s_memrealtime(); F.pr += n_ - gp_t; } gp_t = __builtin_amdgcn_s_memrealtime(); } while (0)
#else
#define GP_T(k) do { } while (0)
#endif
constexpr int GD_Q = 0, GD_K = 17408, GD_V = 34816, GD_KK = 52224, GD_QK = 68864, GD_L = 85504, GD_SM = 118272;
__device__ __forceinline__ void gdn_prep(Frame& F, int l) {
    const bf16* U = WSP(bf16, WS_U);
    const int w = F.wave;
#pragma unroll 1
    for (int it0 = F.bid; it0 < NCHUNK * 4 * GDN_PREP_REPS; it0 += F.G) {
        const int it = it0 % (NCHUNK * 4);
        int tid = F.tid; asm volatile("" : "+v"(tid));
        const int lane = tid & 63, r16 = lane & 15, quad = lane >> 4;
        const int g = it >> 2, h = it & 3;
        int lo, hi; seq_bounds(g, lo, hi);
        LAS bf16* raw = (LAS bf16*)(F.lds + GD_KK);
#ifdef PROBE_SUB
        unsigned long long gp_t = __builtin_amdgcn_s_memrealtime();
#endif
#pragma unroll 1
        for (int ten = 0; ten < 3; ++ten) {
            const int ucol = (ten == 0 ? UCQ : (ten == 1 ? UCK : UCV)) + 128 * h;
            const int t = tid >> 3, ds = tid & 7;
            f32x4 cwv[4][4];
            { const float* cw = F.in[I_CCW] + (size_t)l * 4 * 1536 + ten * 512 + 128 * h + 16 * ds;
#pragma unroll
              for (int j = 0; j < 4; ++j)
#pragma unroll
                for (int q4 = 0; q4 < 4; ++q4) cwv[j][q4] = *(const f32x4*)(cw + j * 1536 + 4 * q4); }
            __syncthreads();
            for (int i = tid; i < 67 * 16; i += NT) { const int rr = i >> 4, ch = i & 15, row = 64 * g - 1 + rr;
                v4u v = (v4u){0u, 0u, 0u, 0u};
                if (row >= lo && row < hi) v = *(const v4u*)(U + (size_t)row * UW + ucol + ch * 8);
                *(LAS v4u*)(raw + rr * 128 + ch * 8) = v; }
            __syncthreads();
            float y[16]; float ss = 0.f;
            {
                float xin[4][16];
#pragma unroll
                for (int j = 0; j < 4; ++j) { const v4u r0 = *(const LAS v4u*)(raw + (t + j) * 128 + 16 * ds), r1 = *(const LAS v4u*)(raw + (t + j) * 128 + 16 * ds + 8);
                    const unsigned wv[8] = {r0.x, r0.y, r0.z, r0.w, r1.x, r1.y, r1.z, r1.w};
#pragma unroll
                    for (int q = 0; q < 8; ++q) { xin[j][2 * q] = bflo(wv[q]); xin[j][2 * q + 1] = bfhi(wv[q]); } }
#pragma unroll
                for (int jj = 0; jj < 16; ++jj) {
                    float a = 0.f;
#pragma unroll
                    for (int j = 0; j < 4; ++j) a += cwv[j][jj >> 2][jj & 3] * xin[j][jj];
                    a = siluf_(a); y[jj] = a; ss += a * a;
                }
            }
            float sc = 1.f;
            if (ten < 2) { ss += __shfl_xor(ss, 1); ss += __shfl_xor(ss, 2); ss += __shfl_xor(ss, 4); sc = rsqrtf(ss + EPS); if (ten == 0) sc *= 0.08838834764831845f; }
            LAS bf16* dstp = (LAS bf16*)(F.lds + (ten == 0 ? GD_Q : (ten == 1 ? GD_K : GD_V))) + t * 136 + 16 * ds;
            v4u o0, o1;
            o0.x = pk2(y[0] * sc, y[1] * sc); o0.y = pk2(y[2] * sc, y[3] * sc); o0.z = pk2(y[4] * sc, y[5] * sc); o0.w = pk2(y[6] * sc, y[7] * sc);
            o1.x = pk2(y[8] * sc, y[9] * sc); o1.y = pk2(y[10] * sc, y[11] * sc); o1.z = pk2(y[12] * sc, y[13] * sc); o1.w = pk2(y[14] * sc, y[15] * sc);
            *(LAS v4u*)dstp = o0; *(LAS v4u*)(dstp + 8) = o1;
        }
        __syncthreads();
        const LAS bf16* qs = (const LAS bf16*)(F.lds + GD_Q); const LAS bf16* ks = (const LAS bf16*)(F.lds + GD_K); const LAS bf16* vs = (const LAS bf16*)(F.lds + GD_V);
        GP_T(20);
        {
            const int mat = w >> 2, rt = w & 3;
            const LAS bf16* As = mat ? qs : ks;
            LAS float* Out = (LAS float*)(F.lds + (mat ? GD_QK : GD_KK));
            bf16x8 af[4];
#pragma unroll
            for (int s = 0; s < 4; ++s) af[s] = *(const LAS bf16x8*)(As + (16 * rt + r16) * 136 + 32 * s + 8 * quad);
#pragma unroll
            for (int ct = 0; ct < 4; ++ct) {
                f32x4 acc = (f32x4){0.f, 0.f, 0.f, 0.f};
#pragma unroll
                for (int s = 0; s < 4; ++s) { const bf16x8 bfr = *(const LAS bf16x8*)(ks + (16 * ct + r16) * 136 + 32 * s + 8 * quad);
                    acc = __builtin_amdgcn_mfma_f32_16x16x32_bf16(af[s], bfr, acc, 0, 0, 0); }
#pragma unroll
                for (int j = 0; j < 4; ++j) Out[(16 * rt + 4 * quad + j) * 65 + 16 * ct + r16] = acc[j];
            }
        }
        GP_T(21);
        int tid2 = F.tid; asm volatile("" : "+v"(tid2));
        const int dir = tid2 >> 8, dt = tid2 & 255;
        LAS float* sm = (LAS float*)(F.lds + GD_SM) + dir * 256;
        if (dt < 64) {
            const int ti = dir ? 63 - dt : dt; const size_t row = (size_t)64 * g + ti;
            const float ga = WSP(float, WS_CAB)[row * 16 + dir * 4 + h], gb = WSP(float, WS_CAB)[row * 16 + 8 + dir * 4 + h];
            const float gv = -__expf(F.in[I_CALOG][(l * 2 + dir) * 4 + h]) * softplusf_(ga + F.in[I_CDTB][(l * 2 + dir) * 4 + h]);
            float v = gv;
#pragma unroll
            for (int off = 1; off < 64; off <<= 1) { const float u = __builtin_bit_cast(float, __builtin_amdgcn_ds_bpermute(((lane - off) & 63) << 2, __builtin_bit_cast(int, v))); if (lane >= off) v += u; }
            sm[dt] = gv; sm[64 + dt] = sigmoidf_(gb); sm[128 + dt] = v; sm[192 + dt] = __expf(v);
        }
        __syncthreads();
        size_t cd;
        { int bq, cq_, stp; if (g < 256) { bq = g >> 6; cq_ = g & 63; stp = 4 + (dir ? 63 - cq_ : cq_); } else { bq = (g - 256) >> 2; cq_ = (g - 256) & 3; stp = dir ? 3 - cq_ : cq_; }
          cd = ((size_t)((bq * 4 + h) * 2 + dir)) * 68 + stp; }
        const LAS float* KK = (const LAS float*)(F.lds + GD_KK); const LAS float* QKm = (const LAS float*)(F.lds + GD_QK);
        LAS float* Ls = (LAS float*)(F.lds + GD_L) + dir * 4096;
        {
            bf16* gqk = WSP(bf16, WS_GQK) + cd * 4096;
            for (int idx = dt; idx < 4096; idx += 256) { const int i = idx >> 6, j = idx & 63; const int ti = dir ? 63 - i : i, tj = dir ? 63 - j : j;
                const float dec = j <= i ? __expf(sm[128 + i] - sm[128 + j]) : 0.f;
                Ls[idx] = j < i ? sm[64 + i] * KK[ti * 65 + tj] * dec : 0.f;
                gqk[idx] = (bf16)f2bf(QKm[ti * 65 + tj] * dec); }
        }
        __syncthreads();
        GP_T(22);
        if (F.tid < 256) {
            f32x2_t X[64];
            int ct_ = F.tid; asm volatile("" : "+v"(ct_));
            const int sdir = ct_ >> 7, cp = ct_ & 127;
            const LAS float* sms = (const LAS float*)(F.lds + GD_SM) + sdir * 256;
            const LAS float* Lss = (const LAS float*)(F.lds + GD_L) + sdir * 4096;
            size_t cds;
            { int bq, cq_, stp; if (g < 256) { bq = g >> 6; cq_ = g & 63; stp = 4 + (sdir ? 63 - cq_ : cq_); } else { bq = (g - 256) >> 2; cq_ = (g - 256) & 3; stp = sdir ? 3 - cq_ : cq_; }
              cds = ((size_t)((bq * 4 + h) * 2 + sdir)) * 68 + stp; }
            bf16* outp = WSP(bf16, WS_GW) + cds * 8192 + cp;
#pragma unroll
            for (int i = 0; i < 64; ++i) {
                const int ti = sdir ? 63 - i : i;
                const float be = sms[64 + i];
                f32x2_t a = {be * bf2f(vs[ti * 136 + cp]), be * sms[192 + i] * bf2f(ks[ti * 136 + cp])};
                f32x2_t p0 = {0.f, 0.f}, p1 = p0, p2 = p0, p3 = p0;
#pragma unroll
                for (int j = 0; j < i; ++j) { const float lv = Lss[i * 64 + j]; if ((j & 3) == 0) p0 += X[j] * lv; else if ((j & 3) == 1) p1 += X[j] * lv; else if ((j & 3) == 2) p2 += X[j] * lv; else p3 += X[j] * lv; }
                a -= (p0 + p1) + (p2 + p3);
                X[i] = a;
                outp[i * 128] = (bf16)f2bf(a.y);
                asm volatile("" ::: "memory");
            }
            v4u* up = (v4u*)(WSP(bf16, WS_GU) + cds * 8192 + (size_t)cp * 64);
#pragma unroll
            for (int q8 = 0; q8 < 8; ++q8) { v4u o; o.x = pk2(X[8 * q8].x, X[8 * q8 + 1].x); o.y = pk2(X[8 * q8 + 2].x, X[8 * q8 + 3].x); o.z = pk2(X[8 * q8 + 4].x, X[8 * q8 + 5].x); o.w = pk2(X[8 * q8 + 6].x, X[8 * q8 + 7].x); up[q8] = o; }
        }
        GP_T(23);
        {
            bf16* gqg = WSP(bf16, WS_GQG) + cd * 8192; bf16* gkd = WSP(bf16, WS_GKD) + cd * 8192;
            const float gl = sm[128 + 63];
            for (int idx = dt; idx < 8192; idx += 256) { const int i = idx >> 7, d = idx & 127; const int ti = dir ? 63 - i : i;
                gqg[idx] = (bf16)f2bf(bf2f(qs[ti * 136 + d]) * sm[192 + i]); }
            { const int i = dt & 63; const int ti = dir ? 63 - i : i; const float fk = __expf(gl - sm[128 + i]);
              for (int idx = dt; idx < 8192; idx += 256) { const int d = idx >> 6; gkd[idx] = (bf16)f2bf(bf2f(ks[ti * 136 + d]) * fk); } }
            if (dt == 0) WSP(float, WS_GGL)[cd] = __expf(gl);
        }
        GP_T(24);
    }
    __syncthreads();
}

constexpr int GS_ST = 0, GS_VN = 4352, GS_O = 8192;
struct GdnOps { bf16x8 a[4]; bf16x8 qk[2]; bf16x8 kd[2]; v2u uv; float gl; };
__device__ __forceinline__ bf16x8 ld16_asm(const void* p) { bf16x8 v; asm volatile("global_load_dwordx4 %0, %1, off" : "=v"(v) : "v"(p) : "memory"); return v; }
__device__ __forceinline__ v2u ld8_asm(const void* p) { v2u v; asm volatile("global_load_dwordx2 %0, %1, off" : "=v"(v) : "v"(p) : "memory"); return v; }
__device__ __forceinline__ float ld4_asm(const void* p) { float v; asm volatile("global_load_dword %0, %1, off" : "=v"(v) : "v"(p) : "memory"); return v; }
__device__ __forceinline__ void gdn_load_asm(Frame& F, GdnOps& o, size_t cd, int sl) {
    const int lane = F.lane, w = F.wave, r16 = lane & 15, quad = lane >> 4, rt = w & 3;
    const bf16* ap = (w < 4 ? WSP(bf16, WS_GW) : WSP(bf16, WS_GQG)) + cd * 8192 + (size_t)(16 * rt + r16) * 128 + 8 * quad;
#pragma unroll
    for (int s = 0; s < 4; ++s) o.a[s] = ld16_asm(ap + 32 * s);
    const bf16* kp = WSP(bf16, WS_GKD) + cd * 8192 + (size_t)(16 * w + r16) * 64 + 8 * quad;
    o.kd[0] = ld16_asm(kp); o.kd[1] = ld16_asm(kp + 32);
    const bf16* qp = WSP(bf16, WS_GQK) + cd * 4096 + (size_t)(16 * rt + r16) * 64 + 8 * quad;
    o.qk[0] = ld16_asm(qp); o.qk[1] = ld16_asm(qp + 32);
    o.uv = ld8_asm(WSP(bf16, WS_GU) + cd * 8192 + (size_t)(16 * sl + r16) * 64 + 16 * rt + 4 * quad);
    o.gl = ld4_asm(WSP(float, WS_GGL) + cd);
}
__device__ __forceinline__ void gdn_load(Frame& F, GdnOps& o, size_t cd, int sl) {
    const int lane = F.lane, w = F.wave, r16 = lane & 15, quad = lane >> 4, rt = w & 3;
    const bf16* ap = (w < 4 ? WSP(bf16, WS_GW) : WSP(bf16, WS_GQG)) + cd * 8192 + (size_t)(16 * rt + r16) * 128 + 8 * quad;
#pragma unroll
    for (int s = 0; s < 4; ++s) o.a[s] = *(const bf16x8*)(ap + 32 * s);
    const bf16* kp = WSP(bf16, WS_GKD) + cd * 8192 + (size_t)(16 * w + r16) * 64 + 8 * quad;
    o.kd[0] = *(const bf16x8*)kp; o.kd[1] = *(const bf16x8*)(kp + 32);
    { const bf16* qp = WSP(bf16, WS_GQK) + cd * 4096 + (size_t)(16 * rt + r16) * 64 + 8 * quad; o.qk[0] = *(const bf16x8*)qp; o.qk[1] = *(const bf16x8*)(qp + 32); }
    o.uv = *(const v2u*)(WSP(bf16, WS_GU) + cd * 8192 + (size_t)(16 * sl + r16) * 64 + 16 * rt + 4 * quad);
    o.gl = WSP(float, WS_GGL)[cd];
}
__device__ __forceinline__ size_t gdn_cd(int b, int h, int dir, int s) { return ((size_t)((b * 4 + h) * 2 + dir)) * 68 + s; }
__device__ __forceinline__ int gdn_g(int b, int dir, int s) {
    return s < 4 ? 256 + 4 * b + (dir ? 3 - s : s) : 64 * b + (dir ? 63 - (s - 4) : (s - 4)); }
__device__ __forceinline__ void gdn_scan(Frame& F, int chain) {
    REFRESH_TID(F);
    const int xq = chain & 7, yq = chain >> 3, cg = (yq >> 3) * 8 + xq, sl = yq & 7;
    const int dir = cg & 1, h = (cg >> 1) & 3, b = cg >> 3;
    const int lane = F.lane, w = F.wave, r16 = lane & 15, quad = lane >> 4, rt = w & 3;
    LAS bf16* St = (LAS bf16*)(F.lds + GS_ST); LAS bf16* VNt = (LAS bf16*)(F.lds + GS_VN);
    __syncthreads();
    for (int i = F.tid; i < (GS_VN + 2304) / 4; i += NT) ((LAS unsigned*)F.lds)[i] = 0u;
    __syncthreads();
    f32x4 sacc = (f32x4){0.f, 0.f, 0.f, 0.f};
    float* GO = WSP(float, WS_GO) + (size_t)dir * MROWS * 512;
    LAS float* Ost = (LAS float*)(F.lds + GS_O);
#define GDN_STEP(cur, s_) do { \
          \
        asm volatile("s_waitcnt vmcnt(30)" : "+v"(cur.a[0]), "+v"(cur.a[1]), "+v"(cur.a[2]), "+v"(cur.a[3]), "+v"(cur.kd[0]), "+v"(cur.kd[1]), "+v"(cur.qk[0]), "+v"(cur.qk[1]), "+v"(cur.uv), "+v"(cur.gl) :: "memory"); \
        bf16x8 sbf[4]; \
        _Pragma("unroll") for (int ks = 0; ks < 4; ++ks) sbf[ks] = *(const LAS bf16x8*)(St + r16 * 136 + 32 * ks + 8 * quad); \
        f32x4 acc = (f32x4){0.f, 0.f, 0.f, 0.f}; \
        _Pragma("unroll") for (int ks = 0; ks < 4; ++ks) acc = __builtin_amdgcn_mfma_f32_16x16x32_bf16(cur.a[ks], sbf[ks], acc, 0, 0, 0); \
        if (w < 4) { v2u o; o.x = pk2(bflo(cur.uv.x) - acc[0], bfhi(cur.uv.x) - acc[1]); o.y = pk2(bflo(cur.uv.y) - acc[2], bfhi(cur.uv.y) - acc[3]); \
            *(LAS v2u*)(VNt + r16 * 72 + 16 * rt + 4 * quad) = o; } \
        lds_barrier(); \
        const bf16x8 vb0 = *(const LAS bf16x8*)(VNt + r16 * 72 + 8 * quad), vb1 = *(const LAS bf16x8*)(VNt + r16 * 72 + 32 + 8 * quad); \
        if (w >= 4) { \
            acc = __builtin_amdgcn_mfma_f32_16x16x32_bf16(cur.qk[0], vb0, acc, 0, 0, 0); \
            acc = __builtin_amdgcn_mfma_f32_16x16x32_bf16(cur.qk[1], vb1, acc, 0, 0, 0); \
            _Pragma("unroll") for (int j = 0; j < 4; ++j) Ost[(((s_) & 3) * 64 + 16 * rt + 4 * quad + j) * 16 + r16] = acc[j]; } \
        sacc = sacc * cur.gl; \
        sacc = __builtin_amdgcn_mfma_f32_16x16x32_bf16(cur.kd[0], vb0, sacc, 0, 0, 0); \
        sacc = __builtin_amdgcn_mfma_f32_16x16x32_bf16(cur.kd[1], vb1, sacc, 0, 0, 0); \
        { v2u o; o.x = pk2(sacc[0], sacc[1]); o.y = pk2(sacc[2], sacc[3]); *(LAS v2u*)(St + r16 * 136 + 16 * w + 4 * quad) = o; } \
        lds_barrier(); \
    } while (0)
    GdnOps r0, r1, r2, r3;
    gdn_load_asm(F, r0, gdn_cd(b, h, dir, 0), sl); gdn_load_asm(F, r1, gdn_cd(b, h, dir, 1), sl); gdn_load_asm(F, r2, gdn_cd(b, h, dir, 2), sl); gdn_load_asm(F, r3, gdn_cd(b, h, dir, 3), sl);
#pragma unroll 1
    for (int s = 0; s < 68; s += 4) {
        GDN_STEP(r0, s);     gdn_load_asm(F, r0, gdn_cd(b, h, dir, (s + 4 < 68 ? s + 4 : 67)), sl);
        GDN_STEP(r1, s + 1); gdn_load_asm(F, r1, gdn_cd(b, h, dir, (s + 5 < 68 ? s + 5 : 67)), sl);
        GDN_STEP(r2, s + 2); gdn_load_asm(F, r2, gdn_cd(b, h, dir, (s + 6 < 68 ? s + 6 : 67)), sl);
        GDN_STEP(r3, s + 3);
#pragma unroll
        for (int k2 = 0; k2 < 2; ++k2) { const int idx = F.tid + 512 * k2, st = idx >> 8, i = (idx >> 2) & 63, qd = idx & 3;
            const f32x4 v = *(const LAS f32x4*)(Ost + (st * 64 + i) * 16 + 4 * qd);
            const int g = gdn_g(b, dir, s + st), ti = dir ? 63 - i : i;
            *(f32x4*)(GO + ((size_t)64 * g + ti) * 512 + h * 128 + 16 * sl + 4 * qd) = v; }
        gdn_load_asm(F, r3, gdn_cd(b, h, dir, (s + 7 < 68 ? s + 7 : 67)), sl);
    }
#undef GDN_STEP
    asm volatile("s_waitcnt vmcnt(0)" ::: "memory");
    __syncthreads();
}
template <int NCT> struct GdnOpsW { bf16x8 a[4]; bf16x8 qk[2]; bf16x8 kd[2]; v2u uv[NCT]; float gl; };
template <int NCT>
__device__ __forceinline__ void gdn_load_wide(Frame& F, GdnOpsW<NCT>& o, size_t cd, int part) {
    const int lane = F.lane, w = F.wave, r16 = lane & 15, quad = lane >> 4, rt = w & 3;
    const bf16* ap = (w < 4 ? WSP(bf16, WS_GW) : WSP(bf16, WS_GQG)) + cd * 8192 + (size_t)(16 * rt + r16) * 128 + 8 * quad;
#pragma unroll
    for (int s = 0; s < 4; ++s) o.a[s] = *(const bf16x8*)(ap + 32 * s);
    const bf16* kp = WSP(bf16, WS_GKD) + cd * 8192 + (size_t)(16 * w + r16) * 64 + 8 * quad;
    o.kd[0] = *(const bf16x8*)kp; o.kd[1] = *(const bf16x8*)(kp + 32);
    { const bf16* qp = WSP(bf16, WS_GQK) + cd * 4096 + (size_t)(16 * rt + r16) * 64 + 8 * quad; o.qk[0] = *(const bf16x8*)qp; o.qk[1] = *(const bf16x8*)(qp + 32); }
    const bf16* up = WSP(bf16, WS_GU) + cd * 8192 + (size_t)(part * NCT * 16 + r16) * 64 + 16 * rt + 4 * quad;
#pragma unroll
    for (int ct = 0; ct < NCT; ++ct) o.uv[ct] = *(const v2u*)(up + (size_t)ct * 16 * 64);
    o.gl = WSP(float, WS_GGL)[cd];
}
template <int NCT>
__device__ __forceinline__ void gdn_scan_wide(Frame& F, int cg, int part) {
    REFRESH_TID(F);
    constexpr int NC = NCT * 16, OFF_VN = NC * 136 * 2, OFF_O = OFF_VN + NC * 72 * 2;
    const int dir = cg & 1, h = (cg >> 1) & 3, b = cg >> 3;
    const int lane = F.lane, w = F.wave, r16 = lane & 15, quad = lane >> 4, rt = w & 3;
    LAS bf16* St = (LAS bf16*)(F.lds); LAS bf16* VNt = (LAS bf16*)(F.lds + OFF_VN); LAS float* Ost = (LAS float*)(F.lds + OFF_O);
    __syncthreads();
    for (int i = F.tid; i < OFF_O / 4; i += NT) ((LAS unsigned*)F.lds)[i] = 0u;
    __syncthreads();
    f32x4 sacc[NCT];
#pragma unroll
    for (int ct = 0; ct < NCT; ++ct) sacc[ct] = (f32x4){0.f, 0.f, 0.f, 0.f};
    float* GO = WSP(float, WS_GO) + (size_t)dir * MROWS * 512;
#define GDNW_STEP(cur, s_) do { \
        f32x4 acc[NCT]; \
        _Pragma("unroll") for (int ct = 0; ct < NCT; ++ct) { acc[ct] = (f32x4){0.f, 0.f, 0.f, 0.f}; \
            _Pragma("unroll") for (int ks = 0; ks < 4; ++ks) { const bf16x8 sb = *(const LAS bf16x8*)(St + (16 * ct + r16) * 136 + 32 * ks + 8 * quad); \
                acc[ct] = __builtin_amdgcn_mfma_f32_16x16x32_bf16(cur.a[ks], sb, acc[ct], 0, 0, 0); } } \
        if (w < 4) { _Pragma("unroll") for (int ct = 0; ct < NCT; ++ct) { v2u o; o.x = pk2(bflo(cur.uv[ct].x) - acc[ct][0], bfhi(cur.uv[ct].x) - acc[ct][1]); o.y = pk2(bflo(cur.uv[ct].y) - acc[ct][2], bfhi(cur.uv[ct].y) - acc[ct][3]); \
            *(LAS v2u*)(VNt + (16 * ct + r16) * 72 + 16 * rt + 4 * quad) = o; } } \
        lds_barrier(); \
        _Pragma("unroll") for (int ct = 0; ct < NCT; ++ct) { \
            const bf16x8 vb0 = *(const LAS bf16x8*)(VNt + (16 * ct + r16) * 72 + 8 * quad), vb1 = *(const LAS bf16x8*)(VNt + (16 * ct + r16) * 72 + 32 + 8 * quad); \
            if (w >= 4) { acc[ct] = __builtin_amdgcn_mfma_f32_16x16x32_bf16(cur.qk[0], vb0, acc[ct], 0, 0, 0); acc[ct] = __builtin_amdgcn_mfma_f32_16x16x32_bf16(cur.qk[1], vb1, acc[ct], 0, 0, 0); \
                _Pragma("unroll") for (int j = 0; j < 4; ++j) Ost[(16 * rt + 4 * quad + j) * NC + 16 * ct + r16] = acc[ct][j]; } \
            sacc[ct] = sacc[ct] * cur.gl; \
            sacc[ct] = __builtin_amdgcn_mfma_f32_16x16x32_bf16(cur.kd[0], vb0, sacc[ct], 0, 0, 0); \
            sacc[ct] = __builtin_amdgcn_mfma_f32_16x16x32_bf16(cur.kd[1], vb1, sacc[ct], 0, 0, 0); \
            { v2u o; o.x = pk2(sacc[ct][0], sacc[ct][1]); o.y = pk2(sacc[ct][2], sacc[ct][3]); *(LAS v2u*)(St + (16 * ct + r16) * 136 + 16 * w + 4 * quad) = o; } } \
        lds_barrier(); \
        { const int g = gdn_g(b, dir, (s_)); constexpr int TPR = NC / 16 ;   \
            for (int idx = F.tid; idx < 64 * TPR; idx += NT) { const int i = idx / TPR, c16 = (idx % TPR) * 16, ti = dir ? 63 - i : i; \
                float* gp = GO + ((size_t)64 * g + ti) * 512 + h * 128 + part * NC + c16; \
                _Pragma("unroll") for (int k4 = 0; k4 < 4; ++k4) *(f32x4*)(gp + 4 * k4) = *(const LAS f32x4*)(Ost + i * NC + c16 + 4 * k4); } } \
    } while (0)
    GdnOpsW<NCT> r0, r1;
    gdn_load_wide<NCT>(F, r0, gdn_cd(b, h, dir, 0), part); gdn_load_wide<NCT>(F, r1, gdn_cd(b, h, dir, 1), part);
#pragma unroll 1
    for (int s = 0; s < 68; s += 2) {
        GDNW_STEP(r0, s);     gdn_load_wide<NCT>(F, r0, gdn_cd(b, h, dir, (s + 2 < 68 ? s + 2 : 67)), part);
        GDNW_STEP(r1, s + 1); gdn_load_wide<NCT>(F, r1, gdn_cd(b, h, dir, (s + 3 < 68 ? s + 3 : 67)), part);
    }
#undef GDNW_STEP
    __syncthreads();
}
__device__ __forceinline__ void gdn_out(Frame& F, int l) {
    REFRESH_TID(F);
    const int gw = F.bid * NWAVES + F.wave, NGW = F.G * NWAVES, lane = F.lane;
    const float* G0 = WSP(float, WS_GO); const float* G1 = G0 + (size_t)MROWS * 512;
    const bf16* U = WSP(bf16, WS_U); bf16* YC = WSP(bf16, WS_Y) + (size_t)2 * MROWS * 512;
    const float g0 = F.in[I_CGOUT][l * 128 + 2 * lane], g1 = F.in[I_CGOUT][l * 128 + 2 * lane + 1];
    for (int r0 = gw; r0 < MROWS; r0 += 2 * NGW) {
        const int r1 = r0 + NGW < MROWS ? r0 + NGW : r0;
        f32x2_t a[2][4], c[2][4]; unsigned zz[2][4];
#pragma unroll
        for (int k = 0; k < 2; ++k) { const int r = k ? r1 : r0;
#pragma unroll
            for (int h = 0; h < 4; ++h) { const size_t o = (size_t)r * 512 + h * 128 + 2 * lane;
                a[k][h] = *(const f32x2_t*)(G0 + o); c[k][h] = *(const f32x2_t*)(G1 + o); zz[k][h] = *(const unsigned*)(U + (size_t)r * UW + UCZ + h * 128 + 2 * lane); } }
#pragma unroll
        for (int k = 0; k < 2; ++k) { const int r = k ? r1 : r0; if (k == 1 && r1 == r0) break;
#pragma unroll
            for (int h = 0; h < 4; ++h) { const float a0 = a[k][h].x + c[k][h].x, a1 = a[k][h].y + c[k][h].y;
                const float ss = wave_sum(a0 * a0 + a1 * a1);
                const float rs = rsqrtf(ss * (1.f / 128.f) + EPS);
                *(unsigned*)(YC + (size_t)r * 512 + h * 128 + 2 * lane) = pk2(a0 * rs * g0 * siluf_(bflo(zz[k][h])), a1 * rs * g1 * siluf_(bfhi(zz[k][h]))); } }
    }
}

struct SideFr { bf16x8 a[4], b0[4], b1[4]; };
__device__ __forceinline__ void side_ld(SideFr& f, const bf16* ap, const bf16* bp0, const bf16* bp1) {
#pragma unroll
    for (int s = 0; s < 4; ++s) { f.a[s] = *(const bf16x8*)(ap + 32 * s); f.b0[s] = *(const bf16x8*)(bp0 + 32 * s); f.b1[s] = *(const bf16x8*)(bp1 + 32 * s); }
}
__device__ __forceinline__ void side_mma(f32x4& c0, f32x4& c1, const SideFr& f) {
#pragma unroll
    for (int s = 0; s < 4; ++s) { c0 = __builtin_amdgcn_mfma_f32_16x16x32_bf16(f.a[s], f.b0[s], c0, 0, 0, 0); c1 = __builtin_amdgcn_mfma_f32_16x16x32_bf16(f.a[s], f.b1[s], c1, 0, 0, 0); }
}
__device__ __forceinline__ void side_merge(Frame& F, int l) {
    REFRESH_TID(F);
    const int lane = F.lane, w = F.wave, r16 = lane & 15, quad = lane >> 4, rt = w & 3, chf = w >> 2;
    const bf16* U = WSP(bf16, WS_U);
    for (int tile = F.bid; tile < 256; tile += F.G) {
        const int row0 = TLAT + 64 * (tile >> 4) + 16 * rt, col0 = 64 * (tile & 15) + 32 * chf;
        f32x4 m0 = (f32x4){0.f, 0.f, 0.f, 0.f}, m1 = m0;
#define SM_AP(q) (WSP(bf16, WS_Y) + ((size_t)((q) >> 2) * MROWS + row0 + r16) * 512 + 8 * quad + 128 * ((q) & 3))
#define SM_BP(q) (WSP(bf16, WS_WBR) + (((size_t)l * 4 + ((q) >> 2)) * 1024 + col0 + r16) * 512 + 8 * quad + 128 * ((q) & 3))
        SideFr fa, fb;
        side_ld(fa, SM_AP(0), SM_BP(0), SM_BP(0) + (size_t)16 * 512);
#pragma unroll 1
        for (int br = 0; br < 4; ++br) {
            f32x4 c0 = (f32x4){0.f, 0.f, 0.f, 0.f}, c1 = c0;
            const int q = br * 4;
            side_ld(fb, SM_AP(q + 1), SM_BP(q + 1), SM_BP(q + 1) + (size_t)16 * 512); side_mma(c0, c1, fa);
            side_ld(fa, SM_AP(q + 2), SM_BP(q + 2), SM_BP(q + 2) + (size_t)16 * 512); side_mma(c0, c1, fb);
            side_ld(fb, SM_AP(q + 3), SM_BP(q + 3), SM_BP(q + 3) + (size_t)16 * 512); side_mma(c0, c1, fa);
            { const int qn = q + 4 < 16 ? q + 4 : 15; side_ld(fa, SM_AP(qn), SM_BP(qn), SM_BP(qn) + (size_t)16 * 512); }
            side_mma(c0, c1, fb);
#pragma unroll
            for (int j = 0; j < 4; ++j) { const bf16* gp = U + (size_t)(row0 + 4 * quad + j) * UW + UG + br * 1024 + col0 + r16;
                m0[j] += sigmoidf_(bf2f(gp[0])) * c0[j]; m1[j] += sigmoidf_(bf2f(gp[16])) * c1[j]; }
        }
#undef SM_AP
#undef SM_BP
#pragma unroll
        for (int j = 0; j < 4; ++j) { bf16* mp = WSP(bf16, WS_MB) + (size_t)(row0 + 4 * quad + j) * 1024 + col0 + r16;
            mp[0] = (bf16)f2bf(m0[j]); mp[16] = (bf16)f2bf(m1[j]); }
    }
}
__device__ __forceinline__ void side_outproj(Frame& F, int l) {
    REFRESH_TID(F);
    const int lane = F.lane, w = F.wave, r16 = lane & 15, quad = lane >> 4, rt = w & 3, chf = w >> 2;
    const float* gt = WSP(float, WS_MOD) + ((size_t)l * 5 + 4) * 6144 + 2048;
    for (int tile = F.bid; tile < 256; tile += F.G) {
        const int row0 = TLAT + 64 * (tile >> 4) + 16 * rt, col0 = 64 * (tile & 15) + 32 * chf;
        const bf16* ap = WSP(bf16, WS_MB) + (size_t)(row0 + r16) * 1024 + 8 * quad;
        const bf16* bp0 = WSP(bf16, WS_WOUT) + ((size_t)l * 1024 + col0 + r16) * 1024 + 8 * quad;
        const bf16* bp1 = bp0 + (size_t)16 * 1024;
        f32x4 c0 = (f32x4){0.f, 0.f, 0.f, 0.f}, c1 = c0;
        SideFr fa, fb;
        side_ld(fa, ap, bp0, bp1);
#pragma unroll 1
        for (int kc = 0; kc < 8; kc += 2) {
            side_ld(fb, ap + 128 * (kc + 1), bp0 + 128 * (kc + 1), bp1 + 128 * (kc + 1)); side_mma(c0, c1, fa);
            { const int kn = kc + 2 < 8 ? kc + 2 : 7; side_ld(fa, ap + 128 * kn, bp0 + 128 * kn, bp1 + 128 * kn); }
            side_mma(c0, c1, fb);
        }
        const float g0 = gt[col0 + r16], g1 = gt[col0 + 16 + r16];
#pragma unroll
        for (int j = 0; j < 4; ++j) { float* xp = WSP(float, WS_X) + (size_t)(row0 + 4 * quad + j) * 1024 + col0 + r16;
            xp[0] += g0 * c0[j]; xp[16] += g1 * c1[j]; }
    }
}

#ifndef SCAN_PARTS
#define SCAN_PARTS 2
#endif
constexpr int NSCAN = 4 * SCAN_PARTS;
constexpr int CW_Q = 2048;
__device__ __forceinline__ void mixer_queue_phase(Frame& F, int l) {
    volatile LAS int* qslot = (volatile LAS int*)(F.lds + MISC_OFF + 64);
    const int x0 = (int)(xb_xcc_id() & 7u);
#if defined(PROBE_SUB) && (PROBE_SUB == 4 || PROBE_SUB == 5)
    const unsigned long long tq0 = __builtin_amdgcn_s_memrealtime();
#endif
#pragma unroll 1
    for (int kq = 0; kq < 8; ++kq) {
      const int x = (x0 + kq) & 7;
      for (;;) {
        __syncthreads();
        if (F.tid == 0) *qslot = (int)__hip_atomic_fetch_add(F.ctl + CW_Q + l * 8 + x, 1u, __ATOMIC_RELAXED, __HIP_MEMORY_SCOPE_AGENT);
        __syncthreads();
        const int idx = __builtin_amdgcn_readfirstlane(*qslot);
        if (idx >= 136 + NSCAN) break;
#ifdef PROBE_SUB
        unsigned long long t0_ = 0ull; const bool pr_on = false;
#endif
        if (idx < NSCAN) { gdn_scan_wide<8 / SCAN_PARTS>(F, x + 8 * (idx / SCAN_PARTS), idx % SCAN_PARTS); }
        else { AttnUnit un; const int q = idx - NSCAN;
            if (q < 64) { un.kind = 0; un.b = x >> 1; un.hx = x & 1; un.qx = q; }
            else if (q < 128) { const int qq = q - 64, combo = x + 8 * (qq >> 4); un.kind = 1; un.b = combo >> 3; un.hx = combo & 7; un.qx = qq & 15; }
            else { const int qq = q - 128;
                if (qq < 4) { un.kind = 2; un.b = x >> 1; un.hx = x & 1; un.qx = qq; }
                else { const int combo = x + 8 * (qq - 4); un.kind = 3; un.b = combo >> 3; un.hx = combo & 7; un.qx = 0; } }
            attn_unit(F, l, un); }
#ifdef PROBE_SUB
        if (pr_on) F.pr += __builtin_amdgcn_s_memrealtime() - t0_;
        if (PROBE_SUB == 13 && F.bid == 8 && idx >= 4 && idx < 68) F.pr += 100;
        if (PROBE_SUB == 14 && F.bid == 8 && idx >= 68 && idx < 140) F.pr += 100;
#endif
      }
    }
#if defined(PROBE_SUB) && PROBE_SUB == 4
    if (F.tid == 0) __hip_atomic_fetch_max(F.ctl + 3000 + l, (unsigned)(__builtin_amdgcn_s_memrealtime() - tq0), __ATOMIC_RELAXED, __HIP_MEMORY_SCOPE_AGENT);
#endif
#if defined(PROBE_SUB) && PROBE_SUB == 5
    if (F.tid == 0) __hip_atomic_fetch_max(F.ctl + 3000 + l, 0x7fffffffu - (unsigned)(__builtin_amdgcn_s_memrealtime() - tq0), __ATOMIC_RELAXED, __HIP_MEMORY_SCOPE_AGENT);
#endif
}

#ifndef REP_P0
#define REP_P0 1
#endif
#ifndef REP_B
#define REP_B 1
#endif
#ifndef REP_D1
#define REP_D1 1
#endif
#ifndef REP_D2
#define REP_D2 1
#endif
#ifndef REP_E
#define REP_E 1
#endif
#ifndef REP_F
#define REP_F 1
#endif
#ifndef REP_I
#define REP_I 1
#endif
#ifndef REP_J
#define REP_J 1
#endif
#ifndef REP_C1
#define REP_C1 1
#endif
#ifndef REP_C2
#define REP_C2 1
#endif
#ifndef REP_C4
#define REP_C4 1
#endif
#ifndef REP_G2
#define REP_G2 1
#endif

#ifndef MIXER_QUEUE
#define MIXER_QUEUE 1
#endif
constexpr int PH_PER_LAYER = 11, PH_FINAL = 1 + PH_PER_LAYER * DEPTH, N_PHASES = PH_FINAL + 1;
struct Args { const float* in[32]; float* out; unsigned char* ws; int ph_lo, ph_hi, li, pad; };

__global__ void __launch_bounds__(NT, 2) hybrid_fwd(Args args) {
    extern __shared__ __attribute__((aligned(16))) unsigned char lds_raw[];
    Frame F;
    F.lds = (LAS unsigned char*)lds_raw;
    F.wave = __builtin_amdgcn_readfirstlane((int)threadIdx.x >> 6); F.lane = (int)__builtin_amdgcn_mbcnt_hi(~0u, __builtin_amdgcn_mbcnt_lo(~0u, 0u)); F.tid = F.wave * 64 + F.lane;
    F.G = gridDim.x; F.bid = blockIdx.x; F.pr = 0ull;
    F.in = args.in; F.in0 = args.in;
    F.out = args.out; F.ws = args.ws; F.ws0 = args.ws; F.ctl = (unsigned*)(args.ws + WS_CTL);
    volatile LAS unsigned* MISC = (volatile LAS unsigned*)(F.lds + MISC_OFF);
    if (F.tid < 64) MISC[F.tid] = 0u;
    __syncthreads();
    const int lo = args.ph_lo, hi = args.ph_hi;
    XcdBarrier bar = xcd_barrier_post(F.ctl + CW_BAR + args.li * XCD_BAR_WORDS, MISC + 8);
#ifndef ONLY_MASK
#define ONLY_MASK 0xFFFF
#endif
#define PHON(b) ((ONLY_MASK >> (b)) & 1)
#define IN(k) (lo <= (k) && (k) < hi)
#define SEAM(k) do { if ((k) + 1 < hi) xcd_barrier(bar); } while (0)
#ifdef PROBE_PHASE
    unsigned long long pr_acc = 0ull, pr_t0 = 0ull;
#define PR_BEGIN(k) do { if ((k) == PROBE_PHASE) pr_t0 = __builtin_amdgcn_s_memrealtime(); } while (0)
#define PR_END(k) do { if ((k) == PROBE_PHASE) pr_acc += __builtin_amdgcn_s_memrealtime() - pr_t0; } while (0)
#else
#define PR_BEGIN(k) do { } while (0)
#define PR_END(k) do { } while (0)
#endif

    if (PHON(0) && IN(0)) { REFRESH_TID(F); _Pragma("unroll 1") for (int rep_ = 0; rep_ < REP_P0; ++rep_) { p0_prologue(F); __syncthreads(); } SEAM(0); PR_END(0); }
#pragma unroll 1
    for (int l = 0; l < DEPTH; ++l) {
        const int pb = 1 + PH_PER_LAYER * l;
        if (PHON(1) && IN(pb + 0)) { PR_BEGIN(1); REFRESH_TID(F); norm_phase<0>(F, l); SEAM(pb + 0); PR_END(1); }
        if (PHON(2) && IN(pb + 1)) { PR_BEGIN(2); REFRESH_TID(F);
            pg8::Gemm g{WSP(bf16, WS_H), WSP(bf16, WS_WIN) + (size_t)l * UW * D, MROWS, UW, D};
            pg8::StaticOrder S; S.init(MROWS, UW, F.G, F.bid);
            pg8::EpiStoreBf16 E{WSP(bf16, WS_U), UW};
            _Pragma("unroll 1") for (int rep_ = 0; rep_ < REP_B; ++rep_) { pg8::gemm_phase<pg8::EpiStoreBf16, pg8::StaticOrder, true, true>(F.lds, g, S, E, F.wave); __syncthreads(); }
            SEAM(pb + 1); PR_END(2);
        }
        if (PHON(3) && IN(pb + 2)) { PR_BEGIN(3); REFRESH_TID(F);
#ifndef NO_C1
            PR_BEGIN(30); _Pragma("unroll 1") for (int rep_ = 0; rep_ < REP_C1; ++rep_) { gdn_prep(F, l); __syncthreads(); } PR_END(30);
#endif
#ifndef NO_C2
            PR_BEGIN(31); _Pragma("unroll 1") for (int rep_ = 0; rep_ < REP_C2; ++rep_) { lru_pass1(F, l); __syncthreads(); } PR_END(31);
#endif
            __syncthreads();
#ifndef NO_C3
            PR_BEGIN(32); qk_prep(F, l); PR_END(32);
#endif
#ifndef NO_C4
            PR_BEGIN(33); _Pragma("unroll 1") for (int rep_ = 0; rep_ < REP_C4; ++rep_) { v_transpose(F); __syncthreads(); } PR_END(33); PR_BEGIN(34);
#endif
            SEAM(pb + 2); PR_END(34); PR_END(3);
        }
        if (PHON(4) && IN(pb + 3)) { PR_BEGIN(4); REFRESH_TID(F);
#if MIXER_QUEUE
            lru_carry_all(F);
            __syncthreads();
            mixer_queue_phase(F, l);
#else
            PR_BEGIN(20); for (int ch = F.bid; ch < 256; ch += F.G) gdn_scan(F, ch); PR_END(20);
            PR_BEGIN(21); lru_carry_all(F);
            __syncthreads(); PR_END(21);
            PR_BEGIN(22); attn_phase(F, l); PR_END(22);
#endif
            PR_BEGIN(23);
            SEAM(pb + 3); PR_END(23); PR_END(4);
        }
        if (PHON(5) && IN(pb + 4)) { PR_BEGIN(5); REFRESH_TID(F);
            _Pragma("unroll 1") for (int rep_ = 0; rep_ < REP_E; ++rep_) { lru_pass2(F, l); __syncthreads(); }
            __syncthreads();
            gdn_out(F, l);
            SEAM(pb + 4); PR_END(5);
        }
        if (PHON(6) && IN(pb + 5)) { PR_BEGIN(6); REFRESH_TID(F);
            pg8::Gemm g{WSP(bf16, WS_Y), WSP(bf16, WS_WBR) + (size_t)l * 4 * 1024 * 512, 4 * MROWS, 4 * 1024, 512};
            pg8::MergeOrder S{F.G, F.bid, MROWS / 256, TLAT / 256};
            pg8::EpiMerge E{WSP(bf16, WS_U), UW, UG, WSP(bf16, WS_MF), WSP(bf16, WS_MB), MROWS / 256};
            _Pragma("unroll 1") for (int rep_ = 0; rep_ < REP_F; ++rep_) { pg8::gemm_phase<pg8::EpiMerge, pg8::MergeOrder, true, true>(F.lds, g, S, E, F.wave); __syncthreads(); }
            PR_BEGIN(13); side_merge(F, l); PR_END(13);
            SEAM(pb + 5); PR_END(6);
        }
        if (PHON(7) && IN(pb + 6)) { PR_BEGIN(7); REFRESH_TID(F);
            pg8::Gemm g{WSP(bf16, WS_MB), WSP(bf16, WS_WOUT) + (size_t)l * D * D, MROWS, D, D};
            pg8::StaticOrder S; S.init(TLAT, D, F.G, F.bid);
            pg8::EpiResid E{WSP(float, WS_X), WSP(float, WS_MOD) + (size_t)l * 5 * 6144 + 2048};
            pg8::gemm_phase<pg8::EpiResid, pg8::StaticOrder, true, true>(F.lds, g, S, E, F.wave);
            PR_BEGIN(14); side_outproj(F, l); PR_END(14);
            SEAM(pb + 6); PR_END(7);
        }
        if (PHON(8) && IN(pb + 7)) { PR_BEGIN(8); REFRESH_TID(F); norm_phase<1>(F, l); SEAM(pb + 7); PR_END(8); }
        if (PHON(9) && IN(pb + 8)) { PR_BEGIN(9); REFRESH_TID(F); _Pragma("unroll 1") for (int rep_ = 0; rep_ < REP_G2; ++rep_) { moe_gather(F, l); __syncthreads(); } SEAM(pb + 8); PR_END(9); }
        if (PHON(10) && IN(pb + 9)) { PR_BEGIN(10); REFRESH_TID(F);
            moe_table(F, l);
            pg8::Gemm g{WSP(bf16, WS_HS), WSP(bf16, WS_WGU) + (size_t)l * NEXP * 2048 * D, MOE_ROWS, NEXP * 2048, D};
            pg8::MoeOrder S{(const LAS int*)(F.lds + MISC_OFF + 256), F.G, F.bid, 8};
            pg8::EpiSwiglu E{WSP(bf16, WS_ACT), F.in[I_BGU] + (size_t)l * NEXP * 2048};
            _Pragma("unroll 1") for (int rep_ = 0; rep_ < REP_I; ++rep_) { pg8::gemm_phase<pg8::EpiSwiglu, pg8::MoeOrder, true, true>(F.lds, g, S, E, F.wave); __syncthreads(); }
            SEAM(pb + 9); PR_END(10);
        }
        if (PHON(11) && IN(pb + 10)) { PR_BEGIN(11); REFRESH_TID(F);
            moe_table(F, l);
            pg8::Gemm g{WSP(bf16, WS_ACT), WSP(bf16, WS_WDN) + (size_t)l * NEXP * D * D, MOE_ROWS, NEXP * D, D};
            pg8::MoeOrder S{(const LAS int*)(F.lds + MISC_OFF + 256), F.G, F.bid, 4};
            pg8::EpiDown E{WSP(bf16, WS_YS), F.in[I_BDN] + (size_t)l * NEXP * D};
            _Pragma("unroll 1") for (int rep_ = 0; rep_ < REP_J; ++rep_) { pg8::gemm_phase<pg8::EpiDown, pg8::MoeOrder, true, true>(F.lds, g, S, E, F.wave); __syncthreads(); }
            SEAM(pb + 10); PR_END(11);
        }
    }
    if (PHON(12) && IN(PH_FINAL)) { PR_BEGIN(12); REFRESH_TID(F); norm_phase<2>(F, 0); PR_END(12); }
#if defined(PROBE_SUB) && (PROBE_SUB == 4 || PROBE_SUB == 5)
    if (blockIdx.x == 0) { unsigned long long tot = 0ull;
        for (int q = 0; q < 4; ++q) { const unsigned v = __hip_atomic_load(F.ctl + 3000 + q, __ATOMIC_RELAXED, __HIP_MEMORY_SCOPE_AGENT); tot += (PROBE_SUB == 4) ? v : (0x7fffffffu - v); }
        F.pr = tot; }
#endif
#ifdef PROBE_SUB
    if (F.pr) { const unsigned long long te = __builtin_amdgcn_s_memrealtime(); while (__builtin_amdgcn_s_memrealtime() - te < PROBE_MULT * F.pr) __builtin_amdgcn_s_sleep(8); }
#endif
#ifdef PROBE_PHASE
    if (blockIdx.x == 0) { const unsigned long long te = __builtin_amdgcn_s_memrealtime(); while (__builtin_amdgcn_s_memrealtime() - te < PROBE_MULT * pr_acc) __builtin_amdgcn_s_sleep(8); }
#endif
#undef IN
#undef SEAM
}

extern "C" void kernel_launch(void* const* d_in, const int* in_sizes, int n_in, void* d_out, int out_size, void* d_ws, size_t ws_size, hipStream_t stream) {
    static int grid = 0;
    if (grid == 0) {
        if (n_in != 32 || out_size != TLAT * D || ws_size < WS_END) { fprintf(stderr, "kernel_launch: unexpected shapes (n_in %d out %d ws %zu need %zu)\n", n_in, out_size, ws_size, (size_t)WS_END); grid = -1; return; }
        int dev = 0, cus = 0, per_cu = 0;
        if (hipGetDevice(&dev) != hipSuccess || hipDeviceGetAttribute(&cus, hipDeviceAttributeMultiprocessorCount, dev) != hipSuccess) { grid = -1; return; }
        if (hipFuncSetAttribute((const void*)hybrid_fwd, hipFuncAttributeMaxDynamicSharedMemorySize, LDS_BYTES) != hipSuccess) { fprintf(stderr, "kernel_launch: hipFuncSetAttribute failed\n"); grid = -1; return; }
        if (hipOccupancyMaxActiveBlocksPerMultiprocessor(&per_cu, (const void*)hybrid_fwd, NT, LDS_BYTES) != hipSuccess || per_cu < 1) fprintf(stderr, "kernel_launch: occupancy query says %d\n", per_cu);
        (void)hipGetLastError();
        grid = cus;
    }
    if (grid < 0) return;
    if (hipMemsetAsync((char*)d_ws + WS_CTL, 0, CTL_BYTES, stream) != hipSuccess) return;
    Args a{};
    for (int i = 0; i < 32; ++i) a.in[i] = (const float*)d_in[i];
    a.out = (float*)d_out; a.ws = (unsigned char*)d_ws;
#if MK_MULTI
    for (int p = 0; p < N_PHASES; ++p) { a.ph_lo = p; a.ph_hi = p + 1; a.li = p;
        hipLaunchKernelGGL(hybrid_fwd, dim3(grid), dim3(NT), LDS_BYTES, stream, a); }
#else
    a.ph_lo = 0; a.ph_hi = N_PHASES; a.li = 0;
    hipLaunchKernelGGL(hybrid_fwd, dim3(grid), dim3(NT), LDS_BYTES, stream, a);
#endif
    const hipError_t le = hipPeekAtLastError();
    if (le != hipSuccess) fprintf(stderr, "kernel_launch: launch failed: %s\n", hipGetErrorName(le));
}
```

```cpp
#include <hip/hip_runtime.h>
#include <cstdio>
#include <cstdint>

#ifndef MK_MULTI
#define MK_MULTI 0
#endif

constexpr int D = 1024, NB = 4, SEQ = 4096, LCTX = 256, DEPTH = 4;
constexpr int TLAT = NB * SEQ, TCTX = NB * LCTX, MROWS = TLAT + TCTX;
constexpr int NCHUNK = MROWS / 64;
constexpr int INW = 9488, UW = 9472;
constexpr int UQ = 0, UK = 512, UV = 640, UBX = 768, UBY = 1280, UCQ = 1792, UCK = 2304, UCV = 2816, UCZ = 3328, UDQ = 3840, UDK = 4352, UDV = 4864, UG = 5376;
constexpr int NEXP = 32, TOPK = 4;
constexpr int KEYS = SEQ + LCTX;
constexpr int MOE_ROWS = MROWS * TOPK + NEXP * 256;
constexpr float EPS = 1e-6f;
constexpr float LOG2E = 1.4426950408889634f;

constexpr size_t al256(size_t x) { return (x + 255) & ~(size_t)255; }
constexpr size_t WS_CTL = 0, CTL_BYTES = 1u << 20;
constexpr size_t WS_MOD  = WS_CTL + CTL_BYTES;
constexpr size_t WS_ROPE = WS_MOD + al256((size_t)DEPTH * 5 * 6144 * 4);
constexpr size_t WS_LRUW = WS_ROPE + al256(2 * 64 * 16 * 4);
constexpr size_t WS_WIN  = WS_LRUW + al256((size_t)DEPTH * 2 * 2 * 8 * 4096 * 2);
constexpr size_t WS_WBR  = WS_WIN + al256((size_t)DEPTH * UW * D * 2);
constexpr size_t WS_WOUT = WS_WBR + al256((size_t)DEPTH * 4 * 1024 * 512 * 2);
constexpr size_t WS_WGU  = WS_WOUT + al256((size_t)DEPTH * D * D * 2);
constexpr size_t WS_WDN  = WS_WGU + al256((size_t)DEPTH * NEXP * 2048 * 1024 * 2);
constexpr size_t WS_X    = WS_WDN + al256((size_t)DEPTH * NEXP * 1024 * 1024 * 2);
constexpr size_t WS_H    = WS_X + al256((size_t)MROWS * D * 4);
constexpr size_t WS_U    = WS_H + al256((size_t)MROWS * D * 2);
constexpr size_t WS_CAB  = WS_U + al256((size_t)MROWS * UW * 2);
constexpr size_t WS_VAT  = WS_CAB + al256((size_t)MROWS * 16 * 4);
constexpr size_t WS_VDT  = WS_VAT + al256((size_t)NB * 2 * 64 * KEYS * 2);
constexpr size_t WS_LRA  = WS_VDT + al256((size_t)NB * 8 * 64 * KEYS * 2);
constexpr size_t WS_LRB  = WS_LRA + al256((size_t)NCHUNK * 2 * 512 * 4);
constexpr size_t WS_LRC  = WS_LRB + al256((size_t)NCHUNK * 2 * 512 * 4);
constexpr int NCD = NCHUNK * 4 * 2;
constexpr size_t WS_GW   = WS_LRC + al256((size_t)NCHUNK * 2 * 512 * 4);
constexpr size_t WS_GU   = WS_GW + al256((size_t)NCD * 64 * 128 * 2);
constexpr size_t WS_GQG  = WS_GU + al256((size_t)NCD * 64 * 128 * 2);
constexpr size_t WS_GKD  = WS_GQG + al256((size_t)NCD * 64 * 128 * 2);
constexpr size_t WS_GQK  = WS_GKD + al256((size_t)NCD * 64 * 128 * 2);
constexpr size_t WS_GGL  = WS_GQK + al256((size_t)NCD * 64 * 64 * 2);
constexpr size_t WS_GO   = WS_GGL + al256((size_t)NCD * 4);
constexpr size_t WS_Y    = WS_GO + al256((size_t)2 * MROWS * 512 * 4);
constexpr size_t WS_MF   = WS_Y + al256((size_t)4 * MROWS * 512 * 2);
constexpr size_t WS_MB   = WS_MF + al256((size_t)MROWS * D * 4);
constexpr size_t WS_SROW = WS_MB + al256((size_t)MROWS * D * 2);
constexpr size_t WS_SW   = WS_SROW + al256((size_t)MROWS * 4 * 4);
constexpr size_t WS_SEP  = WS_SW + al256((size_t)MROWS * 4 * 4);
constexpr size_t WS_LIST = WS_SEP + al256((size_t)MROWS * 4 * 4);
constexpr size_t WS_HS   = WS_LIST + al256((size_t)NEXP * MROWS * 4);
constexpr size_t WS_ACT  = WS_HS + al256((size_t)MOE_ROWS * D * 2);
constexpr size_t WS_YS   = WS_ACT + al256((size_t)MOE_ROWS * D * 2);
constexpr size_t WS_END  = WS_YS + al256((size_t)MOE_ROWS * D * 2);

constexpr int CW_BAR = 4096;
constexpr int CW_CNT = 1024;

constexpr int RING_BYTES = 131072;
constexpr int MISC_OFF = RING_BYTES;
constexpr int LDS_BYTES = 147456;
constexpr int NWAVES = 8, NT = 512;

#define GAS __attribute__((address_space(1)))
#define LAS __attribute__((address_space(3)))
typedef unsigned short bf16;
typedef unsigned v4u __attribute__((ext_vector_type(4)));
typedef unsigned v2u __attribute__((ext_vector_type(2)));
typedef float f32x4 __attribute__((ext_vector_type(4)));
typedef float f32x16 __attribute__((ext_vector_type(16)));
typedef short bf16x8 __attribute__((ext_vector_type(8)));
typedef short bf16x4 __attribute__((ext_vector_type(4)));

typedef float f32x2_t __attribute__((ext_vector_type(2))); typedef __bf16 bf16x2_t __attribute__((ext_vector_type(2)));
__device__ __forceinline__ unsigned pk2(float lo, float hi) { f32x2_t v = {lo, hi}; bf16x2_t b = __builtin_convertvector(v, bf16x2_t); return __builtin_bit_cast(unsigned, b); }
__device__ __forceinline__ unsigned f2bf(float f) { return pk2(f, 0.f) & 0xffffu; }
__device__ __forceinline__ float bf2f(unsigned short b) { return __builtin_bit_cast(float, (unsigned)b << 16); }
__device__ __forceinline__ float bflo(unsigned w) { return __builtin_bit_cast(float, w << 16); }
__device__ __forceinline__ float bfhi(unsigned w) { return __builtin_bit_cast(float, w & 0xffff0000u); }
__device__ __forceinline__ float wave_sum(float v) {
#pragma unroll
    for (int o = 1; o < 64; o <<= 1) v += __shfl_xor(v, o);
    return v;
}
__device__ __forceinline__ float sigmoidf_(float x) { return 1.f / (1.f + __expf(-x)); }
__device__ __forceinline__ float softplusf_(float x) { return x > 20.f ? x : log1pf(__expf(x)); }
__device__ __forceinline__ float siluf_(float x) { return x / (1.f + __expf(-x)); }
__device__ __forceinline__ void lds_barrier() { asm volatile("s_waitcnt lgkmcnt(0)\n\ts_barrier" ::: "memory"); }
namespace pg8 {
#define PG8_LAS __attribute__((address_space(3)))
typedef unsigned short bf16_t;
typedef short bf16x8 __attribute__((ext_vector_type(8)));
typedef float f32x4 __attribute__((ext_vector_type(4)));
typedef unsigned u32x4 __attribute__((ext_vector_type(4)));
constexpr int BM = 256, BK = 64, HALF = 128, HTB = HALF * BK * 2  , STAGE_BYTES = 8 * HTB, NXCD = 8, WGM = 8;

__host__ __device__ __forceinline__ int lds_byte(int r, int c) { const int st = (r >> 4) * 2 + (c >> 5), rr = r & 15, cc = c & 31, ob = rr * 64 + cc * 2; return st * 1024 + (ob ^ (((ob >> 9) & 1) << 5)); }
__host__ __device__ __forceinline__ void stage_rc(int b, int& R, int& C) { const int st = b / 1024, sb = b % 1024, swz = sb ^ (((sb >> 9) & 1) << 5); R = (st >> 1) * 16 + swz / 64; C = (st & 1) * 32 + (swz % 64) / 2; }
__host__ __device__ __forceinline__ int perm32(int rho) { const int n = rho >> 4, i = rho & 15; return 8 * (i >> 2) + 4 * n + (i & 3); }

struct Unit { int pm, pn; };
struct Gemm { const bf16_t* A; const bf16_t* Bt; int M, N, K; };

struct StaticOrder {
    int nM, nN, nwg, G, c;
    __host__ __device__ void init(int M, int N, int G_, int c_) { nM = M / BM; nN = N / BM; nwg = nM * nN; G = G_; c = c_; }
    __host__ __device__ bool next(int i, Unit& u) const {
        const long L = (long)i * G + c; if (L >= nwg) return false;
        int wgid = (int)L; { const int q = nwg / NXCD, r = nwg % NXCD, xcd = wgid % NXCD, off = wgid / NXCD; wgid = (xcd < r ? xcd * (q + 1) : r * (q + 1) + (xcd - r) * q) + off; }
        const int nig = WGM * nN, gid = wgid / nig, fm = gid * WGM, gsz = (nM - fm) < WGM ? (nM - fm) : WGM;
        u.pm = fm + ((wgid % nig) % gsz); u.pn = (wgid % nig) / gsz; return true;
    }
    __device__ __forceinline__ void a_ready(const Unit&) const {}
    __device__ __forceinline__ void done(const Unit&) const {}
};

__device__ __forceinline__ unsigned cvt_pk_bf16(float lo, float hi) { unsigned r; asm volatile("v_cvt_pk_bf16_f32 %0, %1, %2" : "=v"(r) : "v"(lo), "v"(hi)); return r; }
typedef float f32x2 __attribute__((ext_vector_type(2)));
template <class Epi, class Sched, bool ALIGN_EPI = false, bool SP2 = false>
__device__ __forceinline__ void gemm_phase(PG8_LAS unsigned char* lds, const Gemm g, const Sched& S, const Epi& E, const int wid_in) {
    int lane_o = (int)__builtin_amdgcn_mbcnt_hi(~0u, __builtin_amdgcn_mbcnt_lo(~0u, 0u)); asm volatile("" : "+v"(lane_o));
    const int wid = __builtin_amdgcn_readfirstlane(wid_in), lane = lane_o, tid = wid * 64 + lane, wr = wid >> 2, wc = wid & 3, fr = lane & 15, fq = lane >> 4;
    const int K = g.K, nt = K / BK;
    unsigned voffA[2], voffB[2];
#pragma unroll
    for (int i = 0; i < 2; ++i) { int R, C; stage_rc(tid * 16 + i * 8192, R, C); const int Rb = Epi::PERM ? ((R & ~31) + perm32(R & 31)) : R;
        voffA[i] = (unsigned)(R * K + C) * 2u; voffB[i] = (unsigned)(Rb * K + C) * 2u; }
    const size_t kstep = (size_t)(BK * 2);
    const size_t hstep = (size_t)HALF * K * 2;
    const size_t tstep = 2 * hstep;
    const unsigned ldsw = (unsigned)wid * 1024u;
    const int aoff = lds_byte(wr * 64 + fr, fq * 8), boff = lds_byte(wc * 32 + fr, fq * 8);
#define PG8_SA(b, h) (((b) * 2 + (h)) * HTB)
#define PG8_SB(b, h) ((4 + (b) * 2 + (h)) * HTB)
#define PG8_STAGE(bufoff, gbase, voff) do { _Pragma("unroll") for (int _i = 0; _i < 2; ++_i) \
        __builtin_amdgcn_global_load_lds((const unsigned*)((const char*)(gbase) + (voff)[_i]), (PG8_LAS unsigned*)(lds + (bufoff) + ldsw + _i * 8192), 16, 0, 0); } while (0)
#define PG8_LDA(dst, b, h) do { _Pragma("unroll") for (int m = 0; m < 4; ++m) _Pragma("unroll") for (int k = 0; k < 2; ++k) dst[m][k] = *(const PG8_LAS bf16x8*)(lds + PG8_SA(b, h) + aoff + m * 2048 + k * 1024); } while (0)
#define PG8_LDB(dst, b, h) do { _Pragma("unroll") for (int n = 0; n < 2; ++n) _Pragma("unroll") for (int k = 0; k < 2; ++k) dst[n][k] = *(const PG8_LAS bf16x8*)(lds + PG8_SB(b, h) + boff + n * 2048 + k * 1024); } while (0)
#define PG8_MMA(ai, bj, At, Bt) do { __builtin_amdgcn_s_setprio(1); _Pragma("unroll") for (int m = 0; m < 4; ++m) _Pragma("unroll") for (int n = 0; n < 2; ++n) _Pragma("unroll") for (int k = 0; k < 2; ++k) \
        acc[ai][bj][m][n] = __builtin_amdgcn_mfma_f32_16x16x32_bf16(Bt[n][k], At[m][k], acc[ai][bj][m][n], 0, 0, 0); __builtin_amdgcn_s_setprio(0); } while (0)
#define PG8_WAIT_V(n) asm volatile("s_waitcnt vmcnt(" #n ")" ::: "memory")
#define PG8_WAIT_L(n) asm volatile("s_waitcnt lgkmcnt(" #n ")" ::: "memory")
#define PG8_BAR __builtin_amdgcn_s_barrier()
#define PG8_SCHED __builtin_amdgcn_sched_barrier(0)
    Unit cur, nxt; int ui = 0;
    if (!S.next(0, cur)) return;
    f32x4 acc[2][2][4][2];
#pragma unroll
    for (int a = 0; a < 2; ++a)
#pragma unroll
        for (int b = 0; b < 2; ++b)
#pragma unroll
            for (int m = 0; m < 4; ++m)
#pragma unroll
                for (int n = 0; n < 2; ++n) acc[a][b][m][n] = (f32x4){0.f, 0.f, 0.f, 0.f};
    bf16x8 At[4][2], B0[2][2], B1[2][2];
    const char* cA = (const char*)g.A + (size_t)cur.pm * tstep; const char* cB = (const char*)g.Bt + (size_t)cur.pn * tstep;
    S.a_ready(cur);
    if constexpr (SP2) {
        PG8_STAGE(PG8_SB(0, 0), cB, voffB); PG8_STAGE(PG8_SB(0, 1), cB + hstep, voffB); PG8_STAGE(PG8_SA(0, 0), cA, voffA); PG8_STAGE(PG8_SA(0, 1), cA + hstep, voffA);
        if (wr == 1) PG8_BAR;
        PG8_WAIT_V(2); PG8_BAR;
        PG8_STAGE(PG8_SB(1, 0), cB + kstep, voffB); PG8_STAGE(PG8_SA(1, 0), cA + kstep, voffA); PG8_STAGE(PG8_SB(1, 1), cB + hstep + kstep, voffB);
        PG8_WAIT_V(6); PG8_BAR;
    } else {
        PG8_STAGE(PG8_SB(0, 0), cB, voffB); PG8_STAGE(PG8_SA(0, 0), cA, voffA); PG8_STAGE(PG8_SB(0, 1), cB + hstep, voffB); PG8_STAGE(PG8_SA(0, 1), cA + hstep, voffA);
        if (wr == 1) PG8_BAR;
        PG8_WAIT_V(4); PG8_BAR;
        PG8_STAGE(PG8_SB(1, 0), cB + kstep, voffB); PG8_STAGE(PG8_SA(1, 0), cA + kstep, voffA); PG8_STAGE(PG8_SB(1, 1), cB + hstep + kstep, voffB);
        PG8_WAIT_V(6); PG8_BAR;
    }
    for (;;) {
        const bool has_next = S.next(ui + 1, nxt);
        const char* nA = has_next ? (const char*)g.A + (size_t)nxt.pm * tstep : cA; const char* nB = has_next ? (const char*)g.Bt + (size_t)nxt.pn * tstep : cB;
        for (int t = 0; t < nt; t += 2) {
            const bool last = (t == nt - 2);
            const char* a1 = cA + (size_t)(t + 1) * kstep;
            const char* a2 = last ? nA : cA + (size_t)(t + 2) * kstep; const char* b2 = last ? nB : cB + (size_t)(t + 2) * kstep;
            const char* a3 = a2 + kstep; const char* b3 = b2 + kstep;
            if (last && has_next) S.a_ready(nxt);
            if constexpr (SP2) {
            PG8_LDB(B0, 0, 0); PG8_LDB(B1, 0, 1); PG8_SCHED; PG8_LDA(At, 0, 0); PG8_STAGE(PG8_SA(1, 1), a1 + hstep, voffA);
            PG8_WAIT_V(8); PG8_WAIT_L(0); PG8_BAR; PG8_MMA(0, 0, At, B0); PG8_MMA(0, 1, At, B1); PG8_BAR; PG8_SCHED;
            PG8_LDA(At, 0, 1); PG8_STAGE(PG8_SB(0, 0), b2, voffB); PG8_STAGE(PG8_SB(0, 1), b2 + hstep, voffB); PG8_STAGE(PG8_SA(0, 0), a2, voffA);
            PG8_WAIT_V(8); PG8_WAIT_L(0); PG8_BAR; PG8_MMA(1, 0, At, B0); PG8_MMA(1, 1, At, B1); PG8_BAR; PG8_SCHED;
            PG8_LDB(B0, 1, 0); PG8_LDB(B1, 1, 1); PG8_SCHED; PG8_LDA(At, 1, 0); PG8_STAGE(PG8_SA(0, 1), a2 + hstep, voffA);
            PG8_WAIT_V(8); PG8_WAIT_L(0); PG8_BAR; PG8_MMA(0, 0, At, B0); PG8_MMA(0, 1, At, B1); PG8_BAR; PG8_SCHED;
            PG8_LDA(At, 1, 1); PG8_STAGE(PG8_SB(1, 0), b3, voffB); PG8_STAGE(PG8_SB(1, 1), b3 + hstep, voffB); PG8_STAGE(PG8_SA(1, 0), a3, voffA);
            PG8_WAIT_V(8); PG8_WAIT_L(0); PG8_BAR; PG8_MMA(1, 0, At, B0); PG8_MMA(1, 1, At, B1); PG8_BAR; PG8_SCHED;
            } else {
            PG8_LDB(B0, 0, 0); PG8_SCHED; PG8_LDA(At, 0, 0); PG8_STAGE(PG8_SA(1, 1), a1 + hstep, voffA);
            PG8_WAIT_L(8); PG8_BAR; PG8_WAIT_L(0); PG8_MMA(0, 0, At, B0); PG8_BAR; PG8_SCHED;
            PG8_LDB(B1, 0, 1); PG8_STAGE(PG8_SB(0, 0), b2, voffB);
            PG8_BAR; PG8_WAIT_L(0); PG8_MMA(0, 1, At, B1); PG8_BAR;
            PG8_LDA(At, 0, 1); PG8_STAGE(PG8_SA(0, 0), a2, voffA);
            PG8_BAR; PG8_WAIT_L(0); PG8_MMA(1, 0, At, B0); PG8_BAR; PG8_SCHED;
            PG8_STAGE(PG8_SB(0, 1), b2 + hstep, voffB);
            PG8_WAIT_V(6); PG8_BAR; PG8_MMA(1, 1, At, B1); PG8_BAR;
            PG8_LDB(B0, 1, 0); PG8_SCHED; PG8_LDA(At, 1, 0); PG8_STAGE(PG8_SA(0, 1), a2 + hstep, voffA);
            PG8_WAIT_L(8); PG8_BAR; PG8_WAIT_L(0); PG8_MMA(0, 0, At, B0); PG8_BAR; PG8_SCHED;
            PG8_LDB(B1, 1, 1); PG8_STAGE(PG8_SB(1, 0), b3, voffB);
            PG8_BAR; PG8_WAIT_L(0); PG8_MMA(0, 1, At, B1); PG8_BAR;
            PG8_LDA(At, 1, 1); PG8_STAGE(PG8_SA(1, 0), a3, voffA);
            PG8_BAR; PG8_WAIT_L(0); PG8_MMA(1, 0, At, B0); PG8_BAR; PG8_SCHED;
            PG8_STAGE(PG8_SB(1, 1), b3 + hstep, voffB);
            PG8_WAIT_V(6); PG8_BAR; PG8_MMA(1, 1, At, B1); PG8_BAR;
            }
        }
        if constexpr (ALIGN_EPI) { if (wr == 0) PG8_BAR; }
        if constexpr (!Epi::AFTER_DRAIN) { E(acc, cur, wr, wc, fr, fq); S.done(cur); }
        if (!has_next) break;
#pragma unroll
        for (int a = 0; a < 2; ++a)
#pragma unroll
            for (int b = 0; b < 2; ++b)
#pragma unroll
                for (int m = 0; m < 4; ++m)
#pragma unroll
                    for (int n = 0; n < 2; ++n) acc[a][b][m][n] = (f32x4){0.f, 0.f, 0.f, 0.f};
        cur = nxt; cA = nA; cB = nB; ++ui;
        if constexpr (ALIGN_EPI) { if (wr == 1) PG8_BAR; }
    }
    PG8_WAIT_V(0);
    if constexpr (!ALIGN_EPI) { if (wr == 0) PG8_BAR; }
    PG8_BAR;
    if constexpr (Epi::AFTER_DRAIN) { E.fused(acc, cur, wr, wc, fr, fq, lds, wid, lane); S.done(cur); }
#undef PG8_SA
#undef PG8_SB
#undef PG8_STAGE
#undef PG8_LDA
#undef PG8_LDB
#undef PG8_MMA
#undef PG8_WAIT_V
#undef PG8_WAIT_L
#undef PG8_BAR
#undef PG8_SCHED
}
}

namespace pg8 {
__device__ __forceinline__ float bflo_(unsigned w) { return __builtin_bit_cast(float, w << 16); }
__device__ __forceinline__ float bfhi_(unsigned w) { return __builtin_bit_cast(float, w & 0xffff0000u); }
__device__ __forceinline__ float sigm_(float x) { return 1.f / (1.f + __expf(-x)); }

struct EpiStoreBf16 {
    static constexpr bool PERM = true, AFTER_DRAIN = false;
    bf16_t* O; int ldc;
    __device__ __forceinline__ void operator()(const f32x4 (&acc)[2][2][4][2], const Unit& u, int wr, int wc, int fr, int fq) const {
        const int row0 = u.pm * BM + wr * 64 + fr, col0 = u.pn * BM + wc * 32 + 8 * fq;
#pragma unroll
        for (int ai = 0; ai < 2; ++ai)
#pragma unroll
            for (int m = 0; m < 4; ++m) { bf16_t* rowp = O + (size_t)(row0 + ai * HALF + m * 16) * ldc + col0;
#pragma unroll
                for (int bj = 0; bj < 2; ++bj) { const f32x4 v0 = acc[ai][bj][m][0], v1 = acc[ai][bj][m][1];
                    u32x4 w; w.x = cvt_pk_bf16(v0[0], v0[1]); w.y = cvt_pk_bf16(v0[2], v0[3]); w.z = cvt_pk_bf16(v1[0], v1[1]); w.w = cvt_pk_bf16(v1[2], v1[3]);
                    *(u32x4*)(rowp + bj * HALF) = w; } }
    }
};

struct EpiMerge {
    static constexpr bool PERM = true, AFTER_DRAIN = false;
    const bf16_t* U; int ldu, gcol0; bf16_t* Mf; bf16_t* Mb; int npm;
    __device__ __forceinline__ void operator()(const f32x4 (&acc)[2][2][4][2], const Unit& u, int wr, int wc, int fr, int fq) const {
        const int br = u.pm / npm, pm = u.pm - br * npm, pn = u.pn & 3;
        const int row0 = pm * BM + wr * 64 + fr, col0 = pn * BM + wc * 32 + 8 * fq;
#pragma unroll
        for (int ai = 0; ai < 2; ++ai) {
            u32x4 gv[4][2], pv[4][2];
#pragma unroll
            for (int m = 0; m < 4; ++m)
#pragma unroll
                for (int bj = 0; bj < 2; ++bj) { const size_t row = (size_t)(row0 + ai * HALF + m * 16); const int col = col0 + bj * HALF;
                    gv[m][bj] = *(const u32x4*)(U + row * ldu + gcol0 + br * 1024 + col);
                    pv[m][bj] = br > 0 ? *(const u32x4*)(Mf + row * 1024 + col) : (u32x4){0u, 0u, 0u, 0u}; }
#pragma unroll
            for (int m = 0; m < 4; ++m)
#pragma unroll
                for (int bj = 0; bj < 2; ++bj) { const size_t row = (size_t)(row0 + ai * HALF + m * 16); const int col = col0 + bj * HALF;
                    const u32x4 g = gv[m][bj], p = pv[m][bj];
                    f32x4 v0 = acc[ai][bj][m][0], v1 = acc[ai][bj][m][1];
                    v0[0] = v0[0] * sigm_(bflo_(g.x)) + bflo_(p.x); v0[1] = v0[1] * sigm_(bfhi_(g.x)) + bfhi_(p.x); v0[2] = v0[2] * sigm_(bflo_(g.y)) + bflo_(p.y); v0[3] = v0[3] * sigm_(bfhi_(g.y)) + bfhi_(p.y);
                    v1[0] = v1[0] * sigm_(bflo_(g.z)) + bflo_(p.z); v1[1] = v1[1] * sigm_(bfhi_(g.z)) + bfhi_(p.z); v1[2] = v1[2] * sigm_(bflo_(g.w)) + bflo_(p.w); v1[3] = v1[3] * sigm_(bfhi_(g.w)) + bfhi_(p.w);
                    u32x4 w; w.x = cvt_pk_bf16(v0[0], v0[1]); w.y = cvt_pk_bf16(v0[2], v0[3]); w.z = cvt_pk_bf16(v1[0], v1[1]); w.w = cvt_pk_bf16(v1[2], v1[3]);
                    *(u32x4*)((br < 3 ? Mf : Mb) + row * 1024 + col) = w; }
        }
    }
};
struct MergeOrder {
    int G, c, npm, ncnt;
    __device__ __forceinline__ bool next(int i, Unit& u) const {
        const int su = (i >> 2) * G + c; if (su >= ncnt * 4) return false;
        const int br = i & 3; u.pm = br * npm + (su >> 2); u.pn = br * 4 + (su & 3); return true; }
    __device__ __forceinline__ void a_ready(const Unit&) const {}
    __device__ __forceinline__ void done(const Unit&) const {}
};

struct EpiResid {
    static constexpr bool PERM = false, AFTER_DRAIN = false;
    float* X; const float* gt;
    __device__ __forceinline__ void operator()(const f32x4 (&acc)[2][2][4][2], const Unit& u, int wr, int wc, int fr, int fq) const {
        const int row0 = u.pm * BM + wr * 64 + fr, col0 = u.pn * BM + wc * 32 + 4 * fq;
        const int mr = u.pm < 64 ? (u.pm >> 4) : 4;
        f32x4 gv[2][2];
#pragma unroll
        for (int bj = 0; bj < 2; ++bj)
#pragma unroll
            for (int n = 0; n < 2; ++n) gv[bj][n] = *(const f32x4*)(gt + (size_t)mr * 6144 + col0 + bj * HALF + n * 16);
#pragma unroll
        for (int ai = 0; ai < 2; ++ai) {
            f32x4 xv[4][2][2];
#pragma unroll
            for (int m = 0; m < 4; ++m)
#pragma unroll
                for (int bj = 0; bj < 2; ++bj)
#pragma unroll
                    for (int n = 0; n < 2; ++n) xv[m][bj][n] = *(const f32x4*)(X + (size_t)(row0 + ai * HALF + m * 16) * 1024 + col0 + bj * HALF + n * 16);
#pragma unroll
            for (int m = 0; m < 4; ++m)
#pragma unroll
                for (int bj = 0; bj < 2; ++bj)
#pragma unroll
                    for (int n = 0; n < 2; ++n) *(f32x4*)(X + (size_t)(row0 + ai * HALF + m * 16) * 1024 + col0 + bj * HALF + n * 16) = xv[m][bj][n] + gv[bj][n] * acc[ai][bj][m][n];
        }
    }
};

struct MoeOrder {
    const PG8_LAS int* tpre; int G, c, ncol;
    __device__ __forceinline__ bool next(int i, Unit& u) const {
        int tau, pnl;
        if ((G & 7) == 0 && ((G >> 3) % ncol) == 0) { const int x = c & 7, y = c >> 3, rp = (G >> 3) / ncol; tau = (i * 8 + x) * rp + y / ncol; pnl = y % ncol; }
        else { const int L = i * G + c; tau = L / ncol; pnl = L - tau * ncol; }
        if (tau >= tpre[32]) return false;
        int e = 0;
#pragma unroll 1
        while (tpre[e + 1] <= tau) ++e;
        u.pm = tau; u.pn = e * ncol + pnl; return true; }
    __device__ __forceinline__ void a_ready(const Unit&) const {}
    __device__ __forceinline__ void done(const Unit&) const {}
};
struct EpiSwiglu {
    static constexpr bool PERM = true, AFTER_DRAIN = false;
    bf16_t* ACT; const float* bgu;
    __device__ __forceinline__ void operator()(const f32x4 (&acc)[2][2][4][2], const Unit& u, int wr, int wc, int fr, int fq) const {
        const int e = u.pn >> 3, pnl = u.pn & 7;
        const int row0 = u.pm * BM + wr * 64 + fr, cl = 128 * pnl + wc * 32 + 8 * fq;
        const float* bg = bgu + (size_t)e * 2048 + cl;
        const f32x4 bg0 = *(const f32x4*)bg, bg1 = *(const f32x4*)(bg + 4), bu0 = *(const f32x4*)(bg + 1024), bu1 = *(const f32x4*)(bg + 1028);
#pragma unroll
        for (int ai = 0; ai < 2; ++ai)
#pragma unroll
            for (int m = 0; m < 4; ++m) {
                f32x4 g0 = acc[ai][0][m][0] + bg0, g1 = acc[ai][0][m][1] + bg1, u0 = acc[ai][1][m][0] + bu0, u1 = acc[ai][1][m][1] + bu1;
                float o[8];
#pragma unroll
                for (int j = 0; j < 4; ++j) { const float g = fminf(g0[j], 7.f), up = fminf(fmaxf(u0[j], -7.f), 7.f); o[j] = (up + 1.f) * g * sigm_(1.702f * g); }
#pragma unroll
                for (int j = 0; j < 4; ++j) { const float g = fminf(g1[j], 7.f), up = fminf(fmaxf(u1[j], -7.f), 7.f); o[4 + j] = (up + 1.f) * g * sigm_(1.702f * g); }
                u32x4 w; w.x = cvt_pk_bf16(o[0], o[1]); w.y = cvt_pk_bf16(o[2], o[3]); w.z = cvt_pk_bf16(o[4], o[5]); w.w = cvt_pk_bf16(o[6], o[7]);
                *(u32x4*)(ACT + (size_t)(row0 + ai * HALF + m * 16) * 1024 + cl) = w; }
    }
};
struct EpiDown {
    static constexpr bool PERM = true, AFTER_DRAIN = false;
    bf16_t* YS; const float* bdn;
    __device__ __forceinline__ void operator()(const f32x4 (&acc)[2][2][4][2], const Unit& u, int wr, int wc, int fr, int fq) const {
        const int e = u.pn >> 2, pnl = u.pn & 3;
        const int row0 = u.pm * BM + wr * 64 + fr, col0 = pnl * BM + wc * 32 + 8 * fq;
        f32x4 bv[2][2];
#pragma unroll
        for (int bj = 0; bj < 2; ++bj)
#pragma unroll
            for (int n = 0; n < 2; ++n) bv[bj][n] = *(const f32x4*)(bdn + (size_t)e * 1024 + col0 + bj * HALF + 4 * n);
#pragma unroll
        for (int ai = 0; ai < 2; ++ai)
#pragma unroll
            for (int m = 0; m < 4; ++m) { bf16_t* rowp = YS + (size_t)(row0 + ai * HALF + m * 16) * 1024 + col0;
#pragma unroll
                for (int bj = 0; bj < 2; ++bj) { const f32x4 v0 = acc[ai][bj][m][0] + bv[bj][0], v1 = acc[ai][bj][m][1] + bv[bj][1];
                    u32x4 w; w.x = cvt_pk_bf16(v0[0], v0[1]); w.y = cvt_pk_bf16(v0[2], v0[3]); w.z = cvt_pk_bf16(v1[0], v1[1]); w.w = cvt_pk_bf16(v1[2], v1[3]);
                    *(u32x4*)(rowp + bj * HALF) = w; } }
    }
};
}
#define XB_TMO      128
#define XB_XCNT(j)  (256  + 64 * (j))
#define XB_XSUB(j)  (1280 + 64 * (j))
#define XB_XGEN(j)  (2304 + 64 * (j))
#define XB_TOP      3328
#define XB_TOPGEN   3392
#define XCD_BAR_WORDS 3456
#define XB_SPIN_CAP (1u << 18)
#define LAS __attribute__((address_space(3)))

__device__ __forceinline__ unsigned xb_ld(unsigned* p)              { return __hip_atomic_load(p, __ATOMIC_RELAXED, __HIP_MEMORY_SCOPE_AGENT); }
__device__ __forceinline__ unsigned xb_add(unsigned* p, unsigned v) { return __hip_atomic_fetch_add(p, v, __ATOMIC_RELAXED, __HIP_MEMORY_SCOPE_AGENT); }
__device__ __forceinline__ unsigned xb_xcc_id() { return (unsigned)__builtin_amdgcn_s_getreg((3 << 11) | 20) & 0xFu; }
#define XB_SPIN(cond, bar) do { unsigned _sp = 0; while (cond) { __builtin_amdgcn_s_sleep(1); \
    if ((++_sp & 255u) == 0u) { if (xb_ld(&(bar)[XB_TMO])) break; if (_sp > XB_SPIN_CAP) { atomicAdd(&(bar)[XB_TMO], 1u); break; } } } } while (0)

struct XcdBarrier {
    unsigned* bar; unsigned x;
    volatile LAS unsigned* st;
};

__device__ __forceinline__ XcdBarrier xcd_barrier_post(unsigned* bar, volatile LAS unsigned* st) {
    XcdBarrier b; b.bar = bar; b.x = xb_xcc_id(); b.st = st;
    if (threadIdx.x == 0) (void)xb_add(&bar[XB_XCNT(b.x)], 1u);
    return b;
}
__device__ __forceinline__ void xcd_barrier_complete(unsigned* bar, unsigned x, unsigned& nloc, unsigned& nx) {
    const unsigned G = gridDim.x * gridDim.y * gridDim.z;
    unsigned sum, cnt, mine, sp = 0u;
    for (;;) {
        sum = 0u; cnt = 0u; mine = 0u;
#pragma unroll
        for (unsigned j = 0; j < 16; ++j) { const unsigned c = xb_ld(&bar[XB_XCNT(j)]); sum += c; cnt += (c > 0u) ? 1u : 0u; mine = (j == x) ? c : mine; }
        if (sum == G) break;
        __builtin_amdgcn_s_sleep(1);
        if ((++sp & 255u) == 0u) { if (xb_ld(&bar[XB_TMO])) break; if (sp > XB_SPIN_CAP) { atomicAdd(&bar[XB_TMO], 1u); break; } }
    }
    nloc = mine > 0u ? mine : 1u; nx = cnt > 0u ? cnt : 1u;
}

__device__ __forceinline__ void xcd_barrier(const XcdBarrier& b) {
    asm volatile("s_waitcnt vmcnt(0)" ::: "memory");
    __syncthreads();
    if (threadIdx.x == 0) {
        unsigned* bar = b.bar;
        __builtin_amdgcn_s_waitcnt(0);
        unsigned nloc = b.st[0], nx = b.st[1];
        if (nloc == 0u) { xcd_barrier_complete(bar, b.x, nloc, nx); b.st[0] = nloc; b.st[1] = nx; }
        const unsigned old = xb_add(&bar[XB_XSUB(b.x)], 1u);
        const unsigned gen = old / nloc;
        if (old + 1u == (gen + 1u) * nloc) {
            __builtin_amdgcn_fence(__ATOMIC_RELEASE, "agent");
            asm volatile("s_waitcnt vmcnt(0)" ::: "memory");
            const unsigned og = xb_add(&bar[XB_TOP], 1u);
            const unsigned tg = og / nx;
            if (og + 1u == (tg + 1u) * nx) xb_add(&bar[XB_TOPGEN], 1u);
            else XB_SPIN(xb_ld(&bar[XB_TOPGEN]) == tg, bar);
            __builtin_amdgcn_fence(__ATOMIC_ACQUIRE, "agent");
            xb_add(&bar[XB_XGEN(b.x)], 1u);
            asm volatile("s_waitcnt vmcnt(0)" ::: "memory");
        } else {
            XB_SPIN(xb_ld(&bar[XB_XGEN(b.x)]) == gen, bar);
            __builtin_amdgcn_fence(__ATOMIC_ACQUIRE, "agent");
            asm volatile("s_waitcnt vmcnt(0)" ::: "memory");
        }
    }
    __syncthreads();
}

struct Frame {
    LAS unsigned char* lds;
    unsigned* ctl;
    int tid, lane, wave, G, bid;
    unsigned long long pr;
    const float* const* in; const float* const* in0;
    float* out;
    unsigned char* ws; unsigned char* ws0;
};
#define WSP(T, off) ((T*)(F.ws + (off)))
#define REFRESH_TID(F) do { int t_ = (int)__builtin_amdgcn_mbcnt_hi(~0u, __builtin_amdgcn_mbcnt_lo(~0u, 0u)); asm volatile("" : "+v"(t_)); F.lane = t_; F.tid = F.wave * 64 + t_; \
    int z_ = 0; asm volatile("s_mov_b32 %0, 0" : "=s"(z_)); F.ws = F.ws0 + z_; F.in = F.in0 + z_; F.bid = (int)blockIdx.x + z_; } while (0)
#define I_X 0
#define I_C 1
#define I_CTX 2
#define I_CCTX 3
#define I_WMOD 4
#define I_BMOD 5
#define I_G1 6
#define I_G2 7
#define I_WIN 8
#define I_AGQ 9
#define I_AGK 10
#define I_BCW 11
#define I_BCB 12
#define I_BLAM 13
#define I_BWR 14
#define I_BBR 15
#define I_BWI 16
#define I_BBI 17
#define I_CCW 18
#define I_CALOG 19
#define I_CDTB 20
#define I_CGOUT 21
#define I_RPB 22
#define I_WBR 23
#define I_WOUT 24
#define I_WRT 25
#define I_BRT 26
#define I_WGU 27
#define I_BGU 28
#define I_WDN 29
#define I_BDN 30
#define I_GFIN 31

__device__ __forceinline__ int mod_row(int r) { return r < TLAT ? (r >> 12) : 4; }

__device__ __forceinline__ void p0_transpose_item(const float* W, size_t pitch, int K, bf16* WT, int drow0, int scol0, int k0, LAS float* scr, int lane) {
    float v[32];
#pragma unroll
    for (int i = 0; i < 32; ++i) { const int kk = 2 * i + (lane >> 5); v[i] = W[(size_t)(k0 + kk) * pitch + scol0 + (lane & 31)]; }
#pragma unroll
    for (int i = 0; i < 32; ++i) { const int kk = 2 * i + (lane >> 5); scr[kk * 33 + (lane & 31)] = v[i]; }
    asm volatile("s_waitcnt lgkmcnt(0)" ::: "memory");
    const int c = lane & 7;
#pragma unroll
    for (int j = 0; j < 4; ++j) { const int n = (lane >> 3) + 8 * j; const LAS float* s = scr + (8 * c) * 33 + n;
        v4u o; o.x = pk2(s[0 * 33], s[1 * 33]); o.y = pk2(s[2 * 33], s[3 * 33]); o.z = pk2(s[4 * 33], s[5 * 33]); o.w = pk2(s[6 * 33], s[7 * 33]);
        *(v4u*)(WT + (size_t)(drow0 + n) * K + k0 + 8 * c) = o; }
    asm volatile("s_waitcnt lgkmcnt(0)" ::: "memory");
}

__device__ __forceinline__ void p0_prologue(Frame& F) {
    LAS float* scr = (LAS float*)(F.lds + F.wave * 16384);
    const int gw = F.bid * NWAVES + F.wave, NGW = F.G * NWAVES;
    constexpr int I_IN = DEPTH * 16 * (UW / 32);
    constexpr int I_BR = DEPTH * 4 * 8 * 32;
    constexpr int I_OUT = DEPTH * 16 * 32;
    constexpr int I_GU = DEPTH * NEXP * 16 * 64;
    constexpr int I_DN = DEPTH * NEXP * 16 * 32;
    constexpr int NITEMS = I_IN + I_BR + I_OUT + I_GU + I_DN;
    for (int it = gw; it < NITEMS; it += NGW) {
        int r = it;
        if (r < I_IN) { const int l = r / (16 * 296), q = r % (16 * 296), kb = q / 296, nb = q % 296; const int n0 = nb * 32, sc = n0 < 3840 ? n0 : n0 + 16;
            p0_transpose_item(F.in[I_WIN] + (size_t)l * D * INW, INW, D, WSP(bf16, WS_WIN) + (size_t)l * UW * D, n0, sc, kb * 64, scr, F.lane); continue; }
        r -= I_IN;
        if (r < I_BR) { const int mi = r / 256, q = r % 256, kb = q / 32, nb = q % 32;
            p0_transpose_item(F.in[I_WBR] + (size_t)mi * 512 * 1024, 1024, 512, WSP(bf16, WS_WBR) + (size_t)mi * 1024 * 512, nb * 32, nb * 32, kb * 64, scr, F.lane); continue; }
        r -= I_BR;
        if (r < I_OUT) { const int l = r / 512, q = r % 512, kb = q / 32, nb = q % 32;
            p0_transpose_item(F.in[I_WOUT] + (size_t)l * D * D, D, D, WSP(bf16, WS_WOUT) + (size_t)l * D * D, nb * 32, nb * 32, kb * 64, scr, F.lane); continue; }
        r -= I_OUT;
        if (r < I_GU) { const int mi = r / 1024, q = r % 1024, kb = q / 64, nb = q % 64; const int j0 = nb * 32, pn = j0 >> 8, bj = (j0 >> 7) & 1, cc = j0 & 127;
            p0_transpose_item(F.in[I_WGU] + (size_t)mi * D * 2048, 2048, D, WSP(bf16, WS_WGU) + (size_t)mi * 2048 * D, j0, 1024 * bj + 128 * pn + cc, kb * 64, scr, F.lane); continue; }
        r -= I_GU;
        { const int mi = r / 512, q = r % 512, kb = q / 32, nb = q % 32;
            p0_transpose_item(F.in[I_WDN] + (size_t)mi * D * D, D, D, WSP(bf16, WS_WDN) + (size_t)mi * D * D, nb * 32, nb * 32, kb * 64, scr, F.lane); }
    }
    __syncthreads();
    {
        LAS float* sc = (LAS float*)F.lds;
        LAS float* part = sc + 5 * 1024;
        bool staged = false;
        for (int it = F.bid; it < DEPTH * 96; it += F.G) {
            if (!staged) {
                for (int i = F.tid; i < 5 * 1024; i += NT) { const int r = i >> 10, k = i & 1023; const float cv = r < 4 ? F.in[I_C][r * 1024 + k] : F.in[I_CCTX][k]; sc[i] = siluf_(cv); }
                __syncthreads(); staged = true;
            }
            const int l = it / 96, cg = it % 96, col = cg * 64 + F.lane;
            const float* wm = F.in[I_WMOD] + (size_t)l * D * 6144 + col;
            float a0 = 0.f, a1 = 0.f, a2 = 0.f, a3 = 0.f, a4 = 0.f;
            const int kb = F.wave * 128;
#pragma unroll 16
            for (int k = 0; k < 128; ++k) { const float w = wm[(size_t)(kb + k) * 6144];
                a0 += sc[kb + k] * w; a1 += sc[1024 + kb + k] * w; a2 += sc[2048 + kb + k] * w; a3 += sc[3072 + kb + k] * w; a4 += sc[4096 + kb + k] * w; }
            LAS float* pp = part + F.wave * 320 + F.lane;
            pp[0] = a0; pp[64] = a1; pp[128] = a2; pp[192] = a3; pp[256] = a4;
            __syncthreads();
            if (F.tid < 320) { const int r = F.tid >> 6, ln = F.tid & 63; float s = 0.f;
#pragma unroll
                for (int w = 0; w < 8; ++w) s += part[w * 320 + r * 64 + ln];
                const int cc = cg * 64 + ln;
                WSP(float, WS_MOD)[((size_t)l * 5 + r) * 6144 + cc] = s + F.in[I_BMOD][l * 6144 + cc]; }
            __syncthreads();
        }
    }
    if (F.bid == 0) {
        for (int i = F.tid; i < 1024; i += NT) { const int p = i >> 4, f = i & 15; const float inv = powf(10000.f, -(float)f / 16.f); const float ang = (float)p * inv;
            WSP(float, WS_ROPE)[i] = cosf(ang); WSP(float, WS_ROPE)[1024 + i] = sinf(ang); }
    }
    for (int i = F.bid * NT + F.tid; i < DEPTH * 2 * 2 * 8 * 4096; i += F.G * NT) {
        const int c = i & 63, d = (i >> 6) & 63, n = (i >> 12) & 7, gate = (i >> 15) & 1, ld = i >> 16;
        const float* src = gate ? F.in[I_BWI] : F.in[I_BWR];
        WSP(bf16, WS_LRUW)[i] = (bf16)f2bf(src[((size_t)ld * 8 + n) * 4096 + c * 64 + d]);
    }
}

template <int MODE>
__device__ __forceinline__ void norm_phase(Frame& F, int l) {
    LAS float* hs = (LAS float*)F.lds;
    LAS int* lcnt = (LAS int*)(F.lds + 65536);
    LAS int* lbase = lcnt + 32;
    const int ngroups = ((MODE == 2 || (MODE == 1 && l == DEPTH - 1)) ? TLAT : MROWS) / 16;
    const float* modl = WSP(float, WS_MOD) + (size_t)l * 5 * 6144;
    float pb0[32], pb1[32];
    if (MODE != 2) {
        REFRESH_TID(F);
        const int r16 = F.lane & 15, quad = F.lane >> 4, w = F.wave;
        const size_t stride = MODE == 0 ? (size_t)INW : (size_t)NEXP;
        const float* wp = (MODE == 0 ? F.in[I_WIN] + (size_t)l * D * INW + 3840 : F.in[I_WRT] + (size_t)l * D * NEXP) + (size_t)(128 * w + quad) * stride + r16;
#pragma unroll
        for (int s = 0; s < 32; ++s) { pb0[s] = wp[(size_t)(4 * s) * stride]; pb1[s] = MODE == 1 ? wp[(size_t)(4 * s) * stride + 16] : 0.f; }
    }
#pragma unroll 1
    for (int gi = F.bid; gi < ngroups; gi += F.G) {
        REFRESH_TID(F);
        if (MODE == 1) { if (F.tid < 32) lcnt[F.tid] = 0; }
#pragma unroll
        for (int i = 0; i < 2; ++i) {
            const int lr = 2 * F.wave + i, r = gi * 16 + lr, mr = mod_row(r);
            const float* xsrc;
            if (MODE == 0 && l == 0) xsrc = r < TLAT ? F.in[I_X] + (size_t)r * D : F.in[I_CTX] + (size_t)(r - TLAT) * D;
            else xsrc = WSP(float, WS_X) + (size_t)r * D;
            f32x4 v[4];
#pragma unroll
            for (int j = 0; j < 4; ++j) v[j] = *(const f32x4*)(xsrc + 4 * F.lane + 256 * j);
            if ((MODE == 0 && l > 0) || MODE == 2) {
                const int lp = MODE == 2 ? DEPTH - 1 : l - 1;
                const float* gt2 = WSP(float, WS_MOD) + ((size_t)lp * 5 + mr) * 6144 + 5120;
                f32x4 cb[4];
#pragma unroll
                for (int j = 0; j < 4; ++j) cb[j] = (f32x4){0.f, 0.f, 0.f, 0.f};
#pragma unroll
                for (int k = 0; k < 4; ++k) {
                    const int sr = WSP(int, WS_SROW)[r * 4 + k]; const float w = WSP(float, WS_SW)[r * 4 + k];
                    const bf16* yr = WSP(bf16, WS_YS) + (size_t)sr * D;
#pragma unroll
                    for (int j = 0; j < 4; ++j) { const v2u y = *(const v2u*)(yr + 4 * F.lane + 256 * j);
                        cb[j].x += w * bflo(y.x); cb[j].y += w * bfhi(y.x); cb[j].z += w * bflo(y.y); cb[j].w += w * bfhi(y.y); }
                }
#pragma unroll
                for (int j = 0; j < 4; ++j) { const f32x4 g = *(const f32x4*)(gt2 + 4 * F.lane + 256 * j); v[j] = v[j] + g * cb[j]; }
            }
            if (MODE == 0) {
#pragma unroll
                for (int j = 0; j < 4; ++j) *(f32x4*)(WSP(float, WS_X) + (size_t)r * D + 4 * F.lane + 256 * j) = v[j];
            }
            float ss = 0.f;
#pragma unroll
            for (int j = 0; j < 4; ++j) ss += (v[j].x * v[j].x + v[j].y * v[j].y) + (v[j].z * v[j].z + v[j].w * v[j].w);
            const float rstd = rsqrtf(wave_sum(ss) * (1.f / D) + EPS);
            if (MODE == 2) {
#pragma unroll
                for (int j = 0; j < 4; ++j) { const f32x4 g = *(const f32x4*)(F.in[I_GFIN] + 4 * F.lane + 256 * j);
                    *(f32x4*)(F.out + (size_t)r * D + 4 * F.lane + 256 * j) = v[j] * rstd * g; }
            } else {
                const float* gn = F.in[MODE == 0 ? I_G1 : I_G2] + l * D;
                const float* sh = modl + (size_t)mr * 6144 + (MODE == 0 ? 0 : 3072);
                const float* sc = sh + 1024;
#pragma unroll
                for (int j = 0; j < 4; ++j) { const int c0 = 4 * F.lane + 256 * j;
                    const f32x4 g = *(const f32x4*)(gn + c0), a = *(const f32x4*)(sh + c0), s = *(const f32x4*)(sc + c0);
                    const f32x4 h = (v[j] * rstd * g) * (s + 1.f) + a;
                    *(LAS f32x4*)(hs + lr * 1024 + c0) = h;
                    v2u o; o.x = pk2(h.x, h.y); o.y = pk2(h.z, h.w);
                    *(v2u*)(WSP(bf16, WS_H) + (size_t)r * D + c0) = o; }
            }
        }
        if (MODE == 2) continue;
        __syncthreads();
        LAS float* red = (LAS float*)(F.lds + 65536 + 256);
        {
            const int r16 = F.lane & 15, quad = F.lane >> 4, w = F.wave;
            const LAS float* hp = hs + r16 * 1024 + 128 * w + quad;
            f32x4 acc0 = (f32x4){0.f, 0.f, 0.f, 0.f}, acc1 = acc0;
#pragma unroll
            for (int s = 0; s < 32; ++s) { const float av = hp[4 * s];
                acc0 = __builtin_amdgcn_mfma_f32_16x16x4f32(av, pb0[s], acc0, 0, 0, 0);
                if (MODE == 1) acc1 = __builtin_amdgcn_mfma_f32_16x16x4f32(av, pb1[s], acc1, 0, 0, 0); }
#pragma unroll
            for (int j = 0; j < 4; ++j) { red[(w * 16 + 4 * quad + j) * 32 + r16] = acc0[j]; if (MODE == 1) red[(w * 16 + 4 * quad + j) * 32 + 16 + r16] = acc1[j]; }
        }
        __syncthreads();
        if (MODE == 0) {
            if (F.tid < 256) {
                const int lr = F.tid >> 4, col = F.tid & 15;
                float sacc = 0.f;
#pragma unroll
                for (int w = 0; w < 8; ++w) sacc += red[(w * 16 + lr) * 32 + col];
                WSP(float, WS_CAB)[(size_t)(gi * 16 + lr) * 16 + col] = sacc;
            }
        } else {
            const int lr = F.tid >> 5, e = F.tid & 31, r = gi * 16 + lr;
            float sacc = 0.f;
#pragma unroll
            for (int w = 0; w < 8; ++w) sacc += red[(w * 16 + lr) * 32 + e];
            const float lg = sacc + F.in[I_BRT][l * NEXP + e];
            float tv0, tv1, tv2, tv3; int ti0, ti1, ti2, ti3; bool taken = false;
#define TOP1(TV, TI) do { float bv = taken ? -INFINITY : lg; int bi = e; \
                _Pragma("unroll") for (int off = 16; off >= 1; off >>= 1) { const float ov = __shfl_xor(bv, off); const int oi = __shfl_xor(bi, off); \
                    if (ov > bv || (ov == bv && oi < bi)) { bv = ov; bi = oi; } } \
                TV = bv; TI = bi; if (bi == e) taken = true; } while (0)
            TOP1(tv0, ti0); TOP1(tv1, ti1); TOP1(tv2, ti2); TOP1(tv3, ti3);
#undef TOP1
            const float e1 = __expf(tv1 - tv0), e2 = __expf(tv2 - tv0), e3 = __expf(tv3 - tv0);
            const float inv = 1.f / (1.f + e1 + e2 + e3);
            const int my_e = e == 0 ? ti0 : (e == 1 ? ti1 : (e == 2 ? ti2 : ti3));
            const float my_w = e == 0 ? inv : (e == 1 ? e1 * inv : (e == 2 ? e2 * inv : e3 * inv));
            int pl = 0;
            if (e < 4) pl = atomicAdd((int*)&lcnt[my_e], 1);
            __syncthreads();
            if (F.tid < 32) { const int c = lcnt[F.tid]; lbase[F.tid] = c > 0 ? (int)__hip_atomic_fetch_add(F.ctl + CW_CNT + l * 32 + F.tid, (unsigned)c, __ATOMIC_RELAXED, __HIP_MEMORY_SCOPE_AGENT) : 0; }
            __syncthreads();
            if (e < 4) { const int p = lbase[my_e] + pl;
                WSP(int, WS_LIST)[(size_t)my_e * MROWS + p] = r * 4 + e;
                WSP(int, WS_SEP)[r * 4 + e] = (my_e << 20) | p;
                WSP(float, WS_SW)[r * 4 + e] = my_w; }
        }
        __syncthreads();
    }
}

__device__ __forceinline__ void moe_table(Frame& F, int l) {
    LAS int* tpre = (LAS int*)(F.lds + MISC_OFF + 256);
    LAS int* cnt = tpre + 40;
    __syncthreads();
    if (F.tid < 32) cnt[F.tid] = (int)__hip_atomic_load(F.ctl + CW_CNT + l * 32 + F.tid, __ATOMIC_RELAXED, __HIP_MEMORY_SCOPE_AGENT);
    __syncthreads();
    if (F.tid == 0) { int s = 0; for (int e = 0; e < 32; ++e) { tpre[e] = s; s += (cnt[e] + 255) >> 8; } tpre[32] = s; }
    __syncthreads();
}
__device__ __forceinline__ void moe_gather(Frame& F, int l) {
    moe_table(F, l);
    const LAS int* tpre = (const LAS int*)(F.lds + MISC_OFF + 256);
    const LAS int* cnt = tpre + 40;
    const int gw = F.bid * NWAVES + F.wave, NGW = F.G * NWAVES;
    REFRESH_TID(F);
    for (int e = 0; e < NEXP; ++e) {
        const int n = cnt[e], base = tpre[e] * 256;
        for (int p = gw; p < n; p += NGW) {
            const int tk = WSP(int, WS_LIST)[(size_t)e * MROWS + p]; const int tok = tk >> 2;
            const v4u* src = (const v4u*)(WSP(bf16, WS_H) + (size_t)tok * D);
            v4u* dst = (v4u*)(WSP(bf16, WS_HS) + (size_t)(base + p) * D);
            dst[F.lane] = src[F.lane]; dst[F.lane + 64] = src[F.lane + 64];
            if (F.lane == 0) WSP(int, WS_SROW)[tk] = base + p;
        }
    }
}

constexpr int AT_KP = 72, AT_VP = 68;
constexpr int AT_KB = 64 * AT_KP * 2, AT_VB = 64 * AT_VP * 2, AT_BUF = AT_KB + AT_VB;
constexpr int AT_RPB = 2 * AT_BUF;

__device__ __forceinline__ float max3f_(float a, float b, float c) { float r; asm("v_max3_f32 %0, %1, %2, %3" : "=v"(r) : "v"(a), "v"(b), "v"(c)); return r; }
struct AttnUnit {
    int kind;
    int b, hx, qx;
};

__device__ __forceinline__ void attn_unit(Frame& F, int l, const AttnUnit un) {
    REFRESH_TID(F);
    const int lane = F.lane, w = F.wave, q32 = lane & 31, hh = lane >> 5;
    const bf16* U = WSP(bf16, WS_U);
    const bool na = (un.kind & 1) != 0, ctxq = un.kind >= 2;
    const int b = un.b;
    int qrow0, qcol, kcol, ycol, nlat, krow_lat0, r_grid = 0, c0 = 0, rs_w = 0;
    const bf16* vt; bf16* Y;
    if (!na) {
        const int head = 4 * un.hx + (w & 3);
        qrow0 = (ctxq ? TLAT + b * LCTX : b * SEQ) + 64 * un.qx + 32 * (w >> 2);
        qcol = UQ + head * 64; kcol = UK + un.hx * 64; ycol = head * 64;
        vt = WSP(bf16, WS_VAT) + (size_t)(b * 2 + un.hx) * 64 * KEYS;
        Y = WSP(bf16, WS_Y);
        nlat = ctxq ? 0 : 64; krow_lat0 = b * SEQ;
    } else {
        const int head = un.hx;
        if (ctxq) { qrow0 = TLAT + b * LCTX + 32 * w; nlat = 0; krow_lat0 = 0; }
        else {
            r_grid = 4 * un.qx + (w >> 1); c0 = 32 * (w & 1);
            qrow0 = b * SEQ + 64 * r_grid + c0;
            int rs_min = 4 * un.qx - 4; rs_min = rs_min < 0 ? 0 : (rs_min > 56 ? 56 : rs_min);
            int rs_max = 4 * un.qx + 3 - 4; rs_max = rs_max < 0 ? 0 : (rs_max > 56 ? 56 : rs_max);
            nlat = rs_max + 8 - rs_min; krow_lat0 = b * SEQ + 64 * rs_min;
            rs_w = r_grid - 4; rs_w = rs_w < 0 ? 0 : (rs_w > 56 ? 56 : rs_w);
            rs_w -= rs_min;
        }
        qcol = UDQ + head * 64; kcol = UDK + head * 64; ycol = head * 64;
        vt = WSP(bf16, WS_VDT) + (size_t)(b * 8 + head) * 64 * KEYS;
        Y = WSP(bf16, WS_Y) + (size_t)3 * MROWS * 512;
    }
    const int vkey_lat0 = krow_lat0 - b * SEQ;
    const int ntile = nlat + 4;
    LAS unsigned char* lds = F.lds;
    if (na && !ctxq) {
        LAS float* rp = (LAS float*)(lds + AT_RPB);
        const float* src = F.in[I_RPB] + ((size_t)l * 8 + un.hx) * 465;
        for (int i = F.tid; i < 465; i += NT) rp[i] = src[i] * LOG2E;
    }
    bf16x8 qf[4];
    {
        const bf16* qp = U + (size_t)(qrow0 + q32) * UW + qcol + 8 * hh;
#pragma unroll
        for (int s = 0; s < 4; ++s) qf[s] = *(const bf16x8*)(qp + 16 * s);
        if (na) {
#pragma unroll
            for (int s = 0; s < 4; ++s) { v4u t = __builtin_bit_cast(v4u, qf[s]); const float sc = 0.125f * LOG2E;
                t.x = pk2(bflo(t.x) * sc, bfhi(t.x) * sc); t.y = pk2(bflo(t.y) * sc, bfhi(t.y) * sc); t.z = pk2(bflo(t.z) * sc, bfhi(t.z) * sc); t.w = pk2(bflo(t.w) * sc, bfhi(t.w) * sc);
                qf[s] = __builtin_bit_cast(bf16x8, t); }
        }
    }
    const int lk = F.tid >> 3, lc = F.tid & 7;
    v4u kr[4], vr[4];
#define AT_LOAD(st, i) do { const int i_ = (i) < ntile ? (i) : ntile - 1; int krow0_, vkey0_; \
        if (i_ < nlat) { krow0_ = krow_lat0 + 64 * i_; vkey0_ = vkey_lat0 + 64 * i_; } else { krow0_ = TLAT + b * LCTX + 64 * (i_ - nlat); vkey0_ = SEQ + 64 * (i_ - nlat); } \
        kr[st] = *(const v4u*)(U + (size_t)(krow0_ + lk) * UW + kcol + lc * 8); \
        vr[st] = *(const v4u*)(vt + (size_t)lk * KEYS + vkey0_ + lc * 8); } while (0)
#define AT_STORE(st, buf) do { LAS unsigned char* b_ = lds + (buf) * AT_BUF; \
        *(LAS v4u*)(b_ + lk * (AT_KP * 2) + lc * 16) = kr[st]; \
        *(LAS v2u*)(b_ + AT_KB + lk * (AT_VP * 2) + lc * 16) = (v2u){vr[st].x, vr[st].y}; \
        *(LAS v2u*)(b_ + AT_KB + lk * (AT_VP * 2) + lc * 16 + 8) = (v2u){vr[st].z, vr[st].w}; } while (0)
    float m_run = 0.f, l_run = 0.f;
    f32x16 negm;
#pragma unroll
    for (int i = 0; i < 16; ++i) negm[i] = 0.f;
    bool first = true;
    f32x16 o0, o1;
#pragma unroll
    for (int i = 0; i < 16; ++i) { o0[i] = 0.f; o1[i] = 0.f; }
    const float sscale = 0.125f * LOG2E;
    const int cq = c0 + q32;
    int cst = cq - 8; cst = cst < 0 ? 0 : (cst > 48 ? 48 : cst);
    AT_LOAD(0, 0); AT_LOAD(1, 1); AT_LOAD(2, 2); AT_LOAD(3, 3);
#pragma unroll 1
    for (int i0 = 0; i0 < ntile; i0 += 4) {
#pragma unroll
      for (int st = 0; st < 4; ++st) {
        const int i = i0 + st;
        if (i >= ntile) break;
        AT_STORE(st, i & 1);
        AT_LOAD(st, i + 4);
        lds_barrier();
        const bool lat_na = na && !ctxq && i < nlat;
        if (lat_na && (i < rs_w || i > rs_w + 7)) continue;
        const LAS unsigned char* kb = lds + (i & 1) * AT_BUF;
        const LAS unsigned char* vb = kb + AT_KB;
        f32x16 s0, s1;
#pragma unroll
        for (int s = 0; s < 4; ++s) {
            const bf16x8 k0 = *(const LAS bf16x8*)(kb + (q32) * (AT_KP * 2) + (16 * s + 8 * hh) * 2);
            const bf16x8 k1 = *(const LAS bf16x8*)(kb + (32 + q32) * (AT_KP * 2) + (16 * s + 8 * hh) * 2);
            s0 = __builtin_amdgcn_mfma_f32_32x32x16_bf16(k0, qf[s], s == 0 ? negm : s0, 0, 0, 0);
            s1 = __builtin_amdgcn_mfma_f32_32x32x16_bf16(k1, qf[s], s == 0 ? negm : s1, 0, 0, 0);
        }
        if (lat_na) {
            const LAS float* rp = (const LAS float*)(lds + AT_RPB);
            const int kr = (krow_lat0 - b * SEQ) / 64 + i;
            const int rb = (kr - r_grid + 7) * 31 + 15 - cq;
#pragma unroll
            for (int j = 0; j < 16; ++j) {
                const int kc0 = (j & 3) + 8 * (j >> 2) + 4 * hh, kc1 = kc0 + 32;
                const bool ok0 = kc0 >= cst && kc0 < cst + 16, ok1 = kc1 >= cst && kc1 < cst + 16;
                int i0 = rb + kc0, i1 = rb + kc1; i0 = i0 < 0 ? 0 : (i0 > 464 ? 464 : i0); i1 = i1 < 0 ? 0 : (i1 > 464 ? 464 : i1);
                const float b0 = rp[i0], b1 = rp[i1];
                s0[j] = ok0 ? s0[j] + b0 : -1e30f;
                s1[j] = ok1 ? s1[j] + b1 : -1e30f;
            }
        }
        float mx = max3f_(s0[0], s1[0], s0[1]);
        mx = max3f_(mx, s1[1], s0[2]); mx = max3f_(mx, s1[2], s0[3]); mx = max3f_(mx, s1[3], s0[4]); mx = max3f_(mx, s1[4], s0[5]); mx = max3f_(mx, s1[5], s0[6]);
        mx = max3f_(mx, s1[6], s0[7]); mx = max3f_(mx, s1[7], s0[8]); mx = max3f_(mx, s1[8], s0[9]); mx = max3f_(mx, s1[9], s0[10]); mx = max3f_(mx, s1[10], s0[11]);
        mx = max3f_(mx, s1[11], s0[12]); mx = max3f_(mx, s1[12], s0[13]); mx = max3f_(mx, s1[13], s0[14]); mx = max3f_(mx, s1[14], s0[15]); mx = fmaxf(mx, s1[15]);
        mx = fmaxf(mx, __shfl_xor(mx, 32));
        if (first || __builtin_amdgcn_ballot_w64(mx > 6.f) != 0ull) {
            const float d = first ? fmaxf(mx, -120.f) : fmaxf(mx, 0.f);
            const float alpha = __builtin_amdgcn_exp2f(-d);
            l_run *= alpha; m_run += d;
#pragma unroll
            for (int j = 0; j < 16; ++j) { o0[j] *= alpha; o1[j] *= alpha; s0[j] -= d; s1[j] -= d; negm[j] = -m_run; }
            first = false;
        }
        f32x2_t ps2 = {0.f, 0.f};
#pragma unroll
        for (int j = 0; j < 16; ++j) { s0[j] = __builtin_amdgcn_exp2f(s0[j]); s1[j] = __builtin_amdgcn_exp2f(s1[j]); ps2 += (f32x2_t){s0[j], s1[j]}; }
        l_run += ps2.x + ps2.y;
        bf16x8 pb[2][2];
#pragma unroll
        for (int s2 = 0; s2 < 2; ++s2) {
            v4u t0, t1;
            t0.x = pk2(s0[8 * s2 + 0], s0[8 * s2 + 1]); t0.y = pk2(s0[8 * s2 + 2], s0[8 * s2 + 3]); t0.z = pk2(s0[8 * s2 + 4], s0[8 * s2 + 5]); t0.w = pk2(s0[8 * s2 + 6], s0[8 * s2 + 7]);
            t1.x = pk2(s1[8 * s2 + 0], s1[8 * s2 + 1]); t1.y = pk2(s1[8 * s2 + 2], s1[8 * s2 + 3]); t1.z = pk2(s1[8 * s2 + 4], s1[8 * s2 + 5]); t1.w = pk2(s1[8 * s2 + 6], s1[8 * s2 + 7]);
            pb[0][s2] = __builtin_bit_cast(bf16x8, t0); pb[1][s2] = __builtin_bit_cast(bf16x8, t1);
        }
#pragma unroll
        for (int sub = 0; sub < 2; ++sub)
#pragma unroll
            for (int s2 = 0; s2 < 2; ++s2) {
                const int ko = (32 * sub + 16 * s2 + 4 * hh) * 2;
                const v2u a0 = *(const LAS v2u*)(vb + (q32) * (AT_VP * 2) + ko), a1 = *(const LAS v2u*)(vb + (q32) * (AT_VP * 2) + ko + 16);
                const v2u c0_ = *(const LAS v2u*)(vb + (32 + q32) * (AT_VP * 2) + ko), c1_ = *(const LAS v2u*)(vb + (32 + q32) * (AT_VP * 2) + ko + 16);
                const bf16x8 vf0 = __builtin_bit_cast(bf16x8, ((v4u){a0.x, a0.y, a1.x, a1.y}));
                const bf16x8 vf1 = __builtin_bit_cast(bf16x8, ((v4u){c0_.x, c0_.y, c1_.x, c1_.y}));
                o0 = __builtin_amdgcn_mfma_f32_32x32x16_bf16(vf0, pb[sub][s2], o0, 0, 0, 0);
                o1 = __builtin_amdgcn_mfma_f32_32x32x16_bf16(vf1, pb[sub][s2], o1, 0, 0, 0);
            }
      }
    }
#undef AT_LOAD
#undef AT_STORE
    const float lt = l_run + __shfl_xor(l_run, 32);
    const float inv = 1.f / lt;
    bf16* yp = Y + (size_t)(qrow0 + q32) * 512 + ycol + 4 * hh;
#pragma unroll
    for (int g = 0; g < 4; ++g) {
        v2u a; a.x = pk2(o0[4 * g] * inv, o0[4 * g + 1] * inv); a.y = pk2(o0[4 * g + 2] * inv, o0[4 * g + 3] * inv);
        v2u c; c.x = pk2(o1[4 * g] * inv, o1[4 * g + 1] * inv); c.y = pk2(o1[4 * g + 2] * inv, o1[4 * g + 3] * inv);
        *(v2u*)(yp + 8 * g) = a; *(v2u*)(yp + 32 + 8 * g) = c;
    }
    __syncthreads();
}

__device__ __forceinline__ void attn_phase(Frame& F, int l) {
    const int x = F.bid & 7, y = F.bid >> 3, ny = F.G >> 3;
    for (int q = y; q < 64; q += ny) { AttnUnit un; un.kind = 0; un.b = x >> 1; un.hx = x & 1; un.qx = q; attn_unit(F, l, un); }
    for (int q = y; q < 64; q += ny) { const int combo = x + 8 * (q >> 4); AttnUnit un; un.kind = 1; un.b = combo >> 3; un.hx = combo & 7; un.qx = q & 15; attn_unit(F, l, un); }
    for (int q = y; q < 8; q += ny) { AttnUnit un;
        if (q < 4) { un.kind = 2; un.b = x >> 1; un.hx = x & 1; un.qx = q; }
        else { const int combo = x + 8 * (q - 4); un.kind = 3; un.b = combo >> 3; un.hx = combo & 7; un.qx = 0; }
        attn_unit(F, l, un); }
}


__device__ __forceinline__ void qk_prep(Frame& F, int l) {
    REFRESH_TID(F);
    const int gw = F.bid * NWAVES + F.wave, NGW = F.G * NWAVES, lane = F.lane;
    bf16* U = WSP(bf16, WS_U);
    const float* tab = WSP(float, WS_ROPE);
    const int d0 = (lane & 7) * 8;
    float gq[8], gk[8];
#pragma unroll
    for (int j = 0; j < 8; ++j) { gq[j] = F.in[I_AGQ][l * 64 + d0 + j]; gk[j] = F.in[I_AGK][l * 64 + d0 + j]; }
    for (int r = gw; r < MROWS; r += NGW) {
        const bool lat = r < TLAT;
        bf16* up = U + (size_t)r * UW;
        const v4u qv = *(const v4u*)(up + UQ + lane * 8);
        v4u kv = (v4u){0u, 0u, 0u, 0u};
        if (lane < 16) kv = *(const v4u*)(up + UK + lane * 8);
        float cs[8], sn[8];
#pragma unroll
        for (int j = 0; j < 8; ++j) { cs[j] = 1.f; sn[j] = 0.f; }
        if (lat) { const int t = r & 4095;
#pragma unroll
            for (int j = 0; j < 8; ++j) { const int i = (d0 + j) & 31; const int idx = i < 16 ? (t >> 6) * 16 + i : (t & 63) * 16 + (i - 16); cs[j] = tab[idx]; sn[j] = tab[1024 + idx]; } }
#pragma unroll
        for (int which = 0; which < 2; ++which) {
            const v4u raw = which ? kv : qv;
            float x[8] = {bflo(raw.x), bfhi(raw.x), bflo(raw.y), bfhi(raw.y), bflo(raw.z), bfhi(raw.z), bflo(raw.w), bfhi(raw.w)};
            float ss = 0.f;
#pragma unroll
            for (int j = 0; j < 8; ++j) ss += x[j] * x[j];
            ss += __shfl_xor(ss, 1); ss += __shfl_xor(ss, 2); ss += __shfl_xor(ss, 4);
            const float rs = rsqrtf(ss * (1.f / 64.f) + EPS);
            float y[8];
#pragma unroll
            for (int j = 0; j < 8; ++j) y[j] = x[j] * rs * (which ? gk[j] : gq[j]);
            const bool hi = (lane & 4) != 0;
#pragma unroll
            for (int j = 0; j < 8; ++j) { const float p = __shfl_xor(y[j], 4);
                if (lat) y[j] = hi ? y[j] * cs[j] + p * sn[j] : y[j] * cs[j] - p * sn[j];
                if (!which) y[j] *= 0.125f * LOG2E; }
            v4u o; o.x = pk2(y[0], y[1]); o.y = pk2(y[2], y[3]); o.z = pk2(y[4], y[5]); o.w = pk2(y[6], y[7]);
            if (!which) *(v4u*)(up + UQ + lane * 8) = o; else if (lane < 16) *(v4u*)(up + UK + lane * 8) = o;
        }
    }
}

__device__ __forceinline__ void v_transpose(Frame& F) {
    REFRESH_TID(F);
    const int gw = F.bid * NWAVES + F.wave, NGW = F.G * NWAVES, lane = F.lane;
    LAS bf16* T = (LAS bf16*)(F.lds + F.wave * 9216);
    const bf16* U = WSP(bf16, WS_U);
    for (int it = gw; it < NCHUNK * 10; it += NGW) {
        const int g = it / 10, hd = it % 10;
        int b, key0;
        if (g < 256) { b = g >> 6; key0 = (g & 63) * 64; } else { b = (g - 256) >> 2; key0 = SEQ + ((g - 256) & 3) * 64; }
        const int scol = hd < 2 ? UV + hd * 64 : UDV + (hd - 2) * 64;
        bf16* dst = hd < 2 ? WSP(bf16, WS_VAT) + (size_t)(b * 2 + hd) * 64 * KEYS : WSP(bf16, WS_VDT) + (size_t)(b * 8 + hd - 2) * 64 * KEYS;
        v4u rv[8];
#pragma unroll
        for (int i = 0; i < 8; ++i) { const int tok = 8 * i + (lane >> 3), ch = lane & 7; rv[i] = *(const v4u*)(U + (size_t)(64 * g + tok) * UW + scol + ch * 8); }
#pragma unroll
        for (int i = 0; i < 8; ++i) { const int tok = 8 * i + (lane >> 3), ch = lane & 7; const unsigned wv[4] = {rv[i].x, rv[i].y, rv[i].z, rv[i].w};
#pragma unroll
            for (int j = 0; j < 4; ++j) { T[(ch * 8 + 2 * j) * 72 + tok] = (bf16)(wv[j] & 0xffffu); T[(ch * 8 + 2 * j + 1) * 72 + tok] = (bf16)(wv[j] >> 16); } }
        asm volatile("s_waitcnt lgkmcnt(0)" ::: "memory");
#pragma unroll
        for (int i = 0; i < 8; ++i) { const int d = 8 * i + (lane >> 3), ch = lane & 7;
            const v4u o = *(const LAS v4u*)(T + d * 72 + ch * 8);
            *(v4u*)(dst + (size_t)d * KEYS + key0 + ch * 8) = o; }
        asm volatile("s_waitcnt lgkmcnt(0)" ::: "memory");
    }
}

constexpr int LR_XCB = 0, LR_WV = 17408, LR_WVB = 12288;
__device__ __forceinline__ void seq_bounds(int g, int& lo, int& hi) {
    if (g < 256) { lo = (g >> 6) * SEQ; hi = lo + SEQ; } else { lo = TLAT + ((g - 256) >> 2) * LCTX; hi = lo + LCTX; }
}
struct LruRaw { v4u r[3]; };
__device__ __forceinline__ void lru_raw_load(Frame& F, LruRaw& R, int g, int q) {
    const bf16* U = WSP(bf16, WS_U);
    int lo, hi; seq_bounds(g, lo, hi);
#pragma unroll
    for (int k = 0; k < 3; ++k) { const int i = F.tid + NT * k, rr = i >> 4, ch = i & 15, row = 64 * g - 1 + rr;
        v4u v = (v4u){0u, 0u, 0u, 0u};
        if (i < 67 * 16 && row >= lo && row < hi) v = *(const v4u*)(U + (size_t)row * UW + UBX + 128 * q + ch * 8);
        R.r[k] = v; }
}
__device__ __forceinline__ void lru_stage_conv(Frame& F, int l, const LruRaw& R, int q) {
    LAS bf16* raw = (LAS bf16*)(F.lds + LR_WV);
    LAS bf16* xcb = (LAS bf16*)(F.lds + LR_XCB);
    __syncthreads();
#pragma unroll
    for (int k = 0; k < 3; ++k) { const int i = F.tid + NT * k, rr = i >> 4, ch = i & 15; if (i < 67 * 16) *(LAS v4u*)(raw + rr * 128 + ch * 8) = R.r[k]; }
    __syncthreads();
    {
        const int ch = F.tid & 127, tg = F.tid >> 7, cabs = 128 * q + ch;
        const float* cw = F.in[I_BCW] + (size_t)l * 4 * 512 + cabs;
        const float w0 = cw[0], w1 = cw[512], w2 = cw[1024], w3 = cw[1536], bb = F.in[I_BCB][l * 512 + cabs];
        float x0 = bf2f(raw[(16 * tg) * 128 + ch]), x1 = bf2f(raw[(16 * tg + 1) * 128 + ch]), x2 = bf2f(raw[(16 * tg + 2) * 128 + ch]);
#pragma unroll
        for (int t = 0; t < 16; ++t) { const float x3 = bf2f(raw[(16 * tg + t + 3) * 128 + ch]);
            const float y = bb + w0 * x0 + w1 * x1 + w2 * x2 + w3 * x3;
            xcb[(16 * tg + t) * 136 + ch] = (bf16)f2bf(y);
            x0 = x1; x1 = x2; x2 = x3; }
    }
    __syncthreads();
}
struct LruW { bf16x8 br0, br1, bi0, bi1; float bR, bI, lam; };
__device__ __forceinline__ void lru_w_load(Frame& F, LruW& W, int l, int dir, int q) {
    const int lane = F.lane, w = F.wave, r16 = lane & 15, quad = lane >> 4;
    const int nbl = w >> 2, dt = w & 3, nb = 2 * q + nbl;
    const bf16* wr = WSP(bf16, WS_LRUW) + ((((size_t)(l * 2 + dir) * 2 + 0) * 8 + nb) * 64 + 16 * dt + r16) * 64 + 8 * quad;
    const bf16* wi = WSP(bf16, WS_LRUW) + ((((size_t)(l * 2 + dir) * 2 + 1) * 8 + nb) * 64 + 16 * dt + r16) * 64 + 8 * quad;
    W.br0 = *(const bf16x8*)wr; W.br1 = *(const bf16x8*)(wr + 32); W.bi0 = *(const bf16x8*)wi; W.bi1 = *(const bf16x8*)(wi + 32);
    const int cabs = 64 * nb + 16 * dt + r16;
    W.bR = F.in[I_BBR][(l * 2 + dir) * 512 + cabs]; W.bI = F.in[I_BBI][(l * 2 + dir) * 512 + cabs]; W.lam = F.in[I_BLAM][(l * 2 + dir) * 512 + cabs];
}
__device__ __forceinline__ void lru_gates(Frame& F, const LruW& W) {
    const int lane = F.lane, w = F.wave, r16 = lane & 15, quad = lane >> 4;
    const LAS bf16* xcb = (const LAS bf16*)(F.lds + LR_XCB);
    LAS float* sa = (LAS float*)(F.lds + LR_WV + w * LR_WVB);
    LAS float* sb = sa + 1024;
    const int nbl = w >> 2, dt = w & 3;
    const int cl = 64 * nbl + 16 * dt + r16;
    const float sp = softplusf_(-W.lam);
#pragma unroll
    for (int tt = 0; tt < 4; ++tt) {
        const LAS bf16* ap = xcb + (16 * tt + r16) * 136 + 64 * nbl + 8 * quad;
        const bf16x8 a0 = *(const LAS bf16x8*)ap, a1 = *(const LAS bf16x8*)(ap + 32);
        f32x4 ar = (f32x4){0.f, 0.f, 0.f, 0.f}, ai = ar;
        ar = __builtin_amdgcn_mfma_f32_16x16x32_bf16(a0, W.br0, ar, 0, 0, 0); ar = __builtin_amdgcn_mfma_f32_16x16x32_bf16(a1, W.br1, ar, 0, 0, 0);
        ai = __builtin_amdgcn_mfma_f32_16x16x32_bf16(a0, W.bi0, ai, 0, 0, 0); ai = __builtin_amdgcn_mfma_f32_16x16x32_bf16(a1, W.bi1, ai, 0, 0, 0);
#pragma unroll
        for (int j = 0; j < 4; ++j) { const int t = 16 * tt + 4 * quad + j;
            const float rg = sigmoidf_(ar[j] + W.bR), ig = sigmoidf_(ai[j] + W.bI);
            const float la = -8.f * rg * sp;
            const float a = __expf(la), x2 = 2.f * la;
            const float om = x2 > -0.05f ? -x2 * (1.f + x2 * (0.5f + x2 * (0.16666667f + x2 * 0.041666668f))) : 1.f - __expf(x2);
            const float mult = __builtin_amdgcn_sqrtf(om);
            const float xv = bf2f(xcb[t * 136 + cl]);
            sa[t * 16 + r16] = a; sb[t * 16 + r16] = mult * ig * xv; }
    }
    asm volatile("s_waitcnt lgkmcnt(0)" ::: "memory");
}
__device__ __forceinline__ void lru_pass1(Frame& F, int l) {
    const bool even = F.G == 256;
    const int nit = even ? (F.bid < 64 ? 2 : 5) : (NCHUNK * 4 - F.bid + F.G - 1) / F.G;
#define LRU1_ITEM(k) (even ? (F.bid < 64 ? F.bid + 64 * (k) : 128 + (F.bid - 64) * 5 + (k)) : F.bid + F.G * (k))
    LruRaw R; REFRESH_TID(F);
    if (nit > 0) { const int i0 = LRU1_ITEM(0); lru_raw_load(F, R, i0 >> 2, i0 & 3); }
#pragma unroll 1
    for (int kk = 0; kk < nit; ++kk) {
        const int it = LRU1_ITEM(kk);
        REFRESH_TID(F);
        const int g = it >> 2, q = it & 3;
        LruW W0, W1; lru_w_load(F, W0, l, 0, q); lru_w_load(F, W1, l, 1, q);
        lru_stage_conv(F, l, R, q);
        { const int itn = kk + 1 < nit ? LRU1_ITEM(kk + 1) : it; lru_raw_load(F, R, itn >> 2, itn & 3); }
#pragma unroll
        for (int dir = 0; dir < 2; ++dir) {
            lru_gates(F, dir ? W1 : W0);
            const int lane = F.lane, w = F.wave, ch = lane & 15, seg = lane >> 4;
            const LAS float* sa = (const LAS float*)(F.lds + LR_WV + w * LR_WVB); const LAS float* sb = sa + 1024;
            float A = 1.f, B = 0.f;
#pragma unroll
            for (int k = 0; k < 16; ++k) { const int tp = 16 * seg + k, t = dir ? 63 - tp : tp; const float a = sa[t * 16 + ch]; B = a * B + sb[t * 16 + ch]; A *= a; }
            float At = 1.f, Bt = 0.f;
#pragma unroll
            for (int s = 0; s < 4; ++s) { const float As = __shfl(A, 16 * s + ch), Bs = __shfl(B, 16 * s + ch); Bt = As * Bt + Bs; At *= As; }
            if (seg == 0) { const int cabs = 128 * q + 64 * (w >> 2) + 16 * (w & 3) + ch;
                WSP(float, WS_LRA)[((size_t)g * 2 + dir) * 512 + cabs] = At; WSP(float, WS_LRB)[((size_t)g * 2 + dir) * 512 + cabs] = Bt; }
            asm volatile("s_waitcnt lgkmcnt(0)" ::: "memory");
        }
    }
}
__device__ __forceinline__ void lru_carry_all(Frame& F) {
    REFRESH_TID(F);
    if (F.tid >= 16) return;
    const float* LA = WSP(float, WS_LRA); const float* LB = WSP(float, WS_LRB); float* LC = WSP(float, WS_LRC);
    for (int chain = F.bid * 16 + F.tid; chain < 4096; chain += F.G * 16) {
        const int ch = chain & 511, dir = (chain >> 9) & 1, b = chain >> 10;
        float h = 0.f;
#pragma unroll 1
        for (int sb = 0; sb < 4; ++sb) {
            float av[17], bv[17]; size_t ix[17];
#pragma unroll
            for (int k = 0; k < 17; ++k) { const int s = sb * 17 + k; int g;
                if (s < 4) g = 256 + 4 * b + (dir ? 3 - s : s); else g = 64 * b + (dir ? 63 - (s - 4) : (s - 4));
                ix[k] = ((size_t)g * 2 + dir) * 512 + ch; av[k] = LA[ix[k]]; bv[k] = LB[ix[k]]; }
#pragma unroll
            for (int k = 0; k < 17; ++k) { LC[ix[k]] = h; h = av[k] * h + bv[k]; }
        }
    }
}
__device__ __forceinline__ float gelu_tanh(float x) { const float u = 0.7978845608028654f * (x + 0.044715f * x * x * x); return x / (1.f + __expf(-2.f * u)); }
__device__ __forceinline__ void lru_pass2(Frame& F, int l) {
    int it = F.bid;
    const int nitems = (l == DEPTH - 1 ? 256 : NCHUNK) * 4;
    LruRaw R; REFRESH_TID(F);
    if (it < nitems) lru_raw_load(F, R, it >> 2, it & 3);
#pragma unroll 1
    for (; it < nitems; it += F.G) {
        REFRESH_TID(F);
        const int g = it >> 2, q = it & 3;
        const int lane = F.lane, w = F.wave, ch = lane & 15, seg = lane >> 4;
        const int cabs = 128 * q + 64 * (w >> 2) + 16 * (w & 3) + ch;
        const bf16* U = WSP(bf16, WS_U); bf16* YB = WSP(bf16, WS_Y) + (size_t)1 * MROWS * 512;
        LruW W0, W1; lru_w_load(F, W0, l, 0, q); lru_w_load(F, W1, l, 1, q);
        const float hc0 = WSP(float, WS_LRC)[((size_t)g * 2 + 0) * 512 + cabs], hc1 = WSP(float, WS_LRC)[((size_t)g * 2 + 1) * 512 + cabs];
        unsigned yraw[16];
#pragma unroll
        for (int k = 0; k < 16; ++k) yraw[k] = U[((size_t)64 * g + 16 * seg + k) * UW + UBY + cabs];
        lru_stage_conv(F, l, R, q);
        { const int itn = it + F.G < nitems ? it + F.G : it; lru_raw_load(F, R, itn >> 2, itn & 3); }
        LAS float* sa = (LAS float*)(F.lds + LR_WV + w * LR_WVB); LAS float* sb = sa + 1024; LAS float* sh = sa + 2048;
#pragma unroll
        for (int dir = 0; dir < 2; ++dir) {
            lru_gates(F, dir ? W1 : W0);
            float A = 1.f, B = 0.f;
#pragma unroll
            for (int k = 0; k < 16; ++k) { const int tp = 16 * seg + k, t = dir ? 63 - tp : tp; const float a = sa[t * 16 + ch]; B = a * B + sb[t * 16 + ch]; A *= a; }
            float h = dir ? hc1 : hc0;
#pragma unroll
            for (int s = 0; s < 3; ++s) { const float As = __shfl(A, 16 * s + ch), Bs = __shfl(B, 16 * s + ch); if (s < seg) h = As * h + Bs; }
#pragma unroll
            for (int k = 0; k < 16; ++k) { const int tp = 16 * seg + k, t = dir ? 63 - tp : tp; h = sa[t * 16 + ch] * h + sb[t * 16 + ch];
                if (dir == 0) sh[t * 16 + ch] = h; else sh[t * 16 + ch] += h; }
            asm volatile("s_waitcnt lgkmcnt(0)" ::: "memory");
        }
#pragma unroll
        for (int k = 0; k < 16; ++k) { const int t = 16 * seg + k; const size_t row = (size_t)64 * g + t;
            YB[row * 512 + cabs] = (bf16)f2bf(sh[t * 16 + ch] * gelu_tanh(bflo(yraw[k]))); }
        asm volatile("s_waitcnt lgkmcnt(0)" ::: "memory");
    }
}

#ifndef GDN_PREP_REPS
#define GDN_PREP_REPS 1
#endif
#ifdef PROBE_SUB
#define GP_T(k) do { if (PROBE_SUB == (k) && F.bid == 0) { const unsigned long long n_ = __builtin_amdgcn_s_memrealtime(); F.pr += n_ - gp_t; } gp_t = __builtin_amdgcn_s_memrealtime(); } while (0)
#else
#define GP_T(k) do { } while (0)
#endif
constexpr int GD_CW = MISC_OFF + 2048;
constexpr int GD_Q = 0, GD_K = 17408, GD_V = 34816, GD_KK = 52224, GD_QK = 68864, GD_L = 85504, GD_SM = 118272;
__device__ __forceinline__ void gdn_prep(Frame& F, int l) {
    const bf16* U = WSP(bf16, WS_U);
    const int w = F.wave;
    __syncthreads();
    for (int i = F.tid; i < 4 * 1536 / 2; i += NT) { const float* cw = F.in[I_CCW] + (size_t)l * 4 * 1536 + 2 * i; ((LAS unsigned*)(F.lds + GD_CW))[i] = pk2(cw[0], cw[1]); }
    __syncthreads();
#pragma unroll 1
    for (int it0 = F.bid; it0 < NCHUNK * 4 * GDN_PREP_REPS; it0 += F.G) {
        const int it = it0 % (NCHUNK * 4);
        int tid = F.tid; asm volatile("" : "+v"(tid));
        const int lane = tid & 63, r16 = lane & 15, quad = lane >> 4;
        const int g = it >> 2, h = it & 3;
        int lo, hi; seq_bounds(g, lo, hi);
        LAS bf16* raw = (LAS bf16*)(F.lds + GD_KK);
#ifdef PROBE_SUB
        unsigned long long gp_t = __builtin_amdgcn_s_memrealtime();
#endif
        __syncthreads();
        for (int i = tid; i < 3 * 67 * 16; i += NT) { const int ten = i / 1072, r_ = i - ten * 1072, rr = r_ >> 4, ch = r_ & 15, row = 64 * g - 1 + rr;
            const int ucol = (ten == 0 ? UCQ : (ten == 1 ? UCK : UCV)) + 128 * h;
            v4u v = (v4u){0u, 0u, 0u, 0u};
            if (row >= lo && row < hi) v = *(const v4u*)(U + (size_t)row * UW + ucol + ch * 8);
            *(LAS v4u*)(raw + ten * (67 * 128) + rr * 128 + ch * 8) = v; }
        __syncthreads();
#pragma unroll 1
        for (int ten = 0; ten < 3; ++ten) {
            const int t = tid >> 3, ds = tid & 7;
            const LAS bf16* rawt = raw + ten * (67 * 128);
            const LAS bf16* cwl = (const LAS bf16*)(F.lds + GD_CW) + ten * 512 + 128 * h + 16 * ds;
            float y[16]; float ss = 0.f;
            {
                float xin[4][16], wv_[4][16];
#pragma unroll
                for (int j = 0; j < 4; ++j) { const v4u r0 = *(const LAS v4u*)(rawt + (t + j) * 128 + 16 * ds), r1 = *(const LAS v4u*)(rawt + (t + j) * 128 + 16 * ds + 8);
                    const v4u w0 = *(const LAS v4u*)(cwl + j * 1536), w1 = *(const LAS v4u*)(cwl + j * 1536 + 8);
                    const unsigned rv[8] = {r0.x, r0.y, r0.z, r0.w, r1.x, r1.y, r1.z, r1.w}, wq[8] = {w0.x, w0.y, w0.z, w0.w, w1.x, w1.y, w1.z, w1.w};
#pragma unroll
                    for (int q = 0; q < 8; ++q) { xin[j][2 * q] = bflo(rv[q]); xin[j][2 * q + 1] = bfhi(rv[q]); wv_[j][2 * q] = bflo(wq[q]); wv_[j][2 * q + 1] = bfhi(wq[q]); } }
#pragma unroll
                for (int jj = 0; jj < 16; ++jj) {
                    float a = 0.f;
#pragma unroll
                    for (int j = 0; j < 4; ++j) a += wv_[j][jj] * xin[j][jj];
                    a = siluf_(a); y[jj] = a; ss += a * a;
                }
            }
            float sc = 1.f;
            if (ten < 2) { ss += __shfl_xor(ss, 1); ss += __shfl_xor(ss, 2); ss += __shfl_xor(ss, 4); sc = rsqrtf(ss + EPS); if (ten == 0) sc *= 0.08838834764831845f; }
            LAS bf16* dstp = (LAS bf16*)(F.lds + (ten == 0 ? GD_Q : (ten == 1 ? GD_K : GD_V))) + t * 136 + 16 * ds;
            v4u o0, o1;
            o0.x = pk2(y[0] * sc, y[1] * sc); o0.y = pk2(y[2] * sc, y[3] * sc); o0.z = pk2(y[4] * sc, y[5] * sc); o0.w = pk2(y[6] * sc, y[7] * sc);
            o1.x = pk2(y[8] * sc, y[9] * sc); o1.y = pk2(y[10] * sc, y[11] * sc); o1.z = pk2(y[12] * sc, y[13] * sc); o1.w = pk2(y[14] * sc, y[15] * sc);
            *(LAS v4u*)dstp = o0; *(LAS v4u*)(dstp + 8) = o1;
        }
        __syncthreads();
        const LAS bf16* qs = (const LAS bf16*)(F.lds + GD_Q); const LAS bf16* ks = (const LAS bf16*)(F.lds + GD_K); const LAS bf16* vs = (const LAS bf16*)(F.lds + GD_V);
        GP_T(20);
        {
            const int mat = w >> 2, rt = w & 3;
            const LAS bf16* As = mat ? qs : ks;
            LAS float* Out = (LAS float*)(F.lds + (mat ? GD_QK : GD_KK));
            bf16x8 af[4];
#pragma unroll
            for (int s = 0; s < 4; ++s) af[s] = *(const LAS bf16x8*)(As + (16 * rt + r16) * 136 + 32 * s + 8 * quad);
#pragma unroll
            for (int ct = 0; ct < 4; ++ct) {
                f32x4 acc = (f32x4){0.f, 0.f, 0.f, 0.f};
#pragma unroll
                for (int s = 0; s < 4; ++s) { const bf16x8 bfr = *(const LAS bf16x8*)(ks + (16 * ct + r16) * 136 + 32 * s + 8 * quad);
                    acc = __builtin_amdgcn_mfma_f32_16x16x32_bf16(af[s], bfr, acc, 0, 0, 0); }
#pragma unroll
                for (int j = 0; j < 4; ++j) Out[(16 * rt + 4 * quad + j) * 65 + 16 * ct + r16] = acc[j];
            }
        }
        GP_T(21);
        int tid2 = F.tid; asm volatile("" : "+v"(tid2));
        const int dir = tid2 >> 8, dt = tid2 & 255;
        LAS float* sm = (LAS float*)(F.lds + GD_SM) + dir * 256;
        if (dt < 64) {
            const int ti = dir ? 63 - dt : dt; const size_t row = (size_t)64 * g + ti;
            const float ga = WSP(float, WS_CAB)[row * 16 + dir * 4 + h], gb = WSP(float, WS_CAB)[row * 16 + 8 + dir * 4 + h];
            const float gv = -__expf(F.in[I_CALOG][(l * 2 + dir) * 4 + h]) * softplusf_(ga + F.in[I_CDTB][(l * 2 + dir) * 4 + h]);
            float v = gv;
#pragma unroll
            for (int off = 1; off < 64; off <<= 1) { const float u = __builtin_bit_cast(float, __builtin_amdgcn_ds_bpermute(((lane - off) & 63) << 2, __builtin_bit_cast(int, v))); if (lane >= off) v += u; }
            sm[dt] = gv; sm[64 + dt] = sigmoidf_(gb); sm[128 + dt] = v; sm[192 + dt] = __expf(v);
        }
        __syncthreads();
        size_t cd;
        { int bq, cq_, stp; if (g < 256) { bq = g >> 6; cq_ = g & 63; stp = 4 + (dir ? 63 - cq_ : cq_); } else { bq = (g - 256) >> 2; cq_ = (g - 256) & 3; stp = dir ? 3 - cq_ : cq_; }
          cd = ((size_t)((bq * 4 + h) * 2 + dir)) * 68 + stp; }
        const LAS float* KK = (const LAS float*)(F.lds + GD_KK); const LAS float* QKm = (const LAS float*)(F.lds + GD_QK);
        LAS float* Ls = (LAS float*)(F.lds + GD_L) + dir * 4096;
        {
            bf16* gqk = WSP(bf16, WS_GQK) + cd * 4096;
            for (int idx = dt; idx < 4096; idx += 256) { const int i = idx >> 6, j = idx & 63; const int ti = dir ? 63 - i : i, tj = dir ? 63 - j : j;
                const float dec = j <= i ? __expf(sm[128 + i] - sm[128 + j]) : 0.f;
                Ls[idx] = j < i ? sm[64 + i] * KK[ti * 65 + tj] * dec : 0.f;
                gqk[idx] = (bf16)f2bf(QKm[ti * 65 + tj] * dec); }
        }
        __syncthreads();
        GP_T(22);
        if (F.tid < 256) {
            f32x2_t X[64];
            int ct_ = F.tid; asm volatile("" : "+v"(ct_));
            const int sdir = ct_ >> 7, cp = ct_ & 127;
            const LAS float* sms = (const LAS float*)(F.lds + GD_SM) + sdir * 256;
            const LAS float* Lss = (const LAS float*)(F.lds + GD_L) + sdir * 4096;
            size_t cds;
            { int bq, cq_, stp; if (g < 256) { bq = g >> 6; cq_ = g & 63; stp = 4 + (sdir ? 63 - cq_ : cq_); } else { bq = (g - 256) >> 2; cq_ = (g - 256) & 3; stp = sdir ? 3 - cq_ : cq_; }
              cds = ((size_t)((bq * 4 + h) * 2 + sdir)) * 68 + stp; }
            bf16* outp = WSP(bf16, WS_GW) + cds * 8192 + cp;
#pragma unroll
            for (int i = 0; i < 64; ++i) {
                const int ti = sdir ? 63 - i : i;
                const float be = sms[64 + i];
                f32x2_t a = {be * bf2f(vs[ti * 136 + cp]), be * sms[192 + i] * bf2f(ks[ti * 136 + cp])};
                f32x2_t p0 = {0.f, 0.f}, p1 = p0, p2 = p0, p3 = p0;
#pragma unroll
                for (int j = 0; j < i; ++j) { const float lv = Lss[i * 64 + j]; if ((j & 3) == 0) p0 += X[j] * lv; else if ((j & 3) == 1) p1 += X[j] * lv; else if ((j & 3) == 2) p2 += X[j] * lv; else p3 += X[j] * lv; }
                a -= (p0 + p1) + (p2 + p3);
                X[i] = a;
                outp[i * 128] = (bf16)f2bf(a.y);
                asm volatile("" ::: "memory");
            }
            v4u* up = (v4u*)(WSP(bf16, WS_GU) + cds * 8192 + (size_t)cp * 64);
#pragma unroll
            for (int q8 = 0; q8 < 8; ++q8) { v4u o; o.x = pk2(X[8 * q8].x, X[8 * q8 + 1].x); o.y = pk2(X[8 * q8 + 2].x, X[8 * q8 + 3].x); o.z = pk2(X[8 * q8 + 4].x, X[8 * q8 + 5].x); o.w = pk2(X[8 * q8 + 6].x, X[8 * q8 + 7].x); up[q8] = o; }
        }
        GP_T(23);
        {
            bf16* gqg = WSP(bf16, WS_GQG) + cd * 8192; bf16* gkd = WSP(bf16, WS_GKD) + cd * 8192;
            const float gl = sm[128 + 63];
            for (int idx = dt; idx < 8192; idx += 256) { const int i = idx >> 7, d = idx & 127; const int ti = dir ? 63 - i : i;
                gqg[idx] = (bf16)f2bf(bf2f(qs[ti * 136 + d]) * sm[192 + i]); }
            { const int i = dt & 63; const int ti = dir ? 63 - i : i; const float fk = __expf(gl - sm[128 + i]);
              for (int idx = dt; idx < 8192; idx += 256) { const int d = idx >> 6; gkd[idx] = (bf16)f2bf(bf2f(ks[ti * 136 + d]) * fk); } }
            if (dt == 0) WSP(float, WS_GGL)[cd] = __expf(gl);
        }
        GP_T(24);
    }
    __syncthreads();
}

constexpr int GS_ST = 0, GS_VN = 4352, GS_O = 8192;
struct GdnOps { bf16x8 a[4]; bf16x8 qk[2]; bf16x8 kd[2]; v2u uv; float gl; };
__device__ __forceinline__ bf16x8 ld16_asm(const void* p) { bf16x8 v; asm volatile("global_load_dwordx4 %0, %1, off" : "=v"(v) : "v"(p) : "memory"); return v; }
__device__ __forceinline__ v2u ld8_asm(const void* p) { v2u v; asm volatile("global_load_dwordx2 %0, %1, off" : "=v"(v) : "v"(p) : "memory"); return v; }
__device__ __forceinline__ float ld4_asm(const void* p) { float v; asm volatile("global_load_dword %0, %1, off" : "=v"(v) : "v"(p) : "memory"); return v; }
__device__ __forceinline__ void gdn_load_asm(Frame& F, GdnOps& o, size_t cd, int sl) {
    const int lane = F.lane, w = F.wave, r16 = lane & 15, quad = lane >> 4, rt = w & 3;
    const bf16* ap = (w < 4 ? WSP(bf16, WS_GW) : WSP(bf16, WS_GQG)) + cd * 8192 + (size_t)(16 * rt + r16) * 128 + 8 * quad;
#pragma unroll
    for (int s = 0; s < 4; ++s) o.a[s] = ld16_asm(ap + 32 * s);
    const bf16* kp = WSP(bf16, WS_GKD) + cd * 8192 + (size_t)(16 * w + r16) * 64 + 8 * quad;
    o.kd[0] = ld16_asm(kp); o.kd[1] = ld16_asm(kp + 32);
    const bf16* qp = WSP(bf16, WS_GQK) + cd * 4096 + (size_t)(16 * rt + r16) * 64 + 8 * quad;
    o.qk[0] = ld16_asm(qp); o.qk[1] = ld16_asm(qp + 32);
    o.uv = ld8_asm(WSP(bf16, WS_GU) + cd * 8192 + (size_t)(16 * sl + r16) * 64 + 16 * rt + 4 * quad);
    o.gl = ld4_asm(WSP(float, WS_GGL) + cd);
}
__device__ __forceinline__ void gdn_load(Frame& F, GdnOps& o, size_t cd, int sl) {
    const int lane = F.lane, w = F.wave, r16 = lane & 15, quad = lane >> 4, rt = w & 3;
    const bf16* ap = (w < 4 ? WSP(bf16, WS_GW) : WSP(bf16, WS_GQG)) + cd * 8192 + (size_t)(16 * rt + r16) * 128 + 8 * quad;
#pragma unroll
    for (int s = 0; s < 4; ++s) o.a[s] = *(const bf16x8*)(ap + 32 * s);
    const bf16* kp = WSP(bf16, WS_GKD) + cd * 8192 + (size_t)(16 * w + r16) * 64 + 8 * quad;
    o.kd[0] = *(const bf16x8*)kp; o.kd[1] = *(const bf16x8*)(kp + 32);
    { const bf16* qp = WSP(bf16, WS_GQK) + cd * 4096 + (size_t)(16 * rt + r16) * 64 + 8 * quad; o.qk[0] = *(const bf16x8*)qp; o.qk[1] = *(const bf16x8*)(qp + 32); }
    o.uv = *(const v2u*)(WSP(bf16, WS_GU) + cd * 8192 + (size_t)(16 * sl + r16) * 64 + 16 * rt + 4 * quad);
    o.gl = WSP(float, WS_GGL)[cd];
}
__device__ __forceinline__ size_t gdn_cd(int b, int h, int dir, int s) { return ((size_t)((b * 4 + h) * 2 + dir)) * 68 + s; }
__device__ __forceinline__ int gdn_g(int b, int dir, int s) {
    return s < 4 ? 256 + 4 * b + (dir ? 3 - s : s) : 64 * b + (dir ? 63 - (s - 4) : (s - 4)); }
__device__ __forceinline__ void gdn_scan(Frame& F, int chain) {
    REFRESH_TID(F);
    const int xq = chain & 7, yq = chain >> 3, cg = (yq >> 3) * 8 + xq, sl = yq & 7;
    const int dir = cg & 1, h = (cg >> 1) & 3, b = cg >> 3;
    const int lane = F.lane, w = F.wave, r16 = lane & 15, quad = lane >> 4, rt = w & 3;
    LAS bf16* St = (LAS bf16*)(F.lds + GS_ST); LAS bf16* VNt = (LAS bf16*)(F.lds + GS_VN);
    __syncthreads();
    for (int i = F.tid; i < (GS_VN + 2304) / 4; i += NT) ((LAS unsigned*)F.lds)[i] = 0u;
    __syncthreads();
    f32x4 sacc = (f32x4){0.f, 0.f, 0.f, 0.f};
    float* GO = WSP(float, WS_GO) + (size_t)dir * MROWS * 512;
    LAS float* Ost = (LAS float*)(F.lds + GS_O);
#define GDN_STEP(cur, s_) do { \
          \
        asm volatile("s_waitcnt vmcnt(30)" : "+v"(cur.a[0]), "+v"(cur.a[1]), "+v"(cur.a[2]), "+v"(cur.a[3]), "+v"(cur.kd[0]), "+v"(cur.kd[1]), "+v"(cur.qk[0]), "+v"(cur.qk[1]), "+v"(cur.uv), "+v"(cur.gl) :: "memory"); \
        bf16x8 sbf[4]; \
        _Pragma("unroll") for (int ks = 0; ks < 4; ++ks) sbf[ks] = *(const LAS bf16x8*)(St + r16 * 136 + 32 * ks + 8 * quad); \
        f32x4 acc = (f32x4){0.f, 0.f, 0.f, 0.f}; \
        _Pragma("unroll") for (int ks = 0; ks < 4; ++ks) acc = __builtin_amdgcn_mfma_f32_16x16x32_bf16(cur.a[ks], sbf[ks], acc, 0, 0, 0); \
        if (w < 4) { v2u o; o.x = pk2(bflo(cur.uv.x) - acc[0], bfhi(cur.uv.x) - acc[1]); o.y = pk2(bflo(cur.uv.y) - acc[2], bfhi(cur.uv.y) - acc[3]); \
            *(LAS v2u*)(VNt + r16 * 72 + 16 * rt + 4 * quad) = o; } \
        lds_barrier(); \
        const bf16x8 vb0 = *(const LAS bf16x8*)(VNt + r16 * 72 + 8 * quad), vb1 = *(const LAS bf16x8*)(VNt + r16 * 72 + 32 + 8 * quad); \
        if (w >= 4) { \
            acc = __builtin_amdgcn_mfma_f32_16x16x32_bf16(cur.qk[0], vb0, acc, 0, 0, 0); \
            acc = __builtin_amdgcn_mfma_f32_16x16x32_bf16(cur.qk[1], vb1, acc, 0, 0, 0); \
            _Pragma("unroll") for (int j = 0; j < 4; ++j) Ost[(((s_) & 3) * 64 + 16 * rt + 4 * quad + j) * 16 + r16] = acc[j]; } \
        sacc = sacc * cur.gl; \
        sacc = __builtin_amdgcn_mfma_f32_16x16x32_bf16(cur.kd[0], vb0, sacc, 0, 0, 0); \
        sacc = __builtin_amdgcn_mfma_f32_16x16x32_bf16(cur.kd[1], vb1, sacc, 0, 0, 0); \
        { v2u o; o.x = pk2(sacc[0], sacc[1]); o.y = pk2(sacc[2], sacc[3]); *(LAS v2u*)(St + r16 * 136 + 16 * w + 4 * quad) = o; } \
        lds_barrier(); \
    } while (0)
    GdnOps r0, r1, r2, r3;
    gdn_load_asm(F, r0, gdn_cd(b, h, dir, 0), sl); gdn_load_asm(F, r1, gdn_cd(b, h, dir, 1), sl); gdn_load_asm(F, r2, gdn_cd(b, h, dir, 2), sl); gdn_load_asm(F, r3, gdn_cd(b, h, dir, 3), sl);
#pragma unroll 1
    for (int s = 0; s < 68; s += 4) {
        GDN_STEP(r0, s);     gdn_load_asm(F, r0, gdn_cd(b, h, dir, (s + 4 < 68 ? s + 4 : 67)), sl);
        GDN_STEP(r1, s + 1); gdn_load_asm(F, r1, gdn_cd(b, h, dir, (s + 5 < 68 ? s + 5 : 67)), sl);
        GDN_STEP(r2, s + 2); gdn_load_asm(F, r2, gdn_cd(b, h, dir, (s + 6 < 68 ? s + 6 : 67)), sl);
        GDN_STEP(r3, s + 3);
#pragma unroll
        for (int k2 = 0; k2 < 2; ++k2) { const int idx = F.tid + 512 * k2, st = idx >> 8, i = (idx >> 2) & 63, qd = idx & 3;
            const f32x4 v = *(const LAS f32x4*)(Ost + (st * 64 + i) * 16 + 4 * qd);
            const int g = gdn_g(b, dir, s + st), ti = dir ? 63 - i : i;
            *(f32x4*)(GO + ((size_t)64 * g + ti) * 512 + h * 128 + 16 * sl + 4 * qd) = v; }
        gdn_load_asm(F, r3, gdn_cd(b, h, dir, (s + 7 < 68 ? s + 7 : 67)), sl);
    }
#undef GDN_STEP
    asm volatile("s_waitcnt vmcnt(0)" ::: "memory");
    __syncthreads();
}
template <int NCT> struct GdnOpsW { bf16x8 a[4]; bf16x8 qk[2]; bf16x8 kd[2]; v2u uv[NCT]; float gl; };
template <int NCT>
__device__ __forceinline__ void gdn_load_wide(Frame& F, GdnOpsW<NCT>& o, size_t cd, int part) {
    const int lane = F.lane, w = F.wave, r16 = lane & 15, quad = lane >> 4, rt = w & 3;
    const bf16* ap = (w < 4 ? WSP(bf16, WS_GW) : WSP(bf16, WS_GQG)) + cd * 8192 + (size_t)(16 * rt + r16) * 128 + 8 * quad;
#pragma unroll
    for (int s = 0; s < 4; ++s) o.a[s] = *(const bf16x8*)(ap + 32 * s);
    const bf16* kp = WSP(bf16, WS_GKD) + cd * 8192 + (size_t)(16 * w + r16) * 64 + 8 * quad;
    o.kd[0] = *(const bf16x8*)kp; o.kd[1] = *(const bf16x8*)(kp + 32);
    { const bf16* qp = WSP(bf16, WS_GQK) + cd * 4096 + (size_t)(16 * rt + r16) * 64 + 8 * quad; o.qk[0] = *(const bf16x8*)qp; o.qk[1] = *(const bf16x8*)(qp + 32); }
    const bf16* up = WSP(bf16, WS_GU) + cd * 8192 + (size_t)(part * NCT * 16 + r16) * 64 + 16 * rt + 4 * quad;
#pragma unroll
    for (int ct = 0; ct < NCT; ++ct) o.uv[ct] = *(const v2u*)(up + (size_t)ct * 16 * 64);
    o.gl = WSP(float, WS_GGL)[cd];
}
template <int NCT>
__device__ __forceinline__ void gdn_scan_wide(Frame& F, int cg, int part) {
    REFRESH_TID(F);
    constexpr int NC = NCT * 16, OFF_VN = NC * 136 * 2, OFF_O = OFF_VN + NC * 72 * 2;
    const int dir = cg & 1, h = (cg >> 1) & 3, b = cg >> 3;
    const int lane = F.lane, w = F.wave, r16 = lane & 15, quad = lane >> 4, rt = w & 3;
    LAS bf16* St = (LAS bf16*)(F.lds); LAS bf16* VNt = (LAS bf16*)(F.lds + OFF_VN); LAS float* Ost = (LAS float*)(F.lds + OFF_O);
    __syncthreads();
    for (int i = F.tid; i < OFF_O / 4; i += NT) ((LAS unsigned*)F.lds)[i] = 0u;
    __syncthreads();
    f32x4 sacc[NCT];
#pragma unroll
    for (int ct = 0; ct < NCT; ++ct) sacc[ct] = (f32x4){0.f, 0.f, 0.f, 0.f};
    float* GO = WSP(float, WS_GO) + (size_t)dir * MROWS * 512;
#define GDNW_STEP(cur, s_) do { \
        f32x4 acc[NCT]; \
        _Pragma("unroll") for (int ct = 0; ct < NCT; ++ct) { acc[ct] = (f32x4){0.f, 0.f, 0.f, 0.f}; \
            _Pragma("unroll") for (int ks = 0; ks < 4; ++ks) { const bf16x8 sb = *(const LAS bf16x8*)(St + (16 * ct + r16) * 136 + 32 * ks + 8 * quad); \
                acc[ct] = __builtin_amdgcn_mfma_f32_16x16x32_bf16(cur.a[ks], sb, acc[ct], 0, 0, 0); } } \
        if (w < 4) { _Pragma("unroll") for (int ct = 0; ct < NCT; ++ct) { v2u o; o.x = pk2(bflo(cur.uv[ct].x) - acc[ct][0], bfhi(cur.uv[ct].x) - acc[ct][1]); o.y = pk2(bflo(cur.uv[ct].y) - acc[ct][2], bfhi(cur.uv[ct].y) - acc[ct][3]); \
            *(LAS v2u*)(VNt + (16 * ct + r16) * 72 + 16 * rt + 4 * quad) = o; } } \
        lds_barrier(); \
        _Pragma("unroll") for (int ct = 0; ct < NCT; ++ct) { \
            const bf16x8 vb0 = *(const LAS bf16x8*)(VNt + (16 * ct + r16) * 72 + 8 * quad), vb1 = *(const LAS bf16x8*)(VNt + (16 * ct + r16) * 72 + 32 + 8 * quad); \
            if (w >= 4) { acc[ct] = __builtin_amdgcn_mfma_f32_16x16x32_bf16(cur.qk[0], vb0, acc[ct], 0, 0, 0); acc[ct] = __builtin_amdgcn_mfma_f32_16x16x32_bf16(cur.qk[1], vb1, acc[ct], 0, 0, 0); \
                _Pragma("unroll") for (int j = 0; j < 4; ++j) Ost[(16 * rt + 4 * quad + j) * NC + 16 * ct + r16] = acc[ct][j]; } \
            sacc[ct] = sacc[ct] * cur.gl; \
            sacc[ct] = __builtin_amdgcn_mfma_f32_16x16x32_bf16(cur.kd[0], vb0, sacc[ct], 0, 0, 0); \
            sacc[ct] = __builtin_amdgcn_mfma_f32_16x16x32_bf16(cur.kd[1], vb1, sacc[ct], 0, 0, 0); \
            { v2u o; o.x = pk2(sacc[ct][0], sacc[ct][1]); o.y = pk2(sacc[ct][2], sacc[ct][3]); *(LAS v2u*)(St + (16 * ct + r16) * 136 + 16 * w + 4 * quad) = o; } } \
        lds_barrier(); \
        { const int g = gdn_g(b, dir, (s_)); constexpr int TPR = NC / 16 ;   \
            for (int idx = F.tid; idx < 64 * TPR; idx += NT) { const int i = idx / TPR, c16 = (idx % TPR) * 16, ti = dir ? 63 - i : i; \
                float* gp = GO + ((size_t)64 * g + ti) * 512 + h * 128 + part * NC + c16; \
                _Pragma("unroll") for (int k4 = 0; k4 < 4; ++k4) *(f32x4*)(gp + 4 * k4) = *(const LAS f32x4*)(Ost + i * NC + c16 + 4 * k4); } } \
    } while (0)
    GdnOpsW<NCT> r0, r1;
    gdn_load_wide<NCT>(F, r0, gdn_cd(b, h, dir, 0), part); gdn_load_wide<NCT>(F, r1, gdn_cd(b, h, dir, 1), part);
#pragma unroll 1
    for (int s = 0; s < 68; s += 2) {
        GDNW_STEP(r0, s);     gdn_load_wide<NCT>(F, r0, gdn_cd(b, h, dir, (s + 2 < 68 ? s + 2 : 67)), part);
        GDNW_STEP(r1, s + 1); gdn_load_wide<NCT>(F, r1, gdn_cd(b, h, dir, (s + 3 < 68 ? s + 3 : 67)), part);
    }
#undef GDNW_STEP
    __syncthreads();
}
__device__ __forceinline__ void gdn_out(Frame& F, int l) {
    REFRESH_TID(F);
    const int gw = F.bid * NWAVES + F.wave, NGW = F.G * NWAVES, lane = F.lane;
    const float* G0 = WSP(float, WS_GO); const float* G1 = G0 + (size_t)MROWS * 512;
    const bf16* U = WSP(bf16, WS_U); bf16* YC = WSP(bf16, WS_Y) + (size_t)2 * MROWS * 512;
    const float g0 = F.in[I_CGOUT][l * 128 + 2 * lane], g1 = F.in[I_CGOUT][l * 128 + 2 * lane + 1];
    int rlo, rhi;
    const int nrows = l == DEPTH - 1 ? TLAT : MROWS;
    if (F.G == 256 && l < DEPTH - 1) { if (F.bid < 64) { rlo = 38 * F.bid; rhi = rlo + 38; } else { rlo = 2432 + 78 * (F.bid - 64); rhi = rlo + 78; } }
    else { const int per = (nrows + F.G - 1) / F.G; rlo = per * F.bid; rhi = rlo + per < nrows ? rlo + per : nrows; if (rlo > nrows) rlo = nrows; }
    for (int r0 = rlo + F.wave; r0 < rhi; r0 += 2 * NWAVES) {
        const int r1 = r0 + NWAVES < rhi ? r0 + NWAVES : r0;
        f32x2_t a[2][4], c[2][4]; unsigned zz[2][4];
#pragma unroll
        for (int k = 0; k < 2; ++k) { const int r = k ? r1 : r0;
#pragma unroll
            for (int h = 0; h < 4; ++h) { const size_t o = (size_t)r * 512 + h * 128 + 2 * lane;
                a[k][h] = *(const f32x2_t*)(G0 + o); c[k][h] = *(const f32x2_t*)(G1 + o); zz[k][h] = *(const unsigned*)(U + (size_t)r * UW + UCZ + h * 128 + 2 * lane); } }
#pragma unroll
        for (int k = 0; k < 2; ++k) { const int r = k ? r1 : r0; if (k == 1 && r1 == r0) break;
#pragma unroll
            for (int h = 0; h < 4; ++h) { const float a0 = a[k][h].x + c[k][h].x, a1 = a[k][h].y + c[k][h].y;
                const float ss = wave_sum(a0 * a0 + a1 * a1);
                const float rs = rsqrtf(ss * (1.f / 128.f) + EPS);
                *(unsigned*)(YC + (size_t)r * 512 + h * 128 + 2 * lane) = pk2(a0 * rs * g0 * siluf_(bflo(zz[k][h])), a1 * rs * g1 * siluf_(bfhi(zz[k][h]))); } }
    }
}


struct SideFr { bf16x8 a[4], b0[4], b1[4]; };
__device__ __forceinline__ void side_ld(SideFr& f, const bf16* ap, const bf16* bp0, const bf16* bp1) {
#pragma unroll
    for (int s = 0; s < 4; ++s) { f.a[s] = *(const bf16x8*)(ap + 32 * s); f.b0[s] = *(const bf16x8*)(bp0 + 32 * s); f.b1[s] = *(const bf16x8*)(bp1 + 32 * s); }
}
__device__ __forceinline__ void side_mma(f32x4& c0, f32x4& c1, const SideFr& f) {
#pragma unroll
    for (int s = 0; s < 4; ++s) { c0 = __builtin_amdgcn_mfma_f32_16x16x32_bf16(f.a[s], f.b0[s], c0, 0, 0, 0); c1 = __builtin_amdgcn_mfma_f32_16x16x32_bf16(f.a[s], f.b1[s], c1, 0, 0, 0); }
}
__device__ __forceinline__ void side_merge(Frame& F, int l) {
    REFRESH_TID(F);
    const int lane = F.lane, w = F.wave, r16 = lane & 15, quad = lane >> 4, rt = w & 3, chf = w >> 2;
    const bf16* U = WSP(bf16, WS_U);
    for (int tile = F.bid; tile < 256; tile += F.G) {
        const int row0 = TLAT + 64 * (tile >> 4) + 16 * rt, col0 = 64 * (tile & 15) + 32 * chf;
        f32x4 m0 = (f32x4){0.f, 0.f, 0.f, 0.f}, m1 = m0;
#define SM_AP(q) (WSP(bf16, WS_Y) + ((size_t)((q) >> 2) * MROWS + row0 + r16) * 512 + 8 * quad + 128 * ((q) & 3))
#define SM_BP(q) (WSP(bf16, WS_WBR) + (((size_t)l * 4 + ((q) >> 2)) * 1024 + col0 + r16) * 512 + 8 * quad + 128 * ((q) & 3))
        SideFr fa, fb;
        side_ld(fa, SM_AP(0), SM_BP(0), SM_BP(0) + (size_t)16 * 512);
#pragma unroll 1
        for (int br = 0; br < 4; ++br) {
            f32x4 c0 = (f32x4){0.f, 0.f, 0.f, 0.f}, c1 = c0;
            const int q = br * 4;
            side_ld(fb, SM_AP(q + 1), SM_BP(q + 1), SM_BP(q + 1) + (size_t)16 * 512); side_mma(c0, c1, fa);
            side_ld(fa, SM_AP(q + 2), SM_BP(q + 2), SM_BP(q + 2) + (size_t)16 * 512); side_mma(c0, c1, fb);
            side_ld(fb, SM_AP(q + 3), SM_BP(q + 3), SM_BP(q + 3) + (size_t)16 * 512); side_mma(c0, c1, fa);
            { const int qn = q + 4 < 16 ? q + 4 : 15; side_ld(fa, SM_AP(qn), SM_BP(qn), SM_BP(qn) + (size_t)16 * 512); }
            side_mma(c0, c1, fb);
#pragma unroll
            for (int j = 0; j < 4; ++j) { const bf16* gp = U + (size_t)(row0 + 4 * quad + j) * UW + UG + br * 1024 + col0 + r16;
                m0[j] += sigmoidf_(bf2f(gp[0])) * c0[j]; m1[j] += sigmoidf_(bf2f(gp[16])) * c1[j]; }
        }
#undef SM_AP
#undef SM_BP
#pragma unroll
        for (int j = 0; j < 4; ++j) { bf16* mp = WSP(bf16, WS_MB) + (size_t)(row0 + 4 * quad + j) * 1024 + col0 + r16;
            mp[0] = (bf16)f2bf(m0[j]); mp[16] = (bf16)f2bf(m1[j]); }
    }
}
__device__ __forceinline__ void side_outproj(Frame& F, int l) {
    REFRESH_TID(F);
    const int lane = F.lane, w = F.wave, r16 = lane & 15, quad = lane >> 4, rt = w & 3, chf = w >> 2;
    const float* gt = WSP(float, WS_MOD) + ((size_t)l * 5 + 4) * 6144 + 2048;
    for (int tile = F.bid; tile < 256; tile += F.G) {
        const int row0 = TLAT + 64 * (tile >> 4) + 16 * rt, col0 = 64 * (tile & 15) + 32 * chf;
        const bf16* ap = WSP(bf16, WS_MB) + (size_t)(row0 + r16) * 1024 + 8 * quad;
        const bf16* bp0 = WSP(bf16, WS_WOUT) + ((size_t)l * 1024 + col0 + r16) * 1024 + 8 * quad;
        const bf16* bp1 = bp0 + (size_t)16 * 1024;
        f32x4 c0 = (f32x4){0.f, 0.f, 0.f, 0.f}, c1 = c0;
        SideFr fa, fb;
        side_ld(fa, ap, bp0, bp1);
#pragma unroll 1
        for (int kc = 0; kc < 8; kc += 2) {
            side_ld(fb, ap + 128 * (kc + 1), bp0 + 128 * (kc + 1), bp1 + 128 * (kc + 1)); side_mma(c0, c1, fa);
            { const int kn = kc + 2 < 8 ? kc + 2 : 7; side_ld(fa, ap + 128 * kn, bp0 + 128 * kn, bp1 + 128 * kn); }
            side_mma(c0, c1, fb);
        }
        const float g0 = gt[col0 + r16], g1 = gt[col0 + 16 + r16];
#pragma unroll
        for (int j = 0; j < 4; ++j) { float* xp = WSP(float, WS_X) + (size_t)(row0 + 4 * quad + j) * 1024 + col0 + r16;
            xp[0] += g0 * c0[j]; xp[16] += g1 * c1[j]; }
    }
}

#ifndef SCAN_PARTS
#define SCAN_PARTS 2
#endif
constexpr int NSCAN = 4 * SCAN_PARTS;
constexpr int CW_Q = 2048;
__device__ __forceinline__ void mixer_queue_phase(Frame& F, int l) {
    volatile LAS int* qslot = (volatile LAS int*)(F.lds + MISC_OFF + 64);
    const int x0 = (int)(xb_xcc_id() & 7u);
#if defined(PROBE_SUB) && (PROBE_SUB == 4 || PROBE_SUB == 5)
    const unsigned long long tq0 = __builtin_amdgcn_s_memrealtime();
#endif
#pragma unroll 1
    for (int kq = 0; kq < 8; ++kq) {
      const int x = (x0 + kq) & 7;
      for (;;) {
        __syncthreads();
        if (F.tid == 0) *qslot = (int)__hip_atomic_fetch_add(F.ctl + CW_Q + l * 8 + x, 1u, __ATOMIC_RELAXED, __HIP_MEMORY_SCOPE_AGENT);
        __syncthreads();
        const int idx = __builtin_amdgcn_readfirstlane(*qslot);
        if (idx >= (l == DEPTH - 1 ? 128 : 136) + NSCAN) break;
#ifdef PROBE_SUB
        unsigned long long t0_ = 0ull; const bool pr_on = false;
#endif
        if (idx < NSCAN) { gdn_scan_wide<8 / SCAN_PARTS>(F, x + 8 * (idx / SCAN_PARTS), idx % SCAN_PARTS); }
        else { AttnUnit un; const int q = idx - NSCAN;
            if (q < 64) { un.kind = 0; un.b = x >> 1; un.hx = x & 1; un.qx = q; }
            else if (q < 128) { const int qq = q - 64, combo = x + 8 * (qq >> 4); un.kind = 1; un.b = combo >> 3; un.hx = combo & 7; un.qx = qq & 15; }
            else { const int qq = q - 128;
                if (qq < 4) { un.kind = 2; un.b = x >> 1; un.hx = x & 1; un.qx = qq; }
                else { const int combo = x + 8 * (qq - 4); un.kind = 3; un.b = combo >> 3; un.hx = combo & 7; un.qx = 0; } }
            attn_unit(F, l, un); }
#ifdef PROBE_SUB
        if (pr_on) F.pr += __builtin_amdgcn_s_memrealtime() - t0_;
        if (PROBE_SUB == 13 && F.bid == 8 && idx >= 4 && idx < 68) F.pr += 100;
        if (PROBE_SUB == 14 && F.bid == 8 && idx >= 68 && idx < 140) F.pr += 100;
#endif
      }
    }
#if defined(PROBE_SUB) && PROBE_SUB == 4
    if (F.tid == 0) __hip_atomic_fetch_max(F.ctl + 3000 + l, (unsigned)(__builtin_amdgcn_s_memrealtime() - tq0), __ATOMIC_RELAXED, __HIP_MEMORY_SCOPE_AGENT);
#endif
#if defined(PROBE_SUB) && PROBE_SUB == 5
    if (F.tid == 0) __hip_atomic_fetch_max(F.ctl + 3000 + l, 0x7fffffffu - (unsigned)(__builtin_amdgcn_s_memrealtime() - tq0), __ATOMIC_RELAXED, __HIP_MEMORY_SCOPE_AGENT);
#endif
}

#ifndef REP_P0
#define REP_P0 1
#endif
#ifndef REP_B
#define REP_B 1
#endif
#ifndef REP_D1
#define REP_D1 1
#endif
#ifndef REP_D2
#define REP_D2 1
#endif
#ifndef REP_E
#define REP_E 1
#endif
#ifndef REP_F
#define REP_F 1
#endif
#ifndef REP_I
#define REP_I 1
#endif
#ifndef REP_J
#define REP_J 1
#endif
#ifndef REP_C1
#define REP_C1 1
#endif
#ifndef REP_C2
#define REP_C2 1
#endif
#ifndef REP_C4
#define REP_C4 1
#endif
#ifndef REP_G2
#define REP_G2 1
#endif

#ifndef MIXER_QUEUE
#define MIXER_QUEUE 1
#endif
constexpr int PH_PER_LAYER = 11, PH_FINAL = 1 + PH_PER_LAYER * DEPTH, N_PHASES = PH_FINAL + 1;
struct Args { const float* in[32]; float* out; unsigned char* ws; int ph_lo, ph_hi, li, pad; };

__global__ void __launch_bounds__(NT, 2) hybrid_fwd(Args args) {
    extern __shared__ __attribute__((aligned(16))) unsigned char lds_raw[];
    Frame F;
    F.lds = (LAS unsigned char*)lds_raw;
    F.wave = __builtin_amdgcn_readfirstlane((int)threadIdx.x >> 6); F.lane = (int)__builtin_amdgcn_mbcnt_hi(~0u, __builtin_amdgcn_mbcnt_lo(~0u, 0u)); F.tid = F.wave * 64 + F.lane;
    F.G = gridDim.x; F.bid = blockIdx.x; F.pr = 0ull;
    F.in = args.in; F.in0 = args.in;
    F.out = args.out; F.ws = args.ws; F.ws0 = args.ws; F.ctl = (unsigned*)(args.ws + WS_CTL);
    volatile LAS unsigned* MISC = (volatile LAS unsigned*)(F.lds + MISC_OFF);
    if (F.tid < 64) MISC[F.tid] = 0u;
    __syncthreads();
    const int lo = args.ph_lo, hi = args.ph_hi;
    XcdBarrier bar = xcd_barrier_post(F.ctl + CW_BAR + args.li * XCD_BAR_WORDS, MISC + 8);
#ifndef ONLY_MASK
#define ONLY_MASK 0xFFFF
#endif
#define PHON(b) ((ONLY_MASK >> (b)) & 1)
#define IN(k) (lo <= (k) && (k) < hi)
#define SEAM(k) do { if ((k) + 1 < hi) xcd_barrier(bar); } while (0)
#ifdef PROBE_PHASE
    unsigned long long pr_acc = 0ull, pr_t0 = 0ull;
#define PR_BEGIN(k) do { if ((k) == PROBE_PHASE) pr_t0 = __builtin_amdgcn_s_memrealtime(); } while (0)
#define PR_END(k) do { if ((k) == PROBE_PHASE) pr_acc += __builtin_amdgcn_s_memrealtime() - pr_t0; } while (0)
#else
#define PR_BEGIN(k) do { } while (0)
#define PR_END(k) do { } while (0)
#endif

    if (PHON(0) && IN(0)) { REFRESH_TID(F); _Pragma("unroll 1") for (int rep_ = 0; rep_ < REP_P0; ++rep_) { p0_prologue(F); __syncthreads(); } SEAM(0); PR_END(0); }
#pragma unroll 1
    for (int l = 0; l < DEPTH; ++l) {
        const int pb = 1 + PH_PER_LAYER * l;
        if (PHON(1) && IN(pb + 0)) { PR_BEGIN(1); REFRESH_TID(F); norm_phase<0>(F, l); SEAM(pb + 0); PR_END(1); }
        if (PHON(2) && IN(pb + 1)) { PR_BEGIN(2); REFRESH_TID(F);
            pg8::Gemm g{WSP(bf16, WS_H), WSP(bf16, WS_WIN) + (size_t)l * UW * D, MROWS, UW, D};
            pg8::StaticOrder S; S.init(MROWS, UW, F.G, F.bid);
            pg8::EpiStoreBf16 E{WSP(bf16, WS_U), UW};
            _Pragma("unroll 1") for (int rep_ = 0; rep_ < REP_B; ++rep_) { pg8::gemm_phase<pg8::EpiStoreBf16, pg8::StaticOrder, true, true>(F.lds, g, S, E, F.wave); __syncthreads(); }
            SEAM(pb + 1); PR_END(2);
        }
        if (PHON(3) && IN(pb + 2)) { PR_BEGIN(3); REFRESH_TID(F);
#ifndef NO_C1
            PR_BEGIN(30); _Pragma("unroll 1") for (int rep_ = 0; rep_ < REP_C1; ++rep_) { gdn_prep(F, l); __syncthreads(); } PR_END(30);
#endif
#ifndef NO_C2
            PR_BEGIN(31); _Pragma("unroll 1") for (int rep_ = 0; rep_ < REP_C2; ++rep_) { lru_pass1(F, l); __syncthreads(); } PR_END(31);
#endif
            __syncthreads();
#ifndef NO_C3
            PR_BEGIN(32); qk_prep(F, l); PR_END(32);
#endif
#ifndef NO_C4
            PR_BEGIN(33); _Pragma("unroll 1") for (int rep_ = 0; rep_ < REP_C4; ++rep_) { v_transpose(F); __syncthreads(); } PR_END(33); PR_BEGIN(34);
#endif
            SEAM(pb + 2); PR_END(34); PR_END(3);
        }
        if (PHON(4) && IN(pb + 3)) { PR_BEGIN(4); REFRESH_TID(F);
#if MIXER_QUEUE
            lru_carry_all(F);
            __syncthreads();
            mixer_queue_phase(F, l);
#else
            PR_BEGIN(20); for (int ch = F.bid; ch < 256; ch += F.G) gdn_scan(F, ch); PR_END(20);
            PR_BEGIN(21); lru_carry_all(F);
            __syncthreads(); PR_END(21);
            PR_BEGIN(22); attn_phase(F, l); PR_END(22);
#endif
            PR_BEGIN(23);
            SEAM(pb + 3); PR_END(23); PR_END(4);
        }
        if (PHON(5) && IN(pb + 4)) { PR_BEGIN(5); REFRESH_TID(F);
            _Pragma("unroll 1") for (int rep_ = 0; rep_ < REP_E; ++rep_) { lru_pass2(F, l); __syncthreads(); }
            __syncthreads();
            gdn_out(F, l);
            SEAM(pb + 4); PR_END(5);
        }
        if (PHON(6) && IN(pb + 5)) { PR_BEGIN(6); REFRESH_TID(F);
            pg8::Gemm g{WSP(bf16, WS_Y), WSP(bf16, WS_WBR) + (size_t)l * 4 * 1024 * 512, 4 * MROWS, 4 * 1024, 512};
            pg8::MergeOrder S{F.G, F.bid, MROWS / 256, TLAT / 256};
            pg8::EpiMerge E{WSP(bf16, WS_U), UW, UG, WSP(bf16, WS_MF), WSP(bf16, WS_MB), MROWS / 256};
            _Pragma("unroll 1") for (int rep_ = 0; rep_ < REP_F; ++rep_) { pg8::gemm_phase<pg8::EpiMerge, pg8::MergeOrder, true, true>(F.lds, g, S, E, F.wave); __syncthreads(); }
            PR_BEGIN(13); if (l < DEPTH - 1) side_merge(F, l); PR_END(13);
            SEAM(pb + 5); PR_END(6);
        }
        if (PHON(7) && IN(pb + 6)) { PR_BEGIN(7); REFRESH_TID(F);
            pg8::Gemm g{WSP(bf16, WS_MB), WSP(bf16, WS_WOUT) + (size_t)l * D * D, MROWS, D, D};
            pg8::StaticOrder S; S.init(TLAT, D, F.G, F.bid);
            pg8::EpiResid E{WSP(float, WS_X), WSP(float, WS_MOD) + (size_t)l * 5 * 6144 + 2048};
            pg8::gemm_phase<pg8::EpiResid, pg8::StaticOrder, true, true>(F.lds, g, S, E, F.wave);
            PR_BEGIN(14); if (l < DEPTH - 1) side_outproj(F, l); PR_END(14);
            SEAM(pb + 6); PR_END(7);
        }
        if (PHON(8) && IN(pb + 7)) { PR_BEGIN(8); REFRESH_TID(F); norm_phase<1>(F, l); SEAM(pb + 7); PR_END(8); }
        if (PHON(9) && IN(pb + 8)) { PR_BEGIN(9); REFRESH_TID(F); _Pragma("unroll 1") for (int rep_ = 0; rep_ < REP_G2; ++rep_) { moe_gather(F, l); __syncthreads(); } SEAM(pb + 8); PR_END(9); }
        if (PHON(10) && IN(pb + 9)) { PR_BEGIN(10); REFRESH_TID(F);
            moe_table(F, l);
            pg8::Gemm g{WSP(bf16, WS_HS), WSP(bf16, WS_WGU) + (size_t)l * NEXP * 2048 * D, MOE_ROWS, NEXP * 2048, D};
            pg8::MoeOrder S{(const LAS int*)(F.lds + MISC_OFF + 256), F.G, F.bid, 8};
            pg8::EpiSwiglu E{WSP(bf16, WS_ACT), F.in[I_BGU] + (size_t)l * NEXP * 2048};
            _Pragma("unroll 1") for (int rep_ = 0; rep_ < REP_I; ++rep_) { pg8::gemm_phase<pg8::EpiSwiglu, pg8::MoeOrder, true, true>(F.lds, g, S, E, F.wave); __syncthreads(); }
            SEAM(pb + 9); PR_END(10);
        }
        if (PHON(11) && IN(pb + 10)) { PR_BEGIN(11); REFRESH_TID(F);
            moe_table(F, l);
            pg8::Gemm g{WSP(bf16, WS_ACT), WSP(bf16, WS_WDN) + (size_t)l * NEXP * D * D, MOE_ROWS, NEXP * D, D};
            pg8::MoeOrder S{(const LAS int*)(F.lds + MISC_OFF + 256), F.G, F.bid, 4};
            pg8::EpiDown E{WSP(bf16, WS_YS), F.in[I_BDN] + (size_t)l * NEXP * D};
            _Pragma("unroll 1") for (int rep_ = 0; rep_ < REP_J; ++rep_) { pg8::gemm_phase<pg8::EpiDown, pg8::MoeOrder, true, true>(F.lds, g, S, E, F.wave); __syncthreads(); }
            SEAM(pb + 10); PR_END(11);
        }
    }
    if (PHON(12) && IN(PH_FINAL)) { PR_BEGIN(12); REFRESH_TID(F); norm_phase<2>(F, 0); PR_END(12); }
#if defined(PROBE_SUB) && (PROBE_SUB == 4 || PROBE_SUB == 5)
    if (blockIdx.x == 0) { unsigned long long tot = 0ull;
        for (int q = 0; q < 4; ++q) { const unsigned v = __hip_atomic_load(F.ctl + 3000 + q, __ATOMIC_RELAXED, __HIP_MEMORY_SCOPE_AGENT); tot += (PROBE_SUB == 4) ? v : (0x7fffffffu - v); }
        F.pr = tot; }
#endif
#ifdef PROBE_SUB
    if (F.pr) { const unsigned long long te = __builtin_amdgcn_s_memrealtime(); while (__builtin_amdgcn_s_memrealtime() - te < PROBE_MULT * F.pr) __builtin_amdgcn_s_sleep(8); }
#endif
#ifdef PROBE_PHASE
    if (blockIdx.x == 0) { const unsigned long long te = __builtin_amdgcn_s_memrealtime(); while (__builtin_amdgcn_s_memrealtime() - te < PROBE_MULT * pr_acc) __builtin_amdgcn_s_sleep(8); }
#endif
#undef IN
#undef SEAM
}

extern "C" void kernel_launch(void* const* d_in, const int* in_sizes, int n_in, void* d_out, int out_size, void* d_ws, size_t ws_size, hipStream_t stream) {
    static int grid = 0;
    if (grid == 0) {
        if (n_in != 32 || out_size != TLAT * D || ws_size < WS_END) { fprintf(stderr, "kernel_launch: unexpected shapes (n_in %d out %d ws %zu need %zu)\n", n_in, out_size, ws_size, (size_t)WS_END); grid = -1; return; }
        int dev = 0, cus = 0, per_cu = 0;
        if (hipGetDevice(&dev) != hipSuccess || hipDeviceGetAttribute(&cus, hipDeviceAttributeMultiprocessorCount, dev) != hipSuccess) { grid = -1; return; }
        if (hipFuncSetAttribute((const void*)hybrid_fwd, hipFuncAttributeMaxDynamicSharedMemorySize, LDS_BYTES) != hipSuccess) { fprintf(stderr, "kernel_launch: hipFuncSetAttribute failed\n"); grid = -1; return; }
        if (hipOccupancyMaxActiveBlocksPerMultiprocessor(&per_cu, (const void*)hybrid_fwd, NT, LDS_BYTES) != hipSuccess || per_cu < 1) fprintf(stderr, "kernel_launch: occupancy query says %d\n", per_cu);
        (void)hipGetLastError();
        grid = cus;
    }
    if (grid < 0) return;
    if (hipMemsetAsync((char*)d_ws + WS_CTL, 0, CTL_BYTES, stream) != hipSuccess) return;
    Args a{};
    for (int i = 0; i < 32; ++i) a.in[i] = (const float*)d_in[i];
    a.out = (float*)d_out; a.ws = (unsigned char*)d_ws;
#if MK_MULTI
    for (int p = 0; p < N_PHASES; ++p) { a.ph_lo = p; a.ph_hi = p + 1; a.li = p;
        hipLaunchKernelGGL(hybrid_fwd, dim3(grid), dim3(NT), LDS_BYTES, stream, a); }
#else
    a.ph_lo = 0; a.ph_hi = N_PHASES; a.li = 0;
    hipLaunchKernelGGL(hybrid_fwd, dim3(grid), dim3(NT), LDS_BYTES, stream, a);
#endif
    const hipError_t le = hipPeekAtLastError();
    if (le != hipSuccess) fprintf(stderr, "kernel_launch: launch failed: %s\n", hipGetErrorName(le));
}
```

```cpp
#include <hip/hip_runtime.h>
#include <cstdio>
#include <cstdint>

#ifndef MK_MULTI
#define MK_MULTI 0
#endif

constexpr int D = 1024, NB = 4, SEQ = 4096, LCTX = 256, DEPTH = 4;
constexpr int TLAT = NB * SEQ, TCTX = NB * LCTX, MROWS = TLAT + TCTX;
constexpr int NCHUNK = MROWS / 64;
constexpr int INW = 9488, UW = 9472;
constexpr int UQ = 0, UK = 512, UV = 640, UBX = 768, UBY = 1280, UCQ = 1792, UCK = 2304, UCV = 2816, UCZ = 3328, UDQ = 3840, UDK = 4352, UDV = 4864, UG = 5376;
constexpr int NEXP = 32, TOPK = 4;
constexpr int KEYS = SEQ + LCTX;
constexpr int MOE_ROWS = MROWS * TOPK + NEXP * 256;
constexpr float EPS = 1e-6f;
constexpr float LOG2E = 1.4426950408889634f;

constexpr size_t al256(size_t x) { return (x + 255) & ~(size_t)255; }
constexpr size_t WS_CTL = 0, CTL_BYTES = 1u << 20;
constexpr size_t WS_MOD  = WS_CTL + CTL_BYTES;
constexpr size_t WS_ROPE = WS_MOD + al256((size_t)DEPTH * 5 * 6144 * 4);
constexpr size_t WS_LRUW = WS_ROPE + al256(2 * 64 * 16 * 4);
constexpr size_t WS_WIN  = WS_LRUW + al256((size_t)DEPTH * 2 * 2 * 8 * 4096 * 2);
constexpr size_t WS_WBR  = WS_WIN + al256((size_t)DEPTH * UW * D * 2);
constexpr size_t WS_WOUT = WS_WBR + al256((size_t)DEPTH * 4 * 1024 * 512 * 2);
constexpr size_t WS_WGU  = WS_WOUT + al256((size_t)DEPTH * D * D * 2);
constexpr size_t WS_WDN  = WS_WGU + al256((size_t)DEPTH * NEXP * 2048 * 1024 * 2);
constexpr size_t WS_X    = WS_WDN + al256((size_t)DEPTH * NEXP * 1024 * 1024 * 2);
constexpr size_t WS_H    = WS_X + al256((size_t)MROWS * D * 4);
constexpr size_t WS_U    = WS_H + al256((size_t)MROWS * D * 2);
constexpr size_t WS_CAB  = WS_U + al256((size_t)MROWS * UW * 2);
constexpr size_t WS_VAT  = WS_CAB + al256((size_t)MROWS * 16 * 4);
constexpr size_t WS_VDT  = WS_VAT + al256((size_t)NB * 2 * 64 * KEYS * 2);
constexpr size_t WS_LRA  = WS_VDT + al256((size_t)NB * 8 * 64 * KEYS * 2);
constexpr size_t WS_LRB  = WS_LRA + al256((size_t)NCHUNK * 2 * 512 * 4);
constexpr size_t WS_LRC  = WS_LRB + al256((size_t)NCHUNK * 2 * 512 * 4);
constexpr int NCD = NCHUNK * 4 * 2;
constexpr size_t WS_GW   = WS_LRC + al256((size_t)NCHUNK * 2 * 512 * 4);
constexpr size_t WS_GU   = WS_GW + al256((size_t)NCD * 64 * 128 * 2);
constexpr size_t WS_GQG  = WS_GU + al256((size_t)NCD * 64 * 128 * 2);
constexpr size_t WS_GKD  = WS_GQG + al256((size_t)NCD * 64 * 128 * 2);
constexpr size_t WS_GQK  = WS_GKD + al256((size_t)NCD * 64 * 128 * 2);
constexpr size_t WS_GGL  = WS_GQK + al256((size_t)NCD * 64 * 64 * 2);
constexpr size_t WS_GO   = WS_GGL + al256((size_t)NCD * 4);
constexpr size_t WS_Y    = WS_GO + al256((size_t)2 * MROWS * 512 * 4);
constexpr size_t WS_MF   = WS_Y + al256((size_t)4 * MROWS * 512 * 2);
constexpr size_t WS_MB   = WS_MF + al256((size_t)MROWS * D * 4);
constexpr size_t WS_SROW = WS_MB + al256((size_t)MROWS * D * 2);
constexpr size_t WS_SW   = WS_SROW + al256((size_t)MROWS * 4 * 4);
constexpr size_t WS_SEP  = WS_SW + al256((size_t)MROWS * 4 * 4);
constexpr size_t WS_LIST = WS_SEP + al256((size_t)MROWS * 4 * 4);
constexpr size_t WS_HS   = WS_LIST + al256((size_t)NEXP * MROWS * 4);
constexpr size_t WS_ACT  = WS_HS + al256((size_t)MOE_ROWS * D * 2);
constexpr size_t WS_YS   = WS_ACT + al256((size_t)MOE_ROWS * D * 2);
constexpr size_t WS_END  = WS_YS + al256((size_t)MOE_ROWS * D * 2);

constexpr int CW_BAR = 4096;
constexpr int CW_CNT = 1024;

constexpr int RING_BYTES = 131072;
constexpr int MISC_OFF = RING_BYTES;
constexpr int LDS_BYTES = 147456;
constexpr int NWAVES = 8, NT = 512;

#define GAS __attribute__((address_space(1)))
#define LAS __attribute__((address_space(3)))
typedef unsigned short bf16;
typedef unsigned v4u __attribute__((ext_vector_type(4)));
typedef unsigned v2u __attribute__((ext_vector_type(2)));
typedef float f32x4 __attribute__((ext_vector_type(4)));
typedef float f32x16 __attribute__((ext_vector_type(16)));
typedef short bf16x8 __attribute__((ext_vector_type(8)));
typedef short bf16x4 __attribute__((ext_vector_type(4)));

typedef float f32x2_t __attribute__((ext_vector_type(2))); typedef __bf16 bf16x2_t __attribute__((ext_vector_type(2)));
__device__ __forceinline__ unsigned pk2(float lo, float hi) { f32x2_t v = {lo, hi}; bf16x2_t b = __builtin_convertvector(v, bf16x2_t); return __builtin_bit_cast(unsigned, b); }
__device__ __forceinline__ unsigned f2bf(float f) { return pk2(f, 0.f) & 0xffffu; }
__device__ __forceinline__ float bf2f(unsigned short b) { return __builtin_bit_cast(float, (unsigned)b << 16); }
__device__ __forceinline__ float bflo(unsigned w) { return __builtin_bit_cast(float, w << 16); }
__device__ __forceinline__ float bfhi(unsigned w) { return __builtin_bit_cast(float, w & 0xffff0000u); }
__device__ __forceinline__ float wave_sum(float v) {
#pragma unroll
    for (int o = 1; o < 64; o <<= 1) v += __shfl_xor(v, o);
    return v;
}
__device__ __forceinline__ float sigmoidf_(float x) { return 1.f / (1.f + __expf(-x)); }
__device__ __forceinline__ float softplusf_(float x) { return x > 20.f ? x : log1pf(__expf(x)); }
__device__ __forceinline__ float siluf_(float x) { return x / (1.f + __expf(-x)); }
__device__ __forceinline__ void lds_barrier() { asm volatile("s_waitcnt lgkmcnt(0)\n\ts_barrier" ::: "memory"); }
namespace pg8 {
#define PG8_LAS __attribute__((address_space(3)))
typedef unsigned short bf16_t;
typedef short bf16x8 __attribute__((ext_vector_type(8)));
typedef float f32x4 __attribute__((ext_vector_type(4)));
typedef unsigned u32x4 __attribute__((ext_vector_type(4)));
constexpr int BM = 256, BK = 64, HALF = 128, HTB = HALF * BK * 2  , STAGE_BYTES = 8 * HTB, NXCD = 8, WGM = 8;

__host__ __device__ __forceinline__ int lds_byte(int r, int c) { const int st = (r >> 4) * 2 + (c >> 5), rr = r & 15, cc = c & 31, ob = rr * 64 + cc * 2; return st * 1024 + (ob ^ (((ob >> 9) & 1) << 5)); }
__host__ __device__ __forceinline__ void stage_rc(int b, int& R, int& C) { const int st = b / 1024, sb = b % 1024, swz = sb ^ (((sb >> 9) & 1) << 5); R = (st >> 1) * 16 + swz / 64; C = (st & 1) * 32 + (swz % 64) / 2; }
__host__ __device__ __forceinline__ int perm32(int rho) { const int n = rho >> 4, i = rho & 15; return 8 * (i >> 2) + 4 * n + (i & 3); }

struct Unit { int pm, pn; };
struct Gemm { const bf16_t* A; const bf16_t* Bt; int M, N, K; };

struct StaticOrder {
    int nM, nN, nwg, G, c;
    __host__ __device__ void init(int M, int N, int G_, int c_) { nM = M / BM; nN = N / BM; nwg = nM * nN; G = G_; c = c_; }
    __host__ __device__ bool next(int i, Unit& u) const {
        const long L = (long)i * G + c; if (L >= nwg) return false;
        int wgid = (int)L; { const int q = nwg / NXCD, r = nwg % NXCD, xcd = wgid % NXCD, off = wgid / NXCD; wgid = (xcd < r ? xcd * (q + 1) : r * (q + 1) + (xcd - r) * q) + off; }
        const int nig = WGM * nN, gid = wgid / nig, fm = gid * WGM, gsz = (nM - fm) < WGM ? (nM - fm) : WGM;
        u.pm = fm + ((wgid % nig) % gsz); u.pn = (wgid % nig) / gsz; return true;
    }
    __device__ __forceinline__ void a_ready(const Unit&) const {}
    __device__ __forceinline__ void done(const Unit&) const {}
};

__device__ __forceinline__ unsigned cvt_pk_bf16(float lo, float hi) { unsigned r; asm volatile("v_cvt_pk_bf16_f32 %0, %1, %2" : "=v"(r) : "v"(lo), "v"(hi)); return r; }
typedef float f32x2 __attribute__((ext_vector_type(2)));
template <class Epi, class Sched, bool ALIGN_EPI = false, bool SP2 = false>
__device__ __forceinline__ void gemm_phase(PG8_LAS unsigned char* lds, const Gemm g, const Sched& S, const Epi& E, const int wid_in) {
    int lane_o = (int)__builtin_amdgcn_mbcnt_hi(~0u, __builtin_amdgcn_mbcnt_lo(~0u, 0u)); asm volatile("" : "+v"(lane_o));
    const int wid = __builtin_amdgcn_readfirstlane(wid_in), lane = lane_o, tid = wid * 64 + lane, wr = wid >> 2, wc = wid & 3, fr = lane & 15, fq = lane >> 4;
    const int K = g.K, nt = K / BK;
    unsigned voffA[2], voffB[2];
#pragma unroll
    for (int i = 0; i < 2; ++i) { int R, C; stage_rc(tid * 16 + i * 8192, R, C); const int Rb = Epi::PERM ? ((R & ~31) + perm32(R & 31)) : R;
        voffA[i] = (unsigned)(R * K + C) * 2u; voffB[i] = (unsigned)(Rb * K + C) * 2u; }
    const size_t kstep = (size_t)(BK * 2);
    const size_t hstep = (size_t)HALF * K * 2;
    const size_t tstep = 2 * hstep;
    const unsigned ldsw = (unsigned)wid * 1024u;
    const int aoff = lds_byte(wr * 64 + fr, fq * 8), boff = lds_byte(wc * 32 + fr, fq * 8);
#define PG8_SA(b, h) (((b) * 2 + (h)) * HTB)
#define PG8_SB(b, h) ((4 + (b) * 2 + (h)) * HTB)
#define PG8_STAGE(bufoff, gbase, voff) do { _Pragma("unroll") for (int _i = 0; _i < 2; ++_i) \
        __builtin_amdgcn_global_load_lds((const unsigned*)((const char*)(gbase) + (voff)[_i]), (PG8_LAS unsigned*)(lds + (bufoff) + ldsw + _i * 8192), 16, 0, 0); } while (0)
#define PG8_LDA(dst, b, h) do { _Pragma("unroll") for (int m = 0; m < 4; ++m) _Pragma("unroll") for (int k = 0; k < 2; ++k) dst[m][k] = *(const PG8_LAS bf16x8*)(lds + PG8_SA(b, h) + aoff + m * 2048 + k * 1024); } while (0)
#define PG8_LDB(dst, b, h) do { _Pragma("unroll") for (int n = 0; n < 2; ++n) _Pragma("unroll") for (int k = 0; k < 2; ++k) dst[n][k] = *(const PG8_LAS bf16x8*)(lds + PG8_SB(b, h) + boff + n * 2048 + k * 1024); } while (0)
#define PG8_MMA(ai, bj, At, Bt) do { __builtin_amdgcn_s_setprio(1); _Pragma("unroll") for (int m = 0; m < 4; ++m) _Pragma("unroll") for (int n = 0; n < 2; ++n) _Pragma("unroll") for (int k = 0; k < 2; ++k) \
        acc[ai][bj][m][n] = __builtin_amdgcn_mfma_f32_16x16x32_bf16(Bt[n][k], At[m][k], acc[ai][bj][m][n], 0, 0, 0); __builtin_amdgcn_s_setprio(0); } while (0)
#define PG8_WAIT_V(n) asm volatile("s_waitcnt vmcnt(" #n ")" ::: "memory")
#define PG8_WAIT_L(n) asm volatile("s_waitcnt lgkmcnt(" #n ")" ::: "memory")
#define PG8_BAR __builtin_amdgcn_s_barrier()
#define PG8_SCHED __builtin_amdgcn_sched_barrier(0)
    Unit cur, nxt; int ui = 0;
    if (!S.next(0, cur)) return;
    f32x4 acc[2][2][4][2];
#pragma unroll
    for (int a = 0; a < 2; ++a)
#pragma unroll
        for (int b = 0; b < 2; ++b)
#pragma unroll
            for (int m = 0; m < 4; ++m)
#pragma unroll
                for (int n = 0; n < 2; ++n) acc[a][b][m][n] = (f32x4){0.f, 0.f, 0.f, 0.f};
    bf16x8 At[4][2], B0[2][2], B1[2][2];
    const char* cA = (const char*)g.A + (size_t)cur.pm * tstep; const char* cB = (const char*)g.Bt + (size_t)cur.pn * tstep;
    S.a_ready(cur);
    if constexpr (SP2) {
        PG8_STAGE(PG8_SB(0, 0), cB, voffB); PG8_STAGE(PG8_SB(0, 1), cB + hstep, voffB); PG8_STAGE(PG8_SA(0, 0), cA, voffA); PG8_STAGE(PG8_SA(0, 1), cA + hstep, voffA);
        if (wr == 1) PG8_BAR;
        PG8_WAIT_V(2); PG8_BAR;
        PG8_STAGE(PG8_SB(1, 0), cB + kstep, voffB); PG8_STAGE(PG8_SA(1, 0), cA + kstep, voffA); PG8_STAGE(PG8_SB(1, 1), cB + hstep + kstep, voffB);
        PG8_WAIT_V(6); PG8_BAR;
    } else {
        PG8_STAGE(PG8_SB(0, 0), cB, voffB); PG8_STAGE(PG8_SA(0, 0), cA, voffA); PG8_STAGE(PG8_SB(0, 1), cB + hstep, voffB); PG8_STAGE(PG8_SA(0, 1), cA + hstep, voffA);
        if (wr == 1) PG8_BAR;
        PG8_WAIT_V(4); PG8_BAR;
        PG8_STAGE(PG8_SB(1, 0), cB + kstep, voffB); PG8_STAGE(PG8_SA(1, 0), cA + kstep, voffA); PG8_STAGE(PG8_SB(1, 1), cB + hstep + kstep, voffB);
        PG8_WAIT_V(6); PG8_BAR;
    }
    for (;;) {
        const bool has_next = S.next(ui + 1, nxt);
        const char* nA = has_next ? (const char*)g.A + (size_t)nxt.pm * tstep : cA; const char* nB = has_next ? (const char*)g.Bt + (size_t)nxt.pn * tstep : cB;
        for (int t = 0; t < nt; t += 2) {
            const bool last = (t == nt - 2);
            const char* a1 = cA + (size_t)(t + 1) * kstep;
            const char* a2 = last ? nA : cA + (size_t)(t + 2) * kstep; const char* b2 = last ? nB : cB + (size_t)(t + 2) * kstep;
            const char* a3 = a2 + kstep; const char* b3 = b2 + kstep;
            if (last && has_next) S.a_ready(nxt);
            if constexpr (SP2) {
            PG8_LDB(B0, 0, 0); PG8_LDB(B1, 0, 1); PG8_SCHED; PG8_LDA(At, 0, 0); PG8_STAGE(PG8_SA(1, 1), a1 + hstep, voffA);
            PG8_WAIT_V(8); PG8_WAIT_L(0); PG8_BAR; PG8_MMA(0, 0, At, B0); PG8_MMA(0, 1, At, B1); PG8_BAR; PG8_SCHED;
            PG8_LDA(At, 0, 1); PG8_STAGE(PG8_SB(0, 0), b2, voffB); PG8_STAGE(PG8_SB(0, 1), b2 + hstep, voffB); PG8_STAGE(PG8_SA(0, 0), a2, voffA);
            PG8_WAIT_V(8); PG8_WAIT_L(0); PG8_BAR; PG8_MMA(1, 0, At, B0); PG8_MMA(1, 1, At, B1); PG8_BAR; PG8_SCHED;
            PG8_LDB(B0, 1, 0); PG8_LDB(B1, 1, 1); PG8_SCHED; PG8_LDA(At, 1, 0); PG8_STAGE(PG8_SA(0, 1), a2 + hstep, voffA);
            PG8_WAIT_V(8); PG8_WAIT_L(0); PG8_BAR; PG8_MMA(0, 0, At, B0); PG8_MMA(0, 1, At, B1); PG8_BAR; PG8_SCHED;
            PG8_LDA(At, 1, 1); PG8_STAGE(PG8_SB(1, 0), b3, voffB); PG8_STAGE(PG8_SB(1, 1), b3 + hstep, voffB); PG8_STAGE(PG8_SA(1, 0), a3, voffA);
            PG8_WAIT_V(8); PG8_WAIT_L(0); PG8_BAR; PG8_MMA(1, 0, At, B0); PG8_MMA(1, 1, At, B1); PG8_BAR; PG8_SCHED;
            } else {
            PG8_LDB(B0, 0, 0); PG8_SCHED; PG8_LDA(At, 0, 0); PG8_STAGE(PG8_SA(1, 1), a1 + hstep, voffA);
            PG8_WAIT_L(8); PG8_BAR; PG8_WAIT_L(0); PG8_MMA(0, 0, At, B0); PG8_BAR; PG8_SCHED;
            PG8_LDB(B1, 0, 1); PG8_STAGE(PG8_SB(0, 0), b2, voffB);
            PG8_BAR; PG8_WAIT_L(0); PG8_MMA(0, 1, At, B1); PG8_BAR;
            PG8_LDA(At, 0, 1); PG8_STAGE(PG8_SA(0, 0), a2, voffA);
            PG8_BAR; PG8_WAIT_L(0); PG8_MMA(1, 0, At, B0); PG8_BAR; PG8_SCHED;
            PG8_STAGE(PG8_SB(0, 1), b2 + hstep, voffB);
            PG8_WAIT_V(6); PG8_BAR; PG8_MMA(1, 1, At, B1); PG8_BAR;
            PG8_LDB(B0, 1, 0); PG8_SCHED; PG8_LDA(At, 1, 0); PG8_STAGE(PG8_SA(0, 1), a2 + hstep, voffA);
            PG8_WAIT_L(8); PG8_BAR; PG8_WAIT_L(0); PG8_MMA(0, 0, At, B0); PG8_BAR; PG8_SCHED;
            PG8_LDB(B1, 1, 1); PG8_STAGE(PG8_SB(1, 0), b3, voffB);
            PG8_BAR; PG8_WAIT_L(0); PG8_MMA(0, 1, At, B1); PG8_BAR;
            PG8_LDA(At, 1, 1); PG8_STAGE(PG8_SA(1, 0), a3, voffA);
            PG8_BAR; PG8_WAIT_L(0); PG8_MMA(1, 0, At, B0); PG8_BAR; PG8_SCHED;
            PG8_STAGE(PG8_SB(1, 1), b3 + hstep, voffB);
            PG8_WAIT_V(6); PG8_BAR; PG8_MMA(1, 1, At, B1); PG8_BAR;
            }
        }
        if constexpr (ALIGN_EPI) { if (wr == 0) PG8_BAR; }
        if constexpr (!Epi::AFTER_DRAIN) { E(acc, cur, wr, wc, fr, fq); S.done(cur); }
        if (!has_next) break;
#pragma unroll
        for (int a = 0; a < 2; ++a)
#pragma unroll
            for (int b = 0; b < 2; ++b)
#pragma unroll
                for (int m = 0; m < 4; ++m)
#pragma unroll
                    for (int n = 0; n < 2; ++n) acc[a][b][m][n] = (f32x4){0.f, 0.f, 0.f, 0.f};
        cur = nxt; cA = nA; cB = nB; ++ui;
        if constexpr (ALIGN_EPI) { if (wr == 1) PG8_BAR; }
    }
    PG8_WAIT_V(0);
    if constexpr (!ALIGN_EPI) { if (wr == 0) PG8_BAR; }
    PG8_BAR;
    if constexpr (Epi::AFTER_DRAIN) { E.fused(acc, cur, wr, wc, fr, fq, lds, wid, lane); S.done(cur); }
#undef PG8_SA
#undef PG8_SB
#undef PG8_STAGE
#undef PG8_LDA
#undef PG8_LDB
#undef PG8_MMA
#undef PG8_WAIT_V
#undef PG8_WAIT_L
#undef PG8_BAR
#undef PG8_SCHED
}
}

namespace pg8 {
__device__ __forceinline__ float bflo_(unsigned w) { return __builtin_bit_cast(float, w << 16); }
__device__ __forceinline__ float bfhi_(unsigned w) { return __builtin_bit_cast(float, w & 0xffff0000u); }
__device__ __forceinline__ float sigm_(float x) { return 1.f / (1.f + __expf(-x)); }

struct EpiStoreBf16 {
    static constexpr bool PERM = true, AFTER_DRAIN = false;
    bf16_t* O; int ldc;
    __device__ __forceinline__ void operator()(const f32x4 (&acc)[2][2][4][2], const Unit& u, int wr, int wc, int fr, int fq) const {
        const int row0 = u.pm * BM + wr * 64 + fr, col0 = u.pn * BM + wc * 32 + 8 * fq;
#pragma unroll
        for (int ai = 0; ai < 2; ++ai)
#pragma unroll
            for (int m = 0; m < 4; ++m) { bf16_t* rowp = O + (size_t)(row0 + ai * HALF + m * 16) * ldc + col0;
#pragma unroll
                for (int bj = 0; bj < 2; ++bj) { const f32x4 v0 = acc[ai][bj][m][0], v1 = acc[ai][bj][m][1];
                    u32x4 w; w.x = cvt_pk_bf16(v0[0], v0[1]); w.y = cvt_pk_bf16(v0[2], v0[3]); w.z = cvt_pk_bf16(v1[0], v1[1]); w.w = cvt_pk_bf16(v1[2], v1[3]);
                    *(u32x4*)(rowp + bj * HALF) = w; } }
    }
};

struct EpiMerge {
    static constexpr bool PERM = true, AFTER_DRAIN = false;
    const bf16_t* U; int ldu, gcol0; bf16_t* Mf; bf16_t* Mb; int npm;
    __device__ __forceinline__ void operator()(const f32x4 (&acc)[2][2][4][2], const Unit& u, int wr, int wc, int fr, int fq) const {
        const int br = u.pm / npm, pm = u.pm - br * npm, pn = u.pn & 3;
        const int row0 = pm * BM + wr * 64 + fr, col0 = pn * BM + wc * 32 + 8 * fq;
#pragma unroll
        for (int ai = 0; ai < 2; ++ai) {
            u32x4 gv[4][2], pv[4][2];
#pragma unroll
            for (int m = 0; m < 4; ++m)
#pragma unroll
                for (int bj = 0; bj < 2; ++bj) { const size_t row = (size_t)(row0 + ai * HALF + m * 16); const int col = col0 + bj * HALF;
                    gv[m][bj] = *(const u32x4*)(U + row * ldu + gcol0 + br * 1024 + col);
                    pv[m][bj] = br > 0 ? *(const u32x4*)(Mf + row * 1024 + col) : (u32x4){0u, 0u, 0u, 0u}; }
#pragma unroll
            for (int m = 0; m < 4; ++m)
#pragma unroll
                for (int bj = 0; bj < 2; ++bj) { const size_t row = (size_t)(row0 + ai * HALF + m * 16); const int col = col0 + bj * HALF;
                    const u32x4 g = gv[m][bj], p = pv[m][bj];
                    f32x4 v0 = acc[ai][bj][m][0], v1 = acc[ai][bj][m][1];
                    v0[0] = v0[0] * sigm_(bflo_(g.x)) + bflo_(p.x); v0[1] = v0[1] * sigm_(bfhi_(g.x)) + bfhi_(p.x); v0[2] = v0[2] * sigm_(bflo_(g.y)) + bflo_(p.y); v0[3] = v0[3] * sigm_(bfhi_(g.y)) + bfhi_(p.y);
                    v1[0] = v1[0] * sigm_(bflo_(g.z)) + bflo_(p.z); v1[1] = v1[1] * sigm_(bfhi_(g.z)) + bfhi_(p.z); v1[2] = v1[2] * sigm_(bflo_(g.w)) + bflo_(p.w); v1[3] = v1[3] * sigm_(bfhi_(g.w)) + bfhi_(p.w);
                    u32x4 w; w.x = cvt_pk_bf16(v0[0], v0[1]); w.y = cvt_pk_bf16(v0[2], v0[3]); w.z = cvt_pk_bf16(v1[0], v1[1]); w.w = cvt_pk_bf16(v1[2], v1[3]);
                    *(u32x4*)((br < 3 ? Mf : Mb) + row * 1024 + col) = w; }
        }
    }
};
struct MergeOrder {
    int G, c, npm, ncnt;
    __device__ __forceinline__ bool next(int i, Unit& u) const {
        const int su = (i >> 2) * G + c; if (su >= ncnt * 4) return false;
        const int br = i & 3; u.pm = br * npm + (su >> 2); u.pn = br * 4 + (su & 3); return true; }
    __device__ __forceinline__ void a_ready(const Unit&) const {}
    __device__ __forceinline__ void done(const Unit&) const {}
};

struct EpiResid {
    static constexpr bool PERM = false, AFTER_DRAIN = false;
    float* X; const float* gt;
    __device__ __forceinline__ void operator()(const f32x4 (&acc)[2][2][4][2], const Unit& u, int wr, int wc, int fr, int fq) const {
        const int row0 = u.pm * BM + wr * 64 + fr, col0 = u.pn * BM + wc * 32 + 4 * fq;
        const int mr = u.pm < 64 ? (u.pm >> 4) : 4;
        f32x4 gv[2][2];
#pragma unroll
        for (int bj = 0; bj < 2; ++bj)
#pragma unroll
            for (int n = 0; n < 2; ++n) gv[bj][n] = *(const f32x4*)(gt + (size_t)mr * 6144 + col0 + bj * HALF + n * 16);
#pragma unroll
        for (int ai = 0; ai < 2; ++ai) {
            f32x4 xv[4][2][2];
#pragma unroll
            for (int m = 0; m < 4; ++m)
#pragma unroll
                for (int bj = 0; bj < 2; ++bj)
#pragma unroll
                    for (int n = 0; n < 2; ++n) xv[m][bj][n] = *(const f32x4*)(X + (size_t)(row0 + ai * HALF + m * 16) * 1024 + col0 + bj * HALF + n * 16);
#pragma unroll
            for (int m = 0; m < 4; ++m)
#pragma unroll
                for (int bj = 0; bj < 2; ++bj)
#pragma unroll
                    for (int n = 0; n < 2; ++n) *(f32x4*)(X + (size_t)(row0 + ai * HALF + m * 16) * 1024 + col0 + bj * HALF + n * 16) = xv[m][bj][n] + gv[bj][n] * acc[ai][bj][m][n];
        }
    }
};

struct MoeOrder {
    const PG8_LAS int* tpre; int G, c, ncol;
    __device__ __forceinline__ bool next(int i, Unit& u) const {
        int tau, pnl;
        if ((G & 7) == 0 && ((G >> 3) % ncol) == 0) { const int x = c & 7, y = c >> 3, rp = (G >> 3) / ncol; tau = (i * 8 + x) * rp + y / ncol; pnl = y % ncol; }
        else { const int L = i * G + c; tau = L / ncol; pnl = L - tau * ncol; }
        if (tau >= tpre[32]) return false;
        int e = 0;
#pragma unroll 1
        while (tpre[e + 1] <= tau) ++e;
        u.pm = tau; u.pn = e * ncol + pnl; return true; }
    __device__ __forceinline__ void a_ready(const Unit&) const {}
    __device__ __forceinline__ void done(const Unit&) const {}
};
struct EpiSwiglu {
    static constexpr bool PERM = true, AFTER_DRAIN = false;
    bf16_t* ACT; const float* bgu;
    __device__ __forceinline__ void operator()(const f32x4 (&acc)[2][2][4][2], const Unit& u, int wr, int wc, int fr, int fq) const {
        const int e = u.pn >> 3, pnl = u.pn & 7;
        const int row0 = u.pm * BM + wr * 64 + fr, cl = 128 * pnl + wc * 32 + 8 * fq;
        const float* bg = bgu + (size_t)e * 2048 + cl;
        const f32x4 bg0 = *(const f32x4*)bg, bg1 = *(const f32x4*)(bg + 4), bu0 = *(const f32x4*)(bg + 1024), bu1 = *(const f32x4*)(bg + 1028);
#pragma unroll
        for (int ai = 0; ai < 2; ++ai)
#pragma unroll
            for (int m = 0; m < 4; ++m) {
                f32x4 g0 = acc[ai][0][m][0] + bg0, g1 = acc[ai][0][m][1] + bg1, u0 = acc[ai][1][m][0] + bu0, u1 = acc[ai][1][m][1] + bu1;
                float o[8];
#pragma unroll
                for (int j = 0; j < 4; ++j) { const float g = fminf(g0[j], 7.f), up = fminf(fmaxf(u0[j], -7.f), 7.f); o[j] = (up + 1.f) * g * sigm_(1.702f * g); }
#pragma unroll
                for (int j = 0; j < 4; ++j) { const float g = fminf(g1[j], 7.f), up = fminf(fmaxf(u1[j], -7.f), 7.f); o[4 + j] = (up + 1.f) * g * sigm_(1.702f * g); }
                u32x4 w; w.x = cvt_pk_bf16(o[0], o[1]); w.y = cvt_pk_bf16(o[2], o[3]); w.z = cvt_pk_bf16(o[4], o[5]); w.w = cvt_pk_bf16(o[6], o[7]);
                *(u32x4*)(ACT + (size_t)(row0 + ai * HALF + m * 16) * 1024 + cl) = w; }
    }
};
struct EpiDown {
    static constexpr bool PERM = true, AFTER_DRAIN = false;
    bf16_t* YS; const float* bdn;
    __device__ __forceinline__ void operator()(const f32x4 (&acc)[2][2][4][2], const Unit& u, int wr, int wc, int fr, int fq) const {
        const int e = u.pn >> 2, pnl = u.pn & 3;
        const int row0 = u.pm * BM + wr * 64 + fr, col0 = pnl * BM + wc * 32 + 8 * fq;
        f32x4 bv[2][2];
#pragma unroll
        for (int bj = 0; bj < 2; ++bj)
#pragma unroll
            for (int n = 0; n < 2; ++n) bv[bj][n] = *(const f32x4*)(bdn + (size_t)e * 1024 + col0 + bj * HALF + 4 * n);
#pragma unroll
        for (int ai = 0; ai < 2; ++ai)
#pragma unroll
            for (int m = 0; m < 4; ++m) { bf16_t* rowp = YS + (size_t)(row0 + ai * HALF + m * 16) * 1024 + col0;
#pragma unroll
                for (int bj = 0; bj < 2; ++bj) { const f32x4 v0 = acc[ai][bj][m][0] + bv[bj][0], v1 = acc[ai][bj][m][1] + bv[bj][1];
                    u32x4 w; w.x = cvt_pk_bf16(v0[0], v0[1]); w.y = cvt_pk_bf16(v0[2], v0[3]); w.z = cvt_pk_bf16(v1[0], v1[1]); w.w = cvt_pk_bf16(v1[2], v1[3]);
                    *(u32x4*)(rowp + bj * HALF) = w; } }
    }
};
}
#define XB_TMO      128
#define XB_XCNT(j)  (256  + 64 * (j))
#define XB_XSUB(j)  (1280 + 64 * (j))
#define XB_XGEN(j)  (2304 + 64 * (j))
#define XB_TOP      3328
#define XB_TOPGEN   3392
#define XCD_BAR_WORDS 3456
#define XB_SPIN_CAP (1u << 18)
#define LAS __attribute__((address_space(3)))

__device__ __forceinline__ unsigned xb_ld(unsigned* p)              { return __hip_atomic_load(p, __ATOMIC_RELAXED, __HIP_MEMORY_SCOPE_AGENT); }
__device__ __forceinline__ unsigned xb_add(unsigned* p, unsigned v) { return __hip_atomic_fetch_add(p, v, __ATOMIC_RELAXED, __HIP_MEMORY_SCOPE_AGENT); }
__device__ __forceinline__ unsigned xb_xcc_id() { return (unsigned)__builtin_amdgcn_s_getreg((3 << 11) | 20) & 0xFu; }
#define XB_SPIN(cond, bar) do { unsigned _sp = 0; while (cond) { __builtin_amdgcn_s_sleep(1); \
    if ((++_sp & 255u) == 0u) { if (xb_ld(&(bar)[XB_TMO])) break; if (_sp > XB_SPIN_CAP) { atomicAdd(&(bar)[XB_TMO], 1u); break; } } } } while (0)

struct XcdBarrier {
    unsigned* bar; unsigned x;
    volatile LAS unsigned* st;
};

__device__ __forceinline__ XcdBarrier xcd_barrier_post(unsigned* bar, volatile LAS unsigned* st) {
    XcdBarrier b; b.bar = bar; b.x = xb_xcc_id(); b.st = st;
    if (threadIdx.x == 0) (void)xb_add(&bar[XB_XCNT(b.x)], 1u);
    return b;
}
__device__ __forceinline__ void xcd_barrier_complete(unsigned* bar, unsigned x, unsigned& nloc, unsigned& nx) {
    const unsigned G = gridDim.x * gridDim.y * gridDim.z;
    unsigned sum, cnt, mine, sp = 0u;
    for (;;) {
        sum = 0u; cnt = 0u; mine = 0u;
#pragma unroll
        for (unsigned j = 0; j < 16; ++j) { const unsigned c = xb_ld(&bar[XB_XCNT(j)]); sum += c; cnt += (c > 0u) ? 1u : 0u; mine = (j == x) ? c : mine; }
        if (sum == G) break;
        __builtin_amdgcn_s_sleep(1);
        if ((++sp & 255u) == 0u) { if (xb_ld(&bar[XB_TMO])) break; if (sp > XB_SPIN_CAP) { atomicAdd(&bar[XB_TMO], 1u); break; } }
    }
    nloc = mine > 0u ? mine : 1u; nx = cnt > 0u ? cnt : 1u;
}

__device__ __forceinline__ void xcd_barrier(const XcdBarrier& b) {
    asm volatile("s_waitcnt vmcnt(0)" ::: "memory");
    __syncthreads();
    if (threadIdx.x == 0) {
        unsigned* bar = b.bar;
        __builtin_amdgcn_s_waitcnt(0);
        unsigned nloc = b.st[0], nx = b.st[1];
        if (nloc == 0u) { xcd_barrier_complete(bar, b.x, nloc, nx); b.st[0] = nloc; b.st[1] = nx; }
        const unsigned old = xb_add(&bar[XB_XSUB(b.x)], 1u);
        const unsigned gen = old / nloc;
        if (old + 1u == (gen + 1u) * nloc) {
            __builtin_amdgcn_fence(__ATOMIC_RELEASE, "agent");
            asm volatile("s_waitcnt vmcnt(0)" ::: "memory");
            const unsigned og = xb_add(&bar[XB_TOP], 1u);
            const unsigned tg = og / nx;
            if (og + 1u == (tg + 1u) * nx) xb_add(&bar[XB_TOPGEN], 1u);
            else XB_SPIN(xb_ld(&bar[XB_TOPGEN]) == tg, bar);
            __builtin_amdgcn_fence(__ATOMIC_ACQUIRE, "agent");
            xb_add(&bar[XB_XGEN(b.x)], 1u);
            asm volatile("s_waitcnt vmcnt(0)" ::: "memory");
        } else {
            XB_SPIN(xb_ld(&bar[XB_XGEN(b.x)]) == gen, bar);
            __builtin_amdgcn_fence(__ATOMIC_ACQUIRE, "agent");
            asm volatile("s_waitcnt vmcnt(0)" ::: "memory");
        }
    }
    __syncthreads();
}

struct Frame {
    LAS unsigned char* lds;
    unsigned* ctl;
    int tid, lane, wave, G, bid;
    unsigned long long pr;
    const float* const* in; const float* const* in0;
    float* out;
    unsigned char* ws; unsigned char* ws0;
};
#define WSP(T, off) ((T*)(F.ws + (off)))
#define REFRESH_TID(F) do { int t_ = (int)__builtin_amdgcn_mbcnt_hi(~0u, __builtin_amdgcn_mbcnt_lo(~0u, 0u)); asm volatile("" : "+v"(t_)); F.lane = t_; F.tid = F.wave * 64 + t_; \
    int z_ = 0; asm volatile("s_mov_b32 %0, 0" : "=s"(z_)); F.ws = F.ws0 + z_; F.in = F.in0 + z_; F.bid = (int)blockIdx.x + z_; } while (0)
#define I_X 0
#define I_C 1
#define I_CTX 2
#define I_CCTX 3
#define I_WMOD 4
#define I_BMOD 5
#define I_G1 6
#define I_G2 7
#define I_WIN 8
#define I_AGQ 9
#define I_AGK 10
#define I_BCW 11
#define I_BCB 12
#define I_BLAM 13
#define I_BWR 14
#define I_BBR 15
#define I_BWI 16
#define I_BBI 17
#define I_CCW 18
#define I_CALOG 19
#define I_CDTB 20
#define I_CGOUT 21
#define I_RPB 22
#define I_WBR 23
#define I_WOUT 24
#define I_WRT 25
#define I_BRT 26
#define I_WGU 27
#define I_BGU 28
#define I_WDN 29
#define I_BDN 30
#define I_GFIN 31

__device__ __forceinline__ int mod_row(int r) { return r < TLAT ? (r >> 12) : 4; }

__device__ __forceinline__ void p0_transpose_item(const float* W, size_t pitch, int K, bf16* WT, int drow0, int scol0, int k0, LAS float* scr, int lane) {
    float v[32];
#pragma unroll
    for (int i = 0; i < 32; ++i) { const int kk = 2 * i + (lane >> 5); v[i] = W[(size_t)(k0 + kk) * pitch + scol0 + (lane & 31)]; }
#pragma unroll
    for (int i = 0; i < 32; ++i) { const int kk = 2 * i + (lane >> 5); scr[kk * 33 + (lane & 31)] = v[i]; }
    asm volatile("s_waitcnt lgkmcnt(0)" ::: "memory");
    const int c = lane & 7;
#pragma unroll
    for (int j = 0; j < 4; ++j) { const int n = (lane >> 3) + 8 * j; const LAS float* s = scr + (8 * c) * 33 + n;
        v4u o; o.x = pk2(s[0 * 33], s[1 * 33]); o.y = pk2(s[2 * 33], s[3 * 33]); o.z = pk2(s[4 * 33], s[5 * 33]); o.w = pk2(s[6 * 33], s[7 * 33]);
        *(v4u*)(WT + (size_t)(drow0 + n) * K + k0 + 8 * c) = o; }
    asm volatile("s_waitcnt lgkmcnt(0)" ::: "memory");
}

__device__ __forceinline__ void p0_prologue(Frame& F) {
    LAS float* scr = (LAS float*)(F.lds + F.wave * 16384);
    const int gw = F.bid * NWAVES + F.wave, NGW = F.G * NWAVES;
    constexpr int I_IN = DEPTH * 16 * (UW / 32);
    constexpr int I_BR = DEPTH * 4 * 8 * 32;
    constexpr int I_OUT = DEPTH * 16 * 32;
    constexpr int I_GU = DEPTH * NEXP * 16 * 64;
    constexpr int I_DN = DEPTH * NEXP * 16 * 32;
    constexpr int NITEMS = I_IN + I_BR + I_OUT + I_GU + I_DN;
    for (int it = gw; it < NITEMS; it += NGW) {
        int r = it;
        if (r < I_IN) { const int l = r / (16 * 296), q = r % (16 * 296), kb = q / 296, nb = q % 296; const int n0 = nb * 32, sc = n0 < 3840 ? n0 : n0 + 16;
            p0_transpose_item(F.in[I_WIN] + (size_t)l * D * INW, INW, D, WSP(bf16, WS_WIN) + (size_t)l * UW * D, n0, sc, kb * 64, scr, F.lane); continue; }
        r -= I_IN;
        if (r < I_BR) { const int mi = r / 256, q = r % 256, kb = q / 32, nb = q % 32;
            p0_transpose_item(F.in[I_WBR] + (size_t)mi * 512 * 1024, 1024, 512, WSP(bf16, WS_WBR) + (size_t)mi * 1024 * 512, nb * 32, nb * 32, kb * 64, scr, F.lane); continue; }
        r -= I_BR;
        if (r < I_OUT) { const int l = r / 512, q = r % 512, kb = q / 32, nb = q % 32;
            p0_transpose_item(F.in[I_WOUT] + (size_t)l * D * D, D, D, WSP(bf16, WS_WOUT) + (size_t)l * D * D, nb * 32, nb * 32, kb * 64, scr, F.lane); continue; }
        r -= I_OUT;
        if (r < I_GU) { const int mi = r / 1024, q = r % 1024, kb = q / 64, nb = q % 64; const int j0 = nb * 32, pn = j0 >> 8, bj = (j0 >> 7) & 1, cc = j0 & 127;
            p0_transpose_item(F.in[I_WGU] + (size_t)mi * D * 2048, 2048, D, WSP(bf16, WS_WGU) + (size_t)mi * 2048 * D, j0, 1024 * bj + 128 * pn + cc, kb * 64, scr, F.lane); continue; }
        r -= I_GU;
        { const int mi = r / 512, q = r % 512, kb = q / 32, nb = q % 32;
            p0_transpose_item(F.in[I_WDN] + (size_t)mi * D * D, D, D, WSP(bf16, WS_WDN) + (size_t)mi * D * D, nb * 32, nb * 32, kb * 64, scr, F.lane); }
    }
    __syncthreads();
    {
        LAS float* sc = (LAS float*)F.lds;
        LAS float* part = sc + 5 * 1024;
        bool staged = false;
        for (int it = F.bid; it < DEPTH * 96; it += F.G) {
            if (!staged) {
                for (int i = F.tid; i < 5 * 1024; i += NT) { const int r = i >> 10, k = i & 1023; const float cv = r < 4 ? F.in[I_C][r * 1024 + k] : F.in[I_CCTX][k]; sc[i] = siluf_(cv); }
                __syncthreads(); staged = true;
            }
            const int l = it / 96, cg = it % 96, col = cg * 64 + F.lane;
            const float* wm = F.in[I_WMOD] + (size_t)l * D * 6144 + col;
            float a0 = 0.f, a1 = 0.f, a2 = 0.f, a3 = 0.f, a4 = 0.f;
            const int kb = F.wave * 128;
#pragma unroll 16
            for (int k = 0; k < 128; ++k) { const float w = wm[(size_t)(kb + k) * 6144];
                a0 += sc[kb + k] * w; a1 += sc[1024 + kb + k] * w; a2 += sc[2048 + kb + k] * w; a3 += sc[3072 + kb + k] * w; a4 += sc[4096 + kb + k] * w; }
            LAS float* pp = part + F.wave * 320 + F.lane;
            pp[0] = a0; pp[64] = a1; pp[128] = a2; pp[192] = a3; pp[256] = a4;
            __syncthreads();
            if (F.tid < 320) { const int r = F.tid >> 6, ln = F.tid & 63; float s = 0.f;
#pragma unroll
                for (int w = 0; w < 8; ++w) s += part[w * 320 + r * 64 + ln];
                const int cc = cg * 64 + ln;
                WSP(float, WS_MOD)[((size_t)l * 5 + r) * 6144 + cc] = s + F.in[I_BMOD][l * 6144 + cc]; }
            __syncthreads();
        }
    }
    if (F.bid == 0) {
        for (int i = F.tid; i < 1024; i += NT) { const int p = i >> 4, f = i & 15; const float inv = powf(10000.f, -(float)f / 16.f); const float ang = (float)p * inv;
            WSP(float, WS_ROPE)[i] = cosf(ang); WSP(float, WS_ROPE)[1024 + i] = sinf(ang); }
    }
    for (int i = F.bid * NT + F.tid; i < DEPTH * 2 * 2 * 8 * 4096; i += F.G * NT) {
        const int c = i & 63, d = (i >> 6) & 63, n = (i >> 12) & 7, gate = (i >> 15) & 1, ld = i >> 16;
        const float* src = gate ? F.in[I_BWI] : F.in[I_BWR];
        WSP(bf16, WS_LRUW)[i] = (bf16)f2bf(src[((size_t)ld * 8 + n) * 4096 + c * 64 + d]);
    }
}

template <int MODE>
__device__ __forceinline__ void norm_phase(Frame& F, int l) {
    LAS float* hs = (LAS float*)F.lds;
    LAS int* lcnt = (LAS int*)(F.lds + 65536);
    LAS int* lbase = lcnt + 32;
    const int ngroups = ((MODE == 2 || (MODE == 1 && l == DEPTH - 1)) ? TLAT : MROWS) / 16;
    const float* modl = WSP(float, WS_MOD) + (size_t)l * 5 * 6144;
    float pb0[32], pb1[32];
    if (MODE != 2) {
        REFRESH_TID(F);
        const int r16 = F.lane & 15, quad = F.lane >> 4, w = F.wave;
        const size_t stride = MODE == 0 ? (size_t)INW : (size_t)NEXP;
        const float* wp = (MODE == 0 ? F.in[I_WIN] + (size_t)l * D * INW + 3840 : F.in[I_WRT] + (size_t)l * D * NEXP) + (size_t)(128 * w + quad) * stride + r16;
#pragma unroll
        for (int s = 0; s < 32; ++s) { pb0[s] = wp[(size_t)(4 * s) * stride]; pb1[s] = MODE == 1 ? wp[(size_t)(4 * s) * stride + 16] : 0.f; }
    }
#pragma unroll 1
    for (int gi = F.bid; gi < ngroups; gi += F.G) {
        REFRESH_TID(F);
        if (MODE == 1) { if (F.tid < 32) lcnt[F.tid] = 0; }
        constexpr bool COMB = true;
        const bool comb = (MODE == 0 && l > 0) || MODE == 2;
        f32x4 vv[2][4]; v2u yv[2][4][4]; float swv[2][4];
#pragma unroll
        for (int i = 0; i < 2; ++i) {
            const int r = gi * 16 + 2 * F.wave + i;
            const float* xsrc;
            if (MODE == 0 && l == 0) xsrc = r < TLAT ? F.in[I_X] + (size_t)r * D : F.in[I_CTX] + (size_t)(r - TLAT) * D;
            else xsrc = WSP(float, WS_X) + (size_t)r * D;
#pragma unroll
            for (int j = 0; j < 4; ++j) vv[i][j] = *(const f32x4*)(xsrc + 4 * F.lane + 256 * j);
        }
        if (COMB && comb) {
            int srv[2][4];
#pragma unroll
            for (int i = 0; i < 2; ++i)
#pragma unroll
                for (int k = 0; k < 4; ++k) { const int r = gi * 16 + 2 * F.wave + i; srv[i][k] = WSP(int, WS_SROW)[r * 4 + k]; swv[i][k] = WSP(float, WS_SW)[r * 4 + k]; }
#pragma unroll
            for (int i = 0; i < 2; ++i)
#pragma unroll
                for (int k = 0; k < 4; ++k) { const bf16* yr = WSP(bf16, WS_YS) + (size_t)srv[i][k] * D;
#pragma unroll
                    for (int j = 0; j < 4; ++j) yv[i][k][j] = *(const v2u*)(yr + 4 * F.lane + 256 * j); }
        }
#pragma unroll
        for (int i = 0; i < 2; ++i) {
            const int lr = 2 * F.wave + i, r = gi * 16 + lr, mr = mod_row(r);
            f32x4 v[4];
#pragma unroll
            for (int j = 0; j < 4; ++j) v[j] = vv[i][j];
            if (comb) {
                const int lp = MODE == 2 ? DEPTH - 1 : l - 1;
                const float* gt2 = WSP(float, WS_MOD) + ((size_t)lp * 5 + mr) * 6144 + 5120;
                f32x4 cb[4];
#pragma unroll
                for (int j = 0; j < 4; ++j) cb[j] = (f32x4){0.f, 0.f, 0.f, 0.f};
#pragma unroll
                for (int k = 0; k < 4; ++k) { const float w = swv[i][k];
#pragma unroll
                    for (int j = 0; j < 4; ++j) { const v2u y = yv[i][k][j];
                        cb[j].x += w * bflo(y.x); cb[j].y += w * bfhi(y.x); cb[j].z += w * bflo(y.y); cb[j].w += w * bfhi(y.y); }
                }
#pragma unroll
                for (int j = 0; j < 4; ++j) { const f32x4 g = *(const f32x4*)(gt2 + 4 * F.lane + 256 * j); v[j] = v[j] + g * cb[j]; }
            }
            if (MODE == 0) {
#pragma unroll
                for (int j = 0; j < 4; ++j) *(f32x4*)(WSP(float, WS_X) + (size_t)r * D + 4 * F.lane + 256 * j) = v[j];
            }
            float ss = 0.f;
#pragma unroll
            for (int j = 0; j < 4; ++j) ss += (v[j].x * v[j].x + v[j].y * v[j].y) + (v[j].z * v[j].z + v[j].w * v[j].w);
            const float rstd = rsqrtf(wave_sum(ss) * (1.f / D) + EPS);
            if (MODE == 2) {
#pragma unroll
                for (int j = 0; j < 4; ++j) { const f32x4 g = *(const f32x4*)(F.in[I_GFIN] + 4 * F.lane + 256 * j);
                    *(f32x4*)(F.out + (size_t)r * D + 4 * F.lane + 256 * j) = v[j] * rstd * g; }
            } else {
                const float* gn = F.in[MODE == 0 ? I_G1 : I_G2] + l * D;
                const float* sh = modl + (size_t)mr * 6144 + (MODE == 0 ? 0 : 3072);
                const float* sc = sh + 1024;
#pragma unroll
                for (int j = 0; j < 4; ++j) { const int c0 = 4 * F.lane + 256 * j;
                    const f32x4 g = *(const f32x4*)(gn + c0), a = *(const f32x4*)(sh + c0), s = *(const f32x4*)(sc + c0);
                    const f32x4 h = (v[j] * rstd * g) * (s + 1.f) + a;
                    *(LAS f32x4*)(hs + lr * 1024 + c0) = h;
                    v2u o; o.x = pk2(h.x, h.y); o.y = pk2(h.z, h.w);
                    *(v2u*)(WSP(bf16, WS_H) + (size_t)r * D + c0) = o; }
            }
        }
        if (MODE == 2) continue;
        __syncthreads();
        LAS float* red = (LAS float*)(F.lds + 65536 + 256);
        {
            const int r16 = F.lane & 15, quad = F.lane >> 4, w = F.wave;
            const LAS float* hp = hs + r16 * 1024 + 128 * w + quad;
            f32x4 acc0 = (f32x4){0.f, 0.f, 0.f, 0.f}, acc1 = acc0;
#pragma unroll
            for (int s = 0; s < 32; ++s) { const float av = hp[4 * s];
                acc0 = __builtin_amdgcn_mfma_f32_16x16x4f32(av, pb0[s], acc0, 0, 0, 0);
                if (MODE == 1) acc1 = __builtin_amdgcn_mfma_f32_16x16x4f32(av, pb1[s], acc1, 0, 0, 0); }
#pragma unroll
            for (int j = 0; j < 4; ++j) { red[(w * 16 + 4 * quad + j) * 32 + r16] = acc0[j]; if (MODE == 1) red[(w * 16 + 4 * quad + j) * 32 + 16 + r16] = acc1[j]; }
        }
        __syncthreads();
        if (MODE == 0) {
            if (F.tid < 256) {
                const int lr = F.tid >> 4, col = F.tid & 15;
                float sacc = 0.f;
#pragma unroll
                for (int w = 0; w < 8; ++w) sacc += red[(w * 16 + lr) * 32 + col];
                WSP(float, WS_CAB)[(size_t)(gi * 16 + lr) * 16 + col] = sacc;
            }
        } else {
            const int lr = F.tid >> 5, e = F.tid & 31, r = gi * 16 + lr;
            float sacc = 0.f;
#pragma unroll
            for (int w = 0; w < 8; ++w) sacc += red[(w * 16 + lr) * 32 + e];
            const float lg = sacc + F.in[I_BRT][l * NEXP + e];
            float tv0, tv1, tv2, tv3; int ti0, ti1, ti2, ti3; bool taken = false;
#define TOP1(TV, TI) do { float bv = taken ? -INFINITY : lg; int bi = e; \
                _Pragma("unroll") for (int off = 16; off >= 1; off >>= 1) { const float ov = __shfl_xor(bv, off); const int oi = __shfl_xor(bi, off); \
                    if (ov > bv || (ov == bv && oi < bi)) { bv = ov; bi = oi; } } \
                TV = bv; TI = bi; if (bi == e) taken = true; } while (0)
            TOP1(tv0, ti0); TOP1(tv1, ti1); TOP1(tv2, ti2); TOP1(tv3, ti3);
#undef TOP1
            const float e1 = __expf(tv1 - tv0), e2 = __expf(tv2 - tv0), e3 = __expf(tv3 - tv0);
            const float inv = 1.f / (1.f + e1 + e2 + e3);
            const int my_e = e == 0 ? ti0 : (e == 1 ? ti1 : (e == 2 ? ti2 : ti3));
            const float my_w = e == 0 ? inv : (e == 1 ? e1 * inv : (e == 2 ? e2 * inv : e3 * inv));
            int pl = 0;
            if (e < 4) pl = atomicAdd((int*)&lcnt[my_e], 1);
            __syncthreads();
            if (F.tid < 32) { const int c = lcnt[F.tid]; lbase[F.tid] = c > 0 ? (int)__hip_atomic_fetch_add(F.ctl + CW_CNT + l * 32 + F.tid, (unsigned)c, __ATOMIC_RELAXED, __HIP_MEMORY_SCOPE_AGENT) : 0; }
            __syncthreads();
            if (e < 4) { const int p = lbase[my_e] + pl;
                WSP(int, WS_LIST)[(size_t)my_e * MROWS + p] = r * 4 + e;
                WSP(int, WS_SEP)[r * 4 + e] = (my_e << 20) | p;
                WSP(float, WS_SW)[r * 4 + e] = my_w; }
        }
        __syncthreads();
    }
}

__device__ __forceinline__ void moe_table(Frame& F, int l) {
    LAS int* tpre = (LAS int*)(F.lds + MISC_OFF + 256);
    LAS int* cnt = tpre + 40;
    __syncthreads();
    if (F.tid < 32) cnt[F.tid] = (int)__hip_atomic_load(F.ctl + CW_CNT + l * 32 + F.tid, __ATOMIC_RELAXED, __HIP_MEMORY_SCOPE_AGENT);
    __syncthreads();
    if (F.tid == 0) { int s = 0; for (int e = 0; e < 32; ++e) { tpre[e] = s; s += (cnt[e] + 255) >> 8; } tpre[32] = s; }
    __syncthreads();
}
__device__ __forceinline__ void moe_gather(Frame& F, int l) {
    moe_table(F, l);
    const LAS int* tpre = (const LAS int*)(F.lds + MISC_OFF + 256);
    const LAS int* cnt = tpre + 40;
    const int gw = F.bid * NWAVES + F.wave, NGW = F.G * NWAVES;
    REFRESH_TID(F);
    for (int pb_ = gw; pb_ < MROWS; pb_ += NGW) {
        for (int e0 = 0; e0 < NEXP; e0 += 4) {
            int tk[4]; v4u ra[4], rb[4];
#pragma unroll
            for (int k = 0; k < 4; ++k) tk[k] = pb_ < cnt[e0 + k] ? WSP(int, WS_LIST)[(size_t)(e0 + k) * MROWS + pb_] : -1;
#pragma unroll
            for (int k = 0; k < 4; ++k) { const int tok = tk[k] >= 0 ? tk[k] >> 2 : 0; const v4u* src = (const v4u*)(WSP(bf16, WS_H) + (size_t)tok * D); ra[k] = src[F.lane]; rb[k] = src[F.lane + 64]; }
#pragma unroll
            for (int k = 0; k < 4; ++k) if (tk[k] >= 0) { const int dr = tpre[e0 + k] * 256 + pb_; v4u* dst = (v4u*)(WSP(bf16, WS_HS) + (size_t)dr * D); dst[F.lane] = ra[k]; dst[F.lane + 64] = rb[k];
                    if (F.lane == 0) WSP(int, WS_SROW)[tk[k]] = dr; }
        }
        bool more = false;
        for (int e = 0; e < NEXP; ++e) more |= pb_ + NGW < cnt[e];
        if (!more) break;
    }
}

constexpr int AT_KP = 72, AT_VP = 68;
constexpr int AT_KB = 64 * AT_KP * 2, AT_VB = 64 * AT_VP * 2, AT_BUF = AT_KB + AT_VB;
constexpr int AT_RPB = 2 * AT_BUF;

__device__ __forceinline__ float max3f_(float a, float b, float c) { float r; asm("v_max3_f32 %0, %1, %2, %3" : "=v"(r) : "v"(a), "v"(b), "v"(c)); return r; }
struct AttnUnit {
    int kind;
    int b, hx, qx;
};

__device__ __forceinline__ void attn_unit(Frame& F, int l, const AttnUnit un) {
    REFRESH_TID(F);
    const int lane = F.lane, w = F.wave, q32 = lane & 31, hh = lane >> 5;
    const bf16* U = WSP(bf16, WS_U);
    const bool na = (un.kind & 1) != 0, ctxq = un.kind >= 2;
    const int b = un.b;
    int qrow0, qcol, kcol, ycol, nlat, krow_lat0, r_grid = 0, c0 = 0, rs_w = 0;
    const bf16* vt; bf16* Y;
    if (!na) {
        const int head = 4 * un.hx + (w & 3);
        qrow0 = (ctxq ? TLAT + b * LCTX : b * SEQ) + 64 * un.qx + 32 * (w >> 2);
        qcol = UQ + head * 64; kcol = UK + un.hx * 64; ycol = head * 64;
        vt = WSP(bf16, WS_VAT) + (size_t)(b * 2 + un.hx) * 64 * KEYS;
        Y = WSP(bf16, WS_Y);
        nlat = ctxq ? 0 : 64; krow_lat0 = b * SEQ;
    } else {
        const int head = un.hx;
        if (ctxq) { qrow0 = TLAT + b * LCTX + 32 * w; nlat = 0; krow_lat0 = 0; }
        else {
            r_grid = 4 * un.qx + (w >> 1); c0 = 32 * (w & 1);
            qrow0 = b * SEQ + 64 * r_grid + c0;
            int rs_min = 4 * un.qx - 4; rs_min = rs_min < 0 ? 0 : (rs_min > 56 ? 56 : rs_min);
            int rs_max = 4 * un.qx + 3 - 4; rs_max = rs_max < 0 ? 0 : (rs_max > 56 ? 56 : rs_max);
            nlat = rs_max + 8 - rs_min; krow_lat0 = b * SEQ + 64 * rs_min;
            rs_w = r_grid - 4; rs_w = rs_w < 0 ? 0 : (rs_w > 56 ? 56 : rs_w);
            rs_w -= rs_min;
        }
        qcol = UDQ + head * 64; kcol = UDK + head * 64; ycol = head * 64;
        vt = WSP(bf16, WS_VDT) + (size_t)(b * 8 + head) * 64 * KEYS;
        Y = WSP(bf16, WS_Y) + (size_t)3 * MROWS * 512;
    }
    const int vkey_lat0 = krow_lat0 - b * SEQ;
    const int ntile = nlat + 4;
    LAS unsigned char* lds = F.lds;
    if (na && !ctxq) {
        LAS float* rp = (LAS float*)(lds + AT_RPB);
        const float* src = F.in[I_RPB] + ((size_t)l * 8 + un.hx) * 465;
        for (int i = F.tid; i < 465; i += NT) rp[i] = src[i] * LOG2E;
    }
    bf16x8 qf[4];
    {
        const bf16* qp = U + (size_t)(qrow0 + q32) * UW + qcol + 8 * hh;
#pragma unroll
        for (int s = 0; s < 4; ++s) qf[s] = *(const bf16x8*)(qp + 16 * s);
        if (na) {
#pragma unroll
            for (int s = 0; s < 4; ++s) { v4u t = __builtin_bit_cast(v4u, qf[s]); const float sc = 0.125f * LOG2E;
                t.x = pk2(bflo(t.x) * sc, bfhi(t.x) * sc); t.y = pk2(bflo(t.y) * sc, bfhi(t.y) * sc); t.z = pk2(bflo(t.z) * sc, bfhi(t.z) * sc); t.w = pk2(bflo(t.w) * sc, bfhi(t.w) * sc);
                qf[s] = __builtin_bit_cast(bf16x8, t); }
        }
    }
    const int lk = F.tid >> 3, lc = F.tid & 7;
    v4u kr[4], vr[4];
#define AT_TILE_ADDR(i, krow0_, vkey0_) do { const int i_ = (i) < ntile ? (i) : ntile - 1; \
        if (i_ < nlat) { krow0_ = krow_lat0 + 64 * i_; vkey0_ = vkey_lat0 + 64 * i_; } else { krow0_ = TLAT + b * LCTX + 64 * (i_ - nlat); vkey0_ = SEQ + 64 * (i_ - nlat); } } while (0)
#define AT_LDK(dst, i) do { int kr0_, vk0_; AT_TILE_ADDR(i, kr0_, vk0_); (void)vk0_; dst = *(const v4u*)(U + (size_t)(kr0_ + lk) * UW + kcol + lc * 8); } while (0)
#define AT_LDV(dst, i) do { int kr0_, vk0_; AT_TILE_ADDR(i, kr0_, vk0_); (void)kr0_; dst = *(const v4u*)(vt + (size_t)lk * KEYS + vk0_ + lc * 8); } while (0)
#define AT_STK(src, buf) do { *(LAS v4u*)(lds + (buf) * AT_BUF + lk * (AT_KP * 2) + lc * 16) = src; } while (0)
#define AT_STV(src, buf) do { LAS unsigned char* b_ = lds + (buf) * AT_BUF + AT_KB + lk * (AT_VP * 2) + lc * 16; *(LAS v2u*)b_ = (v2u){src.x, src.y}; *(LAS v2u*)(b_ + 8) = (v2u){src.z, src.w}; } while (0)
    float m_run = 0.f, l_run = 0.f;
    f32x16 negm;
#pragma unroll
    for (int i = 0; i < 16; ++i) negm[i] = 0.f;
    bool first = true;
    f32x16 o0, o1;
#pragma unroll
    for (int i = 0; i < 16; ++i) { o0[i] = 0.f; o1[i] = 0.f; }
    const int cq = c0 + q32;
    int cst = cq - 8; cst = cst < 0 ? 0 : (cst > 48 ? 48 : cst);
#define AT_ACTIVE(i) (!(na && !ctxq && (i) < nlat && ((i) < rs_w || (i) > rs_w + 7)))
#define AT_QK(S0, S1, buf) do { const LAS unsigned char* kb_ = lds + (buf) * AT_BUF; \
        _Pragma("unroll") for (int s = 0; s < 4; ++s) { \
            const bf16x8 k0 = *(const LAS bf16x8*)(kb_ + (q32) * (AT_KP * 2) + (16 * s + 8 * hh) * 2); \
            const bf16x8 k1 = *(const LAS bf16x8*)(kb_ + (32 + q32) * (AT_KP * 2) + (16 * s + 8 * hh) * 2); \
            S0 = __builtin_amdgcn_mfma_f32_32x32x16_bf16(k0, qf[s], s == 0 ? negm : S0, 0, 0, 0); \
            S1 = __builtin_amdgcn_mfma_f32_32x32x16_bf16(k1, qf[s], s == 0 ? negm : S1, 0, 0, 0); } } while (0)
#define AT_SOFTMAX_PV(C0, C1, N0, N1, nvalid, i, vbuf) do { \
        if (na && !ctxq && (i) < nlat) { \
            const LAS float* rp = (const LAS float*)(lds + AT_RPB); \
            const int kr_ = (krow_lat0 - b * SEQ) / 64 + (i); const int rb = (kr_ - r_grid + 7) * 31 + 15 - cq; \
            _Pragma("unroll") for (int j = 0; j < 16; ++j) { \
                const int kc0 = (j & 3) + 8 * (j >> 2) + 4 * hh, kc1 = kc0 + 32; \
                const bool ok0 = kc0 >= cst && kc0 < cst + 16, ok1 = kc1 >= cst && kc1 < cst + 16; \
                int i0_ = rb + kc0, i1_ = rb + kc1; i0_ = i0_ < 0 ? 0 : (i0_ > 464 ? 464 : i0_); i1_ = i1_ < 0 ? 0 : (i1_ > 464 ? 464 : i1_); \
                const float b0 = rp[i0_], b1 = rp[i1_]; \
                C0[j] = ok0 ? C0[j] + b0 : -1e30f; C1[j] = ok1 ? C1[j] + b1 : -1e30f; } } \
        float mx = max3f_(C0[0], C1[0], C0[1]); \
        mx = max3f_(mx, C1[1], C0[2]); mx = max3f_(mx, C1[2], C0[3]); mx = max3f_(mx, C1[3], C0[4]); mx = max3f_(mx, C1[4], C0[5]); mx = max3f_(mx, C1[5], C0[6]); \
        mx = max3f_(mx, C1[6], C0[7]); mx = max3f_(mx, C1[7], C0[8]); mx = max3f_(mx, C1[8], C0[9]); mx = max3f_(mx, C1[9], C0[10]); mx = max3f_(mx, C1[10], C0[11]); \
        mx = max3f_(mx, C1[11], C0[12]); mx = max3f_(mx, C1[12], C0[13]); mx = max3f_(mx, C1[13], C0[14]); mx = max3f_(mx, C1[14], C0[15]); mx = fmaxf(mx, C1[15]); \
        mx = fmaxf(mx, __shfl_xor(mx, 32)); \
        if (first || __builtin_amdgcn_ballot_w64(mx > 6.f) != 0ull) {     \
            const float d = first ? fmaxf(mx, -120.f) : fmaxf(mx, 0.f); \
            const float alpha = __builtin_amdgcn_exp2f(-d); \
            l_run *= alpha; m_run += d; \
            _Pragma("unroll") for (int j = 0; j < 16; ++j) { o0[j] *= alpha; o1[j] *= alpha; C0[j] -= d; C1[j] -= d; negm[j] = -m_run; } \
            if (nvalid) { _Pragma("unroll") for (int j = 0; j < 16; ++j) { N0[j] -= d; N1[j] -= d; } } \
            first = false; } \
        float ps = 0.f; \
        _Pragma("unroll") for (int j = 0; j < 16; ++j) { C0[j] = __builtin_amdgcn_exp2f(C0[j]); C1[j] = __builtin_amdgcn_exp2f(C1[j]); ps += C0[j]; ps += C1[j]; } \
        l_run += ps; \
        bf16x8 pb[2][2]; \
        _Pragma("unroll") for (int s2 = 0; s2 < 2; ++s2) { v4u t0, t1; \
            t0.x = pk2(C0[8 * s2 + 0], C0[8 * s2 + 1]); t0.y = pk2(C0[8 * s2 + 2], C0[8 * s2 + 3]); t0.z = pk2(C0[8 * s2 + 4], C0[8 * s2 + 5]); t0.w = pk2(C0[8 * s2 + 6], C0[8 * s2 + 7]); \
            t1.x = pk2(C1[8 * s2 + 0], C1[8 * s2 + 1]); t1.y = pk2(C1[8 * s2 + 2], C1[8 * s2 + 3]); t1.z = pk2(C1[8 * s2 + 4], C1[8 * s2 + 5]); t1.w = pk2(C1[8 * s2 + 6], C1[8 * s2 + 7]); \
            pb[0][s2] = __builtin_bit_cast(bf16x8, t0); pb[1][s2] = __builtin_bit_cast(bf16x8, t1); } \
        const LAS unsigned char* vb_ = lds + (vbuf) * AT_BUF + AT_KB; \
        _Pragma("unroll") for (int sub = 0; sub < 2; ++sub) _Pragma("unroll") for (int s2 = 0; s2 < 2; ++s2) { \
            const int ko = (32 * sub + 16 * s2 + 4 * hh) * 2; \
            const v2u a0 = *(const LAS v2u*)(vb_ + (q32) * (AT_VP * 2) + ko), a1 = *(const LAS v2u*)(vb_ + (q32) * (AT_VP * 2) + ko + 16); \
            const v2u c0_ = *(const LAS v2u*)(vb_ + (32 + q32) * (AT_VP * 2) + ko), c1_ = *(const LAS v2u*)(vb_ + (32 + q32) * (AT_VP * 2) + ko + 16); \
            const bf16x8 vf0 = __builtin_bit_cast(bf16x8, ((v4u){a0.x, a0.y, a1.x, a1.y})); \
            const bf16x8 vf1 = __builtin_bit_cast(bf16x8, ((v4u){c0_.x, c0_.y, c1_.x, c1_.y})); \
            o0 = __builtin_amdgcn_mfma_f32_32x32x16_bf16(vf0, pb[sub][s2], o0, 0, 0, 0); \
            o1 = __builtin_amdgcn_mfma_f32_32x32x16_bf16(vf1, pb[sub][s2], o1, 0, 0, 0); } } while (0)
    f32x16 sa0, sa1, sb0, sb1;
    {
        v4u k0r, k1r, v0r; AT_LDK(k0r, 0); AT_LDK(k1r, 1); AT_LDV(v0r, 0);
#pragma unroll
        for (int st = 0; st < 4; ++st) { AT_LDK(kr[st], st + 2); AT_LDV(vr[st], st + 1); }
        AT_STK(k0r, 0); AT_STK(k1r, 1); AT_STV(v0r, 0);
        lds_barrier();
        if (AT_ACTIVE(0)) AT_QK(sa0, sa1, 0);
        lds_barrier();
    }
    const int ntile4 = (ntile + 3) & ~3;
#pragma unroll 1
    for (int i0 = 0; i0 < ntile4; i0 += 4) {
#pragma unroll
      for (int st = 0; st < 4; ++st) {
        const int i = i0 + st;
        AT_STK(kr[st], st & 1); AT_STV(vr[st], (st + 1) & 1);
        AT_LDK(kr[st], i + 6); AT_LDV(vr[st], i + 5);
        const bool nvalid = (i + 1 < ntile) && AT_ACTIVE(i + 1);
        if (st & 1) { if (nvalid) AT_QK(sa0, sa1, 0); if (i < ntile && AT_ACTIVE(i)) AT_SOFTMAX_PV(sb0, sb1, sa0, sa1, nvalid, i, 1); }
        else        { if (nvalid) AT_QK(sb0, sb1, 1); if (i < ntile && AT_ACTIVE(i)) AT_SOFTMAX_PV(sa0, sa1, sb0, sb1, nvalid, i, 0); }
        lds_barrier();
      }
    }
#undef AT_TILE_ADDR
#undef AT_LDK
#undef AT_LDV
#undef AT_STK
#undef AT_STV
#undef AT_ACTIVE
#undef AT_QK
#undef AT_SOFTMAX_PV
    const float lt = l_run + __shfl_xor(l_run, 32);
    const float inv = 1.f / lt;
    bf16* yp = Y + (size_t)(qrow0 + q32) * 512 + ycol + 4 * hh;
#pragma unroll
    for (int g = 0; g < 4; ++g) {
        v2u a; a.x = pk2(o0[4 * g] * inv, o0[4 * g + 1] * inv); a.y = pk2(o0[4 * g + 2] * inv, o0[4 * g + 3] * inv);
        v2u c; c.x = pk2(o1[4 * g] * inv, o1[4 * g + 1] * inv); c.y = pk2(o1[4 * g + 2] * inv, o1[4 * g + 3] * inv);
        *(v2u*)(yp + 8 * g) = a; *(v2u*)(yp + 32 + 8 * g) = c;
    }
    __syncthreads();
}

__device__ __forceinline__ void attn_phase(Frame& F, int l) {
    const int x = F.bid & 7, y = F.bid >> 3, ny = F.G >> 3;
    for (int q = y; q < 64; q += ny) { AttnUnit un; un.kind = 0; un.b = x >> 1; un.hx = x & 1; un.qx = q; attn_unit(F, l, un); }
    for (int q = y; q < 64; q += ny) { const int combo = x + 8 * (q >> 4); AttnUnit un; un.kind = 1; un.b = combo >> 3; un.hx = combo & 7; un.qx = q & 15; attn_unit(F, l, un); }
    for (int q = y; q < 8; q += ny) { AttnUnit un;
        if (q < 4) { un.kind = 2; un.b = x >> 1; un.hx = x & 1; un.qx = q; }
        else { const int combo = x + 8 * (q - 4); un.kind = 3; un.b = combo >> 3; un.hx = combo & 7; un.qx = 0; }
        attn_unit(F, l, un); }
}


__device__ __forceinline__ void qk_prep(Frame& F, int l) {
    REFRESH_TID(F);
    const int gw = F.bid * NWAVES + F.wave, NGW = F.G * NWAVES, lane = F.lane;
    bf16* U = WSP(bf16, WS_U);
    const float* tab = WSP(float, WS_ROPE);
    const int d0 = (lane & 7) * 8;
    float gq[8], gk[8];
#pragma unroll
    for (int j = 0; j < 8; ++j) { gq[j] = F.in[I_AGQ][l * 64 + d0 + j]; gk[j] = F.in[I_AGK][l * 64 + d0 + j]; }
    for (int r0 = gw; r0 < MROWS; r0 += 2 * NGW) {
        const int r1 = r0 + NGW;
        v4u qv2[2], kv2[2];
#pragma unroll
        for (int k = 0; k < 2; ++k) { const int r = k ? (r1 < MROWS ? r1 : r0) : r0; const bf16* up = U + (size_t)r * UW;
            qv2[k] = *(const v4u*)(up + UQ + lane * 8); kv2[k] = (v4u){0u, 0u, 0u, 0u}; if (lane < 16) kv2[k] = *(const v4u*)(up + UK + lane * 8); }
#pragma unroll
        for (int k = 0; k < 2; ++k) {
        const int r = k ? r1 : r0; if (r >= MROWS) break;
        const bool lat = r < TLAT;
        bf16* up = U + (size_t)r * UW;
        const v4u qv = qv2[k], kv = kv2[k];
        float cs[8], sn[8];
#pragma unroll
        for (int j = 0; j < 8; ++j) { cs[j] = 1.f; sn[j] = 0.f; }
        if (lat) { const int t = r & 4095;
#pragma unroll
            for (int j = 0; j < 8; ++j) { const int i = (d0 + j) & 31; const int idx = i < 16 ? (t >> 6) * 16 + i : (t & 63) * 16 + (i - 16); cs[j] = tab[idx]; sn[j] = tab[1024 + idx]; } }
#pragma unroll
        for (int which = 0; which < 2; ++which) {
            const v4u raw = which ? kv : qv;
            float x[8] = {bflo(raw.x), bfhi(raw.x), bflo(raw.y), bfhi(raw.y), bflo(raw.z), bfhi(raw.z), bflo(raw.w), bfhi(raw.w)};
            float ss = 0.f;
#pragma unroll
            for (int j = 0; j < 8; ++j) ss += x[j] * x[j];
            ss += __shfl_xor(ss, 1); ss += __shfl_xor(ss, 2); ss += __shfl_xor(ss, 4);
            const float rs = rsqrtf(ss * (1.f / 64.f) + EPS);
            float y[8];
#pragma unroll
            for (int j = 0; j < 8; ++j) y[j] = x[j] * rs * (which ? gk[j] : gq[j]);
            const bool hi = (lane & 4) != 0;
#pragma unroll
            for (int j = 0; j < 8; ++j) { const float p = __shfl_xor(y[j], 4);
                if (lat) y[j] = hi ? y[j] * cs[j] + p * sn[j] : y[j] * cs[j] - p * sn[j];
                if (!which) y[j] *= 0.125f * LOG2E; }
            v4u o; o.x = pk2(y[0], y[1]); o.y = pk2(y[2], y[3]); o.z = pk2(y[4], y[5]); o.w = pk2(y[6], y[7]);
            if (!which) *(v4u*)(up + UQ + lane * 8) = o; else if (lane < 16) *(v4u*)(up + UK + lane * 8) = o;
        }
        }
    }
}

__device__ __forceinline__ void v_transpose(Frame& F) {
    REFRESH_TID(F);
    const int gw = F.bid * NWAVES + F.wave, NGW = F.G * NWAVES, lane = F.lane;
    LAS bf16* T = (LAS bf16*)(F.lds + F.wave * 9216);
    const bf16* U = WSP(bf16, WS_U);
    for (int it = gw; it < NCHUNK * 10; it += NGW) {
        const int g = it / 10, hd = it % 10;
        int b, key0;
        if (g < 256) { b = g >> 6; key0 = (g & 63) * 64; } else { b = (g - 256) >> 2; key0 = SEQ + ((g - 256) & 3) * 64; }
        const int scol = hd < 2 ? UV + hd * 64 : UDV + (hd - 2) * 64;
        bf16* dst = hd < 2 ? WSP(bf16, WS_VAT) + (size_t)(b * 2 + hd) * 64 * KEYS : WSP(bf16, WS_VDT) + (size_t)(b * 8 + hd - 2) * 64 * KEYS;
        v4u rv[8];
#pragma unroll
        for (int i = 0; i < 8; ++i) { const int tok = 8 * i + (lane >> 3), ch = lane & 7; rv[i] = *(const v4u*)(U + (size_t)(64 * g + tok) * UW + scol + ch * 8); }
#pragma unroll
        for (int i = 0; i < 8; ++i) { const int tok = 8 * i + (lane >> 3), ch = lane & 7; const unsigned wv[4] = {rv[i].x, rv[i].y, rv[i].z, rv[i].w};
#pragma unroll
            for (int j = 0; j < 4; ++j) { T[(ch * 8 + 2 * j) * 72 + tok] = (bf16)(wv[j] & 0xffffu); T[(ch * 8 + 2 * j + 1) * 72 + tok] = (bf16)(wv[j] >> 16); } }
        asm volatile("s_waitcnt lgkmcnt(0)" ::: "memory");
#pragma unroll
        for (int i = 0; i < 8; ++i) { const int d = 8 * i + (lane >> 3), ch = lane & 7;
            const v4u o = *(const LAS v4u*)(T + d * 72 + ch * 8);
            *(v4u*)(dst + (size_t)d * KEYS + key0 + ch * 8) = o; }
        asm volatile("s_waitcnt lgkmcnt(0)" ::: "memory");
    }
}

constexpr int LR_XCB = 0, LR_WV = 17408, LR_WVB = 12288;
__device__ __forceinline__ void seq_bounds(int g, int& lo, int& hi) {
    if (g < 256) { lo = (g >> 6) * SEQ; hi = lo + SEQ; } else { lo = TLAT + ((g - 256) >> 2) * LCTX; hi = lo + LCTX; }
}
struct LruRaw { v4u r[3]; };
__device__ __forceinline__ void lru_raw_load(Frame& F, LruRaw& R, int g, int q) {
    const bf16* U = WSP(bf16, WS_U);
    int lo, hi; seq_bounds(g, lo, hi);
#pragma unroll
    for (int k = 0; k < 3; ++k) { const int i = F.tid + NT * k, rr = i >> 4, ch = i & 15, row = 64 * g - 1 + rr;
        v4u v = (v4u){0u, 0u, 0u, 0u};
        if (i < 67 * 16 && row >= lo && row < hi) v = *(const v4u*)(U + (size_t)row * UW + UBX + 128 * q + ch * 8);
        R.r[k] = v; }
}
__device__ __forceinline__ void lru_stage_conv(Frame& F, int l, const LruRaw& R, int q) {
    LAS bf16* raw = (LAS bf16*)(F.lds + LR_WV);
    LAS bf16* xcb = (LAS bf16*)(F.lds + LR_XCB);
    __syncthreads();
#pragma unroll
    for (int k = 0; k < 3; ++k) { const int i = F.tid + NT * k, rr = i >> 4, ch = i & 15; if (i < 67 * 16) *(LAS v4u*)(raw + rr * 128 + ch * 8) = R.r[k]; }
    __syncthreads();
    {
        const int ch = F.tid & 127, tg = F.tid >> 7, cabs = 128 * q + ch;
        const float* cw = F.in[I_BCW] + (size_t)l * 4 * 512 + cabs;
        const float w0 = cw[0], w1 = cw[512], w2 = cw[1024], w3 = cw[1536], bb = F.in[I_BCB][l * 512 + cabs];
        float x0 = bf2f(raw[(16 * tg) * 128 + ch]), x1 = bf2f(raw[(16 * tg + 1) * 128 + ch]), x2 = bf2f(raw[(16 * tg + 2) * 128 + ch]);
#pragma unroll
        for (int t = 0; t < 16; ++t) { const float x3 = bf2f(raw[(16 * tg + t + 3) * 128 + ch]);
            const float y = bb + w0 * x0 + w1 * x1 + w2 * x2 + w3 * x3;
            xcb[(16 * tg + t) * 136 + ch] = (bf16)f2bf(y);
            x0 = x1; x1 = x2; x2 = x3; }
    }
    __syncthreads();
}
struct LruW { bf16x8 br0, br1, bi0, bi1; float bR, bI, lam; };
__device__ __forceinline__ void lru_w_load(Frame& F, LruW& W, int l, int dir, int q) {
    const int lane = F.lane, w = F.wave, r16 = lane & 15, quad = lane >> 4;
    const int nbl = w >> 2, dt = w & 3, nb = 2 * q + nbl;
    const bf16* wr = WSP(bf16, WS_LRUW) + ((((size_t)(l * 2 + dir) * 2 + 0) * 8 + nb) * 64 + 16 * dt + r16) * 64 + 8 * quad;
    const bf16* wi = WSP(bf16, WS_LRUW) + ((((size_t)(l * 2 + dir) * 2 + 1) * 8 + nb) * 64 + 16 * dt + r16) * 64 + 8 * quad;
    W.br0 = *(const bf16x8*)wr; W.br1 = *(const bf16x8*)(wr + 32); W.bi0 = *(const bf16x8*)wi; W.bi1 = *(const bf16x8*)(wi + 32);
    const int cabs = 64 * nb + 16 * dt + r16;
    W.bR = F.in[I_BBR][(l * 2 + dir) * 512 + cabs]; W.bI = F.in[I_BBI][(l * 2 + dir) * 512 + cabs]; W.lam = F.in[I_BLAM][(l * 2 + dir) * 512 + cabs];
}
__device__ __forceinline__ void lru_gates(Frame& F, const LruW& W) {
    const int lane = F.lane, w = F.wave, r16 = lane & 15, quad = lane >> 4;
    const LAS bf16* xcb = (const LAS bf16*)(F.lds + LR_XCB);
    LAS float* sa = (LAS float*)(F.lds + LR_WV + w * LR_WVB);
    LAS float* sb = sa + 1024;
    const int nbl = w >> 2, dt = w & 3;
    const int cl = 64 * nbl + 16 * dt + r16;
    const float sp = softplusf_(-W.lam);
#pragma unroll
    for (int tt = 0; tt < 4; ++tt) {
        const LAS bf16* ap = xcb + (16 * tt + r16) * 136 + 64 * nbl + 8 * quad;
        const bf16x8 a0 = *(const LAS bf16x8*)ap, a1 = *(const LAS bf16x8*)(ap + 32);
        f32x4 ar = (f32x4){0.f, 0.f, 0.f, 0.f}, ai = ar;
        ar = __builtin_amdgcn_mfma_f32_16x16x32_bf16(a0, W.br0, ar, 0, 0, 0); ar = __builtin_amdgcn_mfma_f32_16x16x32_bf16(a1, W.br1, ar, 0, 0, 0);
        ai = __builtin_amdgcn_mfma_f32_16x16x32_bf16(a0, W.bi0, ai, 0, 0, 0); ai = __builtin_amdgcn_mfma_f32_16x16x32_bf16(a1, W.bi1, ai, 0, 0, 0);
#pragma unroll
        for (int j = 0; j < 4; ++j) { const int t = 16 * tt + 4 * quad + j;
            const float rg = sigmoidf_(ar[j] + W.bR), ig = sigmoidf_(ai[j] + W.bI);
            const float la = -8.f * rg * sp;
            const float a = __expf(la), x2 = 2.f * la;
            const float om = x2 > -0.05f ? -x2 * (1.f + x2 * (0.5f + x2 * (0.16666667f + x2 * 0.041666668f))) : 1.f - __expf(x2);
            const float mult = __builtin_amdgcn_sqrtf(om);
            const float xv = bf2f(xcb[t * 136 + cl]);
            sa[t * 16 + r16] = a; sb[t * 16 + r16] = mult * ig * xv; }
    }
    asm volatile("s_waitcnt lgkmcnt(0)" ::: "memory");
}
__device__ __forceinline__ void lru_pass1(Frame& F, int l) {
    const bool even = F.G == 256;
    const int nit = even ? (F.bid < 64 ? 2 : 5) : (NCHUNK * 4 - F.bid + F.G - 1) / F.G;
#define LRU1_ITEM(k) (even ? (F.bid < 64 ? F.bid + 64 * (k) : 128 + (F.bid - 64) * 5 + (k)) : F.bid + F.G * (k))
    LruRaw R; REFRESH_TID(F);
    if (nit > 0) { const int i0 = LRU1_ITEM(0); lru_raw_load(F, R, i0 >> 2, i0 & 3); }
#pragma unroll 1
    for (int kk = 0; kk < nit; ++kk) {
        const int it = LRU1_ITEM(kk);
        REFRESH_TID(F);
        const int g = it >> 2, q = it & 3;
        LruW W0, W1; lru_w_load(F, W0, l, 0, q); lru_w_load(F, W1, l, 1, q);
        lru_stage_conv(F, l, R, q);
        { const int itn = kk + 1 < nit ? LRU1_ITEM(kk + 1) : it; lru_raw_load(F, R, itn >> 2, itn & 3); }
#pragma unroll
        for (int dir = 0; dir < 2; ++dir) {
            lru_gates(F, dir ? W1 : W0);
            const int lane = F.lane, w = F.wave, ch = lane & 15, seg = lane >> 4;
            const LAS float* sa = (const LAS float*)(F.lds + LR_WV + w * LR_WVB); const LAS float* sb = sa + 1024;
            float A = 1.f, B = 0.f;
#pragma unroll
            for (int k = 0; k < 16; ++k) { const int tp = 16 * seg + k, t = dir ? 63 - tp : tp; const float a = sa[t * 16 + ch]; B = a * B + sb[t * 16 + ch]; A *= a; }
            float At = 1.f, Bt = 0.f;
#pragma unroll
            for (int s = 0; s < 4; ++s) { const float As = __shfl(A, 16 * s + ch), Bs = __shfl(B, 16 * s + ch); Bt = As * Bt + Bs; At *= As; }
            if (seg == 0) { const int cabs = 128 * q + 64 * (w >> 2) + 16 * (w & 3) + ch;
                WSP(float, WS_LRA)[((size_t)g * 2 + dir) * 512 + cabs] = At; WSP(float, WS_LRB)[((size_t)g * 2 + dir) * 512 + cabs] = Bt; }
            asm volatile("s_waitcnt lgkmcnt(0)" ::: "memory");
        }
    }
}
__device__ __forceinline__ void lru_carry_all(Frame& F) {
    REFRESH_TID(F);
    if (F.tid >= 16) return;
    const float* LA = WSP(float, WS_LRA); const float* LB = WSP(float, WS_LRB); float* LC = WSP(float, WS_LRC);
    for (int chain = F.bid * 16 + F.tid; chain < 4096; chain += F.G * 16) {
        const int ch = chain & 511, dir = (chain >> 9) & 1, b = chain >> 10;
        float h = 0.f;
#pragma unroll 1
        for (int sb = 0; sb < 4; ++sb) {
            float av[17], bv[17]; size_t ix[17];
#pragma unroll
            for (int k = 0; k < 17; ++k) { const int s = sb * 17 + k; int g;
                if (s < 4) g = 256 + 4 * b + (dir ? 3 - s : s); else g = 64 * b + (dir ? 63 - (s - 4) : (s - 4));
                ix[k] = ((size_t)g * 2 + dir) * 512 + ch; av[k] = LA[ix[k]]; bv[k] = LB[ix[k]]; }
#pragma unroll
            for (int k = 0; k < 17; ++k) { LC[ix[k]] = h; h = av[k] * h + bv[k]; }
        }
    }
}
__device__ __forceinline__ float gelu_tanh(float x) { const float u = 0.7978845608028654f * (x + 0.044715f * x * x * x); return x / (1.f + __expf(-2.f * u)); }
__device__ __forceinline__ void lru_pass2(Frame& F, int l) {
    int it = F.bid;
    const int nitems = (l == DEPTH - 1 ? 256 : NCHUNK) * 4;
    LruRaw R; REFRESH_TID(F);
    if (it < nitems) lru_raw_load(F, R, it >> 2, it & 3);
#pragma unroll 1
    for (; it < nitems; it += F.G) {
        REFRESH_TID(F);
        const int g = it >> 2, q = it & 3;
        const int lane = F.lane, w = F.wave, ch = lane & 15, seg = lane >> 4;
        const int cabs = 128 * q + 64 * (w >> 2) + 16 * (w & 3) + ch;
        const bf16* U = WSP(bf16, WS_U); bf16* YB = WSP(bf16, WS_Y) + (size_t)1 * MROWS * 512;
        LruW W0, W1; lru_w_load(F, W0, l, 0, q); lru_w_load(F, W1, l, 1, q);
        const float hc0 = WSP(float, WS_LRC)[((size_t)g * 2 + 0) * 512 + cabs], hc1 = WSP(float, WS_LRC)[((size_t)g * 2 + 1) * 512 + cabs];
        unsigned yraw[16];
#pragma unroll
        for (int k = 0; k < 16; ++k) yraw[k] = U[((size_t)64 * g + 16 * seg + k) * UW + UBY + cabs];
        lru_stage_conv(F, l, R, q);
        { const int itn = it + F.G < nitems ? it + F.G : it; lru_raw_load(F, R, itn >> 2, itn & 3); }
        LAS float* sa = (LAS float*)(F.lds + LR_WV + w * LR_WVB); LAS float* sb = sa + 1024; LAS float* sh = sa + 2048;
#pragma unroll
        for (int dir = 0; dir < 2; ++dir) {
            lru_gates(F, dir ? W1 : W0);
            float A = 1.f, B = 0.f;
#pragma unroll
            for (int k = 0; k < 16; ++k) { const int tp = 16 * seg + k, t = dir ? 63 - tp : tp; const float a = sa[t * 16 + ch]; B = a * B + sb[t * 16 + ch]; A *= a; }
            float h = dir ? hc1 : hc0;
#pragma unroll
            for (int s = 0; s < 3; ++s) { const float As = __shfl(A, 16 * s + ch), Bs = __shfl(B, 16 * s + ch); if (s < seg) h = As * h + Bs; }
#pragma unroll
            for (int k = 0; k < 16; ++k) { const int tp = 16 * seg + k, t = dir ? 63 - tp : tp; h = sa[t * 16 + ch] * h + sb[t * 16 + ch];
                if (dir == 0) sh[t * 16 + ch] = h; else sh[t * 16 + ch] += h; }
            asm volatile("s_waitcnt lgkmcnt(0)" ::: "memory");
        }
#pragma unroll
        for (int k = 0; k < 16; ++k) { const int t = 16 * seg + k; const size_t row = (size_t)64 * g + t;
            YB[row * 512 + cabs] = (bf16)f2bf(sh[t * 16 + ch] * gelu_tanh(bflo(yraw[k]))); }
        asm volatile("s_waitcnt lgkmcnt(0)" ::: "memory");
    }
}

#ifndef GDN_PREP_REPS
#define GDN_PREP_REPS 1
#endif
#ifdef PROBE_SUB
#define GP_T(k) do { if (PROBE_SUB == (k) && F.bid == 0) { const unsigned long long n_ = __builtin_amdgcn_s_memrealtime(); F.pr += n_ - gp_t; } gp_t = __builtin_amdgcn_s_memrealtime(); } while (0)
#else
#define GP_T(k) do { } while (0)
#endif
constexpr int GD_CW = MISC_OFF + 2048;
constexpr int GD_Q = 0, GD_K = 17408, GD_V = 34816, GD_KK = 52224, GD_QK = 68864, GD_L = 85504, GD_SM = 118272;
__device__ __forceinline__ void gdn_prep(Frame& F, int l) {
    const bf16* U = WSP(bf16, WS_U);
    const int w = F.wave;
    __syncthreads();
    for (int i = F.tid; i < 4 * 1536 / 2; i += NT) { const float* cw = F.in[I_CCW] + (size_t)l * 4 * 1536 + 2 * i; ((LAS unsigned*)(F.lds + GD_CW))[i] = pk2(cw[0], cw[1]); }
    __syncthreads();
#pragma unroll 1
    for (int it0 = F.bid; it0 < NCHUNK * 4 * GDN_PREP_REPS; it0 += F.G) {
        const int it = it0 % (NCHUNK * 4);
        int tid = F.tid; asm volatile("" : "+v"(tid));
        const int lane = tid & 63, r16 = lane & 15, quad = lane >> 4;
        const int g = it >> 2, h = it & 3;
        int lo, hi; seq_bounds(g, lo, hi);
        LAS bf16* raw = (LAS bf16*)(F.lds + GD_KK);
#ifdef PROBE_SUB
        unsigned long long gp_t = __builtin_amdgcn_s_memrealtime();
#endif
        __syncthreads();
        {
            v4u rv[7];
#pragma unroll
            for (int k = 0; k < 7; ++k) { const int i = tid + NT * k; const int ten = i / 1072, r_ = i - ten * 1072, rr = r_ >> 4, ch = r_ & 15, row = 64 * g - 1 + rr;
                const int ucol = (ten == 0 ? UCQ : (ten == 1 ? UCK : UCV)) + 128 * h;
                rv[k] = (v4u){0u, 0u, 0u, 0u};
                if (i < 3216 && row >= lo && row < hi) rv[k] = *(const v4u*)(U + (size_t)row * UW + ucol + ch * 8); }
#pragma unroll
            for (int k = 0; k < 7; ++k) { const int i = tid + NT * k; const int ten = i / 1072, r_ = i - ten * 1072, rr = r_ >> 4, ch = r_ & 15;
                if (i < 3216) *(LAS v4u*)(raw + ten * (67 * 128) + rr * 128 + ch * 8) = rv[k]; }
        }
        __syncthreads();
#pragma unroll 1
        for (int ten = 0; ten < 3; ++ten) {
            const int t = tid >> 3, ds = tid & 7;
            const LAS bf16* rawt = raw + ten * (67 * 128);
            const LAS bf16* cwl = (const LAS bf16*)(F.lds + GD_CW) + ten * 512 + 128 * h + 16 * ds;
            float y[16]; float ss = 0.f;
            {
                float xin[4][16], wv_[4][16];
#pragma unroll
                for (int j = 0; j < 4; ++j) { const v4u r0 = *(const LAS v4u*)(rawt + (t + j) * 128 + 16 * ds), r1 = *(const LAS v4u*)(rawt + (t + j) * 128 + 16 * ds + 8);
                    const v4u w0 = *(const LAS v4u*)(cwl + j * 1536), w1 = *(const LAS v4u*)(cwl + j * 1536 + 8);
                    const unsigned rv[8] = {r0.x, r0.y, r0.z, r0.w, r1.x, r1.y, r1.z, r1.w}, wq[8] = {w0.x, w0.y, w0.z, w0.w, w1.x, w1.y, w1.z, w1.w};
#pragma unroll
                    for (int q = 0; q < 8; ++q) { xin[j][2 * q] = bflo(rv[q]); xin[j][2 * q + 1] = bfhi(rv[q]); wv_[j][2 * q] = bflo(wq[q]); wv_[j][2 * q + 1] = bfhi(wq[q]); } }
#pragma unroll
                for (int jj = 0; jj < 16; ++jj) {
                    float a = 0.f;
#pragma unroll
                    for (int j = 0; j < 4; ++j) a += wv_[j][jj] * xin[j][jj];
                    a = siluf_(a); y[jj] = a; ss += a * a;
                }
            }
            float sc = 1.f;
            if (ten < 2) { ss += __shfl_xor(ss, 1); ss += __shfl_xor(ss, 2); ss += __shfl_xor(ss, 4); sc = rsqrtf(ss + EPS); if (ten == 0) sc *= 0.08838834764831845f; }
            LAS bf16* dstp = (LAS bf16*)(F.lds + (ten == 0 ? GD_Q : (ten == 1 ? GD_K : GD_V))) + t * 136 + 16 * ds;
            v4u o0, o1;
            o0.x = pk2(y[0] * sc, y[1] * sc); o0.y = pk2(y[2] * sc, y[3] * sc); o0.z = pk2(y[4] * sc, y[5] * sc); o0.w = pk2(y[6] * sc, y[7] * sc);
            o1.x = pk2(y[8] * sc, y[9] * sc); o1.y = pk2(y[10] * sc, y[11] * sc); o1.z = pk2(y[12] * sc, y[13] * sc); o1.w = pk2(y[14] * sc, y[15] * sc);
            *(LAS v4u*)dstp = o0; *(LAS v4u*)(dstp + 8) = o1;
        }
        __syncthreads();
        const LAS bf16* qs = (const LAS bf16*)(F.lds + GD_Q); const LAS bf16* ks = (const LAS bf16*)(F.lds + GD_K); const LAS bf16* vs = (const LAS bf16*)(F.lds + GD_V);
        GP_T(20);
        {
            const int mat = w >> 2, rt = w & 3;
            const LAS bf16* As = mat ? qs : ks;
            LAS float* Out = (LAS float*)(F.lds + (mat ? GD_QK : GD_KK));
            bf16x8 af[4];
#pragma unroll
            for (int s = 0; s < 4; ++s) af[s] = *(const LAS bf16x8*)(As + (16 * rt + r16) * 136 + 32 * s + 8 * quad);
#pragma unroll
            for (int ct = 0; ct < 4; ++ct) {
                f32x4 acc = (f32x4){0.f, 0.f, 0.f, 0.f};
#pragma unroll
                for (int s = 0; s < 4; ++s) { const bf16x8 bfr = *(const LAS bf16x8*)(ks + (16 * ct + r16) * 136 + 32 * s + 8 * quad);
                    acc = __builtin_amdgcn_mfma_f32_16x16x32_bf16(af[s], bfr, acc, 0, 0, 0); }
#pragma unroll
                for (int j = 0; j < 4; ++j) Out[(16 * rt + 4 * quad + j) * 65 + 16 * ct + r16] = acc[j];
            }
        }
        GP_T(21);
        int tid2 = F.tid; asm volatile("" : "+v"(tid2));
        const int dir = tid2 >> 8, dt = tid2 & 255;
        LAS float* sm = (LAS float*)(F.lds + GD_SM) + dir * 256;
        if (dt < 64) {
            const int ti = dir ? 63 - dt : dt; const size_t row = (size_t)64 * g + ti;
            const float ga = WSP(float, WS_CAB)[row * 16 + dir * 4 + h], gb = WSP(float, WS_CAB)[row * 16 + 8 + dir * 4 + h];
            const float gv = -__expf(F.in[I_CALOG][(l * 2 + dir) * 4 + h]) * softplusf_(ga + F.in[I_CDTB][(l * 2 + dir) * 4 + h]);
            float v = gv;
#pragma unroll
            for (int off = 1; off < 64; off <<= 1) { const float u = __builtin_bit_cast(float, __builtin_amdgcn_ds_bpermute(((lane - off) & 63) << 2, __builtin_bit_cast(int, v))); if (lane >= off) v += u; }
            sm[dt] = gv; sm[64 + dt] = sigmoidf_(gb); sm[128 + dt] = v; sm[192 + dt] = __expf(v);
        }
        __syncthreads();
        size_t cd;
        { int bq, cq_, stp; if (g < 256) { bq = g >> 6; cq_ = g & 63; stp = 4 + (dir ? 63 - cq_ : cq_); } else { bq = (g - 256) >> 2; cq_ = (g - 256) & 3; stp = dir ? 3 - cq_ : cq_; }
          cd = ((size_t)((bq * 4 + h) * 2 + dir)) * 68 + stp; }
        const LAS float* KK = (const LAS float*)(F.lds + GD_KK); const LAS float* QKm = (const LAS float*)(F.lds + GD_QK);
        LAS float* Ls = (LAS float*)(F.lds + GD_L) + dir * 4096;
        {
            bf16* gqk = WSP(bf16, WS_GQK) + cd * 4096;
            for (int idx = dt; idx < 4096; idx += 256) { const int i = idx >> 6, j = idx & 63; const int ti = dir ? 63 - i : i, tj = dir ? 63 - j : j;
                const float dec = j <= i ? __expf(sm[128 + i] - sm[128 + j]) : 0.f;
                Ls[idx] = j < i ? sm[64 + i] * KK[ti * 65 + tj] * dec : 0.f;
                gqk[idx] = (bf16)f2bf(QKm[ti * 65 + tj] * dec); }
        }
        __syncthreads();
        GP_T(22);
        if (F.tid < 256) {
            f32x2_t X[64];
            int ct_ = F.tid; asm volatile("" : "+v"(ct_));
            const int sdir = ct_ >> 7, cp = ct_ & 127;
            const LAS float* sms = (const LAS float*)(F.lds + GD_SM) + sdir * 256;
            const LAS float* Lss = (const LAS float*)(F.lds + GD_L) + sdir * 4096;
            size_t cds;
            { int bq, cq_, stp; if (g < 256) { bq = g >> 6; cq_ = g & 63; stp = 4 + (sdir ? 63 - cq_ : cq_); } else { bq = (g - 256) >> 2; cq_ = (g - 256) & 3; stp = sdir ? 3 - cq_ : cq_; }
              cds = ((size_t)((bq * 4 + h) * 2 + sdir)) * 68 + stp; }
            bf16* outp = WSP(bf16, WS_GW) + cds * 8192 + cp;
#pragma unroll
            for (int i = 0; i < 64; ++i) {
                const int ti = sdir ? 63 - i : i;
                const float be = sms[64 + i];
                f32x2_t a = {be * bf2f(vs[ti * 136 + cp]), be * sms[192 + i] * bf2f(ks[ti * 136 + cp])};
                f32x2_t p0 = {0.f, 0.f}, p1 = p0, p2 = p0, p3 = p0;
#pragma unroll
                for (int j = 0; j < i; ++j) { const float lv = Lss[i * 64 + j]; if ((j & 3) == 0) p0 += X[j] * lv; else if ((j & 3) == 1) p1 += X[j] * lv; else if ((j & 3) == 2) p2 += X[j] * lv; else p3 += X[j] * lv; }
                a -= (p0 + p1) + (p2 + p3);
                X[i] = a;
                outp[i * 128] = (bf16)f2bf(a.y);
                asm volatile("" ::: "memory");
            }
            v4u* up = (v4u*)(WSP(bf16, WS_GU) + cds * 8192 + (size_t)cp * 64);
#pragma unroll
            for (int q8 = 0; q8 < 8; ++q8) { v4u o; o.x = pk2(X[8 * q8].x, X[8 * q8 + 1].x); o.y = pk2(X[8 * q8 + 2].x, X[8 * q8 + 3].x); o.z = pk2(X[8 * q8 + 4].x, X[8 * q8 + 5].x); o.w = pk2(X[8 * q8 + 6].x, X[8 * q8 + 7].x); up[q8] = o; }
        }
        GP_T(23);
        {
            bf16* gqg = WSP(bf16, WS_GQG) + cd * 8192; bf16* gkd = WSP(bf16, WS_GKD) + cd * 8192;
            const float gl = sm[128 + 63];
            for (int idx = dt; idx < 8192; idx += 256) { const int i = idx >> 7, d = idx & 127; const int ti = dir ? 63 - i : i;
                gqg[idx] = (bf16)f2bf(bf2f(qs[ti * 136 + d]) * sm[192 + i]); }
            { const int i = dt & 63; const int ti = dir ? 63 - i : i; const float fk = __expf(gl - sm[128 + i]);
              for (int idx = dt; idx < 8192; idx += 256) { const int d = idx >> 6; gkd[idx] = (bf16)f2bf(bf2f(ks[ti * 136 + d]) * fk); } }
            if (dt == 0) WSP(float, WS_GGL)[cd] = __expf(gl);
        }
        GP_T(24);
    }
    __syncthreads();
}

constexpr int GS_ST = 0, GS_VN = 4352, GS_O = 8192;
struct GdnOps { bf16x8 a[4]; bf16x8 qk[2]; bf16x8 kd[2]; v2u uv; float gl; };
__device__ __forceinline__ bf16x8 ld16_asm(const void* p) { bf16x8 v; asm volatile("global_load_dwordx4 %0, %1, off" : "=v"(v) : "v"(p) : "memory"); return v; }
__device__ __forceinline__ v2u ld8_asm(const void* p) { v2u v; asm volatile("global_load_dwordx2 %0, %1, off" : "=v"(v) : "v"(p) : "memory"); return v; }
__device__ __forceinline__ float ld4_asm(const void* p) { float v; asm volatile("global_load_dword %0, %1, off" : "=v"(v) : "v"(p) : "memory"); return v; }
__device__ __forceinline__ void gdn_load_asm(Frame& F, GdnOps& o, size_t cd, int sl) {
    const int lane = F.lane, w = F.wave, r16 = lane & 15, quad = lane >> 4, rt = w & 3;
    const bf16* ap = (w < 4 ? WSP(bf16, WS_GW) : WSP(bf16, WS_GQG)) + cd * 8192 + (size_t)(16 * rt + r16) * 128 + 8 * quad;
#pragma unroll
    for (int s = 0; s < 4; ++s) o.a[s] = ld16_asm(ap + 32 * s);
    const bf16* kp = WSP(bf16, WS_GKD) + cd * 8192 + (size_t)(16 * w + r16) * 64 + 8 * quad;
    o.kd[0] = ld16_asm(kp); o.kd[1] = ld16_asm(kp + 32);
    const bf16* qp = WSP(bf16, WS_GQK) + cd * 4096 + (size_t)(16 * rt + r16) * 64 + 8 * quad;
    o.qk[0] = ld16_asm(qp); o.qk[1] = ld16_asm(qp + 32);
    o.uv = ld8_asm(WSP(bf16, WS_GU) + cd * 8192 + (size_t)(16 * sl + r16) * 64 + 16 * rt + 4 * quad);
    o.gl = ld4_asm(WSP(float, WS_GGL) + cd);
}
__device__ __forceinline__ void gdn_load(Frame& F, GdnOps& o, size_t cd, int sl) {
    const int lane = F.lane, w = F.wave, r16 = lane & 15, quad = lane >> 4, rt = w & 3;
    const bf16* ap = (w < 4 ? WSP(bf16, WS_GW) : WSP(bf16, WS_GQG)) + cd * 8192 + (size_t)(16 * rt + r16) * 128 + 8 * quad;
#pragma unroll
    for (int s = 0; s < 4; ++s) o.a[s] = *(const bf16x8*)(ap + 32 * s);
    const bf16* kp = WSP(bf16, WS_GKD) + cd * 8192 + (size_t)(16 * w + r16) * 64 + 8 * quad;
    o.kd[0] = *(const bf16x8*)kp; o.kd[1] = *(const bf16x8*)(kp + 32);
    { const bf16* qp = WSP(bf16, WS_GQK) + cd * 4096 + (size_t)(16 * rt + r16) * 64 + 8 * quad; o.qk[0] = *(const bf16x8*)qp; o.qk[1] = *(const bf16x8*)(qp + 32); }
    o.uv = *(const v2u*)(WSP(bf16, WS_GU) + cd * 8192 + (size_t)(16 * sl + r16) * 64 + 16 * rt + 4 * quad);
    o.gl = WSP(float, WS_GGL)[cd];
}
__device__ __forceinline__ size_t gdn_cd(int b, int h, int dir, int s) { return ((size_t)((b * 4 + h) * 2 + dir)) * 68 + s; }
__device__ __forceinline__ int gdn_g(int b, int dir, int s) {
    return s < 4 ? 256 + 4 * b + (dir ? 3 - s : s) : 64 * b + (dir ? 63 - (s - 4) : (s - 4)); }
__device__ __forceinline__ void gdn_scan(Frame& F, int chain) {
    REFRESH_TID(F);
    const int xq = chain & 7, yq = chain >> 3, cg = (yq >> 3) * 8 + xq, sl = yq & 7;
    const int dir = cg & 1, h = (cg >> 1) & 3, b = cg >> 3;
    const int lane = F.lane, w = F.wave, r16 = lane & 15, quad = lane >> 4, rt = w & 3;
    LAS bf16* St = (LAS bf16*)(F.lds + GS_ST); LAS bf16* VNt = (LAS bf16*)(F.lds + GS_VN);
    __syncthreads();
    for (int i = F.tid; i < (GS_VN + 2304) / 4; i += NT) ((LAS unsigned*)F.lds)[i] = 0u;
    __syncthreads();
    f32x4 sacc = (f32x4){0.f, 0.f, 0.f, 0.f};
    float* GO = WSP(float, WS_GO) + (size_t)dir * MROWS * 512;
    LAS float* Ost = (LAS float*)(F.lds + GS_O);
#define GDN_STEP(cur, s_) do { \
          \
        asm volatile("s_waitcnt vmcnt(30)" : "+v"(cur.a[0]), "+v"(cur.a[1]), "+v"(cur.a[2]), "+v"(cur.a[3]), "+v"(cur.kd[0]), "+v"(cur.kd[1]), "+v"(cur.qk[0]), "+v"(cur.qk[1]), "+v"(cur.uv), "+v"(cur.gl) :: "memory"); \
        bf16x8 sbf[4]; \
        _Pragma("unroll") for (int ks = 0; ks < 4; ++ks) sbf[ks] = *(const LAS bf16x8*)(St + r16 * 136 + 32 * ks + 8 * quad); \
        f32x4 acc = (f32x4){0.f, 0.f, 0.f, 0.f}; \
        _Pragma("unroll") for (int ks = 0; ks < 4; ++ks) acc = __builtin_amdgcn_mfma_f32_16x16x32_bf16(cur.a[ks], sbf[ks], acc, 0, 0, 0); \
        if (w < 4) { v2u o; o.x = pk2(bflo(cur.uv.x) - acc[0], bfhi(cur.uv.x) - acc[1]); o.y = pk2(bflo(cur.uv.y) - acc[2], bfhi(cur.uv.y) - acc[3]); \
            *(LAS v2u*)(VNt + r16 * 72 + 16 * rt + 4 * quad) = o; } \
        lds_barrier(); \
        const bf16x8 vb0 = *(const LAS bf16x8*)(VNt + r16 * 72 + 8 * quad), vb1 = *(const LAS bf16x8*)(VNt + r16 * 72 + 32 + 8 * quad); \
        if (w >= 4) { \
            acc = __builtin_amdgcn_mfma_f32_16x16x32_bf16(cur.qk[0], vb0, acc, 0, 0, 0); \
            acc = __builtin_amdgcn_mfma_f32_16x16x32_bf16(cur.qk[1], vb1, acc, 0, 0, 0); \
            _Pragma("unroll") for (int j = 0; j < 4; ++j) Ost[(((s_) & 3) * 64 + 16 * rt + 4 * quad + j) * 16 + r16] = acc[j]; } \
        sacc = sacc * cur.gl; \
        sacc = __builtin_amdgcn_mfma_f32_16x16x32_bf16(cur.kd[0], vb0, sacc, 0, 0, 0); \
        sacc = __builtin_amdgcn_mfma_f32_16x16x32_bf16(cur.kd[1], vb1, sacc, 0, 0, 0); \
        { v2u o; o.x = pk2(sacc[0], sacc[1]); o.y = pk2(sacc[2], sacc[3]); *(LAS v2u*)(St + r16 * 136 + 16 * w + 4 * quad) = o; } \
        lds_barrier(); \
    } while (0)
    GdnOps r0, r1, r2, r3;
    gdn_load_asm(F, r0, gdn_cd(b, h, dir, 0), sl); gdn_load_asm(F, r1, gdn_cd(b, h, dir, 1), sl); gdn_load_asm(F, r2, gdn_cd(b, h, dir, 2), sl); gdn_load_asm(F, r3, gdn_cd(b, h, dir, 3), sl);
#pragma unroll 1
    for (int s = 0; s < 68; s += 4) {
        GDN_STEP(r0, s);     gdn_load_asm(F, r0, gdn_cd(b, h, dir, (s + 4 < 68 ? s + 4 : 67)), sl);
        GDN_STEP(r1, s + 1); gdn_load_asm(F, r1, gdn_cd(b, h, dir, (s + 5 < 68 ? s + 5 : 67)), sl);
        GDN_STEP(r2, s + 2); gdn_load_asm(F, r2, gdn_cd(b, h, dir, (s + 6 < 68 ? s + 6 : 67)), sl);
        GDN_STEP(r3, s + 3);
#pragma unroll
        for (int k2 = 0; k2 < 2; ++k2) { const int idx = F.tid + 512 * k2, st = idx >> 8, i = (idx >> 2) & 63, qd = idx & 3;
            const f32x4 v = *(const LAS f32x4*)(Ost + (st * 64 + i) * 16 + 4 * qd);
            const int g = gdn_g(b, dir, s + st), ti = dir ? 63 - i : i;
            *(f32x4*)(GO + ((size_t)64 * g + ti) * 512 + h * 128 + 16 * sl + 4 * qd) = v; }
        gdn_load_asm(F, r3, gdn_cd(b, h, dir, (s + 7 < 68 ? s + 7 : 67)), sl);
    }
#undef GDN_STEP
    asm volatile("s_waitcnt vmcnt(0)" ::: "memory");
    __syncthreads();
}
template <int NCT> struct GdnOpsW { bf16x8 a[4]; bf16x8 qk[2]; bf16x8 kd[2]; v2u uv[NCT]; float gl; };
template <int NCT>
__device__ __forceinline__ void gdn_load_wide(Frame& F, GdnOpsW<NCT>& o, size_t cd, int part) {
    const int lane = F.lane, w = F.wave, r16 = lane & 15, quad = lane >> 4, rt = w & 3;
    const bf16* ap = (w < 4 ? WSP(bf16, WS_GW) : WSP(bf16, WS_GQG)) + cd * 8192 + (size_t)(16 * rt + r16) * 128 + 8 * quad;
#pragma unroll
    for (int s = 0; s < 4; ++s) o.a[s] = *(const bf16x8*)(ap + 32 * s);
    const bf16* kp = WSP(bf16, WS_GKD) + cd * 8192 + (size_t)(16 * w + r16) * 64 + 8 * quad;
    o.kd[0] = *(const bf16x8*)kp; o.kd[1] = *(const bf16x8*)(kp + 32);
    { const bf16* qp = WSP(bf16, WS_GQK) + cd * 4096 + (size_t)(16 * rt + r16) * 64 + 8 * quad; o.qk[0] = *(const bf16x8*)qp; o.qk[1] = *(const bf16x8*)(qp + 32); }
    const bf16* up = WSP(bf16, WS_GU) + cd * 8192 + (size_t)(part * NCT * 16 + r16) * 64 + 16 * rt + 4 * quad;
#pragma unroll
    for (int ct = 0; ct < NCT; ++ct) o.uv[ct] = *(const v2u*)(up + (size_t)ct * 16 * 64);
    o.gl = WSP(float, WS_GGL)[cd];
}
template <int NCT>
__device__ __forceinline__ void gdn_scan_wide(Frame& F, int cg, int part) {
    REFRESH_TID(F);
    constexpr int NC = NCT * 16, OFF_VN = NC * 136 * 2, OFF_O = OFF_VN + NC * 72 * 2;
    const int dir = cg & 1, h = (cg >> 1) & 3, b = cg >> 3;
    const int lane = F.lane, w = F.wave, r16 = lane & 15, quad = lane >> 4, rt = w & 3;
    LAS bf16* St = (LAS bf16*)(F.lds); LAS bf16* VNt = (LAS bf16*)(F.lds + OFF_VN); LAS float* Ost = (LAS float*)(F.lds + OFF_O);
    __syncthreads();
    for (int i = F.tid; i < OFF_O / 4; i += NT) ((LAS unsigned*)F.lds)[i] = 0u;
    __syncthreads();
    f32x4 sacc[NCT];
#pragma unroll
    for (int ct = 0; ct < NCT; ++ct) sacc[ct] = (f32x4){0.f, 0.f, 0.f, 0.f};
    float* GO = WSP(float, WS_GO) + (size_t)dir * MROWS * 512;
#define GDNW_STEP(cur, s_) do { \
        f32x4 acc[NCT]; \
        _Pragma("unroll") for (int ct = 0; ct < NCT; ++ct) { acc[ct] = (f32x4){0.f, 0.f, 0.f, 0.f}; \
            _Pragma("unroll") for (int ks = 0; ks < 4; ++ks) { const bf16x8 sb = *(const LAS bf16x8*)(St + (16 * ct + r16) * 136 + 32 * ks + 8 * quad); \
                acc[ct] = __builtin_amdgcn_mfma_f32_16x16x32_bf16(cur.a[ks], sb, acc[ct], 0, 0, 0); } } \
        if (w < 4) { _Pragma("unroll") for (int ct = 0; ct < NCT; ++ct) { v2u o; o.x = pk2(bflo(cur.uv[ct].x) - acc[ct][0], bfhi(cur.uv[ct].x) - acc[ct][1]); o.y = pk2(bflo(cur.uv[ct].y) - acc[ct][2], bfhi(cur.uv[ct].y) - acc[ct][3]); \
            *(LAS v2u*)(VNt + (16 * ct + r16) * 72 + 16 * rt + 4 * quad) = o; } } \
        lds_barrier(); \
        _Pragma("unroll") for (int ct = 0; ct < NCT; ++ct) { \
            const bf16x8 vb0 = *(const LAS bf16x8*)(VNt + (16 * ct + r16) * 72 + 8 * quad), vb1 = *(const LAS bf16x8*)(VNt + (16 * ct + r16) * 72 + 32 + 8 * quad); \
            if (w >= 4) { acc[ct] = __builtin_amdgcn_mfma_f32_16x16x32_bf16(cur.qk[0], vb0, acc[ct], 0, 0, 0); acc[ct] = __builtin_amdgcn_mfma_f32_16x16x32_bf16(cur.qk[1], vb1, acc[ct], 0, 0, 0); \
                _Pragma("unroll") for (int j = 0; j < 4; ++j) Ost[(16 * rt + 4 * quad + j) * NC + 16 * ct + r16] = acc[ct][j]; } \
            sacc[ct] = sacc[ct] * cur.gl; \
            sacc[ct] = __builtin_amdgcn_mfma_f32_16x16x32_bf16(cur.kd[0], vb0, sacc[ct], 0, 0, 0); \
            sacc[ct] = __builtin_amdgcn_mfma_f32_16x16x32_bf16(cur.kd[1], vb1, sacc[ct], 0, 0, 0); \
            { v2u o; o.x = pk2(sacc[ct][0], sacc[ct][1]); o.y = pk2(sacc[ct][2], sacc[ct][3]); *(LAS v2u*)(St + (16 * ct + r16) * 136 + 16 * w + 4 * quad) = o; } } \
        lds_barrier(); \
        { const int g = gdn_g(b, dir, (s_)); constexpr int TPR = NC / 16 ;   \
            for (int idx = F.tid; idx < 64 * TPR; idx += NT) { const int i = idx / TPR, c16 = (idx % TPR) * 16, ti = dir ? 63 - i : i; \
                float* gp = GO + ((size_t)64 * g + ti) * 512 + h * 128 + part * NC + c16; \
                _Pragma("unroll") for (int k4 = 0; k4 < 4; ++k4) *(f32x4*)(gp + 4 * k4) = *(const LAS f32x4*)(Ost + i * NC + c16 + 4 * k4); } } \
    } while (0)
    GdnOpsW<NCT> r0, r1;
    gdn_load_wide<NCT>(F, r0, gdn_cd(b, h, dir, 0), part); gdn_load_wide<NCT>(F, r1, gdn_cd(b, h, dir, 1), part);
#pragma unroll 1
    for (int s = 0; s < 68; s += 2) {
        GDNW_STEP(r0, s);     gdn_load_wide<NCT>(F, r0, gdn_cd(b, h, dir, (s + 2 < 68 ? s + 2 : 67)), part);
        GDNW_STEP(r1, s + 1); gdn_load_wide<NCT>(F, r1, gdn_cd(b, h, dir, (s + 3 < 68 ? s + 3 : 67)), part);
    }
#undef GDNW_STEP
    __syncthreads();
}
__device__ __forceinline__ void gdn_out(Frame& F, int l) {
    REFRESH_TID(F);
    const int gw = F.bid * NWAVES + F.wave, NGW = F.G * NWAVES, lane = F.lane;
    const float* G0 = WSP(float, WS_GO); const float* G1 = G0 + (size_t)MROWS * 512;
    const bf16* U = WSP(bf16, WS_U); bf16* YC = WSP(bf16, WS_Y) + (size_t)2 * MROWS * 512;
    const float g0 = F.in[I_CGOUT][l * 128 + 2 * lane], g1 = F.in[I_CGOUT][l * 128 + 2 * lane + 1];
    int rlo, rhi;
    const int nrows = l == DEPTH - 1 ? TLAT : MROWS;
    if (F.G == 256 && l < DEPTH - 1) { if (F.bid < 64) { rlo = 38 * F.bid; rhi = rlo + 38; } else { rlo = 2432 + 78 * (F.bid - 64); rhi = rlo + 78; } }
    else { const int per = (nrows + F.G - 1) / F.G; rlo = per * F.bid; rhi = rlo + per < nrows ? rlo + per : nrows; if (rlo > nrows) rlo = nrows; }
    for (int r0 = rlo + F.wave; r0 < rhi; r0 += 2 * NWAVES) {
        const int r1 = r0 + NWAVES < rhi ? r0 + NWAVES : r0;
        f32x2_t a[2][4], c[2][4]; unsigned zz[2][4];
#pragma unroll
        for (int k = 0; k < 2; ++k) { const int r = k ? r1 : r0;
#pragma unroll
            for (int h = 0; h < 4; ++h) { const size_t o = (size_t)r * 512 + h * 128 + 2 * lane;
                a[k][h] = *(const f32x2_t*)(G0 + o); c[k][h] = *(const f32x2_t*)(G1 + o); zz[k][h] = *(const unsigned*)(U + (size_t)r * UW + UCZ + h * 128 + 2 * lane); } }
#pragma unroll
        for (int k = 0; k < 2; ++k) { const int r = k ? r1 : r0; if (k == 1 && r1 == r0) break;
#pragma unroll
            for (int h = 0; h < 4; ++h) { const float a0 = a[k][h].x + c[k][h].x, a1 = a[k][h].y + c[k][h].y;
                const float ss = wave_sum(a0 * a0 + a1 * a1);
                const float rs = rsqrtf(ss * (1.f / 128.f) + EPS);
                *(unsigned*)(YC + (size_t)r * 512 + h * 128 + 2 * lane) = pk2(a0 * rs * g0 * siluf_(bflo(zz[k][h])), a1 * rs * g1 * siluf_(bfhi(zz[k][h]))); } }
    }
}


struct SideFr { bf16x8 a[4], b0[4], b1[4]; };
__device__ __forceinline__ void side_ld(SideFr& f, const bf16* ap, const bf16* bp0, const bf16* bp1) {
#pragma unroll
    for (int s = 0; s < 4; ++s) { f.a[s] = *(const bf16x8*)(ap + 32 * s); f.b0[s] = *(const bf16x8*)(bp0 + 32 * s); f.b1[s] = *(const bf16x8*)(bp1 + 32 * s); }
}
__device__ __forceinline__ void side_mma(f32x4& c0, f32x4& c1, const SideFr& f) {
#pragma unroll
    for (int s = 0; s < 4; ++s) { c0 = __builtin_amdgcn_mfma_f32_16x16x32_bf16(f.a[s], f.b0[s], c0, 0, 0, 0); c1 = __builtin_amdgcn_mfma_f32_16x16x32_bf16(f.a[s], f.b1[s], c1, 0, 0, 0); }
}
__device__ __forceinline__ void side_merge(Frame& F, int l) {
    REFRESH_TID(F);
    const int lane = F.lane, w = F.wave, r16 = lane & 15, quad = lane >> 4, rt = w & 3, chf = w >> 2;
    const bf16* U = WSP(bf16, WS_U);
    for (int tile = F.bid; tile < 256; tile += F.G) {
        const int row0 = TLAT + 64 * (tile >> 4) + 16 * rt, col0 = 64 * (tile & 15) + 32 * chf;
        f32x4 m0 = (f32x4){0.f, 0.f, 0.f, 0.f}, m1 = m0;
#define SM_AP(q) (WSP(bf16, WS_Y) + ((size_t)((q) >> 2) * MROWS + row0 + r16) * 512 + 8 * quad + 128 * ((q) & 3))
#define SM_BP(q) (WSP(bf16, WS_WBR) + (((size_t)l * 4 + ((q) >> 2)) * 1024 + col0 + r16) * 512 + 8 * quad + 128 * ((q) & 3))
        SideFr fa, fb;
        side_ld(fa, SM_AP(0), SM_BP(0), SM_BP(0) + (size_t)16 * 512);
#pragma unroll 1
        for (int br = 0; br < 4; ++br) {
            f32x4 c0 = (f32x4){0.f, 0.f, 0.f, 0.f}, c1 = c0;
            const int q = br * 4;
            unsigned short gr0[4], gr1[4];
#pragma unroll
            for (int j = 0; j < 4; ++j) { const bf16* gp = U + (size_t)(row0 + 4 * quad + j) * UW + UG + br * 1024 + col0 + r16; gr0[j] = gp[0]; gr1[j] = gp[16]; }
            side_ld(fb, SM_AP(q + 1), SM_BP(q + 1), SM_BP(q + 1) + (size_t)16 * 512); side_mma(c0, c1, fa);
            side_ld(fa, SM_AP(q + 2), SM_BP(q + 2), SM_BP(q + 2) + (size_t)16 * 512); side_mma(c0, c1, fb);
            side_ld(fb, SM_AP(q + 3), SM_BP(q + 3), SM_BP(q + 3) + (size_t)16 * 512); side_mma(c0, c1, fa);
            { const int qn = q + 4 < 16 ? q + 4 : 15; side_ld(fa, SM_AP(qn), SM_BP(qn), SM_BP(qn) + (size_t)16 * 512); }
            side_mma(c0, c1, fb);
#pragma unroll
            for (int j = 0; j < 4; ++j) { m0[j] += sigmoidf_(bf2f(gr0[j])) * c0[j]; m1[j] += sigmoidf_(bf2f(gr1[j])) * c1[j]; }
        }
#undef SM_AP
#undef SM_BP
#pragma unroll
        for (int j = 0; j < 4; ++j) { bf16* mp = WSP(bf16, WS_MB) + (size_t)(row0 + 4 * quad + j) * 1024 + col0 + r16;
            mp[0] = (bf16)f2bf(m0[j]); mp[16] = (bf16)f2bf(m1[j]); }
    }
}
__device__ __forceinline__ void side_outproj(Frame& F, int l) {
    REFRESH_TID(F);
    const int lane = F.lane, w = F.wave, r16 = lane & 15, quad = lane >> 4, rt = w & 3, chf = w >> 2;
    const float* gt = WSP(float, WS_MOD) + ((size_t)l * 5 + 4) * 6144 + 2048;
    for (int tile = F.bid; tile < 256; tile += F.G) {
        const int row0 = TLAT + 64 * (tile >> 4) + 16 * rt, col0 = 64 * (tile & 15) + 32 * chf;
        const bf16* ap = WSP(bf16, WS_MB) + (size_t)(row0 + r16) * 1024 + 8 * quad;
        const bf16* bp0 = WSP(bf16, WS_WOUT) + ((size_t)l * 1024 + col0 + r16) * 1024 + 8 * quad;
        const bf16* bp1 = bp0 + (size_t)16 * 1024;
        f32x4 c0 = (f32x4){0.f, 0.f, 0.f, 0.f}, c1 = c0;
        SideFr fa, fb;
        side_ld(fa, ap, bp0, bp1);
#pragma unroll 1
        for (int kc = 0; kc < 8; kc += 2) {
            side_ld(fb, ap + 128 * (kc + 1), bp0 + 128 * (kc + 1), bp1 + 128 * (kc + 1)); side_mma(c0, c1, fa);
            { const int kn = kc + 2 < 8 ? kc + 2 : 7; side_ld(fa, ap + 128 * kn, bp0 + 128 * kn, bp1 + 128 * kn); }
            side_mma(c0, c1, fb);
        }
        const float g0 = gt[col0 + r16], g1 = gt[col0 + 16 + r16];
#pragma unroll
        for (int j = 0; j < 4; ++j) { float* xp = WSP(float, WS_X) + (size_t)(row0 + 4 * quad + j) * 1024 + col0 + r16;
            xp[0] += g0 * c0[j]; xp[16] += g1 * c1[j]; }
    }
}

#ifndef SCAN_PARTS
#define SCAN_PARTS 2
#endif
constexpr int NSCAN = 4 * SCAN_PARTS;
constexpr int CW_Q = 2048;
__device__ __forceinline__ void mixer_queue_phase(Frame& F, int l) {
    volatile LAS int* qslot = (volatile LAS int*)(F.lds + MISC_OFF + 64);
    const int x0 = (int)(xb_xcc_id() & 7u);
#if defined(PROBE_SUB) && (PROBE_SUB == 4 || PROBE_SUB == 5)
    const unsigned long long tq0 = __builtin_amdgcn_s_memrealtime();
#endif
#pragma unroll 1
    for (int kq = 0; kq < 8; ++kq) {
      const int x = (x0 + kq) & 7;
      for (;;) {
        __syncthreads();
        if (F.tid == 0) *qslot = (int)__hip_atomic_fetch_add(F.ctl + CW_Q + l * 8 + x, 1u, __ATOMIC_RELAXED, __HIP_MEMORY_SCOPE_AGENT);
        __syncthreads();
        const int idx = __builtin_amdgcn_readfirstlane(*qslot);
        if (idx >= (l == DEPTH - 1 ? 128 : 136) + NSCAN) break;
#ifdef PROBE_SUB
        unsigned long long t0_ = 0ull; const bool pr_on = false;
#endif
        if (idx < NSCAN) { gdn_scan_wide<8 / SCAN_PARTS>(F, x + 8 * (idx / SCAN_PARTS), idx % SCAN_PARTS); }
        else { AttnUnit un; const int q = idx - NSCAN;
            if (q < 64) { un.kind = 0; un.b = x >> 1; un.hx = x & 1; un.qx = q; }
            else if (q < 128) { const int qq = q - 64, combo = x + 8 * (qq >> 4); un.kind = 1; un.b = combo >> 3; un.hx = combo & 7; un.qx = qq & 15; }
            else { const int qq = q - 128;
                if (qq < 4) { un.kind = 2; un.b = x >> 1; un.hx = x & 1; un.qx = qq; }
                else { const int combo = x + 8 * (qq - 4); un.kind = 3; un.b = combo >> 3; un.hx = combo & 7; un.qx = 0; } }
            attn_unit(F, l, un); }
#ifdef PROBE_SUB
        if (pr_on) F.pr += __builtin_amdgcn_s_memrealtime() - t0_;
        if (PROBE_SUB == 13 && F.bid == 8 && idx >= 4 && idx < 68) F.pr += 100;
        if (PROBE_SUB == 14 && F.bid == 8 && idx >= 68 && idx < 140) F.pr += 100;
#endif
      }
    }
#if defined(PROBE_SUB) && PROBE_SUB == 4
    if (F.tid == 0) __hip_atomic_fetch_max(F.ctl + 3000 + l, (unsigned)(__builtin_amdgcn_s_memrealtime() - tq0), __ATOMIC_RELAXED, __HIP_MEMORY_SCOPE_AGENT);
#endif
#if defined(PROBE_SUB) && PROBE_SUB == 5
    if (F.tid == 0) __hip_atomic_fetch_max(F.ctl + 3000 + l, 0x7fffffffu - (unsigned)(__builtin_amdgcn_s_memrealtime() - tq0), __ATOMIC_RELAXED, __HIP_MEMORY_SCOPE_AGENT);
#endif
}

#ifndef REP_P0
#define REP_P0 1
#endif
#ifndef REP_B
#define REP_B 1
#endif
#ifndef REP_D1
#define REP_D1 1
#endif
#ifndef REP_D2
#define REP_D2 1
#endif
#ifndef REP_E
#define REP_E 1
#endif
#ifndef REP_F
#define REP_F 1
#endif
#ifndef REP_I
#define REP_I 1
#endif
#ifndef REP_J
#define REP_J 1
#endif
#ifndef REP_C1
#define REP_C1 1
#endif
#ifndef REP_C2
#define REP_C2 1
#endif
#ifndef REP_C4
#define REP_C4 1
#endif
#ifndef REP_G2
#define REP_G2 1
#endif

#ifndef MIXER_QUEUE
#define MIXER_QUEUE 1
#endif
constexpr int PH_PER_LAYER = 11, PH_FINAL = 1 + PH_PER_LAYER * DEPTH, N_PHASES = PH_FINAL + 1;
struct Args { const float* in[32]; float* out; unsigned char* ws; int ph_lo, ph_hi, li, pad; };

__global__ void __launch_bounds__(NT, 2) hybrid_fwd(Args args) {
    extern __shared__ __attribute__((aligned(16))) unsigned char lds_raw[];
    Frame F;
    F.lds = (LAS unsigned char*)lds_raw;
    F.wave = __builtin_amdgcn_readfirstlane((int)threadIdx.x >> 6); F.lane = (int)__builtin_amdgcn_mbcnt_hi(~0u, __builtin_amdgcn_mbcnt_lo(~0u, 0u)); F.tid = F.wave * 64 + F.lane;
    F.G = gridDim.x; F.bid = blockIdx.x; F.pr = 0ull;
    F.in = args.in; F.in0 = args.in;
    F.out = args.out; F.ws = args.ws; F.ws0 = args.ws; F.ctl = (unsigned*)(args.ws + WS_CTL);
    volatile LAS unsigned* MISC = (volatile LAS unsigned*)(F.lds + MISC_OFF);
    if (F.tid < 64) MISC[F.tid] = 0u;
    __syncthreads();
    const int lo = args.ph_lo, hi = args.ph_hi;
    XcdBarrier bar = xcd_barrier_post(F.ctl + CW_BAR + args.li * XCD_BAR_WORDS, MISC + 8);
#ifndef ONLY_MASK
#define ONLY_MASK 0xFFFF
#endif
#define PHON(b) ((ONLY_MASK >> (b)) & 1)
#define IN(k) (lo <= (k) && (k) < hi)
#define SEAM(k) do { if ((k) + 1 < hi) xcd_barrier(bar); } while (0)
#ifdef PROBE_PHASE
    unsigned long long pr_acc = 0ull, pr_t0 = 0ull;
#define PR_BEGIN(k) do { if ((k) == PROBE_PHASE) pr_t0 = __builtin_amdgcn_s_memrealtime(); } while (0)
#define PR_END(k) do { if ((k) == PROBE_PHASE) pr_acc += __builtin_amdgcn_s_memrealtime() - pr_t0; } while (0)
#else
#define PR_BEGIN(k) do { } while (0)
#define PR_END(k) do { } while (0)
#endif

    if (PHON(0) && IN(0)) { REFRESH_TID(F); _Pragma("unroll 1") for (int rep_ = 0; rep_ < REP_P0; ++rep_) { p0_prologue(F); __syncthreads(); } SEAM(0); PR_END(0); }
#pragma unroll 1
    for (int l = 0; l < DEPTH; ++l) {
        const int pb = 1 + PH_PER_LAYER * l;
        if (PHON(1) && IN(pb + 0)) { PR_BEGIN(1); REFRESH_TID(F); norm_phase<0>(F, l); SEAM(pb + 0); PR_END(1); }
        if (PHON(2) && IN(pb + 1)) { PR_BEGIN(2); REFRESH_TID(F);
            pg8::Gemm g{WSP(bf16, WS_H), WSP(bf16, WS_WIN) + (size_t)l * UW * D, MROWS, UW, D};
            pg8::StaticOrder S; S.init(MROWS, UW, F.G, F.bid);
            pg8::EpiStoreBf16 E{WSP(bf16, WS_U), UW};
            _Pragma("unroll 1") for (int rep_ = 0; rep_ < REP_B; ++rep_) { pg8::gemm_phase<pg8::EpiStoreBf16, pg8::StaticOrder, true, true>(F.lds, g, S, E, F.wave); __syncthreads(); }
            SEAM(pb + 1); PR_END(2);
        }
        if (PHON(3) && IN(pb + 2)) { PR_BEGIN(3); REFRESH_TID(F);
#ifndef NO_C1
            PR_BEGIN(30); _Pragma("unroll 1") for (int rep_ = 0; rep_ < REP_C1; ++rep_) { gdn_prep(F, l); __syncthreads(); } PR_END(30);
#endif
#ifndef NO_C2
            PR_BEGIN(31); _Pragma("unroll 1") for (int rep_ = 0; rep_ < REP_C2; ++rep_) { lru_pass1(F, l); __syncthreads(); } PR_END(31);
#endif
            __syncthreads();
#ifndef NO_C3
            PR_BEGIN(32); qk_prep(F, l); PR_END(32);
#endif
#ifndef NO_C4
            PR_BEGIN(33); _Pragma("unroll 1") for (int rep_ = 0; rep_ < REP_C4; ++rep_) { v_transpose(F); __syncthreads(); } PR_END(33); PR_BEGIN(34);
#endif
            SEAM(pb + 2); PR_END(34); PR_END(3);
        }
        if (PHON(4) && IN(pb + 3)) { PR_BEGIN(4); REFRESH_TID(F);
#if MIXER_QUEUE
            lru_carry_all(F);
            __syncthreads();
            mixer_queue_phase(F, l);
#else
            PR_BEGIN(20); for (int ch = F.bid; ch < 256; ch += F.G) gdn_scan(F, ch); PR_END(20);
            PR_BEGIN(21); lru_carry_all(F);
            __syncthreads(); PR_END(21);
            PR_BEGIN(22); attn_phase(F, l); PR_END(22);
#endif
            PR_BEGIN(23);
            SEAM(pb + 3); PR_END(23); PR_END(4);
        }
        if (PHON(5) && IN(pb + 4)) { PR_BEGIN(5); REFRESH_TID(F);
            _Pragma("unroll 1") for (int rep_ = 0; rep_ < REP_E; ++rep_) { lru_pass2(F, l); __syncthreads(); }
            __syncthreads();
            gdn_out(F, l);
            SEAM(pb + 4); PR_END(5);
        }
        if (PHON(6) && IN(pb + 5)) { PR_BEGIN(6); REFRESH_TID(F);
            pg8::Gemm g{WSP(bf16, WS_Y), WSP(bf16, WS_WBR) + (size_t)l * 4 * 1024 * 512, 4 * MROWS, 4 * 1024, 512};
            pg8::MergeOrder S{F.G, F.bid, MROWS / 256, TLAT / 256};
            pg8::EpiMerge E{WSP(bf16, WS_U), UW, UG, WSP(bf16, WS_MF), WSP(bf16, WS_MB), MROWS / 256};
            _Pragma("unroll 1") for (int rep_ = 0; rep_ < REP_F; ++rep_) { pg8::gemm_phase<pg8::EpiMerge, pg8::MergeOrder, true, true>(F.lds, g, S, E, F.wave); __syncthreads(); }
            PR_BEGIN(13); if (l < DEPTH - 1) side_merge(F, l); PR_END(13);
            SEAM(pb + 5); PR_END(6);
        }
        if (PHON(7) && IN(pb + 6)) { PR_BEGIN(7); REFRESH_TID(F);
            pg8::Gemm g{WSP(bf16, WS_MB), WSP(bf16, WS_WOUT) + (size_t)l * D * D, MROWS, D, D};
            pg8::StaticOrder S; S.init(TLAT, D, F.G, F.bid);
            pg8::EpiResid E{WSP(float, WS_X), WSP(float, WS_MOD) + (size_t)l * 5 * 6144 + 2048};
            pg8::gemm_phase<pg8::EpiResid, pg8::StaticOrder, true, true>(F.lds, g, S, E, F.wave);
            PR_BEGIN(14); if (l < DEPTH - 1) side_outproj(F, l); PR_END(14);
            SEAM(pb + 6); PR_END(7);
        }
        if (PHON(8) && IN(pb + 7)) { PR_BEGIN(8); REFRESH_TID(F); norm_phase<1>(F, l); SEAM(pb + 7); PR_END(8); }
        if (PHON(9) && IN(pb + 8)) { PR_BEGIN(9); REFRESH_TID(F); _Pragma("unroll 1") for (int rep_ = 0; rep_ < REP_G2; ++rep_) { moe_gather(F, l); __syncthreads(); } SEAM(pb + 8); PR_END(9); }
        if (PHON(10) && IN(pb + 9)) { PR_BEGIN(10); REFRESH_TID(F);
            moe_table(F, l);
            pg8::Gemm g{WSP(bf16, WS_HS), WSP(bf16, WS_WGU) + (size_t)l * NEXP * 2048 * D, MOE_ROWS, NEXP * 2048, D};
            pg8::MoeOrder S{(const LAS int*)(F.lds + MISC_OFF + 256), F.G, F.bid, 8};
            pg8::EpiSwiglu E{WSP(bf16, WS_ACT), F.in[I_BGU] + (size_t)l * NEXP * 2048};
            _Pragma("unroll 1") for (int rep_ = 0; rep_ < REP_I; ++rep_) { pg8::gemm_phase<pg8::EpiSwiglu, pg8::MoeOrder, true, true>(F.lds, g, S, E, F.wave); __syncthreads(); }
            SEAM(pb + 9); PR_END(10);
        }
        if (PHON(11) && IN(pb + 10)) { PR_BEGIN(11); REFRESH_TID(F);
            moe_table(F, l);
            pg8::Gemm g{WSP(bf16, WS_ACT), WSP(bf16, WS_WDN) + (size_t)l * NEXP * D * D, MOE_ROWS, NEXP * D, D};
            pg8::MoeOrder S{(const LAS int*)(F.lds + MISC_OFF + 256), F.G, F.bid, 4};
            pg8::EpiDown E{WSP(bf16, WS_YS), F.in[I_BDN] + (size_t)l * NEXP * D};
            _Pragma("unroll 1") for (int rep_ = 0; rep_ < REP_J; ++rep_) { pg8::gemm_phase<pg8::EpiDown, pg8::MoeOrder, true, true>(F.lds, g, S, E, F.wave); __syncthreads(); }
            SEAM(pb + 10); PR_END(11);
        }
    }
    if (PHON(12) && IN(PH_FINAL)) { PR_BEGIN(12); REFRESH_TID(F); norm_phase<2>(F, 0); PR_END(12); }
#if defined(PROBE_SUB) && (PROBE_SUB == 4 || PROBE_SUB == 5)
    if (blockIdx.x == 0) { unsigned long long tot = 0ull;
        for (int q = 0; q < 4; ++q) { const unsigned v = __hip_atomic_load(F.ctl + 3000 + q, __ATOMIC_RELAXED, __HIP_MEMORY_SCOPE_AGENT); tot += (PROBE_SUB == 4) ? v : (0x7fffffffu - v); }
        F.pr = tot; }
#endif
#ifdef PROBE_SUB
    if (F.pr) { const unsigned long long te = __builtin_amdgcn_s_memrealtime(); while (__builtin_amdgcn_s_memrealtime() - te < PROBE_MULT * F.pr) __builtin_amdgcn_s_sleep(8); }
#endif
#ifdef PROBE_PHASE
    if (blockIdx.x == 0) { const unsigned long long te = __builtin_amdgcn_s_memrealtime(); while (__builtin_amdgcn_s_memrealtime() - te < PROBE_MULT * pr_acc) __builtin_amdgcn_s_sleep(8); }
#endif
#undef IN
#undef SEAM
}

extern "C" void kernel_launch(void* const* d_in, const int* in_sizes, int n_in, void* d_out, int out_size, void* d_ws, size_t ws_size, hipStream_t stream) {
    static int grid = 0;
    if (grid == 0) {
        if (n_in != 32 || out_size != TLAT * D || ws_size < WS_END) { fprintf(stderr, "kernel_launch: unexpected shapes (n_in %d out %d ws %zu need %zu)\n", n_in, out_size, ws_size, (size_t)WS_END); grid = -1; return; }
        int dev = 0, cus = 0, per_cu = 0;
        if (hipGetDevice(&dev) != hipSuccess || hipDeviceGetAttribute(&cus, hipDeviceAttributeMultiprocessorCount, dev) != hipSuccess) { grid = -1; return; }
        if (hipFuncSetAttribute((const void*)hybrid_fwd, hipFuncAttributeMaxDynamicSharedMemorySize, LDS_BYTES) != hipSuccess) { fprintf(stderr, "kernel_launch: hipFuncSetAttribute failed\n"); grid = -1; return; }
        if (hipOccupancyMaxActiveBlocksPerMultiprocessor(&per_cu, (const void*)hybrid_fwd, NT, LDS_BYTES) != hipSuccess || per_cu < 1) fprintf(stderr, "kernel_launch: occupancy query says %d\n", per_cu);
        (void)hipGetLastError();
        grid = cus;
    }
    if (grid < 0) return;
    if (hipMemsetAsync((char*)d_ws + WS_CTL, 0, CTL_BYTES, stream) != hipSuccess) return;
    Args a{};
    for (int i = 0; i < 32; ++i) a.in[i] = (const float*)d_in[i];
    a.out = (float*)d_out; a.ws = (unsigned char*)d_ws;
#if MK_MULTI
    for (int p = 0; p < N_PHASES; ++p) { a.ph_lo = p; a.ph_hi = p + 1; a.li = p;
        hipLaunchKernelGGL(hybrid_fwd, dim3(grid), dim3(NT), LDS_BYTES, stream, a); }
#else
    a.ph_lo = 0; a.ph_hi = N_PHASES; a.li = 0;
    hipLaunchKernelGGL(hybrid_fwd, dim3(grid), dim3(NT), LDS_BYTES, stream, a);
#endif
    const hipError_t le = hipPeekAtLastError();
    if (le != hipSuccess) fprintf(stderr, "kernel_launch: launch failed: %s\n", hipGetErrorName(le));
}
```

```cpp
#include <hip/hip_runtime.h>
#include <cstdio>
#include <cstdint>

#ifndef MK_MULTI
#define MK_MULTI 0
#endif

constexpr int D = 1024, NB = 4, SEQ = 4096, LCTX = 256, DEPTH = 4;
constexpr int TLAT = NB * SEQ, TCTX = NB * LCTX, MROWS = TLAT + TCTX;
constexpr int NCHUNK = MROWS / 64;
constexpr int INW = 9488, UW = 9472;
constexpr int UQ = 0, UK = 512, UV = 640, UBX = 768, UBY = 1280, UCQ = 1792, UCK = 2304, UCV = 2816, UCZ = 3328, UDQ = 3840, UDK = 4352, UDV = 4864, UG = 5376;
constexpr int NEXP = 32, TOPK = 4;
constexpr int KEYS = SEQ + LCTX;
constexpr int MOE_ROWS = MROWS * TOPK + NEXP * 256;
constexpr float EPS = 1e-6f;
constexpr float LOG2E = 1.4426950408889634f;

constexpr size_t al256(size_t x) { return (x + 255) & ~(size_t)255; }
constexpr size_t WS_CTL = 0, CTL_BYTES = 1u << 20;
constexpr size_t WS_MOD  = WS_CTL + CTL_BYTES;
constexpr size_t WS_ROPE = WS_MOD + al256((size_t)DEPTH * 5 * 6144 * 4);
constexpr size_t WS_LRUW = WS_ROPE + al256(2 * 64 * 16 * 4);
constexpr size_t WS_WIN  = WS_LRUW + al256((size_t)DEPTH * 2 * 2 * 8 * 4096 * 2);
constexpr size_t WS_WBR  = WS_WIN + al256((size_t)DEPTH * UW * D * 2);
constexpr size_t WS_WOUT = WS_WBR + al256((size_t)DEPTH * 4 * 1024 * 512 * 2);
constexpr size_t WS_WGU  = WS_WOUT + al256((size_t)DEPTH * D * D * 2);
constexpr size_t WS_WDN  = WS_WGU + al256((size_t)DEPTH * NEXP * 2048 * 1024 * 2);
constexpr size_t WS_X    = WS_WDN + al256((size_t)DEPTH * NEXP * 1024 * 1024 * 2);
constexpr size_t WS_H    = WS_X + al256((size_t)MROWS * D * 4);
constexpr size_t WS_U    = WS_H + al256((size_t)MROWS * D * 2);
constexpr size_t WS_CAB  = WS_U + al256((size_t)MROWS * UW * 2);
constexpr size_t WS_VAT  = WS_CAB + al256((size_t)MROWS * 16 * 4);
constexpr size_t WS_VDT  = WS_VAT + al256((size_t)NB * 2 * 64 * KEYS * 2);
constexpr size_t WS_LRA  = WS_VDT + al256((size_t)NB * 8 * 64 * KEYS * 2);
constexpr size_t WS_LRB  = WS_LRA + al256((size_t)NCHUNK * 2 * 512 * 4);
constexpr size_t WS_LRC  = WS_LRB + al256((size_t)NCHUNK * 2 * 512 * 4);
constexpr int NCD = NCHUNK * 4 * 2;
constexpr size_t WS_GW   = WS_LRC + al256((size_t)NCHUNK * 2 * 512 * 4);
constexpr size_t WS_GU   = WS_GW + al256((size_t)NCD * 64 * 128 * 2);
constexpr size_t WS_GQG  = WS_GU + al256((size_t)NCD * 64 * 128 * 2);
constexpr size_t WS_GKD  = WS_GQG + al256((size_t)NCD * 64 * 128 * 2);
constexpr size_t WS_GQK  = WS_GKD + al256((size_t)NCD * 64 * 128 * 2);
constexpr size_t WS_GGL  = WS_GQK + al256((size_t)NCD * 64 * 64 * 2);
constexpr size_t WS_GO   = WS_GGL + al256((size_t)NCD * 4);
constexpr size_t WS_Y    = WS_GO + al256((size_t)2 * MROWS * 512 * 4);
constexpr size_t WS_MF   = WS_Y + al256((size_t)4 * MROWS * 512 * 2);
constexpr size_t WS_MB   = WS_MF + al256((size_t)MROWS * D * 4);
constexpr size_t WS_SROW = WS_MB + al256((size_t)MROWS * D * 2);
constexpr size_t WS_SW   = WS_SROW + al256((size_t)MROWS * 4 * 4);
constexpr size_t WS_SEP  = WS_SW + al256((size_t)MROWS * 4 * 4);
constexpr size_t WS_LIST = WS_SEP + al256((size_t)MROWS * 4 * 4);
constexpr size_t WS_HS   = WS_LIST + al256((size_t)NEXP * MROWS * 4);
constexpr size_t WS_ACT  = WS_HS + al256((size_t)MOE_ROWS * D * 2);
constexpr size_t WS_YS   = WS_ACT + al256((size_t)MOE_ROWS * D * 2);
constexpr size_t WS_END  = WS_YS + al256((size_t)MOE_ROWS * D * 2);

constexpr int CW_BAR = 4096;
constexpr int CW_CNT = 1024;

constexpr int RING_BYTES = 131072;
constexpr int MISC_OFF = RING_BYTES;
constexpr int LDS_BYTES = 147456;
constexpr int NWAVES = 8, NT = 512;

#define GAS __attribute__((address_space(1)))
#define LAS __attribute__((address_space(3)))
typedef unsigned short bf16;
typedef unsigned v4u __attribute__((ext_vector_type(4)));
typedef unsigned v2u __attribute__((ext_vector_type(2)));
typedef float f32x4 __attribute__((ext_vector_type(4)));
typedef float f32x16 __attribute__((ext_vector_type(16)));
typedef short bf16x8 __attribute__((ext_vector_type(8)));
typedef short bf16x4 __attribute__((ext_vector_type(4)));

typedef float f32x2_t __attribute__((ext_vector_type(2))); typedef __bf16 bf16x2_t __attribute__((ext_vector_type(2)));
__device__ __forceinline__ unsigned pk2(float lo, float hi) { f32x2_t v = {lo, hi}; bf16x2_t b = __builtin_convertvector(v, bf16x2_t); return __builtin_bit_cast(unsigned, b); }
__device__ __forceinline__ unsigned f2bf(float f) { return pk2(f, 0.f) & 0xffffu; }
__device__ __forceinline__ float bf2f(unsigned short b) { return __builtin_bit_cast(float, (unsigned)b << 16); }
__device__ __forceinline__ float bflo(unsigned w) { return __builtin_bit_cast(float, w << 16); }
__device__ __forceinline__ float bfhi(unsigned w) { return __builtin_bit_cast(float, w & 0xffff0000u); }
__device__ __forceinline__ float wave_sum(float v) {
#pragma unroll
    for (int o = 1; o < 64; o <<= 1) v += __shfl_xor(v, o);
    return v;
}
__device__ __forceinline__ float sigmoidf_(float x) { return 1.f / (1.f + __expf(-x)); }
__device__ __forceinline__ float softplusf_(float x) { return x > 20.f ? x : log1pf(__expf(x)); }
__device__ __forceinline__ float siluf_(float x) { return x / (1.f + __expf(-x)); }
__device__ __forceinline__ void lds_barrier() { asm volatile("s_waitcnt lgkmcnt(0)\n\ts_barrier" ::: "memory"); }
namespace pg8 {
#define PG8_LAS __attribute__((address_space(3)))
typedef unsigned short bf16_t;
typedef short bf16x8 __attribute__((ext_vector_type(8)));
typedef float f32x4 __attribute__((ext_vector_type(4)));
typedef unsigned u32x4 __attribute__((ext_vector_type(4)));
constexpr int BM = 256, BK = 64, HALF = 128, HTB = HALF * BK * 2  , STAGE_BYTES = 8 * HTB, NXCD = 8, WGM = 8;

__host__ __device__ __forceinline__ int lds_byte(int r, int c) { const int st = (r >> 4) * 2 + (c >> 5), rr = r & 15, cc = c & 31, ob = rr * 64 + cc * 2; return st * 1024 + (ob ^ (((ob >> 9) & 1) << 5)); }
__host__ __device__ __forceinline__ void stage_rc(int b, int& R, int& C) { const int st = b / 1024, sb = b % 1024, swz = sb ^ (((sb >> 9) & 1) << 5); R = (st >> 1) * 16 + swz / 64; C = (st & 1) * 32 + (swz % 64) / 2; }
__host__ __device__ __forceinline__ int perm32(int rho) { const int n = rho >> 4, i = rho & 15; return 8 * (i >> 2) + 4 * n + (i & 3); }

struct Unit { int pm, pn; };
struct Gemm { const bf16_t* A; const bf16_t* Bt; int M, N, K; };

struct StaticOrder {
    int nM, nN, nwg, G, c;
    __host__ __device__ void init(int M, int N, int G_, int c_) { nM = M / BM; nN = N / BM; nwg = nM * nN; G = G_; c = c_; }
    __host__ __device__ bool next(int i, Unit& u) const {
        const long L = (long)i * G + c; if (L >= nwg) return false;
        int wgid = (int)L; { const int q = nwg / NXCD, r = nwg % NXCD, xcd = wgid % NXCD, off = wgid / NXCD; wgid = (xcd < r ? xcd * (q + 1) : r * (q + 1) + (xcd - r) * q) + off; }
        const int nig = WGM * nN, gid = wgid / nig, fm = gid * WGM, gsz = (nM - fm) < WGM ? (nM - fm) : WGM;
        u.pm = fm + ((wgid % nig) % gsz); u.pn = (wgid % nig) / gsz; return true;
    }
    __device__ __forceinline__ void a_ready(const Unit&) const {}
    __device__ __forceinline__ void done(const Unit&) const {}
};

__device__ __forceinline__ unsigned cvt_pk_bf16(float lo, float hi) { unsigned r; asm volatile("v_cvt_pk_bf16_f32 %0, %1, %2" : "=v"(r) : "v"(lo), "v"(hi)); return r; }
typedef float f32x2 __attribute__((ext_vector_type(2)));
template <class Epi, class Sched, bool ALIGN_EPI = false, bool SP2 = false>
__device__ __forceinline__ void gemm_phase(PG8_LAS unsigned char* lds, const Gemm g, const Sched& S, const Epi& E, const int wid_in) {
    int lane_o = (int)__builtin_amdgcn_mbcnt_hi(~0u, __builtin_amdgcn_mbcnt_lo(~0u, 0u)); asm volatile("" : "+v"(lane_o));
    const int wid = __builtin_amdgcn_readfirstlane(wid_in), lane = lane_o, tid = wid * 64 + lane, wr = wid >> 2, wc = wid & 3, fr = lane & 15, fq = lane >> 4;
    const int K = g.K, nt = K / BK;
    unsigned voffA[2], voffB[2];
#pragma unroll
    for (int i = 0; i < 2; ++i) { int R, C; stage_rc(tid * 16 + i * 8192, R, C); const int Rb = Epi::PERM ? ((R & ~31) + perm32(R & 31)) : R;
        voffA[i] = (unsigned)(R * K + C) * 2u; voffB[i] = (unsigned)(Rb * K + C) * 2u; }
    const size_t kstep = (size_t)(BK * 2);
    const size_t hstep = (size_t)HALF * K * 2;
    const size_t tstep = 2 * hstep;
    const unsigned ldsw = (unsigned)wid * 1024u;
    const int aoff = lds_byte(wr * 64 + fr, fq * 8), boff = lds_byte(wc * 32 + fr, fq * 8);
#define PG8_SA(b, h) (((b) * 2 + (h)) * HTB)
#define PG8_SB(b, h) ((4 + (b) * 2 + (h)) * HTB)
#define PG8_STAGE(bufoff, gbase, voff) do { _Pragma("unroll") for (int _i = 0; _i < 2; ++_i) \
        __builtin_amdgcn_global_load_lds((const unsigned*)((const char*)(gbase) + (voff)[_i]), (PG8_LAS unsigned*)(lds + (bufoff) + ldsw + _i * 8192), 16, 0, 0); } while (0)
#define PG8_LDA(dst, b, h) do { _Pragma("unroll") for (int m = 0; m < 4; ++m) _Pragma("unroll") for (int k = 0; k < 2; ++k) dst[m][k] = *(const PG8_LAS bf16x8*)(lds + PG8_SA(b, h) + aoff + m * 2048 + k * 1024); } while (0)
#define PG8_LDB(dst, b, h) do { _Pragma("unroll") for (int n = 0; n < 2; ++n) _Pragma("unroll") for (int k = 0; k < 2; ++k) dst[n][k] = *(const PG8_LAS bf16x8*)(lds + PG8_SB(b, h) + boff + n * 2048 + k * 1024); } while (0)
#define PG8_MMA(ai, bj, At, Bt) do { __builtin_amdgcn_s_setprio(1); _Pragma("unroll") for (int m = 0; m < 4; ++m) _Pragma("unroll") for (int n = 0; n < 2; ++n) _Pragma("unroll") for (int k = 0; k < 2; ++k) \
        acc[ai][bj][m][n] = __builtin_amdgcn_mfma_f32_16x16x32_bf16(Bt[n][k], At[m][k], acc[ai][bj][m][n], 0, 0, 0); __builtin_amdgcn_s_setprio(0); } while (0)
#define PG8_WAIT_V(n) asm volatile("s_waitcnt vmcnt(" #n ")" ::: "memory")
#define PG8_WAIT_L(n) asm volatile("s_waitcnt lgkmcnt(" #n ")" ::: "memory")
#define PG8_BAR __builtin_amdgcn_s_barrier()
#define PG8_SCHED __builtin_amdgcn_sched_barrier(0)
    Unit cur, nxt; int ui = 0;
    if (!S.next(0, cur)) return;
    f32x4 acc[2][2][4][2];
#pragma unroll
    for (int a = 0; a < 2; ++a)
#pragma unroll
        for (int b = 0; b < 2; ++b)
#pragma unroll
            for (int m = 0; m < 4; ++m)
#pragma unroll
                for (int n = 0; n < 2; ++n) acc[a][b][m][n] = (f32x4){0.f, 0.f, 0.f, 0.f};
    bf16x8 At[4][2], B0[2][2], B1[2][2];
    const char* cA = (const char*)g.A + (size_t)cur.pm * tstep; const char* cB = (const char*)g.Bt + (size_t)cur.pn * tstep;
    S.a_ready(cur);
    if constexpr (SP2) {
        PG8_STAGE(PG8_SB(0, 0), cB, voffB); PG8_STAGE(PG8_SB(0, 1), cB + hstep, voffB); PG8_STAGE(PG8_SA(0, 0), cA, voffA); PG8_STAGE(PG8_SA(0, 1), cA + hstep, voffA);
        if (wr == 1) PG8_BAR;
        PG8_WAIT_V(2); PG8_BAR;
        PG8_STAGE(PG8_SB(1, 0), cB + kstep, voffB); PG8_STAGE(PG8_SA(1, 0), cA + kstep, voffA); PG8_STAGE(PG8_SB(1, 1), cB + hstep + kstep, voffB);
        PG8_WAIT_V(6); PG8_BAR;
    } else {
        PG8_STAGE(PG8_SB(0, 0), cB, voffB); PG8_STAGE(PG8_SA(0, 0), cA, voffA); PG8_STAGE(PG8_SB(0, 1), cB + hstep, voffB); PG8_STAGE(PG8_SA(0, 1), cA + hstep, voffA);
        if (wr == 1) PG8_BAR;
        PG8_WAIT_V(4); PG8_BAR;
        PG8_STAGE(PG8_SB(1, 0), cB + kstep, voffB); PG8_STAGE(PG8_SA(1, 0), cA + kstep, voffA); PG8_STAGE(PG8_SB(1, 1), cB + hstep + kstep, voffB);
        PG8_WAIT_V(6); PG8_BAR;
    }
    for (;;) {
        const bool has_next = S.next(ui + 1, nxt);
        const char* nA = has_next ? (const char*)g.A + (size_t)nxt.pm * tstep : cA; const char* nB = has_next ? (const char*)g.Bt + (size_t)nxt.pn * tstep : cB;
        for (int t = 0; t < nt; t += 2) {
            const bool last = (t == nt - 2);
            const char* a1 = cA + (size_t)(t + 1) * kstep;
            const char* a2 = last ? nA : cA + (size_t)(t + 2) * kstep; const char* b2 = last ? nB : cB + (size_t)(t + 2) * kstep;
            const char* a3 = a2 + kstep; const char* b3 = b2 + kstep;
            if (last && has_next) S.a_ready(nxt);
            if constexpr (SP2) {
            PG8_LDB(B0, 0, 0); PG8_LDB(B1, 0, 1); PG8_SCHED; PG8_LDA(At, 0, 0); PG8_STAGE(PG8_SA(1, 1), a1 + hstep, voffA);
            PG8_WAIT_V(8); PG8_WAIT_L(0); PG8_BAR; PG8_MMA(0, 0, At, B0); PG8_MMA(0, 1, At, B1); PG8_BAR; PG8_SCHED;
            PG8_LDA(At, 0, 1); PG8_STAGE(PG8_SB(0, 0), b2, voffB); PG8_STAGE(PG8_SB(0, 1), b2 + hstep, voffB); PG8_STAGE(PG8_SA(0, 0), a2, voffA);
            PG8_WAIT_V(8); PG8_WAIT_L(0); PG8_BAR; PG8_MMA(1, 0, At, B0); PG8_MMA(1, 1, At, B1); PG8_BAR; PG8_SCHED;
            PG8_LDB(B0, 1, 0); PG8_LDB(B1, 1, 1); PG8_SCHED; PG8_LDA(At, 1, 0); PG8_STAGE(PG8_SA(0, 1), a2 + hstep, voffA);
            PG8_WAIT_V(8); PG8_WAIT_L(0); PG8_BAR; PG8_MMA(0, 0, At, B0); PG8_MMA(0, 1, At, B1); PG8_BAR; PG8_SCHED;
            PG8_LDA(At, 1, 1); PG8_STAGE(PG8_SB(1, 0), b3, voffB); PG8_STAGE(PG8_SB(1, 1), b3 + hstep, voffB); PG8_STAGE(PG8_SA(1, 0), a3, voffA);
            PG8_WAIT_V(8); PG8_WAIT_L(0); PG8_BAR; PG8_MMA(1, 0, At, B0); PG8_MMA(1, 1, At, B1); PG8_BAR; PG8_SCHED;
            } else {
            PG8_LDB(B0, 0, 0); PG8_SCHED; PG8_LDA(At, 0, 0); PG8_STAGE(PG8_SA(1, 1), a1 + hstep, voffA);
            PG8_WAIT_L(8); PG8_BAR; PG8_WAIT_L(0); PG8_MMA(0, 0, At, B0); PG8_BAR; PG8_SCHED;
            PG8_LDB(B1, 0, 1); PG8_STAGE(PG8_SB(0, 0), b2, voffB);
            PG8_BAR; PG8_WAIT_L(0); PG8_MMA(0, 1, At, B1); PG8_BAR;
            PG8_LDA(At, 0, 1); PG8_STAGE(PG8_SA(0, 0), a2, voffA);
            PG8_BAR; PG8_WAIT_L(0); PG8_MMA(1, 0, At, B0); PG8_BAR; PG8_SCHED;
            PG8_STAGE(PG8_SB(0, 1), b2 + hstep, voffB);
            PG8_WAIT_V(6); PG8_BAR; PG8_MMA(1, 1, At, B1); PG8_BAR;
            PG8_LDB(B0, 1, 0); PG8_SCHED; PG8_LDA(At, 1, 0); PG8_STAGE(PG8_SA(0, 1), a2 + hstep, voffA);
            PG8_WAIT_L(8); PG8_BAR; PG8_WAIT_L(0); PG8_MMA(0, 0, At, B0); PG8_BAR; PG8_SCHED;
            PG8_LDB(B1, 1, 1); PG8_STAGE(PG8_SB(1, 0), b3, voffB);
            PG8_BAR; PG8_WAIT_L(0); PG8_MMA(0, 1, At, B1); PG8_BAR;
            PG8_LDA(At, 1, 1); PG8_STAGE(PG8_SA(1, 0), a3, voffA);
            PG8_BAR; PG8_WAIT_L(0); PG8_MMA(1, 0, At, B0); PG8_BAR; PG8_SCHED;
            PG8_STAGE(PG8_SB(1, 1), b3 + hstep, voffB);
            PG8_WAIT_V(6); PG8_BAR; PG8_MMA(1, 1, At, B1); PG8_BAR;
            }
        }
        if constexpr (ALIGN_EPI) { if (wr == 0) PG8_BAR; }
        if constexpr (!Epi::AFTER_DRAIN) { E(acc, cur, wr, wc, fr, fq); S.done(cur); }
        if (!has_next) break;
#pragma unroll
        for (int a = 0; a < 2; ++a)
#pragma unroll
            for (int b = 0; b < 2; ++b)
#pragma unroll
                for (int m = 0; m < 4; ++m)
#pragma unroll
                    for (int n = 0; n < 2; ++n) acc[a][b][m][n] = (f32x4){0.f, 0.f, 0.f, 0.f};
        cur = nxt; cA = nA; cB = nB; ++ui;
        if constexpr (ALIGN_EPI) { if (wr == 1) PG8_BAR; }
    }
    PG8_WAIT_V(0);
    if constexpr (!ALIGN_EPI) { if (wr == 0) PG8_BAR; }
    PG8_BAR;
    if constexpr (Epi::AFTER_DRAIN) { E.fused(acc, cur, wr, wc, fr, fq, lds, wid, lane); S.done(cur); }
#undef PG8_SA
#undef PG8_SB
#undef PG8_STAGE
#undef PG8_LDA
#undef PG8_LDB
#undef PG8_MMA
#undef PG8_WAIT_V
#undef PG8_WAIT_L
#undef PG8_BAR
#undef PG8_SCHED
}
}

namespace pg8 {
__device__ __forceinline__ float bflo_(unsigned w) { return __builtin_bit_cast(float, w << 16); }
__device__ __forceinline__ float bfhi_(unsigned w) { return __builtin_bit_cast(float, w & 0xffff0000u); }
__device__ __forceinline__ float sigm_(float x) { return 1.f / (1.f + __expf(-x)); }

struct EpiStoreBf16 {
    static constexpr bool PERM = true, AFTER_DRAIN = false;
    bf16_t* O; int ldc;
    __device__ __forceinline__ void operator()(const f32x4 (&acc)[2][2][4][2], const Unit& u, int wr, int wc, int fr, int fq) const {
        const int row0 = u.pm * BM + wr * 64 + fr, col0 = u.pn * BM + wc * 32 + 8 * fq;
#pragma unroll
        for (int ai = 0; ai < 2; ++ai)
#pragma unroll
            for (int m = 0; m < 4; ++m) { bf16_t* rowp = O + (size_t)(row0 + ai * HALF + m * 16) * ldc + col0;
#pragma unroll
                for (int bj = 0; bj < 2; ++bj) { const f32x4 v0 = acc[ai][bj][m][0], v1 = acc[ai][bj][m][1];
                    u32x4 w; w.x = cvt_pk_bf16(v0[0], v0[1]); w.y = cvt_pk_bf16(v0[2], v0[3]); w.z = cvt_pk_bf16(v1[0], v1[1]); w.w = cvt_pk_bf16(v1[2], v1[3]);
                    *(u32x4*)(rowp + bj * HALF) = w; } }
    }
};

struct EpiMerge {
    static constexpr bool PERM = true, AFTER_DRAIN = false;
    const bf16_t* U; int ldu, gcol0; bf16_t* Mf; bf16_t* Mb; int npm;
    __device__ __forceinline__ void operator()(const f32x4 (&acc)[2][2][4][2], const Unit& u, int wr, int wc, int fr, int fq) const {
        const int br = u.pm / npm, pm = u.pm - br * npm, pn = u.pn & 3;
        const int row0 = pm * BM + wr * 64 + fr, col0 = pn * BM + wc * 32 + 8 * fq;
#pragma unroll
        for (int ai = 0; ai < 2; ++ai) {
            u32x4 gv[4][2], pv[4][2];
#pragma unroll
            for (int m = 0; m < 4; ++m)
#pragma unroll
                for (int bj = 0; bj < 2; ++bj) { const size_t row = (size_t)(row0 + ai * HALF + m * 16); const int col = col0 + bj * HALF;
                    gv[m][bj] = *(const u32x4*)(U + row * ldu + gcol0 + br * 1024 + col);
                    pv[m][bj] = br > 0 ? *(const u32x4*)(Mf + row * 1024 + col) : (u32x4){0u, 0u, 0u, 0u}; }
#pragma unroll
            for (int m = 0; m < 4; ++m)
#pragma unroll
                for (int bj = 0; bj < 2; ++bj) { const size_t row = (size_t)(row0 + ai * HALF + m * 16); const int col = col0 + bj * HALF;
                    const u32x4 g = gv[m][bj], p = pv[m][bj];
                    f32x4 v0 = acc[ai][bj][m][0], v1 = acc[ai][bj][m][1];
                    v0[0] = v0[0] * sigm_(bflo_(g.x)) + bflo_(p.x); v0[1] = v0[1] * sigm_(bfhi_(g.x)) + bfhi_(p.x); v0[2] = v0[2] * sigm_(bflo_(g.y)) + bflo_(p.y); v0[3] = v0[3] * sigm_(bfhi_(g.y)) + bfhi_(p.y);
                    v1[0] = v1[0] * sigm_(bflo_(g.z)) + bflo_(p.z); v1[1] = v1[1] * sigm_(bfhi_(g.z)) + bfhi_(p.z); v1[2] = v1[2] * sigm_(bflo_(g.w)) + bflo_(p.w); v1[3] = v1[3] * sigm_(bfhi_(g.w)) + bfhi_(p.w);
                    u32x4 w; w.x = cvt_pk_bf16(v0[0], v0[1]); w.y = cvt_pk_bf16(v0[2], v0[3]); w.z = cvt_pk_bf16(v1[0], v1[1]); w.w = cvt_pk_bf16(v1[2], v1[3]);
                    *(u32x4*)((br < 3 ? Mf : Mb) + row * 1024 + col) = w; }
        }
    }
};
struct MergeOrder {
    int G, c, npm, ncnt;
    __device__ __forceinline__ bool next(int i, Unit& u) const {
        const int su = (i >> 2) * G + c; if (su >= ncnt * 4) return false;
        const int br = i & 3; u.pm = br * npm + (su >> 2); u.pn = br * 4 + (su & 3); return true; }
    __device__ __forceinline__ void a_ready(const Unit&) const {}
    __device__ __forceinline__ void done(const Unit&) const {}
};

struct EpiResid {
    static constexpr bool PERM = false, AFTER_DRAIN = false;
    float* X; const float* gt;
    __device__ __forceinline__ void operator()(const f32x4 (&acc)[2][2][4][2], const Unit& u, int wr, int wc, int fr, int fq) const {
        const int row0 = u.pm * BM + wr * 64 + fr, col0 = u.pn * BM + wc * 32 + 4 * fq;
        const int mr = u.pm < 64 ? (u.pm >> 4) : 4;
        f32x4 gv[2][2];
#pragma unroll
        for (int bj = 0; bj < 2; ++bj)
#pragma unroll
            for (int n = 0; n < 2; ++n) gv[bj][n] = *(const f32x4*)(gt + (size_t)mr * 6144 + col0 + bj * HALF + n * 16);
#pragma unroll
        for (int ai = 0; ai < 2; ++ai) {
            f32x4 xv[4][2][2];
#pragma unroll
            for (int m = 0; m < 4; ++m)
#pragma unroll
                for (int bj = 0; bj < 2; ++bj)
#pragma unroll
                    for (int n = 0; n < 2; ++n) xv[m][bj][n] = *(const f32x4*)(X + (size_t)(row0 + ai * HALF + m * 16) * 1024 + col0 + bj * HALF + n * 16);
#pragma unroll
            for (int m = 0; m < 4; ++m)
#pragma unroll
                for (int bj = 0; bj < 2; ++bj)
#pragma unroll
                    for (int n = 0; n < 2; ++n) *(f32x4*)(X + (size_t)(row0 + ai * HALF + m * 16) * 1024 + col0 + bj * HALF + n * 16) = xv[m][bj][n] + gv[bj][n] * acc[ai][bj][m][n];
        }
    }
};

struct MoeOrder {
    const PG8_LAS int* tpre; int G, c, ncol;
    __device__ __forceinline__ bool next(int i, Unit& u) const {
        int tau, pnl;
        if ((G & 7) == 0 && ((G >> 3) % ncol) == 0) { const int x = c & 7, y = c >> 3, rp = (G >> 3) / ncol; tau = (i * 8 + x) * rp + y / ncol; pnl = y % ncol; }
        else { const int L = i * G + c; tau = L / ncol; pnl = L - tau * ncol; }
        if (tau >= tpre[32]) return false;
        int e = 0;
#pragma unroll 1
        while (tpre[e + 1] <= tau) ++e;
        u.pm = tau; u.pn = e * ncol + pnl; return true; }
    __device__ __forceinline__ void a_ready(const Unit&) const {}
    __device__ __forceinline__ void done(const Unit&) const {}
};
struct EpiSwiglu {
    static constexpr bool PERM = true, AFTER_DRAIN = false;
    bf16_t* ACT; const float* bgu;
    __device__ __forceinline__ void operator()(const f32x4 (&acc)[2][2][4][2], const Unit& u, int wr, int wc, int fr, int fq) const {
        const int e = u.pn >> 3, pnl = u.pn & 7;
        const int row0 = u.pm * BM + wr * 64 + fr, cl = 128 * pnl + wc * 32 + 8 * fq;
        const float* bg = bgu + (size_t)e * 2048 + cl;
        const f32x4 bg0 = *(const f32x4*)bg, bg1 = *(const f32x4*)(bg + 4), bu0 = *(const f32x4*)(bg + 1024), bu1 = *(const f32x4*)(bg + 1028);
#pragma unroll
        for (int ai = 0; ai < 2; ++ai)
#pragma unroll
            for (int m = 0; m < 4; ++m) {
                f32x4 g0 = acc[ai][0][m][0] + bg0, g1 = acc[ai][0][m][1] + bg1, u0 = acc[ai][1][m][0] + bu0, u1 = acc[ai][1][m][1] + bu1;
                float o[8];
#pragma unroll
                for (int j = 0; j < 4; ++j) { const float g = fminf(g0[j], 7.f), up = fminf(fmaxf(u0[j], -7.f), 7.f); o[j] = (up + 1.f) * g * sigm_(1.702f * g); }
#pragma unroll
                for (int j = 0; j < 4; ++j) { const float g = fminf(g1[j], 7.f), up = fminf(fmaxf(u1[j], -7.f), 7.f); o[4 + j] = (up + 1.f) * g * sigm_(1.702f * g); }
                u32x4 w; w.x = cvt_pk_bf16(o[0], o[1]); w.y = cvt_pk_bf16(o[2], o[3]); w.z = cvt_pk_bf16(o[4], o[5]); w.w = cvt_pk_bf16(o[6], o[7]);
                *(u32x4*)(ACT + (size_t)(row0 + ai * HALF + m * 16) * 1024 + cl) = w; }
    }
};
struct EpiDown {
    static constexpr bool PERM = true, AFTER_DRAIN = false;
    bf16_t* YS; const float* bdn;
    __device__ __forceinline__ void operator()(const f32x4 (&acc)[2][2][4][2], const Unit& u, int wr, int wc, int fr, int fq) const {
        const int e = u.pn >> 2, pnl = u.pn & 3;
        const int row0 = u.pm * BM + wr * 64 + fr, col0 = pnl * BM + wc * 32 + 8 * fq;
        f32x4 bv[2][2];
#pragma unroll
        for (int bj = 0; bj < 2; ++bj)
#pragma unroll
            for (int n = 0; n < 2; ++n) bv[bj][n] = *(const f32x4*)(bdn + (size_t)e * 1024 + col0 + bj * HALF + 4 * n);
#pragma unroll
        for (int ai = 0; ai < 2; ++ai)
#pragma unroll
            for (int m = 0; m < 4; ++m) { bf16_t* rowp = YS + (size_t)(row0 + ai * HALF + m * 16) * 1024 + col0;
#pragma unroll
                for (int bj = 0; bj < 2; ++bj) { const f32x4 v0 = acc[ai][bj][m][0] + bv[bj][0], v1 = acc[ai][bj][m][1] + bv[bj][1];
                    u32x4 w; w.x = cvt_pk_bf16(v0[0], v0[1]); w.y = cvt_pk_bf16(v0[2], v0[3]); w.z = cvt_pk_bf16(v1[0], v1[1]); w.w = cvt_pk_bf16(v1[2], v1[3]);
                    *(u32x4*)(rowp + bj * HALF) = w; } }
    }
};
}
#define XB_TMO      128
#define XB_XCNT(j)  (256  + 64 * (j))
#define XB_XSUB(j)  (1280 + 64 * (j))
#define XB_XGEN(j)  (2304 + 64 * (j))
#define XB_TOP      3328
#define XB_TOPGEN   3392
#define XCD_BAR_WORDS 3456
#define XB_SPIN_CAP (1u << 18)
#define LAS __attribute__((address_space(3)))

__device__ __forceinline__ unsigned xb_ld(unsigned* p)              { return __hip_atomic_load(p, __ATOMIC_RELAXED, __HIP_MEMORY_SCOPE_AGENT); }
__device__ __forceinline__ unsigned xb_add(unsigned* p, unsigned v) { return __hip_atomic_fetch_add(p, v, __ATOMIC_RELAXED, __HIP_MEMORY_SCOPE_AGENT); }
__device__ __forceinline__ unsigned xb_xcc_id() { return (unsigned)__builtin_amdgcn_s_getreg((3 << 11) | 20) & 0xFu; }
#define XB_SPIN(cond, bar) do { unsigned _sp = 0; while (cond) { __builtin_amdgcn_s_sleep(1); \
    if ((++_sp & 255u) == 0u) { if (xb_ld(&(bar)[XB_TMO])) break; if (_sp > XB_SPIN_CAP) { atomicAdd(&(bar)[XB_TMO], 1u); break; } } } } while (0)

struct XcdBarrier {
    unsigned* bar; unsigned x;
    volatile LAS unsigned* st;
};

__device__ __forceinline__ XcdBarrier xcd_barrier_post(unsigned* bar, volatile LAS unsigned* st) {
    XcdBarrier b; b.bar = bar; b.x = xb_xcc_id(); b.st = st;
    if (threadIdx.x == 0) (void)xb_add(&bar[XB_XCNT(b.x)], 1u);
    return b;
}
__device__ __forceinline__ void xcd_barrier_complete(unsigned* bar, unsigned x, unsigned& nloc, unsigned& nx) {
    const unsigned G = gridDim.x * gridDim.y * gridDim.z;
    unsigned sum, cnt, mine, sp = 0u;
    for (;;) {
        sum = 0u; cnt = 0u; mine = 0u;
#pragma unroll
        for (unsigned j = 0; j < 16; ++j) { const unsigned c = xb_ld(&bar[XB_XCNT(j)]); sum += c; cnt += (c > 0u) ? 1u : 0u; mine = (j == x) ? c : mine; }
        if (sum == G) break;
        __builtin_amdgcn_s_sleep(1);
        if ((++sp & 255u) == 0u) { if (xb_ld(&bar[XB_TMO])) break; if (sp > XB_SPIN_CAP) { atomicAdd(&bar[XB_TMO], 1u); break; } }
    }
    nloc = mine > 0u ? mine : 1u; nx = cnt > 0u ? cnt : 1u;
}

__device__ __forceinline__ void xcd_barrier(const XcdBarrier& b) {
    asm volatile("s_waitcnt vmcnt(0)" ::: "memory");
    __syncthreads();
    if (threadIdx.x == 0) {
        unsigned* bar = b.bar;
        __builtin_amdgcn_s_waitcnt(0);
        unsigned nloc = b.st[0], nx = b.st[1];
        if (nloc == 0u) { xcd_barrier_complete(bar, b.x, nloc, nx); b.st[0] = nloc; b.st[1] = nx; }
        const unsigned old = xb_add(&bar[XB_XSUB(b.x)], 1u);
        const unsigned gen = old / nloc;
        if (old + 1u == (gen + 1u) * nloc) {
            __builtin_amdgcn_fence(__ATOMIC_RELEASE, "agent");
            asm volatile("s_waitcnt vmcnt(0)" ::: "memory");
            const unsigned og = xb_add(&bar[XB_TOP], 1u);
            const unsigned tg = og / nx;
            if (og + 1u == (tg + 1u) * nx) xb_add(&bar[XB_TOPGEN], 1u);
            else XB_SPIN(xb_ld(&bar[XB_TOPGEN]) == tg, bar);
            __builtin_amdgcn_fence(__ATOMIC_ACQUIRE, "agent");
            xb_add(&bar[XB_XGEN(b.x)], 1u);
            asm volatile("s_waitcnt vmcnt(0)" ::: "memory");
        } else {
            XB_SPIN(xb_ld(&bar[XB_XGEN(b.x)]) == gen, bar);
            __builtin_amdgcn_fence(__ATOMIC_ACQUIRE, "agent");
            asm volatile("s_waitcnt vmcnt(0)" ::: "memory");
        }
    }
    __syncthreads();
}

struct Frame {
    LAS unsigned char* lds;
    unsigned* ctl;
    int tid, lane, wave, G, bid;
    unsigned long long pr;
    const float* const* in; const float* const* in0;
    float* out;
    unsigned char* ws; unsigned char* ws0;
};
#define WSP(T, off) ((T*)(F.ws + (off)))
#define REFRESH_TID(F) do { int t_ = (int)__builtin_amdgcn_mbcnt_hi(~0u, __builtin_amdgcn_mbcnt_lo(~0u, 0u)); asm volatile("" : "+v"(t_)); F.lane = t_; F.tid = F.wave * 64 + t_; \
    int z_ = 0; asm volatile("s_mov_b32 %0, 0" : "=s"(z_)); F.ws = F.ws0 + z_; F.in = F.in0 + z_; F.bid = (int)blockIdx.x + z_; } while (0)
#define I_X 0
#define I_C 1
#define I_CTX 2
#define I_CCTX 3
#define I_WMOD 4
#define I_BMOD 5
#define I_G1 6
#define I_G2 7
#define I_WIN 8
#define I_AGQ 9
#define I_AGK 10
#define I_BCW 11
#define I_BCB 12
#define I_BLAM 13
#define I_BWR 14
#define I_BBR 15
#define I_BWI 16
#define I_BBI 17
#define I_CCW 18
#define I_CALOG 19
#define I_CDTB 20
#define I_CGOUT 21
#define I_RPB 22
#define I_WBR 23
#define I_WOUT 24
#define I_WRT 25
#define I_BRT 26
#define I_WGU 27
#define I_BGU 28
#define I_WDN 29
#define I_BDN 30
#define I_GFIN 31

__device__ __forceinline__ int mod_row(int r) { return r < TLAT ? (r >> 12) : 4; }

__device__ __forceinline__ void p0_transpose_item(const float* W, size_t pitch, int K, bf16* WT, int drow0, int scol0, int k0, LAS float* scr, int lane) {
    float v[32];
#pragma unroll
    for (int i = 0; i < 32; ++i) { const int kk = 2 * i + (lane >> 5); v[i] = W[(size_t)(k0 + kk) * pitch + scol0 + (lane & 31)]; }
#pragma unroll
    for (int i = 0; i < 32; ++i) { const int kk = 2 * i + (lane >> 5); scr[kk * 33 + (lane & 31)] = v[i]; }
    asm volatile("s_waitcnt lgkmcnt(0)" ::: "memory");
    const int c = lane & 7;
#pragma unroll
    for (int j = 0; j < 4; ++j) { const int n = (lane >> 3) + 8 * j; const LAS float* s = scr + (8 * c) * 33 + n;
        v4u o; o.x = pk2(s[0 * 33], s[1 * 33]); o.y = pk2(s[2 * 33], s[3 * 33]); o.z = pk2(s[4 * 33], s[5 * 33]); o.w = pk2(s[6 * 33], s[7 * 33]);
        *(v4u*)(WT + (size_t)(drow0 + n) * K + k0 + 8 * c) = o; }
    asm volatile("s_waitcnt lgkmcnt(0)" ::: "memory");
}

__device__ __forceinline__ void p0_prologue(Frame& F) {
    LAS float* scr = (LAS float*)(F.lds + F.wave * 16384);
    const int gw = F.bid * NWAVES + F.wave, NGW = F.G * NWAVES;
    constexpr int I_IN = DEPTH * 16 * (UW / 32);
    constexpr int I_BR = DEPTH * 4 * 8 * 32;
    constexpr int I_OUT = DEPTH * 16 * 32;
    constexpr int I_GU = DEPTH * NEXP * 16 * 64;
    constexpr int I_DN = DEPTH * NEXP * 16 * 32;
    constexpr int NITEMS = I_IN + I_BR + I_OUT + I_GU + I_DN;
    for (int it = gw; it < NITEMS; it += NGW) {
        int r = it;
        if (r < I_IN) { const int l = r / (16 * 296), q = r % (16 * 296), kb = q / 296, nb = q % 296; const int n0 = nb * 32, sc = n0 < 3840 ? n0 : n0 + 16;
            p0_transpose_item(F.in[I_WIN] + (size_t)l * D * INW, INW, D, WSP(bf16, WS_WIN) + (size_t)l * UW * D, n0, sc, kb * 64, scr, F.lane); continue; }
        r -= I_IN;
        if (r < I_BR) { const int mi = r / 256, q = r % 256, kb = q / 32, nb = q % 32;
            p0_transpose_item(F.in[I_WBR] + (size_t)mi * 512 * 1024, 1024, 512, WSP(bf16, WS_WBR) + (size_t)mi * 1024 * 512, nb * 32, nb * 32, kb * 64, scr, F.lane); continue; }
        r -= I_BR;
        if (r < I_OUT) { const int l = r / 512, q = r % 512, kb = q / 32, nb = q % 32;
            p0_transpose_item(F.in[I_WOUT] + (size_t)l * D * D, D, D, WSP(bf16, WS_WOUT) + (size_t)l * D * D, nb * 32, nb * 32, kb * 64, scr, F.lane); continue; }
        r -= I_OUT;
        if (r < I_GU) { const int mi = r / 1024, q = r % 1024, kb = q / 64, nb = q % 64; const int j0 = nb * 32, pn = j0 >> 8, bj = (j0 >> 7) & 1, cc = j0 & 127;
            p0_transpose_item(F.in[I_WGU] + (size_t)mi * D * 2048, 2048, D, WSP(bf16, WS_WGU) + (size_t)mi * 2048 * D, j0, 1024 * bj + 128 * pn + cc, kb * 64, scr, F.lane); continue; }
        r -= I_GU;
        { const int mi = r / 512, q = r % 512, kb = q / 32, nb = q % 32;
            p0_transpose_item(F.in[I_WDN] + (size_t)mi * D * D, D, D, WSP(bf16, WS_WDN) + (size_t)mi * D * D, nb * 32, nb * 32, kb * 64, scr, F.lane); }
    }
    __syncthreads();
    {
        LAS float* sc = (LAS float*)F.lds;
        LAS float* part = sc + 5 * 1024;
        bool staged = false;
        for (int it = F.bid; it < DEPTH * 96; it += F.G) {
            if (!staged) {
                for (int i = F.tid; i < 5 * 1024; i += NT) { const int r = i >> 10, k = i & 1023; const float cv = r < 4 ? F.in[I_C][r * 1024 + k] : F.in[I_CCTX][k]; sc[i] = siluf_(cv); }
                __syncthreads(); staged = true;
            }
            const int l = it / 96, cg = it % 96, col = cg * 64 + F.lane;
            const float* wm = F.in[I_WMOD] + (size_t)l * D * 6144 + col;
            float a0 = 0.f, a1 = 0.f, a2 = 0.f, a3 = 0.f, a4 = 0.f;
            const int kb = F.wave * 128;
#pragma unroll 16
            for (int k = 0; k < 128; ++k) { const float w = wm[(size_t)(kb + k) * 6144];
                a0 += sc[kb + k] * w; a1 += sc[1024 + kb + k] * w; a2 += sc[2048 + kb + k] * w; a3 += sc[3072 + kb + k] * w; a4 += sc[4096 + kb + k] * w; }
            LAS float* pp = part + F.wave * 320 + F.lane;
            pp[0] = a0; pp[64] = a1; pp[128] = a2; pp[192] = a3; pp[256] = a4;
            __syncthreads();
            if (F.tid < 320) { const int r = F.tid >> 6, ln = F.tid & 63; float s = 0.f;
#pragma unroll
                for (int w = 0; w < 8; ++w) s += part[w * 320 + r * 64 + ln];
                const int cc = cg * 64 + ln;
                WSP(float, WS_MOD)[((size_t)l * 5 + r) * 6144 + cc] = s + F.in[I_BMOD][l * 6144 + cc]; }
            __syncthreads();
        }
    }
    if (F.bid == 0) {
        for (int i = F.tid; i < 1024; i += NT) { const int p = i >> 4, f = i & 15; const float inv = powf(10000.f, -(float)f / 16.f); const float ang = (float)p * inv;
            WSP(float, WS_ROPE)[i] = cosf(ang); WSP(float, WS_ROPE)[1024 + i] = sinf(ang); }
    }
    for (int i = F.bid * NT + F.tid; i < DEPTH * 2 * 2 * 8 * 4096; i += F.G * NT) {
        const int c = i & 63, d = (i >> 6) & 63, n = (i >> 12) & 7, gate = (i >> 15) & 1, ld = i >> 16;
        const float* src = gate ? F.in[I_BWI] : F.in[I_BWR];
        WSP(bf16, WS_LRUW)[i] = (bf16)f2bf(src[((size_t)ld * 8 + n) * 4096 + c * 64 + d]);
    }
}

template <int MODE>
__device__ __forceinline__ void norm_phase(Frame& F, int l) {
    LAS float* hs = (LAS float*)F.lds;
    LAS int* lcnt = (LAS int*)(F.lds + 65536);
    LAS int* lbase = lcnt + 32;
    const int ngroups = ((MODE == 2 || (MODE == 1 && l == DEPTH - 1)) ? TLAT : MROWS) / 16;
    const float* modl = WSP(float, WS_MOD) + (size_t)l * 5 * 6144;
    float pb0[32], pb1[32];
    if (MODE != 2) {
        REFRESH_TID(F);
        const int r16 = F.lane & 15, quad = F.lane >> 4, w = F.wave;
        const size_t stride = MODE == 0 ? (size_t)INW : (size_t)NEXP;
        const float* wp = (MODE == 0 ? F.in[I_WIN] + (size_t)l * D * INW + 3840 : F.in[I_WRT] + (size_t)l * D * NEXP) + (size_t)(128 * w + quad) * stride + r16;
#pragma unroll
        for (int s = 0; s < 32; ++s) { pb0[s] = wp[(size_t)(4 * s) * stride]; pb1[s] = MODE == 1 ? wp[(size_t)(4 * s) * stride + 16] : 0.f; }
    }
#pragma unroll 1
    for (int gi = F.bid; gi < ngroups; gi += F.G) {
        REFRESH_TID(F);
        if (MODE == 1) { if (F.tid < 32) lcnt[F.tid] = 0; }
        constexpr bool COMB = true;
        const bool comb = (MODE == 0 && l > 0) || MODE == 2;
        f32x4 vv[2][4]; v2u yv[2][4][4]; float swv[2][4];
#pragma unroll
        for (int i = 0; i < 2; ++i) {
            const int r = gi * 16 + 2 * F.wave + i;
            const float* xsrc;
            if (MODE == 0 && l == 0) xsrc = r < TLAT ? F.in[I_X] + (size_t)r * D : F.in[I_CTX] + (size_t)(r - TLAT) * D;
            else xsrc = WSP(float, WS_X) + (size_t)r * D;
#pragma unroll
            for (int j = 0; j < 4; ++j) vv[i][j] = *(const f32x4*)(xsrc + 4 * F.lane + 256 * j);
        }
        if (COMB && comb) {
            int srv[2][4];
#pragma unroll
            for (int i = 0; i < 2; ++i)
#pragma unroll
                for (int k = 0; k < 4; ++k) { const int r = gi * 16 + 2 * F.wave + i; srv[i][k] = WSP(int, WS_SROW)[r * 4 + k]; swv[i][k] = WSP(float, WS_SW)[r * 4 + k]; }
#pragma unroll
            for (int i = 0; i < 2; ++i)
#pragma unroll
                for (int k = 0; k < 4; ++k) { const bf16* yr = WSP(bf16, WS_YS) + (size_t)srv[i][k] * D;
#pragma unroll
                    for (int j = 0; j < 4; ++j) yv[i][k][j] = *(const v2u*)(yr + 4 * F.lane + 256 * j); }
        }
#pragma unroll
        for (int i = 0; i < 2; ++i) {
            const int lr = 2 * F.wave + i, r = gi * 16 + lr, mr = mod_row(r);
            f32x4 v[4];
#pragma unroll
            for (int j = 0; j < 4; ++j) v[j] = vv[i][j];
            if (comb) {
                const int lp = MODE == 2 ? DEPTH - 1 : l - 1;
                const float* gt2 = WSP(float, WS_MOD) + ((size_t)lp * 5 + mr) * 6144 + 5120;
                f32x4 cb[4];
#pragma unroll
                for (int j = 0; j < 4; ++j) cb[j] = (f32x4){0.f, 0.f, 0.f, 0.f};
#pragma unroll
                for (int k = 0; k < 4; ++k) { const float w = swv[i][k];
#pragma unroll
                    for (int j = 0; j < 4; ++j) { const v2u y = yv[i][k][j];
                        cb[j].x += w * bflo(y.x); cb[j].y += w * bfhi(y.x); cb[j].z += w * bflo(y.y); cb[j].w += w * bfhi(y.y); }
                }
#pragma unroll
                for (int j = 0; j < 4; ++j) { const f32x4 g = *(const f32x4*)(gt2 + 4 * F.lane + 256 * j); v[j] = v[j] + g * cb[j]; }
            }
            if (MODE == 0) {
#pragma unroll
                for (int j = 0; j < 4; ++j) *(f32x4*)(WSP(float, WS_X) + (size_t)r * D + 4 * F.lane + 256 * j) = v[j];
            }
            float ss = 0.f;
#pragma unroll
            for (int j = 0; j < 4; ++j) ss += (v[j].x * v[j].x + v[j].y * v[j].y) + (v[j].z * v[j].z + v[j].w * v[j].w);
            const float rstd = rsqrtf(wave_sum(ss) * (1.f / D) + EPS);
            if (MODE == 2) {
#pragma unroll
                for (int j = 0; j < 4; ++j) { const f32x4 g = *(const f32x4*)(F.in[I_GFIN] + 4 * F.lane + 256 * j);
                    *(f32x4*)(F.out + (size_t)r * D + 4 * F.lane + 256 * j) = v[j] * rstd * g; }
            } else {
                const float* gn = F.in[MODE == 0 ? I_G1 : I_G2] + l * D;
                const float* sh = modl + (size_t)mr * 6144 + (MODE == 0 ? 0 : 3072);
                const float* sc = sh + 1024;
#pragma unroll
                for (int j = 0; j < 4; ++j) { const int c0 = 4 * F.lane + 256 * j;
                    const f32x4 g = *(const f32x4*)(gn + c0), a = *(const f32x4*)(sh + c0), s = *(const f32x4*)(sc + c0);
                    const f32x4 h = (v[j] * rstd * g) * (s + 1.f) + a;
                    *(LAS f32x4*)(hs + lr * 1024 + c0) = h;
                    v2u o; o.x = pk2(h.x, h.y); o.y = pk2(h.z, h.w);
                    *(v2u*)(WSP(bf16, WS_H) + (size_t)r * D + c0) = o; }
            }
        }
        if (MODE == 2) continue;
        __syncthreads();
        LAS float* red = (LAS float*)(F.lds + 65536 + 256);
        {
            const int r16 = F.lane & 15, quad = F.lane >> 4, w = F.wave;
            const LAS float* hp = hs + r16 * 1024 + 128 * w + quad;
            f32x4 acc0 = (f32x4){0.f, 0.f, 0.f, 0.f}, acc1 = acc0;
#pragma unroll
            for (int s = 0; s < 32; ++s) { const float av = hp[4 * s];
                acc0 = __builtin_amdgcn_mfma_f32_16x16x4f32(av, pb0[s], acc0, 0, 0, 0);
                if (MODE == 1) acc1 = __builtin_amdgcn_mfma_f32_16x16x4f32(av, pb1[s], acc1, 0, 0, 0); }
#pragma unroll
            for (int j = 0; j < 4; ++j) { red[(w * 16 + 4 * quad + j) * 32 + r16] = acc0[j]; if (MODE == 1) red[(w * 16 + 4 * quad + j) * 32 + 16 + r16] = acc1[j]; }
        }
        __syncthreads();
        if (MODE == 0) {
            if (F.tid < 256) {
                const int lr = F.tid >> 4, col = F.tid & 15;
                float sacc = 0.f;
#pragma unroll
                for (int w = 0; w < 8; ++w) sacc += red[(w * 16 + lr) * 32 + col];
                WSP(float, WS_CAB)[(size_t)(gi * 16 + lr) * 16 + col] = sacc;
            }
        } else {
            const int lr = F.tid >> 5, e = F.tid & 31, r = gi * 16 + lr;
            float sacc = 0.f;
#pragma unroll
            for (int w = 0; w < 8; ++w) sacc += red[(w * 16 + lr) * 32 + e];
            const float lg = sacc + F.in[I_BRT][l * NEXP + e];
            float tv0, tv1, tv2, tv3; int ti0, ti1, ti2, ti3; bool taken = false;
#define TOP1(TV, TI) do { float bv = taken ? -INFINITY : lg; int bi = e; \
                _Pragma("unroll") for (int off = 16; off >= 1; off >>= 1) { const float ov = __shfl_xor(bv, off); const int oi = __shfl_xor(bi, off); \
                    if (ov > bv || (ov == bv && oi < bi)) { bv = ov; bi = oi; } } \
                TV = bv; TI = bi; if (bi == e) taken = true; } while (0)
            TOP1(tv0, ti0); TOP1(tv1, ti1); TOP1(tv2, ti2); TOP1(tv3, ti3);
#undef TOP1
            const float e1 = __expf(tv1 - tv0), e2 = __expf(tv2 - tv0), e3 = __expf(tv3 - tv0);
            const float inv = 1.f / (1.f + e1 + e2 + e3);
            const int my_e = e == 0 ? ti0 : (e == 1 ? ti1 : (e == 2 ? ti2 : ti3));
            const float my_w = e == 0 ? inv : (e == 1 ? e1 * inv : (e == 2 ? e2 * inv : e3 * inv));
            int pl = 0;
            if (e < 4) pl = atomicAdd((int*)&lcnt[my_e], 1);
            __syncthreads();
            if (F.tid < 32) { const int c = lcnt[F.tid]; lbase[F.tid] = c > 0 ? (int)__hip_atomic_fetch_add(F.ctl + CW_CNT + l * 32 + F.tid, (unsigned)c, __ATOMIC_RELAXED, __HIP_MEMORY_SCOPE_AGENT) : 0; }
            __syncthreads();
            if (e < 4) { const int p = lbase[my_e] + pl;
                WSP(int, WS_LIST)[(size_t)my_e * MROWS + p] = r * 4 + e;
                WSP(int, WS_SEP)[r * 4 + e] = (my_e << 20) | p;
                WSP(float, WS_SW)[r * 4 + e] = my_w; }
        }
        __syncthreads();
    }
}

__device__ __forceinline__ void moe_table(Frame& F, int l) {
    LAS int* tpre = (LAS int*)(F.lds + MISC_OFF + 256);
    LAS int* cnt = tpre + 40;
    __syncthreads();
    if (F.tid < 32) cnt[F.tid] = (int)__hip_atomic_load(F.ctl + CW_CNT + l * 32 + F.tid, __ATOMIC_RELAXED, __HIP_MEMORY_SCOPE_AGENT);
    __syncthreads();
    if (F.tid == 0) { int s = 0; for (int e = 0; e < 32; ++e) { tpre[e] = s; s += (cnt[e] + 255) >> 8; } tpre[32] = s; }
    __syncthreads();
}
__device__ __forceinline__ void moe_gather(Frame& F, int l) {
    moe_table(F, l);
    const LAS int* tpre = (const LAS int*)(F.lds + MISC_OFF + 256);
    const LAS int* cnt = tpre + 40;
    const int gw = F.bid * NWAVES + F.wave, NGW = F.G * NWAVES;
    REFRESH_TID(F);
    for (int pb_ = gw; pb_ < MROWS; pb_ += NGW) {
        for (int e0 = 0; e0 < NEXP; e0 += 4) {
            int tk[4]; v4u ra[4], rb[4];
#pragma unroll
            for (int k = 0; k < 4; ++k) tk[k] = pb_ < cnt[e0 + k] ? WSP(int, WS_LIST)[(size_t)(e0 + k) * MROWS + pb_] : -1;
#pragma unroll
            for (int k = 0; k < 4; ++k) { const int tok = tk[k] >= 0 ? tk[k] >> 2 : 0; const v4u* src = (const v4u*)(WSP(bf16, WS_H) + (size_t)tok * D); ra[k] = src[F.lane]; rb[k] = src[F.lane + 64]; }
#pragma unroll
            for (int k = 0; k < 4; ++k) if (tk[k] >= 0) { const int dr = tpre[e0 + k] * 256 + pb_; v4u* dst = (v4u*)(WSP(bf16, WS_HS) + (size_t)dr * D); dst[F.lane] = ra[k]; dst[F.lane + 64] = rb[k];
                    if (F.lane == 0) WSP(int, WS_SROW)[tk[k]] = dr; }
        }
        bool more = false;
        for (int e = 0; e < NEXP; ++e) more |= pb_ + NGW < cnt[e];
        if (!more) break;
    }
}

constexpr int AT_KP = 72, AT_VP = 68;
constexpr int AT_KB = 64 * AT_KP * 2, AT_VB = 64 * AT_VP * 2, AT_BUF = AT_KB + AT_VB;
constexpr int AT_RPB = 2 * AT_BUF;

__device__ __forceinline__ float max3f_(float a, float b, float c) { float r; asm("v_max3_f32 %0, %1, %2, %3" : "=v"(r) : "v"(a), "v"(b), "v"(c)); return r; }
struct AttnUnit {
    int kind;
    int b, hx, qx;
};

__device__ __forceinline__ void attn_unit(Frame& F, int l, const AttnUnit un) {
    REFRESH_TID(F);
    const int lane = F.lane, w = F.wave, q32 = lane & 31, hh = lane >> 5;
    const bf16* U = WSP(bf16, WS_U);
    const bool na = (un.kind & 1) != 0, ctxq = un.kind >= 2;
    const int b = un.b;
    int qrow0, qcol, kcol, ycol, nlat, krow_lat0, r_grid = 0, c0 = 0, rs_w = 0;
    const bf16* vt; bf16* Y;
    if (!na) {
        const int head = 4 * un.hx + (w & 3);
        qrow0 = (ctxq ? TLAT + b * LCTX : b * SEQ) + 64 * un.qx + 32 * (w >> 2);
        qcol = UQ + head * 64; kcol = UK + un.hx * 64; ycol = head * 64;
        vt = WSP(bf16, WS_VAT) + (size_t)(b * 2 + un.hx) * 64 * KEYS;
        Y = WSP(bf16, WS_Y);
        nlat = ctxq ? 0 : 64; krow_lat0 = b * SEQ;
    } else {
        const int head = un.hx;
        if (ctxq) { qrow0 = TLAT + b * LCTX + 32 * w; nlat = 0; krow_lat0 = 0; }
        else {
            r_grid = 4 * un.qx + (w >> 1); c0 = 32 * (w & 1);
            qrow0 = b * SEQ + 64 * r_grid + c0;
            int rs_min = 4 * un.qx - 4; rs_min = rs_min < 0 ? 0 : (rs_min > 56 ? 56 : rs_min);
            int rs_max = 4 * un.qx + 3 - 4; rs_max = rs_max < 0 ? 0 : (rs_max > 56 ? 56 : rs_max);
            nlat = rs_max + 8 - rs_min; krow_lat0 = b * SEQ + 64 * rs_min;
            rs_w = r_grid - 4; rs_w = rs_w < 0 ? 0 : (rs_w > 56 ? 56 : rs_w);
            rs_w -= rs_min;
        }
        qcol = UDQ + head * 64; kcol = UDK + head * 64; ycol = head * 64;
        vt = WSP(bf16, WS_VDT) + (size_t)(b * 8 + head) * 64 * KEYS;
        Y = WSP(bf16, WS_Y) + (size_t)3 * MROWS * 512;
    }
    const int vkey_lat0 = krow_lat0 - b * SEQ;
    const int ntile = nlat + 4;
    LAS unsigned char* lds = F.lds;
    if (na && !ctxq) {
        LAS float* rp = (LAS float*)(lds + AT_RPB);
        const float* src = F.in[I_RPB] + ((size_t)l * 8 + un.hx) * 465;
        for (int i = F.tid; i < 465; i += NT) rp[i] = src[i] * LOG2E;
    }
    bf16x8 qf[4];
    {
        const bf16* qp = U + (size_t)(qrow0 + q32) * UW + qcol + 8 * hh;
#pragma unroll
        for (int s = 0; s < 4; ++s) qf[s] = *(const bf16x8*)(qp + 16 * s);
        if (na) {
#pragma unroll
            for (int s = 0; s < 4; ++s) { v4u t = __builtin_bit_cast(v4u, qf[s]); const float sc = 0.125f * LOG2E;
                t.x = pk2(bflo(t.x) * sc, bfhi(t.x) * sc); t.y = pk2(bflo(t.y) * sc, bfhi(t.y) * sc); t.z = pk2(bflo(t.z) * sc, bfhi(t.z) * sc); t.w = pk2(bflo(t.w) * sc, bfhi(t.w) * sc);
                qf[s] = __builtin_bit_cast(bf16x8, t); }
        }
    }
    const int lk = F.tid >> 3, lc = F.tid & 7;
    v4u kr[4], vr[4];
#define AT_TILE_ADDR(i, krow0_, vkey0_) do { const int i_ = (i) < ntile ? (i) : ntile - 1; \
        if (i_ < nlat) { krow0_ = krow_lat0 + 64 * i_; vkey0_ = vkey_lat0 + 64 * i_; } else { krow0_ = TLAT + b * LCTX + 64 * (i_ - nlat); vkey0_ = SEQ + 64 * (i_ - nlat); } } while (0)
#define AT_LDK(dst, i) do { int kr0_, vk0_; AT_TILE_ADDR(i, kr0_, vk0_); (void)vk0_; dst = *(const v4u*)(U + (size_t)(kr0_ + lk) * UW + kcol + lc * 8); } while (0)
#define AT_LDV(dst, i) do { int kr0_, vk0_; AT_TILE_ADDR(i, kr0_, vk0_); (void)kr0_; dst = *(const v4u*)(vt + (size_t)lk * KEYS + vk0_ + lc * 8); } while (0)
#define AT_STK(src, buf) do { *(LAS v4u*)(lds + (buf) * AT_BUF + lk * (AT_KP * 2) + lc * 16) = src; } while (0)
#define AT_STV(src, buf) do { LAS unsigned char* b_ = lds + (buf) * AT_BUF + AT_KB + lk * (AT_VP * 2) + lc * 16; *(LAS v2u*)b_ = (v2u){src.x, src.y}; *(LAS v2u*)(b_ + 8) = (v2u){src.z, src.w}; } while (0)
    float m_run = 0.f, l_run = 0.f;
    f32x16 negm;
#pragma unroll
    for (int i = 0; i < 16; ++i) negm[i] = 0.f;
    bool first = true;
    f32x16 o0, o1;
#pragma unroll
    for (int i = 0; i < 16; ++i) { o0[i] = 0.f; o1[i] = 0.f; }
    const int cq = c0 + q32;
    int cst = cq - 8; cst = cst < 0 ? 0 : (cst > 48 ? 48 : cst);
#define AT_ACTIVE(i) (!(na && !ctxq && (i) < nlat && ((i) < rs_w || (i) > rs_w + 7)))
#define AT_QK(S0, S1, buf) do { const LAS unsigned char* kb_ = lds + (buf) * AT_BUF; \
        _Pragma("unroll") for (int s = 0; s < 4; ++s) { \
            const bf16x8 k0 = *(const LAS bf16x8*)(kb_ + (q32) * (AT_KP * 2) + (16 * s + 8 * hh) * 2); \
            const bf16x8 k1 = *(const LAS bf16x8*)(kb_ + (32 + q32) * (AT_KP * 2) + (16 * s + 8 * hh) * 2); \
            S0 = __builtin_amdgcn_mfma_f32_32x32x16_bf16(k0, qf[s], s == 0 ? negm : S0, 0, 0, 0); \
            S1 = __builtin_amdgcn_mfma_f32_32x32x16_bf16(k1, qf[s], s == 0 ? negm : S1, 0, 0, 0); } } while (0)
#define AT_SOFTMAX_PV(C0, C1, N0, N1, nvalid, i, vbuf) do { \
        if (na && !ctxq && (i) < nlat) { \
            const LAS float* rp = (const LAS float*)(lds + AT_RPB); \
            const int kr_ = (krow_lat0 - b * SEQ) / 64 + (i); const int rb = (kr_ - r_grid + 7) * 31 + 15 - cq; \
            _Pragma("unroll") for (int j = 0; j < 16; ++j) { \
                const int kc0 = (j & 3) + 8 * (j >> 2) + 4 * hh, kc1 = kc0 + 32; \
                const bool ok0 = kc0 >= cst && kc0 < cst + 16, ok1 = kc1 >= cst && kc1 < cst + 16; \
                int i0_ = rb + kc0, i1_ = rb + kc1; i0_ = i0_ < 0 ? 0 : (i0_ > 464 ? 464 : i0_); i1_ = i1_ < 0 ? 0 : (i1_ > 464 ? 464 : i1_); \
                const float b0 = rp[i0_], b1 = rp[i1_]; \
                C0[j] = ok0 ? C0[j] + b0 : -1e30f; C1[j] = ok1 ? C1[j] + b1 : -1e30f; } } \
        float mx = max3f_(C0[0], C1[0], C0[1]); \
        mx = max3f_(mx, C1[1], C0[2]); mx = max3f_(mx, C1[2], C0[3]); mx = max3f_(mx, C1[3], C0[4]); mx = max3f_(mx, C1[4], C0[5]); mx = max3f_(mx, C1[5], C0[6]); \
        mx = max3f_(mx, C1[6], C0[7]); mx = max3f_(mx, C1[7], C0[8]); mx = max3f_(mx, C1[8], C0[9]); mx = max3f_(mx, C1[9], C0[10]); mx = max3f_(mx, C1[10], C0[11]); \
        mx = max3f_(mx, C1[11], C0[12]); mx = max3f_(mx, C1[12], C0[13]); mx = max3f_(mx, C1[13], C0[14]); mx = max3f_(mx, C1[14], C0[15]); mx = fmaxf(mx, C1[15]); \
        mx = fmaxf(mx, __shfl_xor(mx, 32)); \
        if (first || __builtin_amdgcn_ballot_w64(mx > 6.f) != 0ull) {     \
            const float d = first ? fmaxf(mx, -120.f) : fmaxf(mx, 0.f); \
            const float alpha = __builtin_amdgcn_exp2f(-d); \
            l_run *= alpha; m_run += d; \
            _Pragma("unroll") for (int j = 0; j < 16; ++j) { o0[j] *= alpha; o1[j] *= alpha; C0[j] -= d; C1[j] -= d; negm[j] = -m_run; } \
            if (nvalid) { _Pragma("unroll") for (int j = 0; j < 16; ++j) { N0[j] -= d; N1[j] -= d; } } \
            first = false; } \
        float ps = 0.f; \
        _Pragma("unroll") for (int j = 0; j < 16; ++j) { C0[j] = __builtin_amdgcn_exp2f(C0[j]); C1[j] = __builtin_amdgcn_exp2f(C1[j]); ps += C0[j]; ps += C1[j]; } \
        l_run += ps; \
        bf16x8 pb[2][2]; \
        _Pragma("unroll") for (int s2 = 0; s2 < 2; ++s2) { v4u t0, t1; \
            t0.x = pk2(C0[8 * s2 + 0], C0[8 * s2 + 1]); t0.y = pk2(C0[8 * s2 + 2], C0[8 * s2 + 3]); t0.z = pk2(C0[8 * s2 + 4], C0[8 * s2 + 5]); t0.w = pk2(C0[8 * s2 + 6], C0[8 * s2 + 7]); \
            t1.x = pk2(C1[8 * s2 + 0], C1[8 * s2 + 1]); t1.y = pk2(C1[8 * s2 + 2], C1[8 * s2 + 3]); t1.z = pk2(C1[8 * s2 + 4], C1[8 * s2 + 5]); t1.w = pk2(C1[8 * s2 + 6], C1[8 * s2 + 7]); \
            pb[0][s2] = __builtin_bit_cast(bf16x8, t0); pb[1][s2] = __builtin_bit_cast(bf16x8, t1); } \
        const LAS unsigned char* vb_ = lds + (vbuf) * AT_BUF + AT_KB; \
        _Pragma("unroll") for (int sub = 0; sub < 2; ++sub) _Pragma("unroll") for (int s2 = 0; s2 < 2; ++s2) { \
            const int ko = (32 * sub + 16 * s2 + 4 * hh) * 2; \
            const v2u a0 = *(const LAS v2u*)(vb_ + (q32) * (AT_VP * 2) + ko), a1 = *(const LAS v2u*)(vb_ + (q32) * (AT_VP * 2) + ko + 16); \
            const v2u c0_ = *(const LAS v2u*)(vb_ + (32 + q32) * (AT_VP * 2) + ko), c1_ = *(const LAS v2u*)(vb_ + (32 + q32) * (AT_VP * 2) + ko + 16); \
            const bf16x8 vf0 = __builtin_bit_cast(bf16x8, ((v4u){a0.x, a0.y, a1.x, a1.y})); \
            const bf16x8 vf1 = __builtin_bit_cast(bf16x8, ((v4u){c0_.x, c0_.y, c1_.x, c1_.y})); \
            o0 = __builtin_amdgcn_mfma_f32_32x32x16_bf16(vf0, pb[sub][s2], o0, 0, 0, 0); \
            o1 = __builtin_amdgcn_mfma_f32_32x32x16_bf16(vf1, pb[sub][s2], o1, 0, 0, 0); } } while (0)
    f32x16 sa0, sa1, sb0, sb1;
    {
        v4u k0r, k1r, v0r; AT_LDK(k0r, 0); AT_LDK(k1r, 1); AT_LDV(v0r, 0);
#pragma unroll
        for (int st = 0; st < 4; ++st) { AT_LDK(kr[st], st + 2); AT_LDV(vr[st], st + 1); }
        AT_STK(k0r, 0); AT_STK(k1r, 1); AT_STV(v0r, 0);
        lds_barrier();
        if (AT_ACTIVE(0)) AT_QK(sa0, sa1, 0);
        lds_barrier();
    }
    const int ntile4 = (ntile + 3) & ~3;
#pragma unroll 1
    for (int i0 = 0; i0 < ntile4; i0 += 4) {
#pragma unroll
      for (int st = 0; st < 4; ++st) {
        const int i = i0 + st;
        AT_STK(kr[st], st & 1); AT_STV(vr[st], (st + 1) & 1);
        AT_LDK(kr[st], i + 6); AT_LDV(vr[st], i + 5);
        const bool nvalid = (i + 1 < ntile) && AT_ACTIVE(i + 1);
        if (st & 1) { if (nvalid) AT_QK(sa0, sa1, 0); if (i < ntile && AT_ACTIVE(i)) AT_SOFTMAX_PV(sb0, sb1, sa0, sa1, nvalid, i, 1); }
        else        { if (nvalid) AT_QK(sb0, sb1, 1); if (i < ntile && AT_ACTIVE(i)) AT_SOFTMAX_PV(sa0, sa1, sb0, sb1, nvalid, i, 0); }
        lds_barrier();
      }
    }
#undef AT_TILE_ADDR
#undef AT_LDK
#undef AT_LDV
#undef AT_STK
#undef AT_STV
#undef AT_ACTIVE
#undef AT_QK
#undef AT_SOFTMAX_PV
    const float lt = l_run + __shfl_xor(l_run, 32);
    const float inv = 1.f / lt;
    bf16* yp = Y + (size_t)(qrow0 + q32) * 512 + ycol + 4 * hh;
#pragma unroll
    for (int g = 0; g < 4; ++g) {
        v2u a; a.x = pk2(o0[4 * g] * inv, o0[4 * g + 1] * inv); a.y = pk2(o0[4 * g + 2] * inv, o0[4 * g + 3] * inv);
        v2u c; c.x = pk2(o1[4 * g] * inv, o1[4 * g + 1] * inv); c.y = pk2(o1[4 * g + 2] * inv, o1[4 * g + 3] * inv);
        *(v2u*)(yp + 8 * g) = a; *(v2u*)(yp + 32 + 8 * g) = c;
    }
    __syncthreads();
}

__device__ __forceinline__ void attn_phase(Frame& F, int l) {
    const int x = F.bid & 7, y = F.bid >> 3, ny = F.G >> 3;
    for (int q = y; q < 64; q += ny) { AttnUnit un; un.kind = 0; un.b = x >> 1; un.hx = x & 1; un.qx = q; attn_unit(F, l, un); }
    for (int q = y; q < 64; q += ny) { const int combo = x + 8 * (q >> 4); AttnUnit un; un.kind = 1; un.b = combo >> 3; un.hx = combo & 7; un.qx = q & 15; attn_unit(F, l, un); }
    for (int q = y; q < 8; q += ny) { AttnUnit un;
        if (q < 4) { un.kind = 2; un.b = x >> 1; un.hx = x & 1; un.qx = q; }
        else { const int combo = x + 8 * (q - 4); un.kind = 3; un.b = combo >> 3; un.hx = combo & 7; un.qx = 0; }
        attn_unit(F, l, un); }
}


__device__ __forceinline__ void qk_prep(Frame& F, int l) {
    REFRESH_TID(F);
    const int gw = F.bid * NWAVES + F.wave, NGW = F.G * NWAVES, lane = F.lane;
    bf16* U = WSP(bf16, WS_U);
    const float* tab = WSP(float, WS_ROPE);
    const int d0 = (lane & 7) * 8;
    float gq[8], gk[8];
#pragma unroll
    for (int j = 0; j < 8; ++j) { gq[j] = F.in[I_AGQ][l * 64 + d0 + j]; gk[j] = F.in[I_AGK][l * 64 + d0 + j]; }
    for (int r0 = gw; r0 < MROWS; r0 += 2 * NGW) {
        const int r1 = r0 + NGW;
        v4u qv2[2], kv2[2];
#pragma unroll
        for (int k = 0; k < 2; ++k) { const int r = k ? (r1 < MROWS ? r1 : r0) : r0; const bf16* up = U + (size_t)r * UW;
            qv2[k] = *(const v4u*)(up + UQ + lane * 8); kv2[k] = (v4u){0u, 0u, 0u, 0u}; if (lane < 16) kv2[k] = *(const v4u*)(up + UK + lane * 8); }
#pragma unroll
        for (int k = 0; k < 2; ++k) {
        const int r = k ? r1 : r0; if (r >= MROWS) break;
        const bool lat = r < TLAT;
        bf16* up = U + (size_t)r * UW;
        const v4u qv = qv2[k], kv = kv2[k];
        float cs[8], sn[8];
#pragma unroll
        for (int j = 0; j < 8; ++j) { cs[j] = 1.f; sn[j] = 0.f; }
        if (lat) { const int t = r & 4095;
#pragma unroll
            for (int j = 0; j < 8; ++j) { const int i = (d0 + j) & 31; const int idx = i < 16 ? (t >> 6) * 16 + i : (t & 63) * 16 + (i - 16); cs[j] = tab[idx]; sn[j] = tab[1024 + idx]; } }
#pragma unroll
        for (int which = 0; which < 2; ++which) {
            const v4u raw = which ? kv : qv;
            float x[8] = {bflo(raw.x), bfhi(raw.x), bflo(raw.y), bfhi(raw.y), bflo(raw.z), bfhi(raw.z), bflo(raw.w), bfhi(raw.w)};
            float ss = 0.f;
#pragma unroll
            for (int j = 0; j < 8; ++j) ss += x[j] * x[j];
            ss += __shfl_xor(ss, 1); ss += __shfl_xor(ss, 2); ss += __shfl_xor(ss, 4);
            const float rs = rsqrtf(ss * (1.f / 64.f) + EPS);
            float y[8];
#pragma unroll
            for (int j = 0; j < 8; ++j) y[j] = x[j] * rs * (which ? gk[j] : gq[j]);
            const bool hi = (lane & 4) != 0;
#pragma unroll
            for (int j = 0; j < 8; ++j) { const float p = __shfl_xor(y[j], 4);
                if (lat) y[j] = hi ? y[j] * cs[j] + p * sn[j] : y[j] * cs[j] - p * sn[j];
                if (!which) y[j] *= 0.125f * LOG2E; }
            v4u o; o.x = pk2(y[0], y[1]); o.y = pk2(y[2], y[3]); o.z = pk2(y[4], y[5]); o.w = pk2(y[6], y[7]);
            if (!which) *(v4u*)(up + UQ + lane * 8) = o; else if (lane < 16) *(v4u*)(up + UK + lane * 8) = o;
        }
        }
    }
}

__device__ __forceinline__ void v_transpose(Frame& F) {
    REFRESH_TID(F);
    const int gw = F.bid * NWAVES + F.wave, NGW = F.G * NWAVES, lane = F.lane;
    LAS bf16* T = (LAS bf16*)(F.lds + F.wave * 9216);
    const bf16* U = WSP(bf16, WS_U);
    for (int it = gw; it < NCHUNK * 10; it += NGW) {
        const int g = it / 10, hd = it % 10;
        int b, key0;
        if (g < 256) { b = g >> 6; key0 = (g & 63) * 64; } else { b = (g - 256) >> 2; key0 = SEQ + ((g - 256) & 3) * 64; }
        const int scol = hd < 2 ? UV + hd * 64 : UDV + (hd - 2) * 64;
        bf16* dst = hd < 2 ? WSP(bf16, WS_VAT) + (size_t)(b * 2 + hd) * 64 * KEYS : WSP(bf16, WS_VDT) + (size_t)(b * 8 + hd - 2) * 64 * KEYS;
        v4u rv[8];
#pragma unroll
        for (int i = 0; i < 8; ++i) { const int tok = 8 * i + (lane >> 3), ch = lane & 7; rv[i] = *(const v4u*)(U + (size_t)(64 * g + tok) * UW + scol + ch * 8); }
#pragma unroll
        for (int i = 0; i < 8; ++i) { const int tok = 8 * i + (lane >> 3), ch = lane & 7; const unsigned wv[4] = {rv[i].x, rv[i].y, rv[i].z, rv[i].w};
#pragma unroll
            for (int j = 0; j < 4; ++j) { T[(ch * 8 + 2 * j) * 72 + tok] = (bf16)(wv[j] & 0xffffu); T[(ch * 8 + 2 * j + 1) * 72 + tok] = (bf16)(wv[j] >> 16); } }
        asm volatile("s_waitcnt lgkmcnt(0)" ::: "memory");
#pragma unroll
        for (int i = 0; i < 8; ++i) { const int d = 8 * i + (lane >> 3), ch = lane & 7;
            const v4u o = *(const LAS v4u*)(T + d * 72 + ch * 8);
            *(v4u*)(dst + (size_t)d * KEYS + key0 + ch * 8) = o; }
        asm volatile("s_waitcnt lgkmcnt(0)" ::: "memory");
    }
}

constexpr int LR_XCB = 0, LR_WV = 17408, LR_WVB = 12288;
__device__ __forceinline__ void seq_bounds(int g, int& lo, int& hi) {
    if (g < 256) { lo = (g >> 6) * SEQ; hi = lo + SEQ; } else { lo = TLAT + ((g - 256) >> 2) * LCTX; hi = lo + LCTX; }
}
struct LruRaw { v4u r[3]; };
__device__ __forceinline__ void lru_raw_load(Frame& F, LruRaw& R, int g, int q) {
    const bf16* U = WSP(bf16, WS_U);
    int lo, hi; seq_bounds(g, lo, hi);
#pragma unroll
    for (int k = 0; k < 3; ++k) { const int i = F.tid + NT * k, rr = i >> 4, ch = i & 15, row = 64 * g - 1 + rr;
        v4u v = (v4u){0u, 0u, 0u, 0u};
        if (i < 67 * 16 && row >= lo && row < hi) v = *(const v4u*)(U + (size_t)row * UW + UBX + 128 * q + ch * 8);
        R.r[k] = v; }
}
__device__ __forceinline__ void lru_stage_conv(Frame& F, int l, const LruRaw& R, int q) {
    LAS bf16* raw = (LAS bf16*)(F.lds + LR_WV);
    LAS bf16* xcb = (LAS bf16*)(F.lds + LR_XCB);
    lds_barrier();
#pragma unroll
    for (int k = 0; k < 3; ++k) { const int i = F.tid + NT * k, rr = i >> 4, ch = i & 15; if (i < 67 * 16) *(LAS v4u*)(raw + rr * 128 + ch * 8) = R.r[k]; }
    lds_barrier();
    {
        const int ch = F.tid & 127, tg = F.tid >> 7, cabs = 128 * q + ch;
        const float* cw = F.in[I_BCW] + (size_t)l * 4 * 512 + cabs;
        const float w0 = cw[0], w1 = cw[512], w2 = cw[1024], w3 = cw[1536], bb = F.in[I_BCB][l * 512 + cabs];
        float x0 = bf2f(raw[(16 * tg) * 128 + ch]), x1 = bf2f(raw[(16 * tg + 1) * 128 + ch]), x2 = bf2f(raw[(16 * tg + 2) * 128 + ch]);
#pragma unroll
        for (int t = 0; t < 16; ++t) { const float x3 = bf2f(raw[(16 * tg + t + 3) * 128 + ch]);
            const float y = bb + w0 * x0 + w1 * x1 + w2 * x2 + w3 * x3;
            xcb[(16 * tg + t) * 136 + ch] = (bf16)f2bf(y);
            x0 = x1; x1 = x2; x2 = x3; }
    }
    lds_barrier();
}
struct LruW { bf16x8 br0, br1, bi0, bi1; float bR, bI, lam; };
__device__ __forceinline__ void lru_w_load(Frame& F, LruW& W, int l, int dir, int q) {
    const int lane = F.lane, w = F.wave, r16 = lane & 15, quad = lane >> 4;
    const int nbl = w >> 2, dt = w & 3, nb = 2 * q + nbl;
    const bf16* wr = WSP(bf16, WS_LRUW) + ((((size_t)(l * 2 + dir) * 2 + 0) * 8 + nb) * 64 + 16 * dt + r16) * 64 + 8 * quad;
    const bf16* wi = WSP(bf16, WS_LRUW) + ((((size_t)(l * 2 + dir) * 2 + 1) * 8 + nb) * 64 + 16 * dt + r16) * 64 + 8 * quad;
    W.br0 = *(const bf16x8*)wr; W.br1 = *(const bf16x8*)(wr + 32); W.bi0 = *(const bf16x8*)wi; W.bi1 = *(const bf16x8*)(wi + 32);
    const int cabs = 64 * nb + 16 * dt + r16;
    W.bR = F.in[I_BBR][(l * 2 + dir) * 512 + cabs]; W.bI = F.in[I_BBI][(l * 2 + dir) * 512 + cabs]; W.lam = F.in[I_BLAM][(l * 2 + dir) * 512 + cabs];
}
__device__ __forceinline__ void lru_gates(Frame& F, const LruW& W) {
    const int lane = F.lane, w = F.wave, r16 = lane & 15, quad = lane >> 4;
    const LAS bf16* xcb = (const LAS bf16*)(F.lds + LR_XCB);
    LAS float* sa = (LAS float*)(F.lds + LR_WV + w * LR_WVB);
    LAS float* sb = sa + 1024;
    const int nbl = w >> 2, dt = w & 3;
    const int cl = 64 * nbl + 16 * dt + r16;
    const float sp = softplusf_(-W.lam);
#pragma unroll
    for (int tt = 0; tt < 4; ++tt) {
        const LAS bf16* ap = xcb + (16 * tt + r16) * 136 + 64 * nbl + 8 * quad;
        const bf16x8 a0 = *(const LAS bf16x8*)ap, a1 = *(const LAS bf16x8*)(ap + 32);
        f32x4 ar = (f32x4){0.f, 0.f, 0.f, 0.f}, ai = ar;
        ar = __builtin_amdgcn_mfma_f32_16x16x32_bf16(a0, W.br0, ar, 0, 0, 0); ar = __builtin_amdgcn_mfma_f32_16x16x32_bf16(a1, W.br1, ar, 0, 0, 0);
        ai = __builtin_amdgcn_mfma_f32_16x16x32_bf16(a0, W.bi0, ai, 0, 0, 0); ai = __builtin_amdgcn_mfma_f32_16x16x32_bf16(a1, W.bi1, ai, 0, 0, 0);
#pragma unroll
        for (int j = 0; j < 4; ++j) { const int t = 16 * tt + 4 * quad + j;
            const float rg = sigmoidf_(ar[j] + W.bR), ig = sigmoidf_(ai[j] + W.bI);
            const float la = -8.f * rg * sp;
            const float a = __expf(la), x2 = 2.f * la;
            const float om = x2 > -0.05f ? -x2 * (1.f + x2 * (0.5f + x2 * (0.16666667f + x2 * 0.041666668f))) : 1.f - __expf(x2);
            const float mult = __builtin_amdgcn_sqrtf(om);
            const float xv = bf2f(xcb[t * 136 + cl]);
            sa[t * 16 + r16] = a; sb[t * 16 + r16] = mult * ig * xv; }
    }
    asm volatile("s_waitcnt lgkmcnt(0)" ::: "memory");
}
__device__ __forceinline__ void lru_pass1(Frame& F, int l) {
    const bool even = F.G == 256;
    const int nit = even ? (F.bid < 64 ? 2 : 5) : (NCHUNK * 4 - F.bid + F.G - 1) / F.G;
#define LRU1_ITEM(k) (even ? (F.bid < 64 ? F.bid + 64 * (k) : 128 + (F.bid - 64) * 5 + (k)) : F.bid + F.G * (k))
    LruRaw R; REFRESH_TID(F);
    if (nit > 0) { const int i0 = LRU1_ITEM(0); lru_raw_load(F, R, i0 >> 2, i0 & 3); }
#pragma unroll 1
    for (int kk = 0; kk < nit; ++kk) {
        const int it = LRU1_ITEM(kk);
        REFRESH_TID(F);
        const int g = it >> 2, q = it & 3;
        LruW W0, W1; lru_w_load(F, W0, l, 0, q); lru_w_load(F, W1, l, 1, q);
        lru_stage_conv(F, l, R, q);
        { const int itn = kk + 1 < nit ? LRU1_ITEM(kk + 1) : it; lru_raw_load(F, R, itn >> 2, itn & 3); }
#pragma unroll
        for (int dir = 0; dir < 2; ++dir) {
            lru_gates(F, dir ? W1 : W0);
            const int lane = F.lane, w = F.wave, ch = lane & 15, seg = lane >> 4;
            const LAS float* sa = (const LAS float*)(F.lds + LR_WV + w * LR_WVB); const LAS float* sb = sa + 1024;
            float A = 1.f, B = 0.f;
#pragma unroll
            for (int k = 0; k < 16; ++k) { const int tp = 16 * seg + k, t = dir ? 63 - tp : tp; const float a = sa[t * 16 + ch]; B = a * B + sb[t * 16 + ch]; A *= a; }
            float At = 1.f, Bt = 0.f;
#pragma unroll
            for (int s = 0; s < 4; ++s) { const float As = __shfl(A, 16 * s + ch), Bs = __shfl(B, 16 * s + ch); Bt = As * Bt + Bs; At *= As; }
            if (seg == 0) { const int cabs = 128 * q + 64 * (w >> 2) + 16 * (w & 3) + ch;
                WSP(float, WS_LRA)[((size_t)g * 2 + dir) * 512 + cabs] = At; WSP(float, WS_LRB)[((size_t)g * 2 + dir) * 512 + cabs] = Bt; }
            asm volatile("s_waitcnt lgkmcnt(0)" ::: "memory");
        }
    }
}
__device__ __forceinline__ void lru_carry_all(Frame& F) {
    REFRESH_TID(F);
    if (F.tid >= 16) return;
    const float* LA = WSP(float, WS_LRA); const float* LB = WSP(float, WS_LRB); float* LC = WSP(float, WS_LRC);
    for (int chain = F.bid * 16 + F.tid; chain < 4096; chain += F.G * 16) {
        const int ch = chain & 511, dir = (chain >> 9) & 1, b = chain >> 10;
        float h = 0.f;
#pragma unroll 1
        for (int sb = 0; sb < 4; ++sb) {
            float av[17], bv[17]; size_t ix[17];
#pragma unroll
            for (int k = 0; k < 17; ++k) { const int s = sb * 17 + k; int g;
                if (s < 4) g = 256 + 4 * b + (dir ? 3 - s : s); else g = 64 * b + (dir ? 63 - (s - 4) : (s - 4));
                ix[k] = ((size_t)g * 2 + dir) * 512 + ch; av[k] = LA[ix[k]]; bv[k] = LB[ix[k]]; }
#pragma unroll
            for (int k = 0; k < 17; ++k) { LC[ix[k]] = h; h = av[k] * h + bv[k]; }
        }
    }
}
__device__ __forceinline__ float gelu_tanh(float x) { const float u = 0.7978845608028654f * (x + 0.044715f * x * x * x); return x / (1.f + __expf(-2.f * u)); }
__device__ __forceinline__ void lru_pass2(Frame& F, int l) {
    int it = F.bid;
    const int nitems = (l == DEPTH - 1 ? 256 : NCHUNK) * 4;
    LruRaw R; REFRESH_TID(F);
    if (it < nitems) lru_raw_load(F, R, it >> 2, it & 3);
#pragma unroll 1
    for (; it < nitems; it += F.G) {
        REFRESH_TID(F);
        const int g = it >> 2, q = it & 3;
        const int lane = F.lane, w = F.wave, ch = lane & 15, seg = lane >> 4;
        const int cabs = 128 * q + 64 * (w >> 2) + 16 * (w & 3) + ch;
        const bf16* U = WSP(bf16, WS_U); bf16* YB = WSP(bf16, WS_Y) + (size_t)1 * MROWS * 512;
        LruW W0, W1; lru_w_load(F, W0, l, 0, q); lru_w_load(F, W1, l, 1, q);
        const float hc0 = WSP(float, WS_LRC)[((size_t)g * 2 + 0) * 512 + cabs], hc1 = WSP(float, WS_LRC)[((size_t)g * 2 + 1) * 512 + cabs];
        unsigned yraw[16];
#pragma unroll
        for (int k = 0; k < 16; ++k) yraw[k] = U[((size_t)64 * g + 16 * seg + k) * UW + UBY + cabs];
        lru_stage_conv(F, l, R, q);
        { const int itn = it + F.G < nitems ? it + F.G : it; lru_raw_load(F, R, itn >> 2, itn & 3); }
        LAS float* sa = (LAS float*)(F.lds + LR_WV + w * LR_WVB); LAS float* sb = sa + 1024; LAS float* sh = sa + 2048;
#pragma unroll
        for (int dir = 0; dir < 2; ++dir) {
            lru_gates(F, dir ? W1 : W0);
            float A = 1.f, B = 0.f;
#pragma unroll
            for (int k = 0; k < 16; ++k) { const int tp = 16 * seg + k, t = dir ? 63 - tp : tp; const float a = sa[t * 16 + ch]; B = a * B + sb[t * 16 + ch]; A *= a; }
            float h = dir ? hc1 : hc0;
#pragma unroll
            for (int s = 0; s < 3; ++s) { const float As = __shfl(A, 16 * s + ch), Bs = __shfl(B, 16 * s + ch); if (s < seg) h = As * h + Bs; }
#pragma unroll
            for (int k = 0; k < 16; ++k) { const int tp = 16 * seg + k, t = dir ? 63 - tp : tp; h = sa[t * 16 + ch] * h + sb[t * 16 + ch];
                if (dir == 0) sh[t * 16 + ch] = h; else sh[t * 16 + ch] += h; }
            asm volatile("s_waitcnt lgkmcnt(0)" ::: "memory");
        }
#pragma unroll
        for (int k = 0; k < 16; ++k) { const int t = 16 * seg + k; const size_t row = (size_t)64 * g + t;
            YB[row * 512 + cabs] = (bf16)f2bf(sh[t * 16 + ch] * gelu_tanh(bflo(yraw[k]))); }
        asm volatile("s_waitcnt lgkmcnt(0)" ::: "memory");
    }
}

#ifndef GDN_PREP_REPS
#define GDN_PREP_REPS 1
#endif
#ifdef PROBE_SUB
#define GP_T(k) do { if (PROBE_SUB == (k) && F.bid == 0) { const unsigned long long n_ = __builtin_amdgcn_s_memrealtime(); F.pr += n_ - gp_t; } gp_t = __builtin_amdgcn_s_memrealtime(); } while (0)
#else
#define GP_T(k) do { } while (0)
#endif
constexpr int GD_CW = MISC_OFF + 2048;
constexpr int GD_Q = 0, GD_K = 17408, GD_V = 34816, GD_KK = 52224, GD_QK = 68864, GD_L = 85504, GD_SM = 118272;
__device__ __forceinline__ void gdn_prep(Frame& F, int l) {
    const bf16* U = WSP(bf16, WS_U);
    const int w = F.wave;
    __syncthreads();
    for (int i = F.tid; i < 4 * 1536 / 2; i += NT) { const float* cw = F.in[I_CCW] + (size_t)l * 4 * 1536 + 2 * i; ((LAS unsigned*)(F.lds + GD_CW))[i] = pk2(cw[0], cw[1]); }
    __syncthreads();
#pragma unroll 1
    for (int it0 = F.bid; it0 < NCHUNK * 4 * GDN_PREP_REPS; it0 += F.G) {
        const int it = it0 % (NCHUNK * 4);
        int tid = F.tid; asm volatile("" : "+v"(tid));
        const int lane = tid & 63, r16 = lane & 15, quad = lane >> 4;
        const int g = it >> 2, h = it & 3;
        int lo, hi; seq_bounds(g, lo, hi);
        LAS bf16* raw = (LAS bf16*)(F.lds + GD_KK);
#ifdef PROBE_SUB
        unsigned long long gp_t = __builtin_amdgcn_s_memrealtime();
#endif
        lds_barrier();
        {
            v4u rv[7];
#pragma unroll
            for (int k = 0; k < 7; ++k) { const int i = tid + NT * k; const int ten = i / 1072, r_ = i - ten * 1072, rr = r_ >> 4, ch = r_ & 15, row = 64 * g - 1 + rr;
                const int ucol = (ten == 0 ? UCQ : (ten == 1 ? UCK : UCV)) + 128 * h;
                rv[k] = (v4u){0u, 0u, 0u, 0u};
                if (i < 3216 && row >= lo && row < hi) rv[k] = *(const v4u*)(U + (size_t)row * UW + ucol + ch * 8); }
#pragma unroll
            for (int k = 0; k < 7; ++k) { const int i = tid + NT * k; const int ten = i / 1072, r_ = i - ten * 1072, rr = r_ >> 4, ch = r_ & 15;
                if (i < 3216) *(LAS v4u*)(raw + ten * (67 * 128) + rr * 128 + ch * 8) = rv[k]; }
        }
        lds_barrier();
#pragma unroll 1
        for (int ten = 0; ten < 3; ++ten) {
            const int t = tid >> 3, ds = tid & 7;
            const LAS bf16* rawt = raw + ten * (67 * 128);
            const LAS bf16* cwl = (const LAS bf16*)(F.lds + GD_CW) + ten * 512 + 128 * h + 16 * ds;
            float y[16]; float ss = 0.f;
            {
                float xin[4][16], wv_[4][16];
#pragma unroll
                for (int j = 0; j < 4; ++j) { const v4u r0 = *(const LAS v4u*)(rawt + (t + j) * 128 + 16 * ds), r1 = *(const LAS v4u*)(rawt + (t + j) * 128 + 16 * ds + 8);
                    const v4u w0 = *(const LAS v4u*)(cwl + j * 1536), w1 = *(const LAS v4u*)(cwl + j * 1536 + 8);
                    const unsigned rv[8] = {r0.x, r0.y, r0.z, r0.w, r1.x, r1.y, r1.z, r1.w}, wq[8] = {w0.x, w0.y, w0.z, w0.w, w1.x, w1.y, w1.z, w1.w};
#pragma unroll
                    for (int q = 0; q < 8; ++q) { xin[j][2 * q] = bflo(rv[q]); xin[j][2 * q + 1] = bfhi(rv[q]); wv_[j][2 * q] = bflo(wq[q]); wv_[j][2 * q + 1] = bfhi(wq[q]); } }
#pragma unroll
                for (int jj = 0; jj < 16; ++jj) {
                    float a = 0.f;
#pragma unroll
                    for (int j = 0; j < 4; ++j) a += wv_[j][jj] * xin[j][jj];
                    a = siluf_(a); y[jj] = a; ss += a * a;
                }
            }
            float sc = 1.f;
            if (ten < 2) { ss += __shfl_xor(ss, 1); ss += __shfl_xor(ss, 2); ss += __shfl_xor(ss, 4); sc = rsqrtf(ss + EPS); if (ten == 0) sc *= 0.08838834764831845f; }
            LAS bf16* dstp = (LAS bf16*)(F.lds + (ten == 0 ? GD_Q : (ten == 1 ? GD_K : GD_V))) + t * 136 + 16 * ds;
            v4u o0, o1;
            o0.x = pk2(y[0] * sc, y[1] * sc); o0.y = pk2(y[2] * sc, y[3] * sc); o0.z = pk2(y[4] * sc, y[5] * sc); o0.w = pk2(y[6] * sc, y[7] * sc);
            o1.x = pk2(y[8] * sc, y[9] * sc); o1.y = pk2(y[10] * sc, y[11] * sc); o1.z = pk2(y[12] * sc, y[13] * sc); o1.w = pk2(y[14] * sc, y[15] * sc);
            *(LAS v4u*)dstp = o0; *(LAS v4u*)(dstp + 8) = o1;
        }
        lds_barrier();
        const LAS bf16* qs = (const LAS bf16*)(F.lds + GD_Q); const LAS bf16* ks = (const LAS bf16*)(F.lds + GD_K); const LAS bf16* vs = (const LAS bf16*)(F.lds + GD_V);
        GP_T(20);
        {
            const int mat = w >> 2, rt = w & 3;
            const LAS bf16* As = mat ? qs : ks;
            LAS float* Out = (LAS float*)(F.lds + (mat ? GD_QK : GD_KK));
            bf16x8 af[4];
#pragma unroll
            for (int s = 0; s < 4; ++s) af[s] = *(const LAS bf16x8*)(As + (16 * rt + r16) * 136 + 32 * s + 8 * quad);
#pragma unroll
            for (int ct = 0; ct < 4; ++ct) {
                f32x4 acc = (f32x4){0.f, 0.f, 0.f, 0.f};
#pragma unroll
                for (int s = 0; s < 4; ++s) { const bf16x8 bfr = *(const LAS bf16x8*)(ks + (16 * ct + r16) * 136 + 32 * s + 8 * quad);
                    acc = __builtin_amdgcn_mfma_f32_16x16x32_bf16(af[s], bfr, acc, 0, 0, 0); }
#pragma unroll
                for (int j = 0; j < 4; ++j) Out[(16 * rt + 4 * quad + j) * 65 + 16 * ct + r16] = acc[j];
            }
        }
        GP_T(21);
        int tid2 = F.tid; asm volatile("" : "+v"(tid2));
        const int dir = tid2 >> 8, dt = tid2 & 255;
        LAS float* sm = (LAS float*)(F.lds + GD_SM) + dir * 256;
        if (dt < 64) {
            const int ti = dir ? 63 - dt : dt; const size_t row = (size_t)64 * g + ti;
            const float ga = WSP(float, WS_CAB)[row * 16 + dir * 4 + h], gb = WSP(float, WS_CAB)[row * 16 + 8 + dir * 4 + h];
            const float gv = -__expf(F.in[I_CALOG][(l * 2 + dir) * 4 + h]) * softplusf_(ga + F.in[I_CDTB][(l * 2 + dir) * 4 + h]);
            float v = gv;
#pragma unroll
            for (int off = 1; off < 64; off <<= 1) { const float u = __builtin_bit_cast(float, __builtin_amdgcn_ds_bpermute(((lane - off) & 63) << 2, __builtin_bit_cast(int, v))); if (lane >= off) v += u; }
            sm[dt] = gv; sm[64 + dt] = sigmoidf_(gb); sm[128 + dt] = v; sm[192 + dt] = __expf(v);
        }
        lds_barrier();
        size_t cd;
        { int bq, cq_, stp; if (g < 256) { bq = g >> 6; cq_ = g & 63; stp = 4 + (dir ? 63 - cq_ : cq_); } else { bq = (g - 256) >> 2; cq_ = (g - 256) & 3; stp = dir ? 3 - cq_ : cq_; }
          cd = ((size_t)((bq * 4 + h) * 2 + dir)) * 68 + stp; }
        const LAS float* KK = (const LAS float*)(F.lds + GD_KK); const LAS float* QKm = (const LAS float*)(F.lds + GD_QK);
        LAS float* Ls = (LAS float*)(F.lds + GD_L) + dir * 4096;
        {
            bf16* gqk = WSP(bf16, WS_GQK) + cd * 4096;
            for (int idx = dt; idx < 4096; idx += 256) { const int i = idx >> 6, j = idx & 63; const int ti = dir ? 63 - i : i, tj = dir ? 63 - j : j;
                const float dec = j <= i ? __expf(sm[128 + i] - sm[128 + j]) : 0.f;
                Ls[idx] = j < i ? sm[64 + i] * KK[ti * 65 + tj] * dec : 0.f;
                gqk[idx] = (bf16)f2bf(QKm[ti * 65 + tj] * dec); }
        }
        lds_barrier();
        GP_T(22);
        if (F.tid < 256) {
            f32x2_t X[64];
            int ct_ = F.tid; asm volatile("" : "+v"(ct_));
            const int sdir = ct_ >> 7, cp = ct_ & 127;
            const LAS float* sms = (const LAS float*)(F.lds + GD_SM) + sdir * 256;
            const LAS float* Lss = (const LAS float*)(F.lds + GD_L) + sdir * 4096;
            size_t cds;
            { int bq, cq_, stp; if (g < 256) { bq = g >> 6; cq_ = g & 63; stp = 4 + (sdir ? 63 - cq_ : cq_); } else { bq = (g - 256) >> 2; cq_ = (g - 256) & 3; stp = sdir ? 3 - cq_ : cq_; }
              cds = ((size_t)((bq * 4 + h) * 2 + sdir)) * 68 + stp; }
            bf16* outp = WSP(bf16, WS_GW) + cds * 8192 + cp;
#pragma unroll
            for (int i = 0; i < 64; ++i) {
                const int ti = sdir ? 63 - i : i;
                const float be = sms[64 + i];
                f32x2_t a = {be * bf2f(vs[ti * 136 + cp]), be * sms[192 + i] * bf2f(ks[ti * 136 + cp])};
                f32x2_t p0 = {0.f, 0.f}, p1 = p0, p2 = p0, p3 = p0;
#pragma unroll
                for (int j = 0; j < i; ++j) { const float lv = Lss[i * 64 + j]; if ((j & 3) == 0) p0 += X[j] * lv; else if ((j & 3) == 1) p1 += X[j] * lv; else if ((j & 3) == 2) p2 += X[j] * lv; else p3 += X[j] * lv; }
                a -= (p0 + p1) + (p2 + p3);
                X[i] = a;
                outp[i * 128] = (bf16)f2bf(a.y);
                asm volatile("" ::: "memory");
            }
            v4u* up = (v4u*)(WSP(bf16, WS_GU) + cds * 8192 + (size_t)cp * 64);
#pragma unroll
            for (int q8 = 0; q8 < 8; ++q8) { v4u o; o.x = pk2(X[8 * q8].x, X[8 * q8 + 1].x); o.y = pk2(X[8 * q8 + 2].x, X[8 * q8 + 3].x); o.z = pk2(X[8 * q8 + 4].x, X[8 * q8 + 5].x); o.w = pk2(X[8 * q8 + 6].x, X[8 * q8 + 7].x); up[q8] = o; }
        }
        GP_T(23);
        {
            bf16* gqg = WSP(bf16, WS_GQG) + cd * 8192; bf16* gkd = WSP(bf16, WS_GKD) + cd * 8192;
            const float gl = sm[128 + 63];
            for (int idx = dt; idx < 8192; idx += 256) { const int i = idx >> 7, d = idx & 127; const int ti = dir ? 63 - i : i;
                gqg[idx] = (bf16)f2bf(bf2f(qs[ti * 136 + d]) * sm[192 + i]); }
            { const int i = dt & 63; const int ti = dir ? 63 - i : i; const float fk = __expf(gl - sm[128 + i]);
              for (int idx = dt; idx < 8192; idx += 256) { const int d = idx >> 6; gkd[idx] = (bf16)f2bf(bf2f(ks[ti * 136 + d]) * fk); } }
            if (dt == 0) WSP(float, WS_GGL)[cd] = __expf(gl);
        }
        GP_T(24);
    }
    __syncthreads();
}

constexpr int GS_ST = 0, GS_VN = 4352, GS_O = 8192;
struct GdnOps { bf16x8 a[4]; bf16x8 qk[2]; bf16x8 kd[2]; v2u uv; float gl; };
__device__ __forceinline__ bf16x8 ld16_asm(const void* p) { bf16x8 v; asm volatile("global_load_dwordx4 %0, %1, off" : "=v"(v) : "v"(p) : "memory"); return v; }
__device__ __forceinline__ v2u ld8_asm(const void* p) { v2u v; asm volatile("global_load_dwordx2 %0, %1, off" : "=v"(v) : "v"(p) : "memory"); return v; }
__device__ __forceinline__ float ld4_asm(const void* p) { float v; asm volatile("global_load_dword %0, %1, off" : "=v"(v) : "v"(p) : "memory"); return v; }
__device__ __forceinline__ void gdn_load_asm(Frame& F, GdnOps& o, size_t cd, int sl) {
    const int lane = F.lane, w = F.wave, r16 = lane & 15, quad = lane >> 4, rt = w & 3;
    const bf16* ap = (w < 4 ? WSP(bf16, WS_GW) : WSP(bf16, WS_GQG)) + cd * 8192 + (size_t)(16 * rt + r16) * 128 + 8 * quad;
#pragma unroll
    for (int s = 0; s < 4; ++s) o.a[s] = ld16_asm(ap + 32 * s);
    const bf16* kp = WSP(bf16, WS_GKD) + cd * 8192 + (size_t)(16 * w + r16) * 64 + 8 * quad;
    o.kd[0] = ld16_asm(kp); o.kd[1] = ld16_asm(kp + 32);
    const bf16* qp = WSP(bf16, WS_GQK) + cd * 4096 + (size_t)(16 * rt + r16) * 64 + 8 * quad;
    o.qk[0] = ld16_asm(qp); o.qk[1] = ld16_asm(qp + 32);
    o.uv = ld8_asm(WSP(bf16, WS_GU) + cd * 8192 + (size_t)(16 * sl + r16) * 64 + 16 * rt + 4 * quad);
    o.gl = ld4_asm(WSP(float, WS_GGL) + cd);
}
__device__ __forceinline__ void gdn_load(Frame& F, GdnOps& o, size_t cd, int sl) {
    const int lane = F.lane, w = F.wave, r16 = lane & 15, quad = lane >> 4, rt = w & 3;
    const bf16* ap = (w < 4 ? WSP(bf16, WS_GW) : WSP(bf16, WS_GQG)) + cd * 8192 + (size_t)(16 * rt + r16) * 128 + 8 * quad;
#pragma unroll
    for (int s = 0; s < 4; ++s) o.a[s] = *(const bf16x8*)(ap + 32 * s);
    const bf16* kp = WSP(bf16, WS_GKD) + cd * 8192 + (size_t)(16 * w + r16) * 64 + 8 * quad;
    o.kd[0] = *(const bf16x8*)kp; o.kd[1] = *(const bf16x8*)(kp + 32);
    { const bf16* qp = WSP(bf16, WS_GQK) + cd * 4096 + (size_t)(16 * rt + r16) * 64 + 8 * quad; o.qk[0] = *(const bf16x8*)qp; o.qk[1] = *(const bf16x8*)(qp + 32); }
    o.uv = *(const v2u*)(WSP(bf16, WS_GU) + cd * 8192 + (size_t)(16 * sl + r16) * 64 + 16 * rt + 4 * quad);
    o.gl = WSP(float, WS_GGL)[cd];
}
__device__ __forceinline__ size_t gdn_cd(int b, int h, int dir, int s) { return ((size_t)((b * 4 + h) * 2 + dir)) * 68 + s; }
__device__ __forceinline__ int gdn_g(int b, int dir, int s) {
    return s < 4 ? 256 + 4 * b + (dir ? 3 - s : s) : 64 * b + (dir ? 63 - (s - 4) : (s - 4)); }
__device__ __forceinline__ void gdn_scan(Frame& F, int chain) {
    REFRESH_TID(F);
    const int xq = chain & 7, yq = chain >> 3, cg = (yq >> 3) * 8 + xq, sl = yq & 7;
    const int dir = cg & 1, h = (cg >> 1) & 3, b = cg >> 3;
    const int lane = F.lane, w = F.wave, r16 = lane & 15, quad = lane >> 4, rt = w & 3;
    LAS bf16* St = (LAS bf16*)(F.lds + GS_ST); LAS bf16* VNt = (LAS bf16*)(F.lds + GS_VN);
    __syncthreads();
    for (int i = F.tid; i < (GS_VN + 2304) / 4; i += NT) ((LAS unsigned*)F.lds)[i] = 0u;
    __syncthreads();
    f32x4 sacc = (f32x4){0.f, 0.f, 0.f, 0.f};
    float* GO = WSP(float, WS_GO) + (size_t)dir * MROWS * 512;
    LAS float* Ost = (LAS float*)(F.lds + GS_O);
#define GDN_STEP(cur, s_) do { \
          \
        asm volatile("s_waitcnt vmcnt(30)" : "+v"(cur.a[0]), "+v"(cur.a[1]), "+v"(cur.a[2]), "+v"(cur.a[3]), "+v"(cur.kd[0]), "+v"(cur.kd[1]), "+v"(cur.qk[0]), "+v"(cur.qk[1]), "+v"(cur.uv), "+v"(cur.gl) :: "memory"); \
        bf16x8 sbf[4]; \
        _Pragma("unroll") for (int ks = 0; ks < 4; ++ks) sbf[ks] = *(const LAS bf16x8*)(St + r16 * 136 + 32 * ks + 8 * quad); \
        f32x4 acc = (f32x4){0.f, 0.f, 0.f, 0.f}; \
        _Pragma("unroll") for (int ks = 0; ks < 4; ++ks) acc = __builtin_amdgcn_mfma_f32_16x16x32_bf16(cur.a[ks], sbf[ks], acc, 0, 0, 0); \
        if (w < 4) { v2u o; o.x = pk2(bflo(cur.uv.x) - acc[0], bfhi(cur.uv.x) - acc[1]); o.y = pk2(bflo(cur.uv.y) - acc[2], bfhi(cur.uv.y) - acc[3]); \
            *(LAS v2u*)(VNt + r16 * 72 + 16 * rt + 4 * quad) = o; } \
        lds_barrier(); \
        const bf16x8 vb0 = *(const LAS bf16x8*)(VNt + r16 * 72 + 8 * quad), vb1 = *(const LAS bf16x8*)(VNt + r16 * 72 + 32 + 8 * quad); \
        if (w >= 4) { \
            acc = __builtin_amdgcn_mfma_f32_16x16x32_bf16(cur.qk[0], vb0, acc, 0, 0, 0); \
            acc = __builtin_amdgcn_mfma_f32_16x16x32_bf16(cur.qk[1], vb1, acc, 0, 0, 0); \
            _Pragma("unroll") for (int j = 0; j < 4; ++j) Ost[(((s_) & 3) * 64 + 16 * rt + 4 * quad + j) * 16 + r16] = acc[j]; } \
        sacc = sacc * cur.gl; \
        sacc = __builtin_amdgcn_mfma_f32_16x16x32_bf16(cur.kd[0], vb0, sacc, 0, 0, 0); \
        sacc = __builtin_amdgcn_mfma_f32_16x16x32_bf16(cur.kd[1], vb1, sacc, 0, 0, 0); \
        { v2u o; o.x = pk2(sacc[0], sacc[1]); o.y = pk2(sacc[2], sacc[3]); *(LAS v2u*)(St + r16 * 136 + 16 * w + 4 * quad) = o; } \
        lds_barrier(); \
    } while (0)
    GdnOps r0, r1, r2, r3;
    gdn_load_asm(F, r0, gdn_cd(b, h, dir, 0), sl); gdn_load_asm(F, r1, gdn_cd(b, h, dir, 1), sl); gdn_load_asm(F, r2, gdn_cd(b, h, dir, 2), sl); gdn_load_asm(F, r3, gdn_cd(b, h, dir, 3), sl);
#pragma unroll 1
    for (int s = 0; s < 68; s += 4) {
        GDN_STEP(r0, s);     gdn_load_asm(F, r0, gdn_cd(b, h, dir, (s + 4 < 68 ? s + 4 : 67)), sl);
        GDN_STEP(r1, s + 1); gdn_load_asm(F, r1, gdn_cd(b, h, dir, (s + 5 < 68 ? s + 5 : 67)), sl);
        GDN_STEP(r2, s + 2); gdn_load_asm(F, r2, gdn_cd(b, h, dir, (s + 6 < 68 ? s + 6 : 67)), sl);
        GDN_STEP(r3, s + 3);
#pragma unroll
        for (int k2 = 0; k2 < 2; ++k2) { const int idx = F.tid + 512 * k2, st = idx >> 8, i = (idx >> 2) & 63, qd = idx & 3;
            const f32x4 v = *(const LAS f32x4*)(Ost + (st * 64 + i) * 16 + 4 * qd);
            const int g = gdn_g(b, dir, s + st), ti = dir ? 63 - i : i;
            *(f32x4*)(GO + ((size_t)64 * g + ti) * 512 + h * 128 + 16 * sl + 4 * qd) = v; }
        gdn_load_asm(F, r3, gdn_cd(b, h, dir, (s + 7 < 68 ? s + 7 : 67)), sl);
    }
#undef GDN_STEP
    asm volatile("s_waitcnt vmcnt(0)" ::: "memory");
    __syncthreads();
}
template <int NCT> struct GdnOpsW { bf16x8 a[4]; bf16x8 qk[2]; bf16x8 kd[2]; v2u uv[NCT]; float gl; };
template <int NCT>
__device__ __forceinline__ void gdn_load_wide(Frame& F, GdnOpsW<NCT>& o, size_t cd, int part) {
    const int lane = F.lane, w = F.wave, r16 = lane & 15, quad = lane >> 4, rt = w & 3;
    const bf16* ap = (w < 4 ? WSP(bf16, WS_GW) : WSP(bf16, WS_GQG)) + cd * 8192 + (size_t)(16 * rt + r16) * 128 + 8 * quad;
#pragma unroll
    for (int s = 0; s < 4; ++s) o.a[s] = *(const bf16x8*)(ap + 32 * s);
    const bf16* kp = WSP(bf16, WS_GKD) + cd * 8192 + (size_t)(16 * w + r16) * 64 + 8 * quad;
    o.kd[0] = *(const bf16x8*)kp; o.kd[1] = *(const bf16x8*)(kp + 32);
    { const bf16* qp = WSP(bf16, WS_GQK) + cd * 4096 + (size_t)(16 * rt + r16) * 64 + 8 * quad; o.qk[0] = *(const bf16x8*)qp; o.qk[1] = *(const bf16x8*)(qp + 32); }
    const bf16* up = WSP(bf16, WS_GU) + cd * 8192 + (size_t)(part * NCT * 16 + r16) * 64 + 16 * rt + 4 * quad;
#pragma unroll
    for (int ct = 0; ct < NCT; ++ct) o.uv[ct] = *(const v2u*)(up + (size_t)ct * 16 * 64);
    o.gl = WSP(float, WS_GGL)[cd];
}
template <int NCT>
__device__ __forceinline__ void gdn_scan_wide(Frame& F, int cg, int part) {
    REFRESH_TID(F);
    constexpr int NC = NCT * 16, OFF_VN = NC * 136 * 2, OFF_O = OFF_VN + NC * 72 * 2;
    const int dir = cg & 1, h = (cg >> 1) & 3, b = cg >> 3;
    const int lane = F.lane, w = F.wave, r16 = lane & 15, quad = lane >> 4, rt = w & 3;
    LAS bf16* St = (LAS bf16*)(F.lds); LAS bf16* VNt = (LAS bf16*)(F.lds + OFF_VN); LAS float* Ost = (LAS float*)(F.lds + OFF_O);
    __syncthreads();
    for (int i = F.tid; i < OFF_O / 4; i += NT) ((LAS unsigned*)F.lds)[i] = 0u;
    __syncthreads();
    f32x4 sacc[NCT];
#pragma unroll
    for (int ct = 0; ct < NCT; ++ct) sacc[ct] = (f32x4){0.f, 0.f, 0.f, 0.f};
    float* GO = WSP(float, WS_GO) + (size_t)dir * MROWS * 512;
#define GDNW_STEP(cur, s_) do { \
        f32x4 acc[NCT]; \
        _Pragma("unroll") for (int ct = 0; ct < NCT; ++ct) { acc[ct] = (f32x4){0.f, 0.f, 0.f, 0.f}; \
            _Pragma("unroll") for (int ks = 0; ks < 4; ++ks) { const bf16x8 sb = *(const LAS bf16x8*)(St + (16 * ct + r16) * 136 + 32 * ks + 8 * quad); \
                acc[ct] = __builtin_amdgcn_mfma_f32_16x16x32_bf16(cur.a[ks], sb, acc[ct], 0, 0, 0); } } \
        if (w < 4) { _Pragma("unroll") for (int ct = 0; ct < NCT; ++ct) { v2u o; o.x = pk2(bflo(cur.uv[ct].x) - acc[ct][0], bfhi(cur.uv[ct].x) - acc[ct][1]); o.y = pk2(bflo(cur.uv[ct].y) - acc[ct][2], bfhi(cur.uv[ct].y) - acc[ct][3]); \
            *(LAS v2u*)(VNt + (16 * ct + r16) * 72 + 16 * rt + 4 * quad) = o; } } \
        lds_barrier(); \
        _Pragma("unroll") for (int ct = 0; ct < NCT; ++ct) { \
            const bf16x8 vb0 = *(const LAS bf16x8*)(VNt + (16 * ct + r16) * 72 + 8 * quad), vb1 = *(const LAS bf16x8*)(VNt + (16 * ct + r16) * 72 + 32 + 8 * quad); \
            if (w >= 4) { acc[ct] = __builtin_amdgcn_mfma_f32_16x16x32_bf16(cur.qk[0], vb0, acc[ct], 0, 0, 0); acc[ct] = __builtin_amdgcn_mfma_f32_16x16x32_bf16(cur.qk[1], vb1, acc[ct], 0, 0, 0); \
                _Pragma("unroll") for (int j = 0; j < 4; ++j) Ost[(16 * rt + 4 * quad + j) * NC + 16 * ct + r16] = acc[ct][j]; } \
            sacc[ct] = sacc[ct] * cur.gl; \
            sacc[ct] = __builtin_amdgcn_mfma_f32_16x16x32_bf16(cur.kd[0], vb0, sacc[ct], 0, 0, 0); \
            sacc[ct] = __builtin_amdgcn_mfma_f32_16x16x32_bf16(cur.kd[1], vb1, sacc[ct], 0, 0, 0); \
            { v2u o; o.x = pk2(sacc[ct][0], sacc[ct][1]); o.y = pk2(sacc[ct][2], sacc[ct][3]); *(LAS v2u*)(St + (16 * ct + r16) * 136 + 16 * w + 4 * quad) = o; } } \
        lds_barrier(); \
        { const int g = gdn_g(b, dir, (s_)); constexpr int TPR = NC / 16 ;   \
            for (int idx = F.tid; idx < 64 * TPR; idx += NT) { const int i = idx / TPR, c16 = (idx % TPR) * 16, ti = dir ? 63 - i : i; \
                float* gp = GO + ((size_t)64 * g + ti) * 512 + h * 128 + part * NC + c16; \
                _Pragma("unroll") for (int k4 = 0; k4 < 4; ++k4) *(f32x4*)(gp + 4 * k4) = *(const LAS f32x4*)(Ost + i * NC + c16 + 4 * k4); } } \
    } while (0)
    GdnOpsW<NCT> r0, r1;
    gdn_load_wide<NCT>(F, r0, gdn_cd(b, h, dir, 0), part); gdn_load_wide<NCT>(F, r1, gdn_cd(b, h, dir, 1), part);
#pragma unroll 1
    for (int s = 0; s < 68; s += 2) {
        GDNW_STEP(r0, s);     gdn_load_wide<NCT>(F, r0, gdn_cd(b, h, dir, (s + 2 < 68 ? s + 2 : 67)), part);
        GDNW_STEP(r1, s + 1); gdn_load_wide<NCT>(F, r1, gdn_cd(b, h, dir, (s + 3 < 68 ? s + 3 : 67)), part);
    }
#undef GDNW_STEP
    __syncthreads();
}
__device__ __forceinline__ void gdn_out(Frame& F, int l) {
    REFRESH_TID(F);
    const int gw = F.bid * NWAVES + F.wave, NGW = F.G * NWAVES, lane = F.lane;
    const float* G0 = WSP(float, WS_GO); const float* G1 = G0 + (size_t)MROWS * 512;
    const bf16* U = WSP(bf16, WS_U); bf16* YC = WSP(bf16, WS_Y) + (size_t)2 * MROWS * 512;
    const float g0 = F.in[I_CGOUT][l * 128 + 2 * lane], g1 = F.in[I_CGOUT][l * 128 + 2 * lane + 1];
    int rlo, rhi;
    const int nrows = l == DEPTH - 1 ? TLAT : MROWS;
    if (F.G == 256 && l < DEPTH - 1) { if (F.bid < 64) { rlo = 38 * F.bid; rhi = rlo + 38; } else { rlo = 2432 + 78 * (F.bid - 64); rhi = rlo + 78; } }
    else { const int per = (nrows + F.G - 1) / F.G; rlo = per * F.bid; rhi = rlo + per < nrows ? rlo + per : nrows; if (rlo > nrows) rlo = nrows; }
    for (int r0 = rlo + F.wave; r0 < rhi; r0 += 2 * NWAVES) {
        const int r1 = r0 + NWAVES < rhi ? r0 + NWAVES : r0;
        f32x2_t a[2][4], c[2][4]; unsigned zz[2][4];
#pragma unroll
        for (int k = 0; k < 2; ++k) { const int r = k ? r1 : r0;
#pragma unroll
            for (int h = 0; h < 4; ++h) { const size_t o = (size_t)r * 512 + h * 128 + 2 * lane;
                a[k][h] = *(const f32x2_t*)(G0 + o); c[k][h] = *(const f32x2_t*)(G1 + o); zz[k][h] = *(const unsigned*)(U + (size_t)r * UW + UCZ + h * 128 + 2 * lane); } }
#pragma unroll
        for (int k = 0; k < 2; ++k) { const int r = k ? r1 : r0; if (k == 1 && r1 == r0) break;
#pragma unroll
            for (int h = 0; h < 4; ++h) { const float a0 = a[k][h].x + c[k][h].x, a1 = a[k][h].y + c[k][h].y;
                const float ss = wave_sum(a0 * a0 + a1 * a1);
                const float rs = rsqrtf(ss * (1.f / 128.f) + EPS);
                *(unsigned*)(YC + (size_t)r * 512 + h * 128 + 2 * lane) = pk2(a0 * rs * g0 * siluf_(bflo(zz[k][h])), a1 * rs * g1 * siluf_(bfhi(zz[k][h]))); } }
    }
}


struct SideFr { bf16x8 a[4], b0[4], b1[4]; };
__device__ __forceinline__ void side_ld(SideFr& f, const bf16* ap, const bf16* bp0, const bf16* bp1) {
#pragma unroll
    for (int s = 0; s < 4; ++s) { f.a[s] = *(const bf16x8*)(ap + 32 * s); f.b0[s] = *(const bf16x8*)(bp0 + 32 * s); f.b1[s] = *(const bf16x8*)(bp1 + 32 * s); }
}
__device__ __forceinline__ void side_mma(f32x4& c0, f32x4& c1, const SideFr& f) {
#pragma unroll
    for (int s = 0; s < 4; ++s) { c0 = __builtin_amdgcn_mfma_f32_16x16x32_bf16(f.a[s], f.b0[s], c0, 0, 0, 0); c1 = __builtin_amdgcn_mfma_f32_16x16x32_bf16(f.a[s], f.b1[s], c1, 0, 0, 0); }
}
__device__ __forceinline__ void side_merge(Frame& F, int l) {
    REFRESH_TID(F);
    const int lane = F.lane, w = F.wave, r16 = lane & 15, quad = lane >> 4, rt = w & 3, chf = w >> 2;
    const bf16* U = WSP(bf16, WS_U);
    for (int tile = F.bid; tile < 256; tile += F.G) {
        const int row0 = TLAT + 64 * (tile >> 4) + 16 * rt, col0 = 64 * (tile & 15) + 32 * chf;
        f32x4 m0 = (f32x4){0.f, 0.f, 0.f, 0.f}, m1 = m0;
#define SM_AP(q) (WSP(bf16, WS_Y) + ((size_t)((q) >> 2) * MROWS + row0 + r16) * 512 + 8 * quad + 128 * ((q) & 3))
#define SM_BP(q) (WSP(bf16, WS_WBR) + (((size_t)l * 4 + ((q) >> 2)) * 1024 + col0 + r16) * 512 + 8 * quad + 128 * ((q) & 3))
        SideFr fa, fb;
        side_ld(fa, SM_AP(0), SM_BP(0), SM_BP(0) + (size_t)16 * 512);
#pragma unroll 1
        for (int br = 0; br < 4; ++br) {
            f32x4 c0 = (f32x4){0.f, 0.f, 0.f, 0.f}, c1 = c0;
            const int q = br * 4;
            unsigned short gr0[4], gr1[4];
#pragma unroll
            for (int j = 0; j < 4; ++j) { const bf16* gp = U + (size_t)(row0 + 4 * quad + j) * UW + UG + br * 1024 + col0 + r16; gr0[j] = gp[0]; gr1[j] = gp[16]; }
            side_ld(fb, SM_AP(q + 1), SM_BP(q + 1), SM_BP(q + 1) + (size_t)16 * 512); side_mma(c0, c1, fa);
            side_ld(fa, SM_AP(q + 2), SM_BP(q + 2), SM_BP(q + 2) + (size_t)16 * 512); side_mma(c0, c1, fb);
            side_ld(fb, SM_AP(q + 3), SM_BP(q + 3), SM_BP(q + 3) + (size_t)16 * 512); side_mma(c0, c1, fa);
            { const int qn = q + 4 < 16 ? q + 4 : 15; side_ld(fa, SM_AP(qn), SM_BP(qn), SM_BP(qn) + (size_t)16 * 512); }
            side_mma(c0, c1, fb);
#pragma unroll
            for (int j = 0; j < 4; ++j) { m0[j] += sigmoidf_(bf2f(gr0[j])) * c0[j]; m1[j] += sigmoidf_(bf2f(gr1[j])) * c1[j]; }
        }
#undef SM_AP
#undef SM_BP
#pragma unroll
        for (int j = 0; j < 4; ++j) { bf16* mp = WSP(bf16, WS_MB) + (size_t)(row0 + 4 * quad + j) * 1024 + col0 + r16;
            mp[0] = (bf16)f2bf(m0[j]); mp[16] = (bf16)f2bf(m1[j]); }
    }
}
__device__ __forceinline__ void side_outproj(Frame& F, int l) {
    REFRESH_TID(F);
    const int lane = F.lane, w = F.wave, r16 = lane & 15, quad = lane >> 4, rt = w & 3, chf = w >> 2;
    const float* gt = WSP(float, WS_MOD) + ((size_t)l * 5 + 4) * 6144 + 2048;
    for (int tile = F.bid; tile < 256; tile += F.G) {
        const int row0 = TLAT + 64 * (tile >> 4) + 16 * rt, col0 = 64 * (tile & 15) + 32 * chf;
        const bf16* ap = WSP(bf16, WS_MB) + (size_t)(row0 + r16) * 1024 + 8 * quad;
        const bf16* bp0 = WSP(bf16, WS_WOUT) + ((size_t)l * 1024 + col0 + r16) * 1024 + 8 * quad;
        const bf16* bp1 = bp0 + (size_t)16 * 1024;
        f32x4 c0 = (f32x4){0.f, 0.f, 0.f, 0.f}, c1 = c0;
        SideFr fa, fb;
        side_ld(fa, ap, bp0, bp1);
#pragma unroll 1
        for (int kc = 0; kc < 8; kc += 2) {
            side_ld(fb, ap + 128 * (kc + 1), bp0 + 128 * (kc + 1), bp1 + 128 * (kc + 1)); side_mma(c0, c1, fa);
            { const int kn = kc + 2 < 8 ? kc + 2 : 7; side_ld(fa, ap + 128 * kn, bp0 + 128 * kn, bp1 + 128 * kn); }
            side_mma(c0, c1, fb);
        }
        const float g0 = gt[col0 + r16], g1 = gt[col0 + 16 + r16];
#pragma unroll
        for (int j = 0; j < 4; ++j) { float* xp = WSP(float, WS_X) + (size_t)(row0 + 4 * quad + j) * 1024 + col0 + r16;
            xp[0] += g0 * c0[j]; xp[16] += g1 * c1[j]; }
    }
}

#ifndef SCAN_PARTS
#define SCAN_PARTS 2
#endif
constexpr int NSCAN = 4 * SCAN_PARTS;
constexpr int CW_Q = 2048;
__device__ __forceinline__ void mixer_queue_phase(Frame& F, int l) {
    volatile LAS int* qslot = (volatile LAS int*)(F.lds + MISC_OFF + 64);
    const int x0 = (int)(xb_xcc_id() & 7u);
#if defined(PROBE_SUB) && (PROBE_SUB == 4 || PROBE_SUB == 5)
    const unsigned long long tq0 = __builtin_amdgcn_s_memrealtime();
#endif
#pragma unroll 1
    for (int kq = 0; kq < 8; ++kq) {
      const int x = (x0 + kq) & 7;
      for (;;) {
        __syncthreads();
        if (F.tid == 0) *qslot = (int)__hip_atomic_fetch_add(F.ctl + CW_Q + l * 8 + x, 1u, __ATOMIC_RELAXED, __HIP_MEMORY_SCOPE_AGENT);
        __syncthreads();
        const int idx = __builtin_amdgcn_readfirstlane(*qslot);
        if (idx >= (l == DEPTH - 1 ? 128 : 136) + NSCAN) break;
#ifdef PROBE_SUB
        unsigned long long t0_ = 0ull; const bool pr_on = false;
#endif
        if (idx < NSCAN) { gdn_scan_wide<8 / SCAN_PARTS>(F, x + 8 * (idx / SCAN_PARTS), idx % SCAN_PARTS); }
        else { AttnUnit un; const int q = idx - NSCAN;
            if (q < 64) { un.kind = 0; un.b = x >> 1; un.hx = x & 1; un.qx = q; }
            else if (q < 128) { const int qq = q - 64, combo = x + 8 * (qq >> 4); un.kind = 1; un.b = combo >> 3; un.hx = combo & 7; un.qx = qq & 15; }
            else { const int qq = q - 128;
                if (qq < 4) { un.kind = 2; un.b = x >> 1; un.hx = x & 1; un.qx = qq; }
                else { const int combo = x + 8 * (qq - 4); un.kind = 3; un.b = combo >> 3; un.hx = combo & 7; un.qx = 0; } }
            attn_unit(F, l, un); }
#ifdef PROBE_SUB
        if (pr_on) F.pr += __builtin_amdgcn_s_memrealtime() - t0_;
        if (PROBE_SUB == 13 && F.bid == 8 && idx >= 4 && idx < 68) F.pr += 100;
        if (PROBE_SUB == 14 && F.bid == 8 && idx >= 68 && idx < 140) F.pr += 100;
#endif
      }
    }
#if defined(PROBE_SUB) && PROBE_SUB == 4
    if (F.tid == 0) __hip_atomic_fetch_max(F.ctl + 3000 + l, (unsigned)(__builtin_amdgcn_s_memrealtime() - tq0), __ATOMIC_RELAXED, __HIP_MEMORY_SCOPE_AGENT);
#endif
#if defined(PROBE_SUB) && PROBE_SUB == 5
    if (F.tid == 0) __hip_atomic_fetch_max(F.ctl + 3000 + l, 0x7fffffffu - (unsigned)(__builtin_amdgcn_s_memrealtime() - tq0), __ATOMIC_RELAXED, __HIP_MEMORY_SCOPE_AGENT);
#endif
}


#ifndef REP_P0
#define REP_P0 1
#endif
#ifndef REP_B
#define REP_B 1
#endif
#ifndef REP_D1
#define REP_D1 1
#endif
#ifndef REP_D2
#define REP_D2 1
#endif
#ifndef REP_E
#define REP_E 1
#endif
#ifndef REP_F
#define REP_F 1
#endif
#ifndef REP_I
#define REP_I 1
#endif
#ifndef REP_J
#define REP_J 1
#endif
#ifndef REP_C1
#define REP_C1 1
#endif
#ifndef REP_C2
#define REP_C2 1
#endif
#ifndef REP_C4
#define REP_C4 1
#endif
#ifndef REP_G2
#define REP_G2 1
#endif

#ifndef MIXER_QUEUE
#define MIXER_QUEUE 1
#endif
constexpr int PH_PER_LAYER = 11, PH_FINAL = 1 + PH_PER_LAYER * DEPTH, N_PHASES = PH_FINAL + 1;
struct Args { const float* in[32]; float* out; unsigned char* ws; int ph_lo, ph_hi, li, pad; };

__global__ void __launch_bounds__(NT, 2) hybrid_fwd(Args args) {
    extern __shared__ __attribute__((aligned(16))) unsigned char lds_raw[];
    Frame F;
    F.lds = (LAS unsigned char*)lds_raw;
    F.wave = __builtin_amdgcn_readfirstlane((int)threadIdx.x >> 6); F.lane = (int)__builtin_amdgcn_mbcnt_hi(~0u, __builtin_amdgcn_mbcnt_lo(~0u, 0u)); F.tid = F.wave * 64 + F.lane;
    F.G = gridDim.x; F.bid = blockIdx.x; F.pr = 0ull;
    F.in = args.in; F.in0 = args.in;
    F.out = args.out; F.ws = args.ws; F.ws0 = args.ws; F.ctl = (unsigned*)(args.ws + WS_CTL);
    volatile LAS unsigned* MISC = (volatile LAS unsigned*)(F.lds + MISC_OFF);
    if (F.tid < 64) MISC[F.tid] = 0u;
    __syncthreads();
    const int lo = args.ph_lo, hi = args.ph_hi;
    XcdBarrier bar = xcd_barrier_post(F.ctl + CW_BAR + args.li * XCD_BAR_WORDS, MISC + 8);
#ifndef ONLY_MASK
#define ONLY_MASK 0xFFFF
#endif
#define PHON(b) ((ONLY_MASK >> (b)) & 1)
#define IN(k) (lo <= (k) && (k) < hi)
#define SEAM(k) do { if ((k) + 1 < hi) xcd_barrier(bar); } while (0)
#ifdef PROBE_PHASE
    unsigned long long pr_acc = 0ull, pr_t0 = 0ull;
#define PR_BEGIN(k) do { if ((k) == PROBE_PHASE) pr_t0 = __builtin_amdgcn_s_memrealtime(); } while (0)
#define PR_END(k) do { if ((k) == PROBE_PHASE) pr_acc += __builtin_amdgcn_s_memrealtime() - pr_t0; } while (0)
#else
#define PR_BEGIN(k) do { } while (0)
#define PR_END(k) do { } while (0)
#endif

    if (PHON(0) && IN(0)) { REFRESH_TID(F); _Pragma("unroll 1") for (int rep_ = 0; rep_ < REP_P0; ++rep_) { p0_prologue(F); __syncthreads(); } SEAM(0); PR_END(0); }
#pragma unroll 1
    for (int l = 0; l < DEPTH; ++l) {
        const int pb = 1 + PH_PER_LAYER * l;
        if (PHON(1) && IN(pb + 0)) { PR_BEGIN(1); REFRESH_TID(F); norm_phase<0>(F, l); SEAM(pb + 0); PR_END(1); }
        if (PHON(2) && IN(pb + 1)) { PR_BEGIN(2); REFRESH_TID(F);
            pg8::Gemm g{WSP(bf16, WS_H), WSP(bf16, WS_WIN) + (size_t)l * UW * D, MROWS, UW, D};
            pg8::StaticOrder S; S.init(MROWS, UW, F.G, F.bid);
            pg8::EpiStoreBf16 E{WSP(bf16, WS_U), UW};
            _Pragma("unroll 1") for (int rep_ = 0; rep_ < REP_B; ++rep_) { pg8::gemm_phase<pg8::EpiStoreBf16, pg8::StaticOrder, true, true>(F.lds, g, S, E, F.wave); __syncthreads(); }
            SEAM(pb + 1); PR_END(2);
        }
        if (PHON(3) && IN(pb + 2)) { PR_BEGIN(3); REFRESH_TID(F);
#ifndef NO_C1
            PR_BEGIN(30); _Pragma("unroll 1") for (int rep_ = 0; rep_ < REP_C1; ++rep_) { gdn_prep(F, l); __syncthreads(); } PR_END(30);
#endif
#ifndef NO_C2
            PR_BEGIN(31); _Pragma("unroll 1") for (int rep_ = 0; rep_ < REP_C2; ++rep_) { lru_pass1(F, l); __syncthreads(); } PR_END(31);
#endif
            __syncthreads();
#ifndef NO_C3
            PR_BEGIN(32); qk_prep(F, l); PR_END(32);
#endif
#ifndef NO_C4
            PR_BEGIN(33); _Pragma("unroll 1") for (int rep_ = 0; rep_ < REP_C4; ++rep_) { v_transpose(F); __syncthreads(); } PR_END(33); PR_BEGIN(34);
#endif
            SEAM(pb + 2); PR_END(34); PR_END(3);
        }
        if (PHON(4) && IN(pb + 3)) { PR_BEGIN(4); REFRESH_TID(F);
#if MIXER_QUEUE
            lru_carry_all(F);
            __syncthreads();
            mixer_queue_phase(F, l);
#else
            PR_BEGIN(20); for (int ch = F.bid; ch < 256; ch += F.G) gdn_scan(F, ch); PR_END(20);
            PR_BEGIN(21); lru_carry_all(F);
            __syncthreads(); PR_END(21);
            PR_BEGIN(22); attn_phase(F, l); PR_END(22);
#endif
            PR_BEGIN(23);
            SEAM(pb + 3); PR_END(23); PR_END(4);
        }
        if (PHON(5) && IN(pb + 4)) { PR_BEGIN(5); REFRESH_TID(F);
            _Pragma("unroll 1") for (int rep_ = 0; rep_ < REP_E; ++rep_) { lru_pass2(F, l); __syncthreads(); }
            __syncthreads();
            gdn_out(F, l);
            SEAM(pb + 4); PR_END(5);
        }
        if (PHON(6) && IN(pb + 5)) { PR_BEGIN(6); REFRESH_TID(F);
            pg8::Gemm g{WSP(bf16, WS_Y), WSP(bf16, WS_WBR) + (size_t)l * 4 * 1024 * 512, 4 * MROWS, 4 * 1024, 512};
            pg8::MergeOrder S{F.G, F.bid, MROWS / 256, TLAT / 256};
            pg8::EpiMerge E{WSP(bf16, WS_U), UW, UG, WSP(bf16, WS_MF), WSP(bf16, WS_MB), MROWS / 256};
            _Pragma("unroll 1") for (int rep_ = 0; rep_ < REP_F; ++rep_) { pg8::gemm_phase<pg8::EpiMerge, pg8::MergeOrder, true, true>(F.lds, g, S, E, F.wave); __syncthreads(); }
            PR_BEGIN(13); if (l < DEPTH - 1) side_merge(F, l); PR_END(13);
            SEAM(pb + 5); PR_END(6);
        }
        if (PHON(7) && IN(pb + 6)) { PR_BEGIN(7); REFRESH_TID(F);
            pg8::Gemm g{WSP(bf16, WS_MB), WSP(bf16, WS_WOUT) + (size_t)l * D * D, MROWS, D, D};
            pg8::StaticOrder S; S.init(TLAT, D, F.G, F.bid);
            pg8::EpiResid E{WSP(float, WS_X), WSP(float, WS_MOD) + (size_t)l * 5 * 6144 + 2048};
            pg8::gemm_phase<pg8::EpiResid, pg8::StaticOrder, true, true>(F.lds, g, S, E, F.wave);
            PR_BEGIN(14); if (l < DEPTH - 1) side_outproj(F, l); PR_END(14);
            SEAM(pb + 6); PR_END(7);
        }
        if (PHON(8) && IN(pb + 7)) { PR_BEGIN(8); REFRESH_TID(F); norm_phase<1>(F, l); SEAM(pb + 7); PR_END(8); }
        if (PHON(9) && IN(pb + 8)) { PR_BEGIN(9); REFRESH_TID(F); _Pragma("unroll 1") for (int rep_ = 0; rep_ < REP_G2; ++rep_) { moe_gather(F, l); __syncthreads(); } SEAM(pb + 8); PR_END(9); }
        if (PHON(10) && IN(pb + 9)) { PR_BEGIN(10); REFRESH_TID(F);
            moe_table(F, l);
            pg8::Gemm g{WSP(bf16, WS_HS), WSP(bf16, WS_WGU) + (size_t)l * NEXP * 2048 * D, MOE_ROWS, NEXP * 2048, D};
            pg8::MoeOrder S{(const LAS int*)(F.lds + MISC_OFF + 256), F.G, F.bid, 8};
            pg8::EpiSwiglu E{WSP(bf16, WS_ACT), F.in[I_BGU] + (size_t)l * NEXP * 2048};
            _Pragma("unroll 1") for (int rep_ = 0; rep_ < REP_I; ++rep_) { pg8::gemm_phase<pg8::EpiSwiglu, pg8::MoeOrder, true, true>(F.lds, g, S, E, F.wave); __syncthreads(); }
            SEAM(pb + 9); PR_END(10);
        }
        if (PHON(11) && IN(pb + 10)) { PR_BEGIN(11); REFRESH_TID(F);
            moe_table(F, l);
            pg8::Gemm g{WSP(bf16, WS_ACT), WSP(bf16, WS_WDN) + (size_t)l * NEXP * D * D, MOE_ROWS, NEXP * D, D};
            pg8::MoeOrder S{(const LAS int*)(F.lds + MISC_OFF + 256), F.G, F.bid, 4};
            pg8::EpiDown E{WSP(bf16, WS_YS), F.in[I_BDN] + (size_t)l * NEXP * D};
            _Pragma("unroll 1") for (int rep_ = 0; rep_ < REP_J; ++rep_) { pg8::gemm_phase<pg8::EpiDown, pg8::MoeOrder, true, true>(F.lds, g, S, E, F.wave); __syncthreads(); }
            SEAM(pb + 10); PR_END(11);
        }
    }
    if (PHON(12) && IN(PH_FINAL)) { PR_BEGIN(12); REFRESH_TID(F); norm_phase<2>(F, 0); PR_END(12); }
#if defined(PROBE_SUB) && (PROBE_SUB == 4 || PROBE_SUB == 5)
    if (blockIdx.x == 0) { unsigned long long tot = 0ull;
        for (int q = 0; q < 4; ++q) { const unsigned v = __hip_atomic_load(F.ctl + 3000 + q, __ATOMIC_RELAXED, __HIP_MEMORY_SCOPE_AGENT); tot += (PROBE_SUB == 4) ? v : (0x7fffffffu - v); }
        F.pr = tot; }
#endif
#ifdef PROBE_SUB
    if (F.pr) { const unsigned long long te = __builtin_amdgcn_s_memrealtime(); while (__builtin_amdgcn_s_memrealtime() - te < PROBE_MULT * F.pr) __builtin_amdgcn_s_sleep(8); }
#endif
#ifdef PROBE_PHASE
    if (blockIdx.x == 0) { const unsigned long long te = __builtin_amdgcn_s_memrealtime(); while (__builtin_amdgcn_s_memrealtime() - te < PROBE_MULT * pr_acc) __builtin_amdgcn_s_sleep(8); }
#endif
#undef IN
#undef SEAM
}

extern "C" void kernel_launch(void* const* d_in, const int* in_sizes, int n_in, void* d_out, int out_size, void* d_ws, size_t ws_size, hipStream_t stream) {
    static int grid = 0;
    if (grid == 0) {
        if (n_in != 32 || out_size != TLAT * D || ws_size < WS_END) { fprintf(stderr, "kernel_launch: unexpected shapes (n_in %d out %d ws %zu need %zu)\n", n_in, out_size, ws_size, (size_t)WS_END); grid = -1; return; }
        int dev = 0, cus = 0, per_cu = 0;
        if (hipGetDevice(&dev) != hipSuccess || hipDeviceGetAttribute(&cus, hipDeviceAttributeMultiprocessorCount, dev) != hipSuccess) { grid = -1; return; }
        if (hipFuncSetAttribute((const void*)hybrid_fwd, hipFuncAttributeMaxDynamicSharedMemorySize, LDS_BYTES) != hipSuccess) { fprintf(stderr, "kernel_launch: hipFuncSetAttribute failed\n"); grid = -1; return; }
        if (hipOccupancyMaxActiveBlocksPerMultiprocessor(&per_cu, (const void*)hybrid_fwd, NT, LDS_BYTES) != hipSuccess || per_cu < 1) fprintf(stderr, "kernel_launch: occupancy query says %d\n", per_cu);
        (void)hipGetLastError();
        grid = cus;
    }
    if (grid < 0) return;
    if (hipMemsetAsync((char*)d_ws + WS_CTL, 0, CTL_BYTES, stream) != hipSuccess) return;
    Args a{};
    for (int i = 0; i < 32; ++i) a.in[i] = (const float*)d_in[i];
    a.out = (float*)d_out; a.ws = (unsigned char*)d_ws;
#if MK_MULTI
    for (int p = 0; p < N_PHASES; ++p) { a.ph_lo = p; a.ph_hi = p + 1; a.li = p;
        hipLaunchKernelGGL(hybrid_fwd, dim3(grid), dim3(NT), LDS_BYTES, stream, a); }
#else
    a.ph_lo = 0; a.ph_hi = N_PHASES; a.li = 0;
    hipLaunchKernelGGL(hybrid_fwd, dim3(grid), dim3(NT), LDS_BYTES, stream, a);
#endif
    const hipError_t le = hipPeekAtLastError();
    if (le != hipSuccess) fprintf(stderr, "kernel_launch: launch failed: %s\n", hipGetErrorName(le));
}
```

```cpp
#include <hip/hip_runtime.h>
#include <cstdio>
#include <cstdint>

#ifndef MK_MULTI
#define MK_MULTI 0
#endif

constexpr int D = 1024, NB = 4, SEQ = 4096, LCTX = 256, DEPTH = 4;
constexpr int TLAT = NB * SEQ, TCTX = NB * LCTX, MROWS = TLAT + TCTX;
constexpr int NCHUNK = MROWS / 64;
constexpr int INW = 9488, UW = 9472;
constexpr int UQ = 0, UK = 512, UV = 640, UBX = 768, UBY = 1280, UCQ = 1792, UCK = 2304, UCV = 2816, UCZ = 3328, UDQ = 3840, UDK = 4352, UDV = 4864, UG = 5376;
constexpr int NEXP = 32, TOPK = 4;
constexpr int KEYS = SEQ + LCTX;
constexpr int MOE_ROWS = MROWS * TOPK + NEXP * 256;
constexpr float EPS = 1e-6f;
constexpr float LOG2E = 1.4426950408889634f;

constexpr size_t al256(size_t x) { return (x + 255) & ~(size_t)255; }
constexpr size_t WS_CTL = 0, CTL_BYTES = 1u << 20;
constexpr size_t WS_MOD  = WS_CTL + CTL_BYTES;
constexpr size_t WS_ROPE = WS_MOD + al256((size_t)DEPTH * 5 * 6144 * 4);
constexpr size_t WS_LRUW = WS_ROPE + al256(2 * 64 * 16 * 4);
constexpr size_t WS_WIN  = WS_LRUW + al256((size_t)DEPTH * 2 * 2 * 8 * 4096 * 2);
constexpr size_t WS_WBR  = WS_WIN + al256((size_t)DEPTH * UW * D * 2);
constexpr size_t WS_WOUT = WS_WBR + al256((size_t)DEPTH * 4 * 1024 * 512 * 2);
constexpr size_t WS_WGU  = WS_WOUT + al256((size_t)DEPTH * D * D * 2);
constexpr size_t WS_WDN  = WS_WGU + al256((size_t)DEPTH * NEXP * 2048 * 1024 * 2);
constexpr size_t WS_X    = WS_WDN + al256((size_t)DEPTH * NEXP * 1024 * 1024 * 2);
constexpr size_t WS_H    = WS_X + al256((size_t)MROWS * D * 4);
constexpr size_t WS_U    = WS_H + al256((size_t)MROWS * D * 2);
constexpr size_t WS_CAB  = WS_U + al256((size_t)MROWS * UW * 2);
constexpr size_t WS_VAT  = WS_CAB + al256((size_t)MROWS * 16 * 4);
constexpr size_t WS_VDT  = WS_VAT + al256((size_t)NB * 2 * 64 * KEYS * 2);
constexpr size_t WS_LRA  = WS_VDT + al256((size_t)NB * 8 * 64 * KEYS * 2);
constexpr size_t WS_LRB  = WS_LRA + al256((size_t)NCHUNK * 2 * 512 * 4);
constexpr size_t WS_LRC  = WS_LRB + al256((size_t)NCHUNK * 2 * 512 * 4);
constexpr int NCD = NCHUNK * 4 * 2;
constexpr size_t WS_GW   = WS_LRC + al256((size_t)NCHUNK * 2 * 512 * 4);
constexpr size_t WS_GU   = WS_GW + al256((size_t)NCD * 64 * 128 * 2);
constexpr size_t WS_GQG  = WS_GU + al256((size_t)NCD * 64 * 128 * 2);
constexpr size_t WS_GKD  = WS_GQG + al256((size_t)NCD * 64 * 128 * 2);
constexpr size_t WS_GQK  = WS_GKD + al256((size_t)NCD * 64 * 128 * 2);
constexpr size_t WS_GGL  = WS_GQK + al256((size_t)NCD * 64 * 64 * 2);
constexpr size_t WS_GO   = WS_GGL + al256((size_t)NCD * 4);
constexpr size_t WS_Y    = WS_GO + al256((size_t)2 * MROWS * 512 * 4);
constexpr size_t WS_MF   = WS_Y + al256((size_t)4 * MROWS * 512 * 2);
constexpr size_t WS_MB   = WS_MF + al256((size_t)MROWS * D * 4);
constexpr size_t WS_SROW = WS_MB + al256((size_t)MROWS * D * 2);
constexpr size_t WS_SW   = WS_SROW + al256((size_t)MROWS * 4 * 4);
constexpr size_t WS_SEP  = WS_SW + al256((size_t)MROWS * 4 * 4);
constexpr size_t WS_LIST = WS_SEP + al256((size_t)MROWS * 4 * 4);
constexpr size_t WS_HS   = WS_LIST + al256((size_t)NEXP * MROWS * 4);
constexpr size_t WS_ACT  = WS_HS + al256((size_t)MOE_ROWS * D * 2);
constexpr size_t WS_YS   = WS_ACT + al256((size_t)MOE_ROWS * D * 2);
constexpr size_t WS_END  = WS_YS + al256((size_t)MOE_ROWS * D * 2);

constexpr int CW_BAR = 4096;
constexpr int CW_CNT = 1024;

constexpr int RING_BYTES = 131072;
constexpr int MISC_OFF = RING_BYTES;
constexpr int LDS_BYTES = 147456;
constexpr int NWAVES = 8, NT = 512;

#define GAS __attribute__((address_space(1)))
#define LAS __attribute__((address_space(3)))
typedef unsigned short bf16;
typedef unsigned v4u __attribute__((ext_vector_type(4)));
typedef unsigned v2u __attribute__((ext_vector_type(2)));
typedef float f32x4 __attribute__((ext_vector_type(4)));
typedef float f32x16 __attribute__((ext_vector_type(16)));
typedef short bf16x8 __attribute__((ext_vector_type(8)));
typedef short bf16x4 __attribute__((ext_vector_type(4)));

typedef float f32x2_t __attribute__((ext_vector_type(2))); typedef __bf16 bf16x2_t __attribute__((ext_vector_type(2)));
__device__ __forceinline__ unsigned pk2(float lo, float hi) { f32x2_t v = {lo, hi}; bf16x2_t b = __builtin_convertvector(v, bf16x2_t); return __builtin_bit_cast(unsigned, b); }
__device__ __forceinline__ unsigned f2bf(float f) { return pk2(f, 0.f) & 0xffffu; }
__device__ __forceinline__ float bf2f(unsigned short b) { return __builtin_bit_cast(float, (unsigned)b << 16); }
__device__ __forceinline__ float bflo(unsigned w) { return __builtin_bit_cast(float, w << 16); }
__device__ __forceinline__ float bfhi(unsigned w) { return __builtin_bit_cast(float, w & 0xffff0000u); }
__device__ __forceinline__ float wave_sum(float v) {
#pragma unroll
    for (int o = 1; o < 64; o <<= 1) v += __shfl_xor(v, o);
    return v;
}
__device__ __forceinline__ float sigmoidf_(float x) { return __builtin_amdgcn_rcpf(1.f + __expf(-x)); }
__device__ __forceinline__ float softplusf_(float x) { return x > 20.f ? x : log1pf(__expf(x)); }
__device__ __forceinline__ float siluf_(float x) { return x * __builtin_amdgcn_rcpf(1.f + __expf(-x)); }
__device__ __forceinline__ void lds_barrier() { asm volatile("s_waitcnt lgkmcnt(0)\n\ts_barrier" ::: "memory"); }
namespace pg8 {
#define PG8_LAS __attribute__((address_space(3)))
typedef unsigned short bf16_t;
typedef short bf16x8 __attribute__((ext_vector_type(8)));
typedef float f32x4 __attribute__((ext_vector_type(4)));
typedef unsigned u32x4 __attribute__((ext_vector_type(4)));
constexpr int BM = 256, BK = 64, HALF = 128, HTB = HALF * BK * 2  , STAGE_BYTES = 8 * HTB, NXCD = 8, WGM = 8;

__host__ __device__ __forceinline__ int lds_byte(int r, int c) { const int st = (r >> 4) * 2 + (c >> 5), rr = r & 15, cc = c & 31, ob = rr * 64 + cc * 2; return st * 1024 + (ob ^ (((ob >> 9) & 1) << 5)); }
__host__ __device__ __forceinline__ void stage_rc(int b, int& R, int& C) { const int st = b / 1024, sb = b % 1024, swz = sb ^ (((sb >> 9) & 1) << 5); R = (st >> 1) * 16 + swz / 64; C = (st & 1) * 32 + (swz % 64) / 2; }
__host__ __device__ __forceinline__ int perm32(int rho) { const int n = rho >> 4, i = rho & 15; return 8 * (i >> 2) + 4 * n + (i & 3); }

struct Unit { int pm, pn; };
struct Gemm { const bf16_t* A; const bf16_t* Bt; int M, N, K; };

struct StaticOrder {
    int nM, nN, nwg, G, c;
    __host__ __device__ void init(int M, int N, int G_, int c_) { nM = M / BM; nN = N / BM; nwg = nM * nN; G = G_; c = c_; }
    __host__ __device__ bool next(int i, Unit& u) const {
        const long L = (long)i * G + c; if (L >= nwg) return false;
        int wgid = (int)L; { const int q = nwg / NXCD, r = nwg % NXCD, xcd = wgid % NXCD, off = wgid / NXCD; wgid = (xcd < r ? xcd * (q + 1) : r * (q + 1) + (xcd - r) * q) + off; }
        const int nig = WGM * nN, gid = wgid / nig, fm = gid * WGM, gsz = (nM - fm) < WGM ? (nM - fm) : WGM;
        u.pm = fm + ((wgid % nig) % gsz); u.pn = (wgid % nig) / gsz; return true;
    }
    __device__ __forceinline__ void a_ready(const Unit&) const {}
    __device__ __forceinline__ void done(const Unit&) const {}
};

__device__ __forceinline__ unsigned cvt_pk_bf16(float lo, float hi) { unsigned r; asm volatile("v_cvt_pk_bf16_f32 %0, %1, %2" : "=v"(r) : "v"(lo), "v"(hi)); return r; }
typedef float f32x2 __attribute__((ext_vector_type(2)));
template <class Epi, class Sched, bool ALIGN_EPI = false, bool SP2 = false>
__device__ __forceinline__ void gemm_phase(PG8_LAS unsigned char* lds, const Gemm g, const Sched& S, const Epi& E, const int wid_in) {
    int lane_o = (int)__builtin_amdgcn_mbcnt_hi(~0u, __builtin_amdgcn_mbcnt_lo(~0u, 0u)); asm volatile("" : "+v"(lane_o));
    const int wid = __builtin_amdgcn_readfirstlane(wid_in), lane = lane_o, tid = wid * 64 + lane, wr = wid >> 2, wc = wid & 3, fr = lane & 15, fq = lane >> 4;
    const int K = g.K, nt = K / BK;
    unsigned voffA[2], voffB[2];
#pragma unroll
    for (int i = 0; i < 2; ++i) { int R, C; stage_rc(tid * 16 + i * 8192, R, C); const int Rb = Epi::PERM ? ((R & ~31) + perm32(R & 31)) : R;
        voffA[i] = (unsigned)(R * K + C) * 2u; voffB[i] = (unsigned)(Rb * K + C) * 2u; }
    const size_t kstep = (size_t)(BK * 2);
    const size_t hstep = (size_t)HALF * K * 2;
    const size_t tstep = 2 * hstep;
    const unsigned ldsw = (unsigned)wid * 1024u;
    const int aoff = lds_byte(wr * 64 + fr, fq * 8), boff = lds_byte(wc * 32 + fr, fq * 8);
#define PG8_SA(b, h) (((b) * 2 + (h)) * HTB)
#define PG8_SB(b, h) ((4 + (b) * 2 + (h)) * HTB)
#define PG8_STAGE(bufoff, gbase, voff) do { _Pragma("unroll") for (int _i = 0; _i < 2; ++_i) \
        __builtin_amdgcn_global_load_lds((const unsigned*)((const char*)(gbase) + (voff)[_i]), (PG8_LAS unsigned*)(lds + (bufoff) + ldsw + _i * 8192), 16, 0, 0); } while (0)
#define PG8_LDA(dst, b, h) do { _Pragma("unroll") for (int m = 0; m < 4; ++m) _Pragma("unroll") for (int k = 0; k < 2; ++k) dst[m][k] = *(const PG8_LAS bf16x8*)(lds + PG8_SA(b, h) + aoff + m * 2048 + k * 1024); } while (0)
#define PG8_LDB(dst, b, h) do { _Pragma("unroll") for (int n = 0; n < 2; ++n) _Pragma("unroll") for (int k = 0; k < 2; ++k) dst[n][k] = *(const PG8_LAS bf16x8*)(lds + PG8_SB(b, h) + boff + n * 2048 + k * 1024); } while (0)
#define PG8_MMA(ai, bj, At, Bt) do { __builtin_amdgcn_s_setprio(1); _Pragma("unroll") for (int m = 0; m < 4; ++m) _Pragma("unroll") for (int n = 0; n < 2; ++n) _Pragma("unroll") for (int k = 0; k < 2; ++k) \
        acc[ai][bj][m][n] = __builtin_amdgcn_mfma_f32_16x16x32_bf16(Bt[n][k], At[m][k], acc[ai][bj][m][n], 0, 0, 0); __builtin_amdgcn_s_setprio(0); } while (0)
#define PG8_WAIT_V(n) asm volatile("s_waitcnt vmcnt(" #n ")" ::: "memory")
#define PG8_WAIT_L(n) asm volatile("s_waitcnt lgkmcnt(" #n ")" ::: "memory")
#define PG8_BAR __builtin_amdgcn_s_barrier()
#define PG8_SCHED __builtin_amdgcn_sched_barrier(0)
    Unit cur, nxt; int ui = 0;
    if (!S.next(0, cur)) return;
    f32x4 acc[2][2][4][2];
#pragma unroll
    for (int a = 0; a < 2; ++a)
#pragma unroll
        for (int b = 0; b < 2; ++b)
#pragma unroll
            for (int m = 0; m < 4; ++m)
#pragma unroll
                for (int n = 0; n < 2; ++n) acc[a][b][m][n] = (f32x4){0.f, 0.f, 0.f, 0.f};
    bf16x8 At[4][2], B0[2][2], B1[2][2];
    const char* cA = (const char*)g.A + (size_t)cur.pm * tstep; const char* cB = (const char*)g.Bt + (size_t)cur.pn * tstep;
    S.a_ready(cur);
    if constexpr (SP2) {
        PG8_STAGE(PG8_SB(0, 0), cB, voffB); PG8_STAGE(PG8_SB(0, 1), cB + hstep, voffB); PG8_STAGE(PG8_SA(0, 0), cA, voffA); PG8_STAGE(PG8_SA(0, 1), cA + hstep, voffA);
        if (wr == 1) PG8_BAR;
        PG8_WAIT_V(2); PG8_BAR;
        PG8_STAGE(PG8_SB(1, 0), cB + kstep, voffB); PG8_STAGE(PG8_SA(1, 0), cA + kstep, voffA); PG8_STAGE(PG8_SB(1, 1), cB + hstep + kstep, voffB);
        PG8_WAIT_V(6); PG8_BAR;
    } else {
        PG8_STAGE(PG8_SB(0, 0), cB, voffB); PG8_STAGE(PG8_SA(0, 0), cA, voffA); PG8_STAGE(PG8_SB(0, 1), cB + hstep, voffB); PG8_STAGE(PG8_SA(0, 1), cA + hstep, voffA);
        if (wr == 1) PG8_BAR;
        PG8_WAIT_V(4); PG8_BAR;
        PG8_STAGE(PG8_SB(1, 0), cB + kstep, voffB); PG8_STAGE(PG8_SA(1, 0), cA + kstep, voffA); PG8_STAGE(PG8_SB(1, 1), cB + hstep + kstep, voffB);
        PG8_WAIT_V(6); PG8_BAR;
    }
    for (;;) {
        const bool has_next = S.next(ui + 1, nxt);
        const char* nA = has_next ? (const char*)g.A + (size_t)nxt.pm * tstep : cA; const char* nB = has_next ? (const char*)g.Bt + (size_t)nxt.pn * tstep : cB;
        for (int t = 0; t < nt; t += 2) {
            const bool last = (t == nt - 2);
            const char* a1 = cA + (size_t)(t + 1) * kstep;
            const char* a2 = last ? nA : cA + (size_t)(t + 2) * kstep; const char* b2 = last ? nB : cB + (size_t)(t + 2) * kstep;
            const char* a3 = a2 + kstep; const char* b3 = b2 + kstep;
            if (last && has_next) S.a_ready(nxt);
            if constexpr (SP2) {
            PG8_LDB(B0, 0, 0); PG8_LDB(B1, 0, 1); PG8_SCHED; PG8_LDA(At, 0, 0); PG8_STAGE(PG8_SA(1, 1), a1 + hstep, voffA);
            PG8_WAIT_V(8); PG8_WAIT_L(0); PG8_BAR; PG8_MMA(0, 0, At, B0); PG8_MMA(0, 1, At, B1); PG8_BAR; PG8_SCHED;
            PG8_LDA(At, 0, 1); PG8_STAGE(PG8_SB(0, 0), b2, voffB); PG8_STAGE(PG8_SB(0, 1), b2 + hstep, voffB); PG8_STAGE(PG8_SA(0, 0), a2, voffA);
            PG8_WAIT_V(8); PG8_WAIT_L(0); PG8_BAR; PG8_MMA(1, 0, At, B0); PG8_MMA(1, 1, At, B1); PG8_BAR; PG8_SCHED;
            PG8_LDB(B0, 1, 0); PG8_LDB(B1, 1, 1); PG8_SCHED; PG8_LDA(At, 1, 0); PG8_STAGE(PG8_SA(0, 1), a2 + hstep, voffA);
            PG8_WAIT_V(8); PG8_WAIT_L(0); PG8_BAR; PG8_MMA(0, 0, At, B0); PG8_MMA(0, 1, At, B1); PG8_BAR; PG8_SCHED;
            PG8_LDA(At, 1, 1); PG8_STAGE(PG8_SB(1, 0), b3, voffB); PG8_STAGE(PG8_SB(1, 1), b3 + hstep, voffB); PG8_STAGE(PG8_SA(1, 0), a3, voffA);
            PG8_WAIT_V(8); PG8_WAIT_L(0); PG8_BAR; PG8_MMA(1, 0, At, B0); PG8_MMA(1, 1, At, B1); PG8_BAR; PG8_SCHED;
            } else {
            PG8_LDB(B0, 0, 0); PG8_SCHED; PG8_LDA(At, 0, 0); PG8_STAGE(PG8_SA(1, 1), a1 + hstep, voffA);
            PG8_WAIT_L(8); PG8_BAR; PG8_WAIT_L(0); PG8_MMA(0, 0, At, B0); PG8_BAR; PG8_SCHED;
            PG8_LDB(B1, 0, 1); PG8_STAGE(PG8_SB(0, 0), b2, voffB);
            PG8_BAR; PG8_WAIT_L(0); PG8_MMA(0, 1, At, B1); PG8_BAR;
            PG8_LDA(At, 0, 1); PG8_STAGE(PG8_SA(0, 0), a2, voffA);
            PG8_BAR; PG8_WAIT_L(0); PG8_MMA(1, 0, At, B0); PG8_BAR; PG8_SCHED;
            PG8_STAGE(PG8_SB(0, 1), b2 + hstep, voffB);
            PG8_WAIT_V(6); PG8_BAR; PG8_MMA(1, 1, At, B1); PG8_BAR;
            PG8_LDB(B0, 1, 0); PG8_SCHED; PG8_LDA(At, 1, 0); PG8_STAGE(PG8_SA(0, 1), a2 + hstep, voffA);
            PG8_WAIT_L(8); PG8_BAR; PG8_WAIT_L(0); PG8_MMA(0, 0, At, B0); PG8_BAR; PG8_SCHED;
            PG8_LDB(B1, 1, 1); PG8_STAGE(PG8_SB(1, 0), b3, voffB);
            PG8_BAR; PG8_WAIT_L(0); PG8_MMA(0, 1, At, B1); PG8_BAR;
            PG8_LDA(At, 1, 1); PG8_STAGE(PG8_SA(1, 0), a3, voffA);
            PG8_BAR; PG8_WAIT_L(0); PG8_MMA(1, 0, At, B0); PG8_BAR; PG8_SCHED;
            PG8_STAGE(PG8_SB(1, 1), b3 + hstep, voffB);
            PG8_WAIT_V(6); PG8_BAR; PG8_MMA(1, 1, At, B1); PG8_BAR;
            }
        }
        if constexpr (ALIGN_EPI) { if (wr == 0) PG8_BAR; }
        if constexpr (!Epi::AFTER_DRAIN) { E(acc, cur, wr, wc, fr, fq); S.done(cur); }
        if (!has_next) break;
#pragma unroll
        for (int a = 0; a < 2; ++a)
#pragma unroll
            for (int b = 0; b < 2; ++b)
#pragma unroll
                for (int m = 0; m < 4; ++m)
#pragma unroll
                    for (int n = 0; n < 2; ++n) acc[a][b][m][n] = (f32x4){0.f, 0.f, 0.f, 0.f};
        cur = nxt; cA = nA; cB = nB; ++ui;
        if constexpr (ALIGN_EPI) { if (wr == 1) PG8_BAR; }
    }
    PG8_WAIT_V(0);
    if constexpr (!ALIGN_EPI) { if (wr == 0) PG8_BAR; }
    PG8_BAR;
    if constexpr (Epi::AFTER_DRAIN) { E.fused(acc, cur, wr, wc, fr, fq, lds, wid, lane); S.done(cur); }
#undef PG8_SA
#undef PG8_SB
#undef PG8_STAGE
#undef PG8_LDA
#undef PG8_LDB
#undef PG8_MMA
#undef PG8_WAIT_V
#undef PG8_WAIT_L
#undef PG8_BAR
#undef PG8_SCHED
}
}

namespace pg8 {
__device__ __forceinline__ float bflo_(unsigned w) { return __builtin_bit_cast(float, w << 16); }
__device__ __forceinline__ float bfhi_(unsigned w) { return __builtin_bit_cast(float, w & 0xffff0000u); }
__device__ __forceinline__ float sigm_(float x) { return __builtin_amdgcn_rcpf(1.f + __expf(-x)); }

struct EpiStoreBf16 {
    static constexpr bool PERM = true, AFTER_DRAIN = false;
    bf16_t* O; int ldc;
    __device__ __forceinline__ void operator()(const f32x4 (&acc)[2][2][4][2], const Unit& u, int wr, int wc, int fr, int fq) const {
        const int row0 = u.pm * BM + wr * 64 + fr, col0 = u.pn * BM + wc * 32 + 8 * fq;
#pragma unroll
        for (int ai = 0; ai < 2; ++ai)
#pragma unroll
            for (int m = 0; m < 4; ++m) { bf16_t* rowp = O + (size_t)(row0 + ai * HALF + m * 16) * ldc + col0;
#pragma unroll
                for (int bj = 0; bj < 2; ++bj) { const f32x4 v0 = acc[ai][bj][m][0], v1 = acc[ai][bj][m][1];
                    u32x4 w; w.x = cvt_pk_bf16(v0[0], v0[1]); w.y = cvt_pk_bf16(v0[2], v0[3]); w.z = cvt_pk_bf16(v1[0], v1[1]); w.w = cvt_pk_bf16(v1[2], v1[3]);
                    *(u32x4*)(rowp + bj * HALF) = w; } }
    }
};

struct EpiMerge {
    static constexpr bool PERM = true, AFTER_DRAIN = false;
    const bf16_t* U; int ldu, gcol0; bf16_t* Mf; bf16_t* Mb; int npm;
    __device__ __forceinline__ void operator()(const f32x4 (&acc)[2][2][4][2], const Unit& u, int wr, int wc, int fr, int fq) const {
        const int br = u.pm / npm, pm = u.pm - br * npm, pn = u.pn & 3;
        const int row0 = pm * BM + wr * 64 + fr, col0 = pn * BM + wc * 32 + 8 * fq;
#pragma unroll
        for (int ai = 0; ai < 2; ++ai) {
            u32x4 gv[4][2], pv[4][2];
#pragma unroll
            for (int m = 0; m < 4; ++m)
#pragma unroll
                for (int bj = 0; bj < 2; ++bj) { const size_t row = (size_t)(row0 + ai * HALF + m * 16); const int col = col0 + bj * HALF;
                    gv[m][bj] = *(const u32x4*)(U + row * ldu + gcol0 + br * 1024 + col);
                    pv[m][bj] = br > 0 ? *(const u32x4*)(Mf + row * 1024 + col) : (u32x4){0u, 0u, 0u, 0u}; }
#pragma unroll
            for (int m = 0; m < 4; ++m)
#pragma unroll
                for (int bj = 0; bj < 2; ++bj) { const size_t row = (size_t)(row0 + ai * HALF + m * 16); const int col = col0 + bj * HALF;
                    const u32x4 g = gv[m][bj], p = pv[m][bj];
                    f32x4 v0 = acc[ai][bj][m][0], v1 = acc[ai][bj][m][1];
                    v0[0] = v0[0] * sigm_(bflo_(g.x)) + bflo_(p.x); v0[1] = v0[1] * sigm_(bfhi_(g.x)) + bfhi_(p.x); v0[2] = v0[2] * sigm_(bflo_(g.y)) + bflo_(p.y); v0[3] = v0[3] * sigm_(bfhi_(g.y)) + bfhi_(p.y);
                    v1[0] = v1[0] * sigm_(bflo_(g.z)) + bflo_(p.z); v1[1] = v1[1] * sigm_(bfhi_(g.z)) + bfhi_(p.z); v1[2] = v1[2] * sigm_(bflo_(g.w)) + bflo_(p.w); v1[3] = v1[3] * sigm_(bfhi_(g.w)) + bfhi_(p.w);
                    u32x4 w; w.x = cvt_pk_bf16(v0[0], v0[1]); w.y = cvt_pk_bf16(v0[2], v0[3]); w.z = cvt_pk_bf16(v1[0], v1[1]); w.w = cvt_pk_bf16(v1[2], v1[3]);
                    *(u32x4*)((br < 3 ? Mf : Mb) + row * 1024 + col) = w; }
        }
    }
};
struct MergeOrder {
    int G, c, npm, ncnt;
    __device__ __forceinline__ bool next(int i, Unit& u) const {
        const int su = (i >> 2) * G + c; if (su >= ncnt * 4) return false;
        const int br = i & 3; u.pm = br * npm + (su >> 2); u.pn = br * 4 + (su & 3); return true; }
    __device__ __forceinline__ void a_ready(const Unit&) const {}
    __device__ __forceinline__ void done(const Unit&) const {}
};

struct EpiResid {
    static constexpr bool PERM = false, AFTER_DRAIN = false;
    float* X; const float* gt;
    __device__ __forceinline__ void operator()(const f32x4 (&acc)[2][2][4][2], const Unit& u, int wr, int wc, int fr, int fq) const {
        const int row0 = u.pm * BM + wr * 64 + fr, col0 = u.pn * BM + wc * 32 + 4 * fq;
        const int mr = u.pm < 64 ? (u.pm >> 4) : 4;
        f32x4 gv[2][2];
#pragma unroll
        for (int bj = 0; bj < 2; ++bj)
#pragma unroll
            for (int n = 0; n < 2; ++n) gv[bj][n] = *(const f32x4*)(gt + (size_t)mr * 6144 + col0 + bj * HALF + n * 16);
#pragma unroll
        for (int ai = 0; ai < 2; ++ai) {
            f32x4 xv[4][2][2];
#pragma unroll
            for (int m = 0; m < 4; ++m)
#pragma unroll
                for (int bj = 0; bj < 2; ++bj)
#pragma unroll
                    for (int n = 0; n < 2; ++n) xv[m][bj][n] = *(const f32x4*)(X + (size_t)(row0 + ai * HALF + m * 16) * 1024 + col0 + bj * HALF + n * 16);
#pragma unroll
            for (int m = 0; m < 4; ++m)
#pragma unroll
                for (int bj = 0; bj < 2; ++bj)
#pragma unroll
                    for (int n = 0; n < 2; ++n) *(f32x4*)(X + (size_t)(row0 + ai * HALF + m * 16) * 1024 + col0 + bj * HALF + n * 16) = xv[m][bj][n] + gv[bj][n] * acc[ai][bj][m][n];
        }
    }
};

struct MoeOrder {
    const PG8_LAS int* tpre; int G, c, ncol;
    __device__ __forceinline__ bool next(int i, Unit& u) const {
        int tau, pnl;
        if ((G & 7) == 0 && ((G >> 3) % ncol) == 0) { const int x = c & 7, y = c >> 3, rp = (G >> 3) / ncol; tau = (i * 8 + x) * rp + y / ncol; pnl = y % ncol; }
        else { const int L = i * G + c; tau = L / ncol; pnl = L - tau * ncol; }
        if (tau >= tpre[32]) return false;
        int e = 0;
#pragma unroll 1
        while (tpre[e + 1] <= tau) ++e;
        u.pm = tau; u.pn = e * ncol + pnl; return true; }
    __device__ __forceinline__ void a_ready(const Unit&) const {}
    __device__ __forceinline__ void done(const Unit&) const {}
};
struct EpiSwiglu {
    static constexpr bool PERM = true, AFTER_DRAIN = false;
    bf16_t* ACT; const float* bgu;
    __device__ __forceinline__ void operator()(const f32x4 (&acc)[2][2][4][2], const Unit& u, int wr, int wc, int fr, int fq) const {
        const int e = u.pn >> 3, pnl = u.pn & 7;
        const int row0 = u.pm * BM + wr * 64 + fr, cl = 128 * pnl + wc * 32 + 8 * fq;
        const float* bg = bgu + (size_t)e * 2048 + cl;
        const f32x4 bg0 = *(const f32x4*)bg, bg1 = *(const f32x4*)(bg + 4), bu0 = *(const f32x4*)(bg + 1024), bu1 = *(const f32x4*)(bg + 1028);
#pragma unroll
        for (int ai = 0; ai < 2; ++ai)
#pragma unroll
            for (int m = 0; m < 4; ++m) {
                f32x4 g0 = acc[ai][0][m][0] + bg0, g1 = acc[ai][0][m][1] + bg1, u0 = acc[ai][1][m][0] + bu0, u1 = acc[ai][1][m][1] + bu1;
                float o[8];
#pragma unroll
                for (int j = 0; j < 4; ++j) { const float g = fminf(g0[j], 7.f), up = fminf(fmaxf(u0[j], -7.f), 7.f); o[j] = (up + 1.f) * g * sigm_(1.702f * g); }
#pragma unroll
                for (int j = 0; j < 4; ++j) { const float g = fminf(g1[j], 7.f), up = fminf(fmaxf(u1[j], -7.f), 7.f); o[4 + j] = (up + 1.f) * g * sigm_(1.702f * g); }
                u32x4 w; w.x = cvt_pk_bf16(o[0], o[1]); w.y = cvt_pk_bf16(o[2], o[3]); w.z = cvt_pk_bf16(o[4], o[5]); w.w = cvt_pk_bf16(o[6], o[7]);
                *(u32x4*)(ACT + (size_t)(row0 + ai * HALF + m * 16) * 1024 + cl) = w; }
    }
};
struct EpiDown {
    static constexpr bool PERM = true, AFTER_DRAIN = false;
    bf16_t* YS; const float* bdn;
    __device__ __forceinline__ void operator()(const f32x4 (&acc)[2][2][4][2], const Unit& u, int wr, int wc, int fr, int fq) const {
        const int e = u.pn >> 2, pnl = u.pn & 3;
        const int row0 = u.pm * BM + wr * 64 + fr, col0 = pnl * BM + wc * 32 + 8 * fq;
        f32x4 bv[2][2];
#pragma unroll
        for (int bj = 0; bj < 2; ++bj)
#pragma unroll
            for (int n = 0; n < 2; ++n) bv[bj][n] = *(const f32x4*)(bdn + (size_t)e * 1024 + col0 + bj * HALF + 4 * n);
#pragma unroll
        for (int ai = 0; ai < 2; ++ai)
#pragma unroll
            for (int m = 0; m < 4; ++m) { bf16_t* rowp = YS + (size_t)(row0 + ai * HALF + m * 16) * 1024 + col0;
#pragma unroll
                for (int bj = 0; bj < 2; ++bj) { const f32x4 v0 = acc[ai][bj][m][0] + bv[bj][0], v1 = acc[ai][bj][m][1] + bv[bj][1];
                    u32x4 w; w.x = cvt_pk_bf16(v0[0], v0[1]); w.y = cvt_pk_bf16(v0[2], v0[3]); w.z = cvt_pk_bf16(v1[0], v1[1]); w.w = cvt_pk_bf16(v1[2], v1[3]);
                    *(u32x4*)(rowp + bj * HALF) = w; } }
    }
};
}
#define XB_TMO      128
#define XB_XCNT(j)  (256  + 64 * (j))
#define XB_XSUB(j)  (1280 + 64 * (j))
#define XB_XGEN(j)  (2304 + 64 * (j))
#define XB_TOP      3328
#define XB_TOPGEN   3392
#define XCD_BAR_WORDS 3456
#define XB_SPIN_CAP (1u << 18)
#define LAS __attribute__((address_space(3)))

__device__ __forceinline__ unsigned xb_ld(unsigned* p)              { return __hip_atomic_load(p, __ATOMIC_RELAXED, __HIP_MEMORY_SCOPE_AGENT); }
__device__ __forceinline__ unsigned xb_add(unsigned* p, unsigned v) { return __hip_atomic_fetch_add(p, v, __ATOMIC_RELAXED, __HIP_MEMORY_SCOPE_AGENT); }
__device__ __forceinline__ unsigned xb_xcc_id() { return (unsigned)__builtin_amdgcn_s_getreg((3 << 11) | 20) & 0xFu; }
#define XB_SPIN(cond, bar) do { unsigned _sp = 0; while (cond) { __builtin_amdgcn_s_sleep(1); \
    if ((++_sp & 255u) == 0u) { if (xb_ld(&(bar)[XB_TMO])) break; if (_sp > XB_SPIN_CAP) { atomicAdd(&(bar)[XB_TMO], 1u); break; } } } } while (0)

struct XcdBarrier {
    unsigned* bar; unsigned x;
    volatile LAS unsigned* st;
};

__device__ __forceinline__ XcdBarrier xcd_barrier_post(unsigned* bar, volatile LAS unsigned* st) {
    XcdBarrier b; b.bar = bar; b.x = xb_xcc_id(); b.st = st;
    if (threadIdx.x == 0) (void)xb_add(&bar[XB_XCNT(b.x)], 1u);
    return b;
}
__device__ __forceinline__ void xcd_barrier_complete(unsigned* bar, unsigned x, unsigned& nloc, unsigned& nx) {
    const unsigned G = gridDim.x * gridDim.y * gridDim.z;
    unsigned sum, cnt, mine, sp = 0u;
    for (;;) {
        sum = 0u; cnt = 0u; mine = 0u;
#pragma unroll
        for (unsigned j = 0; j < 16; ++j) { const unsigned c = xb_ld(&bar[XB_XCNT(j)]); sum += c; cnt += (c > 0u) ? 1u : 0u; mine = (j == x) ? c : mine; }
        if (sum == G) break;
        __builtin_amdgcn_s_sleep(1);
        if ((++sp & 255u) == 0u) { if (xb_ld(&bar[XB_TMO])) break; if (sp > XB_SPIN_CAP) { atomicAdd(&bar[XB_TMO], 1u); break; } }
    }
    nloc = mine > 0u ? mine : 1u; nx = cnt > 0u ? cnt : 1u;
}

__device__ __forceinline__ void xcd_barrier(const XcdBarrier& b) {
    asm volatile("s_waitcnt vmcnt(0)" ::: "memory");
    __syncthreads();
    if (threadIdx.x == 0) {
        unsigned* bar = b.bar;
        __builtin_amdgcn_s_waitcnt(0);
        unsigned nloc = b.st[0], nx = b.st[1];
        if (nloc == 0u) { xcd_barrier_complete(bar, b.x, nloc, nx); b.st[0] = nloc; b.st[1] = nx; }
        const unsigned old = xb_add(&bar[XB_XSUB(b.x)], 1u);
        const unsigned gen = old / nloc;
        if (old + 1u == (gen + 1u) * nloc) {
            __builtin_amdgcn_fence(__ATOMIC_RELEASE, "agent");
            asm volatile("s_waitcnt vmcnt(0)" ::: "memory");
            const unsigned og = xb_add(&bar[XB_TOP], 1u);
            const unsigned tg = og / nx;
            if (og + 1u == (tg + 1u) * nx) xb_add(&bar[XB_TOPGEN], 1u);
            else XB_SPIN(xb_ld(&bar[XB_TOPGEN]) == tg, bar);
            __builtin_amdgcn_fence(__ATOMIC_ACQUIRE, "agent");
            xb_add(&bar[XB_XGEN(b.x)], 1u);
            asm volatile("s_waitcnt vmcnt(0)" ::: "memory");
        } else {
            XB_SPIN(xb_ld(&bar[XB_XGEN(b.x)]) == gen, bar);
            __builtin_amdgcn_fence(__ATOMIC_ACQUIRE, "agent");
            asm volatile("s_waitcnt vmcnt(0)" ::: "memory");
        }
    }
    __syncthreads();
}

struct Frame {
    LAS unsigned char* lds;
    unsigned* ctl;
    int tid, lane, wave, G, bid;
    unsigned long long pr;
    const float* const* in; const float* const* in0;
    float* out;
    unsigned char* ws; unsigned char* ws0;
};
#define WSP(T, off) ((T*)(F.ws + (off)))
#define REFRESH_TID(F) do { int t_ = (int)__builtin_amdgcn_mbcnt_hi(~0u, __builtin_amdgcn_mbcnt_lo(~0u, 0u)); asm volatile("" : "+v"(t_)); F.lane = t_; F.tid = F.wave * 64 + t_; \
    int z_ = 0; asm volatile("s_mov_b32 %0, 0" : "=s"(z_)); F.ws = F.ws0 + z_; F.in = F.in0 + z_; F.bid = (int)blockIdx.x + z_; } while (0)
#define I_X 0
#define I_C 1
#define I_CTX 2
#define I_CCTX 3
#define I_WMOD 4
#define I_BMOD 5
#define I_G1 6
#define I_G2 7
#define I_WIN 8
#define I_AGQ 9
#define I_AGK 10
#define I_BCW 11
#define I_BCB 12
#define I_BLAM 13
#define I_BWR 14
#define I_BBR 15
#define I_BWI 16
#define I_BBI 17
#define I_CCW 18
#define I_CALOG 19
#define I_CDTB 20
#define I_CGOUT 21
#define I_RPB 22
#define I_WBR 23
#define I_WOUT 24
#define I_WRT 25
#define I_BRT 26
#define I_WGU 27
#define I_BGU 28
#define I_WDN 29
#define I_BDN 30
#define I_GFIN 31

__device__ __forceinline__ int mod_row(int r) { return r < TLAT ? (r >> 12) : 4; }

__device__ __forceinline__ void p0_transpose_item(const float* W, size_t pitch, int K, bf16* WT, int drow0, int scol0, int k0, LAS float* scr, int lane) {
    float v[32];
#pragma unroll
    for (int i = 0; i < 32; ++i) { const int kk = 2 * i + (lane >> 5); v[i] = W[(size_t)(k0 + kk) * pitch + scol0 + (lane & 31)]; }
#pragma unroll
    for (int i = 0; i < 32; ++i) { const int kk = 2 * i + (lane >> 5); scr[kk * 33 + (lane & 31)] = v[i]; }
    asm volatile("s_waitcnt lgkmcnt(0)" ::: "memory");
    const int c = lane & 7;
#pragma unroll
    for (int j = 0; j < 4; ++j) { const int n = (lane >> 3) + 8 * j; const LAS float* s = scr + (8 * c) * 33 + n;
        v4u o; o.x = pk2(s[0 * 33], s[1 * 33]); o.y = pk2(s[2 * 33], s[3 * 33]); o.z = pk2(s[4 * 33], s[5 * 33]); o.w = pk2(s[6 * 33], s[7 * 33]);
        *(v4u*)(WT + (size_t)(drow0 + n) * K + k0 + 8 * c) = o; }
    asm volatile("s_waitcnt lgkmcnt(0)" ::: "memory");
}

__device__ __forceinline__ void p0_prologue(Frame& F) {
    LAS float* scr = (LAS float*)(F.lds + F.wave * 16384);
    const int gw = F.bid * NWAVES + F.wave, NGW = F.G * NWAVES;
    constexpr int I_IN = DEPTH * 16 * (UW / 32);
    constexpr int I_BR = DEPTH * 4 * 8 * 32;
    constexpr int I_OUT = DEPTH * 16 * 32;
    constexpr int I_GU = DEPTH * NEXP * 16 * 64;
    constexpr int I_DN = DEPTH * NEXP * 16 * 32;
    constexpr int NITEMS = I_IN + I_BR + I_OUT + I_GU + I_DN;
    for (int it = gw; it < NITEMS; it += NGW) {
        int r = it;
        if (r < I_IN) { const int l = r / (16 * 296), q = r % (16 * 296), kb = q / 296, nb = q % 296; const int n0 = nb * 32, sc = n0 < 3840 ? n0 : n0 + 16;
            p0_transpose_item(F.in[I_WIN] + (size_t)l * D * INW, INW, D, WSP(bf16, WS_WIN) + (size_t)l * UW * D, n0, sc, kb * 64, scr, F.lane); continue; }
        r -= I_IN;
        if (r < I_BR) { const int mi = r / 256, q = r % 256, kb = q / 32, nb = q % 32;
            p0_transpose_item(F.in[I_WBR] + (size_t)mi * 512 * 1024, 1024, 512, WSP(bf16, WS_WBR) + (size_t)mi * 1024 * 512, nb * 32, nb * 32, kb * 64, scr, F.lane); continue; }
        r -= I_BR;
        if (r < I_OUT) { const int l = r / 512, q = r % 512, kb = q / 32, nb = q % 32;
            p0_transpose_item(F.in[I_WOUT] + (size_t)l * D * D, D, D, WSP(bf16, WS_WOUT) + (size_t)l * D * D, nb * 32, nb * 32, kb * 64, scr, F.lane); continue; }
        r -= I_OUT;
        if (r < I_GU) { const int mi = r / 1024, q = r % 1024, kb = q / 64, nb = q % 64; const int j0 = nb * 32, pn = j0 >> 8, bj = (j0 >> 7) & 1, cc = j0 & 127;
            p0_transpose_item(F.in[I_WGU] + (size_t)mi * D * 2048, 2048, D, WSP(bf16, WS_WGU) + (size_t)mi * 2048 * D, j0, 1024 * bj + 128 * pn + cc, kb * 64, scr, F.lane); continue; }
        r -= I_GU;
        { const int mi = r / 512, q = r % 512, kb = q / 32, nb = q % 32;
            p0_transpose_item(F.in[I_WDN] + (size_t)mi * D * D, D, D, WSP(bf16, WS_WDN) + (size_t)mi * D * D, nb * 32, nb * 32, kb * 64, scr, F.lane); }
    }
    __syncthreads();
    {
        LAS float* sc = (LAS float*)F.lds;
        LAS float* part = sc + 5 * 1024;
        bool staged = false;
        for (int it = F.bid; it < DEPTH * 96; it += F.G) {
            if (!staged) {
                for (int i = F.tid; i < 5 * 1024; i += NT) { const int r = i >> 10, k = i & 1023; const float cv = r < 4 ? F.in[I_C][r * 1024 + k] : F.in[I_CCTX][k]; sc[i] = siluf_(cv); }
                __syncthreads(); staged = true;
            }
            const int l = it / 96, cg = it % 96, col = cg * 64 + F.lane;
            const float* wm = F.in[I_WMOD] + (size_t)l * D * 6144 + col;
            float a0 = 0.f, a1 = 0.f, a2 = 0.f, a3 = 0.f, a4 = 0.f;
            const int kb = F.wave * 128;
#pragma unroll 16
            for (int k = 0; k < 128; ++k) { const float w = wm[(size_t)(kb + k) * 6144];
                a0 += sc[kb + k] * w; a1 += sc[1024 + kb + k] * w; a2 += sc[2048 + kb + k] * w; a3 += sc[3072 + kb + k] * w; a4 += sc[4096 + kb + k] * w; }
            LAS float* pp = part + F.wave * 320 + F.lane;
            pp[0] = a0; pp[64] = a1; pp[128] = a2; pp[192] = a3; pp[256] = a4;
            __syncthreads();
            if (F.tid < 320) { const int r = F.tid >> 6, ln = F.tid & 63; float s = 0.f;
#pragma unroll
                for (int w = 0; w < 8; ++w) s += part[w * 320 + r * 64 + ln];
                const int cc = cg * 64 + ln;
                WSP(float, WS_MOD)[((size_t)l * 5 + r) * 6144 + cc] = s + F.in[I_BMOD][l * 6144 + cc]; }
            __syncthreads();
        }
    }
    if (F.bid == 0) {
        for (int i = F.tid; i < 1024; i += NT) { const int p = i >> 4, f = i & 15; const float inv = powf(10000.f, -(float)f / 16.f); const float ang = (float)p * inv;
            WSP(float, WS_ROPE)[i] = cosf(ang); WSP(float, WS_ROPE)[1024 + i] = sinf(ang); }
    }
    for (int i = F.bid * NT + F.tid; i < DEPTH * 2 * 2 * 8 * 4096; i += F.G * NT) {
        const int c = i & 63, d = (i >> 6) & 63, n = (i >> 12) & 7, gate = (i >> 15) & 1, ld = i >> 16;
        const float* src = gate ? F.in[I_BWI] : F.in[I_BWR];
        WSP(bf16, WS_LRUW)[i] = (bf16)f2bf(src[((size_t)ld * 8 + n) * 4096 + c * 64 + d]);
    }
}

template <int MODE>
__device__ __forceinline__ void norm_phase(Frame& F, int l) {
    LAS float* hs = (LAS float*)F.lds;
    LAS int* lcnt = (LAS int*)(F.lds + 65536);
    LAS int* lbase = lcnt + 32;
    const int ngroups = ((MODE == 2 || (MODE == 1 && l == DEPTH - 1)) ? TLAT : MROWS) / 16;
    const float* modl = WSP(float, WS_MOD) + (size_t)l * 5 * 6144;
    float pb0[32], pb1[32];
    if (MODE != 2) {
        REFRESH_TID(F);
        const int r16 = F.lane & 15, quad = F.lane >> 4, w = F.wave;
        const size_t stride = MODE == 0 ? (size_t)INW : (size_t)NEXP;
        const float* wp = (MODE == 0 ? F.in[I_WIN] + (size_t)l * D * INW + 3840 : F.in[I_WRT] + (size_t)l * D * NEXP) + (size_t)(128 * w + quad) * stride + r16;
#pragma unroll
        for (int s = 0; s < 32; ++s) { pb0[s] = wp[(size_t)(4 * s) * stride]; pb1[s] = MODE == 1 ? wp[(size_t)(4 * s) * stride + 16] : 0.f; }
    }
#pragma unroll 1
    for (int gi = F.bid; gi < ngroups; gi += F.G) {
        REFRESH_TID(F);
        if (MODE == 1) { if (F.tid < 32) lcnt[F.tid] = 0; }
        constexpr bool COMB = true;
        const bool comb = (MODE == 0 && l > 0) || MODE == 2;
        f32x4 vv[2][4]; v2u yv[2][4][4]; float swv[2][4];
#pragma unroll
        for (int i = 0; i < 2; ++i) {
            const int r = gi * 16 + 2 * F.wave + i;
            const float* xsrc;
            if (MODE == 0 && l == 0) xsrc = r < TLAT ? F.in[I_X] + (size_t)r * D : F.in[I_CTX] + (size_t)(r - TLAT) * D;
            else xsrc = WSP(float, WS_X) + (size_t)r * D;
#pragma unroll
            for (int j = 0; j < 4; ++j) vv[i][j] = *(const f32x4*)(xsrc + 4 * F.lane + 256 * j);
        }
        if (COMB && comb) {
            int srv[2][4];
#pragma unroll
            for (int i = 0; i < 2; ++i)
#pragma unroll
                for (int k = 0; k < 4; ++k) { const int r = gi * 16 + 2 * F.wave + i; srv[i][k] = WSP(int, WS_SROW)[r * 4 + k]; swv[i][k] = WSP(float, WS_SW)[r * 4 + k]; }
#pragma unroll
            for (int i = 0; i < 2; ++i)
#pragma unroll
                for (int k = 0; k < 4; ++k) { const bf16* yr = WSP(bf16, WS_YS) + (size_t)srv[i][k] * D;
#pragma unroll
                    for (int j = 0; j < 4; ++j) yv[i][k][j] = *(const v2u*)(yr + 4 * F.lane + 256 * j); }
        }
#pragma unroll
        for (int i = 0; i < 2; ++i) {
            const int lr = 2 * F.wave + i, r = gi * 16 + lr, mr = mod_row(r);
            f32x4 v[4];
#pragma unroll
            for (int j = 0; j < 4; ++j) v[j] = vv[i][j];
            if (comb) {
                const int lp = MODE == 2 ? DEPTH - 1 : l - 1;
                const float* gt2 = WSP(float, WS_MOD) + ((size_t)lp * 5 + mr) * 6144 + 5120;
                f32x4 cb[4];
#pragma unroll
                for (int j = 0; j < 4; ++j) cb[j] = (f32x4){0.f, 0.f, 0.f, 0.f};
#pragma unroll
                for (int k = 0; k < 4; ++k) { const float w = swv[i][k];
#pragma unroll
                    for (int j = 0; j < 4; ++j) { const v2u y = yv[i][k][j];
                        cb[j].x += w * bflo(y.x); cb[j].y += w * bfhi(y.x); cb[j].z += w * bflo(y.y); cb[j].w += w * bfhi(y.y); }
                }
#pragma unroll
                for (int j = 0; j < 4; ++j) { const f32x4 g = *(const f32x4*)(gt2 + 4 * F.lane + 256 * j); v[j] = v[j] + g * cb[j]; }
            }
            if (MODE == 0) {
#pragma unroll
                for (int j = 0; j < 4; ++j) *(f32x4*)(WSP(float, WS_X) + (size_t)r * D + 4 * F.lane + 256 * j) = v[j];
            }
            float ss = 0.f;
#pragma unroll
            for (int j = 0; j < 4; ++j) ss += (v[j].x * v[j].x + v[j].y * v[j].y) + (v[j].z * v[j].z + v[j].w * v[j].w);
            const float rstd = rsqrtf(wave_sum(ss) * (1.f / D) + EPS);
            if (MODE == 2) {
#pragma unroll
                for (int j = 0; j < 4; ++j) { const f32x4 g = *(const f32x4*)(F.in[I_GFIN] + 4 * F.lane + 256 * j);
                    *(f32x4*)(F.out + (size_t)r * D + 4 * F.lane + 256 * j) = v[j] * rstd * g; }
            } else {
                const float* gn = F.in[MODE == 0 ? I_G1 : I_G2] + l * D;
                const float* sh = modl + (size_t)mr * 6144 + (MODE == 0 ? 0 : 3072);
                const float* sc = sh + 1024;
#pragma unroll
                for (int j = 0; j < 4; ++j) { const int c0 = 4 * F.lane + 256 * j;
                    const f32x4 g = *(const f32x4*)(gn + c0), a = *(const f32x4*)(sh + c0), s = *(const f32x4*)(sc + c0);
                    const f32x4 h = (v[j] * rstd * g) * (s + 1.f) + a;
                    *(LAS f32x4*)(hs + lr * 1024 + c0) = h;
                    v2u o; o.x = pk2(h.x, h.y); o.y = pk2(h.z, h.w);
                    *(v2u*)(WSP(bf16, WS_H) + (size_t)r * D + c0) = o; }
            }
        }
        if (MODE == 2) continue;
        __syncthreads();
        LAS float* red = (LAS float*)(F.lds + 65536 + 256);
        {
            const int r16 = F.lane & 15, quad = F.lane >> 4, w = F.wave;
            const LAS float* hp = hs + r16 * 1024 + 128 * w + quad;
            f32x4 acc0 = (f32x4){0.f, 0.f, 0.f, 0.f}, acc1 = acc0;
#pragma unroll
            for (int s = 0; s < 32; ++s) { const float av = hp[4 * s];
                acc0 = __builtin_amdgcn_mfma_f32_16x16x4f32(av, pb0[s], acc0, 0, 0, 0);
                if (MODE == 1) acc1 = __builtin_amdgcn_mfma_f32_16x16x4f32(av, pb1[s], acc1, 0, 0, 0); }
#pragma unroll
            for (int j = 0; j < 4; ++j) { red[(w * 16 + 4 * quad + j) * 32 + r16] = acc0[j]; if (MODE == 1) red[(w * 16 + 4 * quad + j) * 32 + 16 + r16] = acc1[j]; }
        }
        __syncthreads();
        if (MODE == 0) {
            if (F.tid < 256) {
                const int lr = F.tid >> 4, col = F.tid & 15;
                float sacc = 0.f;
#pragma unroll
                for (int w = 0; w < 8; ++w) sacc += red[(w * 16 + lr) * 32 + col];
                WSP(float, WS_CAB)[(size_t)(gi * 16 + lr) * 16 + col] = sacc;
            }
        } else {
            const int lr = F.tid >> 5, e = F.tid & 31, r = gi * 16 + lr;
            float sacc = 0.f;
#pragma unroll
            for (int w = 0; w < 8; ++w) sacc += red[(w * 16 + lr) * 32 + e];
            const float lg = sacc + F.in[I_BRT][l * NEXP + e];
            float tv0, tv1, tv2, tv3; int ti0, ti1, ti2, ti3; bool taken = false;
#define TOP1(TV, TI) do { float bv = taken ? -INFINITY : lg; int bi = e; \
                _Pragma("unroll") for (int off = 16; off >= 1; off >>= 1) { const float ov = __shfl_xor(bv, off); const int oi = __shfl_xor(bi, off); \
                    if (ov > bv || (ov == bv && oi < bi)) { bv = ov; bi = oi; } } \
                TV = bv; TI = bi; if (bi == e) taken = true; } while (0)
            TOP1(tv0, ti0); TOP1(tv1, ti1); TOP1(tv2, ti2); TOP1(tv3, ti3);
#undef TOP1
            const float e1 = __expf(tv1 - tv0), e2 = __expf(tv2 - tv0), e3 = __expf(tv3 - tv0);
            const float inv = 1.f / (1.f + e1 + e2 + e3);
            const int my_e = e == 0 ? ti0 : (e == 1 ? ti1 : (e == 2 ? ti2 : ti3));
            const float my_w = e == 0 ? inv : (e == 1 ? e1 * inv : (e == 2 ? e2 * inv : e3 * inv));
            int pl = 0;
            if (e < 4) pl = atomicAdd((int*)&lcnt[my_e], 1);
            __syncthreads();
            if (F.tid < 32) { const int c = lcnt[F.tid]; lbase[F.tid] = c > 0 ? (int)__hip_atomic_fetch_add(F.ctl + CW_CNT + l * 32 + F.tid, (unsigned)c, __ATOMIC_RELAXED, __HIP_MEMORY_SCOPE_AGENT) : 0; }
            __syncthreads();
            if (e < 4) { const int p = lbase[my_e] + pl;
                WSP(int, WS_LIST)[(size_t)my_e * MROWS + p] = r * 4 + e;
                WSP(int, WS_SEP)[r * 4 + e] = (my_e << 20) | p;
                WSP(float, WS_SW)[r * 4 + e] = my_w; }
        }
        __syncthreads();
    }
}

__device__ __forceinline__ void moe_table(Frame& F, int l) {
    LAS int* tpre = (LAS int*)(F.lds + MISC_OFF + 256);
    LAS int* cnt = tpre + 40;
    __syncthreads();
    if (F.tid < 32) cnt[F.tid] = (int)__hip_atomic_load(F.ctl + CW_CNT + l * 32 + F.tid, __ATOMIC_RELAXED, __HIP_MEMORY_SCOPE_AGENT);
    __syncthreads();
    if (F.tid == 0) { int s = 0; for (int e = 0; e < 32; ++e) { tpre[e] = s; s += (cnt[e] + 255) >> 8; } tpre[32] = s; }
    __syncthreads();
}
__device__ __forceinline__ void moe_gather(Frame& F, int l) {
    moe_table(F, l);
    const LAS int* tpre = (const LAS int*)(F.lds + MISC_OFF + 256);
    const LAS int* cnt = tpre + 40;
    const int gw = F.bid * NWAVES + F.wave, NGW = F.G * NWAVES;
    REFRESH_TID(F);
    for (int pb_ = gw; pb_ < MROWS; pb_ += NGW) {
        for (int e0 = 0; e0 < NEXP; e0 += 4) {
            int tk[4]; v4u ra[4], rb[4];
#pragma unroll
            for (int k = 0; k < 4; ++k) tk[k] = pb_ < cnt[e0 + k] ? WSP(int, WS_LIST)[(size_t)(e0 + k) * MROWS + pb_] : -1;
#pragma unroll
            for (int k = 0; k < 4; ++k) { const int tok = tk[k] >= 0 ? tk[k] >> 2 : 0; const v4u* src = (const v4u*)(WSP(bf16, WS_H) + (size_t)tok * D); ra[k] = src[F.lane]; rb[k] = src[F.lane + 64]; }
#pragma unroll
            for (int k = 0; k < 4; ++k) if (tk[k] >= 0) { const int dr = tpre[e0 + k] * 256 + pb_; v4u* dst = (v4u*)(WSP(bf16, WS_HS) + (size_t)dr * D); dst[F.lane] = ra[k]; dst[F.lane + 64] = rb[k];
                    if (F.lane == 0) WSP(int, WS_SROW)[tk[k]] = dr; }
        }
        bool more = false;
        for (int e = 0; e < NEXP; ++e) more |= pb_ + NGW < cnt[e];
        if (!more) break;
    }
}


constexpr int AT_KP = 72, AT_VP = 68;
constexpr int AT_KB = 64 * AT_KP * 2, AT_VB = 64 * AT_VP * 2, AT_BUF = AT_KB + AT_VB;
constexpr int AT_RPB = 2 * AT_BUF;

__device__ __forceinline__ float max3f_(float a, float b, float c) { float r; asm("v_max3_f32 %0, %1, %2, %3" : "=v"(r) : "v"(a), "v"(b), "v"(c)); return r; }
struct AttnUnit {
    int kind;
    int b, hx, qx;
};

__device__ __forceinline__ void attn_unit(Frame& F, int l, const AttnUnit un) {
    REFRESH_TID(F);
    const int lane = F.lane, w = F.wave, q32 = lane & 31, hh = lane >> 5;
    const bf16* U = WSP(bf16, WS_U);
    const bool na = (un.kind & 1) != 0, ctxq = un.kind >= 2;
    const int b = un.b;
    int qrow0, qcol, kcol, ycol, nlat, krow_lat0, r_grid = 0, c0 = 0, rs_w = 0;
    const bf16* vt; bf16* Y;
    if (!na) {
        const int head = 4 * un.hx + (w & 3);
        qrow0 = (ctxq ? TLAT + b * LCTX : b * SEQ) + 64 * un.qx + 32 * (w >> 2);
        qcol = UQ + head * 64; kcol = UK + un.hx * 64; ycol = head * 64;
        vt = WSP(bf16, WS_VAT) + (size_t)(b * 2 + un.hx) * 64 * KEYS;
        Y = WSP(bf16, WS_Y);
        nlat = ctxq ? 0 : 64; krow_lat0 = b * SEQ;
    } else {
        const int head = un.hx;
        if (ctxq) { qrow0 = TLAT + b * LCTX + 32 * w; nlat = 0; krow_lat0 = 0; }
        else {
            r_grid = 4 * un.qx + (w >> 1); c0 = 32 * (w & 1);
            qrow0 = b * SEQ + 64 * r_grid + c0;
            int rs_min = 4 * un.qx - 4; rs_min = rs_min < 0 ? 0 : (rs_min > 56 ? 56 : rs_min);
            int rs_max = 4 * un.qx + 3 - 4; rs_max = rs_max < 0 ? 0 : (rs_max > 56 ? 56 : rs_max);
            nlat = rs_max + 8 - rs_min; krow_lat0 = b * SEQ + 64 * rs_min;
            rs_w = r_grid - 4; rs_w = rs_w < 0 ? 0 : (rs_w > 56 ? 56 : rs_w);
            rs_w -= rs_min;
        }
        qcol = UDQ + head * 64; kcol = UDK + head * 64; ycol = head * 64;
        vt = WSP(bf16, WS_VDT) + (size_t)(b * 8 + head) * 64 * KEYS;
        Y = WSP(bf16, WS_Y) + (size_t)3 * MROWS * 512;
    }
    const int vkey_lat0 = krow_lat0 - b * SEQ;
    const int ntile = nlat + 4;
    LAS unsigned char* lds = F.lds;
    if (na && !ctxq) {
        LAS float* rp = (LAS float*)(lds + AT_RPB);
        const float* src = F.in[I_RPB] + ((size_t)l * 8 + un.hx) * 465;
        for (int i = F.tid; i < 465; i += NT) rp[i] = src[i] * LOG2E;
    }
    bf16x8 qf[4];
    {
        const bf16* qp = U + (size_t)(qrow0 + q32) * UW + qcol + 8 * hh;
#pragma unroll
        for (int s = 0; s < 4; ++s) qf[s] = *(const bf16x8*)(qp + 16 * s);
        if (na) {
#pragma unroll
            for (int s = 0; s < 4; ++s) { v4u t = __builtin_bit_cast(v4u, qf[s]); const float sc = 0.125f * LOG2E;
                t.x = pk2(bflo(t.x) * sc, bfhi(t.x) * sc); t.y = pk2(bflo(t.y) * sc, bfhi(t.y) * sc); t.z = pk2(bflo(t.z) * sc, bfhi(t.z) * sc); t.w = pk2(bflo(t.w) * sc, bfhi(t.w) * sc);
                qf[s] = __builtin_bit_cast(bf16x8, t); }
        }
    }
    const int lk = F.tid >> 3, lc = F.tid & 7;
    v4u kr[4], vr[4];
#define AT_TILE_ADDR(i, krow0_, vkey0_) do { const int i_ = (i) < ntile ? (i) : ntile - 1; \
        if (i_ < nlat) { krow0_ = krow_lat0 + 64 * i_; vkey0_ = vkey_lat0 + 64 * i_; } else { krow0_ = TLAT + b * LCTX + 64 * (i_ - nlat); vkey0_ = SEQ + 64 * (i_ - nlat); } } while (0)
#define AT_LDK(dst, i) do { int kr0_, vk0_; AT_TILE_ADDR(i, kr0_, vk0_); (void)vk0_; dst = *(const v4u*)(U + (size_t)(kr0_ + lk) * UW + kcol + lc * 8); } while (0)
#define AT_LDV(dst, i) do { int kr0_, vk0_; AT_TILE_ADDR(i, kr0_, vk0_); (void)kr0_; dst = *(const v4u*)(vt + (size_t)lk * KEYS + vk0_ + lc * 8); } while (0)
#define AT_STK(src, buf) do { *(LAS v4u*)(lds + (buf) * AT_BUF + lk * (AT_KP * 2) + lc * 16) = src; } while (0)
#define AT_STV(src, buf) do { LAS unsigned char* b_ = lds + (buf) * AT_BUF + AT_KB + lk * (AT_VP * 2) + lc * 16; *(LAS v2u*)b_ = (v2u){src.x, src.y}; *(LAS v2u*)(b_ + 8) = (v2u){src.z, src.w}; } while (0)
    float m_run = 0.f, l_run = 0.f;
    f32x16 negm;
#pragma unroll
    for (int i = 0; i < 16; ++i) negm[i] = 0.f;
    bool first = true;
    f32x16 o0, o1;
#pragma unroll
    for (int i = 0; i < 16; ++i) { o0[i] = 0.f; o1[i] = 0.f; }
    const int cq = c0 + q32;
    int cst = cq - 8; cst = cst < 0 ? 0 : (cst > 48 ? 48 : cst);
#define AT_ACTIVE(i) (!(na && !ctxq && (i) < nlat && ((i) < rs_w || (i) > rs_w + 7)))
#define AT_QK(S0, S1, buf) do { const LAS unsigned char* kb_ = lds + (buf) * AT_BUF; \
        _Pragma("unroll") for (int s = 0; s < 4; ++s) { \
            const bf16x8 k0 = *(const LAS bf16x8*)(kb_ + (q32) * (AT_KP * 2) + (16 * s + 8 * hh) * 2); \
            const bf16x8 k1 = *(const LAS bf16x8*)(kb_ + (32 + q32) * (AT_KP * 2) + (16 * s + 8 * hh) * 2); \
            S0 = __builtin_amdgcn_mfma_f32_32x32x16_bf16(k0, qf[s], s == 0 ? negm : S0, 0, 0, 0); \
            S1 = __builtin_amdgcn_mfma_f32_32x32x16_bf16(k1, qf[s], s == 0 ? negm : S1, 0, 0, 0); } } while (0)
#define AT_SOFTMAX_PV(C0, C1, N0, N1, nvalid, i, vbuf) do { \
        if (na && !ctxq && (i) < nlat) { \
            const LAS float* rp = (const LAS float*)(lds + AT_RPB); \
            const int kr_ = (krow_lat0 - b * SEQ) / 64 + (i); const int rb = (kr_ - r_grid + 7) * 31 + 15 - cq; \
            _Pragma("unroll") for (int j = 0; j < 16; ++j) { \
                const int kc0 = (j & 3) + 8 * (j >> 2) + 4 * hh, kc1 = kc0 + 32; \
                const bool ok0 = kc0 >= cst && kc0 < cst + 16, ok1 = kc1 >= cst && kc1 < cst + 16; \
                int i0_ = rb + kc0, i1_ = rb + kc1; i0_ = i0_ < 0 ? 0 : (i0_ > 464 ? 464 : i0_); i1_ = i1_ < 0 ? 0 : (i1_ > 464 ? 464 : i1_); \
                const float b0 = rp[i0_], b1 = rp[i1_]; \
                C0[j] = ok0 ? C0[j] + b0 : -1e30f; C1[j] = ok1 ? C1[j] + b1 : -1e30f; } } \
        float mx = max3f_(C0[0], C1[0], C0[1]); \
        mx = max3f_(mx, C1[1], C0[2]); mx = max3f_(mx, C1[2], C0[3]); mx = max3f_(mx, C1[3], C0[4]); mx = max3f_(mx, C1[4], C0[5]); mx = max3f_(mx, C1[5], C0[6]); \
        mx = max3f_(mx, C1[6], C0[7]); mx = max3f_(mx, C1[7], C0[8]); mx = max3f_(mx, C1[8], C0[9]); mx = max3f_(mx, C1[9], C0[10]); mx = max3f_(mx, C1[10], C0[11]); \
        mx = max3f_(mx, C1[11], C0[12]); mx = max3f_(mx, C1[12], C0[13]); mx = max3f_(mx, C1[13], C0[14]); mx = max3f_(mx, C1[14], C0[15]); mx = fmaxf(mx, C1[15]); \
        mx = fmaxf(mx, __shfl_xor(mx, 32)); \
        if (first || __builtin_amdgcn_ballot_w64(mx > 6.f) != 0ull) {     \
            const float d = first ? fmaxf(mx, -120.f) : fmaxf(mx, 0.f); \
            const float alpha = __builtin_amdgcn_exp2f(-d); \
            l_run *= alpha; m_run += d; \
            _Pragma("unroll") for (int j = 0; j < 16; ++j) { o0[j] *= alpha; o1[j] *= alpha; C0[j] -= d; C1[j] -= d; negm[j] = -m_run; } \
            if (nvalid) { _Pragma("unroll") for (int j = 0; j < 16; ++j) { N0[j] -= d; N1[j] -= d; } } \
            first = false; } \
        float ps = 0.f; \
        _Pragma("unroll") for (int j = 0; j < 16; ++j) { C0[j] = __builtin_amdgcn_exp2f(C0[j]); C1[j] = __builtin_amdgcn_exp2f(C1[j]); ps += C0[j]; ps += C1[j]; } \
        l_run += ps; \
        bf16x8 pb[2][2]; \
        _Pragma("unroll") for (int s2 = 0; s2 < 2; ++s2) { v4u t0, t1; \
            t0.x = pk2(C0[8 * s2 + 0], C0[8 * s2 + 1]); t0.y = pk2(C0[8 * s2 + 2], C0[8 * s2 + 3]); t0.z = pk2(C0[8 * s2 + 4], C0[8 * s2 + 5]); t0.w = pk2(C0[8 * s2 + 6], C0[8 * s2 + 7]); \
            t1.x = pk2(C1[8 * s2 + 0], C1[8 * s2 + 1]); t1.y = pk2(C1[8 * s2 + 2], C1[8 * s2 + 3]); t1.z = pk2(C1[8 * s2 + 4], C1[8 * s2 + 5]); t1.w = pk2(C1[8 * s2 + 6], C1[8 * s2 + 7]); \
            pb[0][s2] = __builtin_bit_cast(bf16x8, t0); pb[1][s2] = __builtin_bit_cast(bf16x8, t1); } \
        const LAS unsigned char* vb_ = lds + (vbuf) * AT_BUF + AT_KB; \
        _Pragma("unroll") for (int sub = 0; sub < 2; ++sub) _Pragma("unroll") for (int s2 = 0; s2 < 2; ++s2) { \
            const int ko = (32 * sub + 16 * s2 + 4 * hh) * 2; \
            const v2u a0 = *(const LAS v2u*)(vb_ + (q32) * (AT_VP * 2) + ko), a1 = *(const LAS v2u*)(vb_ + (q32) * (AT_VP * 2) + ko + 16); \
            const v2u c0_ = *(const LAS v2u*)(vb_ + (32 + q32) * (AT_VP * 2) + ko), c1_ = *(const LAS v2u*)(vb_ + (32 + q32) * (AT_VP * 2) + ko + 16); \
            const bf16x8 vf0 = __builtin_bit_cast(bf16x8, ((v4u){a0.x, a0.y, a1.x, a1.y})); \
            const bf16x8 vf1 = __builtin_bit_cast(bf16x8, ((v4u){c0_.x, c0_.y, c1_.x, c1_.y})); \
            o0 = __builtin_amdgcn_mfma_f32_32x32x16_bf16(vf0, pb[sub][s2], o0, 0, 0, 0); \
            o1 = __builtin_amdgcn_mfma_f32_32x32x16_bf16(vf1, pb[sub][s2], o1, 0, 0, 0); } } while (0)
    f32x16 sa0, sa1, sb0, sb1;
    {
        v4u k0r, k1r, v0r; AT_LDK(k0r, 0); AT_LDK(k1r, 1); AT_LDV(v0r, 0);
#pragma unroll
        for (int st = 0; st < 4; ++st) { AT_LDK(kr[st], st + 2); AT_LDV(vr[st], st + 1); }
        AT_STK(k0r, 0); AT_STK(k1r, 1); AT_STV(v0r, 0);
        lds_barrier();
        if (AT_ACTIVE(0)) AT_QK(sa0, sa1, 0);
        lds_barrier();
    }
    const int ntile4 = (ntile + 3) & ~3;
#pragma unroll 1
    for (int i0 = 0; i0 < ntile4; i0 += 4) {
#pragma unroll
      for (int st = 0; st < 4; ++st) {
        const int i = i0 + st;
        AT_STK(kr[st], st & 1); AT_STV(vr[st], (st + 1) & 1);
        AT_LDK(kr[st], i + 6); AT_LDV(vr[st], i + 5);
        const bool nvalid = (i + 1 < ntile) && AT_ACTIVE(i + 1);
        if (st & 1) { if (nvalid) AT_QK(sa0, sa1, 0); if (i < ntile && AT_ACTIVE(i)) AT_SOFTMAX_PV(sb0, sb1, sa0, sa1, nvalid, i, 1); }
        else        { if (nvalid) AT_QK(sb0, sb1, 1); if (i < ntile && AT_ACTIVE(i)) AT_SOFTMAX_PV(sa0, sa1, sb0, sb1, nvalid, i, 0); }
        lds_barrier();
      }
    }
#undef AT_TILE_ADDR
#undef AT_LDK
#undef AT_LDV
#undef AT_STK
#undef AT_STV
#undef AT_ACTIVE
#undef AT_QK
#undef AT_SOFTMAX_PV
    const float lt = l_run + __shfl_xor(l_run, 32);
    const float inv = 1.f / lt;
    bf16* yp = Y + (size_t)(qrow0 + q32) * 512 + ycol + 4 * hh;
#pragma unroll
    for (int g = 0; g < 4; ++g) {
        v2u a; a.x = pk2(o0[4 * g] * inv, o0[4 * g + 1] * inv); a.y = pk2(o0[4 * g + 2] * inv, o0[4 * g + 3] * inv);
        v2u c; c.x = pk2(o1[4 * g] * inv, o1[4 * g + 1] * inv); c.y = pk2(o1[4 * g + 2] * inv, o1[4 * g + 3] * inv);
        *(v2u*)(yp + 8 * g) = a; *(v2u*)(yp + 32 + 8 * g) = c;
    }
    __syncthreads();
}

__device__ __forceinline__ void attn_phase(Frame& F, int l) {
    const int x = F.bid & 7, y = F.bid >> 3, ny = F.G >> 3;
    for (int q = y; q < 64; q += ny) { AttnUnit un; un.kind = 0; un.b = x >> 1; un.hx = x & 1; un.qx = q; attn_unit(F, l, un); }
    for (int q = y; q < 64; q += ny) { const int combo = x + 8 * (q >> 4); AttnUnit un; un.kind = 1; un.b = combo >> 3; un.hx = combo & 7; un.qx = q & 15; attn_unit(F, l, un); }
    for (int q = y; q < 8; q += ny) { AttnUnit un;
        if (q < 4) { un.kind = 2; un.b = x >> 1; un.hx = x & 1; un.qx = q; }
        else { const int combo = x + 8 * (q - 4); un.kind = 3; un.b = combo >> 3; un.hx = combo & 7; un.qx = 0; }
        attn_unit(F, l, un); }
}


__device__ __forceinline__ void qk_prep(Frame& F, int l) {
    REFRESH_TID(F);
    const int gw = F.bid * NWAVES + F.wave, NGW = F.G * NWAVES, lane = F.lane;
    bf16* U = WSP(bf16, WS_U);
    const float* tab = WSP(float, WS_ROPE);
    const int d0 = (lane & 7) * 8;
    float gq[8], gk[8];
#pragma unroll
    for (int j = 0; j < 8; ++j) { gq[j] = F.in[I_AGQ][l * 64 + d0 + j]; gk[j] = F.in[I_AGK][l * 64 + d0 + j]; }
    for (int r0 = gw; r0 < MROWS; r0 += 2 * NGW) {
        const int r1 = r0 + NGW;
        v4u qv2[2], kv2[2];
#pragma unroll
        for (int k = 0; k < 2; ++k) { const int r = k ? (r1 < MROWS ? r1 : r0) : r0; const bf16* up = U + (size_t)r * UW;
            qv2[k] = *(const v4u*)(up + UQ + lane * 8); kv2[k] = (v4u){0u, 0u, 0u, 0u}; if (lane < 16) kv2[k] = *(const v4u*)(up + UK + lane * 8); }
#pragma unroll
        for (int k = 0; k < 2; ++k) {
        const int r = k ? r1 : r0; if (r >= MROWS) break;
        const bool lat = r < TLAT;
        bf16* up = U + (size_t)r * UW;
        const v4u qv = qv2[k], kv = kv2[k];
        float cs[8], sn[8];
#pragma unroll
        for (int j = 0; j < 8; ++j) { cs[j] = 1.f; sn[j] = 0.f; }
        if (lat) { const int t = r & 4095;
#pragma unroll
            for (int j = 0; j < 8; ++j) { const int i = (d0 + j) & 31; const int idx = i < 16 ? (t >> 6) * 16 + i : (t & 63) * 16 + (i - 16); cs[j] = tab[idx]; sn[j] = tab[1024 + idx]; } }
#pragma unroll
        for (int which = 0; which < 2; ++which) {
            const v4u raw = which ? kv : qv;
            float x[8] = {bflo(raw.x), bfhi(raw.x), bflo(raw.y), bfhi(raw.y), bflo(raw.z), bfhi(raw.z), bflo(raw.w), bfhi(raw.w)};
            float ss = 0.f;
#pragma unroll
            for (int j = 0; j < 8; ++j) ss += x[j] * x[j];
            ss += __shfl_xor(ss, 1); ss += __shfl_xor(ss, 2); ss += __shfl_xor(ss, 4);
            const float rs = rsqrtf(ss * (1.f / 64.f) + EPS);
            float y[8];
#pragma unroll
            for (int j = 0; j < 8; ++j) y[j] = x[j] * rs * (which ? gk[j] : gq[j]);
            const bool hi = (lane & 4) != 0;
#pragma unroll
            for (int j = 0; j < 8; ++j) { const float p = __shfl_xor(y[j], 4);
                if (lat) y[j] = hi ? y[j] * cs[j] + p * sn[j] : y[j] * cs[j] - p * sn[j];
                if (!which) y[j] *= 0.125f * LOG2E; }
            v4u o; o.x = pk2(y[0], y[1]); o.y = pk2(y[2], y[3]); o.z = pk2(y[4], y[5]); o.w = pk2(y[6], y[7]);
            if (!which) *(v4u*)(up + UQ + lane * 8) = o; else if (lane < 16) *(v4u*)(up + UK + lane * 8) = o;
        }
        }
    }
}

__device__ __forceinline__ void v_transpose(Frame& F) {
    REFRESH_TID(F);
    const int gw = F.bid * NWAVES + F.wave, NGW = F.G * NWAVES, lane = F.lane;
    LAS bf16* T = (LAS bf16*)(F.lds + F.wave * 9216);
    const bf16* U = WSP(bf16, WS_U);
    for (int it = gw; it < NCHUNK * 10; it += NGW) {
        const int g = it / 10, hd = it % 10;
        int b, key0;
        if (g < 256) { b = g >> 6; key0 = (g & 63) * 64; } else { b = (g - 256) >> 2; key0 = SEQ + ((g - 256) & 3) * 64; }
        const int scol = hd < 2 ? UV + hd * 64 : UDV + (hd - 2) * 64;
        bf16* dst = hd < 2 ? WSP(bf16, WS_VAT) + (size_t)(b * 2 + hd) * 64 * KEYS : WSP(bf16, WS_VDT) + (size_t)(b * 8 + hd - 2) * 64 * KEYS;
        v4u rv[8];
#pragma unroll
        for (int i = 0; i < 8; ++i) { const int tok = 8 * i + (lane >> 3), ch = lane & 7; rv[i] = *(const v4u*)(U + (size_t)(64 * g + tok) * UW + scol + ch * 8); }
#pragma unroll
        for (int i = 0; i < 8; ++i) { const int tok = 8 * i + (lane >> 3), ch = lane & 7; const unsigned wv[4] = {rv[i].x, rv[i].y, rv[i].z, rv[i].w};
#pragma unroll
            for (int j = 0; j < 4; ++j) { T[(ch * 8 + 2 * j) * 72 + tok] = (bf16)(wv[j] & 0xffffu); T[(ch * 8 + 2 * j + 1) * 72 + tok] = (bf16)(wv[j] >> 16); } }
        asm volatile("s_waitcnt lgkmcnt(0)" ::: "memory");
#pragma unroll
        for (int i = 0; i < 8; ++i) { const int d = 8 * i + (lane >> 3), ch = lane & 7;
            const v4u o = *(const LAS v4u*)(T + d * 72 + ch * 8);
            *(v4u*)(dst + (size_t)d * KEYS + key0 + ch * 8) = o; }
        asm volatile("s_waitcnt lgkmcnt(0)" ::: "memory");
    }
}

constexpr int LR_XCB = 0, LR_WV = 17408, LR_WVB = 12288;
__device__ __forceinline__ void seq_bounds(int g, int& lo, int& hi) {
    if (g < 256) { lo = (g >> 6) * SEQ; hi = lo + SEQ; } else { lo = TLAT + ((g - 256) >> 2) * LCTX; hi = lo + LCTX; }
}
struct LruRaw { v4u r[3]; };
__device__ __forceinline__ void lru_raw_load(Frame& F, LruRaw& R, int g, int q) {
    const bf16* U = WSP(bf16, WS_U);
    int lo, hi; seq_bounds(g, lo, hi);
#pragma unroll
    for (int k = 0; k < 3; ++k) { const int i = F.tid + NT * k, rr = i >> 4, ch = i & 15, row = 64 * g - 1 + rr;
        v4u v = (v4u){0u, 0u, 0u, 0u};
        if (i < 67 * 16 && row >= lo && row < hi) v = *(const v4u*)(U + (size_t)row * UW + UBX + 128 * q + ch * 8);
        R.r[k] = v; }
}
__device__ __forceinline__ void lru_stage_conv(Frame& F, int l, const LruRaw& R, int q) {
    LAS bf16* raw = (LAS bf16*)(F.lds + LR_WV);
    LAS bf16* xcb = (LAS bf16*)(F.lds + LR_XCB);
    lds_barrier();
#pragma unroll
    for (int k = 0; k < 3; ++k) { const int i = F.tid + NT * k, rr = i >> 4, ch = i & 15; if (i < 67 * 16) *(LAS v4u*)(raw + rr * 128 + ch * 8) = R.r[k]; }
    lds_barrier();
    {
        const int ch = F.tid & 127, tg = F.tid >> 7, cabs = 128 * q + ch;
        const float* cw = F.in[I_BCW] + (size_t)l * 4 * 512 + cabs;
        const float w0 = cw[0], w1 = cw[512], w2 = cw[1024], w3 = cw[1536], bb = F.in[I_BCB][l * 512 + cabs];
        float x0 = bf2f(raw[(16 * tg) * 128 + ch]), x1 = bf2f(raw[(16 * tg + 1) * 128 + ch]), x2 = bf2f(raw[(16 * tg + 2) * 128 + ch]);
#pragma unroll
        for (int t = 0; t < 16; ++t) { const float x3 = bf2f(raw[(16 * tg + t + 3) * 128 + ch]);
            const float y = bb + w0 * x0 + w1 * x1 + w2 * x2 + w3 * x3;
            xcb[(16 * tg + t) * 136 + ch] = (bf16)f2bf(y);
            x0 = x1; x1 = x2; x2 = x3; }
    }
    lds_barrier();
}
struct LruW { bf16x8 br0, br1, bi0, bi1; float bR, bI, lam; };
__device__ __forceinline__ void lru_w_load(Frame& F, LruW& W, int l, int dir, int q) {
    const int lane = F.lane, w = F.wave, r16 = lane & 15, quad = lane >> 4;
    const int nbl = w >> 2, dt = w & 3, nb = 2 * q + nbl;
    const bf16* wr = WSP(bf16, WS_LRUW) + ((((size_t)(l * 2 + dir) * 2 + 0) * 8 + nb) * 64 + 16 * dt + r16) * 64 + 8 * quad;
    const bf16* wi = WSP(bf16, WS_LRUW) + ((((size_t)(l * 2 + dir) * 2 + 1) * 8 + nb) * 64 + 16 * dt + r16) * 64 + 8 * quad;
    W.br0 = *(const bf16x8*)wr; W.br1 = *(const bf16x8*)(wr + 32); W.bi0 = *(const bf16x8*)wi; W.bi1 = *(const bf16x8*)(wi + 32);
    const int cabs = 64 * nb + 16 * dt + r16;
    W.bR = F.in[I_BBR][(l * 2 + dir) * 512 + cabs]; W.bI = F.in[I_BBI][(l * 2 + dir) * 512 + cabs]; W.lam = F.in[I_BLAM][(l * 2 + dir) * 512 + cabs];
}
__device__ __forceinline__ void lru_gates(Frame& F, const LruW& W) {
    const int lane = F.lane, w = F.wave, r16 = lane & 15, quad = lane >> 4;
    const LAS bf16* xcb = (const LAS bf16*)(F.lds + LR_XCB);
    LAS float* sa = (LAS float*)(F.lds + LR_WV + w * LR_WVB);
    LAS float* sb = sa + 1024;
    const int nbl = w >> 2, dt = w & 3;
    const int cl = 64 * nbl + 16 * dt + r16;
    const float sp = softplusf_(-W.lam);
#pragma unroll
    for (int tt = 0; tt < 4; ++tt) {
        const LAS bf16* ap = xcb + (16 * tt + r16) * 136 + 64 * nbl + 8 * quad;
        const bf16x8 a0 = *(const LAS bf16x8*)ap, a1 = *(const LAS bf16x8*)(ap + 32);
        f32x4 ar = (f32x4){0.f, 0.f, 0.f, 0.f}, ai = ar;
        ar = __builtin_amdgcn_mfma_f32_16x16x32_bf16(a0, W.br0, ar, 0, 0, 0); ar = __builtin_amdgcn_mfma_f32_16x16x32_bf16(a1, W.br1, ar, 0, 0, 0);
        ai = __builtin_amdgcn_mfma_f32_16x16x32_bf16(a0, W.bi0, ai, 0, 0, 0); ai = __builtin_amdgcn_mfma_f32_16x16x32_bf16(a1, W.bi1, ai, 0, 0, 0);
#pragma unroll
        for (int j = 0; j < 4; ++j) { const int t = 16 * tt + 4 * quad + j;
            const float rg = sigmoidf_(ar[j] + W.bR), ig = sigmoidf_(ai[j] + W.bI);
            const float la = -8.f * rg * sp;
            const float a = __expf(la), x2 = 2.f * la;
            const float om = x2 > -0.05f ? -x2 * (1.f + x2 * (0.5f + x2 * (0.16666667f + x2 * 0.041666668f))) : 1.f - __expf(x2);
            const float mult = __builtin_amdgcn_sqrtf(om);
            const float xv = bf2f(xcb[t * 136 + cl]);
            sa[t * 16 + r16] = a; sb[t * 16 + r16] = mult * ig * xv; }
    }
    asm volatile("s_waitcnt lgkmcnt(0)" ::: "memory");
}
__device__ __forceinline__ void lru_pass1(Frame& F, int l) {
    const bool even = F.G == 256;
    const int nit = even ? (F.bid < 64 ? 2 : 5) : (NCHUNK * 4 - F.bid + F.G - 1) / F.G;
#define LRU1_ITEM(k) (even ? (F.bid < 64 ? F.bid + 64 * (k) : 128 + (F.bid - 64) * 5 + (k)) : F.bid + F.G * (k))
    LruRaw R; REFRESH_TID(F);
    if (nit > 0) { const int i0 = LRU1_ITEM(0); lru_raw_load(F, R, i0 >> 2, i0 & 3); }
#pragma unroll 1
    for (int kk = 0; kk < nit; ++kk) {
        const int it = LRU1_ITEM(kk);
        REFRESH_TID(F);
        const int g = it >> 2, q = it & 3;
        LruW W0, W1; lru_w_load(F, W0, l, 0, q); lru_w_load(F, W1, l, 1, q);
        lru_stage_conv(F, l, R, q);
        { const int itn = kk + 1 < nit ? LRU1_ITEM(kk + 1) : it; lru_raw_load(F, R, itn >> 2, itn & 3); }
#pragma unroll
        for (int dir = 0; dir < 2; ++dir) {
            lru_gates(F, dir ? W1 : W0);
            const int lane = F.lane, w = F.wave, ch = lane & 15, seg = lane >> 4;
            const LAS float* sa = (const LAS float*)(F.lds + LR_WV + w * LR_WVB); const LAS float* sb = sa + 1024;
            float A = 1.f, B = 0.f;
#pragma unroll
            for (int k = 0; k < 16; ++k) { const int tp = 16 * seg + k, t = dir ? 63 - tp : tp; const float a = sa[t * 16 + ch]; B = a * B + sb[t * 16 + ch]; A *= a; }
            float At = 1.f, Bt = 0.f;
#pragma unroll
            for (int s = 0; s < 4; ++s) { const float As = __shfl(A, 16 * s + ch), Bs = __shfl(B, 16 * s + ch); Bt = As * Bt + Bs; At *= As; }
            if (seg == 0) { const int cabs = 128 * q + 64 * (w >> 2) + 16 * (w & 3) + ch;
                WSP(float, WS_LRA)[((size_t)g * 2 + dir) * 512 + cabs] = At; WSP(float, WS_LRB)[((size_t)g * 2 + dir) * 512 + cabs] = Bt; }
            asm volatile("s_waitcnt lgkmcnt(0)" ::: "memory");
        }
    }
}
__device__ __forceinline__ void lru_carry_all(Frame& F) {
    REFRESH_TID(F);
    if (F.tid >= 16) return;
    const float* LA = WSP(float, WS_LRA); const float* LB = WSP(float, WS_LRB); float* LC = WSP(float, WS_LRC);
    for (int chain = F.bid * 16 + F.tid; chain < 4096; chain += F.G * 16) {
        const int ch = chain & 511, dir = (chain >> 9) & 1, b = chain >> 10;
        float h = 0.f;
#pragma unroll 1
        for (int sb = 0; sb < 4; ++sb) {
            float av[17], bv[17]; size_t ix[17];
#pragma unroll
            for (int k = 0; k < 17; ++k) { const int s = sb * 17 + k; int g;
                if (s < 4) g = 256 + 4 * b + (dir ? 3 - s : s); else g = 64 * b + (dir ? 63 - (s - 4) : (s - 4));
                ix[k] = ((size_t)g * 2 + dir) * 512 + ch; av[k] = LA[ix[k]]; bv[k] = LB[ix[k]]; }
#pragma unroll
            for (int k = 0; k < 17; ++k) { LC[ix[k]] = h; h = av[k] * h + bv[k]; }
        }
    }
}
__device__ __forceinline__ float gelu_tanh(float x) { const float u = 0.7978845608028654f * (x + 0.044715f * x * x * x); return x * __builtin_amdgcn_rcpf(1.f + __expf(-2.f * u)); }
__device__ __forceinline__ void lru_pass2(Frame& F, int l) {
    int it = F.bid;
    const int nitems = (l == DEPTH - 1 ? 256 : NCHUNK) * 4;
    LruRaw R; REFRESH_TID(F);
    if (it < nitems) lru_raw_load(F, R, it >> 2, it & 3);
#pragma unroll 1
    for (; it < nitems; it += F.G) {
        REFRESH_TID(F);
        const int g = it >> 2, q = it & 3;
        const int lane = F.lane, w = F.wave, ch = lane & 15, seg = lane >> 4;
        const int cabs = 128 * q + 64 * (w >> 2) + 16 * (w & 3) + ch;
        const bf16* U = WSP(bf16, WS_U); bf16* YB = WSP(bf16, WS_Y) + (size_t)1 * MROWS * 512;
        LruW W0, W1; lru_w_load(F, W0, l, 0, q); lru_w_load(F, W1, l, 1, q);
        const float hc0 = WSP(float, WS_LRC)[((size_t)g * 2 + 0) * 512 + cabs], hc1 = WSP(float, WS_LRC)[((size_t)g * 2 + 1) * 512 + cabs];
        unsigned yraw[16];
#pragma unroll
        for (int k = 0; k < 16; ++k) yraw[k] = U[((size_t)64 * g + 16 * seg + k) * UW + UBY + cabs];
        lru_stage_conv(F, l, R, q);
        { const int itn = it + F.G < nitems ? it + F.G : it; lru_raw_load(F, R, itn >> 2, itn & 3); }
        LAS float* sa = (LAS float*)(F.lds + LR_WV + w * LR_WVB); LAS float* sb = sa + 1024; LAS float* sh = sa + 2048;
#pragma unroll
        for (int dir = 0; dir < 2; ++dir) {
            lru_gates(F, dir ? W1 : W0);
            float A = 1.f, B = 0.f;
#pragma unroll
            for (int k = 0; k < 16; ++k) { const int tp = 16 * seg + k, t = dir ? 63 - tp : tp; const float a = sa[t * 16 + ch]; B = a * B + sb[t * 16 + ch]; A *= a; }
            float h = dir ? hc1 : hc0;
#pragma unroll
            for (int s = 0; s < 3; ++s) { const float As = __shfl(A, 16 * s + ch), Bs = __shfl(B, 16 * s + ch); if (s < seg) h = As * h + Bs; }
#pragma unroll
            for (int k = 0; k < 16; ++k) { const int tp = 16 * seg + k, t = dir ? 63 - tp : tp; h = sa[t * 16 + ch] * h + sb[t * 16 + ch];
                if (dir == 0) sh[t * 16 + ch] = h; else sh[t * 16 + ch] += h; }
            asm volatile("s_waitcnt lgkmcnt(0)" ::: "memory");
        }
#pragma unroll
        for (int k = 0; k < 16; ++k) { const int t = 16 * seg + k; const size_t row = (size_t)64 * g + t;
            YB[row * 512 + cabs] = (bf16)f2bf(sh[t * 16 + ch] * gelu_tanh(bflo(yraw[k]))); }
        asm volatile("s_waitcnt lgkmcnt(0)" ::: "memory");
    }
}

#ifndef GDN_PREP_REPS
#define GDN_PREP_REPS 1
#endif
#ifdef PROBE_SUB
#define GP_T(k) do { if (PROBE_SUB == (k) && F.bid == 0) { const unsigned long long n_ = __builtin_amdgcn_s_memrealtime(); F.pr += n_ - gp_t; } gp_t = __builtin_amdgcn_s_memrealtime(); } while (0)
#else
#define GP_T(k) do { } while (0)
#endif
constexpr int GD_CW = MISC_OFF + 2048;
constexpr int GD_Q = 0, GD_K = 17408, GD_V = 34816, GD_KK = 52224, GD_QK = 68864, GD_L = 85504, GD_SM = 118272;
__device__ __forceinline__ void gdn_prep(Frame& F, int l) {
    const bf16* U = WSP(bf16, WS_U);
    const int w = F.wave;
    __syncthreads();
    for (int i = F.tid; i < 4 * 1536 / 2; i += NT) { const float* cw = F.in[I_CCW] + (size_t)l * 4 * 1536 + 2 * i; ((LAS unsigned*)(F.lds + GD_CW))[i] = pk2(cw[0], cw[1]); }
    __syncthreads();
#pragma unroll 1
    for (int it0 = F.bid; it0 < NCHUNK * 4 * GDN_PREP_REPS; it0 += F.G) {
        const int it = it0 % (NCHUNK * 4);
        int tid = F.tid; asm volatile("" : "+v"(tid));
        const int lane = tid & 63, r16 = lane & 15, quad = lane >> 4;
        const int g = it >> 2, h = it & 3;
        int lo, hi; seq_bounds(g, lo, hi);
        LAS bf16* raw = (LAS bf16*)(F.lds + GD_KK);
#ifdef PROBE_SUB
        unsigned long long gp_t = __builtin_amdgcn_s_memrealtime();
#endif
        lds_barrier();
        {
            v4u rv[7];
#pragma unroll
            for (int k = 0; k < 7; ++k) { const int i = tid + NT * k; const int ten = i / 1072, r_ = i - ten * 1072, rr = r_ >> 4, ch = r_ & 15, row = 64 * g - 1 + rr;
                const int ucol = (ten == 0 ? UCQ : (ten == 1 ? UCK : UCV)) + 128 * h;
                rv[k] = (v4u){0u, 0u, 0u, 0u};
                if (i < 3216 && row >= lo && row < hi) rv[k] = *(const v4u*)(U + (size_t)row * UW + ucol + ch * 8); }
#pragma unroll
            for (int k = 0; k < 7; ++k) { const int i = tid + NT * k; const int ten = i / 1072, r_ = i - ten * 1072, rr = r_ >> 4, ch = r_ & 15;
                if (i < 3216) *(LAS v4u*)(raw + ten * (67 * 128) + rr * 128 + ch * 8) = rv[k]; }
        }
        lds_barrier();
#pragma unroll 1
        for (int ten = 0; ten < 3; ++ten) {
            const int t = tid >> 3, ds = tid & 7;
            const LAS bf16* rawt = raw + ten * (67 * 128);
            const LAS bf16* cwl = (const LAS bf16*)(F.lds + GD_CW) + ten * 512 + 128 * h + 16 * ds;
            float y[16]; float ss = 0.f;
            {
                float xin[4][16], wv_[4][16];
#pragma unroll
                for (int j = 0; j < 4; ++j) { const v4u r0 = *(const LAS v4u*)(rawt + (t + j) * 128 + 16 * ds), r1 = *(const LAS v4u*)(rawt + (t + j) * 128 + 16 * ds + 8);
                    const v4u w0 = *(const LAS v4u*)(cwl + j * 1536), w1 = *(const LAS v4u*)(cwl + j * 1536 + 8);
                    const unsigned rv[8] = {r0.x, r0.y, r0.z, r0.w, r1.x, r1.y, r1.z, r1.w}, wq[8] = {w0.x, w0.y, w0.z, w0.w, w1.x, w1.y, w1.z, w1.w};
#pragma unroll
                    for (int q = 0; q < 8; ++q) { xin[j][2 * q] = bflo(rv[q]); xin[j][2 * q + 1] = bfhi(rv[q]); wv_[j][2 * q] = bflo(wq[q]); wv_[j][2 * q + 1] = bfhi(wq[q]); } }
#pragma unroll
                for (int jj = 0; jj < 16; ++jj) {
                    float a = 0.f;
#pragma unroll
                    for (int j = 0; j < 4; ++j) a += wv_[j][jj] * xin[j][jj];
                    a = siluf_(a); y[jj] = a; ss += a * a;
                }
            }
            float sc = 1.f;
            if (ten < 2) { ss += __shfl_xor(ss, 1); ss += __shfl_xor(ss, 2); ss += __shfl_xor(ss, 4); sc = rsqrtf(ss + EPS); if (ten == 0) sc *= 0.08838834764831845f; }
            LAS bf16* dstp = (LAS bf16*)(F.lds + (ten == 0 ? GD_Q : (ten == 1 ? GD_K : GD_V))) + t * 136 + 16 * ds;
            v4u o0, o1;
            o0.x = pk2(y[0] * sc, y[1] * sc); o0.y = pk2(y[2] * sc, y[3] * sc); o0.z = pk2(y[4] * sc, y[5] * sc); o0.w = pk2(y[6] * sc, y[7] * sc);
            o1.x = pk2(y[8] * sc, y[9] * sc); o1.y = pk2(y[10] * sc, y[11] * sc); o1.z = pk2(y[12] * sc, y[13] * sc); o1.w = pk2(y[14] * sc, y[15] * sc);
            *(LAS v4u*)dstp = o0; *(LAS v4u*)(dstp + 8) = o1;
        }
        lds_barrier();
        const LAS bf16* qs = (const LAS bf16*)(F.lds + GD_Q); const LAS bf16* ks = (const LAS bf16*)(F.lds + GD_K); const LAS bf16* vs = (const LAS bf16*)(F.lds + GD_V);
        GP_T(20);
        {
            const int mat = w >> 2, rt = w & 3;
            const LAS bf16* As = mat ? qs : ks;
            LAS float* Out = (LAS float*)(F.lds + (mat ? GD_QK : GD_KK));
            bf16x8 af[4];
#pragma unroll
            for (int s = 0; s < 4; ++s) af[s] = *(const LAS bf16x8*)(As + (16 * rt + r16) * 136 + 32 * s + 8 * quad);
#pragma unroll
            for (int ct = 0; ct < 4; ++ct) {
                f32x4 acc = (f32x4){0.f, 0.f, 0.f, 0.f};
#pragma unroll
                for (int s = 0; s < 4; ++s) { const bf16x8 bfr = *(const LAS bf16x8*)(ks + (16 * ct + r16) * 136 + 32 * s + 8 * quad);
                    acc = __builtin_amdgcn_mfma_f32_16x16x32_bf16(af[s], bfr, acc, 0, 0, 0); }
#pragma unroll
                for (int j = 0; j < 4; ++j) Out[(16 * rt + 4 * quad + j) * 65 + 16 * ct + r16] = acc[j];
            }
        }
        GP_T(21);
        int tid2 = F.tid; asm volatile("" : "+v"(tid2));
        const int dir = tid2 >> 8, dt = tid2 & 255;
        LAS float* sm = (LAS float*)(F.lds + GD_SM) + dir * 256;
        if (dt < 64) {
            const int ti = dir ? 63 - dt : dt; const size_t row = (size_t)64 * g + ti;
            const float ga = WSP(float, WS_CAB)[row * 16 + dir * 4 + h], gb = WSP(float, WS_CAB)[row * 16 + 8 + dir * 4 + h];
            const float gv = -__expf(F.in[I_CALOG][(l * 2 + dir) * 4 + h]) * softplusf_(ga + F.in[I_CDTB][(l * 2 + dir) * 4 + h]);
            float v = gv;
#pragma unroll
            for (int off = 1; off < 64; off <<= 1) { const float u = __builtin_bit_cast(float, __builtin_amdgcn_ds_bpermute(((lane - off) & 63) << 2, __builtin_bit_cast(int, v))); if (lane >= off) v += u; }
            sm[dt] = gv; sm[64 + dt] = sigmoidf_(gb); sm[128 + dt] = v; sm[192 + dt] = __expf(v);
        }
        lds_barrier();
        size_t cd;
        { int bq, cq_, stp; if (g < 256) { bq = g >> 6; cq_ = g & 63; stp = 4 + (dir ? 63 - cq_ : cq_); } else { bq = (g - 256) >> 2; cq_ = (g - 256) & 3; stp = dir ? 3 - cq_ : cq_; }
          cd = ((size_t)((bq * 4 + h) * 2 + dir)) * 68 + stp; }
        const LAS float* KK = (const LAS float*)(F.lds + GD_KK); const LAS float* QKm = (const LAS float*)(F.lds + GD_QK);
        LAS float* Ls = (LAS float*)(F.lds + GD_L) + dir * 4096;
        {
            bf16* gqk = WSP(bf16, WS_GQK) + cd * 4096;
            for (int idx = dt; idx < 4096; idx += 256) { const int i = idx >> 6, j = idx & 63; const int ti = dir ? 63 - i : i, tj = dir ? 63 - j : j;
                const float dec = j <= i ? __expf(sm[128 + i] - sm[128 + j]) : 0.f;
                Ls[idx] = j < i ? sm[64 + i] * KK[ti * 65 + tj] * dec : 0.f;
                gqk[idx] = (bf16)f2bf(QKm[ti * 65 + tj] * dec); }
        }
        lds_barrier();
        GP_T(22);
        if (F.tid < 256) {
            f32x2_t X[64];
            int ct_ = F.tid; asm volatile("" : "+v"(ct_));
            const int sdir = ct_ >> 7, cp = ct_ & 127;
            const LAS float* sms = (const LAS float*)(F.lds + GD_SM) + sdir * 256;
            const LAS float* Lss = (const LAS float*)(F.lds + GD_L) + sdir * 4096;
            size_t cds;
            { int bq, cq_, stp; if (g < 256) { bq = g >> 6; cq_ = g & 63; stp = 4 + (sdir ? 63 - cq_ : cq_); } else { bq = (g - 256) >> 2; cq_ = (g - 256) & 3; stp = sdir ? 3 - cq_ : cq_; }
              cds = ((size_t)((bq * 4 + h) * 2 + sdir)) * 68 + stp; }
            bf16* outp = WSP(bf16, WS_GW) + cds * 8192 + cp;
#pragma unroll
            for (int i = 0; i < 64; ++i) {
                const int ti = sdir ? 63 - i : i;
                const float be = sms[64 + i];
                f32x2_t a = {be * bf2f(vs[ti * 136 + cp]), be * sms[192 + i] * bf2f(ks[ti * 136 + cp])};
                f32x2_t p0 = {0.f, 0.f}, p1 = p0, p2 = p0, p3 = p0;
#pragma unroll
                for (int j = 0; j < i; ++j) { const float lv = Lss[i * 64 + j]; if ((j & 3) == 0) p0 += X[j] * lv; else if ((j & 3) == 1) p1 += X[j] * lv; else if ((j & 3) == 2) p2 += X[j] * lv; else p3 += X[j] * lv; }
                a -= (p0 + p1) + (p2 + p3);
                X[i] = a;
                outp[i * 128] = (bf16)f2bf(a.y);
                asm volatile("" ::: "memory");
            }
            v4u* up = (v4u*)(WSP(bf16, WS_GU) + cds * 8192 + (size_t)cp * 64);
#pragma unroll
            for (int q8 = 0; q8 < 8; ++q8) { v4u o; o.x = pk2(X[8 * q8].x, X[8 * q8 + 1].x); o.y = pk2(X[8 * q8 + 2].x, X[8 * q8 + 3].x); o.z = pk2(X[8 * q8 + 4].x, X[8 * q8 + 5].x); o.w = pk2(X[8 * q8 + 6].x, X[8 * q8 + 7].x); up[q8] = o; }
        }
        GP_T(23);
        {
            bf16* gqg = WSP(bf16, WS_GQG) + cd * 8192; bf16* gkd = WSP(bf16, WS_GKD) + cd * 8192;
            const float gl = sm[128 + 63];
            for (int idx = dt; idx < 8192; idx += 256) { const int i = idx >> 7, d = idx & 127; const int ti = dir ? 63 - i : i;
                gqg[idx] = (bf16)f2bf(bf2f(qs[ti * 136 + d]) * sm[192 + i]); }
            { const int i = dt & 63; const int ti = dir ? 63 - i : i; const float fk = __expf(gl - sm[128 + i]);
              for (int idx = dt; idx < 8192; idx += 256) { const int d = idx >> 6; gkd[idx] = (bf16)f2bf(bf2f(ks[ti * 136 + d]) * fk); } }
            if (dt == 0) WSP(float, WS_GGL)[cd] = __expf(gl);
        }
        GP_T(24);
    }
    __syncthreads();
}

constexpr int GS_ST = 0, GS_VN = 4352, GS_O = 8192;
struct GdnOps { bf16x8 a[4]; bf16x8 qk[2]; bf16x8 kd[2]; v2u uv; float gl; };
__device__ __forceinline__ bf16x8 ld16_asm(const void* p) { bf16x8 v; asm volatile("global_load_dwordx4 %0, %1, off" : "=v"(v) : "v"(p) : "memory"); return v; }
__device__ __forceinline__ v2u ld8_asm(const void* p) { v2u v; asm volatile("global_load_dwordx2 %0, %1, off" : "=v"(v) : "v"(p) : "memory"); return v; }
__device__ __forceinline__ float ld4_asm(const void* p) { float v; asm volatile("global_load_dword %0, %1, off" : "=v"(v) : "v"(p) : "memory"); return v; }
__device__ __forceinline__ void gdn_load_asm(Frame& F, GdnOps& o, size_t cd, int sl) {
    const int lane = F.lane, w = F.wave, r16 = lane & 15, quad = lane >> 4, rt = w & 3;
    const bf16* ap = (w < 4 ? WSP(bf16, WS_GW) : WSP(bf16, WS_GQG)) + cd * 8192 + (size_t)(16 * rt + r16) * 128 + 8 * quad;
#pragma unroll
    for (int s = 0; s < 4; ++s) o.a[s] = ld16_asm(ap + 32 * s);
    const bf16* kp = WSP(bf16, WS_GKD) + cd * 8192 + (size_t)(16 * w + r16) * 64 + 8 * quad;
    o.kd[0] = ld16_asm(kp); o.kd[1] = ld16_asm(kp + 32);
    const bf16* qp = WSP(bf16, WS_GQK) + cd * 4096 + (size_t)(16 * rt + r16) * 64 + 8 * quad;
    o.qk[0] = ld16_asm(qp); o.qk[1] = ld16_asm(qp + 32);
    o.uv = ld8_asm(WSP(bf16, WS_GU) + cd * 8192 + (size_t)(16 * sl + r16) * 64 + 16 * rt + 4 * quad);
    o.gl = ld4_asm(WSP(float, WS_GGL) + cd);
}
__device__ __forceinline__ void gdn_load(Frame& F, GdnOps& o, size_t cd, int sl) {
    const int lane = F.lane, w = F.wave, r16 = lane & 15, quad = lane >> 4, rt = w & 3;
    const bf16* ap = (w < 4 ? WSP(bf16, WS_GW) : WSP(bf16, WS_GQG)) + cd * 8192 + (size_t)(16 * rt + r16) * 128 + 8 * quad;
#pragma unroll
    for (int s = 0; s < 4; ++s) o.a[s] = *(const bf16x8*)(ap + 32 * s);
    const bf16* kp = WSP(bf16, WS_GKD) + cd * 8192 + (size_t)(16 * w + r16) * 64 + 8 * quad;
    o.kd[0] = *(const bf16x8*)kp; o.kd[1] = *(const bf16x8*)(kp + 32);
    { const bf16* qp = WSP(bf16, WS_GQK) + cd * 4096 + (size_t)(16 * rt + r16) * 64 + 8 * quad; o.qk[0] = *(const bf16x8*)qp; o.qk[1] = *(const bf16x8*)(qp + 32); }
    o.uv = *(const v2u*)(WSP(bf16, WS_GU) + cd * 8192 + (size_t)(16 * sl + r16) * 64 + 16 * rt + 4 * quad);
    o.gl = WSP(float, WS_GGL)[cd];
}
__device__ __forceinline__ size_t gdn_cd(int b, int h, int dir, int s) { return ((size_t)((b * 4 + h) * 2 + dir)) * 68 + s; }
__device__ __forceinline__ int gdn_g(int b, int dir, int s) {
    return s < 4 ? 256 + 4 * b + (dir ? 3 - s : s) : 64 * b + (dir ? 63 - (s - 4) : (s - 4)); }
__device__ __forceinline__ void gdn_scan(Frame& F, int chain) {
    REFRESH_TID(F);
    const int xq = chain & 7, yq = chain >> 3, cg = (yq >> 3) * 8 + xq, sl = yq & 7;
    const int dir = cg & 1, h = (cg >> 1) & 3, b = cg >> 3;
    const int lane = F.lane, w = F.wave, r16 = lane & 15, quad = lane >> 4, rt = w & 3;
    LAS bf16* St = (LAS bf16*)(F.lds + GS_ST); LAS bf16* VNt = (LAS bf16*)(F.lds + GS_VN);
    __syncthreads();
    for (int i = F.tid; i < (GS_VN + 2304) / 4; i += NT) ((LAS unsigned*)F.lds)[i] = 0u;
    __syncthreads();
    f32x4 sacc = (f32x4){0.f, 0.f, 0.f, 0.f};
    float* GO = WSP(float, WS_GO) + (size_t)dir * MROWS * 512;
    LAS float* Ost = (LAS float*)(F.lds + GS_O);
#define GDN_STEP(cur, s_) do { \
          \
        asm volatile("s_waitcnt vmcnt(30)" : "+v"(cur.a[0]), "+v"(cur.a[1]), "+v"(cur.a[2]), "+v"(cur.a[3]), "+v"(cur.kd[0]), "+v"(cur.kd[1]), "+v"(cur.qk[0]), "+v"(cur.qk[1]), "+v"(cur.uv), "+v"(cur.gl) :: "memory"); \
        bf16x8 sbf[4]; \
        _Pragma("unroll") for (int ks = 0; ks < 4; ++ks) sbf[ks] = *(const LAS bf16x8*)(St + r16 * 136 + 32 * ks + 8 * quad); \
        f32x4 acc = (f32x4){0.f, 0.f, 0.f, 0.f}; \
        _Pragma("unroll") for (int ks = 0; ks < 4; ++ks) acc = __builtin_amdgcn_mfma_f32_16x16x32_bf16(cur.a[ks], sbf[ks], acc, 0, 0, 0); \
        if (w < 4) { v2u o; o.x = pk2(bflo(cur.uv.x) - acc[0], bfhi(cur.uv.x) - acc[1]); o.y = pk2(bflo(cur.uv.y) - acc[2], bfhi(cur.uv.y) - acc[3]); \
            *(LAS v2u*)(VNt + r16 * 72 + 16 * rt + 4 * quad) = o; } \
        lds_barrier(); \
        const bf16x8 vb0 = *(const LAS bf16x8*)(VNt + r16 * 72 + 8 * quad), vb1 = *(const LAS bf16x8*)(VNt + r16 * 72 + 32 + 8 * quad); \
        if (w >= 4) { \
            acc = __builtin_amdgcn_mfma_f32_16x16x32_bf16(cur.qk[0], vb0, acc, 0, 0, 0); \
            acc = __builtin_amdgcn_mfma_f32_16x16x32_bf16(cur.qk[1], vb1, acc, 0, 0, 0); \
            _Pragma("unroll") for (int j = 0; j < 4; ++j) Ost[(((s_) & 3) * 64 + 16 * rt + 4 * quad + j) * 16 + r16] = acc[j]; } \
        sacc = sacc * cur.gl; \
        sacc = __builtin_amdgcn_mfma_f32_16x16x32_bf16(cur.kd[0], vb0, sacc, 0, 0, 0); \
        sacc = __builtin_amdgcn_mfma_f32_16x16x32_bf16(cur.kd[1], vb1, sacc, 0, 0, 0); \
        { v2u o; o.x = pk2(sacc[0], sacc[1]); o.y = pk2(sacc[2], sacc[3]); *(LAS v2u*)(St + r16 * 136 + 16 * w + 4 * quad) = o; } \
        lds_barrier(); \
    } while (0)
    GdnOps r0, r1, r2, r3;
    gdn_load_asm(F, r0, gdn_cd(b, h, dir, 0), sl); gdn_load_asm(F, r1, gdn_cd(b, h, dir, 1), sl); gdn_load_asm(F, r2, gdn_cd(b, h, dir, 2), sl); gdn_load_asm(F, r3, gdn_cd(b, h, dir, 3), sl);
#pragma unroll 1
    for (int s = 0; s < 68; s += 4) {
        GDN_STEP(r0, s);     gdn_load_asm(F, r0, gdn_cd(b, h, dir, (s + 4 < 68 ? s + 4 : 67)), sl);
        GDN_STEP(r1, s + 1); gdn_load_asm(F, r1, gdn_cd(b, h, dir, (s + 5 < 68 ? s + 5 : 67)), sl);
        GDN_STEP(r2, s + 2); gdn_load_asm(F, r2, gdn_cd(b, h, dir, (s + 6 < 68 ? s + 6 : 67)), sl);
        GDN_STEP(r3, s + 3);
#pragma unroll
        for (int k2 = 0; k2 < 2; ++k2) { const int idx = F.tid + 512 * k2, st = idx >> 8, i = (idx >> 2) & 63, qd = idx & 3;
            const f32x4 v = *(const LAS f32x4*)(Ost + (st * 64 + i) * 16 + 4 * qd);
            const int g = gdn_g(b, dir, s + st), ti = dir ? 63 - i : i;
            *(f32x4*)(GO + ((size_t)64 * g + ti) * 512 + h * 128 + 16 * sl + 4 * qd) = v; }
        gdn_load_asm(F, r3, gdn_cd(b, h, dir, (s + 7 < 68 ? s + 7 : 67)), sl);
    }
#undef GDN_STEP
    asm volatile("s_waitcnt vmcnt(0)" ::: "memory");
    __syncthreads();
}
template <int NCT> struct GdnOpsW { bf16x8 a[4]; bf16x8 qk[2]; bf16x8 kd[2]; v2u uv[NCT]; float gl; };
template <int NCT>
__device__ __forceinline__ void gdn_load_wide(Frame& F, GdnOpsW<NCT>& o, size_t cd, int part) {
    const int lane = F.lane, w = F.wave, r16 = lane & 15, quad = lane >> 4, rt = w & 3;
    const bf16* ap = (w < 4 ? WSP(bf16, WS_GW) : WSP(bf16, WS_GQG)) + cd * 8192 + (size_t)(16 * rt + r16) * 128 + 8 * quad;
#pragma unroll
    for (int s = 0; s < 4; ++s) o.a[s] = *(const bf16x8*)(ap + 32 * s);
    const bf16* kp = WSP(bf16, WS_GKD) + cd * 8192 + (size_t)(16 * w + r16) * 64 + 8 * quad;
    o.kd[0] = *(const bf16x8*)kp; o.kd[1] = *(const bf16x8*)(kp + 32);
    { const bf16* qp = WSP(bf16, WS_GQK) + cd * 4096 + (size_t)(16 * rt + r16) * 64 + 8 * quad; o.qk[0] = *(const bf16x8*)qp; o.qk[1] = *(const bf16x8*)(qp + 32); }
    const bf16* up = WSP(bf16, WS_GU) + cd * 8192 + (size_t)(part * NCT * 16 + r16) * 64 + 16 * rt + 4 * quad;
#pragma unroll
    for (int ct = 0; ct < NCT; ++ct) o.uv[ct] = *(const v2u*)(up + (size_t)ct * 16 * 64);
    o.gl = WSP(float, WS_GGL)[cd];
}
template <int NCT>
__device__ __forceinline__ void gdn_scan_wide(Frame& F, int cg, int part) {
    REFRESH_TID(F);
    constexpr int NC = NCT * 16, OFF_VN = NC * 136 * 2, OFF_O = OFF_VN + NC * 72 * 2;
    const int dir = cg & 1, h = (cg >> 1) & 3, b = cg >> 3;
    const int lane = F.lane, w = F.wave, r16 = lane & 15, quad = lane >> 4, rt = w & 3;
    LAS bf16* St = (LAS bf16*)(F.lds); LAS bf16* VNt = (LAS bf16*)(F.lds + OFF_VN); LAS float* Ost = (LAS float*)(F.lds + OFF_O);
    __syncthreads();
    for (int i = F.tid; i < OFF_O / 4; i += NT) ((LAS unsigned*)F.lds)[i] = 0u;
    __syncthreads();
    f32x4 sacc[NCT];
#pragma unroll
    for (int ct = 0; ct < NCT; ++ct) sacc[ct] = (f32x4){0.f, 0.f, 0.f, 0.f};
    float* GO = WSP(float, WS_GO) + (size_t)dir * MROWS * 512;
#define GDNW_STEP(cur, s_) do { \
        f32x4 acc[NCT]; \
        _Pragma("unroll") for (int ct = 0; ct < NCT; ++ct) { acc[ct] = (f32x4){0.f, 0.f, 0.f, 0.f}; \
            _Pragma("unroll") for (int ks = 0; ks < 4; ++ks) { const bf16x8 sb = *(const LAS bf16x8*)(St + (16 * ct + r16) * 136 + 32 * ks + 8 * quad); \
                acc[ct] = __builtin_amdgcn_mfma_f32_16x16x32_bf16(cur.a[ks], sb, acc[ct], 0, 0, 0); } } \
        if (w < 4) { _Pragma("unroll") for (int ct = 0; ct < NCT; ++ct) { v2u o; o.x = pk2(bflo(cur.uv[ct].x) - acc[ct][0], bfhi(cur.uv[ct].x) - acc[ct][1]); o.y = pk2(bflo(cur.uv[ct].y) - acc[ct][2], bfhi(cur.uv[ct].y) - acc[ct][3]); \
            *(LAS v2u*)(VNt + (16 * ct + r16) * 72 + 16 * rt + 4 * quad) = o; } } \
        lds_barrier(); \
        _Pragma("unroll") for (int ct = 0; ct < NCT; ++ct) { \
            const bf16x8 vb0 = *(const LAS bf16x8*)(VNt + (16 * ct + r16) * 72 + 8 * quad), vb1 = *(const LAS bf16x8*)(VNt + (16 * ct + r16) * 72 + 32 + 8 * quad); \
            if (w >= 4) { acc[ct] = __builtin_amdgcn_mfma_f32_16x16x32_bf16(cur.qk[0], vb0, acc[ct], 0, 0, 0); acc[ct] = __builtin_amdgcn_mfma_f32_16x16x32_bf16(cur.qk[1], vb1, acc[ct], 0, 0, 0); \
                _Pragma("unroll") for (int j = 0; j < 4; ++j) Ost[(16 * rt + 4 * quad + j) * NC + 16 * ct + r16] = acc[ct][j]; } \
            sacc[ct] = sacc[ct] * cur.gl; \
            sacc[ct] = __builtin_amdgcn_mfma_f32_16x16x32_bf16(cur.kd[0], vb0, sacc[ct], 0, 0, 0); \
            sacc[ct] = __builtin_amdgcn_mfma_f32_16x16x32_bf16(cur.kd[1], vb1, sacc[ct], 0, 0, 0); \
            { v2u o; o.x = pk2(sacc[ct][0], sacc[ct][1]); o.y = pk2(sacc[ct][2], sacc[ct][3]); *(LAS v2u*)(St + (16 * ct + r16) * 136 + 16 * w + 4 * quad) = o; } } \
        lds_barrier(); \
        { const int g = gdn_g(b, dir, (s_)); constexpr int TPR = NC / 16 ;   \
            for (int idx = F.tid; idx < 64 * TPR; idx += NT) { const int i = idx / TPR, c16 = (idx % TPR) * 16, ti = dir ? 63 - i : i; \
                float* gp = GO + ((size_t)64 * g + ti) * 512 + h * 128 + part * NC + c16; \
                _Pragma("unroll") for (int k4 = 0; k4 < 4; ++k4) *(f32x4*)(gp + 4 * k4) = *(const LAS f32x4*)(Ost + i * NC + c16 + 4 * k4); } } \
    } while (0)
    GdnOpsW<NCT> r0, r1;
    gdn_load_wide<NCT>(F, r0, gdn_cd(b, h, dir, 0), part); gdn_load_wide<NCT>(F, r1, gdn_cd(b, h, dir, 1), part);
#pragma unroll 1
    for (int s = 0; s < 68; s += 2) {
        GDNW_STEP(r0, s);     gdn_load_wide<NCT>(F, r0, gdn_cd(b, h, dir, (s + 2 < 68 ? s + 2 : 67)), part);
        GDNW_STEP(r1, s + 1); gdn_load_wide<NCT>(F, r1, gdn_cd(b, h, dir, (s + 3 < 68 ? s + 3 : 67)), part);
    }
#undef GDNW_STEP
    __syncthreads();
}
__device__ __forceinline__ void gdn_out(Frame& F, int l) {
    REFRESH_TID(F);
    const int gw = F.bid * NWAVES + F.wave, NGW = F.G * NWAVES, lane = F.lane;
    const float* G0 = WSP(float, WS_GO); const float* G1 = G0 + (size_t)MROWS * 512;
    const bf16* U = WSP(bf16, WS_U); bf16* YC = WSP(bf16, WS_Y) + (size_t)2 * MROWS * 512;
    const float g0 = F.in[I_CGOUT][l * 128 + 2 * lane], g1 = F.in[I_CGOUT][l * 128 + 2 * lane + 1];
    int rlo, rhi;
    const int nrows = l == DEPTH - 1 ? TLAT : MROWS;
    if (F.G == 256 && l < DEPTH - 1) { if (F.bid < 64) { rlo = 38 * F.bid; rhi = rlo + 38; } else { rlo = 2432 + 78 * (F.bid - 64); rhi = rlo + 78; } }
    else { const int per = (nrows + F.G - 1) / F.G; rlo = per * F.bid; rhi = rlo + per < nrows ? rlo + per : nrows; if (rlo > nrows) rlo = nrows; }
    for (int r0 = rlo + F.wave; r0 < rhi; r0 += 2 * NWAVES) {
        const int r1 = r0 + NWAVES < rhi ? r0 + NWAVES : r0;
        f32x2_t a[2][4], c[2][4]; unsigned zz[2][4];
#pragma unroll
        for (int k = 0; k < 2; ++k) { const int r = k ? r1 : r0;
#pragma unroll
            for (int h = 0; h < 4; ++h) { const size_t o = (size_t)r * 512 + h * 128 + 2 * lane;
                a[k][h] = *(const f32x2_t*)(G0 + o); c[k][h] = *(const f32x2_t*)(G1 + o); zz[k][h] = *(const unsigned*)(U + (size_t)r * UW + UCZ + h * 128 + 2 * lane); } }
#pragma unroll
        for (int k = 0; k < 2; ++k) { const int r = k ? r1 : r0; if (k == 1 && r1 == r0) break;
#pragma unroll
            for (int h = 0; h < 4; ++h) { const float a0 = a[k][h].x + c[k][h].x, a1 = a[k][h].y + c[k][h].y;
                const float ss = wave_sum(a0 * a0 + a1 * a1);
                const float rs = rsqrtf(ss * (1.f / 128.f) + EPS);
                *(unsigned*)(YC + (size_t)r * 512 + h * 128 + 2 * lane) = pk2(a0 * rs * g0 * siluf_(bflo(zz[k][h])), a1 * rs * g1 * siluf_(bfhi(zz[k][h]))); } }
    }
}


struct SideFr { bf16x8 a[4], b0[4], b1[4]; };
__device__ __forceinline__ void side_ld(SideFr& f, const bf16* ap, const bf16* bp0, const bf16* bp1) {
#pragma unroll
    for (int s = 0; s < 4; ++s) { f.a[s] = *(const bf16x8*)(ap + 32 * s); f.b0[s] = *(const bf16x8*)(bp0 + 32 * s); f.b1[s] = *(const bf16x8*)(bp1 + 32 * s); }
}
__device__ __forceinline__ void side_mma(f32x4& c0, f32x4& c1, const SideFr& f) {
#pragma unroll
    for (int s = 0; s < 4; ++s) { c0 = __builtin_amdgcn_mfma_f32_16x16x32_bf16(f.a[s], f.b0[s], c0, 0, 0, 0); c1 = __builtin_amdgcn_mfma_f32_16x16x32_bf16(f.a[s], f.b1[s], c1, 0, 0, 0); }
}
__device__ __forceinline__ void side_merge(Frame& F, int l) {
    REFRESH_TID(F);
    const int lane = F.lane, w = F.wave, r16 = lane & 15, quad = lane >> 4, rt = w & 3, chf = w >> 2;
    const bf16* U = WSP(bf16, WS_U);
    for (int tile = F.bid; tile < 256; tile += F.G) {
        const int row0 = TLAT + 64 * (tile >> 4) + 16 * rt, col0 = 64 * (tile & 15) + 32 * chf;
        f32x4 m0 = (f32x4){0.f, 0.f, 0.f, 0.f}, m1 = m0;
#define SM_AP(q) (WSP(bf16, WS_Y) + ((size_t)((q) >> 2) * MROWS + row0 + r16) * 512 + 8 * quad + 128 * ((q) & 3))
#define SM_BP(q) (WSP(bf16, WS_WBR) + (((size_t)l * 4 + ((q) >> 2)) * 1024 + col0 + r16) * 512 + 8 * quad + 128 * ((q) & 3))
        SideFr fa, fb;
        side_ld(fa, SM_AP(0), SM_BP(0), SM_BP(0) + (size_t)16 * 512);
#pragma unroll 1
        for (int br = 0; br < 4; ++br) {
            f32x4 c0 = (f32x4){0.f, 0.f, 0.f, 0.f}, c1 = c0;
            const int q = br * 4;
            unsigned short gr0[4], gr1[4];
#pragma unroll
            for (int j = 0; j < 4; ++j) { const bf16* gp = U + (size_t)(row0 + 4 * quad + j) * UW + UG + br * 1024 + col0 + r16; gr0[j] = gp[0]; gr1[j] = gp[16]; }
            side_ld(fb, SM_AP(q + 1), SM_BP(q + 1), SM_BP(q + 1) + (size_t)16 * 512); side_mma(c0, c1, fa);
            side_ld(fa, SM_AP(q + 2), SM_BP(q + 2), SM_BP(q + 2) + (size_t)16 * 512); side_mma(c0, c1, fb);
            side_ld(fb, SM_AP(q + 3), SM_BP(q + 3), SM_BP(q + 3) + (size_t)16 * 512); side_mma(c0, c1, fa);
            { const int qn = q + 4 < 16 ? q + 4 : 15; side_ld(fa, SM_AP(qn), SM_BP(qn), SM_BP(qn) + (size_t)16 * 512); }
            side_mma(c0, c1, fb);
#pragma unroll
            for (int j = 0; j < 4; ++j) { m0[j] += sigmoidf_(bf2f(gr0[j])) * c0[j]; m1[j] += sigmoidf_(bf2f(gr1[j])) * c1[j]; }
        }
#undef SM_AP
#undef SM_BP
#pragma unroll
        for (int j = 0; j < 4; ++j) { bf16* mp = WSP(bf16, WS_MB) + (size_t)(row0 + 4 * quad + j) * 1024 + col0 + r16;
            mp[0] = (bf16)f2bf(m0[j]); mp[16] = (bf16)f2bf(m1[j]); }
    }
}
__device__ __forceinline__ void side_outproj(Frame& F, int l) {
    REFRESH_TID(F);
    const int lane = F.lane, w = F.wave, r16 = lane & 15, quad = lane >> 4, rt = w & 3, chf = w >> 2;
    const float* gt = WSP(float, WS_MOD) + ((size_t)l * 5 + 4) * 6144 + 2048;
    for (int tile = F.bid; tile < 256; tile += F.G) {
        const int row0 = TLAT + 64 * (tile >> 4) + 16 * rt, col0 = 64 * (tile & 15) + 32 * chf;
        const bf16* ap = WSP(bf16, WS_MB) + (size_t)(row0 + r16) * 1024 + 8 * quad;
        const bf16* bp0 = WSP(bf16, WS_WOUT) + ((size_t)l * 1024 + col0 + r16) * 1024 + 8 * quad;
        const bf16* bp1 = bp0 + (size_t)16 * 1024;
        f32x4 c0 = (f32x4){0.f, 0.f, 0.f, 0.f}, c1 = c0;
        SideFr fa, fb;
        side_ld(fa, ap, bp0, bp1);
#pragma unroll 1
        for (int kc = 0; kc < 8; kc += 2) {
            side_ld(fb, ap + 128 * (kc + 1), bp0 + 128 * (kc + 1), bp1 + 128 * (kc + 1)); side_mma(c0, c1, fa);
            { const int kn = kc + 2 < 8 ? kc + 2 : 7; side_ld(fa, ap + 128 * kn, bp0 + 128 * kn, bp1 + 128 * kn); }
            side_mma(c0, c1, fb);
        }
        const float g0 = gt[col0 + r16], g1 = gt[col0 + 16 + r16];
#pragma unroll
        for (int j = 0; j < 4; ++j) { float* xp = WSP(float, WS_X) + (size_t)(row0 + 4 * quad + j) * 1024 + col0 + r16;
            xp[0] += g0 * c0[j]; xp[16] += g1 * c1[j]; }
    }
}

#ifndef SCAN_PARTS
#define SCAN_PARTS 2
#endif
constexpr int NSCAN = 4 * SCAN_PARTS;
constexpr int CW_Q = 2048;
__device__ __forceinline__ void mixer_queue_phase(Frame& F, int l) {
    volatile LAS int* qslot = (volatile LAS int*)(F.lds + MISC_OFF + 64);
    const int x0 = (int)(xb_xcc_id() & 7u);
#if defined(PROBE_SUB) && (PROBE_SUB == 4 || PROBE_SUB == 5)
    const unsigned long long tq0 = __builtin_amdgcn_s_memrealtime();
#endif
#pragma unroll 1
    for (int kq = 0; kq < 8; ++kq) {
      const int x = (x0 + kq) & 7;
      for (;;) {
        __syncthreads();
        if (F.tid == 0) *qslot = (int)__hip_atomic_fetch_add(F.ctl + CW_Q + l * 8 + x, 1u, __ATOMIC_RELAXED, __HIP_MEMORY_SCOPE_AGENT);
        __syncthreads();
        const int idx = __builtin_amdgcn_readfirstlane(*qslot);
        if (idx >= (l == DEPTH - 1 ? 128 : 136) + NSCAN) break;
#ifdef PROBE_SUB
        unsigned long long t0_ = 0ull; const bool pr_on = false;
#endif
        if (idx < NSCAN) { gdn_scan_wide<8 / SCAN_PARTS>(F, x + 8 * (idx / SCAN_PARTS), idx % SCAN_PARTS); }
        else { AttnUnit un; const int q = idx - NSCAN;
            if (q < 64) { un.kind = 0; un.b = x >> 1; un.hx = x & 1; un.qx = q; }
            else if (q < 128) { const int qq = q - 64, combo = x + 8 * (qq >> 4); un.kind = 1; un.b = combo >> 3; un.hx = combo & 7; un.qx = qq & 15; }
            else { const int qq = q - 128;
                if (qq < 4) { un.kind = 2; un.b = x >> 1; un.hx = x & 1; un.qx = qq; }
                else { const int combo = x + 8 * (qq - 4); un.kind = 3; un.b = combo >> 3; un.hx = combo & 7; un.qx = 0; } }
            attn_unit(F, l, un); }
#ifdef PROBE_SUB
        if (pr_on) F.pr += __builtin_amdgcn_s_memrealtime() - t0_;
        if (PROBE_SUB == 13 && F.bid == 8 && idx >= 4 && idx < 68) F.pr += 100;
        if (PROBE_SUB == 14 && F.bid == 8 && idx >= 68 && idx < 140) F.pr += 100;
#endif
      }
    }
#if defined(PROBE_SUB) && PROBE_SUB == 4
    if (F.tid == 0) __hip_atomic_fetch_max(F.ctl + 3000 + l, (unsigned)(__builtin_amdgcn_s_memrealtime() - tq0), __ATOMIC_RELAXED, __HIP_MEMORY_SCOPE_AGENT);
#endif
#if defined(PROBE_SUB) && PROBE_SUB == 5
    if (F.tid == 0) __hip_atomic_fetch_max(F.ctl + 3000 + l, 0x7fffffffu - (unsigned)(__builtin_amdgcn_s_memrealtime() - tq0), __ATOMIC_RELAXED, __HIP_MEMORY_SCOPE_AGENT);
#endif
}


#ifndef REP_P0
#define REP_P0 1
#endif
#ifndef REP_B
#define REP_B 1
#endif
#ifndef REP_D1
#define REP_D1 1
#endif
#ifndef REP_D2
#define REP_D2 1
#endif
#ifndef REP_E
#define REP_E 1
#endif
#ifndef REP_F
#define REP_F 1
#endif
#ifndef REP_I
#define REP_I 1
#endif
#ifndef REP_J
#define REP_J 1
#endif
#ifndef REP_C1
#define REP_C1 1
#endif
#ifndef REP_C2
#define REP_C2 1
#endif
#ifndef REP_C4
#define REP_C4 1
#endif
#ifndef REP_G2
#define REP_G2 1
#endif

#ifndef MIXER_QUEUE
#define MIXER_QUEUE 1
#endif
constexpr int PH_PER_LAYER = 11, PH_FINAL = 1 + PH_PER_LAYER * DEPTH, N_PHASES = PH_FINAL + 1;
struct Args { const float* in[32]; float* out; unsigned char* ws; int ph_lo, ph_hi, li, pad; };

__global__ void __launch_bounds__(NT, 2) hybrid_fwd(Args args) {
    extern __shared__ __attribute__((aligned(16))) unsigned char lds_raw[];
    Frame F;
    F.lds = (LAS unsigned char*)lds_raw;
    F.wave = __builtin_amdgcn_readfirstlane((int)threadIdx.x >> 6); F.lane = (int)__builtin_amdgcn_mbcnt_hi(~0u, __builtin_amdgcn_mbcnt_lo(~0u, 0u)); F.tid = F.wave * 64 + F.lane;
    F.G = gridDim.x; F.bid = blockIdx.x; F.pr = 0ull;
    F.in = args.in; F.in0 = args.in;
    F.out = args.out; F.ws = args.ws; F.ws0 = args.ws; F.ctl = (unsigned*)(args.ws + WS_CTL);
    volatile LAS unsigned* MISC = (volatile LAS unsigned*)(F.lds + MISC_OFF);
    if (F.tid < 64) MISC[F.tid] = 0u;
    __syncthreads();
    const int lo = args.ph_lo, hi = args.ph_hi;
    XcdBarrier bar = xcd_barrier_post(F.ctl + CW_BAR + args.li * XCD_BAR_WORDS, MISC + 8);
#ifndef ONLY_MASK
#define ONLY_MASK 0xFFFF
#endif
#define PHON(b) ((ONLY_MASK >> (b)) & 1)
#define IN(k) (lo <= (k) && (k) < hi)
#define SEAM(k) do { if ((k) + 1 < hi) xcd_barrier(bar); } while (0)
#ifdef PROBE_PHASE
    unsigned long long pr_acc = 0ull, pr_t0 = 0ull;
#define PR_BEGIN(k) do { if ((k) == PROBE_PHASE) pr_t0 = __builtin_amdgcn_s_memrealtime(); } while (0)
#define PR_END(k) do { if ((k) == PROBE_PHASE) pr_acc += __builtin_amdgcn_s_memrealtime() - pr_t0; } while (0)
#else
#define PR_BEGIN(k) do { } while (0)
#define PR_END(k) do { } while (0)
#endif

    if (PHON(0) && IN(0)) { REFRESH_TID(F); _Pragma("unroll 1") for (int rep_ = 0; rep_ < REP_P0; ++rep_) { p0_prologue(F); __syncthreads(); } SEAM(0); PR_END(0); }
#pragma unroll 1
    for (int l = 0; l < DEPTH; ++l) {
        const int pb = 1 + PH_PER_LAYER * l;
        if (PHON(1) && IN(pb + 0)) { PR_BEGIN(1); REFRESH_TID(F); norm_phase<0>(F, l); SEAM(pb + 0); PR_END(1); }
        if (PHON(2) && IN(pb + 1)) { PR_BEGIN(2); REFRESH_TID(F);
            pg8::Gemm g{WSP(bf16, WS_H), WSP(bf16, WS_WIN) + (size_t)l * UW * D, MROWS, UW, D};
            pg8::StaticOrder S; S.init(MROWS, UW, F.G, F.bid);
            pg8::EpiStoreBf16 E{WSP(bf16, WS_U), UW};
            _Pragma("unroll 1") for (int rep_ = 0; rep_ < REP_B; ++rep_) { pg8::gemm_phase<pg8::EpiStoreBf16, pg8::StaticOrder, true, true>(F.lds, g, S, E, F.wave); __syncthreads(); }
            SEAM(pb + 1); PR_END(2);
        }
        if (PHON(3) && IN(pb + 2)) { PR_BEGIN(3); REFRESH_TID(F);
#ifndef NO_C1
            PR_BEGIN(30); _Pragma("unroll 1") for (int rep_ = 0; rep_ < REP_C1; ++rep_) { gdn_prep(F, l); __syncthreads(); } PR_END(30);
#endif
#ifndef NO_C2
            PR_BEGIN(31); _Pragma("unroll 1") for (int rep_ = 0; rep_ < REP_C2; ++rep_) { lru_pass1(F, l); __syncthreads(); } PR_END(31);
#endif
            __syncthreads();
#ifndef NO_C3
            PR_BEGIN(32); qk_prep(F, l); PR_END(32);
#endif
#ifndef NO_C4
            PR_BEGIN(33); _Pragma("unroll 1") for (int rep_ = 0; rep_ < REP_C4; ++rep_) { v_transpose(F); __syncthreads(); } PR_END(33); PR_BEGIN(34);
#endif
            SEAM(pb + 2); PR_END(34); PR_END(3);
        }
        if (PHON(4) && IN(pb + 3)) { PR_BEGIN(4); REFRESH_TID(F);
#if MIXER_QUEUE
            lru_carry_all(F);
            __syncthreads();
            mixer_queue_phase(F, l);
#else
            PR_BEGIN(20); for (int ch = F.bid; ch < 256; ch += F.G) gdn_scan(F, ch); PR_END(20);
            PR_BEGIN(21); lru_carry_all(F);
            __syncthreads(); PR_END(21);
            PR_BEGIN(22); attn_phase(F, l); PR_END(22);
#endif
            PR_BEGIN(23);
            SEAM(pb + 3); PR_END(23); PR_END(4);
        }
        if (PHON(5) && IN(pb + 4)) { PR_BEGIN(5); REFRESH_TID(F);
            _Pragma("unroll 1") for (int rep_ = 0; rep_ < REP_E; ++rep_) { lru_pass2(F, l); __syncthreads(); }
            __syncthreads();
            gdn_out(F, l);
            SEAM(pb + 4); PR_END(5);
        }
        if (PHON(6) && IN(pb + 5)) { PR_BEGIN(6); REFRESH_TID(F);
            pg8::Gemm g{WSP(bf16, WS_Y), WSP(bf16, WS_WBR) + (size_t)l * 4 * 1024 * 512, 4 * MROWS, 4 * 1024, 512};
            pg8::MergeOrder S{F.G, F.bid, MROWS / 256, TLAT / 256};
            pg8::EpiMerge E{WSP(bf16, WS_U), UW, UG, WSP(bf16, WS_MF), WSP(bf16, WS_MB), MROWS / 256};
            _Pragma("unroll 1") for (int rep_ = 0; rep_ < REP_F; ++rep_) { pg8::gemm_phase<pg8::EpiMerge, pg8::MergeOrder, true, true>(F.lds, g, S, E, F.wave); __syncthreads(); }
            PR_BEGIN(13); if (l < DEPTH - 1) side_merge(F, l); PR_END(13);
            SEAM(pb + 5); PR_END(6);
        }
        if (PHON(7) && IN(pb + 6)) { PR_BEGIN(7); REFRESH_TID(F);
            pg8::Gemm g{WSP(bf16, WS_MB), WSP(bf16, WS_WOUT) + (size_t)l * D * D, MROWS, D, D};
            pg8::StaticOrder S; S.init(TLAT, D, F.G, F.bid);
            pg8::EpiResid E{WSP(float, WS_X), WSP(float, WS_MOD) + (size_t)l * 5 * 6144 + 2048};
            pg8::gemm_phase<pg8::EpiResid, pg8::StaticOrder, true, true>(F.lds, g, S, E, F.wave);
            PR_BEGIN(14); if (l < DEPTH - 1) side_outproj(F, l); PR_END(14);
            SEAM(pb + 6); PR_END(7);
        }
        if (PHON(8) && IN(pb + 7)) { PR_BEGIN(8); REFRESH_TID(F); norm_phase<1>(F, l); SEAM(pb + 7); PR_END(8); }
        if (PHON(9) && IN(pb + 8)) { PR_BEGIN(9); REFRESH_TID(F); _Pragma("unroll 1") for (int rep_ = 0; rep_ < REP_G2; ++rep_) { moe_gather(F, l); __syncthreads(); } SEAM(pb + 8); PR_END(9); }
        if (PHON(10) && IN(pb + 9)) { PR_BEGIN(10); REFRESH_TID(F);
            moe_table(F, l);
            pg8::Gemm g{WSP(bf16, WS_HS), WSP(bf16, WS_WGU) + (size_t)l * NEXP * 2048 * D, MOE_ROWS, NEXP * 2048, D};
            pg8::MoeOrder S{(const LAS int*)(F.lds + MISC_OFF + 256), F.G, F.bid, 8};
            pg8::EpiSwiglu E{WSP(bf16, WS_ACT), F.in[I_BGU] + (size_t)l * NEXP * 2048};
            _Pragma("unroll 1") for (int rep_ = 0; rep_ < REP_I; ++rep_) { pg8::gemm_phase<pg8::EpiSwiglu, pg8::MoeOrder, true, true>(F.lds, g, S, E, F.wave); __syncthreads(); }
            SEAM(pb + 9); PR_END(10);
        }
        if (PHON(11) && IN(pb + 10)) { PR_BEGIN(11); REFRESH_TID(F);
            moe_table(F, l);
            pg8::Gemm g{WSP(bf16, WS_ACT), WSP(bf16, WS_WDN) + (size_t)l * NEXP * D * D, MOE_ROWS, NEXP * D, D};
            pg8::MoeOrder S{(const LAS int*)(F.lds + MISC_OFF + 256), F.G, F.bid, 4};
            pg8::EpiDown E{WSP(bf16, WS_YS), F.in[I_BDN] + (size_t)l * NEXP * D};
            _Pragma("unroll 1") for (int rep_ = 0; rep_ < REP_J; ++rep_) { pg8::gemm_phase<pg8::EpiDown, pg8::MoeOrder, true, true>(F.lds, g, S, E, F.wave); __syncthreads(); }
            SEAM(pb + 10); PR_END(11);
        }
    }
    if (PHON(12) && IN(PH_FINAL)) { PR_BEGIN(12); REFRESH_TID(F); norm_phase<2>(F, 0); PR_END(12); }
#if defined(PROBE_SUB) && (PROBE_SUB == 4 || PROBE_SUB == 5)
    if (blockIdx.x == 0) { unsigned long long tot = 0ull;
        for (int q = 0; q < 4; ++q) { const unsigned v = __hip_atomic_load(F.ctl + 3000 + q, __ATOMIC_RELAXED, __HIP_MEMORY_SCOPE_AGENT); tot += (PROBE_SUB == 4) ? v : (0x7fffffffu - v); }
        F.pr = tot; }
#endif
#ifdef PROBE_SUB
    if (F.pr) { const unsigned long long te = __builtin_amdgcn_s_memrealtime(); while (__builtin_amdgcn_s_memrealtime() - te < PROBE_MULT * F.pr) __builtin_amdgcn_s_sleep(8); }
#endif
#ifdef PROBE_PHASE
    if (blockIdx.x == 0) { const unsigned long long te = __builtin_amdgcn_s_memrealtime(); while (__builtin_amdgcn_s_memrealtime() - te < PROBE_MULT * pr_acc) __builtin_amdgcn_s_sleep(8); }
#endif
#undef IN
#undef SEAM
}

extern "C" void kernel_launch(void* const* d_in, const int* in_sizes, int n_in, void* d_out, int out_size, void* d_ws, size_t ws_size, hipStream_t stream) {
    static int grid = 0;
    if (grid == 0) {
        if (n_in != 32 || out_size != TLAT * D || ws_size < WS_END) { fprintf(stderr, "kernel_launch: unexpected shapes (n_in %d out %d ws %zu need %zu)\n", n_in, out_size, ws_size, (size_t)WS_END); grid = -1; return; }
        int dev = 0, cus = 0, per_cu = 0;
        if (hipGetDevice(&dev) != hipSuccess || hipDeviceGetAttribute(&cus, hipDeviceAttributeMultiprocessorCount, dev) != hipSuccess) { grid = -1; return; }
        if (hipFuncSetAttribute((const void*)hybrid_fwd, hipFuncAttributeMaxDynamicSharedMemorySize, LDS_BYTES) != hipSuccess) { fprintf(stderr, "kernel_launch: hipFuncSetAttribute failed\n"); grid = -1; return; }
        if (hipOccupancyMaxActiveBlocksPerMultiprocessor(&per_cu, (const void*)hybrid_fwd, NT, LDS_BYTES) != hipSuccess || per_cu < 1) fprintf(stderr, "kernel_launch: occupancy query says %d\n", per_cu);
        (void)hipGetLastError();
        grid = cus;
    }
    if (grid < 0) return;
    if (hipMemsetAsync((char*)d_ws + WS_CTL, 0, CTL_BYTES, stream) != hipSuccess) return;
    Args a{};
    for (int i = 0; i < 32; ++i) a.in[i] = (const float*)d_in[i];
    a.out = (float*)d_out; a.ws = (unsigned char*)d_ws;
#if MK_MULTI
    for (int p = 0; p < N_PHASES; ++p) { a.ph_lo = p; a.ph_hi = p + 1; a.li = p;
        hipLaunchKernelGGL(hybrid_fwd, dim3(grid), dim3(NT), LDS_BYTES, stream, a); }
#else
    a.ph_lo = 0; a.ph_hi = N_PHASES; a.li = 0;
    hipLaunchKernelGGL(hybrid_fwd, dim3(grid), dim3(NT), LDS_BYTES, stream, a);
#endif
    const hipError_t le = hipPeekAtLastError();
    if (le != hipSuccess) fprintf(stderr, "kernel_launch: launch failed: %s\n", hipGetErrorName(le));
}
```

```cpp
#include <hip/hip_runtime.h>
#include <cstdio>
#include <cstdint>

#ifndef MK_MULTI
#define MK_MULTI 0
#endif

constexpr int D = 1024, NB = 4, SEQ = 4096, LCTX = 256, DEPTH = 4;
constexpr int TLAT = NB * SEQ, TCTX = NB * LCTX, MROWS = TLAT + TCTX;
constexpr int NCHUNK = MROWS / 64;
constexpr int INW = 9488, UW = 9472;
constexpr int UQ = 0, UK = 512, UV = 640, UBX = 768, UBY = 1280, UCQ = 1792, UCK = 2304, UCV = 2816, UCZ = 3328, UDQ = 3840, UDK = 4352, UDV = 4864, UG = 5376;
constexpr int NEXP = 32, TOPK = 4;
constexpr int KEYS = SEQ + LCTX;
constexpr int MOE_ROWS = MROWS * TOPK + NEXP * 256;
constexpr float EPS = 1e-6f;
constexpr float LOG2E = 1.4426950408889634f;

constexpr size_t al256(size_t x) { return (x + 255) & ~(size_t)255; }
constexpr size_t WS_CTL = 0, CTL_BYTES = 1u << 20;
constexpr size_t WS_MOD  = WS_CTL + CTL_BYTES;
constexpr size_t WS_ROPE = WS_MOD + al256((size_t)DEPTH * 5 * 6144 * 4);
constexpr size_t WS_LRUW = WS_ROPE + al256(2 * 64 * 16 * 4);
constexpr size_t WS_WIN  = WS_LRUW + al256((size_t)DEPTH * 2 * 2 * 8 * 4096 * 2);
constexpr size_t WS_WBR  = WS_WIN + al256((size_t)DEPTH * UW * D * 2);
constexpr size_t WS_WOUT = WS_WBR + al256((size_t)DEPTH * 4 * 1024 * 512 * 2);
constexpr size_t WS_WGU  = WS_WOUT + al256((size_t)DEPTH * D * D * 2);
constexpr size_t WS_WDN  = WS_WGU + al256((size_t)DEPTH * NEXP * 2048 * 1024 * 2);
constexpr size_t WS_X    = WS_WDN + al256((size_t)DEPTH * NEXP * 1024 * 1024 * 2);
constexpr size_t WS_H    = WS_X + al256((size_t)MROWS * D * 4);
constexpr size_t WS_U    = WS_H + al256((size_t)MROWS * D * 2);
constexpr size_t WS_CAB  = WS_U + al256((size_t)MROWS * UW * 2);
constexpr size_t WS_VAT  = WS_CAB + al256((size_t)MROWS * 16 * 4);
constexpr size_t WS_VDT  = WS_VAT + al256((size_t)NB * 2 * 64 * KEYS * 2);
constexpr size_t WS_LRA  = WS_VDT + al256((size_t)NB * 8 * 64 * KEYS * 2);
constexpr size_t WS_LRB  = WS_LRA + al256((size_t)NCHUNK * 2 * 512 * 4);
constexpr size_t WS_LRC  = WS_LRB + al256((size_t)NCHUNK * 2 * 512 * 4);
constexpr int NCD = NCHUNK * 4 * 2;
constexpr size_t WS_GW   = WS_LRC + al256((size_t)NCHUNK * 2 * 512 * 4);
constexpr size_t WS_GU   = WS_GW + al256((size_t)NCD * 64 * 128 * 2);
constexpr size_t WS_GQG  = WS_GU + al256((size_t)NCD * 64 * 128 * 2);
constexpr size_t WS_GKD  = WS_GQG + al256((size_t)NCD * 64 * 128 * 2);
constexpr size_t WS_GQK  = WS_GKD + al256((size_t)NCD * 64 * 128 * 2);
constexpr size_t WS_GGL  = WS_GQK + al256((size_t)NCD * 64 * 64 * 2);
constexpr size_t WS_GO   = WS_GGL + al256((size_t)NCD * 4);
constexpr size_t WS_Y    = WS_GO + al256((size_t)2 * MROWS * 512 * 4);
constexpr size_t WS_MF   = WS_Y + al256((size_t)4 * MROWS * 512 * 2);
constexpr size_t WS_MB   = WS_MF + al256((size_t)MROWS * D * 4);
constexpr size_t WS_SROW = WS_MB + al256((size_t)MROWS * D * 2);
constexpr size_t WS_SW   = WS_SROW + al256((size_t)MROWS * 4 * 4);
constexpr size_t WS_SEP  = WS_SW + al256((size_t)MROWS * 4 * 4);
constexpr size_t WS_LIST = WS_SEP + al256((size_t)MROWS * 4 * 4);
constexpr size_t WS_HS   = WS_LIST + al256((size_t)NEXP * MROWS * 4);
constexpr size_t WS_ACT  = WS_HS + al256((size_t)MOE_ROWS * D * 2);
constexpr size_t WS_YS   = WS_ACT + al256((size_t)MOE_ROWS * D * 2);
constexpr size_t WS_END  = WS_YS + al256((size_t)MOE_ROWS * D * 2);

constexpr int CW_BAR = 4096;
constexpr int CW_CNT = 1024;

constexpr int RING_BYTES = 131072;
constexpr int MISC_OFF = RING_BYTES;
constexpr int LDS_BYTES = 147456;
constexpr int NWAVES = 8, NT = 512;

#define GAS __attribute__((address_space(1)))
#define LAS __attribute__((address_space(3)))
typedef unsigned short bf16;
typedef unsigned v4u __attribute__((ext_vector_type(4)));
typedef unsigned v2u __attribute__((ext_vector_type(2)));
typedef float f32x4 __attribute__((ext_vector_type(4)));
typedef float f32x16 __attribute__((ext_vector_type(16)));
typedef short bf16x8 __attribute__((ext_vector_type(8)));
typedef short bf16x4 __attribute__((ext_vector_type(4)));

typedef float f32x2_t __attribute__((ext_vector_type(2))); typedef __bf16 bf16x2_t __attribute__((ext_vector_type(2)));
__device__ __forceinline__ unsigned pk2(float lo, float hi) { f32x2_t v = {lo, hi}; bf16x2_t b = __builtin_convertvector(v, bf16x2_t); return __builtin_bit_cast(unsigned, b); }
__device__ __forceinline__ unsigned f2bf(float f) { return pk2(f, 0.f) & 0xffffu; }
__device__ __forceinline__ float bf2f(unsigned short b) { return __builtin_bit_cast(float, (unsigned)b << 16); }
__device__ __forceinline__ float bflo(unsigned w) { return __builtin_bit_cast(float, w << 16); }
__device__ __forceinline__ float bfhi(unsigned w) { return __builtin_bit_cast(float, w & 0xffff0000u); }
__device__ __forceinline__ float wave_sum(float v) {
#pragma unroll
    for (int o = 1; o < 64; o <<= 1) v += __shfl_xor(v, o);
    return v;
}
__device__ __forceinline__ float sigmoidf_(float x) { return __builtin_amdgcn_rcpf(1.f + __expf(-x)); }
__device__ __forceinline__ float softplusf_(float x) { return x > 20.f ? x : log1pf(__expf(x)); }
__device__ __forceinline__ float siluf_(float x) { return x * __builtin_amdgcn_rcpf(1.f + __expf(-x)); }
__device__ __forceinline__ void lds_barrier() { asm volatile("s_waitcnt lgkmcnt(0)\n\ts_barrier" ::: "memory"); }
namespace pg8 {
#define PG8_LAS __attribute__((address_space(3)))
typedef unsigned short bf16_t;
typedef short bf16x8 __attribute__((ext_vector_type(8)));
typedef float f32x4 __attribute__((ext_vector_type(4)));
typedef unsigned u32x4 __attribute__((ext_vector_type(4)));
constexpr int BM = 256, BK = 64, HALF = 128, HTB = HALF * BK * 2  , STAGE_BYTES = 8 * HTB, NXCD = 8, WGM = 8;

__host__ __device__ __forceinline__ int lds_byte(int r, int c) { const int st = (r >> 4) * 2 + (c >> 5), rr = r & 15, cc = c & 31, ob = rr * 64 + cc * 2; return st * 1024 + (ob ^ (((ob >> 9) & 1) << 5)); }
__host__ __device__ __forceinline__ void stage_rc(int b, int& R, int& C) { const int st = b / 1024, sb = b % 1024, swz = sb ^ (((sb >> 9) & 1) << 5); R = (st >> 1) * 16 + swz / 64; C = (st & 1) * 32 + (swz % 64) / 2; }
__host__ __device__ __forceinline__ int perm32(int rho) { const int n = rho >> 4, i = rho & 15; return 8 * (i >> 2) + 4 * n + (i & 3); }

struct Unit { int pm, pn; };
struct Gemm { const bf16_t* A; const bf16_t* Bt; int M, N, K; };

struct StaticOrder {
    int nM, nN, nwg, G, c;
    __host__ __device__ void init(int M, int N, int G_, int c_) { nM = M / BM; nN = N / BM; nwg = nM * nN; G = G_; c = c_; }
    __host__ __device__ bool next(int i, Unit& u) const {
        const long L = (long)i * G + c; if (L >= nwg) return false;
        int wgid = (int)L; { const int q = nwg / NXCD, r = nwg % NXCD, xcd = wgid % NXCD, off = wgid / NXCD; wgid = (xcd < r ? xcd * (q + 1) : r * (q + 1) + (xcd - r) * q) + off; }
        const int nig = WGM * nN, gid = wgid / nig, fm = gid * WGM, gsz = (nM - fm) < WGM ? (nM - fm) : WGM;
        u.pm = fm + ((wgid % nig) % gsz); u.pn = (wgid % nig) / gsz; return true;
    }
    __device__ __forceinline__ void a_ready(const Unit&) const {}
    __device__ __forceinline__ void done(const Unit&) const {}
};

__device__ __forceinline__ unsigned cvt_pk_bf16(float lo, float hi) { unsigned r; asm volatile("v_cvt_pk_bf16_f32 %0, %1, %2" : "=v"(r) : "v"(lo), "v"(hi)); return r; }
typedef float f32x2 __attribute__((ext_vector_type(2)));
template <class Epi, class Sched, bool ALIGN_EPI = false, bool SP2 = false>
__device__ __forceinline__ void gemm_phase(PG8_LAS unsigned char* lds, const Gemm g, const Sched& S, const Epi& E, const int wid_in) {
    int lane_o = (int)__builtin_amdgcn_mbcnt_hi(~0u, __builtin_amdgcn_mbcnt_lo(~0u, 0u)); asm volatile("" : "+v"(lane_o));
    const int wid = __builtin_amdgcn_readfirstlane(wid_in), lane = lane_o, tid = wid * 64 + lane, wr = wid >> 2, wc = wid & 3, fr = lane & 15, fq = lane >> 4;
    const int K = g.K, nt = K / BK;
    unsigned voffA[2], voffB[2];
#pragma unroll
    for (int i = 0; i < 2; ++i) { int R, C; stage_rc(tid * 16 + i * 8192, R, C); const int Rb = Epi::PERM ? ((R & ~31) + perm32(R & 31)) : R;
        voffA[i] = (unsigned)(R * K + C) * 2u; voffB[i] = (unsigned)(Rb * K + C) * 2u; }
    const size_t kstep = (size_t)(BK * 2);
    const size_t hstep = (size_t)HALF * K * 2;
    const size_t tstep = 2 * hstep;
    const unsigned ldsw = (unsigned)wid * 1024u;
    const int aoff = lds_byte(wr * 64 + fr, fq * 8), boff = lds_byte(wc * 32 + fr, fq * 8);
#define PG8_SA(b, h) (((b) * 2 + (h)) * HTB)
#define PG8_SB(b, h) ((4 + (b) * 2 + (h)) * HTB)
#define PG8_STAGE(bufoff, gbase, voff) do { _Pragma("unroll") for (int _i = 0; _i < 2; ++_i) \
        __builtin_amdgcn_global_load_lds((const unsigned*)((const char*)(gbase) + (voff)[_i]), (PG8_LAS unsigned*)(lds + (bufoff) + ldsw + _i * 8192), 16, 0, 0); } while (0)
#define PG8_LDA(dst, b, h) do { _Pragma("unroll") for (int m = 0; m < 4; ++m) _Pragma("unroll") for (int k = 0; k < 2; ++k) dst[m][k] = *(const PG8_LAS bf16x8*)(lds + PG8_SA(b, h) + aoff + m * 2048 + k * 1024); } while (0)
#define PG8_LDB(dst, b, h) do { _Pragma("unroll") for (int n = 0; n < 2; ++n) _Pragma("unroll") for (int k = 0; k < 2; ++k) dst[n][k] = *(const PG8_LAS bf16x8*)(lds + PG8_SB(b, h) + boff + n * 2048 + k * 1024); } while (0)
#define PG8_MMA(ai, bj, At, Bt) do { __builtin_amdgcn_s_setprio(1); _Pragma("unroll") for (int m = 0; m < 4; ++m) _Pragma("unroll") for (int n = 0; n < 2; ++n) _Pragma("unroll") for (int k = 0; k < 2; ++k) \
        acc[ai][bj][m][n] = __builtin_amdgcn_mfma_f32_16x16x32_bf16(Bt[n][k], At[m][k], acc[ai][bj][m][n], 0, 0, 0); __builtin_amdgcn_s_setprio(0); } while (0)
#define PG8_WAIT_V(n) asm volatile("s_waitcnt vmcnt(" #n ")" ::: "memory")
#define PG8_WAIT_L(n) asm volatile("s_waitcnt lgkmcnt(" #n ")" ::: "memory")
#define PG8_BAR __builtin_amdgcn_s_barrier()
#define PG8_SCHED __builtin_amdgcn_sched_barrier(0)
    Unit cur, nxt; int ui = 0;
    if (!S.next(0, cur)) return;
    f32x4 acc[2][2][4][2];
#pragma unroll
    for (int a = 0; a < 2; ++a)
#pragma unroll
        for (int b = 0; b < 2; ++b)
#pragma unroll
            for (int m = 0; m < 4; ++m)
#pragma unroll
                for (int n = 0; n < 2; ++n) acc[a][b][m][n] = (f32x4){0.f, 0.f, 0.f, 0.f};
    bf16x8 At[4][2], B0[2][2], B1[2][2];
    const char* cA = (const char*)g.A + (size_t)cur.pm * tstep; const char* cB = (const char*)g.Bt + (size_t)cur.pn * tstep;
    S.a_ready(cur);
    if constexpr (SP2) {
        PG8_STAGE(PG8_SB(0, 0), cB, voffB); PG8_STAGE(PG8_SB(0, 1), cB + hstep, voffB); PG8_STAGE(PG8_SA(0, 0), cA, voffA); PG8_STAGE(PG8_SA(0, 1), cA + hstep, voffA);
        if (wr == 1) PG8_BAR;
        PG8_WAIT_V(2); PG8_BAR;
        PG8_STAGE(PG8_SB(1, 0), cB + kstep, voffB); PG8_STAGE(PG8_SA(1, 0), cA + kstep, voffA); PG8_STAGE(PG8_SB(1, 1), cB + hstep + kstep, voffB);
        PG8_WAIT_V(6); PG8_BAR;
    } else {
        PG8_STAGE(PG8_SB(0, 0), cB, voffB); PG8_STAGE(PG8_SA(0, 0), cA, voffA); PG8_STAGE(PG8_SB(0, 1), cB + hstep, voffB); PG8_STAGE(PG8_SA(0, 1), cA + hstep, voffA);
        if (wr == 1) PG8_BAR;
        PG8_WAIT_V(4); PG8_BAR;
        PG8_STAGE(PG8_SB(1, 0), cB + kstep, voffB); PG8_STAGE(PG8_SA(1, 0), cA + kstep, voffA); PG8_STAGE(PG8_SB(1, 1), cB + hstep + kstep, voffB);
        PG8_WAIT_V(6); PG8_BAR;
    }
    for (;;) {
        const bool has_next = S.next(ui + 1, nxt);
        const char* nA = has_next ? (const char*)g.A + (size_t)nxt.pm * tstep : cA; const char* nB = has_next ? (const char*)g.Bt + (size_t)nxt.pn * tstep : cB;
        for (int t = 0; t < nt; t += 2) {
            const bool last = (t == nt - 2);
            const char* a1 = cA + (size_t)(t + 1) * kstep;
            const char* a2 = last ? nA : cA + (size_t)(t + 2) * kstep; const char* b2 = last ? nB : cB + (size_t)(t + 2) * kstep;
            const char* a3 = a2 + kstep; const char* b3 = b2 + kstep;
            if (last && has_next) S.a_ready(nxt);
            if constexpr (SP2) {
            PG8_LDB(B0, 0, 0); PG8_LDB(B1, 0, 1); PG8_SCHED; PG8_LDA(At, 0, 0); PG8_STAGE(PG8_SA(1, 1), a1 + hstep, voffA);
            PG8_WAIT_V(8); PG8_WAIT_L(0); PG8_BAR; PG8_MMA(0, 0, At, B0); PG8_MMA(0, 1, At, B1); PG8_BAR; PG8_SCHED;
            PG8_LDA(At, 0, 1); PG8_STAGE(PG8_SB(0, 0), b2, voffB); PG8_STAGE(PG8_SB(0, 1), b2 + hstep, voffB); PG8_STAGE(PG8_SA(0, 0), a2, voffA);
            PG8_WAIT_V(8); PG8_WAIT_L(0); PG8_BAR; PG8_MMA(1, 0, At, B0); PG8_MMA(1, 1, At, B1); PG8_BAR; PG8_SCHED;
            PG8_LDB(B0, 1, 0); PG8_LDB(B1, 1, 1); PG8_SCHED; PG8_LDA(At, 1, 0); PG8_STAGE(PG8_SA(0, 1), a2 + hstep, voffA);
            PG8_WAIT_V(8); PG8_WAIT_L(0); PG8_BAR; PG8_MMA(0, 0, At, B0); PG8_MMA(0, 1, At, B1); PG8_BAR; PG8_SCHED;
            PG8_LDA(At, 1, 1); PG8_STAGE(PG8_SB(1, 0), b3, voffB); PG8_STAGE(PG8_SB(1, 1), b3 + hstep, voffB); PG8_STAGE(PG8_SA(1, 0), a3, voffA);
            PG8_WAIT_V(8); PG8_WAIT_L(0); PG8_BAR; PG8_MMA(1, 0, At, B0); PG8_MMA(1, 1, At, B1); PG8_BAR; PG8_SCHED;
            } else {
            PG8_LDB(B0, 0, 0); PG8_SCHED; PG8_LDA(At, 0, 0); PG8_STAGE(PG8_SA(1, 1), a1 + hstep, voffA);
            PG8_WAIT_L(8); PG8_BAR; PG8_WAIT_L(0); PG8_MMA(0, 0, At, B0); PG8_BAR; PG8_SCHED;
            PG8_LDB(B1, 0, 1); PG8_STAGE(PG8_SB(0, 0), b2, voffB);
            PG8_BAR; PG8_WAIT_L(0); PG8_MMA(0, 1, At, B1); PG8_BAR;
            PG8_LDA(At, 0, 1); PG8_STAGE(PG8_SA(0, 0), a2, voffA);
            PG8_BAR; PG8_WAIT_L(0); PG8_MMA(1, 0, At, B0); PG8_BAR; PG8_SCHED;
            PG8_STAGE(PG8_SB(0, 1), b2 + hstep, voffB);
            PG8_WAIT_V(6); PG8_BAR; PG8_MMA(1, 1, At, B1); PG8_BAR;
            PG8_LDB(B0, 1, 0); PG8_SCHED; PG8_LDA(At, 1, 0); PG8_STAGE(PG8_SA(0, 1), a2 + hstep, voffA);
            PG8_WAIT_L(8); PG8_BAR; PG8_WAIT_L(0); PG8_MMA(0, 0, At, B0); PG8_BAR; PG8_SCHED;
            PG8_LDB(B1, 1, 1); PG8_STAGE(PG8_SB(1, 0), b3, voffB);
            PG8_BAR; PG8_WAIT_L(0); PG8_MMA(0, 1, At, B1); PG8_BAR;
            PG8_LDA(At, 1, 1); PG8_STAGE(PG8_SA(1, 0), a3, voffA);
            PG8_BAR; PG8_WAIT_L(0); PG8_MMA(1, 0, At, B0); PG8_BAR; PG8_SCHED;
            PG8_STAGE(PG8_SB(1, 1), b3 + hstep, voffB);
            PG8_WAIT_V(6); PG8_BAR; PG8_MMA(1, 1, At, B1); PG8_BAR;
            }
        }
        if constexpr (ALIGN_EPI) { if (wr == 0) PG8_BAR; }
        if constexpr (!Epi::AFTER_DRAIN) { E(acc, cur, wr, wc, fr, fq); S.done(cur); }
        if (!has_next) break;
#pragma unroll
        for (int a = 0; a < 2; ++a)
#pragma unroll
            for (int b = 0; b < 2; ++b)
#pragma unroll
                for (int m = 0; m < 4; ++m)
#pragma unroll
                    for (int n = 0; n < 2; ++n) acc[a][b][m][n] = (f32x4){0.f, 0.f, 0.f, 0.f};
        cur = nxt; cA = nA; cB = nB; ++ui;
        if constexpr (ALIGN_EPI) { if (wr == 1) PG8_BAR; }
    }
    PG8_WAIT_V(0);
    if constexpr (!ALIGN_EPI) { if (wr == 0) PG8_BAR; }
    PG8_BAR;
    if constexpr (Epi::AFTER_DRAIN) { E.fused(acc, cur, wr, wc, fr, fq, lds, wid, lane); S.done(cur); }
#undef PG8_SA
#undef PG8_SB
#undef PG8_STAGE
#undef PG8_LDA
#undef PG8_LDB
#undef PG8_MMA
#undef PG8_WAIT_V
#undef PG8_WAIT_L
#undef PG8_BAR
#undef PG8_SCHED
}
}

namespace pg8 {
__device__ __forceinline__ float bflo_(unsigned w) { return __builtin_bit_cast(float, w << 16); }
__device__ __forceinline__ float bfhi_(unsigned w) { return __builtin_bit_cast(float, w & 0xffff0000u); }
__device__ __forceinline__ float sigm_(float x) { return __builtin_amdgcn_rcpf(1.f + __expf(-x)); }

struct EpiStoreBf16 {
    static constexpr bool PERM = true, AFTER_DRAIN = false;
    bf16_t* O; int ldc;
    __device__ __forceinline__ void operator()(const f32x4 (&acc)[2][2][4][2], const Unit& u, int wr, int wc, int fr, int fq) const {
        const int row0 = u.pm * BM + wr * 64 + fr, col0 = u.pn * BM + wc * 32 + 8 * fq;
#pragma unroll
        for (int ai = 0; ai < 2; ++ai)
#pragma unroll
            for (int m = 0; m < 4; ++m) { bf16_t* rowp = O + (size_t)(row0 + ai * HALF + m * 16) * ldc + col0;
#pragma unroll
                for (int bj = 0; bj < 2; ++bj) { const f32x4 v0 = acc[ai][bj][m][0], v1 = acc[ai][bj][m][1];
                    u32x4 w; w.x = cvt_pk_bf16(v0[0], v0[1]); w.y = cvt_pk_bf16(v0[2], v0[3]); w.z = cvt_pk_bf16(v1[0], v1[1]); w.w = cvt_pk_bf16(v1[2], v1[3]);
                    *(u32x4*)(rowp + bj * HALF) = w; } }
    }
};

struct EpiMerge {
    static constexpr bool PERM = true, AFTER_DRAIN = false;
    const bf16_t* U; int ldu, gcol0; bf16_t* Mf; bf16_t* Mb; int npm;
    __device__ __forceinline__ void operator()(const f32x4 (&acc)[2][2][4][2], const Unit& u, int wr, int wc, int fr, int fq) const {
        const int br = u.pm / npm, pm = u.pm - br * npm, pn = u.pn & 3;
        const int row0 = pm * BM + wr * 64 + fr, col0 = pn * BM + wc * 32 + 8 * fq;
#pragma unroll
        for (int ai = 0; ai < 2; ++ai) {
            u32x4 gv[4][2], pv[4][2];
#pragma unroll
            for (int m = 0; m < 4; ++m)
#pragma unroll
                for (int bj = 0; bj < 2; ++bj) { const size_t row = (size_t)(row0 + ai * HALF + m * 16); const int col = col0 + bj * HALF;
                    gv[m][bj] = *(const u32x4*)(U + row * ldu + gcol0 + br * 1024 + col);
                    pv[m][bj] = br > 0 ? *(const u32x4*)(Mf + row * 1024 + col) : (u32x4){0u, 0u, 0u, 0u}; }
#pragma unroll
            for (int m = 0; m < 4; ++m)
#pragma unroll
                for (int bj = 0; bj < 2; ++bj) { const size_t row = (size_t)(row0 + ai * HALF + m * 16); const int col = col0 + bj * HALF;
                    const u32x4 g = gv[m][bj], p = pv[m][bj];
                    f32x4 v0 = acc[ai][bj][m][0], v1 = acc[ai][bj][m][1];
                    v0[0] = v0[0] * sigm_(bflo_(g.x)) + bflo_(p.x); v0[1] = v0[1] * sigm_(bfhi_(g.x)) + bfhi_(p.x); v0[2] = v0[2] * sigm_(bflo_(g.y)) + bflo_(p.y); v0[3] = v0[3] * sigm_(bfhi_(g.y)) + bfhi_(p.y);
                    v1[0] = v1[0] * sigm_(bflo_(g.z)) + bflo_(p.z); v1[1] = v1[1] * sigm_(bfhi_(g.z)) + bfhi_(p.z); v1[2] = v1[2] * sigm_(bflo_(g.w)) + bflo_(p.w); v1[3] = v1[3] * sigm_(bfhi_(g.w)) + bfhi_(p.w);
                    u32x4 w; w.x = cvt_pk_bf16(v0[0], v0[1]); w.y = cvt_pk_bf16(v0[2], v0[3]); w.z = cvt_pk_bf16(v1[0], v1[1]); w.w = cvt_pk_bf16(v1[2], v1[3]);
                    *(u32x4*)((br < 3 ? Mf : Mb) + row * 1024 + col) = w; }
        }
    }
};
struct MergeOrder {
    int G, c, npm, ncnt;
    __device__ __forceinline__ bool next(int i, Unit& u) const {
        const int su = (i >> 2) * G + c; if (su >= ncnt * 4) return false;
        const int br = i & 3; u.pm = br * npm + (su >> 2); u.pn = br * 4 + (su & 3); return true; }
    __device__ __forceinline__ void a_ready(const Unit&) const {}
    __device__ __forceinline__ void done(const Unit&) const {}
};

struct EpiResid {
    static constexpr bool PERM = false, AFTER_DRAIN = false;
    float* X; const float* gt;
    __device__ __forceinline__ void operator()(const f32x4 (&acc)[2][2][4][2], const Unit& u, int wr, int wc, int fr, int fq) const {
        const int row0 = u.pm * BM + wr * 64 + fr, col0 = u.pn * BM + wc * 32 + 4 * fq;
        const int mr = u.pm < 64 ? (u.pm >> 4) : 4;
        f32x4 gv[2][2];
#pragma unroll
        for (int bj = 0; bj < 2; ++bj)
#pragma unroll
            for (int n = 0; n < 2; ++n) gv[bj][n] = *(const f32x4*)(gt + (size_t)mr * 6144 + col0 + bj * HALF + n * 16);
#pragma unroll
        for (int ai = 0; ai < 2; ++ai) {
            f32x4 xv[4][2][2];
#pragma unroll
            for (int m = 0; m < 4; ++m)
#pragma unroll
                for (int bj = 0; bj < 2; ++bj)
#pragma unroll
                    for (int n = 0; n < 2; ++n) xv[m][bj][n] = *(const f32x4*)(X + (size_t)(row0 + ai * HALF + m * 16) * 1024 + col0 + bj * HALF + n * 16);
#pragma unroll
            for (int m = 0; m < 4; ++m)
#pragma unroll
                for (int bj = 0; bj < 2; ++bj)
#pragma unroll
                    for (int n = 0; n < 2; ++n) *(f32x4*)(X + (size_t)(row0 + ai * HALF + m * 16) * 1024 + col0 + bj * HALF + n * 16) = xv[m][bj][n] + gv[bj][n] * acc[ai][bj][m][n];
        }
    }
};

struct MoeOrder {
    const PG8_LAS int* tpre; int G, c, ncol;
    __device__ __forceinline__ bool next(int i, Unit& u) const {
        int tau, pnl;
        if ((G & 7) == 0 && ((G >> 3) % ncol) == 0) { const int x = c & 7, y = c >> 3, rp = (G >> 3) / ncol; tau = (i * 8 + x) * rp + y / ncol; pnl = y % ncol; }
        else { const int L = i * G + c; tau = L / ncol; pnl = L - tau * ncol; }
        if (tau >= tpre[32]) return false;
        int e = 0;
#pragma unroll 1
        while (tpre[e + 1] <= tau) ++e;
        u.pm = tau; u.pn = e * ncol + pnl; return true; }
    __device__ __forceinline__ void a_ready(const Unit&) const {}
    __device__ __forceinline__ void done(const Unit&) const {}
};
struct EpiSwiglu {
    static constexpr bool PERM = true, AFTER_DRAIN = false;
    bf16_t* ACT; const float* bgu;
    __device__ __forceinline__ void operator()(const f32x4 (&acc)[2][2][4][2], const Unit& u, int wr, int wc, int fr, int fq) const {
        const int e = u.pn >> 3, pnl = u.pn & 7;
        const int row0 = u.pm * BM + wr * 64 + fr, cl = 128 * pnl + wc * 32 + 8 * fq;
        const float* bg = bgu + (size_t)e * 2048 + cl;
        const f32x4 bg0 = *(const f32x4*)bg, bg1 = *(const f32x4*)(bg + 4), bu0 = *(const f32x4*)(bg + 1024), bu1 = *(const f32x4*)(bg + 1028);
#pragma unroll
        for (int ai = 0; ai < 2; ++ai)
#pragma unroll
            for (int m = 0; m < 4; ++m) {
                f32x4 g0 = acc[ai][0][m][0] + bg0, g1 = acc[ai][0][m][1] + bg1, u0 = acc[ai][1][m][0] + bu0, u1 = acc[ai][1][m][1] + bu1;
                float o[8];
#pragma unroll
                for (int j = 0; j < 4; ++j) { const float g = fminf(g0[j], 7.f), up = fminf(fmaxf(u0[j], -7.f), 7.f); o[j] = (up + 1.f) * g * sigm_(1.702f * g); }
#pragma unroll
                for (int j = 0; j < 4; ++j) { const float g = fminf(g1[j], 7.f), up = fminf(fmaxf(u1[j], -7.f), 7.f); o[4 + j] = (up + 1.f) * g * sigm_(1.702f * g); }
                u32x4 w; w.x = cvt_pk_bf16(o[0], o[1]); w.y = cvt_pk_bf16(o[2], o[3]); w.z = cvt_pk_bf16(o[4], o[5]); w.w = cvt_pk_bf16(o[6], o[7]);
                *(u32x4*)(ACT + (size_t)(row0 + ai * HALF + m * 16) * 1024 + cl) = w; }
    }
};
struct EpiDown {
    static constexpr bool PERM = true, AFTER_DRAIN = false;
    bf16_t* YS; const float* bdn;
    __device__ __forceinline__ void operator()(const f32x4 (&acc)[2][2][4][2], const Unit& u, int wr, int wc, int fr, int fq) const {
        const int e = u.pn >> 2, pnl = u.pn & 3;
        const int row0 = u.pm * BM + wr * 64 + fr, col0 = pnl * BM + wc * 32 + 8 * fq;
        f32x4 bv[2][2];
#pragma unroll
        for (int bj = 0; bj < 2; ++bj)
#pragma unroll
            for (int n = 0; n < 2; ++n) bv[bj][n] = *(const f32x4*)(bdn + (size_t)e * 1024 + col0 + bj * HALF + 4 * n);
#pragma unroll
        for (int ai = 0; ai < 2; ++ai)
#pragma unroll
            for (int m = 0; m < 4; ++m) { bf16_t* rowp = YS + (size_t)(row0 + ai * HALF + m * 16) * 1024 + col0;
#pragma unroll
                for (int bj = 0; bj < 2; ++bj) { const f32x4 v0 = acc[ai][bj][m][0] + bv[bj][0], v1 = acc[ai][bj][m][1] + bv[bj][1];
                    u32x4 w; w.x = cvt_pk_bf16(v0[0], v0[1]); w.y = cvt_pk_bf16(v0[2], v0[3]); w.z = cvt_pk_bf16(v1[0], v1[1]); w.w = cvt_pk_bf16(v1[2], v1[3]);
                    *(u32x4*)(rowp + bj * HALF) = w; } }
    }
};
}
#define XB_TMO      128
#define XB_XCNT(j)  (256  + 64 * (j))
#define XB_XSUB(j)  (1280 + 64 * (j))
#define XB_XGEN(j)  (2304 + 64 * (j))
#define XB_TOP      3328
#define XB_TOPGEN   3392
#define XCD_BAR_WORDS 3456
#define XB_SPIN_CAP (1u << 18)
#define LAS __attribute__((address_space(3)))

__device__ __forceinline__ unsigned xb_ld(unsigned* p)              { return __hip_atomic_load(p, __ATOMIC_RELAXED, __HIP_MEMORY_SCOPE_AGENT); }
__device__ __forceinline__ unsigned xb_add(unsigned* p, unsigned v) { return __hip_atomic_fetch_add(p, v, __ATOMIC_RELAXED, __HIP_MEMORY_SCOPE_AGENT); }
__device__ __forceinline__ unsigned xb_xcc_id() { return (unsigned)__builtin_amdgcn_s_getreg((3 << 11) | 20) & 0xFu; }
#define XB_SPIN(cond, bar) do { unsigned _sp = 0; while (cond) { __builtin_amdgcn_s_sleep(1); \
    if ((++_sp & 255u) == 0u) { if (xb_ld(&(bar)[XB_TMO])) break; if (_sp > XB_SPIN_CAP) { atomicAdd(&(bar)[XB_TMO], 1u); break; } } } } while (0)

struct XcdBarrier {
    unsigned* bar; unsigned x;
    volatile LAS unsigned* st;
};

__device__ __forceinline__ XcdBarrier xcd_barrier_post(unsigned* bar, volatile LAS unsigned* st) {
    XcdBarrier b; b.bar = bar; b.x = xb_xcc_id(); b.st = st;
    if (threadIdx.x == 0) (void)xb_add(&bar[XB_XCNT(b.x)], 1u);
    return b;
}
__device__ __forceinline__ void xcd_barrier_complete(unsigned* bar, unsigned x, unsigned& nloc, unsigned& nx) {
    const unsigned G = gridDim.x * gridDim.y * gridDim.z;
    unsigned sum, cnt, mine, sp = 0u;
    for (;;) {
        sum = 0u; cnt = 0u; mine = 0u;
#pragma unroll
        for (unsigned j = 0; j < 16; ++j) { const unsigned c = xb_ld(&bar[XB_XCNT(j)]); sum += c; cnt += (c > 0u) ? 1u : 0u; mine = (j == x) ? c : mine; }
        if (sum == G) break;
        __builtin_amdgcn_s_sleep(1);
        if ((++sp & 255u) == 0u) { if (xb_ld(&bar[XB_TMO])) break; if (sp > XB_SPIN_CAP) { atomicAdd(&bar[XB_TMO], 1u); break; } }
    }
    nloc = mine > 0u ? mine : 1u; nx = cnt > 0u ? cnt : 1u;
}

__device__ __forceinline__ void xcd_barrier(const XcdBarrier& b) {
    asm volatile("s_waitcnt vmcnt(0)" ::: "memory");
    __syncthreads();
    if (threadIdx.x == 0) {
        unsigned* bar = b.bar;
        __builtin_amdgcn_s_waitcnt(0);
        unsigned nloc = b.st[0], nx = b.st[1];
        if (nloc == 0u) { xcd_barrier_complete(bar, b.x, nloc, nx); b.st[0] = nloc; b.st[1] = nx; }
        const unsigned old = xb_add(&bar[XB_XSUB(b.x)], 1u);
        const unsigned gen = old / nloc;
        if (old + 1u == (gen + 1u) * nloc) {
            __builtin_amdgcn_fence(__ATOMIC_RELEASE, "agent");
            asm volatile("s_waitcnt vmcnt(0)" ::: "memory");
            const unsigned og = xb_add(&bar[XB_TOP], 1u);
            const unsigned tg = og / nx;
            if (og + 1u == (tg + 1u) * nx) xb_add(&bar[XB_TOPGEN], 1u);
            else XB_SPIN(xb_ld(&bar[XB_TOPGEN]) == tg, bar);
            __builtin_amdgcn_fence(__ATOMIC_ACQUIRE, "agent");
            xb_add(&bar[XB_XGEN(b.x)], 1u);
            asm volatile("s_waitcnt vmcnt(0)" ::: "memory");
        } else {
            XB_SPIN(xb_ld(&bar[XB_XGEN(b.x)]) == gen, bar);
            __builtin_amdgcn_fence(__ATOMIC_ACQUIRE, "agent");
            asm volatile("s_waitcnt vmcnt(0)" ::: "memory");
        }
    }
    __syncthreads();
}

struct Frame {
    LAS unsigned char* lds;
    unsigned* ctl;
    int tid, lane, wave, G, bid;
    unsigned long long pr;
    const float* const* in; const float* const* in0;
    float* out;
    unsigned char* ws; unsigned char* ws0;
};
#define WSP(T, off) ((T*)(F.ws + (off)))
#define REFRESH_TID(F) do { int t_ = (int)__builtin_amdgcn_mbcnt_hi(~0u, __builtin_amdgcn_mbcnt_lo(~0u, 0u)); asm volatile("" : "+v"(t_)); F.lane = t_; F.tid = F.wave * 64 + t_; \
    int z_ = 0; asm volatile("s_mov_b32 %0, 0" : "=s"(z_)); F.ws = F.ws0 + z_; F.in = F.in0 + z_; F.bid = (int)blockIdx.x + z_; } while (0)
#define I_X 0
#define I_C 1
#define I_CTX 2
#define I_CCTX 3
#define I_WMOD 4
#define I_BMOD 5
#define I_G1 6
#define I_G2 7
#define I_WIN 8
#define I_AGQ 9
#define I_AGK 10
#define I_BCW 11
#define I_BCB 12
#define I_BLAM 13
#define I_BWR 14
#define I_BBR 15
#define I_BWI 16
#define I_BBI 17
#define I_CCW 18
#define I_CALOG 19
#define I_CDTB 20
#define I_CGOUT 21
#define I_RPB 22
#define I_WBR 23
#define I_WOUT 24
#define I_WRT 25
#define I_BRT 26
#define I_WGU 27
#define I_BGU 28
#define I_WDN 29
#define I_BDN 30
#define I_GFIN 31

__device__ __forceinline__ int mod_row(int r) { return r < TLAT ? (r >> 12) : 4; }

__device__ __forceinline__ void p0_transpose_item(const float* W, size_t pitch, int K, bf16* WT, int drow0, int scol0, int k0, LAS float* scr, int lane) {
    float v[32];
#pragma unroll
    for (int i = 0; i < 32; ++i) { const int kk = 2 * i + (lane >> 5); v[i] = W[(size_t)(k0 + kk) * pitch + scol0 + (lane & 31)]; }
#pragma unroll
    for (int i = 0; i < 32; ++i) { const int kk = 2 * i + (lane >> 5); scr[kk * 33 + (lane & 31)] = v[i]; }
    asm volatile("s_waitcnt lgkmcnt(0)" ::: "memory");
    const int c = lane & 7;
#pragma unroll
    for (int j = 0; j < 4; ++j) { const int n = (lane >> 3) + 8 * j; const LAS float* s = scr + (8 * c) * 33 + n;
        v4u o; o.x = pk2(s[0 * 33], s[1 * 33]); o.y = pk2(s[2 * 33], s[3 * 33]); o.z = pk2(s[4 * 33], s[5 * 33]); o.w = pk2(s[6 * 33], s[7 * 33]);
        *(v4u*)(WT + (size_t)(drow0 + n) * K + k0 + 8 * c) = o; }
    asm volatile("s_waitcnt lgkmcnt(0)" ::: "memory");
}

__device__ __forceinline__ void p0_prologue(Frame& F) {
    LAS float* scr = (LAS float*)(F.lds + F.wave * 16384);
    const int gw = F.bid * NWAVES + F.wave, NGW = F.G * NWAVES;
    constexpr int I_IN = DEPTH * 16 * (UW / 32);
    constexpr int I_BR = DEPTH * 4 * 8 * 32;
    constexpr int I_OUT = DEPTH * 16 * 32;
    constexpr int I_GU = DEPTH * NEXP * 16 * 64;
    constexpr int I_DN = DEPTH * NEXP * 16 * 32;
    constexpr int NITEMS = I_IN + I_BR + I_OUT + I_GU + I_DN;
    for (int it = gw; it < NITEMS; it += NGW) {
        int r = it;
        if (r < I_IN) { const int l = r / (16 * 296), q = r % (16 * 296), kb = q / 296, nb = q % 296; const int n0 = nb * 32, sc = n0 < 3840 ? n0 : n0 + 16;
            p0_transpose_item(F.in[I_WIN] + (size_t)l * D * INW, INW, D, WSP(bf16, WS_WIN) + (size_t)l * UW * D, n0, sc, kb * 64, scr, F.lane); continue; }
        r -= I_IN;
        if (r < I_BR) { const int mi = r / 256, q = r % 256, kb = q / 32, nb = q % 32;
            p0_transpose_item(F.in[I_WBR] + (size_t)mi * 512 * 1024, 1024, 512, WSP(bf16, WS_WBR) + (size_t)mi * 1024 * 512, nb * 32, nb * 32, kb * 64, scr, F.lane); continue; }
        r -= I_BR;
        if (r < I_OUT) { const int l = r / 512, q = r % 512, kb = q / 32, nb = q % 32;
            p0_transpose_item(F.in[I_WOUT] + (size_t)l * D * D, D, D, WSP(bf16, WS_WOUT) + (size_t)l * D * D, nb * 32, nb * 32, kb * 64, scr, F.lane); continue; }
        r -= I_OUT;
        if (r < I_GU) { const int mi = r / 1024, q = r % 1024, kb = q / 64, nb = q % 64; const int j0 = nb * 32, pn = j0 >> 8, bj = (j0 >> 7) & 1, cc = j0 & 127;
            p0_transpose_item(F.in[I_WGU] + (size_t)mi * D * 2048, 2048, D, WSP(bf16, WS_WGU) + (size_t)mi * 2048 * D, j0, 1024 * bj + 128 * pn + cc, kb * 64, scr, F.lane); continue; }
        r -= I_GU;
        { const int mi = r / 512, q = r % 512, kb = q / 32, nb = q % 32;
            p0_transpose_item(F.in[I_WDN] + (size_t)mi * D * D, D, D, WSP(bf16, WS_WDN) + (size_t)mi * D * D, nb * 32, nb * 32, kb * 64, scr, F.lane); }
    }
    __syncthreads();
    {
        LAS float* sc = (LAS float*)F.lds;
        LAS float* part = sc + 5 * 1024;
        bool staged = false;
        for (int it = F.bid; it < DEPTH * 96; it += F.G) {
            if (!staged) {
                for (int i = F.tid; i < 5 * 1024; i += NT) { const int r = i >> 10, k = i & 1023; const float cv = r < 4 ? F.in[I_C][r * 1024 + k] : F.in[I_CCTX][k]; sc[i] = siluf_(cv); }
                __syncthreads(); staged = true;
            }
            const int l = it / 96, cg = it % 96, col = cg * 64 + F.lane;
            const float* wm = F.in[I_WMOD] + (size_t)l * D * 6144 + col;
            float a0 = 0.f, a1 = 0.f, a2 = 0.f, a3 = 0.f, a4 = 0.f;
            const int kb = F.wave * 128;
#pragma unroll 16
            for (int k = 0; k < 128; ++k) { const float w = wm[(size_t)(kb + k) * 6144];
                a0 += sc[kb + k] * w; a1 += sc[1024 + kb + k] * w; a2 += sc[2048 + kb + k] * w; a3 += sc[3072 + kb + k] * w; a4 += sc[4096 + kb + k] * w; }
            LAS float* pp = part + F.wave * 320 + F.lane;
            pp[0] = a0; pp[64] = a1; pp[128] = a2; pp[192] = a3; pp[256] = a4;
            __syncthreads();
            if (F.tid < 320) { const int r = F.tid >> 6, ln = F.tid & 63; float s = 0.f;
#pragma unroll
                for (int w = 0; w < 8; ++w) s += part[w * 320 + r * 64 + ln];
                const int cc = cg * 64 + ln;
                WSP(float, WS_MOD)[((size_t)l * 5 + r) * 6144 + cc] = s + F.in[I_BMOD][l * 6144 + cc]; }
            __syncthreads();
        }
    }
    if (F.bid == 0) {
        for (int i = F.tid; i < 1024; i += NT) { const int p = i >> 4, f = i & 15; const float inv = powf(10000.f, -(float)f / 16.f); const float ang = (float)p * inv;
            WSP(float, WS_ROPE)[i] = cosf(ang); WSP(float, WS_ROPE)[1024 + i] = sinf(ang); }
    }
    for (int i = F.bid * NT + F.tid; i < DEPTH * 2 * 2 * 8 * 4096; i += F.G * NT) {
        const int c = i & 63, d = (i >> 6) & 63, n = (i >> 12) & 7, gate = (i >> 15) & 1, ld = i >> 16;
        const float* src = gate ? F.in[I_BWI] : F.in[I_BWR];
        WSP(bf16, WS_LRUW)[i] = (bf16)f2bf(src[((size_t)ld * 8 + n) * 4096 + c * 64 + d]);
    }
}

template <int MODE>
__device__ __forceinline__ void norm_phase(Frame& F, int l) {
    LAS float* hs = (LAS float*)F.lds;
    LAS int* lcnt = (LAS int*)(F.lds + 65536);
    LAS int* lbase = lcnt + 32;
    const int ngroups = ((MODE == 2 || (MODE == 1 && l == DEPTH - 1)) ? TLAT : MROWS) / 16;
    const float* modl = WSP(float, WS_MOD) + (size_t)l * 5 * 6144;
    float pb0[32], pb1[32];
    if (MODE != 2) {
        REFRESH_TID(F);
        const int r16 = F.lane & 15, quad = F.lane >> 4, w = F.wave;
        const size_t stride = MODE == 0 ? (size_t)INW : (size_t)NEXP;
        const float* wp = (MODE == 0 ? F.in[I_WIN] + (size_t)l * D * INW + 3840 : F.in[I_WRT] + (size_t)l * D * NEXP) + (size_t)(128 * w + quad) * stride + r16;
#pragma unroll
        for (int s = 0; s < 32; ++s) { pb0[s] = wp[(size_t)(4 * s) * stride]; pb1[s] = MODE == 1 ? wp[(size_t)(4 * s) * stride + 16] : 0.f; }
    }
#pragma unroll 1
    for (int gi = F.bid; gi < ngroups; gi += F.G) {
        REFRESH_TID(F);
        if (MODE == 1) { if (F.tid < 32) lcnt[F.tid] = 0; }
        constexpr bool COMB = true;
        const bool comb = (MODE == 0 && l > 0) || MODE == 2;
        f32x4 vv[2][4]; v2u yv[2][4][4]; float swv[2][4];
#pragma unroll
        for (int i = 0; i < 2; ++i) {
            const int r = gi * 16 + 2 * F.wave + i;
            const float* xsrc;
            if (MODE == 0 && l == 0) xsrc = r < TLAT ? F.in[I_X] + (size_t)r * D : F.in[I_CTX] + (size_t)(r - TLAT) * D;
            else xsrc = WSP(float, WS_X) + (size_t)r * D;
#pragma unroll
            for (int j = 0; j < 4; ++j) vv[i][j] = *(const f32x4*)(xsrc + 4 * F.lane + 256 * j);
        }
        if (COMB && comb) {
            int srv[2][4];
#pragma unroll
            for (int i = 0; i < 2; ++i)
#pragma unroll
                for (int k = 0; k < 4; ++k) { const int r = gi * 16 + 2 * F.wave + i; srv[i][k] = WSP(int, WS_SROW)[r * 4 + k]; swv[i][k] = WSP(float, WS_SW)[r * 4 + k]; }
#pragma unroll
            for (int i = 0; i < 2; ++i)
#pragma unroll
                for (int k = 0; k < 4; ++k) { const bf16* yr = WSP(bf16, WS_YS) + (size_t)srv[i][k] * D;
#pragma unroll
                    for (int j = 0; j < 4; ++j) yv[i][k][j] = *(const v2u*)(yr + 4 * F.lane + 256 * j); }
        }
#pragma unroll
        for (int i = 0; i < 2; ++i) {
            const int lr = 2 * F.wave + i, r = gi * 16 + lr, mr = mod_row(r);
            f32x4 v[4];
#pragma unroll
            for (int j = 0; j < 4; ++j) v[j] = vv[i][j];
            if (comb) {
                const int lp = MODE == 2 ? DEPTH - 1 : l - 1;
                const float* gt2 = WSP(float, WS_MOD) + ((size_t)lp * 5 + mr) * 6144 + 5120;
                f32x4 cb[4];
#pragma unroll
                for (int j = 0; j < 4; ++j) cb[j] = (f32x4){0.f, 0.f, 0.f, 0.f};
#pragma unroll
                for (int k = 0; k < 4; ++k) { const float w = swv[i][k];
#pragma unroll
                    for (int j = 0; j < 4; ++j) { const v2u y = yv[i][k][j];
                        cb[j].x += w * bflo(y.x); cb[j].y += w * bfhi(y.x); cb[j].z += w * bflo(y.y); cb[j].w += w * bfhi(y.y); }
                }
#pragma unroll
                for (int j = 0; j < 4; ++j) { const f32x4 g = *(const f32x4*)(gt2 + 4 * F.lane + 256 * j); v[j] = v[j] + g * cb[j]; }
            }
            if (MODE == 0) {
#pragma unroll
                for (int j = 0; j < 4; ++j) *(f32x4*)(WSP(float, WS_X) + (size_t)r * D + 4 * F.lane + 256 * j) = v[j];
            }
            float ss = 0.f;
#pragma unroll
            for (int j = 0; j < 4; ++j) ss += (v[j].x * v[j].x + v[j].y * v[j].y) + (v[j].z * v[j].z + v[j].w * v[j].w);
            const float rstd = rsqrtf(wave_sum(ss) * (1.f / D) + EPS);
            if (MODE == 2) {
#pragma unroll
                for (int j = 0; j < 4; ++j) { const f32x4 g = *(const f32x4*)(F.in[I_GFIN] + 4 * F.lane + 256 * j);
                    *(f32x4*)(F.out + (size_t)r * D + 4 * F.lane + 256 * j) = v[j] * rstd * g; }
            } else {
                const float* gn = F.in[MODE == 0 ? I_G1 : I_G2] + l * D;
                const float* sh = modl + (size_t)mr * 6144 + (MODE == 0 ? 0 : 3072);
                const float* sc = sh + 1024;
#pragma unroll
                for (int j = 0; j < 4; ++j) { const int c0 = 4 * F.lane + 256 * j;
                    const f32x4 g = *(const f32x4*)(gn + c0), a = *(const f32x4*)(sh + c0), s = *(const f32x4*)(sc + c0);
                    const f32x4 h = (v[j] * rstd * g) * (s + 1.f) + a;
                    *(LAS f32x4*)(hs + lr * 1024 + c0) = h;
                    v2u o; o.x = pk2(h.x, h.y); o.y = pk2(h.z, h.w);
                    *(v2u*)(WSP(bf16, WS_H) + (size_t)r * D + c0) = o; }
            }
        }
        if (MODE == 2) continue;
        __syncthreads();
        LAS float* red = (LAS float*)(F.lds + 65536 + 256);
        {
            const int r16 = F.lane & 15, quad = F.lane >> 4, w = F.wave;
            const LAS float* hp = hs + r16 * 1024 + 128 * w + quad;
            f32x4 acc0 = (f32x4){0.f, 0.f, 0.f, 0.f}, acc1 = acc0;
#pragma unroll
            for (int s = 0; s < 32; ++s) { const float av = hp[4 * s];
                acc0 = __builtin_amdgcn_mfma_f32_16x16x4f32(av, pb0[s], acc0, 0, 0, 0);
                if (MODE == 1) acc1 = __builtin_amdgcn_mfma_f32_16x16x4f32(av, pb1[s], acc1, 0, 0, 0); }
#pragma unroll
            for (int j = 0; j < 4; ++j) { red[(w * 16 + 4 * quad + j) * 32 + r16] = acc0[j]; if (MODE == 1) red[(w * 16 + 4 * quad + j) * 32 + 16 + r16] = acc1[j]; }
        }
        __syncthreads();
        if (MODE == 0) {
            if (F.tid < 256) {
                const int lr = F.tid >> 4, col = F.tid & 15;
                float sacc = 0.f;
#pragma unroll
                for (int w = 0; w < 8; ++w) sacc += red[(w * 16 + lr) * 32 + col];
                WSP(float, WS_CAB)[(size_t)(gi * 16 + lr) * 16 + col] = sacc;
            }
        } else {
            const int lr = F.tid >> 5, e = F.tid & 31, r = gi * 16 + lr;
            float sacc = 0.f;
#pragma unroll
            for (int w = 0; w < 8; ++w) sacc += red[(w * 16 + lr) * 32 + e];
            const float lg = sacc + F.in[I_BRT][l * NEXP + e];
            float tv0, tv1, tv2, tv3; int ti0, ti1, ti2, ti3; bool taken = false;
#define TOP1(TV, TI) do { float bv = taken ? -INFINITY : lg; int bi = e; \
                _Pragma("unroll") for (int off = 16; off >= 1; off >>= 1) { const float ov = __shfl_xor(bv, off); const int oi = __shfl_xor(bi, off); \
                    if (ov > bv || (ov == bv && oi < bi)) { bv = ov; bi = oi; } } \
                TV = bv; TI = bi; if (bi == e) taken = true; } while (0)
            TOP1(tv0, ti0); TOP1(tv1, ti1); TOP1(tv2, ti2); TOP1(tv3, ti3);
#undef TOP1
            const float e1 = __expf(tv1 - tv0), e2 = __expf(tv2 - tv0), e3 = __expf(tv3 - tv0);
            const float inv = 1.f / (1.f + e1 + e2 + e3);
            const int my_e = e == 0 ? ti0 : (e == 1 ? ti1 : (e == 2 ? ti2 : ti3));
            const float my_w = e == 0 ? inv : (e == 1 ? e1 * inv : (e == 2 ? e2 * inv : e3 * inv));
            int pl = 0;
            if (e < 4) pl = atomicAdd((int*)&lcnt[my_e], 1);
            __syncthreads();
            if (F.tid < 32) { const int c = lcnt[F.tid]; lbase[F.tid] = c > 0 ? (int)__hip_atomic_fetch_add(F.ctl + CW_CNT + l * 32 + F.tid, (unsigned)c, __ATOMIC_RELAXED, __HIP_MEMORY_SCOPE_AGENT) : 0; }
            __syncthreads();
            if (e < 4) { const int p = lbase[my_e] + pl;
                WSP(int, WS_LIST)[(size_t)my_e * MROWS + p] = r * 4 + e;
                WSP(int, WS_SEP)[r * 4 + e] = (my_e << 20) | p;
                WSP(float, WS_SW)[r * 4 + e] = my_w; }
        }
        __syncthreads();
    }
}

__device__ __forceinline__ void moe_table(Frame& F, int l) {
    LAS int* tpre = (LAS int*)(F.lds + MISC_OFF + 256);
    LAS int* cnt = tpre + 40;
    __syncthreads();
    if (F.tid < 32) cnt[F.tid] = (int)__hip_atomic_load(F.ctl + CW_CNT + l * 32 + F.tid, __ATOMIC_RELAXED, __HIP_MEMORY_SCOPE_AGENT);
    __syncthreads();
    if (F.tid == 0) { int s = 0; for (int e = 0; e < 32; ++e) { tpre[e] = s; s += (cnt[e] + 255) >> 8; } tpre[32] = s; }
    __syncthreads();
}
__device__ __forceinline__ void moe_gather(Frame& F, int l) {
    moe_table(F, l);
    const LAS int* tpre = (const LAS int*)(F.lds + MISC_OFF + 256);
    const LAS int* cnt = tpre + 40;
    const int gw = F.bid * NWAVES + F.wave, NGW = F.G * NWAVES;
    REFRESH_TID(F);
    const int nrows_pad = tpre[32] * 256;
    int e = 0;
    for (int r0 = gw; r0 < nrows_pad; r0 += 8 * NGW) {
        int tk[8]; v4u ra[8], rb[8];
#pragma unroll
        for (int k = 0; k < 8; ++k) { const int r = r0 + k * NGW; tk[k] = -1;
            if (r < nrows_pad) { const int tau = r >> 8;
#pragma unroll 1
                while (tpre[e + 1] <= tau) ++e;
                const int p = r - tpre[e] * 256;
                if (p < cnt[e]) tk[k] = WSP(int, WS_LIST)[(size_t)e * MROWS + p]; } }
#pragma unroll
        for (int k = 0; k < 8; ++k) { const int tok = tk[k] >= 0 ? tk[k] >> 2 : 0; const v4u* src = (const v4u*)(WSP(bf16, WS_H) + (size_t)tok * D); ra[k] = src[F.lane]; rb[k] = src[F.lane + 64]; }
#pragma unroll
        for (int k = 0; k < 8; ++k) if (tk[k] >= 0) { const int dr = r0 + k * NGW; v4u* dst = (v4u*)(WSP(bf16, WS_HS) + (size_t)dr * D); dst[F.lane] = ra[k]; dst[F.lane + 64] = rb[k];
                if (F.lane == 0) WSP(int, WS_SROW)[tk[k]] = dr; }
    }
}


constexpr int AT_KP = 72, AT_VP = 68;
constexpr int AT_KB = 64 * AT_KP * 2, AT_VB = 64 * AT_VP * 2, AT_BUF = AT_KB + AT_VB;
constexpr int AT_RPB = 2 * AT_BUF;

__device__ __forceinline__ float max3f_(float a, float b, float c) { float r; asm("v_max3_f32 %0, %1, %2, %3" : "=v"(r) : "v"(a), "v"(b), "v"(c)); return r; }
struct AttnUnit {
    int kind;
    int b, hx, qx;
};

__device__ __forceinline__ void attn_unit(Frame& F, int l, const AttnUnit un) {
    REFRESH_TID(F);
    const int lane = F.lane, w = F.wave, q32 = lane & 31, hh = lane >> 5;
    const bf16* U = WSP(bf16, WS_U);
    const bool na = (un.kind & 1) != 0, ctxq = un.kind >= 2;
    const int b = un.b;
    int qrow0, qcol, kcol, ycol, nlat, krow_lat0, r_grid = 0, c0 = 0, rs_w = 0;
    const bf16* vt; bf16* Y;
    if (!na) {
        const int head = 4 * un.hx + (w & 3);
        qrow0 = (ctxq ? TLAT + b * LCTX : b * SEQ) + 64 * un.qx + 32 * (w >> 2);
        qcol = UQ + head * 64; kcol = UK + un.hx * 64; ycol = head * 64;
        vt = WSP(bf16, WS_VAT) + (size_t)(b * 2 + un.hx) * 64 * KEYS;
        Y = WSP(bf16, WS_Y);
        nlat = ctxq ? 0 : 64; krow_lat0 = b * SEQ;
    } else {
        const int head = un.hx;
        if (ctxq) { qrow0 = TLAT + b * LCTX + 32 * w; nlat = 0; krow_lat0 = 0; }
        else {
            r_grid = 4 * un.qx + (w >> 1); c0 = 32 * (w & 1);
            qrow0 = b * SEQ + 64 * r_grid + c0;
            int rs_min = 4 * un.qx - 4; rs_min = rs_min < 0 ? 0 : (rs_min > 56 ? 56 : rs_min);
            int rs_max = 4 * un.qx + 3 - 4; rs_max = rs_max < 0 ? 0 : (rs_max > 56 ? 56 : rs_max);
            nlat = rs_max + 8 - rs_min; krow_lat0 = b * SEQ + 64 * rs_min;
            rs_w = r_grid - 4; rs_w = rs_w < 0 ? 0 : (rs_w > 56 ? 56 : rs_w);
            rs_w -= rs_min;
        }
        qcol = UDQ + head * 64; kcol = UDK + head * 64; ycol = head * 64;
        vt = WSP(bf16, WS_VDT) + (size_t)(b * 8 + head) * 64 * KEYS;
        Y = WSP(bf16, WS_Y) + (size_t)3 * MROWS * 512;
    }
    const int vkey_lat0 = krow_lat0 - b * SEQ;
    const int ntile = nlat + 4;
    LAS unsigned char* lds = F.lds;
    if (na && !ctxq) {
        LAS float* rp = (LAS float*)(lds + AT_RPB);
        const float* src = F.in[I_RPB] + ((size_t)l * 8 + un.hx) * 465;
        for (int i = F.tid; i < 465; i += NT) rp[i] = src[i] * LOG2E;
    }
    bf16x8 qf[4];
    {
        const bf16* qp = U + (size_t)(qrow0 + q32) * UW + qcol + 8 * hh;
#pragma unroll
        for (int s = 0; s < 4; ++s) qf[s] = *(const bf16x8*)(qp + 16 * s);
        if (na) {
#pragma unroll
            for (int s = 0; s < 4; ++s) { v4u t = __builtin_bit_cast(v4u, qf[s]); const float sc = 0.125f * LOG2E;
                t.x = pk2(bflo(t.x) * sc, bfhi(t.x) * sc); t.y = pk2(bflo(t.y) * sc, bfhi(t.y) * sc); t.z = pk2(bflo(t.z) * sc, bfhi(t.z) * sc); t.w = pk2(bflo(t.w) * sc, bfhi(t.w) * sc);
                qf[s] = __builtin_bit_cast(bf16x8, t); }
        }
    }
    const int lk = F.tid >> 3, lc = F.tid & 7;
    v4u kr[4], vr[4];
#define AT_TILE_ADDR(i, krow0_, vkey0_) do { const int i_ = (i) < ntile ? (i) : ntile - 1; \
        if (i_ < nlat) { krow0_ = krow_lat0 + 64 * i_; vkey0_ = vkey_lat0 + 64 * i_; } else { krow0_ = TLAT + b * LCTX + 64 * (i_ - nlat); vkey0_ = SEQ + 64 * (i_ - nlat); } } while (0)
#define AT_LDK(dst, i) do { int kr0_, vk0_; AT_TILE_ADDR(i, kr0_, vk0_); (void)vk0_; dst = *(const v4u*)(U + (size_t)(kr0_ + lk) * UW + kcol + lc * 8); } while (0)
#define AT_LDV(dst, i) do { int kr0_, vk0_; AT_TILE_ADDR(i, kr0_, vk0_); (void)kr0_; dst = *(const v4u*)(vt + (size_t)lk * KEYS + vk0_ + lc * 8); } while (0)
#define AT_STK(src, buf) do { *(LAS v4u*)(lds + (buf) * AT_BUF + lk * (AT_KP * 2) + lc * 16) = src; } while (0)
#define AT_STV(src, buf) do { LAS unsigned char* b_ = lds + (buf) * AT_BUF + AT_KB + lk * (AT_VP * 2) + lc * 16; *(LAS v2u*)b_ = (v2u){src.x, src.y}; *(LAS v2u*)(b_ + 8) = (v2u){src.z, src.w}; } while (0)
    float m_run = 0.f, l_run = 0.f;
    f32x16 negm;
#pragma unroll
    for (int i = 0; i < 16; ++i) negm[i] = 0.f;
    bool first = true;
    f32x16 o0, o1;
#pragma unroll
    for (int i = 0; i < 16; ++i) { o0[i] = 0.f; o1[i] = 0.f; }
    const int cq = c0 + q32;
    int cst = cq - 8; cst = cst < 0 ? 0 : (cst > 48 ? 48 : cst);
#define AT_ACTIVE(i) (!(na && !ctxq && (i) < nlat && ((i) < rs_w || (i) > rs_w + 7)))
#define AT_QK(S0, S1, buf) do { const LAS unsigned char* kb_ = lds + (buf) * AT_BUF; \
        _Pragma("unroll") for (int s = 0; s < 4; ++s) { \
            const bf16x8 k0 = *(const LAS bf16x8*)(kb_ + (q32) * (AT_KP * 2) + (16 * s + 8 * hh) * 2); \
            const bf16x8 k1 = *(const LAS bf16x8*)(kb_ + (32 + q32) * (AT_KP * 2) + (16 * s + 8 * hh) * 2); \
            S0 = __builtin_amdgcn_mfma_f32_32x32x16_bf16(k0, qf[s], s == 0 ? negm : S0, 0, 0, 0); \
            S1 = __builtin_amdgcn_mfma_f32_32x32x16_bf16(k1, qf[s], s == 0 ? negm : S1, 0, 0, 0); } } while (0)
#define AT_SOFTMAX_PV(C0, C1, N0, N1, nvalid, i, vbuf) do { \
        if (na && !ctxq && (i) < nlat) { \
            const LAS float* rp = (const LAS float*)(lds + AT_RPB); \
            const int kr_ = (krow_lat0 - b * SEQ) / 64 + (i); const int rb = (kr_ - r_grid + 7) * 31 + 15 - cq; \
            _Pragma("unroll") for (int j = 0; j < 16; ++j) { \
                const int kc0 = (j & 3) + 8 * (j >> 2) + 4 * hh, kc1 = kc0 + 32; \
                const bool ok0 = kc0 >= cst && kc0 < cst + 16, ok1 = kc1 >= cst && kc1 < cst + 16; \
                int i0_ = rb + kc0, i1_ = rb + kc1; i0_ = i0_ < 0 ? 0 : (i0_ > 464 ? 464 : i0_); i1_ = i1_ < 0 ? 0 : (i1_ > 464 ? 464 : i1_); \
                const float b0 = rp[i0_], b1 = rp[i1_]; \
                C0[j] = ok0 ? C0[j] + b0 : -1e30f; C1[j] = ok1 ? C1[j] + b1 : -1e30f; } } \
        float mx = max3f_(C0[0], C1[0], C0[1]); \
        mx = max3f_(mx, C1[1], C0[2]); mx = max3f_(mx, C1[2], C0[3]); mx = max3f_(mx, C1[3], C0[4]); mx = max3f_(mx, C1[4], C0[5]); mx = max3f_(mx, C1[5], C0[6]); \
        mx = max3f_(mx, C1[6], C0[7]); mx = max3f_(mx, C1[7], C0[8]); mx = max3f_(mx, C1[8], C0[9]); mx = max3f_(mx, C1[9], C0[10]); mx = max3f_(mx, C1[10], C0[11]); \
        mx = max3f_(mx, C1[11], C0[12]); mx = max3f_(mx, C1[12], C0[13]); mx = max3f_(mx, C1[13], C0[14]); mx = max3f_(mx, C1[14], C0[15]); mx = fmaxf(mx, C1[15]); \
        mx = fmaxf(mx, __shfl_xor(mx, 32)); \
        if (first || __builtin_amdgcn_ballot_w64(mx > 6.f) != 0ull) {     \
            const float d = first ? fmaxf(mx, -120.f) : fmaxf(mx, 0.f); \
            const float alpha = __builtin_amdgcn_exp2f(-d); \
            l_run *= alpha; m_run += d; \
            _Pragma("unroll") for (int j = 0; j < 16; ++j) { o0[j] *= alpha; o1[j] *= alpha; C0[j] -= d; C1[j] -= d; negm[j] = -m_run; } \
            if (nvalid) { _Pragma("unroll") for (int j = 0; j < 16; ++j) { N0[j] -= d; N1[j] -= d; } } \
            first = false; } \
        float ps = 0.f; \
        _Pragma("unroll") for (int j = 0; j < 16; ++j) { C0[j] = __builtin_amdgcn_exp2f(C0[j]); C1[j] = __builtin_amdgcn_exp2f(C1[j]); ps += C0[j]; ps += C1[j]; } \
        l_run += ps; \
        bf16x8 pb[2][2]; \
        _Pragma("unroll") for (int s2 = 0; s2 < 2; ++s2) { v4u t0, t1; \
            t0.x = pk2(C0[8 * s2 + 0], C0[8 * s2 + 1]); t0.y = pk2(C0[8 * s2 + 2], C0[8 * s2 + 3]); t0.z = pk2(C0[8 * s2 + 4], C0[8 * s2 + 5]); t0.w = pk2(C0[8 * s2 + 6], C0[8 * s2 + 7]); \
            t1.x = pk2(C1[8 * s2 + 0], C1[8 * s2 + 1]); t1.y = pk2(C1[8 * s2 + 2], C1[8 * s2 + 3]); t1.z = pk2(C1[8 * s2 + 4], C1[8 * s2 + 5]); t1.w = pk2(C1[8 * s2 + 6], C1[8 * s2 + 7]); \
            pb[0][s2] = __builtin_bit_cast(bf16x8, t0); pb[1][s2] = __builtin_bit_cast(bf16x8, t1); } \
        const LAS unsigned char* vb_ = lds + (vbuf) * AT_BUF + AT_KB; \
        _Pragma("unroll") for (int sub = 0; sub < 2; ++sub) _Pragma("unroll") for (int s2 = 0; s2 < 2; ++s2) { \
            const int ko = (32 * sub + 16 * s2 + 4 * hh) * 2; \
            const v2u a0 = *(const LAS v2u*)(vb_ + (q32) * (AT_VP * 2) + ko), a1 = *(const LAS v2u*)(vb_ + (q32) * (AT_VP * 2) + ko + 16); \
            const v2u c0_ = *(const LAS v2u*)(vb_ + (32 + q32) * (AT_VP * 2) + ko), c1_ = *(const LAS v2u*)(vb_ + (32 + q32) * (AT_VP * 2) + ko + 16); \
            const bf16x8 vf0 = __builtin_bit_cast(bf16x8, ((v4u){a0.x, a0.y, a1.x, a1.y})); \
            const bf16x8 vf1 = __builtin_bit_cast(bf16x8, ((v4u){c0_.x, c0_.y, c1_.x, c1_.y})); \
            o0 = __builtin_amdgcn_mfma_f32_32x32x16_bf16(vf0, pb[sub][s2], o0, 0, 0, 0); \
            o1 = __builtin_amdgcn_mfma_f32_32x32x16_bf16(vf1, pb[sub][s2], o1, 0, 0, 0); } } while (0)
    f32x16 sa0, sa1, sb0, sb1;
    {
        v4u k0r, k1r, v0r; AT_LDK(k0r, 0); AT_LDK(k1r, 1); AT_LDV(v0r, 0);
#pragma unroll
        for (int st = 0; st < 4; ++st) { AT_LDK(kr[st], st + 2); AT_LDV(vr[st], st + 1); }
        AT_STK(k0r, 0); AT_STK(k1r, 1); AT_STV(v0r, 0);
        lds_barrier();
        if (AT_ACTIVE(0)) AT_QK(sa0, sa1, 0);
        lds_barrier();
    }
    const int ntile4 = (ntile + 3) & ~3;
#pragma unroll 1
    for (int i0 = 0; i0 < ntile4; i0 += 4) {
#pragma unroll
      for (int st = 0; st < 4; ++st) {
        const int i = i0 + st;
        AT_STK(kr[st], st & 1); AT_STV(vr[st], (st + 1) & 1);
        AT_LDK(kr[st], i + 6); AT_LDV(vr[st], i + 5);
        const bool nvalid = (i + 1 < ntile) && AT_ACTIVE(i + 1);
        if (st & 1) { if (nvalid) AT_QK(sa0, sa1, 0); if (i < ntile && AT_ACTIVE(i)) AT_SOFTMAX_PV(sb0, sb1, sa0, sa1, nvalid, i, 1); }
        else        { if (nvalid) AT_QK(sb0, sb1, 1); if (i < ntile && AT_ACTIVE(i)) AT_SOFTMAX_PV(sa0, sa1, sb0, sb1, nvalid, i, 0); }
        lds_barrier();
      }
    }
#undef AT_TILE_ADDR
#undef AT_LDK
#undef AT_LDV
#undef AT_STK
#undef AT_STV
#undef AT_ACTIVE
#undef AT_QK
#undef AT_SOFTMAX_PV
    const float lt = l_run + __shfl_xor(l_run, 32);
    const float inv = 1.f / lt;
    bf16* yp = Y + (size_t)(qrow0 + q32) * 512 + ycol + 4 * hh;
#pragma unroll
    for (int g = 0; g < 4; ++g) {
        v2u a; a.x = pk2(o0[4 * g] * inv, o0[4 * g + 1] * inv); a.y = pk2(o0[4 * g + 2] * inv, o0[4 * g + 3] * inv);
        v2u c; c.x = pk2(o1[4 * g] * inv, o1[4 * g + 1] * inv); c.y = pk2(o1[4 * g + 2] * inv, o1[4 * g + 3] * inv);
        *(v2u*)(yp + 8 * g) = a; *(v2u*)(yp + 32 + 8 * g) = c;
    }
    __syncthreads();
}

__device__ __forceinline__ void attn_phase(Frame& F, int l) {
    const int x = F.bid & 7, y = F.bid >> 3, ny = F.G >> 3;
    for (int q = y; q < 64; q += ny) { AttnUnit un; un.kind = 0; un.b = x >> 1; un.hx = x & 1; un.qx = q; attn_unit(F, l, un); }
    for (int q = y; q < 64; q += ny) { const int combo = x + 8 * (q >> 4); AttnUnit un; un.kind = 1; un.b = combo >> 3; un.hx = combo & 7; un.qx = q & 15; attn_unit(F, l, un); }
    for (int q = y; q < 8; q += ny) { AttnUnit un;
        if (q < 4) { un.kind = 2; un.b = x >> 1; un.hx = x & 1; un.qx = q; }
        else { const int combo = x + 8 * (q - 4); un.kind = 3; un.b = combo >> 3; un.hx = combo & 7; un.qx = 0; }
        attn_unit(F, l, un); }
}


__device__ __forceinline__ void qk_prep(Frame& F, int l) {
    REFRESH_TID(F);
    const int gw = F.bid * NWAVES + F.wave, NGW = F.G * NWAVES, lane = F.lane;
    bf16* U = WSP(bf16, WS_U);
    const float* tab = WSP(float, WS_ROPE);
    const int d0 = (lane & 7) * 8;
    float gq[8], gk[8];
#pragma unroll
    for (int j = 0; j < 8; ++j) { gq[j] = F.in[I_AGQ][l * 64 + d0 + j]; gk[j] = F.in[I_AGK][l * 64 + d0 + j]; }
    for (int r0 = gw; r0 < MROWS; r0 += 2 * NGW) {
        const int r1 = r0 + NGW;
        v4u qv2[2], kv2[2];
#pragma unroll
        for (int k = 0; k < 2; ++k) { const int r = k ? (r1 < MROWS ? r1 : r0) : r0; const bf16* up = U + (size_t)r * UW;
            qv2[k] = *(const v4u*)(up + UQ + lane * 8); kv2[k] = (v4u){0u, 0u, 0u, 0u}; if (lane < 16) kv2[k] = *(const v4u*)(up + UK + lane * 8); }
#pragma unroll
        for (int k = 0; k < 2; ++k) {
        const int r = k ? r1 : r0; if (r >= MROWS) break;
        const bool lat = r < TLAT;
        bf16* up = U + (size_t)r * UW;
        const v4u qv = qv2[k], kv = kv2[k];
        float cs[8], sn[8];
#pragma unroll
        for (int j = 0; j < 8; ++j) { cs[j] = 1.f; sn[j] = 0.f; }
        if (lat) { const int t = r & 4095;
#pragma unroll
            for (int j = 0; j < 8; ++j) { const int i = (d0 + j) & 31; const int idx = i < 16 ? (t >> 6) * 16 + i : (t & 63) * 16 + (i - 16); cs[j] = tab[idx]; sn[j] = tab[1024 + idx]; } }
#pragma unroll
        for (int which = 0; which < 2; ++which) {
            const v4u raw = which ? kv : qv;
            float x[8] = {bflo(raw.x), bfhi(raw.x), bflo(raw.y), bfhi(raw.y), bflo(raw.z), bfhi(raw.z), bflo(raw.w), bfhi(raw.w)};
            float ss = 0.f;
#pragma unroll
            for (int j = 0; j < 8; ++j) ss += x[j] * x[j];
            ss += __shfl_xor(ss, 1); ss += __shfl_xor(ss, 2); ss += __shfl_xor(ss, 4);
            const float rs = rsqrtf(ss * (1.f / 64.f) + EPS);
            float y[8];
#pragma unroll
            for (int j = 0; j < 8; ++j) y[j] = x[j] * rs * (which ? gk[j] : gq[j]);
            const bool hi = (lane & 4) != 0;
#pragma unroll
            for (int j = 0; j < 8; ++j) { const float p = __shfl_xor(y[j], 4);
                if (lat) y[j] = hi ? y[j] * cs[j] + p * sn[j] : y[j] * cs[j] - p * sn[j];
                if (!which) y[j] *= 0.125f * LOG2E; }
            v4u o; o.x = pk2(y[0], y[1]); o.y = pk2(y[2], y[3]); o.z = pk2(y[4], y[5]); o.w = pk2(y[6], y[7]);
            if (!which) *(v4u*)(up + UQ + lane * 8) = o; else if (lane < 16) *(v4u*)(up + UK + lane * 8) = o;
        }
        }
    }
}

__device__ __forceinline__ void v_transpose(Frame& F) {
    REFRESH_TID(F);
    const int gw = F.bid * NWAVES + F.wave, NGW = F.G * NWAVES, lane = F.lane;
    LAS bf16* T = (LAS bf16*)(F.lds + F.wave * 9216);
    const bf16* U = WSP(bf16, WS_U);
    for (int it = gw; it < NCHUNK * 10; it += NGW) {
        const int g = it / 10, hd = it % 10;
        int b, key0;
        if (g < 256) { b = g >> 6; key0 = (g & 63) * 64; } else { b = (g - 256) >> 2; key0 = SEQ + ((g - 256) & 3) * 64; }
        const int scol = hd < 2 ? UV + hd * 64 : UDV + (hd - 2) * 64;
        bf16* dst = hd < 2 ? WSP(bf16, WS_VAT) + (size_t)(b * 2 + hd) * 64 * KEYS : WSP(bf16, WS_VDT) + (size_t)(b * 8 + hd - 2) * 64 * KEYS;
        v4u rv[8];
#pragma unroll
        for (int i = 0; i < 8; ++i) { const int tok = 8 * i + (lane >> 3), ch = lane & 7; rv[i] = *(const v4u*)(U + (size_t)(64 * g + tok) * UW + scol + ch * 8); }
#pragma unroll
        for (int i = 0; i < 8; ++i) { const int tok = 8 * i + (lane >> 3), ch = lane & 7; const unsigned wv[4] = {rv[i].x, rv[i].y, rv[i].z, rv[i].w};
#pragma unroll
            for (int j = 0; j < 4; ++j) { T[(ch * 8 + 2 * j) * 72 + tok] = (bf16)(wv[j] & 0xffffu); T[(ch * 8 + 2 * j + 1) * 72 + tok] = (bf16)(wv[j] >> 16); } }
        asm volatile("s_waitcnt lgkmcnt(0)" ::: "memory");
#pragma unroll
        for (int i = 0; i < 8; ++i) { const int d = 8 * i + (lane >> 3), ch = lane & 7;
            const v4u o = *(const LAS v4u*)(T + d * 72 + ch * 8);
            *(v4u*)(dst + (size_t)d * KEYS + key0 + ch * 8) = o; }
        asm volatile("s_waitcnt lgkmcnt(0)" ::: "memory");
    }
}

constexpr int LR_XCB = 0, LR_WV = 17408, LR_WVB = 12288;
__device__ __forceinline__ void seq_bounds(int g, int& lo, int& hi) {
    if (g < 256) { lo = (g >> 6) * SEQ; hi = lo + SEQ; } else { lo = TLAT + ((g - 256) >> 2) * LCTX; hi = lo + LCTX; }
}
struct LruRaw { v4u r[3]; };
__device__ __forceinline__ void lru_raw_load(Frame& F, LruRaw& R, int g, int q) {
    const bf16* U = WSP(bf16, WS_U);
    int lo, hi; seq_bounds(g, lo, hi);
#pragma unroll
    for (int k = 0; k < 3; ++k) { const int i = F.tid + NT * k, rr = i >> 4, ch = i & 15, row = 64 * g - 1 + rr;
        v4u v = (v4u){0u, 0u, 0u, 0u};
        if (i < 67 * 16 && row >= lo && row < hi) v = *(const v4u*)(U + (size_t)row * UW + UBX + 128 * q + ch * 8);
        R.r[k] = v; }
}
__device__ __forceinline__ void lru_stage_conv(Frame& F, int l, const LruRaw& R, int q) {
    LAS bf16* raw = (LAS bf16*)(F.lds + LR_WV);
    LAS bf16* xcb = (LAS bf16*)(F.lds + LR_XCB);
    lds_barrier();
#pragma unroll
    for (int k = 0; k < 3; ++k) { const int i = F.tid + NT * k, rr = i >> 4, ch = i & 15; if (i < 67 * 16) *(LAS v4u*)(raw + rr * 128 + ch * 8) = R.r[k]; }
    lds_barrier();
    {
        const int ch = F.tid & 127, tg = F.tid >> 7, cabs = 128 * q + ch;
        const float* cw = F.in[I_BCW] + (size_t)l * 4 * 512 + cabs;
        const float w0 = cw[0], w1 = cw[512], w2 = cw[1024], w3 = cw[1536], bb = F.in[I_BCB][l * 512 + cabs];
        float x0 = bf2f(raw[(16 * tg) * 128 + ch]), x1 = bf2f(raw[(16 * tg + 1) * 128 + ch]), x2 = bf2f(raw[(16 * tg + 2) * 128 + ch]);
#pragma unroll
        for (int t = 0; t < 16; ++t) { const float x3 = bf2f(raw[(16 * tg + t + 3) * 128 + ch]);
            const float y = bb + w0 * x0 + w1 * x1 + w2 * x2 + w3 * x3;
            xcb[(16 * tg + t) * 136 + ch] = (bf16)f2bf(y);
            x0 = x1; x1 = x2; x2 = x3; }
    }
    lds_barrier();
}
struct LruW { bf16x8 br0, br1, bi0, bi1; float bR, bI, lam; };
__device__ __forceinline__ void lru_w_load(Frame& F, LruW& W, int l, int dir, int q) {
    const int lane = F.lane, w = F.wave, r16 = lane & 15, quad = lane >> 4;
    const int nbl = w >> 2, dt = w & 3, nb = 2 * q + nbl;
    const bf16* wr = WSP(bf16, WS_LRUW) + ((((size_t)(l * 2 + dir) * 2 + 0) * 8 + nb) * 64 + 16 * dt + r16) * 64 + 8 * quad;
    const bf16* wi = WSP(bf16, WS_LRUW) + ((((size_t)(l * 2 + dir) * 2 + 1) * 8 + nb) * 64 + 16 * dt + r16) * 64 + 8 * quad;
    W.br0 = *(const bf16x8*)wr; W.br1 = *(const bf16x8*)(wr + 32); W.bi0 = *(const bf16x8*)wi; W.bi1 = *(const bf16x8*)(wi + 32);
    const int cabs = 64 * nb + 16 * dt + r16;
    W.bR = F.in[I_BBR][(l * 2 + dir) * 512 + cabs]; W.bI = F.in[I_BBI][(l * 2 + dir) * 512 + cabs]; W.lam = F.in[I_BLAM][(l * 2 + dir) * 512 + cabs];
}
__device__ __forceinline__ void lru_gates(Frame& F, const LruW& W) {
    const int lane = F.lane, w = F.wave, r16 = lane & 15, quad = lane >> 4;
    const LAS bf16* xcb = (const LAS bf16*)(F.lds + LR_XCB);
    LAS float* sa = (LAS float*)(F.lds + LR_WV + w * LR_WVB);
    LAS float* sb = sa + 1024;
    const int nbl = w >> 2, dt = w & 3;
    const int cl = 64 * nbl + 16 * dt + r16;
    const float sp = softplusf_(-W.lam);
#pragma unroll
    for (int tt = 0; tt < 4; ++tt) {
        const LAS bf16* ap = xcb + (16 * tt + r16) * 136 + 64 * nbl + 8 * quad;
        const bf16x8 a0 = *(const LAS bf16x8*)ap, a1 = *(const LAS bf16x8*)(ap + 32);
        f32x4 ar = (f32x4){0.f, 0.f, 0.f, 0.f}, ai = ar;
        ar = __builtin_amdgcn_mfma_f32_16x16x32_bf16(a0, W.br0, ar, 0, 0, 0); ar = __builtin_amdgcn_mfma_f32_16x16x32_bf16(a1, W.br1, ar, 0, 0, 0);
        ai = __builtin_amdgcn_mfma_f32_16x16x32_bf16(a0, W.bi0, ai, 0, 0, 0); ai = __builtin_amdgcn_mfma_f32_16x16x32_bf16(a1, W.bi1, ai, 0, 0, 0);
#pragma unroll
        for (int j = 0; j < 4; ++j) { const int t = 16 * tt + 4 * quad + j;
            const float rg = sigmoidf_(ar[j] + W.bR), ig = sigmoidf_(ai[j] + W.bI);
            const float la = -8.f * rg * sp;
            const float a = __expf(la), x2 = 2.f * la;
            const float om = x2 > -0.05f ? -x2 * (1.f + x2 * (0.5f + x2 * (0.16666667f + x2 * 0.041666668f))) : 1.f - __expf(x2);
            const float mult = __builtin_amdgcn_sqrtf(om);
            const float xv = bf2f(xcb[t * 136 + cl]);
            sa[t * 16 + r16] = a; sb[t * 16 + r16] = mult * ig * xv; }
    }
    asm volatile("s_waitcnt lgkmcnt(0)" ::: "memory");
}
__device__ __forceinline__ void lru_pass1(Frame& F, int l) {
    const bool even = F.G == 256;
    const int nit = even ? (F.bid < 64 ? 2 : 5) : (NCHUNK * 4 - F.bid + F.G - 1) / F.G;
#define LRU1_ITEM(k) (even ? (F.bid < 64 ? F.bid + 64 * (k) : 128 + (F.bid - 64) * 5 + (k)) : F.bid + F.G * (k))
    LruRaw R; REFRESH_TID(F);
    if (nit > 0) { const int i0 = LRU1_ITEM(0); lru_raw_load(F, R, i0 >> 2, i0 & 3); }
#pragma unroll 1
    for (int kk = 0; kk < nit; ++kk) {
        const int it = LRU1_ITEM(kk);
        REFRESH_TID(F);
        const int g = it >> 2, q = it & 3;
        LruW W0, W1; lru_w_load(F, W0, l, 0, q); lru_w_load(F, W1, l, 1, q);
        lru_stage_conv(F, l, R, q);
        { const int itn = kk + 1 < nit ? LRU1_ITEM(kk + 1) : it; lru_raw_load(F, R, itn >> 2, itn & 3); }
#pragma unroll
        for (int dir = 0; dir < 2; ++dir) {
            lru_gates(F, dir ? W1 : W0);
            const int lane = F.lane, w = F.wave, ch = lane & 15, seg = lane >> 4;
            const LAS float* sa = (const LAS float*)(F.lds + LR_WV + w * LR_WVB); const LAS float* sb = sa + 1024;
            float A = 1.f, B = 0.f;
#pragma unroll
            for (int k = 0; k < 16; ++k) { const int tp = 16 * seg + k, t = dir ? 63 - tp : tp; const float a = sa[t * 16 + ch]; B = a * B + sb[t * 16 + ch]; A *= a; }
            float At = 1.f, Bt = 0.f;
#pragma unroll
            for (int s = 0; s < 4; ++s) { const float As = __shfl(A, 16 * s + ch), Bs = __shfl(B, 16 * s + ch); Bt = As * Bt + Bs; At *= As; }
            if (seg == 0) { const int cabs = 128 * q + 64 * (w >> 2) + 16 * (w & 3) + ch;
                WSP(float, WS_LRA)[((size_t)g * 2 + dir) * 512 + cabs] = At; WSP(float, WS_LRB)[((size_t)g * 2 + dir) * 512 + cabs] = Bt; }
            asm volatile("s_waitcnt lgkmcnt(0)" ::: "memory");
        }
    }
}
__device__ __forceinline__ void lru_carry_all(Frame& F) {
    REFRESH_TID(F);
    if (F.tid >= 16) return;
    const float* LA = WSP(float, WS_LRA); const float* LB = WSP(float, WS_LRB); float* LC = WSP(float, WS_LRC);
    for (int chain = F.bid * 16 + F.tid; chain < 4096; chain += F.G * 16) {
        const int ch = chain & 511, dir = (chain >> 9) & 1, b = chain >> 10;
        float h = 0.f;
#pragma unroll 1
        for (int sb = 0; sb < 4; ++sb) {
            float av[17], bv[17]; size_t ix[17];
#pragma unroll
            for (int k = 0; k < 17; ++k) { const int s = sb * 17 + k; int g;
                if (s < 4) g = 256 + 4 * b + (dir ? 3 - s : s); else g = 64 * b + (dir ? 63 - (s - 4) : (s - 4));
                ix[k] = ((size_t)g * 2 + dir) * 512 + ch; av[k] = LA[ix[k]]; bv[k] = LB[ix[k]]; }
#pragma unroll
            for (int k = 0; k < 17; ++k) { LC[ix[k]] = h; h = av[k] * h + bv[k]; }
        }
    }
}
__device__ __forceinline__ float gelu_tanh(float x) { const float u = 0.7978845608028654f * (x + 0.044715f * x * x * x); return x * __builtin_amdgcn_rcpf(1.f + __expf(-2.f * u)); }
__device__ __forceinline__ void lru_pass2(Frame& F, int l) {
    int it = F.bid;
    const int nitems = (l == DEPTH - 1 ? 256 : NCHUNK) * 4;
    LruRaw R; REFRESH_TID(F);
    if (it < nitems) lru_raw_load(F, R, it >> 2, it & 3);
#pragma unroll 1
    for (; it < nitems; it += F.G) {
        REFRESH_TID(F);
        const int g = it >> 2, q = it & 3;
        const int lane = F.lane, w = F.wave, ch = lane & 15, seg = lane >> 4;
        const int cabs = 128 * q + 64 * (w >> 2) + 16 * (w & 3) + ch;
        const bf16* U = WSP(bf16, WS_U); bf16* YB = WSP(bf16, WS_Y) + (size_t)1 * MROWS * 512;
        LruW W0, W1; lru_w_load(F, W0, l, 0, q); lru_w_load(F, W1, l, 1, q);
        const float hc0 = WSP(float, WS_LRC)[((size_t)g * 2 + 0) * 512 + cabs], hc1 = WSP(float, WS_LRC)[((size_t)g * 2 + 1) * 512 + cabs];
        unsigned yraw[16];
#pragma unroll
        for (int k = 0; k < 16; ++k) yraw[k] = U[((size_t)64 * g + 16 * seg + k) * UW + UBY + cabs];
        lru_stage_conv(F, l, R, q);
        { const int itn = it + F.G < nitems ? it + F.G : it; lru_raw_load(F, R, itn >> 2, itn & 3); }
        LAS float* sa = (LAS float*)(F.lds + LR_WV + w * LR_WVB); LAS float* sb = sa + 1024; LAS float* sh = sa + 2048;
#pragma unroll
        for (int dir = 0; dir < 2; ++dir) {
            lru_gates(F, dir ? W1 : W0);
            float A = 1.f, B = 0.f;
#pragma unroll
            for (int k = 0; k < 16; ++k) { const int tp = 16 * seg + k, t = dir ? 63 - tp : tp; const float a = sa[t * 16 + ch]; B = a * B + sb[t * 16 + ch]; A *= a; }
            float h = dir ? hc1 : hc0;
#pragma unroll
            for (int s = 0; s < 3; ++s) { const float As = __shfl(A, 16 * s + ch), Bs = __shfl(B, 16 * s + ch); if (s < seg) h = As * h + Bs; }
#pragma unroll
            for (int k = 0; k < 16; ++k) { const int tp = 16 * seg + k, t = dir ? 63 - tp : tp; h = sa[t * 16 + ch] * h + sb[t * 16 + ch];
                if (dir == 0) sh[t * 16 + ch] = h; else sh[t * 16 + ch] += h; }
            asm volatile("s_waitcnt lgkmcnt(0)" ::: "memory");
        }
#pragma unroll
        for (int k = 0; k < 16; ++k) { const int t = 16 * seg + k; const size_t row = (size_t)64 * g + t;
            YB[row * 512 + cabs] = (bf16)f2bf(sh[t * 16 + ch] * gelu_tanh(bflo(yraw[k]))); }
        asm volatile("s_waitcnt lgkmcnt(0)" ::: "memory");
    }
}

#ifndef GDN_PREP_REPS
#define GDN_PREP_REPS 1
#endif
#ifdef PROBE_SUB
#define GP_T(k) do { if (PROBE_SUB == (k) && F.bid == 0) { const unsigned long long n_ = __builtin_amdgcn_s_memrealtime(); F.pr += n_ - gp_t; } gp_t = __builtin_amdgcn_s_memrealtime(); } while (0)
#else
#define GP_T(k) do { } while (0)
#endif
constexpr int GD_CW = MISC_OFF + 2048;
constexpr int GD_Q = 0, GD_K = 17408, GD_V = 34816, GD_KK = 52224, GD_QK = 68864, GD_L = 85504, GD_SM = 118272;
__device__ __forceinline__ void gdn_prep(Frame& F, int l) {
    const bf16* U = WSP(bf16, WS_U);
    const int w = F.wave;
    __syncthreads();
    for (int i = F.tid; i < 4 * 1536 / 2; i += NT) { const float* cw = F.in[I_CCW] + (size_t)l * 4 * 1536 + 2 * i; ((LAS unsigned*)(F.lds + GD_CW))[i] = pk2(cw[0], cw[1]); }
    __syncthreads();
#pragma unroll 1
    for (int it0 = F.bid; it0 < NCHUNK * 4 * GDN_PREP_REPS; it0 += F.G) {
        const int it = it0 % (NCHUNK * 4);
        int tid = F.tid; asm volatile("" : "+v"(tid));
        const int lane = tid & 63, r16 = lane & 15, quad = lane >> 4;
        const int g = it >> 2, h = it & 3;
        int lo, hi; seq_bounds(g, lo, hi);
        LAS bf16* raw = (LAS bf16*)(F.lds + GD_KK);
#ifdef PROBE_SUB
        unsigned long long gp_t = __builtin_amdgcn_s_memrealtime();
#endif
        lds_barrier();
        {
            v4u rv[7];
#pragma unroll
            for (int k = 0; k < 7; ++k) { const int i = tid + NT * k; const int ten = i / 1072, r_ = i - ten * 1072, rr = r_ >> 4, ch = r_ & 15, row = 64 * g - 1 + rr;
                const int ucol = (ten == 0 ? UCQ : (ten == 1 ? UCK : UCV)) + 128 * h;
                rv[k] = (v4u){0u, 0u, 0u, 0u};
                if (i < 3216 && row >= lo && row < hi) rv[k] = *(const v4u*)(U + (size_t)row * UW + ucol + ch * 8); }
#pragma unroll
            for (int k = 0; k < 7; ++k) { const int i = tid + NT * k; const int ten = i / 1072, r_ = i - ten * 1072, rr = r_ >> 4, ch = r_ & 15;
                if (i < 3216) *(LAS v4u*)(raw + ten * (67 * 128) + rr * 128 + ch * 8) = rv[k]; }
        }
        lds_barrier();
#pragma unroll 1
        for (int ten = 0; ten < 3; ++ten) {
            const int t = tid >> 3, ds = tid & 7;
            const LAS bf16* rawt = raw + ten * (67 * 128);
            const LAS bf16* cwl = (const LAS bf16*)(F.lds + GD_CW) + ten * 512 + 128 * h + 16 * ds;
            float y[16]; float ss = 0.f;
            {
                float xin[4][16], wv_[4][16];
#pragma unroll
                for (int j = 0; j < 4; ++j) { const v4u r0 = *(const LAS v4u*)(rawt + (t + j) * 128 + 16 * ds), r1 = *(const LAS v4u*)(rawt + (t + j) * 128 + 16 * ds + 8);
                    const v4u w0 = *(const LAS v4u*)(cwl + j * 1536), w1 = *(const LAS v4u*)(cwl + j * 1536 + 8);
                    const unsigned rv[8] = {r0.x, r0.y, r0.z, r0.w, r1.x, r1.y, r1.z, r1.w}, wq[8] = {w0.x, w0.y, w0.z, w0.w, w1.x, w1.y, w1.z, w1.w};
#pragma unroll
                    for (int q = 0; q < 8; ++q) { xin[j][2 * q] = bflo(rv[q]); xin[j][2 * q + 1] = bfhi(rv[q]); wv_[j][2 * q] = bflo(wq[q]); wv_[j][2 * q + 1] = bfhi(wq[q]); } }
#pragma unroll
                for (int jj = 0; jj < 16; ++jj) {
                    float a = 0.f;
#pragma unroll
                    for (int j = 0; j < 4; ++j) a += wv_[j][jj] * xin[j][jj];
                    a = siluf_(a); y[jj] = a; ss += a * a;
                }
            }
            float sc = 1.f;
            if (ten < 2) { ss += __shfl_xor(ss, 1); ss += __shfl_xor(ss, 2); ss += __shfl_xor(ss, 4); sc = rsqrtf(ss + EPS); if (ten == 0) sc *= 0.08838834764831845f; }
            LAS bf16* dstp = (LAS bf16*)(F.lds + (ten == 0 ? GD_Q : (ten == 1 ? GD_K : GD_V))) + t * 136 + 16 * ds;
            v4u o0, o1;
            o0.x = pk2(y[0] * sc, y[1] * sc); o0.y = pk2(y[2] * sc, y[3] * sc); o0.z = pk2(y[4] * sc, y[5] * sc); o0.w = pk2(y[6] * sc, y[7] * sc);
            o1.x = pk2(y[8] * sc, y[9] * sc); o1.y = pk2(y[10] * sc, y[11] * sc); o1.z = pk2(y[12] * sc, y[13] * sc); o1.w = pk2(y[14] * sc, y[15] * sc);
            *(LAS v4u*)dstp = o0; *(LAS v4u*)(dstp + 8) = o1;
        }
        lds_barrier();
        const LAS bf16* qs = (const LAS bf16*)(F.lds + GD_Q); const LAS bf16* ks = (const LAS bf16*)(F.lds + GD_K); const LAS bf16* vs = (const LAS bf16*)(F.lds + GD_V);
        GP_T(20);
        {
            const int mat = w >> 2, rt = w & 3;
            const LAS bf16* As = mat ? qs : ks;
            LAS float* Out = (LAS float*)(F.lds + (mat ? GD_QK : GD_KK));
            bf16x8 af[4];
#pragma unroll
            for (int s = 0; s < 4; ++s) af[s] = *(const LAS bf16x8*)(As + (16 * rt + r16) * 136 + 32 * s + 8 * quad);
#pragma unroll
            for (int ct = 0; ct < 4; ++ct) {
                f32x4 acc = (f32x4){0.f, 0.f, 0.f, 0.f};
#pragma unroll
                for (int s = 0; s < 4; ++s) { const bf16x8 bfr = *(const LAS bf16x8*)(ks + (16 * ct + r16) * 136 + 32 * s + 8 * quad);
                    acc = __builtin_amdgcn_mfma_f32_16x16x32_bf16(af[s], bfr, acc, 0, 0, 0); }
#pragma unroll
                for (int j = 0; j < 4; ++j) Out[(16 * rt + 4 * quad + j) * 65 + 16 * ct + r16] = acc[j];
            }
        }
        GP_T(21);
        int tid2 = F.tid; asm volatile("" : "+v"(tid2));
        const int dir = tid2 >> 8, dt = tid2 & 255;
        LAS float* sm = (LAS float*)(F.lds + GD_SM) + dir * 256;
        if (dt < 64) {
            const int ti = dir ? 63 - dt : dt; const size_t row = (size_t)64 * g + ti;
            const float ga = WSP(float, WS_CAB)[row * 16 + dir * 4 + h], gb = WSP(float, WS_CAB)[row * 16 + 8 + dir * 4 + h];
            const float gv = -__expf(F.in[I_CALOG][(l * 2 + dir) * 4 + h]) * softplusf_(ga + F.in[I_CDTB][(l * 2 + dir) * 4 + h]);
            float v = gv;
#pragma unroll
            for (int off = 1; off < 64; off <<= 1) { const float u = __builtin_bit_cast(float, __builtin_amdgcn_ds_bpermute(((lane - off) & 63) << 2, __builtin_bit_cast(int, v))); if (lane >= off) v += u; }
            sm[dt] = gv; sm[64 + dt] = sigmoidf_(gb); sm[128 + dt] = v; sm[192 + dt] = __expf(v);
        }
        lds_barrier();
        size_t cd;
        { int bq, cq_, stp; if (g < 256) { bq = g >> 6; cq_ = g & 63; stp = 4 + (dir ? 63 - cq_ : cq_); } else { bq = (g - 256) >> 2; cq_ = (g - 256) & 3; stp = dir ? 3 - cq_ : cq_; }
          cd = ((size_t)((bq * 4 + h) * 2 + dir)) * 68 + stp; }
        const LAS float* KK = (const LAS float*)(F.lds + GD_KK); const LAS float* QKm = (const LAS float*)(F.lds + GD_QK);
        LAS float* Ls = (LAS float*)(F.lds + GD_L) + dir * 4096;
        {
            bf16* gqk = WSP(bf16, WS_GQK) + cd * 4096;
            for (int idx = dt; idx < 4096; idx += 256) { const int i = idx >> 6, j = idx & 63; const int ti = dir ? 63 - i : i, tj = dir ? 63 - j : j;
                const float dec = j <= i ? __expf(sm[128 + i] - sm[128 + j]) : 0.f;
                Ls[idx] = j < i ? sm[64 + i] * KK[ti * 65 + tj] * dec : 0.f;
                gqk[idx] = (bf16)f2bf(QKm[ti * 65 + tj] * dec); }
        }
        lds_barrier();
        GP_T(22);
        if (F.tid < 256) {
            f32x2_t X[64];
            int ct_ = F.tid; asm volatile("" : "+v"(ct_));
            const int sdir = ct_ >> 7, cp = ct_ & 127;
            const LAS float* sms = (const LAS float*)(F.lds + GD_SM) + sdir * 256;
            const LAS float* Lss = (const LAS float*)(F.lds + GD_L) + sdir * 4096;
            size_t cds;
            { int bq, cq_, stp; if (g < 256) { bq = g >> 6; cq_ = g & 63; stp = 4 + (sdir ? 63 - cq_ : cq_); } else { bq = (g - 256) >> 2; cq_ = (g - 256) & 3; stp = sdir ? 3 - cq_ : cq_; }
              cds = ((size_t)((bq * 4 + h) * 2 + sdir)) * 68 + stp; }
            bf16* outp = WSP(bf16, WS_GW) + cds * 8192 + cp;
#pragma unroll
            for (int i = 0; i < 64; ++i) {
                const int ti = sdir ? 63 - i : i;
                const float be = sms[64 + i];
                f32x2_t a = {be * bf2f(vs[ti * 136 + cp]), be * sms[192 + i] * bf2f(ks[ti * 136 + cp])};
                f32x2_t p0 = {0.f, 0.f}, p1 = p0, p2 = p0, p3 = p0;
#pragma unroll
                for (int j = 0; j < i; ++j) { const float lv = Lss[i * 64 + j]; if ((j & 3) == 0) p0 += X[j] * lv; else if ((j & 3) == 1) p1 += X[j] * lv; else if ((j & 3) == 2) p2 += X[j] * lv; else p3 += X[j] * lv; }
                a -= (p0 + p1) + (p2 + p3);
                X[i] = a;
                outp[i * 128] = (bf16)f2bf(a.y);
                asm volatile("" ::: "memory");
            }
            v4u* up = (v4u*)(WSP(bf16, WS_GU) + cds * 8192 + (size_t)cp * 64);
#pragma unroll
            for (int q8 = 0; q8 < 8; ++q8) { v4u o; o.x = pk2(X[8 * q8].x, X[8 * q8 + 1].x); o.y = pk2(X[8 * q8 + 2].x, X[8 * q8 + 3].x); o.z = pk2(X[8 * q8 + 4].x, X[8 * q8 + 5].x); o.w = pk2(X[8 * q8 + 6].x, X[8 * q8 + 7].x); up[q8] = o; }
        }
        GP_T(23);
        {
            bf16* gqg = WSP(bf16, WS_GQG) + cd * 8192; bf16* gkd = WSP(bf16, WS_GKD) + cd * 8192;
            const float gl = sm[128 + 63];
            for (int idx = dt; idx < 8192; idx += 256) { const int i = idx >> 7, d = idx & 127; const int ti = dir ? 63 - i : i;
                gqg[idx] = (bf16)f2bf(bf2f(qs[ti * 136 + d]) * sm[192 + i]); }
            { const int i = dt & 63; const int ti = dir ? 63 - i : i; const float fk = __expf(gl - sm[128 + i]);
              for (int idx = dt; idx < 8192; idx += 256) { const int d = idx >> 6; gkd[idx] = (bf16)f2bf(bf2f(ks[ti * 136 + d]) * fk); } }
            if (dt == 0) WSP(float, WS_GGL)[cd] = __expf(gl);
        }
        GP_T(24);
    }
    __syncthreads();
}

constexpr int GS_ST = 0, GS_VN = 4352, GS_O = 8192;
struct GdnOps { bf16x8 a[4]; bf16x8 qk[2]; bf16x8 kd[2]; v2u uv; float gl; };
__device__ __forceinline__ bf16x8 ld16_asm(const void* p) { bf16x8 v; asm volatile("global_load_dwordx4 %0, %1, off" : "=v"(v) : "v"(p) : "memory"); return v; }
__device__ __forceinline__ v2u ld8_asm(const void* p) { v2u v; asm volatile("global_load_dwordx2 %0, %1, off" : "=v"(v) : "v"(p) : "memory"); return v; }
__device__ __forceinline__ float ld4_asm(const void* p) { float v; asm volatile("global_load_dword %0, %1, off" : "=v"(v) : "v"(p) : "memory"); return v; }
__device__ __forceinline__ void gdn_load_asm(Frame& F, GdnOps& o, size_t cd, int sl) {
    const int lane = F.lane, w = F.wave, r16 = lane & 15, quad = lane >> 4, rt = w & 3;
    const bf16* ap = (w < 4 ? WSP(bf16, WS_GW) : WSP(bf16, WS_GQG)) + cd * 8192 + (size_t)(16 * rt + r16) * 128 + 8 * quad;
#pragma unroll
    for (int s = 0; s < 4; ++s) o.a[s] = ld16_asm(ap + 32 * s);
    const bf16* kp = WSP(bf16, WS_GKD) + cd * 8192 + (size_t)(16 * w + r16) * 64 + 8 * quad;
    o.kd[0] = ld16_asm(kp); o.kd[1] = ld16_asm(kp + 32);
    const bf16* qp = WSP(bf16, WS_GQK) + cd * 4096 + (size_t)(16 * rt + r16) * 64 + 8 * quad;
    o.qk[0] = ld16_asm(qp); o.qk[1] = ld16_asm(qp + 32);
    o.uv = ld8_asm(WSP(bf16, WS_GU) + cd * 8192 + (size_t)(16 * sl + r16) * 64 + 16 * rt + 4 * quad);
    o.gl = ld4_asm(WSP(float, WS_GGL) + cd);
}
__device__ __forceinline__ void gdn_load(Frame& F, GdnOps& o, size_t cd, int sl) {
    const int lane = F.lane, w = F.wave, r16 = lane & 15, quad = lane >> 4, rt = w & 3;
    const bf16* ap = (w < 4 ? WSP(bf16, WS_GW) : WSP(bf16, WS_GQG)) + cd * 8192 + (size_t)(16 * rt + r16) * 128 + 8 * quad;
#pragma unroll
    for (int s = 0; s < 4; ++s) o.a[s] = *(const bf16x8*)(ap + 32 * s);
    const bf16* kp = WSP(bf16, WS_GKD) + cd * 8192 + (size_t)(16 * w + r16) * 64 + 8 * quad;
    o.kd[0] = *(const bf16x8*)kp; o.kd[1] = *(const bf16x8*)(kp + 32);
    { const bf16* qp = WSP(bf16, WS_GQK) + cd * 4096 + (size_t)(16 * rt + r16) * 64 + 8 * quad; o.qk[0] = *(const bf16x8*)qp; o.qk[1] = *(const bf16x8*)(qp + 32); }
    o.uv = *(const v2u*)(WSP(bf16, WS_GU) + cd * 8192 + (size_t)(16 * sl + r16) * 64 + 16 * rt + 4 * quad);
    o.gl = WSP(float, WS_GGL)[cd];
}
__device__ __forceinline__ size_t gdn_cd(int b, int h, int dir, int s) { return ((size_t)((b * 4 + h) * 2 + dir)) * 68 + s; }
__device__ __forceinline__ int gdn_g(int b, int dir, int s) {
    return s < 4 ? 256 + 4 * b + (dir ? 3 - s : s) : 64 * b + (dir ? 63 - (s - 4) : (s - 4)); }
__device__ __forceinline__ void gdn_scan(Frame& F, int chain) {
    REFRESH_TID(F);
    const int xq = chain & 7, yq = chain >> 3, cg = (yq >> 3) * 8 + xq, sl = yq & 7;
    const int dir = cg & 1, h = (cg >> 1) & 3, b = cg >> 3;
    const int lane = F.lane, w = F.wave, r16 = lane & 15, quad = lane >> 4, rt = w & 3;
    LAS bf16* St = (LAS bf16*)(F.lds + GS_ST); LAS bf16* VNt = (LAS bf16*)(F.lds + GS_VN);
    __syncthreads();
    for (int i = F.tid; i < (GS_VN + 2304) / 4; i += NT) ((LAS unsigned*)F.lds)[i] = 0u;
    __syncthreads();
    f32x4 sacc = (f32x4){0.f, 0.f, 0.f, 0.f};
    float* GO = WSP(float, WS_GO) + (size_t)dir * MROWS * 512;
    LAS float* Ost = (LAS float*)(F.lds + GS_O);
#define GDN_STEP(cur, s_) do { \
          \
        asm volatile("s_waitcnt vmcnt(30)" : "+v"(cur.a[0]), "+v"(cur.a[1]), "+v"(cur.a[2]), "+v"(cur.a[3]), "+v"(cur.kd[0]), "+v"(cur.kd[1]), "+v"(cur.qk[0]), "+v"(cur.qk[1]), "+v"(cur.uv), "+v"(cur.gl) :: "memory"); \
        bf16x8 sbf[4]; \
        _Pragma("unroll") for (int ks = 0; ks < 4; ++ks) sbf[ks] = *(const LAS bf16x8*)(St + r16 * 136 + 32 * ks + 8 * quad); \
        f32x4 acc = (f32x4){0.f, 0.f, 0.f, 0.f}; \
        _Pragma("unroll") for (int ks = 0; ks < 4; ++ks) acc = __builtin_amdgcn_mfma_f32_16x16x32_bf16(cur.a[ks], sbf[ks], acc, 0, 0, 0); \
        if (w < 4) { v2u o; o.x = pk2(bflo(cur.uv.x) - acc[0], bfhi(cur.uv.x) - acc[1]); o.y = pk2(bflo(cur.uv.y) - acc[2], bfhi(cur.uv.y) - acc[3]); \
            *(LAS v2u*)(VNt + r16 * 72 + 16 * rt + 4 * quad) = o; } \
        lds_barrier(); \
        const bf16x8 vb0 = *(const LAS bf16x8*)(VNt + r16 * 72 + 8 * quad), vb1 = *(const LAS bf16x8*)(VNt + r16 * 72 + 32 + 8 * quad); \
        if (w >= 4) { \
            acc = __builtin_amdgcn_mfma_f32_16x16x32_bf16(cur.qk[0], vb0, acc, 0, 0, 0); \
            acc = __builtin_amdgcn_mfma_f32_16x16x32_bf16(cur.qk[1], vb1, acc, 0, 0, 0); \
            _Pragma("unroll") for (int j = 0; j < 4; ++j) Ost[(((s_) & 3) * 64 + 16 * rt + 4 * quad + j) * 16 + r16] = acc[j]; } \
        sacc = sacc * cur.gl; \
        sacc = __builtin_amdgcn_mfma_f32_16x16x32_bf16(cur.kd[0], vb0, sacc, 0, 0, 0); \
        sacc = __builtin_amdgcn_mfma_f32_16x16x32_bf16(cur.kd[1], vb1, sacc, 0, 0, 0); \
        { v2u o; o.x = pk2(sacc[0], sacc[1]); o.y = pk2(sacc[2], sacc[3]); *(LAS v2u*)(St + r16 * 136 + 16 * w + 4 * quad) = o; } \
        lds_barrier(); \
    } while (0)
    GdnOps r0, r1, r2, r3;
    gdn_load_asm(F, r0, gdn_cd(b, h, dir, 0), sl); gdn_load_asm(F, r1, gdn_cd(b, h, dir, 1), sl); gdn_load_asm(F, r2, gdn_cd(b, h, dir, 2), sl); gdn_load_asm(F, r3, gdn_cd(b, h, dir, 3), sl);
#pragma unroll 1
    for (int s = 0; s < 68; s += 4) {
        GDN_STEP(r0, s);     gdn_load_asm(F, r0, gdn_cd(b, h, dir, (s + 4 < 68 ? s + 4 : 67)), sl);
        GDN_STEP(r1, s + 1); gdn_load_asm(F, r1, gdn_cd(b, h, dir, (s + 5 < 68 ? s + 5 : 67)), sl);
        GDN_STEP(r2, s + 2); gdn_load_asm(F, r2, gdn_cd(b, h, dir, (s + 6 < 68 ? s + 6 : 67)), sl);
        GDN_STEP(r3, s + 3);
#pragma unroll
        for (int k2 = 0; k2 < 2; ++k2) { const int idx = F.tid + 512 * k2, st = idx >> 8, i = (idx >> 2) & 63, qd = idx & 3;
            const f32x4 v = *(const LAS f32x4*)(Ost + (st * 64 + i) * 16 + 4 * qd);
            const int g = gdn_g(b, dir, s + st), ti = dir ? 63 - i : i;
            *(f32x4*)(GO + ((size_t)64 * g + ti) * 512 + h * 128 + 16 * sl + 4 * qd) = v; }
        gdn_load_asm(F, r3, gdn_cd(b, h, dir, (s + 7 < 68 ? s + 7 : 67)), sl);
    }
#undef GDN_STEP
    asm volatile("s_waitcnt vmcnt(0)" ::: "memory");
    __syncthreads();
}
template <int NCT> struct GdnOpsW { bf16x8 a[4]; bf16x8 qk[2]; bf16x8 kd[2]; v2u uv[NCT]; float gl; };
template <int NCT>
__device__ __forceinline__ void gdn_load_wide(Frame& F, GdnOpsW<NCT>& o, size_t cd, int part) {
    const int lane = F.lane, w = F.wave, r16 = lane & 15, quad = lane >> 4, rt = w & 3;
    const bf16* ap = (w < 4 ? WSP(bf16, WS_GW) : WSP(bf16, WS_GQG)) + cd * 8192 + (size_t)(16 * rt + r16) * 128 + 8 * quad;
#pragma unroll
    for (int s = 0; s < 4; ++s) o.a[s] = *(const bf16x8*)(ap + 32 * s);
    const bf16* kp = WSP(bf16, WS_GKD) + cd * 8192 + (size_t)(16 * w + r16) * 64 + 8 * quad;
    o.kd[0] = *(const bf16x8*)kp; o.kd[1] = *(const bf16x8*)(kp + 32);
    { const bf16* qp = WSP(bf16, WS_GQK) + cd * 4096 + (size_t)(16 * rt + r16) * 64 + 8 * quad; o.qk[0] = *(const bf16x8*)qp; o.qk[1] = *(const bf16x8*)(qp + 32); }
    const bf16* up = WSP(bf16, WS_GU) + cd * 8192 + (size_t)(part * NCT * 16 + r16) * 64 + 16 * rt + 4 * quad;
#pragma unroll
    for (int ct = 0; ct < NCT; ++ct) o.uv[ct] = *(const v2u*)(up + (size_t)ct * 16 * 64);
    o.gl = WSP(float, WS_GGL)[cd];
}
template <int NCT>
__device__ __forceinline__ void gdn_scan_wide(Frame& F, int cg, int part) {
    REFRESH_TID(F);
    constexpr int NC = NCT * 16, OFF_VN = NC * 136 * 2, OFF_O = OFF_VN + NC * 72 * 2;
    const int dir = cg & 1, h = (cg >> 1) & 3, b = cg >> 3;
    const int lane = F.lane, w = F.wave, r16 = lane & 15, quad = lane >> 4, rt = w & 3;
    LAS bf16* St = (LAS bf16*)(F.lds); LAS bf16* VNt = (LAS bf16*)(F.lds + OFF_VN); LAS float* Ost = (LAS float*)(F.lds + OFF_O);
    __syncthreads();
    for (int i = F.tid; i < OFF_O / 4; i += NT) ((LAS unsigned*)F.lds)[i] = 0u;
    __syncthreads();
    f32x4 sacc[NCT];
#pragma unroll
    for (int ct = 0; ct < NCT; ++ct) sacc[ct] = (f32x4){0.f, 0.f, 0.f, 0.f};
    float* GO = WSP(float, WS_GO) + (size_t)dir * MROWS * 512;
#define GDNW_STEP(cur, s_) do { \
        f32x4 acc[NCT]; \
        _Pragma("unroll") for (int ct = 0; ct < NCT; ++ct) { acc[ct] = (f32x4){0.f, 0.f, 0.f, 0.f}; \
            _Pragma("unroll") for (int ks = 0; ks < 4; ++ks) { const bf16x8 sb = *(const LAS bf16x8*)(St + (16 * ct + r16) * 136 + 32 * ks + 8 * quad); \
                acc[ct] = __builtin_amdgcn_mfma_f32_16x16x32_bf16(cur.a[ks], sb, acc[ct], 0, 0, 0); } } \
        if (w < 4) { _Pragma("unroll") for (int ct = 0; ct < NCT; ++ct) { v2u o; o.x = pk2(bflo(cur.uv[ct].x) - acc[ct][0], bfhi(cur.uv[ct].x) - acc[ct][1]); o.y = pk2(bflo(cur.uv[ct].y) - acc[ct][2], bfhi(cur.uv[ct].y) - acc[ct][3]); \
            *(LAS v2u*)(VNt + (16 * ct + r16) * 72 + 16 * rt + 4 * quad) = o; } } \
        lds_barrier(); \
        _Pragma("unroll") for (int ct = 0; ct < NCT; ++ct) { \
            const bf16x8 vb0 = *(const LAS bf16x8*)(VNt + (16 * ct + r16) * 72 + 8 * quad), vb1 = *(const LAS bf16x8*)(VNt + (16 * ct + r16) * 72 + 32 + 8 * quad); \
            if (w >= 4) { acc[ct] = __builtin_amdgcn_mfma_f32_16x16x32_bf16(cur.qk[0], vb0, acc[ct], 0, 0, 0); acc[ct] = __builtin_amdgcn_mfma_f32_16x16x32_bf16(cur.qk[1], vb1, acc[ct], 0, 0, 0); \
                _Pragma("unroll") for (int j = 0; j < 4; ++j) Ost[(16 * rt + 4 * quad + j) * NC + 16 * ct + r16] = acc[ct][j]; } \
            sacc[ct] = sacc[ct] * cur.gl; \
            sacc[ct] = __builtin_amdgcn_mfma_f32_16x16x32_bf16(cur.kd[0], vb0, sacc[ct], 0, 0, 0); \
            sacc[ct] = __builtin_amdgcn_mfma_f32_16x16x32_bf16(cur.kd[1], vb1, sacc[ct], 0, 0, 0); \
            { v2u o; o.x = pk2(sacc[ct][0], sacc[ct][1]); o.y = pk2(sacc[ct][2], sacc[ct][3]); *(LAS v2u*)(St + (16 * ct + r16) * 136 + 16 * w + 4 * quad) = o; } } \
        lds_barrier(); \
        { const int g = gdn_g(b, dir, (s_)); constexpr int TPR = NC / 16 ;   \
            for (int idx = F.tid; idx < 64 * TPR; idx += NT) { const int i = idx / TPR, c16 = (idx % TPR) * 16, ti = dir ? 63 - i : i; \
                float* gp = GO + ((size_t)64 * g + ti) * 512 + h * 128 + part * NC + c16; \
                _Pragma("unroll") for (int k4 = 0; k4 < 4; ++k4) *(f32x4*)(gp + 4 * k4) = *(const LAS f32x4*)(Ost + i * NC + c16 + 4 * k4); } } \
    } while (0)
    GdnOpsW<NCT> r0, r1;
    gdn_load_wide<NCT>(F, r0, gdn_cd(b, h, dir, 0), part); gdn_load_wide<NCT>(F, r1, gdn_cd(b, h, dir, 1), part);
#pragma unroll 1
    for (int s = 0; s < 68; s += 2) {
        GDNW_STEP(r0, s);     gdn_load_wide<NCT>(F, r0, gdn_cd(b, h, dir, (s + 2 < 68 ? s + 2 : 67)), part);
        GDNW_STEP(r1, s + 1); gdn_load_wide<NCT>(F, r1, gdn_cd(b, h, dir, (s + 3 < 68 ? s + 3 : 67)), part);
    }
#undef GDNW_STEP
    __syncthreads();
}
__device__ __forceinline__ void gdn_out(Frame& F, int l) {
    REFRESH_TID(F);
    const int gw = F.bid * NWAVES + F.wave, NGW = F.G * NWAVES, lane = F.lane;
    const float* G0 = WSP(float, WS_GO); const float* G1 = G0 + (size_t)MROWS * 512;
    const bf16* U = WSP(bf16, WS_U); bf16* YC = WSP(bf16, WS_Y) + (size_t)2 * MROWS * 512;
    const float g0 = F.in[I_CGOUT][l * 128 + 2 * lane], g1 = F.in[I_CGOUT][l * 128 + 2 * lane + 1];
    int rlo, rhi;
    const int nrows = l == DEPTH - 1 ? TLAT : MROWS;
    if (F.G == 256 && l < DEPTH - 1) { if (F.bid < 64) { rlo = 38 * F.bid; rhi = rlo + 38; } else { rlo = 2432 + 78 * (F.bid - 64); rhi = rlo + 78; } }
    else { const int per = (nrows + F.G - 1) / F.G; rlo = per * F.bid; rhi = rlo + per < nrows ? rlo + per : nrows; if (rlo > nrows) rlo = nrows; }
    for (int r0 = rlo + F.wave; r0 < rhi; r0 += 2 * NWAVES) {
        const int r1 = r0 + NWAVES < rhi ? r0 + NWAVES : r0;
        f32x2_t a[2][4], c[2][4]; unsigned zz[2][4];
#pragma unroll
        for (int k = 0; k < 2; ++k) { const int r = k ? r1 : r0;
#pragma unroll
            for (int h = 0; h < 4; ++h) { const size_t o = (size_t)r * 512 + h * 128 + 2 * lane;
                a[k][h] = *(const f32x2_t*)(G0 + o); c[k][h] = *(const f32x2_t*)(G1 + o); zz[k][h] = *(const unsigned*)(U + (size_t)r * UW + UCZ + h * 128 + 2 * lane); } }
#pragma unroll
        for (int k = 0; k < 2; ++k) { const int r = k ? r1 : r0; if (k == 1 && r1 == r0) break;
#pragma unroll
            for (int h = 0; h < 4; ++h) { const float a0 = a[k][h].x + c[k][h].x, a1 = a[k][h].y + c[k][h].y;
                const float ss = wave_sum(a0 * a0 + a1 * a1);
                const float rs = rsqrtf(ss * (1.f / 128.f) + EPS);
                *(unsigned*)(YC + (size_t)r * 512 + h * 128 + 2 * lane) = pk2(a0 * rs * g0 * siluf_(bflo(zz[k][h])), a1 * rs * g1 * siluf_(bfhi(zz[k][h]))); } }
    }
}


constexpr int SD_P = 136;
constexpr int SD_MAT = 64 * SD_P * 2, SD_BUF = 2 * SD_MAT;
struct SideRegs { v4u a[2], b[2]; };
__device__ __forceinline__ void side_g2r(SideRegs& R, const bf16* Ab, size_t lda, const bf16* Bb, size_t ldb, int tid) {
#pragma unroll
    for (int k = 0; k < 2; ++k) { const int pc = tid + 512 * k, r = pc >> 4, c = pc & 15;
        R.a[k] = *(const v4u*)(Ab + (size_t)r * lda + c * 8); R.b[k] = *(const v4u*)(Bb + (size_t)r * ldb + c * 8); }
}
__device__ __forceinline__ void side_r2l(const SideRegs& R, LAS unsigned char* buf, int tid) {
#pragma unroll
    for (int k = 0; k < 2; ++k) { const int pc = tid + 512 * k, r = pc >> 4, c = pc & 15;
        *(LAS v4u*)(buf + (r * SD_P + c * 8) * 2) = R.a[k]; *(LAS v4u*)(buf + SD_MAT + (r * SD_P + c * 8) * 2) = R.b[k]; }
}
__device__ __forceinline__ void side_lmma(f32x4& c0, f32x4& c1, const LAS unsigned char* buf, int rt, int chf, int r16, int quad) {
    const LAS bf16* A = (const LAS bf16*)buf + (16 * rt + r16) * SD_P + 8 * quad;
    const LAS bf16* B0 = (const LAS bf16*)(buf + SD_MAT) + (32 * chf + r16) * SD_P + 8 * quad;
    const LAS bf16* B1 = B0 + 16 * SD_P;
#pragma unroll
    for (int s = 0; s < 4; ++s) { const bf16x8 a = *(const LAS bf16x8*)(A + 32 * s);
        c0 = __builtin_amdgcn_mfma_f32_16x16x32_bf16(a, *(const LAS bf16x8*)(B0 + 32 * s), c0, 0, 0, 0);
        c1 = __builtin_amdgcn_mfma_f32_16x16x32_bf16(a, *(const LAS bf16x8*)(B1 + 32 * s), c1, 0, 0, 0); }
}
__device__ __forceinline__ void side_merge(Frame& F, int l) {
    REFRESH_TID(F);
    const int lane = F.lane, w = F.wave, r16 = lane & 15, quad = lane >> 4, rt = w & 3, chf = w >> 2;
    const bf16* U = WSP(bf16, WS_U);
    for (int tile = F.bid; tile < 256; tile += F.G) {
        const int rowT = TLAT + 64 * (tile >> 4), colT = 64 * (tile & 15);
        const int row0 = rowT + 16 * rt, col0 = colT + 32 * chf;
        f32x4 m0 = (f32x4){0.f, 0.f, 0.f, 0.f}, m1 = m0, c0 = m0, c1 = m0;
#define SM_A(q) (WSP(bf16, WS_Y) + ((size_t)((q) >> 2) * MROWS + rowT) * 512 + 128 * ((q) & 3))
#define SM_B(q) (WSP(bf16, WS_WBR) + (((size_t)l * 4 + ((q) >> 2)) * 1024 + colT) * 512 + 128 * ((q) & 3))
        SideRegs R[4];
        __syncthreads();
        side_g2r(R[0], SM_A(0), 512, SM_B(0), 512, F.tid); side_r2l(R[0], F.lds, F.tid);
#pragma unroll
        for (int j = 0; j < 4; ++j) side_g2r(R[j], SM_A(j + 1), 512, SM_B(j + 1), 512, F.tid);
        lds_barrier();
        unsigned short gr0[4], gr1[4];
#pragma unroll 1
        for (int q0 = 0; q0 < 16; q0 += 4) {
#pragma unroll
            for (int j = 0; j < 4; ++j) { const bf16* gp = U + (size_t)(row0 + 4 * quad + j) * UW + UG + (q0 >> 2) * 1024 + col0 + r16; gr0[j] = gp[0]; gr1[j] = gp[16]; }
#pragma unroll
            for (int j = 0; j < 4; ++j) { const int q = q0 + j;
                side_lmma(c0, c1, F.lds + (j & 1) * SD_BUF, rt, chf, r16, quad);
                side_r2l(R[j], F.lds + ((j + 1) & 1) * SD_BUF, F.tid);
                { const int qn = q + 5 < 16 ? q + 5 : 15; side_g2r(R[j], SM_A(qn), 512, SM_B(qn), 512, F.tid); }
                lds_barrier(); }
#pragma unroll
            for (int j = 0; j < 4; ++j) { m0[j] += sigmoidf_(bf2f(gr0[j])) * c0[j]; m1[j] += sigmoidf_(bf2f(gr1[j])) * c1[j]; }
            c0 = (f32x4){0.f, 0.f, 0.f, 0.f}; c1 = c0;
        }
#undef SM_A
#undef SM_B
#pragma unroll
        for (int j = 0; j < 4; ++j) { bf16* mp = WSP(bf16, WS_MB) + (size_t)(row0 + 4 * quad + j) * 1024 + col0 + r16;
            mp[0] = (bf16)f2bf(m0[j]); mp[16] = (bf16)f2bf(m1[j]); }
    }
}
__device__ __forceinline__ void side_outproj(Frame& F, int l) {
    REFRESH_TID(F);
    const int lane = F.lane, w = F.wave, r16 = lane & 15, quad = lane >> 4, rt = w & 3, chf = w >> 2;
    const float* gt = WSP(float, WS_MOD) + ((size_t)l * 5 + 4) * 6144 + 2048;
    for (int tile = F.bid; tile < 256; tile += F.G) {
        const int rowT = TLAT + 64 * (tile >> 4), colT = 64 * (tile & 15);
        const int row0 = rowT + 16 * rt, col0 = colT + 32 * chf;
        const bf16* Ab = WSP(bf16, WS_MB) + (size_t)rowT * 1024;
        const bf16* Bb = WSP(bf16, WS_WOUT) + ((size_t)l * 1024 + colT) * 1024;
        f32x4 c0 = (f32x4){0.f, 0.f, 0.f, 0.f}, c1 = c0;
        SideRegs R[4];
        __syncthreads();
        side_g2r(R[0], Ab, 1024, Bb, 1024, F.tid); side_r2l(R[0], F.lds, F.tid);
#pragma unroll
        for (int j = 0; j < 4; ++j) side_g2r(R[j], Ab + 128 * (j + 1), 1024, Bb + 128 * (j + 1), 1024, F.tid);
        lds_barrier();
#pragma unroll 1
        for (int q0 = 0; q0 < 8; q0 += 4) {
#pragma unroll
            for (int j = 0; j < 4; ++j) { const int q = q0 + j;
                side_lmma(c0, c1, F.lds + (j & 1) * SD_BUF, rt, chf, r16, quad);
                side_r2l(R[j], F.lds + ((j + 1) & 1) * SD_BUF, F.tid);
                { const int qn = q + 5 < 8 ? q + 5 : 7; side_g2r(R[j], Ab + 128 * qn, 1024, Bb + 128 * qn, 1024, F.tid); }
                lds_barrier(); }
        }
        const float g0 = gt[col0 + r16], g1 = gt[col0 + 16 + r16];
#pragma unroll
        for (int j = 0; j < 4; ++j) { float* xp = WSP(float, WS_X) + (size_t)(row0 + 4 * quad + j) * 1024 + col0 + r16;
            xp[0] += g0 * c0[j]; xp[16] += g1 * c1[j]; }
    }
}

#ifndef SCAN_PARTS
#define SCAN_PARTS 2
#endif
constexpr int NSCAN = 4 * SCAN_PARTS;
constexpr int CW_Q = 2048;
__device__ __forceinline__ void mixer_queue_phase(Frame& F, int l) {
    volatile LAS int* qslot = (volatile LAS int*)(F.lds + MISC_OFF + 64);
    const int x0 = (int)(xb_xcc_id() & 7u);
#if defined(PROBE_SUB) && (PROBE_SUB == 4 || PROBE_SUB == 5)
    const unsigned long long tq0 = __builtin_amdgcn_s_memrealtime();
#endif
#pragma unroll 1
    for (int kq = 0; kq < 8; ++kq) {
      const int x = (x0 + kq) & 7;
      for (;;) {
        __syncthreads();
        if (F.tid == 0) *qslot = (int)__hip_atomic_fetch_add(F.ctl + CW_Q + l * 8 + x, 1u, __ATOMIC_RELAXED, __HIP_MEMORY_SCOPE_AGENT);
        __syncthreads();
        const int idx = __builtin_amdgcn_readfirstlane(*qslot);
        if (idx >= (l == DEPTH - 1 ? 128 : 136) + NSCAN) break;
#ifdef PROBE_SUB
        unsigned long long t0_ = 0ull; const bool pr_on = false;
#endif
        if (idx < NSCAN) { gdn_scan_wide<8 / SCAN_PARTS>(F, x + 8 * (idx / SCAN_PARTS), idx % SCAN_PARTS); }
        else { AttnUnit un; const int q = idx - NSCAN;
            if (q < 64) { un.kind = 0; un.b = x >> 1; un.hx = x & 1; un.qx = q; }
            else if (q < 128) { const int qq = q - 64, combo = x + 8 * (qq >> 4); un.kind = 1; un.b = combo >> 3; un.hx = combo & 7; un.qx = qq & 15; }
            else { const int qq = q - 128;
                if (qq < 4) { un.kind = 2; un.b = x >> 1; un.hx = x & 1; un.qx = qq; }
                else { const int combo = x + 8 * (qq - 4); un.kind = 3; un.b = combo >> 3; un.hx = combo & 7; un.qx = 0; } }
            attn_unit(F, l, un); }
#ifdef PROBE_SUB
        if (pr_on) F.pr += __builtin_amdgcn_s_memrealtime() - t0_;
        if (PROBE_SUB == 13 && F.bid == 8 && idx >= 4 && idx < 68) F.pr += 100;
        if (PROBE_SUB == 14 && F.bid == 8 && idx >= 68 && idx < 140) F.pr += 100;
#endif
      }
    }
#if defined(PROBE_SUB) && PROBE_SUB == 4
    if (F.tid == 0) __hip_atomic_fetch_max(F.ctl + 3000 + l, (unsigned)(__builtin_amdgcn_s_memrealtime() - tq0), __ATOMIC_RELAXED, __HIP_MEMORY_SCOPE_AGENT);
#endif
#if defined(PROBE_SUB) && PROBE_SUB == 5
    if (F.tid == 0) __hip_atomic_fetch_max(F.ctl + 3000 + l, 0x7fffffffu - (unsigned)(__builtin_amdgcn_s_memrealtime() - tq0), __ATOMIC_RELAXED, __HIP_MEMORY_SCOPE_AGENT);
#endif
}


#ifndef REP_P0
#define REP_P0 1
#endif
#ifndef REP_B
#define REP_B 1
#endif
#ifndef REP_D1
#define REP_D1 1
#endif
#ifndef REP_D2
#define REP_D2 1
#endif
#ifndef REP_E
#define REP_E 1
#endif
#ifndef REP_F
#define REP_F 1
#endif
#ifndef REP_I
#define REP_I 1
#endif
#ifndef REP_J
#define REP_J 1
#endif
#ifndef REP_C1
#define REP_C1 1
#endif
#ifndef REP_C2
#define REP_C2 1
#endif
#ifndef REP_C4
#define REP_C4 1
#endif
#ifndef REP_G2
#define REP_G2 1
#endif

#ifndef MIXER_QUEUE
#define MIXER_QUEUE 1
#endif
constexpr int PH_PER_LAYER = 11, PH_FINAL = 1 + PH_PER_LAYER * DEPTH, N_PHASES = PH_FINAL + 1;
struct Args { const float* in[32]; float* out; unsigned char* ws; int ph_lo, ph_hi, li, pad; };

__global__ void __launch_bounds__(NT, 2) hybrid_fwd(Args args) {
    extern __shared__ __attribute__((aligned(16))) unsigned char lds_raw[];
    Frame F;
    F.lds = (LAS unsigned char*)lds_raw;
    F.wave = __builtin_amdgcn_readfirstlane((int)threadIdx.x >> 6); F.lane = (int)__builtin_amdgcn_mbcnt_hi(~0u, __builtin_amdgcn_mbcnt_lo(~0u, 0u)); F.tid = F.wave * 64 + F.lane;
    F.G = gridDim.x; F.bid = blockIdx.x; F.pr = 0ull;
    F.in = args.in; F.in0 = args.in;
    F.out = args.out; F.ws = args.ws; F.ws0 = args.ws; F.ctl = (unsigned*)(args.ws + WS_CTL);
    volatile LAS unsigned* MISC = (volatile LAS unsigned*)(F.lds + MISC_OFF);
    if (F.tid < 64) MISC[F.tid] = 0u;
    __syncthreads();
    const int lo = args.ph_lo, hi = args.ph_hi;
    XcdBarrier bar = xcd_barrier_post(F.ctl + CW_BAR + args.li * XCD_BAR_WORDS, MISC + 8);
#ifndef ONLY_MASK
#define ONLY_MASK 0xFFFF
#endif
#define PHON(b) ((ONLY_MASK >> (b)) & 1)
#define IN(k) (lo <= (k) && (k) < hi)
#define SEAM(k) do { if ((k) + 1 < hi) xcd_barrier(bar); } while (0)
#ifdef PROBE_PHASE
    unsigned long long pr_acc = 0ull, pr_t0 = 0ull;
#define PR_BEGIN(k) do { if ((k) == PROBE_PHASE) pr_t0 = __builtin_amdgcn_s_memrealtime(); } while (0)
#define PR_END(k) do { if ((k) == PROBE_PHASE) pr_acc += __builtin_amdgcn_s_memrealtime() - pr_t0; } while (0)
#else
#define PR_BEGIN(k) do { } while (0)
#define PR_END(k) do { } while (0)
#endif

    if (PHON(0) && IN(0)) { REFRESH_TID(F); _Pragma("unroll 1") for (int rep_ = 0; rep_ < REP_P0; ++rep_) { p0_prologue(F); __syncthreads(); } SEAM(0); PR_END(0); }
#pragma unroll 1
    for (int l = 0; l < DEPTH; ++l) {
        const int pb = 1 + PH_PER_LAYER * l;
        if (PHON(1) && IN(pb + 0)) { PR_BEGIN(1); REFRESH_TID(F); norm_phase<0>(F, l); SEAM(pb + 0); PR_END(1); }
        if (PHON(2) && IN(pb + 1)) { PR_BEGIN(2); REFRESH_TID(F);
            pg8::Gemm g{WSP(bf16, WS_H), WSP(bf16, WS_WIN) + (size_t)l * UW * D, MROWS, UW, D};
            pg8::StaticOrder S; S.init(MROWS, UW, F.G, F.bid);
            pg8::EpiStoreBf16 E{WSP(bf16, WS_U), UW};
            _Pragma("unroll 1") for (int rep_ = 0; rep_ < REP_B; ++rep_) { pg8::gemm_phase<pg8::EpiStoreBf16, pg8::StaticOrder, true, true>(F.lds, g, S, E, F.wave); __syncthreads(); }
            SEAM(pb + 1); PR_END(2);
        }
        if (PHON(3) && IN(pb + 2)) { PR_BEGIN(3); REFRESH_TID(F);
#ifndef NO_C1
            PR_BEGIN(30); _Pragma("unroll 1") for (int rep_ = 0; rep_ < REP_C1; ++rep_) { gdn_prep(F, l); __syncthreads(); } PR_END(30);
#endif
#ifndef NO_C2
            PR_BEGIN(31); _Pragma("unroll 1") for (int rep_ = 0; rep_ < REP_C2; ++rep_) { lru_pass1(F, l); __syncthreads(); } PR_END(31);
#endif
            __syncthreads();
#ifndef NO_C3
            PR_BEGIN(32); qk_prep(F, l); PR_END(32);
#endif
#ifndef NO_C4
            PR_BEGIN(33); _Pragma("unroll 1") for (int rep_ = 0; rep_ < REP_C4; ++rep_) { v_transpose(F); __syncthreads(); } PR_END(33); PR_BEGIN(34);
#endif
            SEAM(pb + 2); PR_END(34); PR_END(3);
        }
        if (PHON(4) && IN(pb + 3)) { PR_BEGIN(4); REFRESH_TID(F);
#if MIXER_QUEUE
            lru_carry_all(F);
            __syncthreads();
            mixer_queue_phase(F, l);
#else
            PR_BEGIN(20); for (int ch = F.bid; ch < 256; ch += F.G) gdn_scan(F, ch); PR_END(20);
            PR_BEGIN(21); lru_carry_all(F);
            __syncthreads(); PR_END(21);
            PR_BEGIN(22); attn_phase(F, l); PR_END(22);
#endif
            PR_BEGIN(23);
            SEAM(pb + 3); PR_END(23); PR_END(4);
        }
        if (PHON(5) && IN(pb + 4)) { PR_BEGIN(5); REFRESH_TID(F);
            _Pragma("unroll 1") for (int rep_ = 0; rep_ < REP_E; ++rep_) { lru_pass2(F, l); __syncthreads(); }
            __syncthreads();
            gdn_out(F, l);
            SEAM(pb + 4); PR_END(5);
        }
        if (PHON(6) && IN(pb + 5)) { PR_BEGIN(6); REFRESH_TID(F);
            pg8::Gemm g{WSP(bf16, WS_Y), WSP(bf16, WS_WBR) + (size_t)l * 4 * 1024 * 512, 4 * MROWS, 4 * 1024, 512};
            pg8::MergeOrder S{F.G, F.bid, MROWS / 256, TLAT / 256};
            pg8::EpiMerge E{WSP(bf16, WS_U), UW, UG, WSP(bf16, WS_MF), WSP(bf16, WS_MB), MROWS / 256};
            _Pragma("unroll 1") for (int rep_ = 0; rep_ < REP_F; ++rep_) { pg8::gemm_phase<pg8::EpiMerge, pg8::MergeOrder, true, true>(F.lds, g, S, E, F.wave); __syncthreads(); }
            PR_BEGIN(13); if (l < DEPTH - 1) side_merge(F, l); PR_END(13);
            SEAM(pb + 5); PR_END(6);
        }
        if (PHON(7) && IN(pb + 6)) { PR_BEGIN(7); REFRESH_TID(F);
            pg8::Gemm g{WSP(bf16, WS_MB), WSP(bf16, WS_WOUT) + (size_t)l * D * D, MROWS, D, D};
            pg8::StaticOrder S; S.init(TLAT, D, F.G, F.bid);
            pg8::EpiResid E{WSP(float, WS_X), WSP(float, WS_MOD) + (size_t)l * 5 * 6144 + 2048};
            pg8::gemm_phase<pg8::EpiResid, pg8::StaticOrder, true, true>(F.lds, g, S, E, F.wave);
            PR_BEGIN(14); if (l < DEPTH - 1) side_outproj(F, l); PR_END(14);
            SEAM(pb + 6); PR_END(7);
        }
        if (PHON(8) && IN(pb + 7)) { PR_BEGIN(8); REFRESH_TID(F); norm_phase<1>(F, l); SEAM(pb + 7); PR_END(8); }
        if (PHON(9) && IN(pb + 8)) { PR_BEGIN(9); REFRESH_TID(F); _Pragma("unroll 1") for (int rep_ = 0; rep_ < REP_G2; ++rep_) { moe_gather(F, l); __syncthreads(); } SEAM(pb + 8); PR_END(9); }
        if (PHON(10) && IN(pb + 9)) { PR_BEGIN(10); REFRESH_TID(F);
            moe_table(F, l);
            pg8::Gemm g{WSP(bf16, WS_HS), WSP(bf16, WS_WGU) + (size_t)l * NEXP * 2048 * D, MOE_ROWS, NEXP * 2048, D};
            pg8::MoeOrder S{(const LAS int*)(F.lds + MISC_OFF + 256), F.G, F.bid, 8};
            pg8::EpiSwiglu E{WSP(bf16, WS_ACT), F.in[I_BGU] + (size_t)l * NEXP * 2048};
            _Pragma("unroll 1") for (int rep_ = 0; rep_ < REP_I; ++rep_) { pg8::gemm_phase<pg8::EpiSwiglu, pg8::MoeOrder, true, true>(F.lds, g, S, E, F.wave); __syncthreads(); }
            SEAM(pb + 9); PR_END(10);
        }
        if (PHON(11) && IN(pb + 10)) { PR_BEGIN(11); REFRESH_TID(F);
            moe_table(F, l);
            pg8::Gemm g{WSP(bf16, WS_ACT), WSP(bf16, WS_WDN) + (size_t)l * NEXP * D * D, MOE_ROWS, NEXP * D, D};
            pg8::MoeOrder S{(const LAS int*)(F.lds + MISC_OFF + 256), F.G, F.bid, 4};
            pg8::EpiDown E{WSP(bf16, WS_YS), F.in[I_BDN] + (size_t)l * NEXP * D};
            _Pragma("unroll 1") for (int rep_ = 0; rep_ < REP_J; ++rep_) { pg8::gemm_phase<pg8::EpiDown, pg8::MoeOrder, true, true>(F.lds, g, S, E, F.wave); __syncthreads(); }
            SEAM(pb + 10); PR_END(11);
        }
    }
    if (PHON(12) && IN(PH_FINAL)) { PR_BEGIN(12); REFRESH_TID(F); norm_phase<2>(F, 0); PR_END(12); }
#if defined(PROBE_SUB) && (PROBE_SUB == 4 || PROBE_SUB == 5)
    if (blockIdx.x == 0) { unsigned long long tot = 0ull;
        for (int q = 0; q < 4; ++q) { const unsigned v = __hip_atomic_load(F.ctl + 3000 + q, __ATOMIC_RELAXED, __HIP_MEMORY_SCOPE_AGENT); tot += (PROBE_SUB == 4) ? v : (0x7fffffffu - v); }
        F.pr = tot; }
#endif
#ifdef PROBE_SUB
    if (F.pr) { const unsigned long long te = __builtin_amdgcn_s_memrealtime(); while (__builtin_amdgcn_s_memrealtime() - te < PROBE_MULT * F.pr) __builtin_amdgcn_s_sleep(8); }
#endif
#ifdef PROBE_PHASE
    if (blockIdx.x == 0) { const unsigned long long te = __builtin_amdgcn_s_memrealtime(); while (__builtin_amdgcn_s_memrealtime() - te < PROBE_MULT * pr_acc) __builtin_amdgcn_s_sleep(8); }
#endif
#undef IN
#undef SEAM
}

extern "C" void kernel_launch(void* const* d_in, const int* in_sizes, int n_in, void* d_out, int out_size, void* d_ws, size_t ws_size, hipStream_t stream) {
    static int grid = 0;
    if (grid == 0) {
        if (n_in != 32 || out_size != TLAT * D || ws_size < WS_END) { fprintf(stderr, "kernel_launch: unexpected shapes (n_in %d out %d ws %zu need %zu)\n", n_in, out_size, ws_size, (size_t)WS_END); grid = -1; return; }
        int dev = 0, cus = 0, per_cu = 0;
        if (hipGetDevice(&dev) != hipSuccess || hipDeviceGetAttribute(&cus, hipDeviceAttributeMultiprocessorCount, dev) != hipSuccess) { grid = -1; return; }
        if (hipFuncSetAttribute((const void*)hybrid_fwd, hipFuncAttributeMaxDynamicSharedMemorySize, LDS_BYTES) != hipSuccess) { fprintf(stderr, "kernel_launch: hipFuncSetAttribute failed\n"); grid = -1; return; }
        if (hipOccupancyMaxActiveBlocksPerMultiprocessor(&per_cu, (const void*)hybrid_fwd, NT, LDS_BYTES) != hipSuccess || per_cu < 1) fprintf(stderr, "kernel_launch: occupancy query says %d\n", per_cu);
        (void)hipGetLastError();
        grid = cus;
    }
    if (grid < 0) return;
    if (hipMemsetAsync((char*)d_ws + WS_CTL, 0, CTL_BYTES, stream) != hipSuccess) return;
    Args a{};
    for (int i = 0; i < 32; ++i) a.in[i] = (const float*)d_in[i];
    a.out = (float*)d_out; a.ws = (unsigned char*)d_ws;
#if MK_MULTI
    for (int p = 0; p < N_PHASES; ++p) { a.ph_lo = p; a.ph_hi = p + 1; a.li = p;
        hipLaunchKernelGGL(hybrid_fwd, dim3(grid), dim3(NT), LDS_BYTES, stream, a); }
#else
    a.ph_lo = 0; a.ph_hi = N_PHASES; a.li = 0;
    hipLaunchKernelGGL(hybrid_fwd, dim3(grid), dim3(NT), LDS_BYTES, stream, a);
#endif
    const hipError_t le = hipPeekAtLastError();
    if (le != hipSuccess) fprintf(stderr, "kernel_launch: launch failed: %s\n", hipGetErrorName(le));
}
```

```cpp
#include <hip/hip_runtime.h>
#include <cstdio>
#include <cstdint>

#ifndef MK_MULTI
#define MK_MULTI 0
#endif

constexpr int D = 1024, NB = 4, SEQ = 4096, LCTX = 256, DEPTH = 4;
constexpr int TLAT = NB * SEQ, TCTX = NB * LCTX, MROWS = TLAT + TCTX;
constexpr int NCHUNK = MROWS / 64;
constexpr int INW = 9488, UW = 9472;
constexpr int UQ = 0, UK = 512, UV = 640, UBX = 768, UBY = 1280, UCQ = 1792, UCK = 2304, UCV = 2816, UCZ = 3328, UDQ = 3840, UDK = 4352, UDV = 4864, UG = 5376;
constexpr int NEXP = 32, TOPK = 4;
constexpr int KEYS = SEQ + LCTX;
constexpr int MOE_ROWS = MROWS * TOPK + NEXP * 256;
constexpr float EPS = 1e-6f;
constexpr float LOG2E = 1.4426950408889634f;

constexpr size_t al256(size_t x) { return (x + 255) & ~(size_t)255; }
constexpr size_t WS_CTL = 0, CTL_BYTES = 1u << 20;
constexpr size_t WS_MOD  = WS_CTL + CTL_BYTES;
constexpr size_t WS_ROPE = WS_MOD + al256((size_t)DEPTH * 5 * 6144 * 4);
constexpr size_t WS_LRUW = WS_ROPE + al256(2 * 64 * 16 * 4);
constexpr size_t WS_WIN  = WS_LRUW + al256((size_t)DEPTH * 2 * 2 * 8 * 4096 * 2);
constexpr size_t WS_WBR  = WS_WIN + al256((size_t)DEPTH * UW * D * 2);
constexpr size_t WS_WOUT = WS_WBR + al256((size_t)DEPTH * 4 * 1024 * 512 * 2);
constexpr size_t WS_WGU  = WS_WOUT + al256((size_t)DEPTH * D * D * 2);
constexpr size_t WS_WDN  = WS_WGU + al256((size_t)DEPTH * NEXP * 2048 * 1024 * 2);
constexpr size_t WS_X    = WS_WDN + al256((size_t)DEPTH * NEXP * 1024 * 1024 * 2);
constexpr size_t WS_H    = WS_X + al256((size_t)MROWS * D * 4);
constexpr size_t WS_U    = WS_H + al256((size_t)MROWS * D * 2);
constexpr size_t WS_CAB  = WS_U + al256((size_t)MROWS * UW * 2);
constexpr size_t WS_VAT  = WS_CAB + al256((size_t)MROWS * 16 * 4);
constexpr size_t WS_VDT  = WS_VAT + al256((size_t)NB * 2 * 64 * KEYS * 2);
constexpr size_t WS_LRA  = WS_VDT + al256((size_t)NB * 8 * 64 * KEYS * 2);
constexpr size_t WS_LRB  = WS_LRA + al256((size_t)NCHUNK * 2 * 512 * 4);
constexpr size_t WS_LRC  = WS_LRB + al256((size_t)NCHUNK * 2 * 512 * 4);
constexpr int NCD = NCHUNK * 4 * 2;
constexpr size_t WS_GW   = WS_LRC + al256((size_t)NCHUNK * 2 * 512 * 4);
constexpr size_t WS_GU   = WS_GW + al256((size_t)NCD * 64 * 128 * 2);
constexpr size_t WS_GQG  = WS_GU + al256((size_t)NCD * 64 * 128 * 2);
constexpr size_t WS_GKD  = WS_GQG + al256((size_t)NCD * 64 * 128 * 2);
constexpr size_t WS_GQK  = WS_GKD + al256((size_t)NCD * 64 * 128 * 2);
constexpr size_t WS_GGL  = WS_GQK + al256((size_t)NCD * 64 * 64 * 2);
constexpr size_t WS_GO   = WS_GGL + al256((size_t)NCD * 4);
constexpr size_t WS_Y    = WS_GO + al256((size_t)2 * MROWS * 512 * 4);
constexpr size_t WS_MF   = WS_Y + al256((size_t)4 * MROWS * 512 * 2);
constexpr size_t WS_MB   = WS_MF + al256((size_t)MROWS * D * 4);
constexpr size_t WS_SROW = WS_MB + al256((size_t)MROWS * D * 2);
constexpr size_t WS_SW   = WS_SROW + al256((size_t)MROWS * 4 * 4);
constexpr size_t WS_SEP  = WS_SW + al256((size_t)MROWS * 4 * 4);
constexpr size_t WS_LIST = WS_SEP + al256((size_t)MROWS * 4 * 4);
constexpr size_t WS_HS   = WS_LIST + al256((size_t)NEXP * MROWS * 4);
constexpr size_t WS_ACT  = WS_HS + al256((size_t)MOE_ROWS * D * 2);
constexpr size_t WS_YS   = WS_ACT + al256((size_t)MOE_ROWS * D * 2);
constexpr size_t WS_END  = WS_YS + al256((size_t)MOE_ROWS * D * 2);

constexpr int CW_BAR = 4096;
constexpr int CW_CNT = 1024;

constexpr int RING_BYTES = 131072;
constexpr int MISC_OFF = RING_BYTES;
constexpr int LDS_BYTES = 147456;
constexpr int NWAVES = 8, NT = 512;

#define GAS __attribute__((address_space(1)))
#define LAS __attribute__((address_space(3)))
typedef unsigned short bf16;
typedef unsigned v4u __attribute__((ext_vector_type(4)));
typedef unsigned v2u __attribute__((ext_vector_type(2)));
typedef float f32x4 __attribute__((ext_vector_type(4)));
typedef float f32x16 __attribute__((ext_vector_type(16)));
typedef short bf16x8 __attribute__((ext_vector_type(8)));
typedef short bf16x4 __attribute__((ext_vector_type(4)));

typedef float f32x2_t __attribute__((ext_vector_type(2))); typedef __bf16 bf16x2_t __attribute__((ext_vector_type(2)));
__device__ __forceinline__ unsigned pk2(float lo, float hi) { f32x2_t v = {lo, hi}; bf16x2_t b = __builtin_convertvector(v, bf16x2_t); return __builtin_bit_cast(unsigned, b); }
__device__ __forceinline__ unsigned f2bf(float f) { return pk2(f, 0.f) & 0xffffu; }
__device__ __forceinline__ float bf2f(unsigned short b) { return __builtin_bit_cast(float, (unsigned)b << 16); }
__device__ __forceinline__ float bflo(unsigned w) { return __builtin_bit_cast(float, w << 16); }
__device__ __forceinline__ float bfhi(unsigned w) { return __builtin_bit_cast(float, w & 0xffff0000u); }
__device__ __forceinline__ float wave_sum(float v) {
#pragma unroll
    for (int o = 1; o < 64; o <<= 1) v += __shfl_xor(v, o);
    return v;
}
__device__ __forceinline__ float sigmoidf_(float x) { return __builtin_amdgcn_rcpf(1.f + __expf(-x)); }
__device__ __forceinline__ float softplusf_(float x) { return x > 20.f ? x : log1pf(__expf(x)); }
__device__ __forceinline__ float siluf_(float x) { return x * __builtin_amdgcn_rcpf(1.f + __expf(-x)); }
__device__ __forceinline__ void lds_barrier() { asm volatile("s_waitcnt lgkmcnt(0)\n\ts_barrier" ::: "memory"); }
namespace pg8 {
#define PG8_LAS __attribute__((address_space(3)))
typedef unsigned short bf16_t;
typedef short bf16x8 __attribute__((ext_vector_type(8)));
typedef float f32x4 __attribute__((ext_vector_type(4)));
typedef unsigned u32x4 __attribute__((ext_vector_type(4)));
constexpr int BM = 256, BK = 64, HALF = 128, HTB = HALF * BK * 2  , STAGE_BYTES = 8 * HTB, NXCD = 8, WGM = 8;

__host__ __device__ __forceinline__ int lds_byte(int r, int c) { const int st = (r >> 4) * 2 + (c >> 5), rr = r & 15, cc = c & 31, ob = rr * 64 + cc * 2; return st * 1024 + (ob ^ (((ob >> 9) & 1) << 5)); }
__host__ __device__ __forceinline__ void stage_rc(int b, int& R, int& C) { const int st = b / 1024, sb = b % 1024, swz = sb ^ (((sb >> 9) & 1) << 5); R = (st >> 1) * 16 + swz / 64; C = (st & 1) * 32 + (swz % 64) / 2; }
__host__ __device__ __forceinline__ int perm32(int rho) { const int n = rho >> 4, i = rho & 15; return 8 * (i >> 2) + 4 * n + (i & 3); }

struct Unit { int pm, pn; };
struct Gemm { const bf16_t* A; const bf16_t* Bt; int M, N, K; };

struct StaticOrder {
    int nM, nN, nwg, G, c;
    __host__ __device__ void init(int M, int N, int G_, int c_) { nM = M / BM; nN = N / BM; nwg = nM * nN; G = G_; c = c_; }
    __host__ __device__ bool next(int i, Unit& u) const {
        const long L = (long)i * G + c; if (L >= nwg) return false;
        int wgid = (int)L; { const int q = nwg / NXCD, r = nwg % NXCD, xcd = wgid % NXCD, off = wgid / NXCD; wgid = (xcd < r ? xcd * (q + 1) : r * (q + 1) + (xcd - r) * q) + off; }
        const int nig = WGM * nN, gid = wgid / nig, fm = gid * WGM, gsz = (nM - fm) < WGM ? (nM - fm) : WGM;
        u.pm = fm + ((wgid % nig) % gsz); u.pn = (wgid % nig) / gsz; return true;
    }
    __device__ __forceinline__ void a_ready(const Unit&) const {}
    __device__ __forceinline__ void done(const Unit&) const {}
};

__device__ __forceinline__ unsigned cvt_pk_bf16(float lo, float hi) { unsigned r; asm volatile("v_cvt_pk_bf16_f32 %0, %1, %2" : "=v"(r) : "v"(lo), "v"(hi)); return r; }
typedef float f32x2 __attribute__((ext_vector_type(2)));
template <class Epi, class Sched, bool ALIGN_EPI = false, bool SP2 = false>
__device__ __forceinline__ void gemm_phase(PG8_LAS unsigned char* lds, const Gemm g, const Sched& S, const Epi& E, const int wid_in) {
    int lane_o = (int)__builtin_amdgcn_mbcnt_hi(~0u, __builtin_amdgcn_mbcnt_lo(~0u, 0u)); asm volatile("" : "+v"(lane_o));
    const int wid = __builtin_amdgcn_readfirstlane(wid_in), lane = lane_o, tid = wid * 64 + lane, wr = wid >> 2, wc = wid & 3, fr = lane & 15, fq = lane >> 4;
    const int K = g.K, nt = K / BK;
    unsigned voffA[2], voffB[2];
#pragma unroll
    for (int i = 0; i < 2; ++i) { int R, C; stage_rc(tid * 16 + i * 8192, R, C); const int Rb = Epi::PERM ? ((R & ~31) + perm32(R & 31)) : R;
        voffA[i] = (unsigned)(R * K + C) * 2u; voffB[i] = (unsigned)(Rb * K + C) * 2u; }
    const size_t kstep = (size_t)(BK * 2);
    const size_t hstep = (size_t)HALF * K * 2;
    const size_t tstep = 2 * hstep;
    const unsigned ldsw = (unsigned)wid * 1024u;
    const int aoff = lds_byte(wr * 64 + fr, fq * 8), boff = lds_byte(wc * 32 + fr, fq * 8);
#define PG8_SA(b, h) (((b) * 2 + (h)) * HTB)
#define PG8_SB(b, h) ((4 + (b) * 2 + (h)) * HTB)
#define PG8_STAGE(bufoff, gbase, voff) do { _Pragma("unroll") for (int _i = 0; _i < 2; ++_i) \
        __builtin_amdgcn_global_load_lds((const unsigned*)((const char*)(gbase) + (voff)[_i]), (PG8_LAS unsigned*)(lds + (bufoff) + ldsw + _i * 8192), 16, 0, 0); } while (0)
#define PG8_LDA(dst, b, h) do { _Pragma("unroll") for (int m = 0; m < 4; ++m) _Pragma("unroll") for (int k = 0; k < 2; ++k) dst[m][k] = *(const PG8_LAS bf16x8*)(lds + PG8_SA(b, h) + aoff + m * 2048 + k * 1024); } while (0)
#define PG8_LDB(dst, b, h) do { _Pragma("unroll") for (int n = 0; n < 2; ++n) _Pragma("unroll") for (int k = 0; k < 2; ++k) dst[n][k] = *(const PG8_LAS bf16x8*)(lds + PG8_SB(b, h) + boff + n * 2048 + k * 1024); } while (0)
#define PG8_MMA(ai, bj, At, Bt) do { __builtin_amdgcn_s_setprio(1); _Pragma("unroll") for (int m = 0; m < 4; ++m) _Pragma("unroll") for (int n = 0; n < 2; ++n) _Pragma("unroll") for (int k = 0; k < 2; ++k) \
        acc[ai][bj][m][n] = __builtin_amdgcn_mfma_f32_16x16x32_bf16(Bt[n][k], At[m][k], acc[ai][bj][m][n], 0, 0, 0); __builtin_amdgcn_s_setprio(0); } while (0)
#define PG8_WAIT_V(n) asm volatile("s_waitcnt vmcnt(" #n ")" ::: "memory")
#define PG8_WAIT_L(n) asm volatile("s_waitcnt lgkmcnt(" #n ")" ::: "memory")
#define PG8_BAR __builtin_amdgcn_s_barrier()
#define PG8_SCHED __builtin_amdgcn_sched_barrier(0)
    Unit cur, nxt; int ui = 0;
    if (!S.next(0, cur)) return;
    f32x4 acc[2][2][4][2];
#pragma unroll
    for (int a = 0; a < 2; ++a)
#pragma unroll
        for (int b = 0; b < 2; ++b)
#pragma unroll
            for (int m = 0; m < 4; ++m)
#pragma unroll
                for (int n = 0; n < 2; ++n) acc[a][b][m][n] = (f32x4){0.f, 0.f, 0.f, 0.f};
    bf16x8 At[4][2], B0[2][2], B1[2][2];
    const char* cA = (const char*)g.A + (size_t)cur.pm * tstep; const char* cB = (const char*)g.Bt + (size_t)cur.pn * tstep;
    S.a_ready(cur);
    if constexpr (SP2) {
        PG8_STAGE(PG8_SB(0, 0), cB, voffB); PG8_STAGE(PG8_SB(0, 1), cB + hstep, voffB); PG8_STAGE(PG8_SA(0, 0), cA, voffA); PG8_STAGE(PG8_SA(0, 1), cA + hstep, voffA);
        if (wr == 1) PG8_BAR;
        PG8_WAIT_V(2); PG8_BAR;
        PG8_STAGE(PG8_SB(1, 0), cB + kstep, voffB); PG8_STAGE(PG8_SA(1, 0), cA + kstep, voffA); PG8_STAGE(PG8_SB(1, 1), cB + hstep + kstep, voffB);
        PG8_WAIT_V(6); PG8_BAR;
    } else {
        PG8_STAGE(PG8_SB(0, 0), cB, voffB); PG8_STAGE(PG8_SA(0, 0), cA, voffA); PG8_STAGE(PG8_SB(0, 1), cB + hstep, voffB); PG8_STAGE(PG8_SA(0, 1), cA + hstep, voffA);
        if (wr == 1) PG8_BAR;
        PG8_WAIT_V(4); PG8_BAR;
        PG8_STAGE(PG8_SB(1, 0), cB + kstep, voffB); PG8_STAGE(PG8_SA(1, 0), cA + kstep, voffA); PG8_STAGE(PG8_SB(1, 1), cB + hstep + kstep, voffB);
        PG8_WAIT_V(6); PG8_BAR;
    }
    for (;;) {
        const bool has_next = S.next(ui + 1, nxt);
        const char* nA = has_next ? (const char*)g.A + (size_t)nxt.pm * tstep : cA; const char* nB = has_next ? (const char*)g.Bt + (size_t)nxt.pn * tstep : cB;
        for (int t = 0; t < nt; t += 2) {
            const bool last = (t == nt - 2);
            const char* a1 = cA + (size_t)(t + 1) * kstep;
            const char* a2 = last ? nA : cA + (size_t)(t + 2) * kstep; const char* b2 = last ? nB : cB + (size_t)(t + 2) * kstep;
            const char* a3 = a2 + kstep; const char* b3 = b2 + kstep;
            if (last && has_next) S.a_ready(nxt);
            if constexpr (SP2) {
            PG8_LDB(B0, 0, 0); PG8_LDB(B1, 0, 1); PG8_SCHED; PG8_LDA(At, 0, 0); PG8_STAGE(PG8_SA(1, 1), a1 + hstep, voffA);
            PG8_WAIT_V(8); PG8_WAIT_L(0); PG8_BAR; PG8_MMA(0, 0, At, B0); PG8_MMA(0, 1, At, B1); PG8_BAR; PG8_SCHED;
            PG8_LDA(At, 0, 1); PG8_STAGE(PG8_SB(0, 0), b2, voffB); PG8_STAGE(PG8_SB(0, 1), b2 + hstep, voffB); PG8_STAGE(PG8_SA(0, 0), a2, voffA);
            PG8_WAIT_V(8); PG8_WAIT_L(0); PG8_BAR; PG8_MMA(1, 0, At, B0); PG8_MMA(1, 1, At, B1); PG8_BAR; PG8_SCHED;
            PG8_LDB(B0, 1, 0); PG8_LDB(B1, 1, 1); PG8_SCHED; PG8_LDA(At, 1, 0); PG8_STAGE(PG8_SA(0, 1), a2 + hstep, voffA);
            PG8_WAIT_V(8); PG8_WAIT_L(0); PG8_BAR; PG8_MMA(0, 0, At, B0); PG8_MMA(0, 1, At, B1); PG8_BAR; PG8_SCHED;
            PG8_LDA(At, 1, 1); PG8_STAGE(PG8_SB(1, 0), b3, voffB); PG8_STAGE(PG8_SB(1, 1), b3 + hstep, voffB); PG8_STAGE(PG8_SA(1, 0), a3, voffA);
            PG8_WAIT_V(8); PG8_WAIT_L(0); PG8_BAR; PG8_MMA(1, 0, At, B0); PG8_MMA(1, 1, At, B1); PG8_BAR; PG8_SCHED;
            } else {
            PG8_LDB(B0, 0, 0); PG8_SCHED; PG8_LDA(At, 0, 0); PG8_STAGE(PG8_SA(1, 1), a1 + hstep, voffA);
            PG8_WAIT_L(8); PG8_BAR; PG8_WAIT_L(0); PG8_MMA(0, 0, At, B0); PG8_BAR; PG8_SCHED;
            PG8_LDB(B1, 0, 1); PG8_STAGE(PG8_SB(0, 0), b2, voffB);
            PG8_BAR; PG8_WAIT_L(0); PG8_MMA(0, 1, At, B1); PG8_BAR;
            PG8_LDA(At, 0, 1); PG8_STAGE(PG8_SA(0, 0), a2, voffA);
            PG8_BAR; PG8_WAIT_L(0); PG8_MMA(1, 0, At, B0); PG8_BAR; PG8_SCHED;
            PG8_STAGE(PG8_SB(0, 1), b2 + hstep, voffB);
            PG8_WAIT_V(6); PG8_BAR; PG8_MMA(1, 1, At, B1); PG8_BAR;
            PG8_LDB(B0, 1, 0); PG8_SCHED; PG8_LDA(At, 1, 0); PG8_STAGE(PG8_SA(0, 1), a2 + hstep, voffA);
            PG8_WAIT_L(8); PG8_BAR; PG8_WAIT_L(0); PG8_MMA(0, 0, At, B0); PG8_BAR; PG8_SCHED;
            PG8_LDB(B1, 1, 1); PG8_STAGE(PG8_SB(1, 0), b3, voffB);
            PG8_BAR; PG8_WAIT_L(0); PG8_MMA(0, 1, At, B1); PG8_BAR;
            PG8_LDA(At, 1, 1); PG8_STAGE(PG8_SA(1, 0), a3, voffA);
            PG8_BAR; PG8_WAIT_L(0); PG8_MMA(1, 0, At, B0); PG8_BAR; PG8_SCHED;
            PG8_STAGE(PG8_SB(1, 1), b3 + hstep, voffB);
            PG8_WAIT_V(6); PG8_BAR; PG8_MMA(1, 1, At, B1); PG8_BAR;
            }
        }
        if constexpr (ALIGN_EPI) { if (wr == 0) PG8_BAR; }
        if constexpr (!Epi::AFTER_DRAIN) { E(acc, cur, wr, wc, fr, fq); S.done(cur); }
        if (!has_next) break;
#pragma unroll
        for (int a = 0; a < 2; ++a)
#pragma unroll
            for (int b = 0; b < 2; ++b)
#pragma unroll
                for (int m = 0; m < 4; ++m)
#pragma unroll
                    for (int n = 0; n < 2; ++n) acc[a][b][m][n] = (f32x4){0.f, 0.f, 0.f, 0.f};
        cur = nxt; cA = nA; cB = nB; ++ui;
        if constexpr (ALIGN_EPI) { if (wr == 1) PG8_BAR; }
    }
    PG8_WAIT_V(0);
    if constexpr (!ALIGN_EPI) { if (wr == 0) PG8_BAR; }
    PG8_BAR;
    if constexpr (Epi::AFTER_DRAIN) { E.fused(acc, cur, wr, wc, fr, fq, lds, wid, lane); S.done(cur); }
#undef PG8_SA
#undef PG8_SB
#undef PG8_STAGE
#undef PG8_LDA
#undef PG8_LDB
#undef PG8_MMA
#undef PG8_WAIT_V
#undef PG8_WAIT_L
#undef PG8_BAR
#undef PG8_SCHED
}
}

namespace pg8 {
__device__ __forceinline__ float bflo_(unsigned w) { return __builtin_bit_cast(float, w << 16); }
__device__ __forceinline__ float bfhi_(unsigned w) { return __builtin_bit_cast(float, w & 0xffff0000u); }
__device__ __forceinline__ float sigm_(float x) { return __builtin_amdgcn_rcpf(1.f + __expf(-x)); }

struct EpiStoreBf16 {
    static constexpr bool PERM = true, AFTER_DRAIN = false;
    bf16_t* O; int ldc;
    __device__ __forceinline__ void operator()(const f32x4 (&acc)[2][2][4][2], const Unit& u, int wr, int wc, int fr, int fq) const {
        const int row0 = u.pm * BM + wr * 64 + fr, col0 = u.pn * BM + wc * 32 + 8 * fq;
#pragma unroll
        for (int ai = 0; ai < 2; ++ai)
#pragma unroll
            for (int m = 0; m < 4; ++m) { bf16_t* rowp = O + (size_t)(row0 + ai * HALF + m * 16) * ldc + col0;
#pragma unroll
                for (int bj = 0; bj < 2; ++bj) { const f32x4 v0 = acc[ai][bj][m][0], v1 = acc[ai][bj][m][1];
                    u32x4 w; w.x = cvt_pk_bf16(v0[0], v0[1]); w.y = cvt_pk_bf16(v0[2], v0[3]); w.z = cvt_pk_bf16(v1[0], v1[1]); w.w = cvt_pk_bf16(v1[2], v1[3]);
                    *(u32x4*)(rowp + bj * HALF) = w; } }
    }
};

struct EpiMerge {
    static constexpr bool PERM = true, AFTER_DRAIN = false;
    const bf16_t* U; int ldu, gcol0; bf16_t* Mf; bf16_t* Mb; int npm;
    __device__ __forceinline__ void operator()(const f32x4 (&acc)[2][2][4][2], const Unit& u, int wr, int wc, int fr, int fq) const {
        const int br = u.pm / npm, pm = u.pm - br * npm, pn = u.pn & 3;
        const int row0 = pm * BM + wr * 64 + fr, col0 = pn * BM + wc * 32 + 8 * fq;
#pragma unroll
        for (int ai = 0; ai < 2; ++ai) {
            u32x4 gv[4][2], pv[4][2];
#pragma unroll
            for (int m = 0; m < 4; ++m)
#pragma unroll
                for (int bj = 0; bj < 2; ++bj) { const size_t row = (size_t)(row0 + ai * HALF + m * 16); const int col = col0 + bj * HALF;
                    gv[m][bj] = *(const u32x4*)(U + row * ldu + gcol0 + br * 1024 + col);
                    pv[m][bj] = br > 0 ? *(const u32x4*)(Mf + row * 1024 + col) : (u32x4){0u, 0u, 0u, 0u}; }
#pragma unroll
            for (int m = 0; m < 4; ++m)
#pragma unroll
                for (int bj = 0; bj < 2; ++bj) { const size_t row = (size_t)(row0 + ai * HALF + m * 16); const int col = col0 + bj * HALF;
                    const u32x4 g = gv[m][bj], p = pv[m][bj];
                    f32x4 v0 = acc[ai][bj][m][0], v1 = acc[ai][bj][m][1];
                    v0[0] = v0[0] * sigm_(bflo_(g.x)) + bflo_(p.x); v0[1] = v0[1] * sigm_(bfhi_(g.x)) + bfhi_(p.x); v0[2] = v0[2] * sigm_(bflo_(g.y)) + bflo_(p.y); v0[3] = v0[3] * sigm_(bfhi_(g.y)) + bfhi_(p.y);
                    v1[0] = v1[0] * sigm_(bflo_(g.z)) + bflo_(p.z); v1[1] = v1[1] * sigm_(bfhi_(g.z)) + bfhi_(p.z); v1[2] = v1[2] * sigm_(bflo_(g.w)) + bflo_(p.w); v1[3] = v1[3] * sigm_(bfhi_(g.w)) + bfhi_(p.w);
                    u32x4 w; w.x = cvt_pk_bf16(v0[0], v0[1]); w.y = cvt_pk_bf16(v0[2], v0[3]); w.z = cvt_pk_bf16(v1[0], v1[1]); w.w = cvt_pk_bf16(v1[2], v1[3]);
                    *(u32x4*)((br < 3 ? Mf : Mb) + row * 1024 + col) = w; }
        }
    }
};
struct MergeOrder {
    int G, c, npm, ncnt;
    __device__ __forceinline__ bool next(int i, Unit& u) const {
        const int su = (i >> 2) * G + c; if (su >= ncnt * 4) return false;
        const int br = i & 3; u.pm = br * npm + (su >> 2); u.pn = br * 4 + (su & 3); return true; }
    __device__ __forceinline__ void a_ready(const Unit&) const {}
    __device__ __forceinline__ void done(const Unit&) const {}
};

struct EpiResid {
    static constexpr bool PERM = false, AFTER_DRAIN = false;
    float* X; const float* gt;
    __device__ __forceinline__ void operator()(const f32x4 (&acc)[2][2][4][2], const Unit& u, int wr, int wc, int fr, int fq) const {
        const int row0 = u.pm * BM + wr * 64 + fr, col0 = u.pn * BM + wc * 32 + 4 * fq;
        const int mr = u.pm < 64 ? (u.pm >> 4) : 4;
        f32x4 gv[2][2];
#pragma unroll
        for (int bj = 0; bj < 2; ++bj)
#pragma unroll
            for (int n = 0; n < 2; ++n) gv[bj][n] = *(const f32x4*)(gt + (size_t)mr * 6144 + col0 + bj * HALF + n * 16);
#pragma unroll
        for (int ai = 0; ai < 2; ++ai) {
            f32x4 xv[4][2][2];
#pragma unroll
            for (int m = 0; m < 4; ++m)
#pragma unroll
                for (int bj = 0; bj < 2; ++bj)
#pragma unroll
                    for (int n = 0; n < 2; ++n) xv[m][bj][n] = *(const f32x4*)(X + (size_t)(row0 + ai * HALF + m * 16) * 1024 + col0 + bj * HALF + n * 16);
#pragma unroll
            for (int m = 0; m < 4; ++m)
#pragma unroll
                for (int bj = 0; bj < 2; ++bj)
#pragma unroll
                    for (int n = 0; n < 2; ++n) *(f32x4*)(X + (size_t)(row0 + ai * HALF + m * 16) * 1024 + col0 + bj * HALF + n * 16) = xv[m][bj][n] + gv[bj][n] * acc[ai][bj][m][n];
        }
    }
};

struct MoeOrder {
    const PG8_LAS int* tpre; int G, c, ncol;
    __device__ __forceinline__ bool next(int i, Unit& u) const {
        int tau, pnl;
        if ((G & 7) == 0 && ((G >> 3) % ncol) == 0) { const int x = c & 7, y = c >> 3, rp = (G >> 3) / ncol; tau = (i * 8 + x) * rp + y / ncol; pnl = y % ncol; }
        else { const int L = i * G + c; tau = L / ncol; pnl = L - tau * ncol; }
        if (tau >= tpre[32]) return false;
        int e = 0;
#pragma unroll 1
        while (tpre[e + 1] <= tau) ++e;
        u.pm = tau; u.pn = e * ncol + pnl; return true; }
    __device__ __forceinline__ void a_ready(const Unit&) const {}
    __device__ __forceinline__ void done(const Unit&) const {}
};
struct EpiSwiglu {
    static constexpr bool PERM = true, AFTER_DRAIN = false;
    bf16_t* ACT; const float* bgu;
    __device__ __forceinline__ void operator()(const f32x4 (&acc)[2][2][4][2], const Unit& u, int wr, int wc, int fr, int fq) const {
        const int e = u.pn >> 3, pnl = u.pn & 7;
        const int row0 = u.pm * BM + wr * 64 + fr, cl = 128 * pnl + wc * 32 + 8 * fq;
        const float* bg = bgu + (size_t)e * 2048 + cl;
        const f32x4 bg0 = *(const f32x4*)bg, bg1 = *(const f32x4*)(bg + 4), bu0 = *(const f32x4*)(bg + 1024), bu1 = *(const f32x4*)(bg + 1028);
#pragma unroll
        for (int ai = 0; ai < 2; ++ai)
#pragma unroll
            for (int m = 0; m < 4; ++m) {
                f32x4 g0 = acc[ai][0][m][0] + bg0, g1 = acc[ai][0][m][1] + bg1, u0 = acc[ai][1][m][0] + bu0, u1 = acc[ai][1][m][1] + bu1;
                float o[8];
#pragma unroll
                for (int j = 0; j < 4; ++j) { const float g = fminf(g0[j], 7.f), up = fminf(fmaxf(u0[j], -7.f), 7.f); o[j] = (up + 1.f) * g * sigm_(1.702f * g); }
#pragma unroll
                for (int j = 0; j < 4; ++j) { const float g = fminf(g1[j], 7.f), up = fminf(fmaxf(u1[j], -7.f), 7.f); o[4 + j] = (up + 1.f) * g * sigm_(1.702f * g); }
                u32x4 w; w.x = cvt_pk_bf16(o[0], o[1]); w.y = cvt_pk_bf16(o[2], o[3]); w.z = cvt_pk_bf16(o[4], o[5]); w.w = cvt_pk_bf16(o[6], o[7]);
                *(u32x4*)(ACT + (size_t)(row0 + ai * HALF + m * 16) * 1024 + cl) = w; }
    }
};
struct EpiDown {
    static constexpr bool PERM = true, AFTER_DRAIN = false;
    bf16_t* YS; const float* bdn;
    __device__ __forceinline__ void operator()(const f32x4 (&acc)[2][2][4][2], const Unit& u, int wr, int wc, int fr, int fq) const {
        const int e = u.pn >> 2, pnl = u.pn & 3;
        const int row0 = u.pm * BM + wr * 64 + fr, col0 = pnl * BM + wc * 32 + 8 * fq;
        f32x4 bv[2][2];
#pragma unroll
        for (int bj = 0; bj < 2; ++bj)
#pragma unroll
            for (int n = 0; n < 2; ++n) bv[bj][n] = *(const f32x4*)(bdn + (size_t)e * 1024 + col0 + bj * HALF + 4 * n);
#pragma unroll
        for (int ai = 0; ai < 2; ++ai)
#pragma unroll
            for (int m = 0; m < 4; ++m) { bf16_t* rowp = YS + (size_t)(row0 + ai * HALF + m * 16) * 1024 + col0;
#pragma unroll
                for (int bj = 0; bj < 2; ++bj) { const f32x4 v0 = acc[ai][bj][m][0] + bv[bj][0], v1 = acc[ai][bj][m][1] + bv[bj][1];
                    u32x4 w; w.x = cvt_pk_bf16(v0[0], v0[1]); w.y = cvt_pk_bf16(v0[2], v0[3]); w.z = cvt_pk_bf16(v1[0], v1[1]); w.w = cvt_pk_bf16(v1[2], v1[3]);
                    *(u32x4*)(rowp + bj * HALF) = w; } }
    }
};
}
#define XB_TMO      128
#define XB_XCNT(j)  (256  + 64 * (j))
#define XB_XSUB(j)  (1280 + 64 * (j))
#define XB_XGEN(j)  (2304 + 64 * (j))
#define XB_TOP      3328
#define XB_TOPGEN   3392
#define XCD_BAR_WORDS 3456
#define XB_SPIN_CAP (1u << 18)
#define LAS __attribute__((address_space(3)))

__device__ __forceinline__ unsigned xb_ld(unsigned* p)              { return __hip_atomic_load(p, __ATOMIC_RELAXED, __HIP_MEMORY_SCOPE_AGENT); }
__device__ __forceinline__ unsigned xb_add(unsigned* p, unsigned v) { return __hip_atomic_fetch_add(p, v, __ATOMIC_RELAXED, __HIP_MEMORY_SCOPE_AGENT); }
__device__ __forceinline__ unsigned xb_xcc_id() { return (unsigned)__builtin_amdgcn_s_getreg((3 << 11) | 20) & 0xFu; }
#define XB_SPIN(cond, bar) do { unsigned _sp = 0; while (cond) { __builtin_amdgcn_s_sleep(1); \
    if ((++_sp & 255u) == 0u) { if (xb_ld(&(bar)[XB_TMO])) break; if (_sp > XB_SPIN_CAP) { atomicAdd(&(bar)[XB_TMO], 1u); break; } } } } while (0)

struct XcdBarrier {
    unsigned* bar; unsigned x;
    volatile LAS unsigned* st;
};

__device__ __forceinline__ XcdBarrier xcd_barrier_post(unsigned* bar, volatile LAS unsigned* st) {
    XcdBarrier b; b.bar = bar; b.x = xb_xcc_id(); b.st = st;
    if (threadIdx.x == 0) (void)xb_add(&bar[XB_XCNT(b.x)], 1u);
    return b;
}
__device__ __forceinline__ void xcd_barrier_complete(unsigned* bar, unsigned x, unsigned& nloc, unsigned& nx) {
    const unsigned G = gridDim.x * gridDim.y * gridDim.z;
    unsigned sum, cnt, mine, sp = 0u;
    for (;;) {
        sum = 0u; cnt = 0u; mine = 0u;
#pragma unroll
        for (unsigned j = 0; j < 16; ++j) { const unsigned c = xb_ld(&bar[XB_XCNT(j)]); sum += c; cnt += (c > 0u) ? 1u : 0u; mine = (j == x) ? c : mine; }
        if (sum == G) break;
        __builtin_amdgcn_s_sleep(1);
        if ((++sp & 255u) == 0u) { if (xb_ld(&bar[XB_TMO])) break; if (sp > XB_SPIN_CAP) { atomicAdd(&bar[XB_TMO], 1u); break; } }
    }
    nloc = mine > 0u ? mine : 1u; nx = cnt > 0u ? cnt : 1u;
}

__device__ __forceinline__ void xcd_barrier(const XcdBarrier& b) {
    asm volatile("s_waitcnt vmcnt(0)" ::: "memory");
    __syncthreads();
    if (threadIdx.x == 0) {
        unsigned* bar = b.bar;
        __builtin_amdgcn_s_waitcnt(0);
        unsigned nloc = b.st[0], nx = b.st[1];
        if (nloc == 0u) { xcd_barrier_complete(bar, b.x, nloc, nx); b.st[0] = nloc; b.st[1] = nx; }
        const unsigned old = xb_add(&bar[XB_XSUB(b.x)], 1u);
        const unsigned gen = old / nloc;
        if (old + 1u == (gen + 1u) * nloc) {
            __builtin_amdgcn_fence(__ATOMIC_RELEASE, "agent");
            asm volatile("s_waitcnt vmcnt(0)" ::: "memory");
            const unsigned og = xb_add(&bar[XB_TOP], 1u);
            const unsigned tg = og / nx;
            if (og + 1u == (tg + 1u) * nx) xb_add(&bar[XB_TOPGEN], 1u);
            else XB_SPIN(xb_ld(&bar[XB_TOPGEN]) == tg, bar);
            __builtin_amdgcn_fence(__ATOMIC_ACQUIRE, "agent");
            xb_add(&bar[XB_XGEN(b.x)], 1u);
            asm volatile("s_waitcnt vmcnt(0)" ::: "memory");
        } else {
            XB_SPIN(xb_ld(&bar[XB_XGEN(b.x)]) == gen, bar);
            __builtin_amdgcn_fence(__ATOMIC_ACQUIRE, "agent");
            asm volatile("s_waitcnt vmcnt(0)" ::: "memory");
        }
    }
    __syncthreads();
}

struct Frame {
    LAS unsigned char* lds;
    unsigned* ctl;
    int tid, lane, wave, G, bid;
    unsigned long long pr;
    const float* const* in; const float* const* in0;
    float* out;
    unsigned char* ws; unsigned char* ws0;
};
#define WSP(T, off) ((T*)(F.ws + (off)))
#define REFRESH_TID(F) do { int t_ = (int)__builtin_amdgcn_mbcnt_hi(~0u, __builtin_amdgcn_mbcnt_lo(~0u, 0u)); asm volatile("" : "+v"(t_)); F.lane = t_; F.tid = F.wave * 64 + t_; \
    int z_ = 0; asm volatile("s_mov_b32 %0, 0" : "=s"(z_)); F.ws = F.ws0 + z_; F.in = F.in0 + z_; F.bid = (int)blockIdx.x + z_; } while (0)
#define I_X 0
#define I_C 1
#define I_CTX 2
#define I_CCTX 3
#define I_WMOD 4
#define I_BMOD 5
#define I_G1 6
#define I_G2 7
#define I_WIN 8
#define I_AGQ 9
#define I_AGK 10
#define I_BCW 11
#define I_BCB 12
#define I_BLAM 13
#define I_BWR 14
#define I_BBR 15
#define I_BWI 16
#define I_BBI 17
#define I_CCW 18
#define I_CALOG 19
#define I_CDTB 20
#define I_CGOUT 21
#define I_RPB 22
#define I_WBR 23
#define I_WOUT 24
#define I_WRT 25
#define I_BRT 26
#define I_WGU 27
#define I_BGU 28
#define I_WDN 29
#define I_BDN 30
#define I_GFIN 31

__device__ __forceinline__ int mod_row(int r) { return r < TLAT ? (r >> 12) : 4; }

__device__ __forceinline__ void p0_transpose_item(const float* W, size_t pitch, int K, bf16* WT, int drow0, int scol0, int k0, LAS float* scr, int lane) {
    float v[32];
#pragma unroll
    for (int i = 0; i < 32; ++i) { const int kk = 2 * i + (lane >> 5); v[i] = W[(size_t)(k0 + kk) * pitch + scol0 + (lane & 31)]; }
#pragma unroll
    for (int i = 0; i < 32; ++i) { const int kk = 2 * i + (lane >> 5); scr[kk * 33 + (lane & 31)] = v[i]; }
    asm volatile("s_waitcnt lgkmcnt(0)" ::: "memory");
    const int c = lane & 7;
#pragma unroll
    for (int j = 0; j < 4; ++j) { const int n = (lane >> 3) + 8 * j; const LAS float* s = scr + (8 * c) * 33 + n;
        v4u o; o.x = pk2(s[0 * 33], s[1 * 33]); o.y = pk2(s[2 * 33], s[3 * 33]); o.z = pk2(s[4 * 33], s[5 * 33]); o.w = pk2(s[6 * 33], s[7 * 33]);
        *(v4u*)(WT + (size_t)(drow0 + n) * K + k0 + 8 * c) = o; }
    asm volatile("s_waitcnt lgkmcnt(0)" ::: "memory");
}

__device__ __forceinline__ void p0_prologue(Frame& F) {
    LAS float* scr = (LAS float*)(F.lds + F.wave * 16384);
    const int gw = F.bid * NWAVES + F.wave, NGW = F.G * NWAVES;
    constexpr int I_IN = DEPTH * 16 * (UW / 32);
    constexpr int I_BR = DEPTH * 4 * 8 * 32;
    constexpr int I_OUT = DEPTH * 16 * 32;
    constexpr int I_GU = DEPTH * NEXP * 16 * 64;
    constexpr int I_DN = DEPTH * NEXP * 16 * 32;
    constexpr int NITEMS = I_IN + I_BR + I_OUT + I_GU + I_DN;
    for (int it = gw; it < NITEMS; it += NGW) {
        int r = it;
        if (r < I_IN) { const int l = r / (16 * 296), q = r % (16 * 296), kb = q / 296, nb = q % 296; const int n0 = nb * 32, sc = n0 < 3840 ? n0 : n0 + 16;
            p0_transpose_item(F.in[I_WIN] + (size_t)l * D * INW, INW, D, WSP(bf16, WS_WIN) + (size_t)l * UW * D, n0, sc, kb * 64, scr, F.lane); continue; }
        r -= I_IN;
        if (r < I_BR) { const int mi = r / 256, q = r % 256, kb = q / 32, nb = q % 32;
            p0_transpose_item(F.in[I_WBR] + (size_t)mi * 512 * 1024, 1024, 512, WSP(bf16, WS_WBR) + (size_t)mi * 1024 * 512, nb * 32, nb * 32, kb * 64, scr, F.lane); continue; }
        r -= I_BR;
        if (r < I_OUT) { const int l = r / 512, q = r % 512, kb = q / 32, nb = q % 32;
            p0_transpose_item(F.in[I_WOUT] + (size_t)l * D * D, D, D, WSP(bf16, WS_WOUT) + (size_t)l * D * D, nb * 32, nb * 32, kb * 64, scr, F.lane); continue; }
        r -= I_OUT;
        if (r < I_GU) { const int mi = r / 1024, q = r % 1024, kb = q / 64, nb = q % 64; const int j0 = nb * 32, pn = j0 >> 8, bj = (j0 >> 7) & 1, cc = j0 & 127;
            p0_transpose_item(F.in[I_WGU] + (size_t)mi * D * 2048, 2048, D, WSP(bf16, WS_WGU) + (size_t)mi * 2048 * D, j0, 1024 * bj + 128 * pn + cc, kb * 64, scr, F.lane); continue; }
        r -= I_GU;
        { const int mi = r / 512, q = r % 512, kb = q / 32, nb = q % 32;
            p0_transpose_item(F.in[I_WDN] + (size_t)mi * D * D, D, D, WSP(bf16, WS_WDN) + (size_t)mi * D * D, nb * 32, nb * 32, kb * 64, scr, F.lane); }
    }
    __syncthreads();
    {
        LAS float* sc = (LAS float*)F.lds;
        LAS float* part = sc + 5 * 1024;
        bool staged = false;
        for (int it = F.bid; it < DEPTH * 96; it += F.G) {
            if (!staged) {
                for (int i = F.tid; i < 5 * 1024; i += NT) { const int r = i >> 10, k = i & 1023; const float cv = r < 4 ? F.in[I_C][r * 1024 + k] : F.in[I_CCTX][k]; sc[i] = siluf_(cv); }
                __syncthreads(); staged = true;
            }
            const int l = it / 96, cg = it % 96, col = cg * 64 + F.lane;
            const float* wm = F.in[I_WMOD] + (size_t)l * D * 6144 + col;
            float a0 = 0.f, a1 = 0.f, a2 = 0.f, a3 = 0.f, a4 = 0.f;
            const int kb = F.wave * 128;
#pragma unroll 16
            for (int k = 0; k < 128; ++k) { const float w = wm[(size_t)(kb + k) * 6144];
                a0 += sc[kb + k] * w; a1 += sc[1024 + kb + k] * w; a2 += sc[2048 + kb + k] * w; a3 += sc[3072 + kb + k] * w; a4 += sc[4096 + kb + k] * w; }
            LAS float* pp = part + F.wave * 320 + F.lane;
            pp[0] = a0; pp[64] = a1; pp[128] = a2; pp[192] = a3; pp[256] = a4;
            __syncthreads();
            if (F.tid < 320) { const int r = F.tid >> 6, ln = F.tid & 63; float s = 0.f;
#pragma unroll
                for (int w = 0; w < 8; ++w) s += part[w * 320 + r * 64 + ln];
                const int cc = cg * 64 + ln;
                WSP(float, WS_MOD)[((size_t)l * 5 + r) * 6144 + cc] = s + F.in[I_BMOD][l * 6144 + cc]; }
            __syncthreads();
        }
    }
    if (F.bid == 0) {
        for (int i = F.tid; i < 1024; i += NT) { const int p = i >> 4, f = i & 15; const float inv = powf(10000.f, -(float)f / 16.f); const float ang = (float)p * inv;
            WSP(float, WS_ROPE)[i] = cosf(ang); WSP(float, WS_ROPE)[1024 + i] = sinf(ang); }
    }
    for (int i = F.bid * NT + F.tid; i < DEPTH * 2 * 2 * 8 * 4096; i += F.G * NT) {
        const int c = i & 63, d = (i >> 6) & 63, n = (i >> 12) & 7, gate = (i >> 15) & 1, ld = i >> 16;
        const float* src = gate ? F.in[I_BWI] : F.in[I_BWR];
        WSP(bf16, WS_LRUW)[i] = (bf16)f2bf(src[((size_t)ld * 8 + n) * 4096 + c * 64 + d]);
    }
}

template <int MODE>
__device__ __forceinline__ void norm_phase(Frame& F, int l) {
    LAS float* hs = (LAS float*)F.lds;
    LAS int* lcnt = (LAS int*)(F.lds + 65536);
    LAS int* lbase = lcnt + 32;
    const int ngroups = ((MODE == 2 || (MODE == 1 && l == DEPTH - 1)) ? TLAT : MROWS) / 16;
    const float* modl = WSP(float, WS_MOD) + (size_t)l * 5 * 6144;
    float pb0[32], pb1[32];
    if (MODE != 2) {
        REFRESH_TID(F);
        const int r16 = F.lane & 15, quad = F.lane >> 4, w = F.wave;
        const size_t stride = MODE == 0 ? (size_t)INW : (size_t)NEXP;
        const float* wp = (MODE == 0 ? F.in[I_WIN] + (size_t)l * D * INW + 3840 : F.in[I_WRT] + (size_t)l * D * NEXP) + (size_t)(128 * w + quad) * stride + r16;
#pragma unroll
        for (int s = 0; s < 32; ++s) { pb0[s] = wp[(size_t)(4 * s) * stride]; pb1[s] = MODE == 1 ? wp[(size_t)(4 * s) * stride + 16] : 0.f; }
    }
#pragma unroll 1
    for (int gi = F.bid; gi < ngroups; gi += F.G) {
        REFRESH_TID(F);
        if (MODE == 1) { if (F.tid < 32) lcnt[F.tid] = 0; }
        constexpr bool COMB = true;
        const bool comb = (MODE == 0 && l > 0) || MODE == 2;
        f32x4 vv[2][4]; v2u yv[2][4][4]; float swv[2][4];
#pragma unroll
        for (int i = 0; i < 2; ++i) {
            const int r = gi * 16 + 2 * F.wave + i;
            const float* xsrc;
            if (MODE == 0 && l == 0) xsrc = r < TLAT ? F.in[I_X] + (size_t)r * D : F.in[I_CTX] + (size_t)(r - TLAT) * D;
            else xsrc = WSP(float, WS_X) + (size_t)r * D;
#pragma unroll
            for (int j = 0; j < 4; ++j) vv[i][j] = *(const f32x4*)(xsrc + 4 * F.lane + 256 * j);
        }
        if (COMB && comb) {
            int srv[2][4];
#pragma unroll
            for (int i = 0; i < 2; ++i)
#pragma unroll
                for (int k = 0; k < 4; ++k) { const int r = gi * 16 + 2 * F.wave + i; srv[i][k] = WSP(int, WS_SROW)[r * 4 + k]; swv[i][k] = WSP(float, WS_SW)[r * 4 + k]; }
#pragma unroll
            for (int i = 0; i < 2; ++i)
#pragma unroll
                for (int k = 0; k < 4; ++k) { const bf16* yr = WSP(bf16, WS_YS) + (size_t)srv[i][k] * D;
#pragma unroll
                    for (int j = 0; j < 4; ++j) yv[i][k][j] = *(const v2u*)(yr + 4 * F.lane + 256 * j); }
        }
#pragma unroll
        for (int i = 0; i < 2; ++i) {
            const int lr = 2 * F.wave + i, r = gi * 16 + lr, mr = mod_row(r);
            f32x4 v[4];
#pragma unroll
            for (int j = 0; j < 4; ++j) v[j] = vv[i][j];
            if (comb) {
                const int lp = MODE == 2 ? DEPTH - 1 : l - 1;
                const float* gt2 = WSP(float, WS_MOD) + ((size_t)lp * 5 + mr) * 6144 + 5120;
                f32x4 cb[4];
#pragma unroll
                for (int j = 0; j < 4; ++j) cb[j] = (f32x4){0.f, 0.f, 0.f, 0.f};
#pragma unroll
                for (int k = 0; k < 4; ++k) { const float w = swv[i][k];
#pragma unroll
                    for (int j = 0; j < 4; ++j) { const v2u y = yv[i][k][j];
                        cb[j].x += w * bflo(y.x); cb[j].y += w * bfhi(y.x); cb[j].z += w * bflo(y.y); cb[j].w += w * bfhi(y.y); }
                }
#pragma unroll
                for (int j = 0; j < 4; ++j) { const f32x4 g = *(const f32x4*)(gt2 + 4 * F.lane + 256 * j); v[j] = v[j] + g * cb[j]; }
            }
            if (MODE == 0) {
#pragma unroll
                for (int j = 0; j < 4; ++j) *(f32x4*)(WSP(float, WS_X) + (size_t)r * D + 4 * F.lane + 256 * j) = v[j];
            }
            float ss = 0.f;
#pragma unroll
            for (int j = 0; j < 4; ++j) ss += (v[j].x * v[j].x + v[j].y * v[j].y) + (v[j].z * v[j].z + v[j].w * v[j].w);
            const float rstd = rsqrtf(wave_sum(ss) * (1.f / D) + EPS);
            if (MODE == 2) {
#pragma unroll
                for (int j = 0; j < 4; ++j) { const f32x4 g = *(const f32x4*)(F.in[I_GFIN] + 4 * F.lane + 256 * j);
                    *(f32x4*)(F.out + (size_t)r * D + 4 * F.lane + 256 * j) = v[j] * rstd * g; }
            } else {
                const float* gn = F.in[MODE == 0 ? I_G1 : I_G2] + l * D;
                const float* sh = modl + (size_t)mr * 6144 + (MODE == 0 ? 0 : 3072);
                const float* sc = sh + 1024;
#pragma unroll
                for (int j = 0; j < 4; ++j) { const int c0 = 4 * F.lane + 256 * j;
                    const f32x4 g = *(const f32x4*)(gn + c0), a = *(const f32x4*)(sh + c0), s = *(const f32x4*)(sc + c0);
                    const f32x4 h = (v[j] * rstd * g) * (s + 1.f) + a;
                    *(LAS f32x4*)(hs + lr * 1024 + c0) = h;
                    v2u o; o.x = pk2(h.x, h.y); o.y = pk2(h.z, h.w);
                    *(v2u*)(WSP(bf16, WS_H) + (size_t)r * D + c0) = o; }
            }
        }
        if (MODE == 2) continue;
        __syncthreads();
        LAS float* red = (LAS float*)(F.lds + 65536 + 256);
        {
            const int r16 = F.lane & 15, quad = F.lane >> 4, w = F.wave;
            const LAS float* hp = hs + r16 * 1024 + 128 * w + quad;
            f32x4 acc0 = (f32x4){0.f, 0.f, 0.f, 0.f}, acc1 = acc0;
#pragma unroll
            for (int s = 0; s < 32; ++s) { const float av = hp[4 * s];
                acc0 = __builtin_amdgcn_mfma_f32_16x16x4f32(av, pb0[s], acc0, 0, 0, 0);
                if (MODE == 1) acc1 = __builtin_amdgcn_mfma_f32_16x16x4f32(av, pb1[s], acc1, 0, 0, 0); }
#pragma unroll
            for (int j = 0; j < 4; ++j) { red[(w * 16 + 4 * quad + j) * 32 + r16] = acc0[j]; if (MODE == 1) red[(w * 16 + 4 * quad + j) * 32 + 16 + r16] = acc1[j]; }
        }
        __syncthreads();
        if (MODE == 0) {
            if (F.tid < 256) {
                const int lr = F.tid >> 4, col = F.tid & 15;
                float sacc = 0.f;
#pragma unroll
                for (int w = 0; w < 8; ++w) sacc += red[(w * 16 + lr) * 32 + col];
                WSP(float, WS_CAB)[(size_t)(gi * 16 + lr) * 16 + col] = sacc;
            }
        } else {
            const int lr = F.tid >> 5, e = F.tid & 31, r = gi * 16 + lr;
            float sacc = 0.f;
#pragma unroll
            for (int w = 0; w < 8; ++w) sacc += red[(w * 16 + lr) * 32 + e];
            const float lg = sacc + F.in[I_BRT][l * NEXP + e];
            float tv0, tv1, tv2, tv3; int ti0, ti1, ti2, ti3; bool taken = false;
#define TOP1(TV, TI) do { float bv = taken ? -INFINITY : lg; int bi = e; \
                _Pragma("unroll") for (int off = 16; off >= 1; off >>= 1) { const float ov = __shfl_xor(bv, off); const int oi = __shfl_xor(bi, off); \
                    if (ov > bv || (ov == bv && oi < bi)) { bv = ov; bi = oi; } } \
                TV = bv; TI = bi; if (bi == e) taken = true; } while (0)
            TOP1(tv0, ti0); TOP1(tv1, ti1); TOP1(tv2, ti2); TOP1(tv3, ti3);
#undef TOP1
            const float e1 = __expf(tv1 - tv0), e2 = __expf(tv2 - tv0), e3 = __expf(tv3 - tv0);
            const float inv = 1.f / (1.f + e1 + e2 + e3);
            const int my_e = e == 0 ? ti0 : (e == 1 ? ti1 : (e == 2 ? ti2 : ti3));
            const float my_w = e == 0 ? inv : (e == 1 ? e1 * inv : (e == 2 ? e2 * inv : e3 * inv));
            int pl = 0;
            if (e < 4) pl = atomicAdd((int*)&lcnt[my_e], 1);
            __syncthreads();
            if (F.tid < 32) { const int c = lcnt[F.tid]; lbase[F.tid] = c > 0 ? (int)__hip_atomic_fetch_add(F.ctl + CW_CNT + l * 32 + F.tid, (unsigned)c, __ATOMIC_RELAXED, __HIP_MEMORY_SCOPE_AGENT) : 0; }
            __syncthreads();
            if (e < 4) { const int p = lbase[my_e] + pl;
                WSP(int, WS_LIST)[(size_t)my_e * MROWS + p] = r * 4 + e;
                WSP(int, WS_SEP)[r * 4 + e] = (my_e << 20) | p;
                WSP(float, WS_SW)[r * 4 + e] = my_w; }
        }
        __syncthreads();
    }
}

__device__ __forceinline__ void moe_table(Frame& F, int l) {
    LAS int* tpre = (LAS int*)(F.lds + MISC_OFF + 256);
    LAS int* cnt = tpre + 40;
    __syncthreads();
    if (F.tid < 32) cnt[F.tid] = (int)__hip_atomic_load(F.ctl + CW_CNT + l * 32 + F.tid, __ATOMIC_RELAXED, __HIP_MEMORY_SCOPE_AGENT);
    __syncthreads();
    if (F.tid == 0) { int s = 0; for (int e = 0; e < 32; ++e) { tpre[e] = s; s += (cnt[e] + 255) >> 8; } tpre[32] = s; }
    __syncthreads();
}
__device__ __forceinline__ void moe_gather(Frame& F, int l) {
    moe_table(F, l);
    const LAS int* tpre = (const LAS int*)(F.lds + MISC_OFF + 256);
    const LAS int* cnt = tpre + 40;
    const int gw = F.bid * NWAVES + F.wave, NGW = F.G * NWAVES;
    REFRESH_TID(F);
    const int nrows_pad = tpre[32] * 256;
    int e = 0;
    for (int r0 = gw; r0 < nrows_pad; r0 += 8 * NGW) {
        int tk[8]; v4u ra[8], rb[8];
#pragma unroll
        for (int k = 0; k < 8; ++k) { const int r = r0 + k * NGW; tk[k] = -1;
            if (r < nrows_pad) { const int tau = r >> 8;
#pragma unroll 1
                while (tpre[e + 1] <= tau) ++e;
                const int p = r - tpre[e] * 256;
                if (p < cnt[e]) tk[k] = WSP(int, WS_LIST)[(size_t)e * MROWS + p]; } }
#pragma unroll
        for (int k = 0; k < 8; ++k) { const int tok = tk[k] >= 0 ? tk[k] >> 2 : 0; const v4u* src = (const v4u*)(WSP(bf16, WS_H) + (size_t)tok * D); ra[k] = src[F.lane]; rb[k] = src[F.lane + 64]; }
#pragma unroll
        for (int k = 0; k < 8; ++k) if (tk[k] >= 0) { const int dr = r0 + k * NGW; v4u* dst = (v4u*)(WSP(bf16, WS_HS) + (size_t)dr * D); dst[F.lane] = ra[k]; dst[F.lane + 64] = rb[k];
                if (F.lane == 0) WSP(int, WS_SROW)[tk[k]] = dr; }
    }
}


constexpr int AT_KP = 72, AT_VP = 68;
constexpr int AT_KB = 64 * AT_KP * 2, AT_VB = 64 * AT_VP * 2, AT_BUF = AT_KB + AT_VB;
constexpr int AT_RPB = 2 * AT_BUF;

__device__ __forceinline__ float max3f_(float a, float b, float c) { float r; asm("v_max3_f32 %0, %1, %2, %3" : "=v"(r) : "v"(a), "v"(b), "v"(c)); return r; }
struct AttnUnit {
    int kind;
    int b, hx, qx;
};

__device__ __forceinline__ void attn_unit(Frame& F, int l, const AttnUnit un) {
    REFRESH_TID(F);
    const int lane = F.lane, w = F.wave, q32 = lane & 31, hh = lane >> 5;
    const bf16* U = WSP(bf16, WS_U);
    const bool na = (un.kind & 1) != 0, ctxq = un.kind >= 2;
    const int b = un.b;
    int qrow0, qcol, kcol, ycol, nlat, krow_lat0, r_grid = 0, c0 = 0, rs_w = 0;
    const bf16* vt; bf16* Y;
    if (!na) {
        const int head = 4 * un.hx + (w & 3);
        qrow0 = (ctxq ? TLAT + b * LCTX : b * SEQ) + 64 * un.qx + 32 * (w >> 2);
        qcol = UQ + head * 64; kcol = UK + un.hx * 64; ycol = head * 64;
        vt = WSP(bf16, WS_VAT) + (size_t)(b * 2 + un.hx) * 64 * KEYS;
        Y = WSP(bf16, WS_Y);
        nlat = ctxq ? 0 : 64; krow_lat0 = b * SEQ;
    } else {
        const int head = un.hx;
        if (ctxq) { qrow0 = TLAT + b * LCTX + 32 * w; nlat = 0; krow_lat0 = 0; }
        else {
            r_grid = 4 * un.qx + (w >> 1); c0 = 32 * (w & 1);
            qrow0 = b * SEQ + 64 * r_grid + c0;
            int rs_min = 4 * un.qx - 4; rs_min = rs_min < 0 ? 0 : (rs_min > 56 ? 56 : rs_min);
            int rs_max = 4 * un.qx + 3 - 4; rs_max = rs_max < 0 ? 0 : (rs_max > 56 ? 56 : rs_max);
            nlat = rs_max + 8 - rs_min; krow_lat0 = b * SEQ + 64 * rs_min;
            rs_w = r_grid - 4; rs_w = rs_w < 0 ? 0 : (rs_w > 56 ? 56 : rs_w);
            rs_w -= rs_min;
        }
        qcol = UDQ + head * 64; kcol = UDK + head * 64; ycol = head * 64;
        vt = WSP(bf16, WS_VDT) + (size_t)(b * 8 + head) * 64 * KEYS;
        Y = WSP(bf16, WS_Y) + (size_t)3 * MROWS * 512;
    }
    const int vkey_lat0 = krow_lat0 - b * SEQ;
    const int ntile = nlat + 4;
    LAS unsigned char* lds = F.lds;
    if (na && !ctxq) {
        LAS float* rp = (LAS float*)(lds + AT_RPB);
        const float* src = F.in[I_RPB] + ((size_t)l * 8 + un.hx) * 465;
        for (int i = F.tid; i < 465; i += NT) rp[i] = src[i] * LOG2E;
    }
    bf16x8 qf[4];
    {
        const bf16* qp = U + (size_t)(qrow0 + q32) * UW + qcol + 8 * hh;
#pragma unroll
        for (int s = 0; s < 4; ++s) qf[s] = *(const bf16x8*)(qp + 16 * s);
        if (na) {
#pragma unroll
            for (int s = 0; s < 4; ++s) { v4u t = __builtin_bit_cast(v4u, qf[s]); const float sc = 0.125f * LOG2E;
                t.x = pk2(bflo(t.x) * sc, bfhi(t.x) * sc); t.y = pk2(bflo(t.y) * sc, bfhi(t.y) * sc); t.z = pk2(bflo(t.z) * sc, bfhi(t.z) * sc); t.w = pk2(bflo(t.w) * sc, bfhi(t.w) * sc);
                qf[s] = __builtin_bit_cast(bf16x8, t); }
        }
    }
    const int lk = F.tid >> 3, lc = F.tid & 7;
    v4u kr[4], vr[4];
#define AT_TILE_ADDR(i, krow0_, vkey0_) do { const int i_ = (i) < ntile ? (i) : ntile - 1; \
        if (i_ < nlat) { krow0_ = krow_lat0 + 64 * i_; vkey0_ = vkey_lat0 + 64 * i_; } else { krow0_ = TLAT + b * LCTX + 64 * (i_ - nlat); vkey0_ = SEQ + 64 * (i_ - nlat); } } while (0)
#define AT_LDK(dst, i) do { int kr0_, vk0_; AT_TILE_ADDR(i, kr0_, vk0_); (void)vk0_; dst = *(const v4u*)(U + (size_t)(kr0_ + lk) * UW + kcol + lc * 8); } while (0)
#define AT_LDV(dst, i) do { int kr0_, vk0_; AT_TILE_ADDR(i, kr0_, vk0_); (void)kr0_; dst = *(const v4u*)(vt + (size_t)lk * KEYS + vk0_ + lc * 8); } while (0)
#define AT_STK(src, buf) do { *(LAS v4u*)(lds + (buf) * AT_BUF + lk * (AT_KP * 2) + lc * 16) = src; } while (0)
#define AT_STV(src, buf) do { LAS unsigned char* b_ = lds + (buf) * AT_BUF + AT_KB + lk * (AT_VP * 2) + lc * 16; *(LAS v2u*)b_ = (v2u){src.x, src.y}; *(LAS v2u*)(b_ + 8) = (v2u){src.z, src.w}; } while (0)
    float m_run = 0.f, l_run = 0.f;
    f32x16 negm;
#pragma unroll
    for (int i = 0; i < 16; ++i) negm[i] = 0.f;
    bool first = true;
    f32x16 o0, o1;
#pragma unroll
    for (int i = 0; i < 16; ++i) { o0[i] = 0.f; o1[i] = 0.f; }
    const int cq = c0 + q32;
    int cst = cq - 8; cst = cst < 0 ? 0 : (cst > 48 ? 48 : cst);
#define AT_ACTIVE(i) (!(na && !ctxq && (i) < nlat && ((i) < rs_w || (i) > rs_w + 7)))
#define AT_QK(S0, S1, buf) do { const LAS unsigned char* kb_ = lds + (buf) * AT_BUF; \
        _Pragma("unroll") for (int s = 0; s < 4; ++s) { \
            const bf16x8 k0 = *(const LAS bf16x8*)(kb_ + (q32) * (AT_KP * 2) + (16 * s + 8 * hh) * 2); \
            const bf16x8 k1 = *(const LAS bf16x8*)(kb_ + (32 + q32) * (AT_KP * 2) + (16 * s + 8 * hh) * 2); \
            S0 = __builtin_amdgcn_mfma_f32_32x32x16_bf16(k0, qf[s], s == 0 ? negm : S0, 0, 0, 0); \
            S1 = __builtin_amdgcn_mfma_f32_32x32x16_bf16(k1, qf[s], s == 0 ? negm : S1, 0, 0, 0); } } while (0)
#define AT_SOFTMAX_PV(C0, C1, N0, N1, nvalid, i, vbuf) do { \
        if (na && !ctxq && (i) < nlat) { \
            const LAS float* rp = (const LAS float*)(lds + AT_RPB); \
            const int kr_ = (krow_lat0 - b * SEQ) / 64 + (i); const int rb = (kr_ - r_grid + 7) * 31 + 15 - cq; \
            _Pragma("unroll") for (int j = 0; j < 16; ++j) { \
                const int kc0 = (j & 3) + 8 * (j >> 2) + 4 * hh, kc1 = kc0 + 32; \
                const bool ok0 = kc0 >= cst && kc0 < cst + 16, ok1 = kc1 >= cst && kc1 < cst + 16; \
                int i0_ = rb + kc0, i1_ = rb + kc1; i0_ = i0_ < 0 ? 0 : (i0_ > 464 ? 464 : i0_); i1_ = i1_ < 0 ? 0 : (i1_ > 464 ? 464 : i1_); \
                const float b0 = rp[i0_], b1 = rp[i1_]; \
                C0[j] = ok0 ? C0[j] + b0 : -1e30f; C1[j] = ok1 ? C1[j] + b1 : -1e30f; } } \
        float mx = max3f_(C0[0], C1[0], C0[1]); \
        mx = max3f_(mx, C1[1], C0[2]); mx = max3f_(mx, C1[2], C0[3]); mx = max3f_(mx, C1[3], C0[4]); mx = max3f_(mx, C1[4], C0[5]); mx = max3f_(mx, C1[5], C0[6]); \
        mx = max3f_(mx, C1[6], C0[7]); mx = max3f_(mx, C1[7], C0[8]); mx = max3f_(mx, C1[8], C0[9]); mx = max3f_(mx, C1[9], C0[10]); mx = max3f_(mx, C1[10], C0[11]); \
        mx = max3f_(mx, C1[11], C0[12]); mx = max3f_(mx, C1[12], C0[13]); mx = max3f_(mx, C1[13], C0[14]); mx = max3f_(mx, C1[14], C0[15]); mx = fmaxf(mx, C1[15]); \
        mx = fmaxf(mx, __shfl_xor(mx, 32)); \
        if (first || __builtin_amdgcn_ballot_w64(mx > 6.f) != 0ull) {     \
            const float d = first ? fmaxf(mx, -120.f) : fmaxf(mx, 0.f); \
            const float alpha = __builtin_amdgcn_exp2f(-d); \
            l_run *= alpha; m_run += d; \
            _Pragma("unroll") for (int j = 0; j < 16; ++j) { o0[j] *= alpha; o1[j] *= alpha; C0[j] -= d; C1[j] -= d; negm[j] = -m_run; } \
            if (nvalid) { _Pragma("unroll") for (int j = 0; j < 16; ++j) { N0[j] -= d; N1[j] -= d; } } \
            first = false; } \
        float ps = 0.f; \
        _Pragma("unroll") for (int j = 0; j < 16; ++j) { C0[j] = __builtin_amdgcn_exp2f(C0[j]); C1[j] = __builtin_amdgcn_exp2f(C1[j]); ps += C0[j]; ps += C1[j]; } \
        l_run += ps; \
        bf16x8 pb[2][2]; \
        _Pragma("unroll") for (int s2 = 0; s2 < 2; ++s2) { v4u t0, t1; \
            t0.x = pk2(C0[8 * s2 + 0], C0[8 * s2 + 1]); t0.y = pk2(C0[8 * s2 + 2], C0[8 * s2 + 3]); t0.z = pk2(C0[8 * s2 + 4], C0[8 * s2 + 5]); t0.w = pk2(C0[8 * s2 + 6], C0[8 * s2 + 7]); \
            t1.x = pk2(C1[8 * s2 + 0], C1[8 * s2 + 1]); t1.y = pk2(C1[8 * s2 + 2], C1[8 * s2 + 3]); t1.z = pk2(C1[8 * s2 + 4], C1[8 * s2 + 5]); t1.w = pk2(C1[8 * s2 + 6], C1[8 * s2 + 7]); \
            pb[0][s2] = __builtin_bit_cast(bf16x8, t0); pb[1][s2] = __builtin_bit_cast(bf16x8, t1); } \
        const LAS unsigned char* vb_ = lds + (vbuf) * AT_BUF + AT_KB; \
        _Pragma("unroll") for (int sub = 0; sub < 2; ++sub) _Pragma("unroll") for (int s2 = 0; s2 < 2; ++s2) { \
            const int ko = (32 * sub + 16 * s2 + 4 * hh) * 2; \
            const v2u a0 = *(const LAS v2u*)(vb_ + (q32) * (AT_VP * 2) + ko), a1 = *(const LAS v2u*)(vb_ + (q32) * (AT_VP * 2) + ko + 16); \
            const v2u c0_ = *(const LAS v2u*)(vb_ + (32 + q32) * (AT_VP * 2) + ko), c1_ = *(const LAS v2u*)(vb_ + (32 + q32) * (AT_VP * 2) + ko + 16); \
            const bf16x8 vf0 = __builtin_bit_cast(bf16x8, ((v4u){a0.x, a0.y, a1.x, a1.y})); \
            const bf16x8 vf1 = __builtin_bit_cast(bf16x8, ((v4u){c0_.x, c0_.y, c1_.x, c1_.y})); \
            o0 = __builtin_amdgcn_mfma_f32_32x32x16_bf16(vf0, pb[sub][s2], o0, 0, 0, 0); \
            o1 = __builtin_amdgcn_mfma_f32_32x32x16_bf16(vf1, pb[sub][s2], o1, 0, 0, 0); } } while (0)
    f32x16 sa0, sa1, sb0, sb1;
    {
        v4u k0r, k1r, v0r; AT_LDK(k0r, 0); AT_LDK(k1r, 1); AT_LDV(v0r, 0);
#pragma unroll
        for (int st = 0; st < 4; ++st) { AT_LDK(kr[st], st + 2); AT_LDV(vr[st], st + 1); }
        AT_STK(k0r, 0); AT_STK(k1r, 1); AT_STV(v0r, 0);
        lds_barrier();
        if (AT_ACTIVE(0)) AT_QK(sa0, sa1, 0);
        lds_barrier();
    }
    const int ntile4 = (ntile + 3) & ~3;
#pragma unroll 1
    for (int i0 = 0; i0 < ntile4; i0 += 4) {
#pragma unroll
      for (int st = 0; st < 4; ++st) {
        const int i = i0 + st;
        AT_STK(kr[st], st & 1); AT_STV(vr[st], (st + 1) & 1);
        AT_LDK(kr[st], i + 6); AT_LDV(vr[st], i + 5);
        const bool nvalid = (i + 1 < ntile) && AT_ACTIVE(i + 1);
        if (st & 1) { if (nvalid) AT_QK(sa0, sa1, 0); if (i < ntile && AT_ACTIVE(i)) AT_SOFTMAX_PV(sb0, sb1, sa0, sa1, nvalid, i, 1); }
        else        { if (nvalid) AT_QK(sb0, sb1, 1); if (i < ntile && AT_ACTIVE(i)) AT_SOFTMAX_PV(sa0, sa1, sb0, sb1, nvalid, i, 0); }
        lds_barrier();
      }
    }
#undef AT_TILE_ADDR
#undef AT_LDK
#undef AT_LDV
#undef AT_STK
#undef AT_STV
#undef AT_ACTIVE
#undef AT_QK
#undef AT_SOFTMAX_PV
    const float lt = l_run + __shfl_xor(l_run, 32);
    const float inv = 1.f / lt;
    bf16* yp = Y + (size_t)(qrow0 + q32) * 512 + ycol + 4 * hh;
#pragma unroll
    for (int g = 0; g < 4; ++g) {
        v2u a; a.x = pk2(o0[4 * g] * inv, o0[4 * g + 1] * inv); a.y = pk2(o0[4 * g + 2] * inv, o0[4 * g + 3] * inv);
        v2u c; c.x = pk2(o1[4 * g] * inv, o1[4 * g + 1] * inv); c.y = pk2(o1[4 * g + 2] * inv, o1[4 * g + 3] * inv);
        *(v2u*)(yp + 8 * g) = a; *(v2u*)(yp + 32 + 8 * g) = c;
    }
    __syncthreads();
}

__device__ __forceinline__ void attn_phase(Frame& F, int l) {
    const int x = F.bid & 7, y = F.bid >> 3, ny = F.G >> 3;
    for (int q = y; q < 64; q += ny) { AttnUnit un; un.kind = 0; un.b = x >> 1; un.hx = x & 1; un.qx = q; attn_unit(F, l, un); }
    for (int q = y; q < 64; q += ny) { const int combo = x + 8 * (q >> 4); AttnUnit un; un.kind = 1; un.b = combo >> 3; un.hx = combo & 7; un.qx = q & 15; attn_unit(F, l, un); }
    for (int q = y; q < 8; q += ny) { AttnUnit un;
        if (q < 4) { un.kind = 2; un.b = x >> 1; un.hx = x & 1; un.qx = q; }
        else { const int combo = x + 8 * (q - 4); un.kind = 3; un.b = combo >> 3; un.hx = combo & 7; un.qx = 0; }
        attn_unit(F, l, un); }
}


__device__ __forceinline__ void qk_prep(Frame& F, int l) {
    REFRESH_TID(F);
    const int gw = F.bid * NWAVES + F.wave, NGW = F.G * NWAVES, lane = F.lane;
    bf16* U = WSP(bf16, WS_U);
    const float* tab = WSP(float, WS_ROPE);
    const int d0 = (lane & 7) * 8;
    float gq[8], gk[8];
#pragma unroll
    for (int j = 0; j < 8; ++j) { gq[j] = F.in[I_AGQ][l * 64 + d0 + j]; gk[j] = F.in[I_AGK][l * 64 + d0 + j]; }
    for (int r0 = gw; r0 < MROWS; r0 += 2 * NGW) {
        const int r1 = r0 + NGW;
        v4u qv2[2], kv2[2];
#pragma unroll
        for (int k = 0; k < 2; ++k) { const int r = k ? (r1 < MROWS ? r1 : r0) : r0; const bf16* up = U + (size_t)r * UW;
            qv2[k] = *(const v4u*)(up + UQ + lane * 8); kv2[k] = (v4u){0u, 0u, 0u, 0u}; if (lane < 16) kv2[k] = *(const v4u*)(up + UK + lane * 8); }
#pragma unroll
        for (int k = 0; k < 2; ++k) {
        const int r = k ? r1 : r0; if (r >= MROWS) break;
        const bool lat = r < TLAT;
        bf16* up = U + (size_t)r * UW;
        const v4u qv = qv2[k], kv = kv2[k];
        float cs[8], sn[8];
#pragma unroll
        for (int j = 0; j < 8; ++j) { cs[j] = 1.f; sn[j] = 0.f; }
        if (lat) { const int t = r & 4095;
#pragma unroll
            for (int j = 0; j < 8; ++j) { const int i = (d0 + j) & 31; const int idx = i < 16 ? (t >> 6) * 16 + i : (t & 63) * 16 + (i - 16); cs[j] = tab[idx]; sn[j] = tab[1024 + idx]; } }
#pragma unroll
        for (int which = 0; which < 2; ++which) {
            const v4u raw = which ? kv : qv;
            float x[8] = {bflo(raw.x), bfhi(raw.x), bflo(raw.y), bfhi(raw.y), bflo(raw.z), bfhi(raw.z), bflo(raw.w), bfhi(raw.w)};
            float ss = 0.f;
#pragma unroll
            for (int j = 0; j < 8; ++j) ss += x[j] * x[j];
            ss += __shfl_xor(ss, 1); ss += __shfl_xor(ss, 2); ss += __shfl_xor(ss, 4);
            const float rs = rsqrtf(ss * (1.f / 64.f) + EPS);
            float y[8];
#pragma unroll
            for (int j = 0; j < 8; ++j) y[j] = x[j] * rs * (which ? gk[j] : gq[j]);
            const bool hi = (lane & 4) != 0;
#pragma unroll
            for (int j = 0; j < 8; ++j) { const float p = __shfl_xor(y[j], 4);
                if (lat) y[j] = hi ? y[j] * cs[j] + p * sn[j] : y[j] * cs[j] - p * sn[j];
                if (!which) y[j] *= 0.125f * LOG2E; }
            v4u o; o.x = pk2(y[0], y[1]); o.y = pk2(y[2], y[3]); o.z = pk2(y[4], y[5]); o.w = pk2(y[6], y[7]);
            if (!which) *(v4u*)(up + UQ + lane * 8) = o; else if (lane < 16) *(v4u*)(up + UK + lane * 8) = o;
        }
        }
    }
}

__device__ __forceinline__ void v_transpose(Frame& F) {
    REFRESH_TID(F);
    const int gw = F.bid * NWAVES + F.wave, NGW = F.G * NWAVES, lane = F.lane;
    LAS bf16* T = (LAS bf16*)(F.lds + F.wave * 9216);
    const bf16* U = WSP(bf16, WS_U);
    for (int it = gw; it < NCHUNK * 10; it += NGW) {
        const int g = it / 10, hd = it % 10;
        int b, key0;
        if (g < 256) { b = g >> 6; key0 = (g & 63) * 64; } else { b = (g - 256) >> 2; key0 = SEQ + ((g - 256) & 3) * 64; }
        const int scol = hd < 2 ? UV + hd * 64 : UDV + (hd - 2) * 64;
        bf16* dst = hd < 2 ? WSP(bf16, WS_VAT) + (size_t)(b * 2 + hd) * 64 * KEYS : WSP(bf16, WS_VDT) + (size_t)(b * 8 + hd - 2) * 64 * KEYS;
        v4u rv[8];
#pragma unroll
        for (int i = 0; i < 8; ++i) { const int tok = 8 * i + (lane >> 3), ch = lane & 7; rv[i] = *(const v4u*)(U + (size_t)(64 * g + tok) * UW + scol + ch * 8); }
#pragma unroll
        for (int i = 0; i < 8; ++i) { const int tok = 8 * i + (lane >> 3), ch = lane & 7; const unsigned wv[4] = {rv[i].x, rv[i].y, rv[i].z, rv[i].w};
#pragma unroll
            for (int j = 0; j < 4; ++j) { T[(ch * 8 + 2 * j) * 72 + tok] = (bf16)(wv[j] & 0xffffu); T[(ch * 8 + 2 * j + 1) * 72 + tok] = (bf16)(wv[j] >> 16); } }
        asm volatile("s_waitcnt lgkmcnt(0)" ::: "memory");
#pragma unroll
        for (int i = 0; i < 8; ++i) { const int d = 8 * i + (lane >> 3), ch = lane & 7;
            const v4u o = *(const LAS v4u*)(T + d * 72 + ch * 8);
            *(v4u*)(dst + (size_t)d * KEYS + key0 + ch * 8) = o; }
        asm volatile("s_waitcnt lgkmcnt(0)" ::: "memory");
    }
}

constexpr int LR_XCB = 0, LR_WV = 17408, LR_WVB = 12288;
__device__ __forceinline__ void seq_bounds(int g, int& lo, int& hi) {
    if (g < 256) { lo = (g >> 6) * SEQ; hi = lo + SEQ; } else { lo = TLAT + ((g - 256) >> 2) * LCTX; hi = lo + LCTX; }
}
struct LruRaw { v4u r[3]; };
__device__ __forceinline__ void lru_raw_load(Frame& F, LruRaw& R, int g, int q) {
    const bf16* U = WSP(bf16, WS_U);
    int lo, hi; seq_bounds(g, lo, hi);
#pragma unroll
    for (int k = 0; k < 3; ++k) { const int i = F.tid + NT * k, rr = i >> 4, ch = i & 15, row = 64 * g - 1 + rr;
        v4u v = (v4u){0u, 0u, 0u, 0u};
        if (i < 67 * 16 && row >= lo && row < hi) v = *(const v4u*)(U + (size_t)row * UW + UBX + 128 * q + ch * 8);
        R.r[k] = v; }
}
__device__ __forceinline__ void lru_stage_conv(Frame& F, int l, const LruRaw& R, int q) {
    LAS bf16* raw = (LAS bf16*)(F.lds + LR_WV);
    LAS bf16* xcb = (LAS bf16*)(F.lds + LR_XCB);
    lds_barrier();
#pragma unroll
    for (int k = 0; k < 3; ++k) { const int i = F.tid + NT * k, rr = i >> 4, ch = i & 15; if (i < 67 * 16) *(LAS v4u*)(raw + rr * 128 + ch * 8) = R.r[k]; }
    lds_barrier();
    {
        const int ch = F.tid & 127, tg = F.tid >> 7, cabs = 128 * q + ch;
        const float* cw = F.in[I_BCW] + (size_t)l * 4 * 512 + cabs;
        const float w0 = cw[0], w1 = cw[512], w2 = cw[1024], w3 = cw[1536], bb = F.in[I_BCB][l * 512 + cabs];
        float x0 = bf2f(raw[(16 * tg) * 128 + ch]), x1 = bf2f(raw[(16 * tg + 1) * 128 + ch]), x2 = bf2f(raw[(16 * tg + 2) * 128 + ch]);
#pragma unroll
        for (int t = 0; t < 16; ++t) { const float x3 = bf2f(raw[(16 * tg + t + 3) * 128 + ch]);
            const float y = bb + w0 * x0 + w1 * x1 + w2 * x2 + w3 * x3;
            xcb[(16 * tg + t) * 136 + ch] = (bf16)f2bf(y);
            x0 = x1; x1 = x2; x2 = x3; }
    }
    lds_barrier();
}
struct LruW { bf16x8 br0, br1, bi0, bi1; float bR, bI, lam; };
__device__ __forceinline__ void lru_w_load(Frame& F, LruW& W, int l, int dir, int q) {
    const int lane = F.lane, w = F.wave, r16 = lane & 15, quad = lane >> 4;
    const int nbl = w >> 2, dt = w & 3, nb = 2 * q + nbl;
    const bf16* wr = WSP(bf16, WS_LRUW) + ((((size_t)(l * 2 + dir) * 2 + 0) * 8 + nb) * 64 + 16 * dt + r16) * 64 + 8 * quad;
    const bf16* wi = WSP(bf16, WS_LRUW) + ((((size_t)(l * 2 + dir) * 2 + 1) * 8 + nb) * 64 + 16 * dt + r16) * 64 + 8 * quad;
    W.br0 = *(const bf16x8*)wr; W.br1 = *(const bf16x8*)(wr + 32); W.bi0 = *(const bf16x8*)wi; W.bi1 = *(const bf16x8*)(wi + 32);
    const int cabs = 64 * nb + 16 * dt + r16;
    W.bR = F.in[I_BBR][(l * 2 + dir) * 512 + cabs]; W.bI = F.in[I_BBI][(l * 2 + dir) * 512 + cabs]; W.lam = F.in[I_BLAM][(l * 2 + dir) * 512 + cabs];
}
__device__ __forceinline__ void lru_gates(Frame& F, const LruW& W) {
    const int lane = F.lane, w = F.wave, r16 = lane & 15, quad = lane >> 4;
    const LAS bf16* xcb = (const LAS bf16*)(F.lds + LR_XCB);
    LAS float* sa = (LAS float*)(F.lds + LR_WV + w * LR_WVB);
    LAS float* sb = sa + 1024;
    const int nbl = w >> 2, dt = w & 3;
    const int cl = 64 * nbl + 16 * dt + r16;
    const float sp = softplusf_(-W.lam);
#pragma unroll
    for (int tt = 0; tt < 4; ++tt) {
        const LAS bf16* ap = xcb + (16 * tt + r16) * 136 + 64 * nbl + 8 * quad;
        const bf16x8 a0 = *(const LAS bf16x8*)ap, a1 = *(const LAS bf16x8*)(ap + 32);
        f32x4 ar = (f32x4){0.f, 0.f, 0.f, 0.f}, ai = ar;
        ar = __builtin_amdgcn_mfma_f32_16x16x32_bf16(a0, W.br0, ar, 0, 0, 0); ar = __builtin_amdgcn_mfma_f32_16x16x32_bf16(a1, W.br1, ar, 0, 0, 0);
        ai = __builtin_amdgcn_mfma_f32_16x16x32_bf16(a0, W.bi0, ai, 0, 0, 0); ai = __builtin_amdgcn_mfma_f32_16x16x32_bf16(a1, W.bi1, ai, 0, 0, 0);
#pragma unroll
        for (int j = 0; j < 4; ++j) { const int t = 16 * tt + 4 * quad + j;
            const float rg = sigmoidf_(ar[j] + W.bR), ig = sigmoidf_(ai[j] + W.bI);
            const float la = -8.f * rg * sp;
            const float a = __expf(la), x2 = 2.f * la;
            const float om = x2 > -0.05f ? -x2 * (1.f + x2 * (0.5f + x2 * (0.16666667f + x2 * 0.041666668f))) : 1.f - __expf(x2);
            const float mult = __builtin_amdgcn_sqrtf(om);
            const float xv = bf2f(xcb[t * 136 + cl]);
            sa[t * 16 + r16] = a; sb[t * 16 + r16] = mult * ig * xv; }
    }
    asm volatile("s_waitcnt lgkmcnt(0)" ::: "memory");
}
__device__ __forceinline__ void lru_pass1(Frame& F, int l) {
    const bool even = F.G == 256;
    const int nit = even ? (F.bid < 64 ? 2 : 5) : (NCHUNK * 4 - F.bid + F.G - 1) / F.G;
#define LRU1_ITEM(k) (even ? (F.bid < 64 ? F.bid + 64 * (k) : 128 + (F.bid - 64) * 5 + (k)) : F.bid + F.G * (k))
    LruRaw R; REFRESH_TID(F);
    if (nit > 0) { const int i0 = LRU1_ITEM(0); lru_raw_load(F, R, i0 >> 2, i0 & 3); }
#pragma unroll 1
    for (int kk = 0; kk < nit; ++kk) {
        const int it = LRU1_ITEM(kk);
        REFRESH_TID(F);
        const int g = it >> 2, q = it & 3;
        LruW W0, W1; lru_w_load(F, W0, l, 0, q); lru_w_load(F, W1, l, 1, q);
        lru_stage_conv(F, l, R, q);
        { const int itn = kk + 1 < nit ? LRU1_ITEM(kk + 1) : it; lru_raw_load(F, R, itn >> 2, itn & 3); }
#pragma unroll
        for (int dir = 0; dir < 2; ++dir) {
            lru_gates(F, dir ? W1 : W0);
            const int lane = F.lane, w = F.wave, ch = lane & 15, seg = lane >> 4;
            const LAS float* sa = (const LAS float*)(F.lds + LR_WV + w * LR_WVB); const LAS float* sb = sa + 1024;
            float A = 1.f, B = 0.f;
#pragma unroll
            for (int k = 0; k < 16; ++k) { const int tp = 16 * seg + k, t = dir ? 63 - tp : tp; const float a = sa[t * 16 + ch]; B = a * B + sb[t * 16 + ch]; A *= a; }
            float At = 1.f, Bt = 0.f;
#pragma unroll
            for (int s = 0; s < 4; ++s) { const float As = __shfl(A, 16 * s + ch), Bs = __shfl(B, 16 * s + ch); Bt = As * Bt + Bs; At *= As; }
            if (seg == 0) { const int cabs = 128 * q + 64 * (w >> 2) + 16 * (w & 3) + ch;
                WSP(float, WS_LRA)[((size_t)g * 2 + dir) * 512 + cabs] = At; WSP(float, WS_LRB)[((size_t)g * 2 + dir) * 512 + cabs] = Bt; }
            asm volatile("s_waitcnt lgkmcnt(0)" ::: "memory");
        }
    }
}
__device__ __forceinline__ void lru_carry_all(Frame& F) {
    REFRESH_TID(F);
    if (F.tid >= 16) return;
    const float* LA = WSP(float, WS_LRA); const float* LB = WSP(float, WS_LRB); float* LC = WSP(float, WS_LRC);
    for (int chain = F.bid * 16 + F.tid; chain < 4096; chain += F.G * 16) {
        const int ch = chain & 511, dir = (chain >> 9) & 1, b = chain >> 10;
        float h = 0.f;
#pragma unroll 1
        for (int sb = 0; sb < 4; ++sb) {
            float av[17], bv[17]; size_t ix[17];
#pragma unroll
            for (int k = 0; k < 17; ++k) { const int s = sb * 17 + k; int g;
                if (s < 4) g = 256 + 4 * b + (dir ? 3 - s : s); else g = 64 * b + (dir ? 63 - (s - 4) : (s - 4));
                ix[k] = ((size_t)g * 2 + dir) * 512 + ch; av[k] = LA[ix[k]]; bv[k] = LB[ix[k]]; }
#pragma unroll
            for (int k = 0; k < 17; ++k) { LC[ix[k]] = h; h = av[k] * h + bv[k]; }
        }
    }
}
__device__ __forceinline__ float gelu_tanh(float x) { const float u = 0.7978845608028654f * (x + 0.044715f * x * x * x); return x * __builtin_amdgcn_rcpf(1.f + __expf(-2.f * u)); }
__device__ __forceinline__ void lru_pass2(Frame& F, int l) {
    int it = F.bid;
    const int nitems = (l == DEPTH - 1 ? 256 : NCHUNK) * 4;
    LruRaw R; REFRESH_TID(F);
    if (it < nitems) lru_raw_load(F, R, it >> 2, it & 3);
#pragma unroll 1
    for (; it < nitems; it += F.G) {
        REFRESH_TID(F);
        const int g = it >> 2, q = it & 3;
        const int lane = F.lane, w = F.wave, ch = lane & 15, seg = lane >> 4;
        const int cabs = 128 * q + 64 * (w >> 2) + 16 * (w & 3) + ch;
        const bf16* U = WSP(bf16, WS_U); bf16* YB = WSP(bf16, WS_Y) + (size_t)1 * MROWS * 512;
        LruW W0, W1; lru_w_load(F, W0, l, 0, q); lru_w_load(F, W1, l, 1, q);
        const float hc0 = WSP(float, WS_LRC)[((size_t)g * 2 + 0) * 512 + cabs], hc1 = WSP(float, WS_LRC)[((size_t)g * 2 + 1) * 512 + cabs];
        unsigned yraw[16];
#pragma unroll
        for (int k = 0; k < 16; ++k) yraw[k] = U[((size_t)64 * g + 16 * seg + k) * UW + UBY + cabs];
        lru_stage_conv(F, l, R, q);
        { const int itn = it + F.G < nitems ? it + F.G : it; lru_raw_load(F, R, itn >> 2, itn & 3); }
        LAS float* sa = (LAS float*)(F.lds + LR_WV + w * LR_WVB); LAS float* sb = sa + 1024; LAS float* sh = sa + 2048;
#pragma unroll
        for (int dir = 0; dir < 2; ++dir) {
            lru_gates(F, dir ? W1 : W0);
            float A = 1.f, B = 0.f;
#pragma unroll
            for (int k = 0; k < 16; ++k) { const int tp = 16 * seg + k, t = dir ? 63 - tp : tp; const float a = sa[t * 16 + ch]; B = a * B + sb[t * 16 + ch]; A *= a; }
            float h = dir ? hc1 : hc0;
#pragma unroll
            for (int s = 0; s < 3; ++s) { const float As = __shfl(A, 16 * s + ch), Bs = __shfl(B, 16 * s + ch); if (s < seg) h = As * h + Bs; }
#pragma unroll
            for (int k = 0; k < 16; ++k) { const int tp = 16 * seg + k, t = dir ? 63 - tp : tp; h = sa[t * 16 + ch] * h + sb[t * 16 + ch];
                if (dir == 0) sh[t * 16 + ch] = h; else sh[t * 16 + ch] += h; }
            asm volatile("s_waitcnt lgkmcnt(0)" ::: "memory");
        }
#pragma unroll
        for (int k = 0; k < 16; ++k) { const int t = 16 * seg + k; const size_t row = (size_t)64 * g + t;
            YB[row * 512 + cabs] = (bf16)f2bf(sh[t * 16 + ch] * gelu_tanh(bflo(yraw[k]))); }
        asm volatile("s_waitcnt lgkmcnt(0)" ::: "memory");
    }
}

#ifndef GDN_PREP_REPS
#define GDN_PREP_REPS 1
#endif
#ifdef PROBE_SUB
#define GP_T(k) do { if (PROBE_SUB == (k) && F.bid == 0) { const unsigned long long n_ = __builtin_amdgcn_s_memrealtime(); F.pr += n_ - gp_t; } gp_t = __builtin_amdgcn_s_memrealtime(); } while (0)
#else
#define GP_T(k) do { } while (0)
#endif
constexpr int GD_CW = MISC_OFF + 2048;
constexpr int GD_Q = 0, GD_K = 17408, GD_V = 34816, GD_KK = 52224, GD_QK = 68864, GD_L = 85504, GD_SM = 118272;
__device__ __forceinline__ void gdn_prep(Frame& F, int l) {
    const bf16* U = WSP(bf16, WS_U);
    const int w = F.wave;
    __syncthreads();
    for (int i = F.tid; i < 4 * 1536 / 2; i += NT) { const float* cw = F.in[I_CCW] + (size_t)l * 4 * 1536 + 2 * i; ((LAS unsigned*)(F.lds + GD_CW))[i] = pk2(cw[0], cw[1]); }
    __syncthreads();
#pragma unroll 1
    for (int it0 = F.bid; it0 < NCHUNK * 4 * GDN_PREP_REPS; it0 += F.G) {
        const int it = it0 % (NCHUNK * 4);
        int tid = F.tid; asm volatile("" : "+v"(tid));
        const int lane = tid & 63, r16 = lane & 15, quad = lane >> 4;
        const int g = it >> 2, h = it & 3;
        int lo, hi; seq_bounds(g, lo, hi);
        LAS bf16* raw = (LAS bf16*)(F.lds + GD_KK);
#ifdef PROBE_SUB
        unsigned long long gp_t = __builtin_amdgcn_s_memrealtime();
#endif
        lds_barrier();
        {
            v4u rv[7];
#pragma unroll
            for (int k = 0; k < 7; ++k) { const int i = tid + NT * k; const int ten = i / 1072, r_ = i - ten * 1072, rr = r_ >> 4, ch = r_ & 15, row = 64 * g - 1 + rr;
                const int ucol = (ten == 0 ? UCQ : (ten == 1 ? UCK : UCV)) + 128 * h;
                rv[k] = (v4u){0u, 0u, 0u, 0u};
                if (i < 3216 && row >= lo && row < hi) rv[k] = *(const v4u*)(U + (size_t)row * UW + ucol + ch * 8); }
#pragma unroll
            for (int k = 0; k < 7; ++k) { const int i = tid + NT * k; const int ten = i / 1072, r_ = i - ten * 1072, rr = r_ >> 4, ch = r_ & 15;
                if (i < 3216) *(LAS v4u*)(raw + ten * (67 * 128) + rr * 128 + ch * 8) = rv[k]; }
        }
        lds_barrier();
#pragma unroll 1
        for (int ten = 0; ten < 3; ++ten) {
            const int t = tid >> 3, ds = tid & 7;
            const LAS bf16* rawt = raw + ten * (67 * 128);
            const LAS bf16* cwl = (const LAS bf16*)(F.lds + GD_CW) + ten * 512 + 128 * h + 16 * ds;
            float y[16]; float ss = 0.f;
            {
                float xin[4][16], wv_[4][16];
#pragma unroll
                for (int j = 0; j < 4; ++j) { const v4u r0 = *(const LAS v4u*)(rawt + (t + j) * 128 + 16 * ds), r1 = *(const LAS v4u*)(rawt + (t + j) * 128 + 16 * ds + 8);
                    const v4u w0 = *(const LAS v4u*)(cwl + j * 1536), w1 = *(const LAS v4u*)(cwl + j * 1536 + 8);
                    const unsigned rv[8] = {r0.x, r0.y, r0.z, r0.w, r1.x, r1.y, r1.z, r1.w}, wq[8] = {w0.x, w0.y, w0.z, w0.w, w1.x, w1.y, w1.z, w1.w};
#pragma unroll
                    for (int q = 0; q < 8; ++q) { xin[j][2 * q] = bflo(rv[q]); xin[j][2 * q + 1] = bfhi(rv[q]); wv_[j][2 * q] = bflo(wq[q]); wv_[j][2 * q + 1] = bfhi(wq[q]); } }
#pragma unroll
                for (int jj = 0; jj < 16; ++jj) {
                    float a = 0.f;
#pragma unroll
                    for (int j = 0; j < 4; ++j) a += wv_[j][jj] * xin[j][jj];
                    a = siluf_(a); y[jj] = a; ss += a * a;
                }
            }
            float sc = 1.f;
            if (ten < 2) { ss += __shfl_xor(ss, 1); ss += __shfl_xor(ss, 2); ss += __shfl_xor(ss, 4); sc = rsqrtf(ss + EPS); if (ten == 0) sc *= 0.08838834764831845f; }
            LAS bf16* dstp = (LAS bf16*)(F.lds + (ten == 0 ? GD_Q : (ten == 1 ? GD_K : GD_V))) + t * 136 + 16 * ds;
            v4u o0, o1;
            o0.x = pk2(y[0] * sc, y[1] * sc); o0.y = pk2(y[2] * sc, y[3] * sc); o0.z = pk2(y[4] * sc, y[5] * sc); o0.w = pk2(y[6] * sc, y[7] * sc);
            o1.x = pk2(y[8] * sc, y[9] * sc); o1.y = pk2(y[10] * sc, y[11] * sc); o1.z = pk2(y[12] * sc, y[13] * sc); o1.w = pk2(y[14] * sc, y[15] * sc);
            *(LAS v4u*)dstp = o0; *(LAS v4u*)(dstp + 8) = o1;
        }
        lds_barrier();
        const LAS bf16* qs = (const LAS bf16*)(F.lds + GD_Q); const LAS bf16* ks = (const LAS bf16*)(F.lds + GD_K); const LAS bf16* vs = (const LAS bf16*)(F.lds + GD_V);
        GP_T(20);
        {
            const int mat = w >> 2, rt = w & 3;
            const LAS bf16* As = mat ? qs : ks;
            LAS float* Out = (LAS float*)(F.lds + (mat ? GD_QK : GD_KK));
            bf16x8 af[4];
#pragma unroll
            for (int s = 0; s < 4; ++s) af[s] = *(const LAS bf16x8*)(As + (16 * rt + r16) * 136 + 32 * s + 8 * quad);
#pragma unroll
            for (int ct = 0; ct < 4; ++ct) {
                f32x4 acc = (f32x4){0.f, 0.f, 0.f, 0.f};
#pragma unroll
                for (int s = 0; s < 4; ++s) { const bf16x8 bfr = *(const LAS bf16x8*)(ks + (16 * ct + r16) * 136 + 32 * s + 8 * quad);
                    acc = __builtin_amdgcn_mfma_f32_16x16x32_bf16(af[s], bfr, acc, 0, 0, 0); }
#pragma unroll
                for (int j = 0; j < 4; ++j) Out[(16 * rt + 4 * quad + j) * 65 + 16 * ct + r16] = acc[j];
            }
        }
        GP_T(21);
        int tid2 = F.tid; asm volatile("" : "+v"(tid2));
        const int dir = tid2 >> 8, dt = tid2 & 255;
        LAS float* sm = (LAS float*)(F.lds + GD_SM) + dir * 256;
        if (dt < 64) {
            const int ti = dir ? 63 - dt : dt; const size_t row = (size_t)64 * g + ti;
            const float ga = WSP(float, WS_CAB)[row * 16 + dir * 4 + h], gb = WSP(float, WS_CAB)[row * 16 + 8 + dir * 4 + h];
            const float gv = -__expf(F.in[I_CALOG][(l * 2 + dir) * 4 + h]) * softplusf_(ga + F.in[I_CDTB][(l * 2 + dir) * 4 + h]);
            float v = gv;
#pragma unroll
            for (int off = 1; off < 64; off <<= 1) { const float u = __builtin_bit_cast(float, __builtin_amdgcn_ds_bpermute(((lane - off) & 63) << 2, __builtin_bit_cast(int, v))); if (lane >= off) v += u; }
            sm[dt] = gv; sm[64 + dt] = sigmoidf_(gb); sm[128 + dt] = v; sm[192 + dt] = __expf(v);
        }
        lds_barrier();
        size_t cd;
        { int bq, cq_, stp; if (g < 256) { bq = g >> 6; cq_ = g & 63; stp = 4 + (dir ? 63 - cq_ : cq_); } else { bq = (g - 256) >> 2; cq_ = (g - 256) & 3; stp = dir ? 3 - cq_ : cq_; }
          cd = ((size_t)((bq * 4 + h) * 2 + dir)) * 68 + stp; }
        const LAS float* KK = (const LAS float*)(F.lds + GD_KK); const LAS float* QKm = (const LAS float*)(F.lds + GD_QK);
        LAS float* Ls = (LAS float*)(F.lds + GD_L) + dir * 4096;
        {
            bf16* gqk = WSP(bf16, WS_GQK) + cd * 4096;
            for (int idx = dt; idx < 4096; idx += 256) { const int i = idx >> 6, j = idx & 63; const int ti = dir ? 63 - i : i, tj = dir ? 63 - j : j;
                const float dec = j <= i ? __expf(sm[128 + i] - sm[128 + j]) : 0.f;
                Ls[idx] = j < i ? sm[64 + i] * KK[ti * 65 + tj] * dec : 0.f;
                gqk[idx] = (bf16)f2bf(QKm[ti * 65 + tj] * dec); }
        }
        lds_barrier();
        GP_T(22);
        {
            int tq = F.tid; asm volatile("" : "+v"(tq));
            const int wq = tq >> 6, lq = tq & 63;
            LAS bf16* VT = (LAS bf16*)(F.lds + GD_KK); LAS bf16* KT = (LAS bf16*)(F.lds + GD_QK);
            if ((wq & 3) == 0) {
                const int sdir = wq >> 2;
                const LAS float* Lss = (const LAS float*)(F.lds + GD_L) + sdir * 4096;
                const LAS float* sms = (const LAS float*)(F.lds + GD_SM) + sdir * 256;
                float X[64];
#pragma unroll
                for (int i = 0; i < 64; ++i) {
                    float p0 = 0.f, p1 = 0.f, p2 = 0.f, p3 = 0.f;
#pragma unroll
                    for (int j = 0; j < i; ++j) { const float t_ = Lss[i * 64 + j] * X[j]; if ((j & 3) == 0) p0 += t_; else if ((j & 3) == 1) p1 += t_; else if ((j & 3) == 2) p2 += t_; else p3 += t_; }
                    X[i] = (i == lq ? 1.f : 0.f) - ((p0 + p1) + (p2 + p3));
                    asm volatile("" ::: "memory");
                }
                const float be = sms[64 + lq], beg = be * sms[192 + lq];
                const int tcol = sdir ? 63 - lq : lq;
                LAS bf16* A1 = (LAS bf16*)(F.lds + GD_L + sdir * 16384); LAS bf16* A2 = A1 + 4096;
                asm volatile("s_waitcnt lgkmcnt(0)" ::: "memory");
#pragma unroll
                for (int i = 0; i < 64; ++i) { A1[i * 64 + tcol] = (bf16)f2bf(X[i] * be); A2[i * 64 + tcol] = (bf16)f2bf(X[i] * beg); }
            } else {
                const int t6 = (wq - 1 - (wq > 4 ? 1 : 0)) * 64 + lq;
                for (int idx = t6; idx < 2 * 8192; idx += 384) { const int mat = idx >> 13, r_ = idx & 8191, n = r_ >> 6, t = r_ & 63;
                    (mat ? KT : VT)[n * 64 + t] = (mat ? ks : vs)[t * 136 + n]; }
            }
            lds_barrier();
            {
                const int sdir = wq >> 2, rt = wq & 3, r16 = lq & 15, quad = lq >> 4;
                const LAS bf16* A1 = (const LAS bf16*)(F.lds + GD_L + sdir * 16384); const LAS bf16* A2 = A1 + 4096;
                size_t cds;
                { int bq, cq_, stp; if (g < 256) { bq = g >> 6; cq_ = g & 63; stp = 4 + (sdir ? 63 - cq_ : cq_); } else { bq = (g - 256) >> 2; cq_ = (g - 256) & 3; stp = sdir ? 3 - cq_ : cq_; }
                  cds = ((size_t)((bq * 4 + h) * 2 + sdir)) * 68 + stp; }
                const bf16x8 a1_0 = *(const LAS bf16x8*)(A1 + (16 * rt + r16) * 64 + 8 * quad), a1_1 = *(const LAS bf16x8*)(A1 + (16 * rt + r16) * 64 + 32 + 8 * quad);
                const bf16x8 a2_0 = *(const LAS bf16x8*)(A2 + (16 * rt + r16) * 64 + 8 * quad), a2_1 = *(const LAS bf16x8*)(A2 + (16 * rt + r16) * 64 + 32 + 8 * quad);
                bf16* gu = WSP(bf16, WS_GU) + cds * 8192; bf16* gw = WSP(bf16, WS_GW) + cds * 8192;
#pragma unroll
                for (int ct = 0; ct < 8; ++ct) {
                    const bf16x8 v0 = *(const LAS bf16x8*)(VT + (16 * ct + r16) * 64 + 8 * quad), v1 = *(const LAS bf16x8*)(VT + (16 * ct + r16) * 64 + 32 + 8 * quad);
                    const bf16x8 k0 = *(const LAS bf16x8*)(KT + (16 * ct + r16) * 64 + 8 * quad), k1 = *(const LAS bf16x8*)(KT + (16 * ct + r16) * 64 + 32 + 8 * quad);
                    f32x4 cu = (f32x4){0.f, 0.f, 0.f, 0.f}, cw = cu;
                    cu = __builtin_amdgcn_mfma_f32_16x16x32_bf16(a1_0, v0, cu, 0, 0, 0); cu = __builtin_amdgcn_mfma_f32_16x16x32_bf16(a1_1, v1, cu, 0, 0, 0);
                    cw = __builtin_amdgcn_mfma_f32_16x16x32_bf16(a2_0, k0, cw, 0, 0, 0); cw = __builtin_amdgcn_mfma_f32_16x16x32_bf16(a2_1, k1, cw, 0, 0, 0);
                    { v2u o; o.x = pk2(cu[0], cu[1]); o.y = pk2(cu[2], cu[3]); *(v2u*)(gu + (size_t)(16 * ct + r16) * 64 + 16 * rt + 4 * quad) = o; }
#pragma unroll
                    for (int j = 0; j < 4; ++j) gw[(size_t)(16 * rt + 4 * quad + j) * 128 + 16 * ct + r16] = (bf16)f2bf(cw[j]);
                }
            }
        }
        GP_T(23);
        {
            bf16* gqg = WSP(bf16, WS_GQG) + cd * 8192; bf16* gkd = WSP(bf16, WS_GKD) + cd * 8192;
            const float gl = sm[128 + 63];
            for (int idx = dt; idx < 8192; idx += 256) { const int i = idx >> 7, d = idx & 127; const int ti = dir ? 63 - i : i;
                gqg[idx] = (bf16)f2bf(bf2f(qs[ti * 136 + d]) * sm[192 + i]); }
            { const int i = dt & 63; const int ti = dir ? 63 - i : i; const float fk = __expf(gl - sm[128 + i]);
              for (int idx = dt; idx < 8192; idx += 256) { const int d = idx >> 6; gkd[idx] = (bf16)f2bf(bf2f(ks[ti * 136 + d]) * fk); } }
            if (dt == 0) WSP(float, WS_GGL)[cd] = __expf(gl);
        }
        GP_T(24);
    }
    __syncthreads();
}

constexpr int GS_ST = 0, GS_VN = 4352, GS_O = 8192;
struct GdnOps { bf16x8 a[4]; bf16x8 qk[2]; bf16x8 kd[2]; v2u uv; float gl; };
__device__ __forceinline__ bf16x8 ld16_asm(const void* p) { bf16x8 v; asm volatile("global_load_dwordx4 %0, %1, off" : "=v"(v) : "v"(p) : "memory"); return v; }
__device__ __forceinline__ v2u ld8_asm(const void* p) { v2u v; asm volatile("global_load_dwordx2 %0, %1, off" : "=v"(v) : "v"(p) : "memory"); return v; }
__device__ __forceinline__ float ld4_asm(const void* p) { float v; asm volatile("global_load_dword %0, %1, off" : "=v"(v) : "v"(p) : "memory"); return v; }
__device__ __forceinline__ void gdn_load_asm(Frame& F, GdnOps& o, size_t cd, int sl) {
    const int lane = F.lane, w = F.wave, r16 = lane & 15, quad = lane >> 4, rt = w & 3;
    const bf16* ap = (w < 4 ? WSP(bf16, WS_GW) : WSP(bf16, WS_GQG)) + cd * 8192 + (size_t)(16 * rt + r16) * 128 + 8 * quad;
#pragma unroll
    for (int s = 0; s < 4; ++s) o.a[s] = ld16_asm(ap + 32 * s);
    const bf16* kp = WSP(bf16, WS_GKD) + cd * 8192 + (size_t)(16 * w + r16) * 64 + 8 * quad;
    o.kd[0] = ld16_asm(kp); o.kd[1] = ld16_asm(kp + 32);
    const bf16* qp = WSP(bf16, WS_GQK) + cd * 4096 + (size_t)(16 * rt + r16) * 64 + 8 * quad;
    o.qk[0] = ld16_asm(qp); o.qk[1] = ld16_asm(qp + 32);
    o.uv = ld8_asm(WSP(bf16, WS_GU) + cd * 8192 + (size_t)(16 * sl + r16) * 64 + 16 * rt + 4 * quad);
    o.gl = ld4_asm(WSP(float, WS_GGL) + cd);
}
__device__ __forceinline__ void gdn_load(Frame& F, GdnOps& o, size_t cd, int sl) {
    const int lane = F.lane, w = F.wave, r16 = lane & 15, quad = lane >> 4, rt = w & 3;
    const bf16* ap = (w < 4 ? WSP(bf16, WS_GW) : WSP(bf16, WS_GQG)) + cd * 8192 + (size_t)(16 * rt + r16) * 128 + 8 * quad;
#pragma unroll
    for (int s = 0; s < 4; ++s) o.a[s] = *(const bf16x8*)(ap + 32 * s);
    const bf16* kp = WSP(bf16, WS_GKD) + cd * 8192 + (size_t)(16 * w + r16) * 64 + 8 * quad;
    o.kd[0] = *(const bf16x8*)kp; o.kd[1] = *(const bf16x8*)(kp + 32);
    { const bf16* qp = WSP(bf16, WS_GQK) + cd * 4096 + (size_t)(16 * rt + r16) * 64 + 8 * quad; o.qk[0] = *(const bf16x8*)qp; o.qk[1] = *(const bf16x8*)(qp + 32); }
    o.uv = *(const v2u*)(WSP(bf16, WS_GU) + cd * 8192 + (size_t)(16 * sl + r16) * 64 + 16 * rt + 4 * quad);
    o.gl = WSP(float, WS_GGL)[cd];
}
__device__ __forceinline__ size_t gdn_cd(int b, int h, int dir, int s) { return ((size_t)((b * 4 + h) * 2 + dir)) * 68 + s; }
__device__ __forceinline__ int gdn_g(int b, int dir, int s) {
    return s < 4 ? 256 + 4 * b + (dir ? 3 - s : s) : 64 * b + (dir ? 63 - (s - 4) : (s - 4)); }
__device__ __forceinline__ void gdn_scan(Frame& F, int chain) {
    REFRESH_TID(F);
    const int xq = chain & 7, yq = chain >> 3, cg = (yq >> 3) * 8 + xq, sl = yq & 7;
    const int dir = cg & 1, h = (cg >> 1) & 3, b = cg >> 3;
    const int lane = F.lane, w = F.wave, r16 = lane & 15, quad = lane >> 4, rt = w & 3;
    LAS bf16* St = (LAS bf16*)(F.lds + GS_ST); LAS bf16* VNt = (LAS bf16*)(F.lds + GS_VN);
    __syncthreads();
    for (int i = F.tid; i < (GS_VN + 2304) / 4; i += NT) ((LAS unsigned*)F.lds)[i] = 0u;
    __syncthreads();
    f32x4 sacc = (f32x4){0.f, 0.f, 0.f, 0.f};
    float* GO = WSP(float, WS_GO) + (size_t)dir * MROWS * 512;
    LAS float* Ost = (LAS float*)(F.lds + GS_O);
#define GDN_STEP(cur, s_) do { \
          \
        asm volatile("s_waitcnt vmcnt(30)" : "+v"(cur.a[0]), "+v"(cur.a[1]), "+v"(cur.a[2]), "+v"(cur.a[3]), "+v"(cur.kd[0]), "+v"(cur.kd[1]), "+v"(cur.qk[0]), "+v"(cur.qk[1]), "+v"(cur.uv), "+v"(cur.gl) :: "memory"); \
        bf16x8 sbf[4]; \
        _Pragma("unroll") for (int ks = 0; ks < 4; ++ks) sbf[ks] = *(const LAS bf16x8*)(St + r16 * 136 + 32 * ks + 8 * quad); \
        f32x4 acc = (f32x4){0.f, 0.f, 0.f, 0.f}; \
        _Pragma("unroll") for (int ks = 0; ks < 4; ++ks) acc = __builtin_amdgcn_mfma_f32_16x16x32_bf16(cur.a[ks], sbf[ks], acc, 0, 0, 0); \
        if (w < 4) { v2u o; o.x = pk2(bflo(cur.uv.x) - acc[0], bfhi(cur.uv.x) - acc[1]); o.y = pk2(bflo(cur.uv.y) - acc[2], bfhi(cur.uv.y) - acc[3]); \
            *(LAS v2u*)(VNt + r16 * 72 + 16 * rt + 4 * quad) = o; } \
        lds_barrier(); \
        const bf16x8 vb0 = *(const LAS bf16x8*)(VNt + r16 * 72 + 8 * quad), vb1 = *(const LAS bf16x8*)(VNt + r16 * 72 + 32 + 8 * quad); \
        if (w >= 4) { \
            acc = __builtin_amdgcn_mfma_f32_16x16x32_bf16(cur.qk[0], vb0, acc, 0, 0, 0); \
            acc = __builtin_amdgcn_mfma_f32_16x16x32_bf16(cur.qk[1], vb1, acc, 0, 0, 0); \
            _Pragma("unroll") for (int j = 0; j < 4; ++j) Ost[(((s_) & 3) * 64 + 16 * rt + 4 * quad + j) * 16 + r16] = acc[j]; } \
        sacc = sacc * cur.gl; \
        sacc = __builtin_amdgcn_mfma_f32_16x16x32_bf16(cur.kd[0], vb0, sacc, 0, 0, 0); \
        sacc = __builtin_amdgcn_mfma_f32_16x16x32_bf16(cur.kd[1], vb1, sacc, 0, 0, 0); \
        { v2u o; o.x = pk2(sacc[0], sacc[1]); o.y = pk2(sacc[2], sacc[3]); *(LAS v2u*)(St + r16 * 136 + 16 * w + 4 * quad) = o; } \
        lds_barrier(); \
    } while (0)
    GdnOps r0, r1, r2, r3;
    gdn_load_asm(F, r0, gdn_cd(b, h, dir, 0), sl); gdn_load_asm(F, r1, gdn_cd(b, h, dir, 1), sl); gdn_load_asm(F, r2, gdn_cd(b, h, dir, 2), sl); gdn_load_asm(F, r3, gdn_cd(b, h, dir, 3), sl);
#pragma unroll 1
    for (int s = 0; s < 68; s += 4) {
        GDN_STEP(r0, s);     gdn_load_asm(F, r0, gdn_cd(b, h, dir, (s + 4 < 68 ? s + 4 : 67)), sl);
        GDN_STEP(r1, s + 1); gdn_load_asm(F, r1, gdn_cd(b, h, dir, (s + 5 < 68 ? s + 5 : 67)), sl);
        GDN_STEP(r2, s + 2); gdn_load_asm(F, r2, gdn_cd(b, h, dir, (s + 6 < 68 ? s + 6 : 67)), sl);
        GDN_STEP(r3, s + 3);
#pragma unroll
        for (int k2 = 0; k2 < 2; ++k2) { const int idx = F.tid + 512 * k2, st = idx >> 8, i = (idx >> 2) & 63, qd = idx & 3;
            const f32x4 v = *(const LAS f32x4*)(Ost + (st * 64 + i) * 16 + 4 * qd);
            const int g = gdn_g(b, dir, s + st), ti = dir ? 63 - i : i;
            *(f32x4*)(GO + ((size_t)64 * g + ti) * 512 + h * 128 + 16 * sl + 4 * qd) = v; }
        gdn_load_asm(F, r3, gdn_cd(b, h, dir, (s + 7 < 68 ? s + 7 : 67)), sl);
    }
#undef GDN_STEP
    asm volatile("s_waitcnt vmcnt(0)" ::: "memory");
    __syncthreads();
}
template <int NCT> struct GdnOpsW { bf16x8 a[4]; bf16x8 qk[2]; bf16x8 kd[2]; v2u uv[NCT]; float gl; };
template <int NCT>
__device__ __forceinline__ void gdn_load_wide(Frame& F, GdnOpsW<NCT>& o, size_t cd, int part) {
    const int lane = F.lane, w = F.wave, r16 = lane & 15, quad = lane >> 4, rt = w & 3;
    const bf16* ap = (w < 4 ? WSP(bf16, WS_GW) : WSP(bf16, WS_GQG)) + cd * 8192 + (size_t)(16 * rt + r16) * 128 + 8 * quad;
#pragma unroll
    for (int s = 0; s < 4; ++s) o.a[s] = *(const bf16x8*)(ap + 32 * s);
    const bf16* kp = WSP(bf16, WS_GKD) + cd * 8192 + (size_t)(16 * w + r16) * 64 + 8 * quad;
    o.kd[0] = *(const bf16x8*)kp; o.kd[1] = *(const bf16x8*)(kp + 32);
    { const bf16* qp = WSP(bf16, WS_GQK) + cd * 4096 + (size_t)(16 * rt + r16) * 64 + 8 * quad; o.qk[0] = *(const bf16x8*)qp; o.qk[1] = *(const bf16x8*)(qp + 32); }
    const bf16* up = WSP(bf16, WS_GU) + cd * 8192 + (size_t)(part * NCT * 16 + r16) * 64 + 16 * rt + 4 * quad;
#pragma unroll
    for (int ct = 0; ct < NCT; ++ct) o.uv[ct] = *(const v2u*)(up + (size_t)ct * 16 * 64);
    o.gl = WSP(float, WS_GGL)[cd];
}
template <int NCT>
__device__ __forceinline__ void gdn_scan_wide(Frame& F, int cg, int part) {
    REFRESH_TID(F);
    constexpr int NC = NCT * 16, OFF_VN = NC * 136 * 2, OFF_O = OFF_VN + NC * 72 * 2;
    const int dir = cg & 1, h = (cg >> 1) & 3, b = cg >> 3;
    const int lane = F.lane, w = F.wave, r16 = lane & 15, quad = lane >> 4, rt = w & 3;
    LAS bf16* St = (LAS bf16*)(F.lds); LAS bf16* VNt = (LAS bf16*)(F.lds + OFF_VN); LAS float* Ost = (LAS float*)(F.lds + OFF_O);
    __syncthreads();
    for (int i = F.tid; i < OFF_O / 4; i += NT) ((LAS unsigned*)F.lds)[i] = 0u;
    __syncthreads();
    f32x4 sacc[NCT];
#pragma unroll
    for (int ct = 0; ct < NCT; ++ct) sacc[ct] = (f32x4){0.f, 0.f, 0.f, 0.f};
    float* GO = WSP(float, WS_GO) + (size_t)dir * MROWS * 512;
#define GDNW_STEP(cur, s_) do { \
        f32x4 acc[NCT]; \
        _Pragma("unroll") for (int ct = 0; ct < NCT; ++ct) { acc[ct] = (f32x4){0.f, 0.f, 0.f, 0.f}; \
            _Pragma("unroll") for (int ks = 0; ks < 4; ++ks) { const bf16x8 sb = *(const LAS bf16x8*)(St + (16 * ct + r16) * 136 + 32 * ks + 8 * quad); \
                acc[ct] = __builtin_amdgcn_mfma_f32_16x16x32_bf16(cur.a[ks], sb, acc[ct], 0, 0, 0); } } \
        if (w < 4) { _Pragma("unroll") for (int ct = 0; ct < NCT; ++ct) { v2u o; o.x = pk2(bflo(cur.uv[ct].x) - acc[ct][0], bfhi(cur.uv[ct].x) - acc[ct][1]); o.y = pk2(bflo(cur.uv[ct].y) - acc[ct][2], bfhi(cur.uv[ct].y) - acc[ct][3]); \
            *(LAS v2u*)(VNt + (16 * ct + r16) * 72 + 16 * rt + 4 * quad) = o; } } \
        lds_barrier(); \
        _Pragma("unroll") for (int ct = 0; ct < NCT; ++ct) { \
            const bf16x8 vb0 = *(const LAS bf16x8*)(VNt + (16 * ct + r16) * 72 + 8 * quad), vb1 = *(const LAS bf16x8*)(VNt + (16 * ct + r16) * 72 + 32 + 8 * quad); \
            if (w >= 4) { acc[ct] = __builtin_amdgcn_mfma_f32_16x16x32_bf16(cur.qk[0], vb0, acc[ct], 0, 0, 0); acc[ct] = __builtin_amdgcn_mfma_f32_16x16x32_bf16(cur.qk[1], vb1, acc[ct], 0, 0, 0); \
                _Pragma("unroll") for (int j = 0; j < 4; ++j) Ost[(16 * rt + 4 * quad + j) * NC + 16 * ct + r16] = acc[ct][j]; } \
            sacc[ct] = sacc[ct] * cur.gl; \
            sacc[ct] = __builtin_amdgcn_mfma_f32_16x16x32_bf16(cur.kd[0], vb0, sacc[ct], 0, 0, 0); \
            sacc[ct] = __builtin_amdgcn_mfma_f32_16x16x32_bf16(cur.kd[1], vb1, sacc[ct], 0, 0, 0); \
            { v2u o; o.x = pk2(sacc[ct][0], sacc[ct][1]); o.y = pk2(sacc[ct][2], sacc[ct][3]); *(LAS v2u*)(St + (16 * ct + r16) * 136 + 16 * w + 4 * quad) = o; } } \
        lds_barrier(); \
        { const int g = gdn_g(b, dir, (s_)); constexpr int TPR = NC / 16 ;   \
            for (int idx = F.tid; idx < 64 * TPR; idx += NT) { const int i = idx / TPR, c16 = (idx % TPR) * 16, ti = dir ? 63 - i : i; \
                float* gp = GO + ((size_t)64 * g + ti) * 512 + h * 128 + part * NC + c16; \
                _Pragma("unroll") for (int k4 = 0; k4 < 4; ++k4) *(f32x4*)(gp + 4 * k4) = *(const LAS f32x4*)(Ost + i * NC + c16 + 4 * k4); } } \
    } while (0)
    GdnOpsW<NCT> r0, r1;
    gdn_load_wide<NCT>(F, r0, gdn_cd(b, h, dir, 0), part); gdn_load_wide<NCT>(F, r1, gdn_cd(b, h, dir, 1), part);
#pragma unroll 1
    for (int s = 0; s < 68; s += 2) {
        GDNW_STEP(r0, s);     gdn_load_wide<NCT>(F, r0, gdn_cd(b, h, dir, (s + 2 < 68 ? s + 2 : 67)), part);
        GDNW_STEP(r1, s + 1); gdn_load_wide<NCT>(F, r1, gdn_cd(b, h, dir, (s + 3 < 68 ? s + 3 : 67)), part);
    }
#undef GDNW_STEP
    __syncthreads();
}
__device__ __forceinline__ void gdn_out(Frame& F, int l) {
    REFRESH_TID(F);
    const int gw = F.bid * NWAVES + F.wave, NGW = F.G * NWAVES, lane = F.lane;
    const float* G0 = WSP(float, WS_GO); const float* G1 = G0 + (size_t)MROWS * 512;
    const bf16* U = WSP(bf16, WS_U); bf16* YC = WSP(bf16, WS_Y) + (size_t)2 * MROWS * 512;
    const float g0 = F.in[I_CGOUT][l * 128 + 2 * lane], g1 = F.in[I_CGOUT][l * 128 + 2 * lane + 1];
    int rlo, rhi;
    const int nrows = l == DEPTH - 1 ? TLAT : MROWS;
    if (F.G == 256 && l < DEPTH - 1) { if (F.bid < 64) { rlo = 38 * F.bid; rhi = rlo + 38; } else { rlo = 2432 + 78 * (F.bid - 64); rhi = rlo + 78; } }
    else { const int per = (nrows + F.G - 1) / F.G; rlo = per * F.bid; rhi = rlo + per < nrows ? rlo + per : nrows; if (rlo > nrows) rlo = nrows; }
    for (int r0 = rlo + F.wave; r0 < rhi; r0 += 2 * NWAVES) {
        const int r1 = r0 + NWAVES < rhi ? r0 + NWAVES : r0;
        f32x2_t a[2][4], c[2][4]; unsigned zz[2][4];
#pragma unroll
        for (int k = 0; k < 2; ++k) { const int r = k ? r1 : r0;
#pragma unroll
            for (int h = 0; h < 4; ++h) { const size_t o = (size_t)r * 512 + h * 128 + 2 * lane;
                a[k][h] = *(const f32x2_t*)(G0 + o); c[k][h] = *(const f32x2_t*)(G1 + o); zz[k][h] = *(const unsigned*)(U + (size_t)r * UW + UCZ + h * 128 + 2 * lane); } }
#pragma unroll
        for (int k = 0; k < 2; ++k) { const int r = k ? r1 : r0; if (k == 1 && r1 == r0) break;
#pragma unroll
            for (int h = 0; h < 4; ++h) { const float a0 = a[k][h].x + c[k][h].x, a1 = a[k][h].y + c[k][h].y;
                const float ss = wave_sum(a0 * a0 + a1 * a1);
                const float rs = rsqrtf(ss * (1.f / 128.f) + EPS);
                *(unsigned*)(YC + (size_t)r * 512 + h * 128 + 2 * lane) = pk2(a0 * rs * g0 * siluf_(bflo(zz[k][h])), a1 * rs * g1 * siluf_(bfhi(zz[k][h]))); } }
    }
}


constexpr int SD_P = 136;
constexpr int SD_MAT = 64 * SD_P * 2, SD_BUF = 2 * SD_MAT;
struct SideRegs { v4u a[2], b[2]; };
__device__ __forceinline__ void side_g2r(SideRegs& R, const bf16* Ab, size_t lda, const bf16* Bb, size_t ldb, int tid) {
#pragma unroll
    for (int k = 0; k < 2; ++k) { const int pc = tid + 512 * k, r = pc >> 4, c = pc & 15;
        R.a[k] = *(const v4u*)(Ab + (size_t)r * lda + c * 8); R.b[k] = *(const v4u*)(Bb + (size_t)r * ldb + c * 8); }
}
__device__ __forceinline__ void side_r2l(const SideRegs& R, LAS unsigned char* buf, int tid) {
#pragma unroll
    for (int k = 0; k < 2; ++k) { const int pc = tid + 512 * k, r = pc >> 4, c = pc & 15;
        *(LAS v4u*)(buf + (r * SD_P + c * 8) * 2) = R.a[k]; *(LAS v4u*)(buf + SD_MAT + (r * SD_P + c * 8) * 2) = R.b[k]; }
}
__device__ __forceinline__ void side_lmma(f32x4& c0, f32x4& c1, const LAS unsigned char* buf, int rt, int chf, int r16, int quad) {
    const LAS bf16* A = (const LAS bf16*)buf + (16 * rt + r16) * SD_P + 8 * quad;
    const LAS bf16* B0 = (const LAS bf16*)(buf + SD_MAT) + (32 * chf + r16) * SD_P + 8 * quad;
    const LAS bf16* B1 = B0 + 16 * SD_P;
#pragma unroll
    for (int s = 0; s < 4; ++s) { const bf16x8 a = *(const LAS bf16x8*)(A + 32 * s);
        c0 = __builtin_amdgcn_mfma_f32_16x16x32_bf16(a, *(const LAS bf16x8*)(B0 + 32 * s), c0, 0, 0, 0);
        c1 = __builtin_amdgcn_mfma_f32_16x16x32_bf16(a, *(const LAS bf16x8*)(B1 + 32 * s), c1, 0, 0, 0); }
}
__device__ __forceinline__ void side_merge(Frame& F, int l) {
    REFRESH_TID(F);
    const int lane = F.lane, w = F.wave, r16 = lane & 15, quad = lane >> 4, rt = w & 3, chf = w >> 2;
    const bf16* U = WSP(bf16, WS_U);
    for (int tile = F.bid; tile < 256; tile += F.G) {
        const int rowT = TLAT + 64 * (tile >> 4), colT = 64 * (tile & 15);
        const int row0 = rowT + 16 * rt, col0 = colT + 32 * chf;
        f32x4 m0 = (f32x4){0.f, 0.f, 0.f, 0.f}, m1 = m0, c0 = m0, c1 = m0;
#define SM_A(q) (WSP(bf16, WS_Y) + ((size_t)((q) >> 2) * MROWS + rowT) * 512 + 128 * ((q) & 3))
#define SM_B(q) (WSP(bf16, WS_WBR) + (((size_t)l * 4 + ((q) >> 2)) * 1024 + colT) * 512 + 128 * ((q) & 3))
        SideRegs R[4];
        __syncthreads();
        side_g2r(R[0], SM_A(0), 512, SM_B(0), 512, F.tid); side_r2l(R[0], F.lds, F.tid);
#pragma unroll
        for (int j = 0; j < 4; ++j) side_g2r(R[j], SM_A(j + 1), 512, SM_B(j + 1), 512, F.tid);
        lds_barrier();
        unsigned short gr0[4], gr1[4];
#pragma unroll 1
        for (int q0 = 0; q0 < 16; q0 += 4) {
#pragma unroll
            for (int j = 0; j < 4; ++j) { const bf16* gp = U + (size_t)(row0 + 4 * quad + j) * UW + UG + (q0 >> 2) * 1024 + col0 + r16; gr0[j] = gp[0]; gr1[j] = gp[16]; }
#pragma unroll
            for (int j = 0; j < 4; ++j) { const int q = q0 + j;
                side_lmma(c0, c1, F.lds + (j & 1) * SD_BUF, rt, chf, r16, quad);
                side_r2l(R[j], F.lds + ((j + 1) & 1) * SD_BUF, F.tid);
                { const int qn = q + 5 < 16 ? q + 5 : 15; side_g2r(R[j], SM_A(qn), 512, SM_B(qn), 512, F.tid); }
                lds_barrier(); }
#pragma unroll
            for (int j = 0; j < 4; ++j) { m0[j] += sigmoidf_(bf2f(gr0[j])) * c0[j]; m1[j] += sigmoidf_(bf2f(gr1[j])) * c1[j]; }
            c0 = (f32x4){0.f, 0.f, 0.f, 0.f}; c1 = c0;
        }
#undef SM_A
#undef SM_B
#pragma unroll
        for (int j = 0; j < 4; ++j) { bf16* mp = WSP(bf16, WS_MB) + (size_t)(row0 + 4 * quad + j) * 1024 + col0 + r16;
            mp[0] = (bf16)f2bf(m0[j]); mp[16] = (bf16)f2bf(m1[j]); }
    }
}
__device__ __forceinline__ void side_outproj(Frame& F, int l) {
    REFRESH_TID(F);
    const int lane = F.lane, w = F.wave, r16 = lane & 15, quad = lane >> 4, rt = w & 3, chf = w >> 2;
    const float* gt = WSP(float, WS_MOD) + ((size_t)l * 5 + 4) * 6144 + 2048;
    for (int tile = F.bid; tile < 256; tile += F.G) {
        const int rowT = TLAT + 64 * (tile >> 4), colT = 64 * (tile & 15);
        const int row0 = rowT + 16 * rt, col0 = colT + 32 * chf;
        const bf16* Ab = WSP(bf16, WS_MB) + (size_t)rowT * 1024;
        const bf16* Bb = WSP(bf16, WS_WOUT) + ((size_t)l * 1024 + colT) * 1024;
        f32x4 c0 = (f32x4){0.f, 0.f, 0.f, 0.f}, c1 = c0;
        SideRegs R[4];
        __syncthreads();
        side_g2r(R[0], Ab, 1024, Bb, 1024, F.tid); side_r2l(R[0], F.lds, F.tid);
#pragma unroll
        for (int j = 0; j < 4; ++j) side_g2r(R[j], Ab + 128 * (j + 1), 1024, Bb + 128 * (j + 1), 1024, F.tid);
        lds_barrier();
#pragma unroll 1
        for (int q0 = 0; q0 < 8; q0 += 4) {
#pragma unroll
            for (int j = 0; j < 4; ++j) { const int q = q0 + j;
                side_lmma(c0, c1, F.lds + (j & 1) * SD_BUF, rt, chf, r16, quad);
                side_r2l(R[j], F.lds + ((j + 1) & 1) * SD_BUF, F.tid);
                { const int qn = q + 5 < 8 ? q + 5 : 7; side_g2r(R[j], Ab + 128 * qn, 1024, Bb + 128 * qn, 1024, F.tid); }
                lds_barrier(); }
        }
        const float g0 = gt[col0 + r16], g1 = gt[col0 + 16 + r16];
#pragma unroll
        for (int j = 0; j < 4; ++j) { float* xp = WSP(float, WS_X) + (size_t)(row0 + 4 * quad + j) * 1024 + col0 + r16;
            xp[0] += g0 * c0[j]; xp[16] += g1 * c1[j]; }
    }
}

#ifndef SCAN_PARTS
#define SCAN_PARTS 2
#endif
constexpr int NSCAN = 4 * SCAN_PARTS;
constexpr int CW_Q = 2048;
__device__ __forceinline__ void mixer_queue_phase(Frame& F, int l) {
    volatile LAS int* qslot = (volatile LAS int*)(F.lds + MISC_OFF + 64);
    const int x0 = (int)(xb_xcc_id() & 7u);
#if defined(PROBE_SUB) && (PROBE_SUB == 4 || PROBE_SUB == 5)
    const unsigned long long tq0 = __builtin_amdgcn_s_memrealtime();
#endif
#pragma unroll 1
    for (int kq = 0; kq < 8; ++kq) {
      const int x = (x0 + kq) & 7;
      for (;;) {
        __syncthreads();
        if (F.tid == 0) *qslot = (int)__hip_atomic_fetch_add(F.ctl + CW_Q + l * 8 + x, 1u, __ATOMIC_RELAXED, __HIP_MEMORY_SCOPE_AGENT);
        __syncthreads();
        const int idx = __builtin_amdgcn_readfirstlane(*qslot);
        if (idx >= (l == DEPTH - 1 ? 128 : 136) + NSCAN) break;
#ifdef PROBE_SUB
        unsigned long long t0_ = 0ull; const bool pr_on = false;
#endif
        if (idx < NSCAN) { gdn_scan_wide<8 / SCAN_PARTS>(F, x + 8 * (idx / SCAN_PARTS), idx % SCAN_PARTS); }
        else { AttnUnit un; const int q = idx - NSCAN;
            if (q < 64) { un.kind = 0; un.b = x >> 1; un.hx = x & 1; un.qx = q; }
            else if (q < 128) { const int qq = q - 64, combo = x + 8 * (qq >> 4); un.kind = 1; un.b = combo >> 3; un.hx = combo & 7; un.qx = qq & 15; }
            else { const int qq = q - 128;
                if (qq < 4) { un.kind = 2; un.b = x >> 1; un.hx = x & 1; un.qx = qq; }
                else { const int combo = x + 8 * (qq - 4); un.kind = 3; un.b = combo >> 3; un.hx = combo & 7; un.qx = 0; } }
            attn_unit(F, l, un); }
#ifdef PROBE_SUB
        if (pr_on) F.pr += __builtin_amdgcn_s_memrealtime() - t0_;
        if (PROBE_SUB == 13 && F.bid == 8 && idx >= 4 && idx < 68) F.pr += 100;
        if (PROBE_SUB == 14 && F.bid == 8 && idx >= 68 && idx < 140) F.pr += 100;
#endif
      }
    }
#if defined(PROBE_SUB) && PROBE_SUB == 4
    if (F.tid == 0) __hip_atomic_fetch_max(F.ctl + 3000 + l, (unsigned)(__builtin_amdgcn_s_memrealtime() - tq0), __ATOMIC_RELAXED, __HIP_MEMORY_SCOPE_AGENT);
#endif
#if defined(PROBE_SUB) && PROBE_SUB == 5
    if (F.tid == 0) __hip_atomic_fetch_max(F.ctl + 3000 + l, 0x7fffffffu - (unsigned)(__builtin_amdgcn_s_memrealtime() - tq0), __ATOMIC_RELAXED, __HIP_MEMORY_SCOPE_AGENT);
#endif
}


#ifndef REP_P0
#define REP_P0 1
#endif
#ifndef REP_B
#define REP_B 1
#endif
#ifndef REP_D1
#define REP_D1 1
#endif
#ifndef REP_D2
#define REP_D2 1
#endif
#ifndef REP_E
#define REP_E 1
#endif
#ifndef REP_F
#define REP_F 1
#endif
#ifndef REP_I
#define REP_I 1
#endif
#ifndef REP_J
#define REP_J 1
#endif
#ifndef REP_C1
#define REP_C1 1
#endif
#ifndef REP_C2
#define REP_C2 1
#endif
#ifndef REP_C4
#define REP_C4 1
#endif
#ifndef REP_G2
#define REP_G2 1
#endif

#ifndef MIXER_QUEUE
#define MIXER_QUEUE 1
#endif
constexpr int PH_PER_LAYER = 11, PH_FINAL = 1 + PH_PER_LAYER * DEPTH, N_PHASES = PH_FINAL + 1;
struct Args { const float* in[32]; float* out; unsigned char* ws; int ph_lo, ph_hi, li, pad; };

__global__ void __launch_bounds__(NT, 2) hybrid_fwd(Args args) {
    extern __shared__ __attribute__((aligned(16))) unsigned char lds_raw[];
    Frame F;
    F.lds = (LAS unsigned char*)lds_raw;
    F.wave = __builtin_amdgcn_readfirstlane((int)threadIdx.x >> 6); F.lane = (int)__builtin_amdgcn_mbcnt_hi(~0u, __builtin_amdgcn_mbcnt_lo(~0u, 0u)); F.tid = F.wave * 64 + F.lane;
    F.G = gridDim.x; F.bid = blockIdx.x; F.pr = 0ull;
    F.in = args.in; F.in0 = args.in;
    F.out = args.out; F.ws = args.ws; F.ws0 = args.ws; F.ctl = (unsigned*)(args.ws + WS_CTL);
    volatile LAS unsigned* MISC = (volatile LAS unsigned*)(F.lds + MISC_OFF);
    if (F.tid < 64) MISC[F.tid] = 0u;
    __syncthreads();
    const int lo = args.ph_lo, hi = args.ph_hi;
    XcdBarrier bar = xcd_barrier_post(F.ctl + CW_BAR + args.li * XCD_BAR_WORDS, MISC + 8);
#ifndef ONLY_MASK
#define ONLY_MASK 0xFFFF
#endif
#define PHON(b) ((ONLY_MASK >> (b)) & 1)
#define IN(k) (lo <= (k) && (k) < hi)
#define SEAM(k) do { if ((k) + 1 < hi) xcd_barrier(bar); } while (0)
#ifdef PROBE_PHASE
    unsigned long long pr_acc = 0ull, pr_t0 = 0ull;
#define PR_BEGIN(k) do { if ((k) == PROBE_PHASE) pr_t0 = __builtin_amdgcn_s_memrealtime(); } while (0)
#define PR_END(k) do { if ((k) == PROBE_PHASE) pr_acc += __builtin_amdgcn_s_memrealtime() - pr_t0; } while (0)
#else
#define PR_BEGIN(k) do { } while (0)
#define PR_END(k) do { } while (0)
#endif

    if (PHON(0) && IN(0)) { REFRESH_TID(F); _Pragma("unroll 1") for (int rep_ = 0; rep_ < REP_P0; ++rep_) { p0_prologue(F); __syncthreads(); } SEAM(0); PR_END(0); }
#pragma unroll 1
    for (int l = 0; l < DEPTH; ++l) {
        const int pb = 1 + PH_PER_LAYER * l;
        if (PHON(1) && IN(pb + 0)) { PR_BEGIN(1); REFRESH_TID(F); norm_phase<0>(F, l); SEAM(pb + 0); PR_END(1); }
        if (PHON(2) && IN(pb + 1)) { PR_BEGIN(2); REFRESH_TID(F);
            pg8::Gemm g{WSP(bf16, WS_H), WSP(bf16, WS_WIN) + (size_t)l * UW * D, MROWS, UW, D};
            pg8::StaticOrder S; S.init(MROWS, UW, F.G, F.bid);
            pg8::EpiStoreBf16 E{WSP(bf16, WS_U), UW};
            _Pragma("unroll 1") for (int rep_ = 0; rep_ < REP_B; ++rep_) { pg8::gemm_phase<pg8::EpiStoreBf16, pg8::StaticOrder, true, true>(F.lds, g, S, E, F.wave); __syncthreads(); }
            SEAM(pb + 1); PR_END(2);
        }
        if (PHON(3) && IN(pb + 2)) { PR_BEGIN(3); REFRESH_TID(F);
#ifndef NO_C1
            PR_BEGIN(30); _Pragma("unroll 1") for (int rep_ = 0; rep_ < REP_C1; ++rep_) { gdn_prep(F, l); __syncthreads(); } PR_END(30);
#endif
#ifndef NO_C2
            PR_BEGIN(31); _Pragma("unroll 1") for (int rep_ = 0; rep_ < REP_C2; ++rep_) { lru_pass1(F, l); __syncthreads(); } PR_END(31);
#endif
            __syncthreads();
#ifndef NO_C3
            PR_BEGIN(32); qk_prep(F, l); PR_END(32);
#endif
#ifndef NO_C4
            PR_BEGIN(33); _Pragma("unroll 1") for (int rep_ = 0; rep_ < REP_C4; ++rep_) { v_transpose(F); __syncthreads(); } PR_END(33); PR_BEGIN(34);
#endif
            SEAM(pb + 2); PR_END(34); PR_END(3);
        }
        if (PHON(4) && IN(pb + 3)) { PR_BEGIN(4); REFRESH_TID(F);
#if MIXER_QUEUE
            lru_carry_all(F);
            __syncthreads();
            mixer_queue_phase(F, l);
#else
            PR_BEGIN(20); for (int ch = F.bid; ch < 256; ch += F.G) gdn_scan(F, ch); PR_END(20);
            PR_BEGIN(21); lru_carry_all(F);
            __syncthreads(); PR_END(21);
            PR_BEGIN(22); attn_phase(F, l); PR_END(22);
#endif
            PR_BEGIN(23);
            SEAM(pb + 3); PR_END(23); PR_END(4);
        }
        if (PHON(5) && IN(pb + 4)) { PR_BEGIN(5); REFRESH_TID(F);
            _Pragma("unroll 1") for (int rep_ = 0; rep_ < REP_E; ++rep_) { lru_pass2(F, l); __syncthreads(); }
            __syncthreads();
            gdn_out(F, l);
            SEAM(pb + 4); PR_END(5);
        }
        if (PHON(6) && IN(pb + 5)) { PR_BEGIN(6); REFRESH_TID(F);
            pg8::Gemm g{WSP(bf16, WS_Y), WSP(bf16, WS_WBR) + (size_t)l * 4 * 1024 * 512, 4 * MROWS, 4 * 1024, 512};
            pg8::MergeOrder S{F.G, F.bid, MROWS / 256, TLAT / 256};
            pg8::EpiMerge E{WSP(bf16, WS_U), UW, UG, WSP(bf16, WS_MF), WSP(bf16, WS_MB), MROWS / 256};
            _Pragma("unroll 1") for (int rep_ = 0; rep_ < REP_F; ++rep_) { pg8::gemm_phase<pg8::EpiMerge, pg8::MergeOrder, true, true>(F.lds, g, S, E, F.wave); __syncthreads(); }
            PR_BEGIN(13); if (l < DEPTH - 1) side_merge(F, l); PR_END(13);
            SEAM(pb + 5); PR_END(6);
        }
        if (PHON(7) && IN(pb + 6)) { PR_BEGIN(7); REFRESH_TID(F);
            pg8::Gemm g{WSP(bf16, WS_MB), WSP(bf16, WS_WOUT) + (size_t)l * D * D, MROWS, D, D};
            pg8::StaticOrder S; S.init(TLAT, D, F.G, F.bid);
            pg8::EpiResid E{WSP(float, WS_X), WSP(float, WS_MOD) + (size_t)l * 5 * 6144 + 2048};
            pg8::gemm_phase<pg8::EpiResid, pg8::StaticOrder, true, true>(F.lds, g, S, E, F.wave);
            PR_BEGIN(14); if (l < DEPTH - 1) side_outproj(F, l); PR_END(14);
            SEAM(pb + 6); PR_END(7);
        }
        if (PHON(8) && IN(pb + 7)) { PR_BEGIN(8); REFRESH_TID(F); norm_phase<1>(F, l); SEAM(pb + 7); PR_END(8); }
        if (PHON(9) && IN(pb + 8)) { PR_BEGIN(9); REFRESH_TID(F); _Pragma("unroll 1") for (int rep_ = 0; rep_ < REP_G2; ++rep_) { moe_gather(F, l); __syncthreads(); } SEAM(pb + 8); PR_END(9); }
        if (PHON(10) && IN(pb + 9)) { PR_BEGIN(10); REFRESH_TID(F);
            moe_table(F, l);
            pg8::Gemm g{WSP(bf16, WS_HS), WSP(bf16, WS_WGU) + (size_t)l * NEXP * 2048 * D, MOE_ROWS, NEXP * 2048, D};
            pg8::MoeOrder S{(const LAS int*)(F.lds + MISC_OFF + 256), F.G, F.bid, 8};
            pg8::EpiSwiglu E{WSP(bf16, WS_ACT), F.in[I_BGU] + (size_t)l * NEXP * 2048};
            _Pragma("unroll 1") for (int rep_ = 0; rep_ < REP_I; ++rep_) { pg8::gemm_phase<pg8::EpiSwiglu, pg8::MoeOrder, true, true>(F.lds, g, S, E, F.wave); __syncthreads(); }
            SEAM(pb + 9); PR_END(10);
        }
        if (PHON(11) && IN(pb + 10)) { PR_BEGIN(11); REFRESH_TID(F);
            moe_table(F, l);
            pg8::Gemm g{WSP(bf16, WS_ACT), WSP(bf16, WS_WDN) + (size_t)l * NEXP * D * D, MOE_ROWS, NEXP * D, D};
            pg8::MoeOrder S{(const LAS int*)(F.lds + MISC_OFF + 256), F.G, F.bid, 4};
            pg8::EpiDown E{WSP(bf16, WS_YS), F.in[I_BDN] + (size_t)l * NEXP * D};
            _Pragma("unroll 1") for (int rep_ = 0; rep_ < REP_J; ++rep_) { pg8::gemm_phase<pg8::EpiDown, pg8::MoeOrder, true, true>(F.lds, g, S, E, F.wave); __syncthreads(); }
            SEAM(pb + 10); PR_END(11);
        }
    }
    if (PHON(12) && IN(PH_FINAL)) { PR_BEGIN(12); REFRESH_TID(F); norm_phase<2>(F, 0); PR_END(12); }
#if defined(PROBE_SUB) && (PROBE_SUB == 4 || PROBE_SUB == 5)
    if (blockIdx.x == 0) { unsigned long long tot = 0ull;
        for (int q = 0; q < 4; ++q) { const unsigned v = __hip_atomic_load(F.ctl + 3000 + q, __ATOMIC_RELAXED, __HIP_MEMORY_SCOPE_AGENT); tot += (PROBE_SUB == 4) ? v : (0x7fffffffu - v); }
        F.pr = tot; }
#endif
#ifdef PROBE_SUB
    if (F.pr) { const unsigned long long te = __builtin_amdgcn_s_memrealtime(); while (__builtin_amdgcn_s_memrealtime() - te < PROBE_MULT * F.pr) __builtin_amdgcn_s_sleep(8); }
#endif
#ifdef PROBE_PHASE
    if (blockIdx.x == 0) { const unsigned long long te = __builtin_amdgcn_s_memrealtime(); while (__builtin_amdgcn_s_memrealtime() - te < PROBE_MULT * pr_acc) __builtin_amdgcn_s_sleep(8); }
#endif
#undef IN
#undef SEAM
}

extern "C" void kernel_launch(void* const* d_in, const int* in_sizes, int n_in, void* d_out, int out_size, void* d_ws, size_t ws_size, hipStream_t stream) {
    static int grid = 0;
    if (grid == 0) {
        if (n_in != 32 || out_size != TLAT * D || ws_size < WS_END) { fprintf(stderr, "kernel_launch: unexpected shapes (n_in %d out %d ws %zu need %zu)\n", n_in, out_size, ws_size, (size_t)WS_END); grid = -1; return; }
        int dev = 0, cus = 0, per_cu = 0;
        if (hipGetDevice(&dev) != hipSuccess || hipDeviceGetAttribute(&cus, hipDeviceAttributeMultiprocessorCount, dev) != hipSuccess) { grid = -1; return; }
        if (hipFuncSetAttribute((const void*)hybrid_fwd, hipFuncAttributeMaxDynamicSharedMemorySize, LDS_BYTES) != hipSuccess) { fprintf(stderr, "kernel_launch: hipFuncSetAttribute failed\n"); grid = -1; return; }
        if (hipOccupancyMaxActiveBlocksPerMultiprocessor(&per_cu, (const void*)hybrid_fwd, NT, LDS_BYTES) != hipSuccess || per_cu < 1) fprintf(stderr, "kernel_launch: occupancy query says %d\n", per_cu);
        (void)hipGetLastError();
        grid = cus;
    }
    if (grid < 0) return;
    if (hipMemsetAsync((char*)d_ws + WS_CTL, 0, CTL_BYTES, stream) != hipSuccess) return;
    Args a{};
    for (int i = 0; i < 32; ++i) a.in[i] = (const float*)d_in[i];
    a.out = (float*)d_out; a.ws = (unsigned char*)d_ws;
#if MK_MULTI
    for (int p = 0; p < N_PHASES; ++p) { a.ph_lo = p; a.ph_hi = p + 1; a.li = p;
        hipLaunchKernelGGL(hybrid_fwd, dim3(grid), dim3(NT), LDS_BYTES, stream, a); }
#else
    a.ph_lo = 0; a.ph_hi = N_PHASES; a.li = 0;
    hipLaunchKernelGGL(hybrid_fwd, dim3(grid), dim3(NT), LDS_BYTES, stream, a);
#endif
    const hipError_t le = hipPeekAtLastError();
    if (le != hipSuccess) fprintf(stderr, "kernel_launch: launch failed: %s\n", hipGetErrorName(le));
}
```
